# Optimizing an MI355X kernel written in HIP

```python
import math
import jax, jax.numpy as jnp
from jax import lax
import numpy as np

D_MODEL = 2048
BATCH = 4
SEQ = 2048
DEPTH = 1

HEAD_DIM = 64
N_ATTN_HEADS = 16
D_ATTN = N_ATTN_HEADS * HEAD_DIM
SSM_GROUP = 16
N_SSM_GROUPS = 64
D_SSM = N_SSM_GROUPS * SSM_GROUP
SSM_STATE = 64
D_MIX = D_ATTN + D_SSM
D_IN_PROJ = 3 * D_ATTN + D_SSM
DILATED_BRANCHES = ((128, 1), (512, 4), (2048, 16))
BLK = 128
N_BUCKETS = 32
MAX_DISTANCE = 2048
PEER_HEADS = 8
PEER_KEYS = 128
PEER_EXPERTS = PEER_KEYS * PEER_KEYS
PEER_QDIM = 256
PEER_TOPK = 16
PEER_TOKEN_BLOCK = 128
EPS = 1e-6
NEG = -1e30

kernel_name = "hymba_s5_dilated_attn_peer_layer"


def rmsnorm(x, g):
    x32 = x.astype(jnp.float32)
    y = x32 * lax.rsqrt(jnp.mean(x32 * x32, axis=-1, keepdims=True) + EPS)
    return (y * g.astype(jnp.float32)).astype(x.dtype)


def t5_bucket(dist):
    max_exact = N_BUCKETS // 2
    n = jnp.maximum(dist, 0)
    nf = jnp.maximum(n, 1).astype(jnp.float32)
    large = max_exact + (jnp.log(nf / max_exact) / math.log(MAX_DISTANCE / max_exact)
                         * (N_BUCKETS - max_exact)).astype(jnp.int32)
    large = jnp.minimum(large, N_BUCKETS - 1)
    return jnp.where(n < max_exact, n, large)


def dilated_branch(q, k, v, rel_bias, window, dil):
    B, S, H, Dh = q.shape
    L = S // dil
    W = window // dil
    Lp = -(-L // BLK) * BLK
    nb = Lp // BLK

    def sub(t, front):
        t = t.reshape(B, L, dil, H, Dh)
        return jnp.pad(t, ((0, 0), (front, Lp - L), (0, 0), (0, 0), (0, 0)))

    qb = sub(q, 0).reshape(B, nb, BLK, dil, H, Dh)
    kp = sub(k, BLK).reshape(B, nb + 1, BLK, dil, H, Dh)
    vp = sub(v, BLK).reshape(B, nb + 1, BLK, dil, H, Dh)
    kb = jnp.concatenate([kp[:, :-1], kp[:, 1:]], axis=2)
    vb = jnp.concatenate([vp[:, :-1], vp[:, 1:]], axis=2)

    qi = jnp.arange(BLK)[:, None]
    kj = jnp.arange(2 * BLK)[None, :]
    rel = qi - kj + BLK
    blk_idx = jnp.arange(nb)[:, None, None]
    valid = (rel >= 0) & (rel <= W) & (blk_idx * BLK - BLK + kj >= 0)
    bias = jnp.transpose(rel_bias.astype(jnp.float32)[t5_bucket(rel * dil)], (2, 0, 1))

    s = jnp.einsum('bnqrhd,bnkrhd->bnrhqk', qb, kb).astype(jnp.float32) / math.sqrt(Dh)
    s = jnp.where(valid[None, :, None, None], s + bias, NEG)
    m = jnp.max(s, axis=-1)
    p = jnp.exp(s - m[..., None])
    l = jnp.sum(p, axis=-1)
    o = jnp.einsum('bnrhqk,bnkrhd->bnrhqd', p, vb.astype(jnp.float32)) / l[..., None]

    o = jnp.transpose(o, (0, 1, 4, 2, 3, 5)).reshape(B, Lp, dil, H, Dh)[:, :L].reshape(B, S, H, Dh)
    m = jnp.transpose(m, (0, 1, 4, 2, 3)).reshape(B, Lp, dil, H)[:, :L].reshape(B, S, H)
    l = jnp.transpose(l, (0, 1, 4, 2, 3)).reshape(B, Lp, dil, H)[:, :L].reshape(B, S, H)
    return o, m, l


def dilated_attention(q, k, v, rel_bias):
    outs, ms, ls = [], [], []
    for window, dil in DILATED_BRANCHES:
        o, m, l = dilated_branch(q, k, v, rel_bias, window, dil)
        outs.append(o)
        ms.append(m)
        ls.append(l)
    m = jnp.stack(ms)
    w = jnp.stack(ls) * jnp.exp(m - jnp.max(m, axis=0, keepdims=True))
    o = jnp.einsum('nbsh,nbshd->bshd', w, jnp.stack(outs)) / jnp.sum(w, axis=0)[..., None]
    return o


def s5_mixer(u, lam_re, lam_im, log_dt, b_re, b_im, c_re, c_im, d_skip, glu_w, glu_b):
    B, S, _ = u.shape
    f32 = jnp.float32
    u32 = u.astype(f32).reshape(B, S, N_SSM_GROUPS, SSM_GROUP)
    lr, li = lam_re.astype(f32), lam_im.astype(f32)
    dt = jnp.exp(log_dt.astype(f32))[:, None]
    mag = jnp.exp(lr * dt)
    a_re, a_im = mag * jnp.cos(li * dt), mag * jnp.sin(li * dt)
    den = lr * lr + li * li
    f_re = ((a_re - 1.0) * lr + a_im * li) / den
    f_im = (a_im * lr - (a_re - 1.0) * li) / den
    br, bi = b_re.astype(f32), b_im.astype(f32)
    bb_re = f_re[..., None] * br - f_im[..., None] * bi
    bb_im = f_re[..., None] * bi + f_im[..., None] * br
    bu_re = jnp.einsum('bsgc,gnc->bsgn', u32, bb_re)
    bu_im = jnp.einsum('bsgc,gnc->bsgn', u32, bb_im)
    A_re = jnp.broadcast_to(a_re, bu_re.shape)
    A_im = jnp.broadcast_to(a_im, bu_im.shape)

    def combine(e1, e2):
        a1r, a1i, b1r, b1i = e1
        a2r, a2i, b2r, b2i = e2
        return (a2r * a1r - a2i * a1i,
                a2r * a1i + a2i * a1r,
                a2r * b1r - a2i * b1i + b2r,
                a2r * b1i + a2i * b1r + b2i)

    _, _, x_re, x_im = lax.associative_scan(combine, (A_re, A_im, bu_re, bu_im), axis=1)
    y = (jnp.einsum('bsgn,gcn->bsgc', x_re, c_re.astype(f32))
         - jnp.einsum('bsgn,gcn->bsgc', x_im, c_im.astype(f32))
         + d_skip.astype(f32) * u32)
    y = jax.nn.gelu(y, approximate=False).reshape(B, S, D_SSM)
    y = y * jax.nn.sigmoid(y @ glu_w.astype(f32) + glu_b.astype(f32))
    return y.astype(u.dtype)


def peer(h, w_q, keys1, keys2, u_tab, v_tab):
    B, S, D = h.shape
    T = B * S
    ht = h.reshape(T, D)
    q = (ht @ w_q).reshape(T, PEER_HEADS, 2, PEER_QDIM // 2)
    s1 = jnp.einsum('thd,hkd->thk', q[:, :, 0], keys1).astype(jnp.float32)
    s2 = jnp.einsum('thd,hkd->thk', q[:, :, 1], keys2).astype(jnp.float32)
    v1, i1 = lax.top_k(s1, PEER_TOPK)
    v2, i2 = lax.top_k(s2, PEER_TOPK)
    cand = (v1[..., :, None] + v2[..., None, :]).reshape(T, PEER_HEADS, PEER_TOPK * PEER_TOPK)
    sc, ci = lax.top_k(cand, PEER_TOPK)
    e1 = jnp.take_along_axis(i1, ci // PEER_TOPK, axis=-1)
    e2 = jnp.take_along_axis(i2, ci % PEER_TOPK, axis=-1)
    experts = e1 * PEER_KEYS + e2
    gates = jax.nn.softmax(sc, axis=-1)

    n_blk = T // PEER_TOKEN_BLOCK
    K = PEER_HEADS * PEER_TOPK

    def block(args):
        hb, eb, gb = args
        a = jnp.einsum('td,tkd->tk', hb, u_tab[eb]).astype(jnp.float32)
        w = gb * jax.nn.gelu(a, approximate=False)
        return jnp.einsum('tk,tkd->td', w, v_tab[eb].astype(jnp.float32))

    out = lax.map(block, (ht.reshape(n_blk, PEER_TOKEN_BLOCK, D),
                          experts.reshape(n_blk, PEER_TOKEN_BLOCK, K),
                          gates.reshape(n_blk, PEER_TOKEN_BLOCK, K)))
    return out.reshape(B, S, D).astype(h.dtype)


def setup_inputs(seed: int = 0) -> dict:
    key = jax.random.key(seed)
    ks = jax.random.split(key, 26)
    f32 = jnp.float32
    nrm = lambda k, shape, scale: jax.random.normal(k, shape, f32) * scale
    gain = lambda k, n: 1.0 + 0.02 * jax.random.normal(k, (n,), f32)
    n_idx = jnp.arange(SSM_STATE, dtype=f32)[None, :]
    return {
        "x": nrm(ks[0], (BATCH, SEQ, D_MODEL), 1.0),
        "norm_mix_g": gain(ks[1], D_MODEL),
        "w_in": nrm(ks[2], (D_MODEL, D_IN_PROJ), D_MODEL ** -0.5),
        "q_norm_g": gain(ks[3], HEAD_DIM),
        "k_norm_g": gain(ks[4], HEAD_DIM),
        "rel_bias": nrm(ks[5], (N_BUCKETS, N_ATTN_HEADS), 0.5),
        "ssm_lambda_re": -0.5 + 0.01 * jax.random.normal(ks[6], (N_SSM_GROUPS, SSM_STATE), f32),
        "ssm_lambda_im": math.pi * n_idx + 0.01 * jax.random.normal(ks[7], (N_SSM_GROUPS, SSM_STATE), f32),
        "ssm_log_dt": jax.random.uniform(ks[8], (N_SSM_GROUPS,), f32, math.log(1e-3), math.log(1e-1)),
        "ssm_b_re": nrm(ks[9], (N_SSM_GROUPS, SSM_STATE, SSM_GROUP), (2 * SSM_GROUP) ** -0.5),
        "ssm_b_im": nrm(ks[10], (N_SSM_GROUPS, SSM_STATE, SSM_GROUP), (2 * SSM_GROUP) ** -0.5),
        "ssm_c_re": nrm(ks[11], (N_SSM_GROUPS, SSM_GROUP, SSM_STATE), (2 * SSM_STATE) ** -0.5),
        "ssm_c_im": nrm(ks[12], (N_SSM_GROUPS, SSM_GROUP, SSM_STATE), (2 * SSM_STATE) ** -0.5),
        "ssm_d": nrm(ks[13], (N_SSM_GROUPS, SSM_GROUP), 1.0),
        "ssm_glu_w": nrm(ks[14], (D_SSM, D_SSM), D_SSM ** -0.5),
        "ssm_glu_b": nrm(ks[15], (D_SSM,), 0.01),
        "attn_out_g": gain(ks[16], D_ATTN),
        "ssm_out_g": gain(ks[17], D_SSM),
        "w_out": nrm(ks[18], (D_MIX, D_MODEL), D_MIX ** -0.5),
        "norm_ffn_g": gain(ks[19], D_MODEL),
        "peer_w_q": nrm(ks[20], (D_MODEL, PEER_HEADS * PEER_QDIM), D_MODEL ** -0.5),
        "peer_keys1": nrm(ks[21], (PEER_HEADS, PEER_KEYS, PEER_QDIM // 2), (PEER_QDIM // 2) ** -0.5),
        "peer_keys2": nrm(ks[22], (PEER_HEADS, PEER_KEYS, PEER_QDIM // 2), (PEER_QDIM // 2) ** -0.5),
        "peer_u": nrm(ks[23], (PEER_EXPERTS, D_MODEL), D_MODEL ** -0.5),
        "peer_v": nrm(ks[24], (PEER_EXPERTS, D_MODEL), 0.5),
    }


def reference(x, norm_mix_g, w_in, q_norm_g, k_norm_g, rel_bias,
              ssm_lambda_re, ssm_lambda_im, ssm_log_dt, ssm_b_re, ssm_b_im,
              ssm_c_re, ssm_c_im, ssm_d, ssm_glu_w, ssm_glu_b,
              attn_out_g, ssm_out_g, w_out, norm_ffn_g,
              peer_w_q, peer_keys1, peer_keys2, peer_u, peer_v):
    B, S, _ = x.shape
    for _layer in range(DEPTH):
        h = rmsnorm(x, norm_mix_g)
        proj = h @ w_in
        q = proj[..., :D_ATTN].reshape(B, S, N_ATTN_HEADS, HEAD_DIM)
        k = proj[..., D_ATTN:2 * D_ATTN].reshape(B, S, N_ATTN_HEADS, HEAD_DIM)
        v = proj[..., 2 * D_ATTN:3 * D_ATTN].reshape(B, S, N_ATTN_HEADS, HEAD_DIM)
        u = proj[..., 3 * D_ATTN:]
        q = rmsnorm(q, q_norm_g)
        k = rmsnorm(k, k_norm_g)
        attn = dilated_attention(q, k, v, rel_bias).reshape(B, S, D_ATTN).astype(x.dtype)
        ssm = s5_mixer(u, ssm_lambda_re, ssm_lambda_im, ssm_log_dt, ssm_b_re, ssm_b_im,
                       ssm_c_re, ssm_c_im, ssm_d, ssm_glu_w, ssm_glu_b)
        mixed = jnp.concatenate([rmsnorm(attn, attn_out_g), rmsnorm(ssm, ssm_out_g)], axis=-1)
        x = x + (mixed @ w_out).astype(x.dtype)
        x = x + peer(rmsnorm(x, norm_ffn_g), peer_w_q, peer_keys1, peer_keys2, peer_u, peer_v)
    return x
```

```cpp
#include <hip/hip_runtime.h>
#include <math.h>
#include <stdint.h>

#define NTOK 8192
#define SEQ 2048
#define DM 2048
#define DPROJ 4096
#define NEXP 16384

__device__ __forceinline__ float wave_sum(float v) {
#pragma unroll
    for (int o = 32; o > 0; o >>= 1) v += __shfl_xor(v, o);
    return v;
}
__device__ __forceinline__ float block_sum256(float v, float* red) {
    v = wave_sum(v);
    __syncthreads();
    if ((threadIdx.x & 63) == 0) red[threadIdx.x >> 6] = v;
    __syncthreads();
    return red[0] + red[1] + red[2] + red[3];
}
__device__ __forceinline__ float gelu_exact(float x) { return 0.5f * x * (1.0f + erff(x * 0.70710678118654752f)); }

__global__ __launch_bounds__(256) void nv_rmsnorm(const float* x, int ldx, const float* g, float* y, int ldy, int D) {
    __shared__ float red[4];
    const float* xr = x + (size_t)blockIdx.x * ldx;
    float s = 0.f;
    for (int i = threadIdx.x; i < D; i += 256) { float v = xr[i]; s += v * v; }
    s = block_sum256(s, red);
    float r = rsqrtf(s / (float)D + 1e-6f);
    float* yr = y + (size_t)blockIdx.x * ldy;
    for (int i = threadIdx.x; i < D; i += 256) yr[i] = xr[i] * r * g[i];
}

__global__ __launch_bounds__(256) void nv_qknorm(float* proj, const float* gq, const float* gk) {
    int w = blockIdx.x * 4 + (threadIdx.x >> 6);
    int lane = threadIdx.x & 63;
    int which = w & 1, h = (w >> 1) & 15, t = w >> 5;
    float* p = proj + (size_t)t * DPROJ + which * 1024 + h * 64;
    float v = p[lane];
    float s = wave_sum(v * v);
    float r = rsqrtf(s / 64.f + 1e-6f);
    p[lane] = v * r * (which ? gk[lane] : gq[lane]);
}

__global__ __launch_bounds__(256) void nv_gemm(const float* A, int lda, const float* B, int ldb, float* C, int ldc, int K) {
    __shared__ float As[16][68];
    __shared__ float Bs[16][68];
    const int tx = threadIdx.x & 15, ty = threadIdx.x >> 4;
    const int m0 = blockIdx.y * 64, n0 = blockIdx.x * 64;
    float acc[4][4];
#pragma unroll
    for (int i = 0; i < 4; ++i)
#pragma unroll
        for (int j = 0; j < 4; ++j) acc[i][j] = 0.f;
    for (int k0 = 0; k0 < K; k0 += 16) {
#pragma unroll
        for (int i = 0; i < 4; ++i) { int idx = threadIdx.x + i * 256; int m = idx >> 4, k = idx & 15; As[k][m] = A[(size_t)(m0 + m) * lda + k0 + k]; }
#pragma unroll
        for (int i = 0; i < 4; ++i) { int idx = threadIdx.x + i * 256; int k = idx >> 6, n = idx & 63; Bs[k][n] = B[(size_t)(k0 + k) * ldb + n0 + n]; }
        __syncthreads();
#pragma unroll
        for (int k = 0; k < 16; ++k) {
            float a[4], b[4];
#pragma unroll
            for (int i = 0; i < 4; ++i) { a[i] = As[k][ty * 4 + i]; b[i] = Bs[k][tx * 4 + i]; }
#pragma unroll
            for (int i = 0; i < 4; ++i)
#pragma unroll
                for (int j = 0; j < 4; ++j) acc[i][j] += a[i] * b[j];
        }
        __syncthreads();
    }
#pragma unroll
    for (int i = 0; i < 4; ++i)
#pragma unroll
        for (int j = 0; j < 4; ++j) C[(size_t)(m0 + ty * 4 + i) * ldc + n0 + tx * 4 + j] = acc[i][j];
}

__device__ __forceinline__ int t5_bucket(int n) {
    if (n < 16) return n;
    float nf = (float)n;
    int large = 16 + (int)(logf(nf / 16.f) / 4.852030263919617f * 16.f);
    return large < 31 ? large : 31;
}

__global__ __launch_bounds__(256) void nv_attn(const float* proj, const float* rel_bias, float* attn) {
    int w = blockIdx.x * 4 + (threadIdx.x >> 6);
    int lane = threadIdx.x & 63;
    int h = w & 15, t = w >> 4;
    int b = t >> 11, ts = t & 2047;
    float q = proj[(size_t)t * DPROJ + h * 64 + lane];
    float m = -1e30f, l = 0.f, o = 0.f;
    for (int br = 0; br < 3; ++br) {
        int d = br == 0 ? 1 : (br == 1 ? 4 : 16);
        for (int j = 0; j <= 128; ++j) {
            int s = ts - j * d;
            if (s < 0) break;
            size_t row = (size_t)(b * SEQ + s) * DPROJ;
            float kv = proj[row + 1024 + h * 64 + lane];
            float vv = proj[row + 2048 + h * 64 + lane];
            float sc = wave_sum(q * kv) * 0.125f + rel_bias[t5_bucket(j * d) * 16 + h];
            float mn = fmaxf(m, sc);
            float scale = expf(m - mn), p = expf(sc - mn);
            l = l * scale + p; o = o * scale + p * vv; m = mn;
        }
    }
    attn[(size_t)t * 1024 + h * 64 + lane] = o / l;
}

__global__ __launch_bounds__(64) void nv_ssm(const float* proj, const float* lam_re, const float* lam_im, const float* log_dt,
                                             const float* b_re, const float* b_im, const float* c_re, const float* c_im, const float* d_skip, float* y) {
    __shared__ float xs[2][64];
    const int b = blockIdx.x >> 6, g = blockIdx.x & 63, n = threadIdx.x;
    const float dt = expf(log_dt[g]);
    const float lr = lam_re[g * 64 + n], li = lam_im[g * 64 + n];
    const float mag = expf(lr * dt);
    const float a_re = mag * cosf(li * dt), a_im = mag * sinf(li * dt);
    const float den = lr * lr + li * li;
    const float f_re = ((a_re - 1.f) * lr + a_im * li) / den;
    const float f_im = (a_im * lr - (a_re - 1.f) * li) / den;
    float bbr[16], bbi[16];
#pragma unroll
    for (int c = 0; c < 16; ++c) {
        float br = b_re[(g * 64 + n) * 16 + c], bi = b_im[(g * 64 + n) * 16 + c];
        bbr[c] = f_re * br - f_im * bi; bbi[c] = f_re * bi + f_im * br;
    }
    const int c = n & 15, qt = n >> 4;
    float cr[16], ci[16];
#pragma unroll
    for (int i = 0; i < 16; ++i) { cr[i] = c_re[(g * 16 + c) * 64 + qt * 16 + i]; ci[i] = c_im[(g * 16 + c) * 64 + qt * 16 + i]; }
    const float dsk = d_skip[g * 16 + c];
    float xr = 0.f, xi = 0.f;
    const float* up = proj + (size_t)(b * SEQ) * DPROJ + 3072 + g * 16;
    float4 u4[4];
#pragma unroll
    for (int i = 0; i < 4; ++i) u4[i] = *(const float4*)(up + i * 4);
    for (int t = 0; t < SEQ; ++t) {
        float u[16];
#pragma unroll
        for (int i = 0; i < 4; ++i) { u[4 * i] = u4[i].x; u[4 * i + 1] = u4[i].y; u[4 * i + 2] = u4[i].z; u[4 * i + 3] = u4[i].w; }
        if (t + 1 < SEQ) {
#pragma unroll
            for (int i = 0; i < 4; ++i) u4[i] = *(const float4*)(up + (size_t)(t + 1) * DPROJ + i * 4);
        }
        float bur = 0.f, bui = 0.f;
#pragma unroll
        for (int cc = 0; cc < 16; ++cc) { bur += bbr[cc] * u[cc]; bui += bbi[cc] * u[cc]; }
        float nr = a_re * xr - a_im * xi + bur;
        float ni = a_re * xi + a_im * xr + bui;
        xr = nr; xi = ni;
        __syncthreads();
        xs[0][n] = xr; xs[1][n] = xi;
        __syncthreads();
        float acc = 0.f;
#pragma unroll
        for (int i = 0; i < 16; ++i) acc += cr[i] * xs[0][qt * 16 + i] - ci[i] * xs[1][qt * 16 + i];
        acc += __shfl_xor(acc, 16);
        acc += __shfl_xor(acc, 32);
        float uc = 0.f;
#pragma unroll
        for (int cc = 0; cc < 16; ++cc) uc = (c == cc) ? u[cc] : uc;
        float yv = acc + dsk * uc;
        if (n < 16) y[(size_t)(b * SEQ + t) * 1024 + g * 16 + c] = gelu_exact(yv);
    }
}

__global__ void nv_glu(const float* y, const float* gate, const float* bias, float* out, int n) {
    int i = blockIdx.x * blockDim.x + threadIdx.x;
    if (i < n) { float gt = gate[i] + bias[i & 1023]; out[i] = y[i] / (1.f + expf(-gt)); }
}
__global__ void nv_add(const float* a, const float* b, float* o, int n) {
    int i = blockIdx.x * blockDim.x + threadIdx.x;
    if (i < n) o[i] = a[i] + b[i];
}

__global__ __launch_bounds__(128) void nv_peer_topk(const float* q, const float* keys1, const float* keys2, int* experts, float* gates) {
    __shared__ float s1[128], s2[128], v1[16], v2[16], cand[256], sc[16];
    __shared__ int i1[16], i2[16], ci[16];
    const int t = blockIdx.x >> 3, h = blockIdx.x & 7, k = threadIdx.x;
    const float* q1 = q + (size_t)t * 2048 + h * 256;
    const float* q2 = q1 + 128;
    const float* k1 = keys1 + (size_t)(h * 128 + k) * 128;
    const float* k2 = keys2 + (size_t)(h * 128 + k) * 128;
    float a = 0.f, bsum = 0.f;
    for (int d = 0; d < 128; ++d) { a += q1[d] * k1[d]; bsum += q2[d] * k2[d]; }
    s1[k] = a; s2[k] = bsum;
    __syncthreads();
    int r1 = 0, r2 = 0;
    for (int j = 0; j < 128; ++j) {
        float o1 = s1[j], o2 = s2[j];
        r1 += (o1 > a || (o1 == a && j < k)) ? 1 : 0;
        r2 += (o2 > bsum || (o2 == bsum && j < k)) ? 1 : 0;
    }
    if (r1 < 16) { v1[r1] = a; i1[r1] = k; }
    if (r2 < 16) { v2[r2] = bsum; i2[r2] = k; }
    __syncthreads();
    cand[k] = v1[k >> 4] + v2[k & 15];
    cand[k + 128] = v1[(k + 128) >> 4] + v2[k & 15];
    __syncthreads();
    for (int rep = 0; rep < 2; ++rep) {
        int idx = k + rep * 128; float cv = cand[idx]; int r = 0;
        for (int j = 0; j < 256; ++j) { float o = cand[j]; r += (o > cv || (o == cv && j < idx)) ? 1 : 0; }
        if (r < 16) { sc[r] = cv; ci[r] = idx; }
    }
    __syncthreads();
    if (k < 16) {
        float mx = sc[0], sum = 0.f;
        for (int j = 0; j < 16; ++j) sum += expf(sc[j] - mx);
        int c = ci[k];
        experts[(size_t)t * 128 + h * 16 + k] = i1[c >> 4] * 128 + i2[c & 15];
        gates[(size_t)t * 128 + h * 16 + k] = expf(sc[k] - mx) / sum;
    }
}

__global__ __launch_bounds__(256) void nv_peer_gather(const float* h2, const int* experts, const float* gates, const float* utab, const float* vtab,
                                                      const float* x1, float* out) {
    __shared__ float red[4];
    const int t = blockIdx.x;
    float hv[8], acc[8];
#pragma unroll
    for (int j = 0; j < 8; ++j) { hv[j] = h2[(size_t)t * DM + threadIdx.x + 256 * j]; acc[j] = 0.f; }
    for (int k = 0; k < 128; ++k) {
        const int e = experts[(size_t)t * 128 + k];
        const float gt = gates[(size_t)t * 128 + k];
        const float* ur = utab + (size_t)e * DM;
        const float* vr = vtab + (size_t)e * DM;
        float p = 0.f;
#pragma unroll
        for (int j = 0; j < 8; ++j) p += hv[j] * ur[threadIdx.x + 256 * j];
        float a = block_sum256(p, red);
        float w = gt * gelu_exact(a);
#pragma unroll
        for (int j = 0; j < 8; ++j) acc[j] += w * vr[threadIdx.x + 256 * j];
    }
#pragma unroll
    for (int j = 0; j < 8; ++j) out[(size_t)t * DM + threadIdx.x + 256 * j] = x1[(size_t)t * DM + threadIdx.x + 256 * j] + acc[j];
}

extern "C" void kernel_launch(void* const* d_in, const int* in_sizes, int n_in, void* d_out, int out_size, void* d_ws, size_t ws_size, hipStream_t stream) {
    const float* x = (const float*)d_in[0];
    const float* norm_mix_g = (const float*)d_in[1];
    const float* w_in = (const float*)d_in[2];
    const float* gq = (const float*)d_in[3];
    const float* gk = (const float*)d_in[4];
    const float* rel_bias = (const float*)d_in[5];
    const float* lam_re = (const float*)d_in[6];
    const float* lam_im = (const float*)d_in[7];
    const float* log_dt = (const float*)d_in[8];
    const float* b_re = (const float*)d_in[9];
    const float* b_im = (const float*)d_in[10];
    const float* c_re = (const float*)d_in[11];
    const float* c_im = (const float*)d_in[12];
    const float* d_skip = (const float*)d_in[13];
    const float* glu_w = (const float*)d_in[14];
    const float* glu_b = (const float*)d_in[15];
    const float* attn_g = (const float*)d_in[16];
    const float* ssm_g = (const float*)d_in[17];
    const float* w_out = (const float*)d_in[18];
    const float* ffn_g = (const float*)d_in[19];
    const float* w_q = (const float*)d_in[20];
    const float* keys1 = (const float*)d_in[21];
    const float* keys2 = (const float*)d_in[22];
    const float* utab = (const float*)d_in[23];
    const float* vtab = (const float*)d_in[24];
    float* out = (float*)d_out;

    char* ws = (char*)d_ws; size_t off = 0;
    auto alloc = [&](size_t bytes) { void* p = ws + off; off += (bytes + 255) & ~(size_t)255; return p; };
    float* h = (float*)alloc((size_t)NTOK * DM * 4);
    float* proj = (float*)alloc((size_t)NTOK * DPROJ * 4);
    float* attn = (float*)alloc((size_t)NTOK * 1024 * 4);
    float* ssmy = (float*)alloc((size_t)NTOK * 1024 * 4);
    float* gate = (float*)alloc((size_t)NTOK * 1024 * 4);
    float* ssmo = (float*)alloc((size_t)NTOK * 1024 * 4);
    float* tmp = (float*)alloc((size_t)NTOK * DM * 4);
    float* x1 = (float*)alloc((size_t)NTOK * DM * 4);
    int* experts = (int*)alloc((size_t)NTOK * 128 * 4);
    float* gates = (float*)alloc((size_t)NTOK * 128 * 4);

    nv_rmsnorm<<<NTOK, 256, 0, stream>>>(x, DM, norm_mix_g, h, DM, DM);
    nv_gemm<<<dim3(DPROJ / 64, NTOK / 64), 256, 0, stream>>>(h, DM, w_in, DPROJ, proj, DPROJ, DM);
    nv_qknorm<<<NTOK * 32 / 4, 256, 0, stream>>>(proj, gq, gk);
    nv_attn<<<NTOK * 16 / 4, 256, 0, stream>>>(proj, rel_bias, attn);
    nv_ssm<<<256, 64, 0, stream>>>(proj, lam_re, lam_im, log_dt, b_re, b_im, c_re, c_im, d_skip, ssmy);
    nv_gemm<<<dim3(1024 / 64, NTOK / 64), 256, 0, stream>>>(ssmy, 1024, glu_w, 1024, gate, 1024, 1024);
    nv_glu<<<NTOK * 1024 / 256, 256, 0, stream>>>(ssmy, gate, glu_b, ssmo, NTOK * 1024);
    float* mixed = h;
    nv_rmsnorm<<<NTOK, 256, 0, stream>>>(attn, 1024, attn_g, mixed, DM, 1024);
    nv_rmsnorm<<<NTOK, 256, 0, stream>>>(ssmo, 1024, ssm_g, mixed + 1024, DM, 1024);
    nv_gemm<<<dim3(DM / 64, NTOK / 64), 256, 0, stream>>>(mixed, DM, w_out, DM, tmp, DM, DM);
    nv_add<<<NTOK * DM / 256, 256, 0, stream>>>(x, tmp, x1, NTOK * DM);
    float* h2 = h;
    nv_rmsnorm<<<NTOK, 256, 0, stream>>>(x1, DM, ffn_g, h2, DM, DM);
    float* pq = proj;
    nv_gemm<<<dim3(DM / 64, NTOK / 64), 256, 0, stream>>>(h2, DM, w_q, DM, pq, DM, DM);
    nv_peer_topk<<<NTOK * 8, 128, 0, stream>>>(pq, keys1, keys2, experts, gates);
    nv_peer_gather<<<NTOK, 256, 0, stream>>>(h2, experts, gates, utab, vtab, x1, out);
}
```

```cpp
#include <hip/hip_runtime.h>
#include <stdint.h>
#include <stdio.h>

typedef unsigned short bf16_t;
typedef float f32x2 __attribute__((ext_vector_type(2)));
typedef unsigned u32x2 __attribute__((ext_vector_type(2)));
using bf16x2v = __attribute__((ext_vector_type(2))) __bf16;

constexpr int NTOK = 8192, SEQ = 2048, DM = 2048, DPROJ = 4096;
constexpr float EPS = 1e-6f;
constexpr float LOG2E = 1.4426950408889634f;

constexpr size_t MB = 1024 * 1024;
constexpr size_t WS_CTL = 0;
constexpr size_t CTL_BYTES = 128 * 1024;
constexpr size_t CTL_QCTR = 16384;
constexpr size_t CTL_RSS_ATTN = 32768, CTL_RSS_SSM = 65536, CTL_RSS_X1 = 98304;
constexpr size_t WS_HB = 256 * 1024;
constexpr size_t WS_WINT = WS_HB + 32 * MB;
constexpr size_t WS_GLUT = WS_WINT + 16 * MB;
constexpr size_t WS_WOUTT = WS_GLUT + 2 * MB;
constexpr size_t WS_WPT = WS_WOUTT + 8 * MB;
constexpr size_t WS_UB = WS_WPT + 8 * MB;
constexpr size_t WS_VB = WS_UB + 64 * MB;
constexpr size_t WS_PROJ = WS_VB + 64 * MB;
constexpr size_t WS_QN = WS_PROJ + 64 * MB;
constexpr size_t WS_KN = WS_QN + 16 * MB;
constexpr size_t WS_VT = WS_KN + 16 * MB;
constexpr size_t WS_YB = WS_VT + 48 * MB + 4096;
constexpr size_t WS_MIXED = WS_YB + 16 * MB;
constexpr size_t WS_SSMP = WS_MIXED + 32 * MB;
constexpr size_t SSMP_ABAR = 0, SSMP_A256 = 32768, SSMP_BFRAG = 65536, SSMP_CFRAG = 65536 + 524288;
constexpr size_t WS_BTAB = WS_SSMP + 1 * MB;
constexpr size_t WS_END = WS_BTAB + 64 * 1024;

constexpr int LDS_BYTES = 147456;
constexpr int MISC_OFF = 147456 - 256;
#define MK_PER_PHASE 1
#define XB_TMO      128
#define XB_XCNT(j)  (256  + 64 * (j))
#define XB_XSUB(j)  (1280 + 64 * (j))
#define XB_XGEN(j)  (2304 + 64 * (j))
#define XB_TOP      3328
#define XB_TOPGEN   3392
#define XCD_BAR_WORDS 3456
#define XB_SPIN_CAP (1u << 18)
#define LAS __attribute__((address_space(3)))

__device__ __forceinline__ unsigned xb_ld(unsigned* p)              { return __hip_atomic_load(p, __ATOMIC_RELAXED, __HIP_MEMORY_SCOPE_AGENT); }
__device__ __forceinline__ unsigned xb_add(unsigned* p, unsigned v) { return __hip_atomic_fetch_add(p, v, __ATOMIC_RELAXED, __HIP_MEMORY_SCOPE_AGENT); }
__device__ __forceinline__ unsigned xb_xcc_id() { return (unsigned)__builtin_amdgcn_s_getreg((3 << 11) | 20) & 0xFu; }
#define XB_SPIN(cond, bar) do { unsigned _sp = 0; while (cond) { __builtin_amdgcn_s_sleep(1); \
    if ((++_sp & 255u) == 0u) { if (xb_ld(&(bar)[XB_TMO])) break; if (_sp > XB_SPIN_CAP) { atomicAdd(&(bar)[XB_TMO], 1u); break; } } } } while (0)

struct XcdBarrier {
    unsigned* bar; unsigned x;
    volatile LAS unsigned* st;
};

__device__ __forceinline__ XcdBarrier xcd_barrier_post(unsigned* bar, volatile LAS unsigned* st) {
    XcdBarrier b; b.bar = bar; b.x = xb_xcc_id(); b.st = st;
    if (threadIdx.x == 0) (void)xb_add(&bar[XB_XCNT(b.x)], 1u);
    return b;
}
__device__ __forceinline__ void xcd_barrier_complete(unsigned* bar, unsigned x, unsigned& nloc, unsigned& nx) {
    const unsigned G = gridDim.x * gridDim.y * gridDim.z;
    unsigned sum, cnt, mine, sp = 0u;
    for (;;) {
        sum = 0u; cnt = 0u; mine = 0u;
#pragma unroll
        for (unsigned j = 0; j < 16; ++j) { const unsigned c = xb_ld(&bar[XB_XCNT(j)]); sum += c; cnt += (c > 0u) ? 1u : 0u; mine = (j == x) ? c : mine; }
        if (sum == G) break;
        __builtin_amdgcn_s_sleep(1);
        if ((++sp & 255u) == 0u) { if (xb_ld(&bar[XB_TMO])) break; if (sp > XB_SPIN_CAP) { atomicAdd(&bar[XB_TMO], 1u); break; } }
    }
    nloc = mine > 0u ? mine : 1u; nx = cnt > 0u ? cnt : 1u;
}

__device__ __forceinline__ void xcd_barrier(const XcdBarrier& b) {
    asm volatile("s_waitcnt vmcnt(0)" ::: "memory");
    __syncthreads();
    if (threadIdx.x == 0) {
        unsigned* bar = b.bar;
        __builtin_amdgcn_s_waitcnt(0);
        unsigned nloc = b.st[0], nx = b.st[1];
        if (nloc == 0u) { xcd_barrier_complete(bar, b.x, nloc, nx); b.st[0] = nloc; b.st[1] = nx; }
        const unsigned old = xb_add(&bar[XB_XSUB(b.x)], 1u);
        const unsigned gen = old / nloc;
        if (old + 1u == (gen + 1u) * nloc) {
            __builtin_amdgcn_fence(__ATOMIC_RELEASE, "agent");
            asm volatile("s_waitcnt vmcnt(0)" ::: "memory");
            const unsigned og = xb_add(&bar[XB_TOP], 1u);
            const unsigned tg = og / nx;
            if (og + 1u == (tg + 1u) * nx) xb_add(&bar[XB_TOPGEN], 1u);
            else XB_SPIN(xb_ld(&bar[XB_TOPGEN]) == tg, bar);
            __builtin_amdgcn_fence(__ATOMIC_ACQUIRE, "agent");
            xb_add(&bar[XB_XGEN(b.x)], 1u);
            asm volatile("s_waitcnt vmcnt(0)" ::: "memory");
        } else {
            XB_SPIN(xb_ld(&bar[XB_XGEN(b.x)]) == gen, bar);
            __builtin_amdgcn_fence(__ATOMIC_ACQUIRE, "agent");
            asm volatile("s_waitcnt vmcnt(0)" ::: "memory");
        }
    }
    __syncthreads();
}
namespace pg8 {
#define PG8_LAS __attribute__((address_space(3)))
typedef unsigned short bf16_t;
typedef short bf16x8 __attribute__((ext_vector_type(8)));
typedef float f32x4 __attribute__((ext_vector_type(4)));
typedef unsigned u32x4 __attribute__((ext_vector_type(4)));
constexpr int BM = 256, BK = 64, HALF = 128, HTB = HALF * BK * 2  , STAGE_BYTES = 8 * HTB, NXCD = 8, WGM = 8;

__host__ __device__ __forceinline__ int lds_byte(int r, int c) { const int st = (r >> 4) * 2 + (c >> 5), rr = r & 15, cc = c & 31, ob = rr * 64 + cc * 2; return st * 1024 + (ob ^ (((ob >> 9) & 1) << 5)); }
__host__ __device__ __forceinline__ void stage_rc(int b, int& R, int& C) { const int st = b / 1024, sb = b % 1024, swz = sb ^ (((sb >> 9) & 1) << 5); R = (st >> 1) * 16 + swz / 64; C = (st & 1) * 32 + (swz % 64) / 2; }
__host__ __device__ __forceinline__ int perm32(int rho) { const int n = rho >> 4, i = rho & 15; return 8 * (i >> 2) + 4 * n + (i & 3); }

struct Unit { int pm, pn; };
struct Gemm { const bf16_t* A; const bf16_t* Bt; int M, N, K; };

struct StaticOrder {
    int nM, nN, nwg, G, c;
    __host__ __device__ void init(int M, int N, int G_, int c_) { nM = M / BM; nN = N / BM; nwg = nM * nN; G = G_; c = c_; }
    __host__ __device__ bool next(int i, Unit& u) const {
        const long L = (long)i * G + c; if (L >= nwg) return false;
        int wgid = (int)L; { const int q = nwg / NXCD, r = nwg % NXCD, xcd = wgid % NXCD, off = wgid / NXCD; wgid = (xcd < r ? xcd * (q + 1) : r * (q + 1) + (xcd - r) * q) + off; }
        const int nig = WGM * nN, gid = wgid / nig, fm = gid * WGM, gsz = (nM - fm) < WGM ? (nM - fm) : WGM;
        u.pm = fm + ((wgid % nig) % gsz); u.pn = (wgid % nig) / gsz; return true;
    }
    __device__ __forceinline__ void a_ready(const Unit&) const {}
    __device__ __forceinline__ void done(const Unit&) const {}
};
typedef float cvt_f32x2 __attribute__((ext_vector_type(2)));
typedef __bf16 cvt_bf16x2 __attribute__((ext_vector_type(2)));
__device__ __forceinline__ unsigned cvt_pk_bf16(float lo, float hi) { return __builtin_bit_cast(unsigned, __builtin_convertvector((cvt_f32x2){lo, hi}, cvt_bf16x2)); }
__device__ __forceinline__ float bflo(unsigned u) { return __uint_as_float(u << 16); }
__device__ __forceinline__ float bfhi(unsigned u) { return __uint_as_float(u & 0xffff0000u); }

struct EpiProj {
    static constexpr bool PERM = true, AFTER_DRAIN = false, HAS_MID = false;
    bf16_t* O; int ldc;
    __device__ __forceinline__ void mid(f32x4 (&)[2][2][4][2], const Unit&, int, int, int, int) const {}
    __device__ __forceinline__ void operator()(const f32x4 (&acc)[2][2][4][2], const Unit& u, int wr, int wc, int fr, int fq) const {
        const int row0 = u.pm * BM + wr * 64 + fr, col0 = u.pn * BM + wc * 32 + 8 * fq;
#pragma unroll
        for (int ai = 0; ai < 2; ++ai)
#pragma unroll
            for (int m = 0; m < 4; ++m) { bf16_t* rowp = O + (size_t)(row0 + ai * HALF + m * 16) * ldc + col0;
#pragma unroll
                for (int bj = 0; bj < 2; ++bj) { const f32x4 v0 = acc[ai][bj][m][0], v1 = acc[ai][bj][m][1];
                    u32x4 w; w.x = cvt_pk_bf16(v0[0], v0[1]); w.y = cvt_pk_bf16(v0[2], v0[3]); w.z = cvt_pk_bf16(v1[0], v1[1]); w.w = cvt_pk_bf16(v1[2], v1[3]);
                    *(u32x4*)(rowp + bj * HALF) = w; } }
    }
};

struct EpiGlu {
    static constexpr bool PERM = true, AFTER_DRAIN = false, HAS_MID = false;
    const bf16_t* Y; bf16_t* O; const float* bias; float* rss;
    __device__ __forceinline__ void mid(f32x4 (&)[2][2][4][2], const Unit&, int, int, int, int) const {}
    __device__ __forceinline__ void operator()(const f32x4 (&acc)[2][2][4][2], const Unit& u, int wr, int wc, int fr, int fq) const {
        const int row0 = u.pm * BM + wr * 64 + fr, col0 = u.pn * BM + wc * 32 + 8 * fq;
        f32x4 bv[2][2];
#pragma unroll
        for (int bj = 0; bj < 2; ++bj)
#pragma unroll
            for (int n = 0; n < 2; ++n) bv[bj][n] = *(const f32x4*)(bias + col0 + bj * HALF + 4 * n);
#pragma unroll
        for (int ai = 0; ai < 2; ++ai)
#pragma unroll
            for (int m = 0; m < 4; ++m) { const int row = row0 + ai * HALF + m * 16; float ss = 0.f;
#pragma unroll
                for (int bj = 0; bj < 2; ++bj) {
                    const u32x4 yv = *(const u32x4*)(Y + (size_t)row * 1024 + col0 + bj * HALF);
                    const f32x4 g0 = acc[ai][bj][m][0] + bv[bj][0], g1 = acc[ai][bj][m][1] + bv[bj][1];
                    float y[8] = {bflo(yv.x), bfhi(yv.x), bflo(yv.y), bfhi(yv.y), bflo(yv.z), bfhi(yv.z), bflo(yv.w), bfhi(yv.w)};
                    float o[8];
#pragma unroll
                    for (int e = 0; e < 4; ++e) { o[e] = y[e] * __builtin_amdgcn_rcpf(1.f + __expf(-g0[e])); o[4 + e] = y[4 + e] * __builtin_amdgcn_rcpf(1.f + __expf(-g1[e])); }
#pragma unroll
                    for (int e = 0; e < 8; ++e) ss += o[e] * o[e];
                    u32x4 w; w.x = cvt_pk_bf16(o[0], o[1]); w.y = cvt_pk_bf16(o[2], o[3]); w.z = cvt_pk_bf16(o[4], o[5]); w.w = cvt_pk_bf16(o[6], o[7]);
                    *(u32x4*)(O + (size_t)row * 2048 + col0 + bj * HALF) = w; }
                ss += __shfl_xor(ss, 16); ss += __shfl_xor(ss, 32);
                if (fq == 0) unsafeAtomicAdd(rss + row, ss); }
    }
};

struct EpiWout {
    static constexpr bool PERM = true, AFTER_DRAIN = false, HAS_MID = true;
    const float* X; float* OUT; bf16_t* XB; float* rss_x; const PG8_LAS float* tab;
    __device__ __forceinline__ void mid(f32x4 (&acc)[2][2][4][2], const Unit& u, int wr, int wc, int fr, int fq) const {
        const PG8_LAS float* tp = tab + wr * 64 + fr;
#pragma unroll
        for (int ai = 0; ai < 2; ++ai)
#pragma unroll
            for (int m = 0; m < 4; ++m) { const float ratio = tp[ai * HALF + m * 16];
#pragma unroll
                for (int bj = 0; bj < 2; ++bj)
#pragma unroll
                    for (int n = 0; n < 2; ++n) acc[ai][bj][m][n] *= ratio; }
    }
    __device__ __forceinline__ void operator()(const f32x4 (&acc)[2][2][4][2], const Unit& u, int wr, int wc, int fr, int fq) const {
        const int row0 = u.pm * BM + wr * 64 + fr, col0 = u.pn * BM + wc * 32 + 8 * fq;
        const PG8_LAS float* tp = tab + 256 + wr * 64 + fr;
#pragma unroll
        for (int ai = 0; ai < 2; ++ai)
#pragma unroll
            for (int m = 0; m < 4; ++m) { const int row = row0 + ai * HALF + m * 16; float ss = 0.f;
                const float rs = tp[ai * HALF + m * 16];
#pragma unroll
                for (int bj = 0; bj < 2; ++bj) { const size_t o = (size_t)row * 2048 + col0 + bj * HALF;
                    const f32x4 x0 = *(const f32x4*)(X + o), x1 = *(const f32x4*)(X + o + 4);
                    const f32x4 v0 = x0 + rs * acc[ai][bj][m][0], v1 = x1 + rs * acc[ai][bj][m][1];
                    *(f32x4*)(OUT + o) = v0; *(f32x4*)(OUT + o + 4) = v1;
                    u32x4 w; w.x = cvt_pk_bf16(v0[0], v0[1]); w.y = cvt_pk_bf16(v0[2], v0[3]); w.z = cvt_pk_bf16(v1[0], v1[1]); w.w = cvt_pk_bf16(v1[2], v1[3]);
                    *(u32x4*)(XB + o) = w;
#pragma unroll
                    for (int e = 0; e < 4; ++e) ss += v0[e] * v0[e] + v1[e] * v1[e]; }
                ss += __shfl_xor(ss, 16); ss += __shfl_xor(ss, 32);
                if (fq == 0) unsafeAtomicAdd(rss_x + row, ss); }
    }
};

struct EpiScores {
    static constexpr bool PERM = false, AFTER_DRAIN = false, HAS_MID = false;
    float* C; const float* rss_x;
    __device__ __forceinline__ void mid(f32x4 (&)[2][2][4][2], const Unit&, int, int, int, int) const {}
    __device__ __forceinline__ void operator()(const f32x4 (&acc)[2][2][4][2], const Unit& u, int wr, int wc, int fr, int fq) const {
        const int row0 = u.pm * BM + wr * 64 + fr, col0 = u.pn * BM + wc * 32 + 4 * fq;
#pragma unroll
        for (int ai = 0; ai < 2; ++ai)
#pragma unroll
            for (int m = 0; m < 4; ++m) { const int row = row0 + ai * HALF + m * 16;
                const float r2 = __builtin_amdgcn_rsqf(rss_x[row] * (1.f / 2048.f) + 1e-6f);
                float* rowp = C + (size_t)row * 2048 + col0;
#pragma unroll
                for (int bj = 0; bj < 2; ++bj)
#pragma unroll
                    for (int n = 0; n < 2; ++n) *(f32x4*)(rowp + bj * HALF + n * 16) = acc[ai][bj][m][n] * r2; }
    }
};

template <class Epi, class Sched, bool STAMP = false>
__device__ __forceinline__ void gemm_phase(PG8_LAS unsigned char* lds, const Gemm g, const Sched& S, const Epi& E, unsigned long long* stamps) {
    const int tid = threadIdx.x, wid = __builtin_amdgcn_readfirstlane(tid >> 6), lane = tid & 63, wr = wid >> 2, wc = wid & 3, fr = lane & 15, fq = lane >> 4;
    const int K = g.K, nt = K / BK;
    int ts_lo = 0, ts_hi = 0, nts = 0; const unsigned long long rt_entry = STAMP ? (unsigned long long)wall_clock64() : 0ull;
#define PG8_STAMP() do { if (STAMP && wid == 0 && nts < 64) { const unsigned long long _c = (unsigned long long)clock64(); \
        ts_lo = (lane == nts) ? (int)(unsigned)_c : ts_lo; ts_hi = (lane == nts) ? (int)(unsigned)(_c >> 32) : ts_hi; ++nts; } } while (0)
    PG8_STAMP();
    unsigned voffA[2], voffB[2];
#pragma unroll
    for (int i = 0; i < 2; ++i) { int R, C; stage_rc(tid * 16 + i * 8192, R, C); const int Rb = Epi::PERM ? ((R & ~31) + perm32(R & 31)) : R;
        voffA[i] = (unsigned)(R * K + C) * 2u; voffB[i] = (unsigned)(Rb * K + C) * 2u; }
    const size_t kstep = (size_t)(BK * 2);
    const size_t hstep = (size_t)HALF * K * 2;
    const size_t tstep = 2 * hstep;
    const unsigned ldsw = (unsigned)wid * 1024u;
    const int aoff = lds_byte(wr * 64 + fr, fq * 8), boff = lds_byte(wc * 32 + fr, fq * 8);
#define PG8_SA(b, h) (((b) * 2 + (h)) * HTB)
#define PG8_SB(b, h) ((4 + (b) * 2 + (h)) * HTB)
#define PG8_STAGE(bufoff, gbase, voff) do { _Pragma("unroll") for (int _i = 0; _i < 2; ++_i) \
        __builtin_amdgcn_global_load_lds((const unsigned*)((const char*)(gbase) + (voff)[_i]), (PG8_LAS unsigned*)(lds + (bufoff) + ldsw + _i * 8192), 16, 0, 0); } while (0)
#define PG8_LDA(dst, b, h) do { _Pragma("unroll") for (int m = 0; m < 4; ++m) _Pragma("unroll") for (int k = 0; k < 2; ++k) dst[m][k] = *(const PG8_LAS bf16x8*)(lds + PG8_SA(b, h) + aoff + m * 2048 + k * 1024); } while (0)
#define PG8_LDB(dst, b, h) do { _Pragma("unroll") for (int n = 0; n < 2; ++n) _Pragma("unroll") for (int k = 0; k < 2; ++k) dst[n][k] = *(const PG8_LAS bf16x8*)(lds + PG8_SB(b, h) + boff + n * 2048 + k * 1024); } while (0)
#define PG8_MMA(ai, bj, At, Bt) do { __builtin_amdgcn_s_setprio(1); _Pragma("unroll") for (int m = 0; m < 4; ++m) _Pragma("unroll") for (int n = 0; n < 2; ++n) _Pragma("unroll") for (int k = 0; k < 2; ++k) \
        acc[ai][bj][m][n] = __builtin_amdgcn_mfma_f32_16x16x32_bf16(Bt[n][k], At[m][k], acc[ai][bj][m][n], 0, 0, 0); __builtin_amdgcn_s_setprio(0); } while (0)
#define PG8_WAIT_V(n) asm volatile("s_waitcnt vmcnt(" #n ")" ::: "memory")
#define PG8_WAIT_L(n) asm volatile("s_waitcnt lgkmcnt(" #n ")" ::: "memory")
#define PG8_BAR __builtin_amdgcn_s_barrier()
#define PG8_SCHED __builtin_amdgcn_sched_barrier(0)
    Unit cur, nxt; int ui = 0;
    if (!S.next(0, cur)) return;
    f32x4 acc[2][2][4][2];
#pragma unroll
    for (int a = 0; a < 2; ++a)
#pragma unroll
        for (int b = 0; b < 2; ++b)
#pragma unroll
            for (int m = 0; m < 4; ++m)
#pragma unroll
                for (int n = 0; n < 2; ++n) acc[a][b][m][n] = (f32x4){0.f, 0.f, 0.f, 0.f};
    bf16x8 At[4][2], B0[2][2], B1[2][2];
    const char* cA = (const char*)g.A + (size_t)cur.pm * tstep; const char* cB = (const char*)g.Bt + (size_t)cur.pn * tstep;
    S.a_ready(cur);
    PG8_STAGE(PG8_SB(0, 0), cB, voffB); PG8_STAGE(PG8_SA(0, 0), cA, voffA); PG8_STAGE(PG8_SB(0, 1), cB + hstep, voffB); PG8_STAGE(PG8_SA(0, 1), cA + hstep, voffA);
    if (wr == 1) PG8_BAR;
    PG8_WAIT_V(4); PG8_BAR;
    PG8_STAGE(PG8_SB(1, 0), cB + kstep, voffB); PG8_STAGE(PG8_SA(1, 0), cA + kstep, voffA); PG8_STAGE(PG8_SB(1, 1), cB + hstep + kstep, voffB);
    PG8_WAIT_V(6); PG8_BAR;
    PG8_STAMP();
    for (;;) {
        const bool has_next = S.next(ui + 1, nxt);
        const char* nA = has_next ? (const char*)g.A + (size_t)nxt.pm * tstep : cA; const char* nB = has_next ? (const char*)g.Bt + (size_t)nxt.pn * tstep : cB;
        for (int t = 0; t < nt; t += 2) {
            const bool last = (t == nt - 2);
            const char* a1 = cA + (size_t)(t + 1) * kstep;
            const char* a2 = last ? nA : cA + (size_t)(t + 2) * kstep; const char* b2 = last ? nB : cB + (size_t)(t + 2) * kstep;
            const char* a3 = a2 + kstep; const char* b3 = b2 + kstep;
            if (last && has_next) S.a_ready(nxt);
            if constexpr (Epi::HAS_MID) { if (t == (nt >> 1)) { E.mid(acc, cur, wr, wc, fr, fq); asm volatile("s_waitcnt lgkmcnt(0)" ::: "memory"); } }
            PG8_LDB(B0, 0, 0); PG8_SCHED; PG8_LDA(At, 0, 0); PG8_STAGE(PG8_SA(1, 1), a1 + hstep, voffA);
            PG8_WAIT_L(8); PG8_BAR; PG8_WAIT_L(0); PG8_MMA(0, 0, At, B0); PG8_BAR; PG8_SCHED;
            PG8_LDB(B1, 0, 1); PG8_STAGE(PG8_SB(0, 0), b2, voffB);
            PG8_BAR; PG8_WAIT_L(0); PG8_MMA(0, 1, At, B1); PG8_BAR;
            PG8_LDA(At, 0, 1); PG8_STAGE(PG8_SA(0, 0), a2, voffA);
            PG8_BAR; PG8_WAIT_L(0); PG8_MMA(1, 0, At, B0); PG8_BAR; PG8_SCHED;
            PG8_STAGE(PG8_SB(0, 1), b2 + hstep, voffB);
            PG8_WAIT_V(6); PG8_BAR; PG8_MMA(1, 1, At, B1); PG8_BAR;
            PG8_LDB(B0, 1, 0); PG8_SCHED; PG8_LDA(At, 1, 0); PG8_STAGE(PG8_SA(0, 1), a2 + hstep, voffA);
            PG8_WAIT_L(8); PG8_BAR; PG8_WAIT_L(0); PG8_MMA(0, 0, At, B0); PG8_BAR; PG8_SCHED;
            PG8_LDB(B1, 1, 1); PG8_STAGE(PG8_SB(1, 0), b3, voffB);
            PG8_BAR; PG8_WAIT_L(0); PG8_MMA(0, 1, At, B1); PG8_BAR;
            PG8_LDA(At, 1, 1); PG8_STAGE(PG8_SA(1, 0), a3, voffA);
            PG8_BAR; PG8_WAIT_L(0); PG8_MMA(1, 0, At, B0); PG8_BAR; PG8_SCHED;
            PG8_STAGE(PG8_SB(1, 1), b3 + hstep, voffB);
            PG8_WAIT_V(6); PG8_BAR; PG8_MMA(1, 1, At, B1); PG8_BAR;
        }
        PG8_STAMP();
        if constexpr (!Epi::AFTER_DRAIN) { E(acc, cur, wr, wc, fr, fq); S.done(cur); }
        PG8_STAMP();
        if (!has_next) break;
#pragma unroll
        for (int a = 0; a < 2; ++a)
#pragma unroll
            for (int b = 0; b < 2; ++b)
#pragma unroll
                for (int m = 0; m < 4; ++m)
#pragma unroll
                    for (int n = 0; n < 2; ++n) acc[a][b][m][n] = (f32x4){0.f, 0.f, 0.f, 0.f};
        cur = nxt; cA = nA; cB = nB; ++ui;
    }
    PG8_WAIT_V(0);
    if (wr == 0) PG8_BAR;
    PG8_BAR;
    if constexpr (Epi::AFTER_DRAIN) { E.fused(acc, cur, wr, wc, fr, fq, lds, wid, lane); S.done(cur); }
    PG8_STAMP();
    if (STAMP && wid == 0) { stamps[lane] = lane < nts ? (((unsigned long long)(unsigned)ts_hi << 32) | (unsigned)ts_lo) : 0ull;
        if (lane == 62) stamps[62] = rt_entry; if (lane == 63) stamps[63] = (unsigned long long)wall_clock64(); }
#undef PG8_STAMP
#undef PG8_SA
#undef PG8_SB
#undef PG8_STAGE
#undef PG8_LDA
#undef PG8_LDB
#undef PG8_MMA
#undef PG8_WAIT_V
#undef PG8_WAIT_L
#undef PG8_BAR
#undef PG8_SCHED
}
}

typedef short bf16x8 __attribute__((ext_vector_type(8)));
typedef float f32x4 __attribute__((ext_vector_type(4)));
typedef unsigned u32x4 __attribute__((ext_vector_type(4)));
using pg8::cvt_pk_bf16; using pg8::bflo; using pg8::bfhi;

#define LDS_WAIT() asm volatile("s_waitcnt lgkmcnt(0)" ::: "memory")
#define CBAR() asm volatile("" ::: "memory")
#define MFMA16(a, b, c) __builtin_amdgcn_mfma_f32_16x16x32_bf16((a), (b), (c), 0, 0, 0)

struct Args { const float* in[25]; float* out; unsigned char* ws; int ph_lo, ph_hi; };

__device__ __forceinline__ float wave_sum(float v) {
#pragma unroll
    for (int o = 1; o < 64; o <<= 1) v += __shfl_xor(v, o);
    return v;
}
__device__ __forceinline__ float wave_max(float v) {
#pragma unroll
    for (int o = 1; o < 64; o <<= 1) v = fmaxf(v, __shfl_xor(v, o));
    return v;
}
__device__ __forceinline__ float gelu_erf(float x) { return 0.5f * x * (1.0f + erff(x * 0.70710678118654752f)); }
__device__ __forceinline__ bf16x8 as_bf16x8(u32x4 v) { return __builtin_bit_cast(bf16x8, v); }

__device__ __forceinline__ void p0_transpose_item(const float* W, int K, int N, bf16_t* WT, const float* sc_a, const float* sc_b, LAS float* scr, int item, int lane) {
    const int nblk = N / 32, kb = item / nblk, nb = item % nblk, k0 = 64 * kb, n0 = 32 * nb;
#pragma unroll 8
    for (int i = 0; i < 32; ++i) { const int kk = 2 * i + (lane >> 5); const int k = k0 + kk;
        const float s = sc_a ? (k < 1024 ? sc_a[k] : sc_b[k - 1024]) : 1.f;
        scr[kk * 33 + (lane & 31)] = W[(size_t)k * N + n0 + (lane & 31)] * s; }
    LDS_WAIT();
    const int c = lane & 7;
#pragma unroll
    for (int j = 0; j < 4; ++j) { const int n = (lane >> 3) + 8 * j; const LAS float* s = scr + (8 * c) * 33 + n;
        u32x4 o; o.x = cvt_pk_bf16(s[0 * 33], s[1 * 33]); o.y = cvt_pk_bf16(s[2 * 33], s[3 * 33]); o.z = cvt_pk_bf16(s[4 * 33], s[5 * 33]); o.w = cvt_pk_bf16(s[6 * 33], s[7 * 33]);
        *(u32x4*)(WT + (size_t)(n0 + n) * K + k0 + 8 * c) = o; }
    LDS_WAIT();
}
template <int MODE> __device__ __forceinline__ void p0_row(const float* xrow, const float* g, bf16_t* orow, int lane) {
    const f32x4* xr = (const f32x4*)xrow + lane; const f32x4* gr = (const f32x4*)g + lane;
    f32x4 v[8]; float s = 0.f;
#pragma unroll
    for (int j = 0; j < 8; ++j) { v[j] = xr[64 * j]; s += (v[j].x * v[j].x + v[j].y * v[j].y) + (v[j].z * v[j].z + v[j].w * v[j].w); }
    float r = 1.f;
    if (MODE == 0) r = 1.0f / sqrtf(wave_sum(s) * (1.f / 2048.f) + EPS);
    u32x2* o8 = (u32x2*)orow + lane;
#pragma unroll
    for (int j = 0; j < 8; ++j) { f32x4 w = v[j] * r; if (MODE != 2) w = w * gr[64 * j];
        u32x2 o; o.x = cvt_pk_bf16(w.x, w.y); o.y = cvt_pk_bf16(w.z, w.w); o8[64 * j] = o; }
}
__device__ __forceinline__ void p0_wp_item(const float* wq, const float* keys1, const float* keys2, const float* gffn, bf16_t* WPT, int item, int lane) {
    const int hj = item >> 7, ib = item & 127, h = hj >> 1, j = hj & 1, i0 = 16 * ib, col0 = h * 256 + j * 128;
    const int lr = lane & 15, g = lane >> 4;
    const float* keys = (j ? keys2 : keys1) + (size_t)h * 128 * 128;
    const float gi = gffn[i0 + lr];
    bf16x8 af[4];
#pragma unroll
    for (int s = 0; s < 4; ++s) { const float* p = wq + (size_t)(i0 + lr) * 2048 + col0 + 32 * s + 8 * g;
        const f32x4 a = *(const f32x4*)p * gi, b = *(const f32x4*)(p + 4) * gi;
        u32x4 w; w.x = cvt_pk_bf16(a.x, a.y); w.y = cvt_pk_bf16(a.z, a.w); w.z = cvt_pk_bf16(b.x, b.y); w.w = cvt_pk_bf16(b.z, b.w); af[s] = as_bf16x8(w); }
    for (int kt = 0; kt < 8; ++kt) {
        f32x4 d = {0.f, 0.f, 0.f, 0.f};
#pragma unroll
        for (int s = 0; s < 4; ++s) { const float* p = keys + (size_t)(16 * kt + lr) * 128 + 32 * s + 8 * g;
            const f32x4 a = *(const f32x4*)p, b = *(const f32x4*)(p + 4);
            u32x4 w; w.x = cvt_pk_bf16(a.x, a.y); w.y = cvt_pk_bf16(a.z, a.w); w.z = cvt_pk_bf16(b.x, b.y); w.w = cvt_pk_bf16(b.z, b.w);
            d = MFMA16(af[s], as_bf16x8(w), d); }
        u32x2 o; o.x = cvt_pk_bf16(d[0], d[1]); o.y = cvt_pk_bf16(d[2], d[3]);
        *(u32x2*)(WPT + (size_t)(hj * 128 + 16 * kt + lr) * 2048 + i0 + 4 * g) = o;
    }
}
__device__ __forceinline__ int t5_bucket(int n) {
    if (n < 16) return n;
    const int large = 16 + (int)(logf((float)n / 16.f) / 4.852030263919617f * 16.f);
    return large < 31 ? large : 31;
}
__device__ __forceinline__ void p0_ssm_item(const Args& A, unsigned char* sp, int g, int lane) {
    const float* lam_re = A.in[6]; const float* lam_im = A.in[7]; const float* log_dt = A.in[8];
    const float* b_re = A.in[9]; const float* b_im = A.in[10]; const float* c_re = A.in[11]; const float* c_im = A.in[12];
    const int n = lane;
    const float dt = expf(log_dt[g]);
    const float lr = lam_re[g * 64 + n], li = lam_im[g * 64 + n];
    const float mag = expf(lr * dt);
    const float a_re = mag * cosf(li * dt), a_im = mag * sinf(li * dt);
    const float den = lr * lr + li * li;
    const float f_re = ((a_re - 1.f) * lr + a_im * li) / den, f_im = (a_im * lr - (a_re - 1.f) * li) / den;
    ((f32x2*)(sp + SSMP_ABAR))[g * 64 + n] = (f32x2){a_re, a_im};
    float pr = a_re, pi = a_im;
#pragma unroll
    for (int i = 0; i < 8; ++i) { const float nr = pr * pr - pi * pi, ni = 2.f * pr * pi; pr = nr; pi = ni; }
    ((f32x2*)(sp + SSMP_A256))[g * 64 + n] = (f32x2){pr, pi};
    float bbr[16], bbi[16];
#pragma unroll
    for (int q = 0; q < 4; ++q) { const f32x4 br = *(const f32x4*)(b_re + (size_t)(g * 64 + n) * 16 + 4 * q), bi = *(const f32x4*)(b_im + (size_t)(g * 64 + n) * 16 + 4 * q);
#pragma unroll
        for (int e = 0; e < 4; ++e) { bbr[4 * q + e] = f_re * br[e] - f_im * bi[e]; bbi[4 * q + e] = f_re * bi[e] + f_im * br[e]; } }
    bf16_t* bf = (bf16_t*)(sp + SSMP_BFRAG);
    const int jre = n >> 4, n16 = n & 15;
#pragma unroll
    for (int kg = 0; kg < 4; ++kg) {
        u32x4 wr = {0u, 0u, 0u, 0u}, wi = {0u, 0u, 0u, 0u};
        if (kg < 2) { const int c0 = (kg & 1) * 8;
            wr.x = cvt_pk_bf16(bbr[c0 + 0], bbr[c0 + 1]); wr.y = cvt_pk_bf16(bbr[c0 + 2], bbr[c0 + 3]); wr.z = cvt_pk_bf16(bbr[c0 + 4], bbr[c0 + 5]); wr.w = cvt_pk_bf16(bbr[c0 + 6], bbr[c0 + 7]);
            wi.x = cvt_pk_bf16(bbi[c0 + 0], bbi[c0 + 1]); wi.y = cvt_pk_bf16(bbi[c0 + 2], bbi[c0 + 3]); wi.z = cvt_pk_bf16(bbi[c0 + 4], bbi[c0 + 5]); wi.w = cvt_pk_bf16(bbi[c0 + 6], bbi[c0 + 7]); }
        *(u32x4*)(bf + ((size_t)(g * 8 + jre) * 64 + kg * 16 + n16) * 8) = wr;
        *(u32x4*)(bf + ((size_t)(g * 8 + 4 + jre) * 64 + kg * 16 + n16) * 8) = wi;
    }
    bf16_t* cf = (bf16_t*)(sp + SSMP_CFRAG);
    const int ch = lane & 15, kg = lane >> 4;
#pragma unroll
    for (int s = 0; s < 4; ++s) { const int k0 = 32 * s + 8 * kg;
        const float* src = (k0 < 64) ? (c_re + (size_t)(g * 16 + ch) * 64 + k0) : (c_im + (size_t)(g * 16 + ch) * 64 + (k0 - 64));
        const float sg = (k0 < 64) ? 1.f : -1.f;
        const f32x4 a = *(const f32x4*)src * sg, b = *(const f32x4*)(src + 4) * sg;
        u32x4 w; w.x = cvt_pk_bf16(a.x, a.y); w.y = cvt_pk_bf16(a.z, a.w); w.z = cvt_pk_bf16(b.x, b.y); w.w = cvt_pk_bf16(b.z, b.w);
        *(u32x4*)(cf + ((size_t)(g * 4 + s) * 64 + lane) * 8) = w; }
}
__device__ __forceinline__ void p0_btab_item(const Args& A, float* btab, int item, int lane) {
    const float* gq = A.in[3]; const float* gk = A.in[4]; const float* rel_bias = A.in[5];
    const int h = item / 3, br = item % 3, d = br == 0 ? 1 : (br == 1 ? 4 : 16);
    const float G = wave_max(fabsf(gq[lane] * gk[lane]));
    const float mb = wave_max(lane < 32 ? rel_bias[lane * 16 + h] : -1e30f);
    const float smax = 8.4f * G + mb;
    for (int idx = lane; idx < 192; idx += 64) { const int rel = idx - 31;
        float v = -1e30f;
        if (rel >= 0 && rel <= 128) v = LOG2E * (rel_bias[t5_bucket(rel * d) * 16 + h] - smax);
        btab[(h * 3 + br) * 192 + idx] = v; }
}

__device__ __forceinline__ void p0_prologue(const Args& A, LAS unsigned char* lds, int wave, int lane) {
    unsigned char* ws = A.ws;
    LAS float* scr = (LAS float*)(lds + wave * 16384);
    const int gw = blockIdx.x * 8 + wave, NGW = gridDim.x * 8;
    constexpr int I_WIN = (2048 / 64) * (4096 / 32), I_GLU = (1024 / 64) * (1024 / 32), I_WOUT = (2048 / 64) * (2048 / 32), I_WP = 2048;
    constexpr int I_H = 8192, I_U = 16384, I_V = 16384, I_SSM = 64, I_BT = 48;
    constexpr int NITEMS = I_WIN + I_GLU + I_WOUT + I_WP + I_H + I_U + I_V + I_SSM + I_BT;
    for (int it = gw; it < NITEMS; it += NGW) {
        int r = it;
        if (r < I_SSM) { p0_ssm_item(A, ws + WS_SSMP, r, lane); continue; } r -= I_SSM;
        if (r < I_BT) { p0_btab_item(A, (float*)(ws + WS_BTAB), r, lane); continue; } r -= I_BT;
        if (r < I_WP) { p0_wp_item(A.in[20], A.in[21], A.in[22], A.in[19], (bf16_t*)(ws + WS_WPT), r, lane); continue; } r -= I_WP;
        if (r < I_WIN) { p0_transpose_item(A.in[2], 2048, 4096, (bf16_t*)(ws + WS_WINT), nullptr, nullptr, scr, r, lane); continue; } r -= I_WIN;
        if (r < I_GLU) { p0_transpose_item(A.in[14], 1024, 1024, (bf16_t*)(ws + WS_GLUT), nullptr, nullptr, scr, r, lane); continue; } r -= I_GLU;
        if (r < I_WOUT) { p0_transpose_item(A.in[18], 2048, 2048, (bf16_t*)(ws + WS_WOUTT), A.in[16], A.in[17], scr, r, lane); continue; } r -= I_WOUT;
        if (r < I_H) { p0_row<0>(A.in[0] + (size_t)r * 2048, A.in[1], (bf16_t*)(ws + WS_HB) + (size_t)r * 2048, lane); continue; } r -= I_H;
        if (r < I_U) { p0_row<1>(A.in[23] + (size_t)r * 2048, A.in[19], (bf16_t*)(ws + WS_UB) + (size_t)r * 2048, lane); continue; } r -= I_U;
        p0_row<2>(A.in[24] + (size_t)r * 2048, A.in[19], (bf16_t*)(ws + WS_VB) + (size_t)r * 2048, lane);
    }
}

constexpr int SSM_WL = 8192 + 16 * 272;
__device__ __forceinline__ void ssm_unit(const Args& A, LAS unsigned char* lds, int b, int g, int wave, int lane) {
    unsigned char* ws = A.ws; unsigned char* sp = ws + WS_SSMP;
    const bf16_t* proj = (const bf16_t*)(ws + WS_PROJ); bf16_t* yb = (bf16_t*)(ws + WS_YB);
    LAS unsigned char* wl = lds + wave * SSM_WL;
    LAS f32x2* BU = (LAS f32x2*)wl; LAS unsigned char* XB = wl + 8192;
    LAS f32x2* carry = (LAS f32x2*)(lds + 8 * SSM_WL);
    const int lr = lane & 15, q = lane >> 4;
    bf16x8 bfr[8], cfr[4];
#pragma unroll
    for (int j = 0; j < 8; ++j) bfr[j] = as_bf16x8(*(const u32x4*)((const bf16_t*)(sp + SSMP_BFRAG) + ((size_t)(g * 8 + j) * 64 + lane) * 8));
#pragma unroll
    for (int s = 0; s < 4; ++s) cfr[s] = as_bf16x8(*(const u32x4*)((const bf16_t*)(sp + SSMP_CFRAG) + ((size_t)(g * 4 + s) * 64 + lane) * 8));
    const f32x2 ab = ((const f32x2*)(sp + SSMP_ABAR))[g * 64 + lane], a256 = ((const f32x2*)(sp + SSMP_A256))[g * 64 + lane];
    const float a_re = ab.x, a_im = ab.y;
    const float dsk = A.in[13][g * 16 + lr];
    const bf16_t* up = proj + (size_t)(b * SEQ + wave * 256) * DPROJ + 3072 + g * 16;
    float xr = 0.f, xi = 0.f;
#ifdef MK_DEBUG2
    unsigned long long hdd = 0ull, hbu = 0ull, hua = 0ull;
#endif
    for (int pass = 0; pass < 2; ++pass) {
        for (int blk = 0; blk < 16; ++blk) {
            u32x4 uraw = {0u, 0u, 0u, 0u};
            if (q < 2) uraw = *(const u32x4*)(up + (size_t)(blk * 16 + lr) * DPROJ + 8 * q);
            const bf16x8 ua = as_bf16x8(uraw);
            f32x4 dd[8];
#pragma unroll
            for (int j = 0; j < 8; ++j) dd[j] = MFMA16(ua, bfr[j], ((f32x4){0.f, 0.f, 0.f, 0.f}));
#pragma unroll
            for (int jj = 0; jj < 4; ++jj)
#pragma unroll
                for (int r = 0; r < 4; ++r) BU[(4 * q + r) * 64 + 16 * jj + lr] = (f32x2){dd[jj][r], dd[4 + jj][r]};
            LDS_WAIT(); CBAR();
            f32x2 bu[16];
#pragma unroll
            for (int t = 0; t < 16; ++t) bu[t] = BU[t * 64 + lane];
#ifdef MK_DEBUG2
            if (pass == 0) {
#pragma unroll
                for (int j = 0; j < 8; ++j)
#pragma unroll
                    for (int r = 0; r < 4; ++r) hdd = hdd * 0x100000001B3ull + __float_as_uint(dd[j][r]);
#pragma unroll
                for (int t = 0; t < 16; ++t) { hbu = hbu * 0x100000001B3ull + __float_as_uint(bu[t].x); hbu = hbu * 0x100000001B3ull + __float_as_uint(bu[t].y); }
                hua = hua * 0x100000001B3ull + uraw.x; hua = hua * 0x100000001B3ull + uraw.y; hua = hua * 0x100000001B3ull + uraw.z; hua = hua * 0x100000001B3ull + uraw.w; }
#endif
            if (pass == 0) {
#pragma unroll
                for (int t = 0; t < 16; ++t) { float nr = fmaf(a_re, xr, fmaf(-a_im, xi, bu[t].x)), ni = fmaf(a_re, xi, fmaf(a_im, xr, bu[t].y)); asm volatile("" : "+v"(nr)); asm volatile("" : "+v"(ni)); xr = nr; xi = ni; }
                asm volatile("" : "+v"(xr), "+v"(xi) :: "memory");
            } else {
#pragma unroll
                for (int t = 0; t < 16; ++t) { float nr = fmaf(a_re, xr, fmaf(-a_im, xi, bu[t].x)), ni = fmaf(a_re, xi, fmaf(a_im, xr, bu[t].y)); asm volatile("" : "+v"(nr)); asm volatile("" : "+v"(ni)); xr = nr; xi = ni;
                    const unsigned pk = cvt_pk_bf16(xr, xi);
                    *(LAS unsigned short*)(XB + t * 272 + lane * 2) = (unsigned short)(pk & 0xffffu);
                    *(LAS unsigned short*)(XB + t * 272 + 128 + lane * 2) = (unsigned short)(pk >> 16); }
                LDS_WAIT(); CBAR();
                f32x4 y = {0.f, 0.f, 0.f, 0.f};
#pragma unroll
                for (int s = 0; s < 4; ++s) { const bf16x8 xa = as_bf16x8(*(const LAS u32x4*)(XB + lr * 272 + (32 * s + 8 * q) * 2)); y = MFMA16(xa, cfr[s], y); }
#pragma unroll
                for (int r = 0; r < 4; ++r) { const int t = blk * 16 + 4 * q + r;
                    const float uv = __uint_as_float((unsigned)up[(size_t)t * DPROJ + lr] << 16);
                    const float yv = gelu_erf(y[r] + dsk * uv);
                    yb[(size_t)(b * SEQ + wave * 256 + t) * 1024 + g * 16 + lr] = (bf16_t)(cvt_pk_bf16(yv, 0.f) & 0xffffu); }
                asm volatile("" : "+v"(xr), "+v"(xi) :: "memory");
            }
        }
        if (pass == 0) {
            carry[wave * 64 + lane] = (f32x2){xr, xi};
#ifdef MK_DEBUG2
            { unsigned long long* hp = (unsigned long long*)(ws + WS_END + 99 * MB);
              const unsigned long long km = (2ull * (((unsigned long long)(b * 64 + g) * 8 + wave) * 64 + lane) + 1ull) * 0x9E3779B97F4A7C15ull;
              atomicAdd(hp + 0, hua * km); atomicAdd(hp + 1, hdd * km); atomicAdd(hp + 2, hbu * km); }
            ((f32x2*)(ws + WS_END + 108 * MB))[((size_t)(b * 64 + g) * 8 + wave) * 64 + lane] = (f32x2){xr, xi};
#endif
            __syncthreads();
            float sr = 0.f, si = 0.f;
            for (int w2 = 0; w2 < wave; ++w2) { const f32x2 e = carry[w2 * 64 + lane]; const float nr = a256.x * sr - a256.y * si + e.x, ni = a256.x * si + a256.y * sr + e.y; sr = nr; si = ni; }
            xr = sr; xi = si;
#ifdef MK_DEBUG2
            ((f32x2*)(ws + WS_END + 109 * MB))[((size_t)(b * 64 + g) * 8 + wave) * 64 + lane] = (f32x2){xr, xi};
#endif
        }
    }
    __syncthreads();
}

__device__ __forceinline__ void prep2_item(const Args& A, LAS unsigned char* wl, int item, int lane) {
    unsigned char* ws = A.ws;
    const bf16_t* proj = (const bf16_t*)(ws + WS_PROJ);
    const int pb = item & 31, h = (item >> 5) & 15, b = item >> 9, P0 = pb * 64;
    const int r8 = lane >> 3, c = lane & 7;
    const float* gq = A.in[3]; const float* gk = A.in[4];
#pragma unroll
    for (int which = 0; which < 2; ++which) {
        const float* gv = which ? gk : gq; const float cs = which ? 1.f : (LOG2E * 0.125f);
        float gl[8];
#pragma unroll
        for (int e = 0; e < 8; ++e) gl[e] = gv[8 * c + e] * cs;
        bf16_t* dst = (bf16_t*)(ws + (which ? WS_KN : WS_QN)) + ((size_t)(b * 16 + h) * SEQ + P0) * 64;
#pragma unroll
        for (int i = 0; i < 8; ++i) { const int row = 8 * i + r8;
            const u32x4 raw = *(const u32x4*)(proj + (size_t)(b * SEQ + P0 + row) * DPROJ + which * 1024 + h * 64 + 8 * c);
            float v[8] = {bflo(raw.x), bfhi(raw.x), bflo(raw.y), bfhi(raw.y), bflo(raw.z), bfhi(raw.z), bflo(raw.w), bfhi(raw.w)};
            float ss = 0.f;
#pragma unroll
            for (int e = 0; e < 8; ++e) ss += v[e] * v[e];
            ss += __shfl_xor(ss, 1); ss += __shfl_xor(ss, 2); ss += __shfl_xor(ss, 4);
            const float r = 1.0f / sqrtf(ss * (1.f / 64.f) + EPS);
            u32x4 w; w.x = cvt_pk_bf16(v[0] * r * gl[0], v[1] * r * gl[1]); w.y = cvt_pk_bf16(v[2] * r * gl[2], v[3] * r * gl[3]);
            w.z = cvt_pk_bf16(v[4] * r * gl[4], v[5] * r * gl[5]); w.w = cvt_pk_bf16(v[6] * r * gl[6], v[7] * r * gl[7]);
            *(u32x4*)(dst + (size_t)row * 64 + 8 * c) = w; }
    }
#pragma unroll
    for (int i = 0; i < 8; ++i) { const int row = 8 * i + r8;
        const u32x4 raw = *(const u32x4*)(proj + (size_t)(b * SEQ + P0 + row) * DPROJ + 2048 + h * 64 + 8 * c);
        *(LAS u32x2*)(wl + row * 136 + c * 16) = (u32x2){raw.x, raw.y}; *(LAS u32x2*)(wl + row * 136 + c * 16 + 8) = (u32x2){raw.z, raw.w}; }
    CBAR();
    unsigned v[64];
#pragma unroll
    for (int p = 0; p < 64; ++p) v[p] = *(const LAS unsigned short*)(wl + p * 136 + lane * 2);
    CBAR();
    bf16_t* vt = (bf16_t*)(ws + WS_VT);
    const size_t rowo = ((size_t)(b * 16 + h) * 64 + lane) * SEQ;
#pragma unroll
    for (int G = 0; G < 2; ++G)
#pragma unroll
        for (int kg = 0; kg < 4; ++kg) { const int a0 = 32 * G + 4 * kg, b0 = 32 * G + 16 + 4 * kg;
            u32x4 w; w.x = v[a0] | (v[a0 + 1] << 16); w.y = v[a0 + 2] | (v[a0 + 3] << 16); w.z = v[b0] | (v[b0 + 1] << 16); w.w = v[b0 + 2] | (v[b0 + 3] << 16);
            *(u32x4*)(vt + rowo + P0 + 32 * G + 8 * kg) = w; }
    { bf16_t* vt4 = vt + (size_t)4 * 16 * 64 * SEQ; const int l0 = P0 >> 2, tile = (l0 >> 4) & 1, grp = l0 >> 5;
#pragma unroll
        for (int r = 0; r < 4; ++r)
#pragma unroll
            for (int kg = 0; kg < 4; ++kg) { const int p0 = 4 * (4 * kg) + r;
                u32x2 w; w.x = v[p0] | (v[p0 + 4] << 16); w.y = v[p0 + 8] | (v[p0 + 12] << 16);
                *(u32x2*)(vt4 + rowo + r * 512 + 32 * grp + 8 * kg + 4 * tile) = w; } }
    { bf16_t* vt16 = vt + (size_t)2 * 4 * 16 * 64 * SEQ; const int l0 = P0 >> 4, w32 = l0 & 31, tile = (w32 >> 4) & 1, kg = (w32 & 15) >> 2, grp = l0 >> 5;
#pragma unroll
        for (int r = 0; r < 16; ++r) { u32x2 w; w.x = v[r] | (v[16 + r] << 16); w.y = v[32 + r] | (v[48 + r] << 16);
            *(u32x2*)(vt16 + rowo + r * 128 + 32 * grp + 8 * kg + 4 * tile) = w; } }
}

__device__ __forceinline__ void attn_unit(const Args& A, LAS unsigned char* lds, int unit, int tid, int wave, int lane) {
    unsigned char* ws = A.ws;
    const int blk = 7 - (unit >> 6), bh = unit & 63, b = bh >> 4, h = bh & 15, p0 = blk * 256;
    LAS float* Oacc = (LAS float*)lds; LAS float* lacc = (LAS float*)(lds + 65536); LAS float* tb = (LAS float*)(lds + 65536 + 1024);
    for (int i = tid; i < 256 * 64 + 256; i += 512) Oacc[i] = 0.f;
    { const float* bt = (const float*)(ws + WS_BTAB) + h * 3 * 192; for (int i = tid; i < 3 * 192; i += 512) tb[i] = bt[i]; }
    __syncthreads();
    const bf16_t* Qn = (const bf16_t*)(ws + WS_QN) + (size_t)bh * SEQ * 64;
    const bf16_t* Kn = (const bf16_t*)(ws + WS_KN) + (size_t)bh * SEQ * 64;
    const int qi = lane & 15, g = lane >> 4;
    for (int it = wave; it < 48; it += 8) {
        const int br = it >> 4, j = it & 15, sh = 2 * br, L = SEQ >> sh;
        int r, lfirst;
        if (br == 0) { r = 0; lfirst = p0 + 16 * j; } else if (br == 1) { r = j & 3; lfirst = (p0 >> 2) + 16 * (j >> 2); } else { r = j; lfirst = p0 >> 4; }
        const bf16_t* VT = (const bf16_t*)(ws + WS_VT) + (size_t)br * 4 * 16 * 64 * SEQ + (size_t)bh * 64 * SEQ + (size_t)r * L;
        const int qpos = ((lfirst + qi) << sh) + r;
        bf16x8 qf[2];
#pragma unroll
        for (int s = 0; s < 2; ++s) qf[s] = as_bf16x8(*(const u32x4*)(Qn + (size_t)qpos * 64 + 32 * s + 8 * g));
        f32x4 o[4];
#pragma unroll
        for (int nt = 0; nt < 4; ++nt) o[nt] = (f32x4){0.f, 0.f, 0.f, 0.f};
        float lsum = 0.f;
        const LAS float* tbb = tb + br * 192;
        int ks = (lfirst - 128) & ~31; if (ks < 0) ks = 0;
        for (int lk0 = ks; lk0 <= lfirst; lk0 += 32) {
            f32x4 sa = {0.f, 0.f, 0.f, 0.f}, sb = {0.f, 0.f, 0.f, 0.f};
            const int kpa = ((lk0 + qi) << sh) + r, kpb = ((lk0 + 16 + qi) << sh) + r;
#pragma unroll
            for (int s = 0; s < 2; ++s) {
                const bf16x8 ka = as_bf16x8(*(const u32x4*)(Kn + (size_t)kpa * 64 + 32 * s + 8 * g));
                const bf16x8 kb = as_bf16x8(*(const u32x4*)(Kn + (size_t)kpb * 64 + 32 * s + 8 * g));
                sa = MFMA16(ka, qf[s], sa); sb = MFMA16(kb, qf[s], sb); }
            const int ba = lfirst + qi - lk0 - 4 * g + 31;
            float pa[4], pb[4];
#pragma unroll
            for (int e = 0; e < 4; ++e) { pa[e] = __builtin_amdgcn_exp2f(sa[e] + tbb[ba - e]); pb[e] = __builtin_amdgcn_exp2f(sb[e] + tbb[ba - 16 - e]); }
            lsum += (pa[0] + pa[1]) + (pa[2] + pa[3]) + (pb[0] + pb[1]) + (pb[2] + pb[3]);
            u32x4 pw; pw.x = cvt_pk_bf16(pa[0], pa[1]); pw.y = cvt_pk_bf16(pa[2], pa[3]); pw.z = cvt_pk_bf16(pb[0], pb[1]); pw.w = cvt_pk_bf16(pb[2], pb[3]);
            const bf16x8 pf = as_bf16x8(pw);
#pragma unroll
            for (int nt = 0; nt < 4; ++nt) { const bf16x8 vf = as_bf16x8(*(const u32x4*)(VT + (size_t)(16 * nt + qi) * SEQ + lk0 + 8 * g)); o[nt] = MFMA16(pf, vf, o[nt]); }
        }
        lsum += __shfl_xor(lsum, 16); lsum += __shfl_xor(lsum, 32);
        if (g == 0) __hip_atomic_fetch_add(lacc + (qpos - p0), lsum, __ATOMIC_RELAXED, __HIP_MEMORY_SCOPE_WORKGROUP);
#pragma unroll
        for (int reg = 0; reg < 4; ++reg) { const int ql = (((lfirst + 4 * g + reg) << sh) + r) - p0;
#pragma unroll
            for (int nt = 0; nt < 4; ++nt) __hip_atomic_fetch_add(Oacc + ql * 64 + 16 * nt + qi, o[nt][reg], __ATOMIC_RELAXED, __HIP_MEMORY_SCOPE_WORKGROUP); }
    }
    __syncthreads();
    { const int ql = tid >> 1, half = tid & 1; const float inv = 1.0f / lacc[ql];
        bf16_t* dst = (bf16_t*)(ws + WS_MIXED) + (size_t)(b * SEQ + p0 + ql) * 2048 + h * 64 + 32 * half;
        float ss = 0.f;
#pragma unroll
        for (int c4 = 0; c4 < 4; ++c4) { float v[8];
#pragma unroll
            for (int e = 0; e < 8; ++e) { v[e] = Oacc[ql * 64 + 32 * half + 8 * c4 + e] * inv; ss += v[e] * v[e]; }
            u32x4 w; w.x = cvt_pk_bf16(v[0], v[1]); w.y = cvt_pk_bf16(v[2], v[3]); w.z = cvt_pk_bf16(v[4], v[5]); w.w = cvt_pk_bf16(v[6], v[7]);
            *(u32x4*)(dst + 8 * c4) = w; }
        ss += __shfl_xor(ss, 1);
        if (half == 0) unsafeAtomicAdd((float*)(ws + WS_CTL + CTL_RSS_ATTN) + b * SEQ + p0 + ql, ss); }
    __syncthreads();
}

__device__ __forceinline__ unsigned fkey(float f) { const unsigned u = __float_as_uint(f); return (u & 0x80000000u) ? ~u : (u | 0x80000000u); }
template <int R> __device__ __forceinline__ void select16(const unsigned (&key)[R], unsigned long long (&m)[R]) {
    unsigned T = 0u; int cnt = R * 64;
    for (int bit = 31; bit >= 0; --bit) { const unsigned cand = T | (1u << bit); int c = 0;
#pragma unroll
        for (int r = 0; r < R; ++r) c += __popcll(__ballot(key[r] >= cand));
        if (c >= 16) { T = cand; cnt = c; if (c == 16) break; } }
    if (cnt == 16) {
#pragma unroll
        for (int r = 0; r < R; ++r) m[r] = __ballot(key[r] >= T);
    } else {
        int need = 16;
#pragma unroll
        for (int r = 0; r < R; ++r) { m[r] = __ballot(key[r] > T); need -= __popcll(m[r]); }
#pragma unroll
        for (int r = 0; r < R; ++r) { unsigned long long eq = __ballot(key[r] == T);
            while (__popcll(eq) > need) eq &= ~(1ull << (63 - __builtin_clzll(eq)));
            need -= __popcll(eq); m[r] |= eq; }
    }
}
__device__ __forceinline__ void peer_topk(const float* sp, LAS float* sc, LAS int* exo, LAS float* gto, int lane) {
    LAS float* v1 = sc; LAS int* i1 = (LAS int*)(sc + 16); LAS float* v2 = sc + 32; LAS int* i2 = (LAS int*)(sc + 48); LAS float* sv = sc + 64; LAS int* si = (LAS int*)(sc + 80);
    const unsigned long long lt = (1ull << lane) - 1ull;
#pragma unroll
    for (int half = 0; half < 2; ++half) {
        const float a0 = sp[half * 128 + lane], a1 = sp[half * 128 + 64 + lane];
        const unsigned key[2] = {fkey(a0), fkey(a1)}; unsigned long long m[2];
        select16<2>(key, m);
        LAS float* vv = half ? v2 : v1; LAS int* ii = half ? i2 : i1;
        if ((m[0] >> lane) & 1ull) { const int pos = __popcll(m[0] & lt); vv[pos] = a0; ii[pos] = lane; }
        if ((m[1] >> lane) & 1ull) { const int pos = __popcll(m[0]) + __popcll(m[1] & lt); vv[pos] = a1; ii[pos] = 64 + lane; }
    }
    CBAR(); LDS_WAIT();
    const int a = lane >> 2, bb = (lane & 3) * 4;
    const float va = v1[a]; float cv[4]; unsigned key[4]; unsigned long long m[4];
#pragma unroll
    for (int e = 0; e < 4; ++e) { cv[e] = va + v2[bb + e]; key[e] = fkey(cv[e]); }
    select16<4>(key, m);
    int base = 0;
#pragma unroll
    for (int e = 0; e < 4; ++e) { if ((m[e] >> lane) & 1ull) { const int pos = base + __popcll(m[e] & lt); sv[pos] = cv[e]; si[pos] = a * 16 + bb + e; } base += __popcll(m[e]); }
    CBAR(); LDS_WAIT();
    if (lane < 16) {
        const float val = sv[lane]; const int fi = si[lane];
        float mx = val;
#pragma unroll
        for (int o = 1; o < 16; o <<= 1) mx = fmaxf(mx, __shfl_xor(mx, o));
        const float ex = expf(val - mx); float sum = ex;
#pragma unroll
        for (int o = 1; o < 16; o <<= 1) sum += __shfl_xor(sum, o);
        exo[lane] = i1[fi >> 4] * 128 + (i2[fi & 15] - 0);
        gto[lane] = ex / sum;
    }
    CBAR(); LDS_WAIT();
}

__device__ __forceinline__ float dot2bf(unsigned k, unsigned q, float acc) { return __builtin_amdgcn_fdot2_f32_bf16(__builtin_bit_cast(bf16x2v, k), __builtin_bit_cast(bf16x2v, q), acc, false); }
constexpr int PD = 4;
__device__ __forceinline__ void peer_wave(const Args& A, LAS unsigned char* lds, int wave, int lane) {
    unsigned char* ws = A.ws;
    const float* scores = (const float*)(ws + WS_PROJ);
    const bf16_t* ub = (const bf16_t*)(ws + WS_UB); const bf16_t* vb = (const bf16_t*)(ws + WS_VB); const bf16_t* x1b = (const bf16_t*)(ws + WS_HB);
    const float* rssx = (const float*)(ws + WS_CTL + CTL_RSS_X1);
    LAS int* exl = (LAS int*)(lds + wave * 4096);
    LAS float* gtl = (LAS float*)(lds + wave * 4096 + 2048);
    LAS float* sc = (LAS float*)(lds + 32768 + wave * 512);
    const int t0 = (blockIdx.x * 8 + wave) * 4;
    if (t0 >= NTOK) return;
    for (int tok = 0; tok < 4; ++tok)
        for (int h = 0; h < 8; ++h) peer_topk(scores + (size_t)(t0 + tok) * 2048 + h * 256, sc, exl + tok * 128 + h * 16, gtl + tok * 128 + h * 16, lane);
    CBAR(); LDS_WAIT();
#ifdef MK_DEBUG
    for (int i = lane; i < 512; i += 64) { ((int*)(ws + WS_END + 100 * MB))[(size_t)t0 * 128 + i] = exl[i]; ((float*)(ws + WS_END + 104 * MB))[(size_t)t0 * 128 + i] = gtl[i]; }
#endif
    u32x4 buf[PD][4];
#define ROWPTR(s) (((s) & 128 ? vb : ub) + (size_t)exl[((s) >> 8) * 128 + ((s) & 127)] * 2048 + 8 * lane)
#define ISSUE(slot, s) do { const bf16_t* _p = ROWPTR(s); _Pragma("unroll") for (int _j = 0; _j < 4; ++_j) buf[slot][_j] = *(const u32x4*)(_p + 512 * _j); } while (0)
#pragma unroll
    for (int i = 0; i < PD; ++i) ISSUE(i, i);
    for (int tok = 0; tok < 4; ++tok) {
        const int t = t0 + tok;
        u32x4 xq[4];
#pragma unroll
        for (int j = 0; j < 4; ++j) xq[j] = *(const u32x4*)(x1b + (size_t)t * 2048 + 8 * lane + 512 * j);
        const float r2 = 1.0f / sqrtf(rssx[t] * (1.f / 2048.f) + EPS);
        float a0 = 0.f, a1 = 0.f;
        for (int k0 = 0; k0 < 128; k0 += PD) {
#pragma unroll
            for (int i = 0; i < PD; ++i) {
                const int k = k0 + i, s = tok * 256 + k;
                float p = 0.f;
#pragma unroll
                for (int j = 0; j < 4; ++j) {
                    p = dot2bf(buf[i][j].x, xq[j].x, p); p = dot2bf(buf[i][j].y, xq[j].y, p); p = dot2bf(buf[i][j].z, xq[j].z, p); p = dot2bf(buf[i][j].w, xq[j].w, p); }
                if (s + PD < 4 * 256) ISSUE(i, s + PD);
                p = wave_sum(p);
                if (k < 64) a0 = (lane == k) ? p : a0; else a1 = (lane == k - 64) ? p : a1;
            }
        }
        const float w0 = gtl[tok * 128 + lane] * gelu_erf(a0 * r2), w1 = gtl[tok * 128 + 64 + lane] * gelu_erf(a1 * r2);
        float acc[32];
#pragma unroll
        for (int i = 0; i < 32; ++i) acc[i] = 0.f;
        for (int k0 = 0; k0 < 128; k0 += PD) {
#pragma unroll
            for (int i = 0; i < PD; ++i) {
                const int k = k0 + i, s = tok * 256 + 128 + k;
                const float w = __builtin_bit_cast(float, __builtin_amdgcn_readlane(__builtin_bit_cast(int, k < 64 ? w0 : w1), k & 63));
#pragma unroll
                for (int j = 0; j < 4; ++j) {
                    acc[8 * j + 0] += w * bflo(buf[i][j].x); acc[8 * j + 1] += w * bfhi(buf[i][j].x);
                    acc[8 * j + 2] += w * bflo(buf[i][j].y); acc[8 * j + 3] += w * bfhi(buf[i][j].y);
                    acc[8 * j + 4] += w * bflo(buf[i][j].z); acc[8 * j + 5] += w * bfhi(buf[i][j].z);
                    acc[8 * j + 6] += w * bflo(buf[i][j].w); acc[8 * j + 7] += w * bfhi(buf[i][j].w); }
                if (s + PD < 4 * 256) ISSUE(i, s + PD);
            }
        }
        float* op = A.out + (size_t)t * 2048 + 8 * lane;
#pragma unroll
        for (int j = 0; j < 4; ++j) {
            const f32x4 x0 = *(const f32x4*)(op + 512 * j), x1 = *(const f32x4*)(op + 512 * j + 4);
            *(f32x4*)(op + 512 * j) = x0 + (f32x4){acc[8 * j], acc[8 * j + 1], acc[8 * j + 2], acc[8 * j + 3]};
            *(f32x4*)(op + 512 * j + 4) = x1 + (f32x4){acc[8 * j + 4], acc[8 * j + 5], acc[8 * j + 6], acc[8 * j + 7]}; }
    }
#undef ROWPTR
#undef ISSUE
}

__global__ void __launch_bounds__(512, 2) mk_fwd(Args args) {
    extern __shared__ __attribute__((aligned(16))) unsigned char lds_raw[];
    LAS unsigned char* lds = (LAS unsigned char*)lds_raw;
    const int tid = threadIdx.x, lane = tid & 63, wave = __builtin_amdgcn_readfirstlane(tid >> 6);
    volatile LAS unsigned* MISC = (volatile LAS unsigned*)(lds + MISC_OFF);
    if (tid < 64) MISC[tid] = 0u;
    __syncthreads();
    unsigned char* ws = args.ws;
    const int lo = args.ph_lo, hi = args.ph_hi;
    XcdBarrier bar; bar.bar = (unsigned*)(ws + WS_CTL); bar.x = 0; bar.st = nullptr;
    if (hi - lo > 1) bar = xcd_barrier_post((unsigned*)(ws + WS_CTL), MISC + 8);
#ifndef PH_MASK
#define PH_MASK 0x7f
#endif
#define IN(k) (((PH_MASK >> (k)) & 1) && lo <= (k) && (k) < hi)
#define SEAM(k) do { if (IN(k) && IN((k) + 1)) xcd_barrier(bar); } while (0)

    if (IN(0)) { p0_prologue(args, lds, wave, lane); }
    SEAM(0);
    if (IN(1)) {
        pg8::Gemm g{(const bf16_t*)(ws + WS_HB), (const bf16_t*)(ws + WS_WINT), NTOK, DPROJ, DM}; pg8::StaticOrder S; S.init(NTOK, DPROJ, gridDim.x, (int)blockIdx.x);
        pg8::EpiProj E{(bf16_t*)(ws + WS_PROJ), DPROJ};
        pg8::gemm_phase<pg8::EpiProj, pg8::StaticOrder, false>(lds, g, S, E, nullptr);
    }
    SEAM(1);
    if (IN(2)) {
        for (int u = blockIdx.x; u < 256; u += gridDim.x) ssm_unit(args, lds, u >> 6, u & 63, wave, lane);
        for (int it = blockIdx.x * 8 + wave; it < 2048; it += gridDim.x * 8) prep2_item(args, lds + wave * SSM_WL, it, lane);
    }
    SEAM(2);
    if (IN(3)) {
        {
            pg8::Gemm g{(const bf16_t*)(ws + WS_YB), (const bf16_t*)(ws + WS_GLUT), NTOK, 1024, 1024}; pg8::StaticOrder S; S.init(NTOK, 1024, gridDim.x, (int)blockIdx.x);
            pg8::EpiGlu E{(const bf16_t*)(ws + WS_YB), (bf16_t*)(ws + WS_MIXED) + 1024, args.in[15], (float*)(ws + WS_CTL + CTL_RSS_SSM)};
            pg8::gemm_phase<pg8::EpiGlu, pg8::StaticOrder, false>(lds, g, S, E, nullptr);
        }
        __syncthreads();
        for (;;) {
            if (tid == 0) MISC[0] = atomicAdd((unsigned*)(ws + WS_CTL + CTL_QCTR), 1u);
            __syncthreads();
            const unsigned u = MISC[0];
            __syncthreads();
            if (u >= 512u) break;
            attn_unit(args, lds, (int)u, tid, wave, lane);
        }
    }
    SEAM(3);
    if (IN(4)) {
        pg8::Gemm g{(const bf16_t*)(ws + WS_MIXED), (const bf16_t*)(ws + WS_WOUTT), NTOK, DM, DM}; pg8::StaticOrder S; S.init(NTOK, DM, gridDim.x, (int)blockIdx.x);
        LAS float* tab = (LAS float*)(lds + 131072);
        { pg8::Unit u0; if (S.next(0, u0) && tid < 256) { const int row = u0.pm * 256 + tid;
            const float ra = 1.0f / sqrtf(((const float*)(ws + WS_CTL + CTL_RSS_ATTN))[row] * (1.f / 1024.f) + EPS), rs = 1.0f / sqrtf(((const float*)(ws + WS_CTL + CTL_RSS_SSM))[row] * (1.f / 1024.f) + EPS);
            tab[tid] = ra / rs; tab[256 + tid] = rs; } }
        __syncthreads();
        pg8::EpiWout E{args.in[0], args.out, (bf16_t*)(ws + WS_HB), (float*)(ws + WS_CTL + CTL_RSS_X1), tab};
        pg8::gemm_phase<pg8::EpiWout, pg8::StaticOrder, false>(lds, g, S, E, nullptr);
    }
    SEAM(4);
    if (IN(5)) {
        pg8::Gemm g{(const bf16_t*)(ws + WS_HB), (const bf16_t*)(ws + WS_WPT), NTOK, DM, DM}; pg8::StaticOrder S; S.init(NTOK, DM, gridDim.x, (int)blockIdx.x);
        pg8::EpiScores E{(float*)(ws + WS_PROJ), (const float*)(ws + WS_CTL + CTL_RSS_X1)};
        pg8::gemm_phase<pg8::EpiScores, pg8::StaticOrder, false>(lds, g, S, E, nullptr);
    }
    SEAM(5);
    if (IN(6)) { peer_wave(args, lds, wave, lane); }
#undef IN
#undef SEAM
}

#ifndef MK_DEBUG
#ifndef MK_PER_PHASE
#define MK_PER_PHASE 0
#endif
extern "C" void kernel_launch(void* const* d_in, const int* in_sizes, int n_in, void* d_out, int out_size, void* d_ws, size_t ws_size, hipStream_t stream) {
    static int grid = 0;
    if (grid == 0) {
        if (n_in != 25 || out_size != NTOK * DM || ws_size < WS_END) { fprintf(stderr, "kernel_launch: unexpected shapes / workspace (%d inputs, out %d, ws %zu < %zu)\n", n_in, out_size, ws_size, (size_t)WS_END); grid = -1; return; }
        int dev = 0, cus = 0, per_cu = 0;
        if (hipGetDevice(&dev) != hipSuccess || hipDeviceGetAttribute(&cus, hipDeviceAttributeMultiprocessorCount, dev) != hipSuccess) { grid = -1; return; }
        if (hipFuncSetAttribute((const void*)mk_fwd, hipFuncAttributeMaxDynamicSharedMemorySize, LDS_BYTES) != hipSuccess) { fprintf(stderr, "kernel_launch: hipFuncSetAttribute failed\n"); grid = -1; return; }
        if (hipOccupancyMaxActiveBlocksPerMultiprocessor(&per_cu, (const void*)mk_fwd, 512, LDS_BYTES) != hipSuccess || per_cu < 1) { fprintf(stderr, "kernel_launch: occupancy query reports %d\n", per_cu); }
        (void)hipGetLastError();
        grid = cus;
    }
    if (grid < 0) return;
    (void)hipMemsetAsync((char*)d_ws + WS_CTL, 0, CTL_BYTES, stream);
    Args a{};
    for (int i = 0; i < 25; ++i) a.in[i] = (const float*)d_in[i];
    a.out = (float*)d_out; a.ws = (unsigned char*)d_ws;
#if MK_PER_PHASE
    for (int p = 0; p < 7; ++p) { a.ph_lo = p; a.ph_hi = p + 1; hipLaunchKernelGGL(mk_fwd, dim3(grid), dim3(512), LDS_BYTES, stream, a); }
#else
    a.ph_lo = 0; a.ph_hi = 7;
    hipLaunchKernelGGL(mk_fwd, dim3(grid), dim3(512), LDS_BYTES, stream, a);
#endif
}
#endif
```

```cpp
#include <hip/hip_runtime.h>
#include <stdint.h>
#include <stdio.h>

typedef unsigned short bf16_t;
typedef float f32x2 __attribute__((ext_vector_type(2)));
typedef unsigned u32x2 __attribute__((ext_vector_type(2)));
using bf16x2v = __attribute__((ext_vector_type(2))) __bf16;

constexpr int NTOK = 8192, SEQ = 2048, DM = 2048, DPROJ = 4096;
constexpr float EPS = 1e-6f;
constexpr float LOG2E = 1.4426950408889634f;

constexpr size_t MB = 1024 * 1024;
constexpr size_t WS_CTL = 0;
constexpr size_t CTL_BYTES = 128 * 1024;
constexpr size_t CTL_QCTR = 16384;
constexpr size_t CTL_RSS_ATTN = 32768, CTL_RSS_SSM = 65536, CTL_RSS_X1 = 98304;
constexpr size_t WS_HB = 256 * 1024;
constexpr size_t WS_WINT = WS_HB + 32 * MB;
constexpr size_t WS_GLUT = WS_WINT + 16 * MB;
constexpr size_t WS_WOUTT = WS_GLUT + 2 * MB;
constexpr size_t WS_WPT = WS_WOUTT + 8 * MB;
constexpr size_t WS_UB = WS_WPT + 8 * MB;
constexpr size_t WS_VB = WS_UB + 64 * MB;
constexpr size_t WS_PROJ = WS_VB + 64 * MB;
constexpr size_t WS_QN = WS_PROJ + 64 * MB;
constexpr size_t WS_KN = WS_QN + 16 * MB;
constexpr size_t WS_VT = WS_KN + 16 * MB;
constexpr size_t WS_YB = WS_VT + 48 * MB + 4096;
constexpr size_t WS_MIXED = WS_YB + 16 * MB;
constexpr size_t WS_SSMP = WS_MIXED + 32 * MB;
constexpr size_t SSMP_ABAR = 0, SSMP_A256 = 32768, SSMP_BFRAG = 65536, SSMP_CFRAG = 65536 + 524288;
constexpr size_t WS_BTAB = WS_SSMP + 1 * MB;
constexpr size_t WS_END = WS_BTAB + 64 * 1024;

constexpr int LDS_BYTES = 147456;
constexpr int MISC_OFF = 147456 - 256;
#define XB_TMO      128
#define XB_XCNT(j)  (256  + 64 * (j))
#define XB_XSUB(j)  (1280 + 64 * (j))
#define XB_XGEN(j)  (2304 + 64 * (j))
#define XB_TOP      3328
#define XB_TOPGEN   3392
#define XCD_BAR_WORDS 3456
#define XB_SPIN_CAP (1u << 18)
#define LAS __attribute__((address_space(3)))

__device__ __forceinline__ unsigned xb_ld(unsigned* p)              { return __hip_atomic_load(p, __ATOMIC_RELAXED, __HIP_MEMORY_SCOPE_AGENT); }
__device__ __forceinline__ unsigned xb_add(unsigned* p, unsigned v) { return __hip_atomic_fetch_add(p, v, __ATOMIC_RELAXED, __HIP_MEMORY_SCOPE_AGENT); }
__device__ __forceinline__ unsigned xb_xcc_id() { return (unsigned)__builtin_amdgcn_s_getreg((3 << 11) | 20) & 0xFu; }
#define XB_SPIN(cond, bar) do { unsigned _sp = 0; while (cond) { __builtin_amdgcn_s_sleep(1); \
    if ((++_sp & 255u) == 0u) { if (xb_ld(&(bar)[XB_TMO])) break; if (_sp > XB_SPIN_CAP) { atomicAdd(&(bar)[XB_TMO], 1u); break; } } } } while (0)

struct XcdBarrier {
    unsigned* bar; unsigned x;
    volatile LAS unsigned* st;
};

__device__ __forceinline__ XcdBarrier xcd_barrier_post(unsigned* bar, volatile LAS unsigned* st) {
    XcdBarrier b; b.bar = bar; b.x = xb_xcc_id(); b.st = st;
    if (threadIdx.x == 0) (void)xb_add(&bar[XB_XCNT(b.x)], 1u);
    return b;
}
__device__ __forceinline__ void xcd_barrier_complete(unsigned* bar, unsigned x, unsigned& nloc, unsigned& nx) {
    const unsigned G = gridDim.x * gridDim.y * gridDim.z;
    unsigned sum, cnt, mine, sp = 0u;
    for (;;) {
        sum = 0u; cnt = 0u; mine = 0u;
#pragma unroll
        for (unsigned j = 0; j < 16; ++j) { const unsigned c = xb_ld(&bar[XB_XCNT(j)]); sum += c; cnt += (c > 0u) ? 1u : 0u; mine = (j == x) ? c : mine; }
        if (sum == G) break;
        __builtin_amdgcn_s_sleep(1);
        if ((++sp & 255u) == 0u) { if (xb_ld(&bar[XB_TMO])) break; if (sp > XB_SPIN_CAP) { atomicAdd(&bar[XB_TMO], 1u); break; } }
    }
    nloc = mine > 0u ? mine : 1u; nx = cnt > 0u ? cnt : 1u;
}

__device__ __forceinline__ void xcd_barrier(const XcdBarrier& b) {
    asm volatile("s_waitcnt vmcnt(0)" ::: "memory");
    __syncthreads();
    if (threadIdx.x == 0) {
        unsigned* bar = b.bar;
        __builtin_amdgcn_s_waitcnt(0);
        unsigned nloc = b.st[0], nx = b.st[1];
        if (nloc == 0u) { xcd_barrier_complete(bar, b.x, nloc, nx); b.st[0] = nloc; b.st[1] = nx; }
        const unsigned old = xb_add(&bar[XB_XSUB(b.x)], 1u);
        const unsigned gen = old / nloc;
        if (old + 1u == (gen + 1u) * nloc) {
            __builtin_amdgcn_fence(__ATOMIC_RELEASE, "agent");
            asm volatile("s_waitcnt vmcnt(0)" ::: "memory");
            const unsigned og = xb_add(&bar[XB_TOP], 1u);
            const unsigned tg = og / nx;
            if (og + 1u == (tg + 1u) * nx) xb_add(&bar[XB_TOPGEN], 1u);
            else XB_SPIN(xb_ld(&bar[XB_TOPGEN]) == tg, bar);
            __builtin_amdgcn_fence(__ATOMIC_ACQUIRE, "agent");
            xb_add(&bar[XB_XGEN(b.x)], 1u);
            asm volatile("s_waitcnt vmcnt(0)" ::: "memory");
        } else {
            XB_SPIN(xb_ld(&bar[XB_XGEN(b.x)]) == gen, bar);
            __builtin_amdgcn_fence(__ATOMIC_ACQUIRE, "agent");
            asm volatile("s_waitcnt vmcnt(0)" ::: "memory");
        }
    }
    __syncthreads();
}
namespace pg8 {
#define PG8_LAS __attribute__((address_space(3)))
typedef unsigned short bf16_t;
typedef short bf16x8 __attribute__((ext_vector_type(8)));
typedef float f32x4 __attribute__((ext_vector_type(4)));
typedef unsigned u32x4 __attribute__((ext_vector_type(4)));
constexpr int BM = 256, BK = 64, HALF = 128, HTB = HALF * BK * 2  , STAGE_BYTES = 8 * HTB, NXCD = 8, WGM = 8;

__host__ __device__ __forceinline__ int lds_byte(int r, int c) { const int st = (r >> 4) * 2 + (c >> 5), rr = r & 15, cc = c & 31, ob = rr * 64 + cc * 2; return st * 1024 + (ob ^ (((ob >> 9) & 1) << 5)); }
__host__ __device__ __forceinline__ void stage_rc(int b, int& R, int& C) { const int st = b / 1024, sb = b % 1024, swz = sb ^ (((sb >> 9) & 1) << 5); R = (st >> 1) * 16 + swz / 64; C = (st & 1) * 32 + (swz % 64) / 2; }
__host__ __device__ __forceinline__ int perm32(int rho) { const int n = rho >> 4, i = rho & 15; return 8 * (i >> 2) + 4 * n + (i & 3); }

struct Unit { int pm, pn; };
struct Gemm { const bf16_t* A; const bf16_t* Bt; int M, N, K; };

struct StaticOrder {
    int nM, nN, nwg, G, c;
    __host__ __device__ void init(int M, int N, int G_, int c_) { nM = M / BM; nN = N / BM; nwg = nM * nN; G = G_; c = c_; }
    __host__ __device__ bool next(int i, Unit& u) const {
        const long L = (long)i * G + c; if (L >= nwg) return false;
        int wgid = (int)L; { const int q = nwg / NXCD, r = nwg % NXCD, xcd = wgid % NXCD, off = wgid / NXCD; wgid = (xcd < r ? xcd * (q + 1) : r * (q + 1) + (xcd - r) * q) + off; }
        const int nig = WGM * nN, gid = wgid / nig, fm = gid * WGM, gsz = (nM - fm) < WGM ? (nM - fm) : WGM;
        u.pm = fm + ((wgid % nig) % gsz); u.pn = (wgid % nig) / gsz; return true;
    }
    __device__ __forceinline__ void a_ready(const Unit&) const {}
    __device__ __forceinline__ void done(const Unit&) const {}
};
typedef float cvt_f32x2 __attribute__((ext_vector_type(2)));
typedef __bf16 cvt_bf16x2 __attribute__((ext_vector_type(2)));
__device__ __forceinline__ unsigned cvt_pk_bf16(float lo, float hi) { return __builtin_bit_cast(unsigned, __builtin_convertvector((cvt_f32x2){lo, hi}, cvt_bf16x2)); }
__device__ __forceinline__ float bflo(unsigned u) { return __uint_as_float(u << 16); }
__device__ __forceinline__ float bfhi(unsigned u) { return __uint_as_float(u & 0xffff0000u); }

struct EpiProj {
    static constexpr bool PERM = true, AFTER_DRAIN = false, HAS_MID = false;
    bf16_t* O; int ldc;
    __device__ __forceinline__ void mid(f32x4 (&)[2][2][4][2], const Unit&, int, int, int, int) const {}
    __device__ __forceinline__ void operator()(const f32x4 (&acc)[2][2][4][2], const Unit& u, int wr, int wc, int fr, int fq) const {
        const int row0 = u.pm * BM + wr * 64 + fr, col0 = u.pn * BM + wc * 32 + 8 * fq;
#pragma unroll
        for (int ai = 0; ai < 2; ++ai)
#pragma unroll
            for (int m = 0; m < 4; ++m) { bf16_t* rowp = O + (size_t)(row0 + ai * HALF + m * 16) * ldc + col0;
#pragma unroll
                for (int bj = 0; bj < 2; ++bj) { const f32x4 v0 = acc[ai][bj][m][0], v1 = acc[ai][bj][m][1];
                    u32x4 w; w.x = cvt_pk_bf16(v0[0], v0[1]); w.y = cvt_pk_bf16(v0[2], v0[3]); w.z = cvt_pk_bf16(v1[0], v1[1]); w.w = cvt_pk_bf16(v1[2], v1[3]);
                    *(u32x4*)(rowp + bj * HALF) = w; } }
    }
};

struct EpiGlu {
    static constexpr bool PERM = true, AFTER_DRAIN = false, HAS_MID = false;
    const bf16_t* Y; bf16_t* O; const float* bias; float* rss;
    __device__ __forceinline__ void mid(f32x4 (&)[2][2][4][2], const Unit&, int, int, int, int) const {}
    __device__ __forceinline__ void operator()(const f32x4 (&acc)[2][2][4][2], const Unit& u, int wr, int wc, int fr, int fq) const {
        const int row0 = u.pm * BM + wr * 64 + fr, col0 = u.pn * BM + wc * 32 + 8 * fq;
        f32x4 bv[2][2];
#pragma unroll
        for (int bj = 0; bj < 2; ++bj)
#pragma unroll
            for (int n = 0; n < 2; ++n) bv[bj][n] = *(const f32x4*)(bias + col0 + bj * HALF + 4 * n);
#pragma unroll
        for (int ai = 0; ai < 2; ++ai)
#pragma unroll
            for (int m = 0; m < 4; ++m) { const int row = row0 + ai * HALF + m * 16; float ss = 0.f;
#pragma unroll
                for (int bj = 0; bj < 2; ++bj) {
                    const u32x4 yv = *(const u32x4*)(Y + (size_t)row * 1024 + col0 + bj * HALF);
                    const f32x4 g0 = acc[ai][bj][m][0] + bv[bj][0], g1 = acc[ai][bj][m][1] + bv[bj][1];
                    float y[8] = {bflo(yv.x), bfhi(yv.x), bflo(yv.y), bfhi(yv.y), bflo(yv.z), bfhi(yv.z), bflo(yv.w), bfhi(yv.w)};
                    float o[8];
#pragma unroll
                    for (int e = 0; e < 4; ++e) { o[e] = y[e] * __builtin_amdgcn_rcpf(1.f + __expf(-g0[e])); o[4 + e] = y[4 + e] * __builtin_amdgcn_rcpf(1.f + __expf(-g1[e])); }
#pragma unroll
                    for (int e = 0; e < 8; ++e) ss += o[e] * o[e];
                    u32x4 w; w.x = cvt_pk_bf16(o[0], o[1]); w.y = cvt_pk_bf16(o[2], o[3]); w.z = cvt_pk_bf16(o[4], o[5]); w.w = cvt_pk_bf16(o[6], o[7]);
                    *(u32x4*)(O + (size_t)row * 2048 + col0 + bj * HALF) = w; }
                ss += __shfl_xor(ss, 16); ss += __shfl_xor(ss, 32);
                if (fq == 0) unsafeAtomicAdd(rss + row, ss); }
    }
};

struct EpiWout {
    static constexpr bool PERM = true, AFTER_DRAIN = false, HAS_MID = true;
    const float* X; float* OUT; bf16_t* XB; float* rss_x; const PG8_LAS float* tab;
    __device__ __forceinline__ void mid(f32x4 (&acc)[2][2][4][2], const Unit& u, int wr, int wc, int fr, int fq) const {
        const PG8_LAS float* tp = tab + wr * 64 + fr;
#pragma unroll
        for (int ai = 0; ai < 2; ++ai)
#pragma unroll
            for (int m = 0; m < 4; ++m) { const float ratio = tp[ai * HALF + m * 16];
#pragma unroll
                for (int bj = 0; bj < 2; ++bj)
#pragma unroll
                    for (int n = 0; n < 2; ++n) acc[ai][bj][m][n] *= ratio; }
    }
    __device__ __forceinline__ void operator()(const f32x4 (&acc)[2][2][4][2], const Unit& u, int wr, int wc, int fr, int fq) const {
        const int row0 = u.pm * BM + wr * 64 + fr, col0 = u.pn * BM + wc * 32 + 8 * fq;
        const PG8_LAS float* tp = tab + 256 + wr * 64 + fr;
#pragma unroll
        for (int ai = 0; ai < 2; ++ai)
#pragma unroll
            for (int m = 0; m < 4; ++m) { const int row = row0 + ai * HALF + m * 16; float ss = 0.f;
                const float rs = tp[ai * HALF + m * 16];
#pragma unroll
                for (int bj = 0; bj < 2; ++bj) { const size_t o = (size_t)row * 2048 + col0 + bj * HALF;
                    const f32x4 x0 = *(const f32x4*)(X + o), x1 = *(const f32x4*)(X + o + 4);
                    const f32x4 v0 = x0 + rs * acc[ai][bj][m][0], v1 = x1 + rs * acc[ai][bj][m][1];
                    *(f32x4*)(OUT + o) = v0; *(f32x4*)(OUT + o + 4) = v1;
                    u32x4 w; w.x = cvt_pk_bf16(v0[0], v0[1]); w.y = cvt_pk_bf16(v0[2], v0[3]); w.z = cvt_pk_bf16(v1[0], v1[1]); w.w = cvt_pk_bf16(v1[2], v1[3]);
                    *(u32x4*)(XB + o) = w;
#pragma unroll
                    for (int e = 0; e < 4; ++e) ss += v0[e] * v0[e] + v1[e] * v1[e]; }
                ss += __shfl_xor(ss, 16); ss += __shfl_xor(ss, 32);
                if (fq == 0) unsafeAtomicAdd(rss_x + row, ss); }
    }
};

struct EpiScores {
    static constexpr bool PERM = false, AFTER_DRAIN = false, HAS_MID = false;
    float* C; const float* rss_x;
    __device__ __forceinline__ void mid(f32x4 (&)[2][2][4][2], const Unit&, int, int, int, int) const {}
    __device__ __forceinline__ void operator()(const f32x4 (&acc)[2][2][4][2], const Unit& u, int wr, int wc, int fr, int fq) const {
        const int row0 = u.pm * BM + wr * 64 + fr, col0 = u.pn * BM + wc * 32 + 4 * fq;
#pragma unroll
        for (int ai = 0; ai < 2; ++ai)
#pragma unroll
            for (int m = 0; m < 4; ++m) { const int row = row0 + ai * HALF + m * 16;
                const float r2 = __builtin_amdgcn_rsqf(rss_x[row] * (1.f / 2048.f) + 1e-6f);
                float* rowp = C + (size_t)row * 2048 + col0;
#pragma unroll
                for (int bj = 0; bj < 2; ++bj)
#pragma unroll
                    for (int n = 0; n < 2; ++n) *(f32x4*)(rowp + bj * HALF + n * 16) = acc[ai][bj][m][n] * r2; }
    }
};

template <class Epi, class Sched, bool STAMP = false>
__device__ __forceinline__ void gemm_phase(PG8_LAS unsigned char* lds, const Gemm g, const Sched& S, const Epi& E, unsigned long long* stamps) {
    const int tid = threadIdx.x, wid = __builtin_amdgcn_readfirstlane(tid >> 6), lane = tid & 63, wr = wid >> 2, wc = wid & 3, fr = lane & 15, fq = lane >> 4;
    const int K = g.K, nt = K / BK;
    int ts_lo = 0, ts_hi = 0, nts = 0; const unsigned long long rt_entry = STAMP ? (unsigned long long)wall_clock64() : 0ull;
#define PG8_STAMP() do { if (STAMP && wid == 0 && nts < 64) { const unsigned long long _c = (unsigned long long)clock64(); \
        ts_lo = (lane == nts) ? (int)(unsigned)_c : ts_lo; ts_hi = (lane == nts) ? (int)(unsigned)(_c >> 32) : ts_hi; ++nts; } } while (0)
    PG8_STAMP();
    unsigned voffA[2], voffB[2];
#pragma unroll
    for (int i = 0; i < 2; ++i) { int R, C; stage_rc(tid * 16 + i * 8192, R, C); const int Rb = Epi::PERM ? ((R & ~31) + perm32(R & 31)) : R;
        voffA[i] = (unsigned)(R * K + C) * 2u; voffB[i] = (unsigned)(Rb * K + C) * 2u; }
    const size_t kstep = (size_t)(BK * 2);
    const size_t hstep = (size_t)HALF * K * 2;
    const size_t tstep = 2 * hstep;
    const unsigned ldsw = (unsigned)wid * 1024u;
    const int aoff = lds_byte(wr * 64 + fr, fq * 8), boff = lds_byte(wc * 32 + fr, fq * 8);
#define PG8_SA(b, h) (((b) * 2 + (h)) * HTB)
#define PG8_SB(b, h) ((4 + (b) * 2 + (h)) * HTB)
#define PG8_STAGE(bufoff, gbase, voff) do { _Pragma("unroll") for (int _i = 0; _i < 2; ++_i) \
        __builtin_amdgcn_global_load_lds((const unsigned*)((const char*)(gbase) + (voff)[_i]), (PG8_LAS unsigned*)(lds + (bufoff) + ldsw + _i * 8192), 16, 0, 0); } while (0)
#define PG8_LDA(dst, b, h) do { _Pragma("unroll") for (int m = 0; m < 4; ++m) _Pragma("unroll") for (int k = 0; k < 2; ++k) dst[m][k] = *(const PG8_LAS bf16x8*)(lds + PG8_SA(b, h) + aoff + m * 2048 + k * 1024); } while (0)
#define PG8_LDB(dst, b, h) do { _Pragma("unroll") for (int n = 0; n < 2; ++n) _Pragma("unroll") for (int k = 0; k < 2; ++k) dst[n][k] = *(const PG8_LAS bf16x8*)(lds + PG8_SB(b, h) + boff + n * 2048 + k * 1024); } while (0)
#define PG8_MMA(ai, bj, At, Bt) do { __builtin_amdgcn_s_setprio(1); _Pragma("unroll") for (int m = 0; m < 4; ++m) _Pragma("unroll") for (int n = 0; n < 2; ++n) _Pragma("unroll") for (int k = 0; k < 2; ++k) \
        acc[ai][bj][m][n] = __builtin_amdgcn_mfma_f32_16x16x32_bf16(Bt[n][k], At[m][k], acc[ai][bj][m][n], 0, 0, 0); __builtin_amdgcn_s_setprio(0); } while (0)
#define PG8_WAIT_V(n) asm volatile("s_waitcnt vmcnt(" #n ")" ::: "memory")
#define PG8_WAIT_L(n) asm volatile("s_waitcnt lgkmcnt(" #n ")" ::: "memory")
#define PG8_BAR __builtin_amdgcn_s_barrier()
#define PG8_SCHED __builtin_amdgcn_sched_barrier(0)
    Unit cur, nxt; int ui = 0;
    if (!S.next(0, cur)) return;
    f32x4 acc[2][2][4][2];
#pragma unroll
    for (int a = 0; a < 2; ++a)
#pragma unroll
        for (int b = 0; b < 2; ++b)
#pragma unroll
            for (int m = 0; m < 4; ++m)
#pragma unroll
                for (int n = 0; n < 2; ++n) acc[a][b][m][n] = (f32x4){0.f, 0.f, 0.f, 0.f};
    bf16x8 At[4][2], B0[2][2], B1[2][2];
    const char* cA = (const char*)g.A + (size_t)cur.pm * tstep; const char* cB = (const char*)g.Bt + (size_t)cur.pn * tstep;
    S.a_ready(cur);
    PG8_STAGE(PG8_SB(0, 0), cB, voffB); PG8_STAGE(PG8_SA(0, 0), cA, voffA); PG8_STAGE(PG8_SB(0, 1), cB + hstep, voffB); PG8_STAGE(PG8_SA(0, 1), cA + hstep, voffA);
    if (wr == 1) PG8_BAR;
    PG8_WAIT_V(4); PG8_BAR;
    PG8_STAGE(PG8_SB(1, 0), cB + kstep, voffB); PG8_STAGE(PG8_SA(1, 0), cA + kstep, voffA); PG8_STAGE(PG8_SB(1, 1), cB + hstep + kstep, voffB);
    PG8_WAIT_V(6); PG8_BAR;
    PG8_STAMP();
    for (;;) {
        const bool has_next = S.next(ui + 1, nxt);
        const char* nA = has_next ? (const char*)g.A + (size_t)nxt.pm * tstep : cA; const char* nB = has_next ? (const char*)g.Bt + (size_t)nxt.pn * tstep : cB;
        for (int t = 0; t < nt; t += 2) {
            const bool last = (t == nt - 2);
            const char* a1 = cA + (size_t)(t + 1) * kstep;
            const char* a2 = last ? nA : cA + (size_t)(t + 2) * kstep; const char* b2 = last ? nB : cB + (size_t)(t + 2) * kstep;
            const char* a3 = a2 + kstep; const char* b3 = b2 + kstep;
            if (last && has_next) S.a_ready(nxt);
            if constexpr (Epi::HAS_MID) { if (t == (nt >> 1)) { E.mid(acc, cur, wr, wc, fr, fq); asm volatile("s_waitcnt lgkmcnt(0)" ::: "memory"); } }
            PG8_LDB(B0, 0, 0); PG8_SCHED; PG8_LDA(At, 0, 0); PG8_STAGE(PG8_SA(1, 1), a1 + hstep, voffA);
            PG8_WAIT_L(8); PG8_BAR; PG8_WAIT_L(0); PG8_MMA(0, 0, At, B0); PG8_BAR; PG8_SCHED;
            PG8_LDB(B1, 0, 1); PG8_STAGE(PG8_SB(0, 0), b2, voffB);
            PG8_BAR; PG8_WAIT_L(0); PG8_MMA(0, 1, At, B1); PG8_BAR;
            PG8_LDA(At, 0, 1); PG8_STAGE(PG8_SA(0, 0), a2, voffA);
            PG8_BAR; PG8_WAIT_L(0); PG8_MMA(1, 0, At, B0); PG8_BAR; PG8_SCHED;
            PG8_STAGE(PG8_SB(0, 1), b2 + hstep, voffB);
            PG8_WAIT_V(6); PG8_BAR; PG8_MMA(1, 1, At, B1); PG8_BAR;
            PG8_LDB(B0, 1, 0); PG8_SCHED; PG8_LDA(At, 1, 0); PG8_STAGE(PG8_SA(0, 1), a2 + hstep, voffA);
            PG8_WAIT_L(8); PG8_BAR; PG8_WAIT_L(0); PG8_MMA(0, 0, At, B0); PG8_BAR; PG8_SCHED;
            PG8_LDB(B1, 1, 1); PG8_STAGE(PG8_SB(1, 0), b3, voffB);
            PG8_BAR; PG8_WAIT_L(0); PG8_MMA(0, 1, At, B1); PG8_BAR;
            PG8_LDA(At, 1, 1); PG8_STAGE(PG8_SA(1, 0), a3, voffA);
            PG8_BAR; PG8_WAIT_L(0); PG8_MMA(1, 0, At, B0); PG8_BAR; PG8_SCHED;
            PG8_STAGE(PG8_SB(1, 1), b3 + hstep, voffB);
            PG8_WAIT_V(6); PG8_BAR; PG8_MMA(1, 1, At, B1); PG8_BAR;
        }
        PG8_STAMP();
        if constexpr (!Epi::AFTER_DRAIN) { E(acc, cur, wr, wc, fr, fq); S.done(cur); }
        PG8_STAMP();
        if (!has_next) break;
#pragma unroll
        for (int a = 0; a < 2; ++a)
#pragma unroll
            for (int b = 0; b < 2; ++b)
#pragma unroll
                for (int m = 0; m < 4; ++m)
#pragma unroll
                    for (int n = 0; n < 2; ++n) acc[a][b][m][n] = (f32x4){0.f, 0.f, 0.f, 0.f};
        cur = nxt; cA = nA; cB = nB; ++ui;
    }
    PG8_WAIT_V(0);
    if (wr == 0) PG8_BAR;
    PG8_BAR;
    if constexpr (Epi::AFTER_DRAIN) { E.fused(acc, cur, wr, wc, fr, fq, lds, wid, lane); S.done(cur); }
    PG8_STAMP();
    if (STAMP && wid == 0) { stamps[lane] = lane < nts ? (((unsigned long long)(unsigned)ts_hi << 32) | (unsigned)ts_lo) : 0ull;
        if (lane == 62) stamps[62] = rt_entry; if (lane == 63) stamps[63] = (unsigned long long)wall_clock64(); }
#undef PG8_STAMP
#undef PG8_SA
#undef PG8_SB
#undef PG8_STAGE
#undef PG8_LDA
#undef PG8_LDB
#undef PG8_MMA
#undef PG8_WAIT_V
#undef PG8_WAIT_L
#undef PG8_BAR
#undef PG8_SCHED
}
}

typedef short bf16x8 __attribute__((ext_vector_type(8)));
typedef float f32x4 __attribute__((ext_vector_type(4)));
typedef unsigned u32x4 __attribute__((ext_vector_type(4)));
using pg8::cvt_pk_bf16; using pg8::bflo; using pg8::bfhi;

#define LDS_WAIT() asm volatile("s_waitcnt lgkmcnt(0)" ::: "memory")
#define CBAR() asm volatile("" ::: "memory")
#define MFMA16(a, b, c) __builtin_amdgcn_mfma_f32_16x16x32_bf16((a), (b), (c), 0, 0, 0)

struct Args { const float* in[25]; float* out; unsigned char* ws; int ph_lo, ph_hi; };

__device__ __forceinline__ float wave_sum(float v) {
#pragma unroll
    for (int o = 1; o < 64; o <<= 1) v += __shfl_xor(v, o);
    return v;
}
__device__ __forceinline__ float wave_max(float v) {
#pragma unroll
    for (int o = 1; o < 64; o <<= 1) v = fmaxf(v, __shfl_xor(v, o));
    return v;
}
__device__ __forceinline__ float gelu_erf(float x) { return 0.5f * x * (1.0f + erff(x * 0.70710678118654752f)); }
__device__ __forceinline__ bf16x8 as_bf16x8(u32x4 v) { return __builtin_bit_cast(bf16x8, v); }

__device__ __forceinline__ void p0_transpose_item(const float* W, int K, int N, bf16_t* WT, const float* sc_a, const float* sc_b, LAS float* scr, int item, int lane) {
    const int nblk = N / 32, kb = item / nblk, nb = item % nblk, k0 = 64 * kb, n0 = 32 * nb;
#pragma unroll 8
    for (int i = 0; i < 32; ++i) { const int kk = 2 * i + (lane >> 5); const int k = k0 + kk;
        const float s = sc_a ? (k < 1024 ? sc_a[k] : sc_b[k - 1024]) : 1.f;
        scr[kk * 33 + (lane & 31)] = W[(size_t)k * N + n0 + (lane & 31)] * s; }
    LDS_WAIT();
    const int c = lane & 7;
#pragma unroll
    for (int j = 0; j < 4; ++j) { const int n = (lane >> 3) + 8 * j; const LAS float* s = scr + (8 * c) * 33 + n;
        u32x4 o; o.x = cvt_pk_bf16(s[0 * 33], s[1 * 33]); o.y = cvt_pk_bf16(s[2 * 33], s[3 * 33]); o.z = cvt_pk_bf16(s[4 * 33], s[5 * 33]); o.w = cvt_pk_bf16(s[6 * 33], s[7 * 33]);
        *(u32x4*)(WT + (size_t)(n0 + n) * K + k0 + 8 * c) = o; }
    LDS_WAIT();
}
template <int MODE> __device__ __forceinline__ void p0_row(const float* xrow, const float* g, bf16_t* orow, int lane) {
    const f32x4* xr = (const f32x4*)xrow + lane; const f32x4* gr = (const f32x4*)g + lane;
    f32x4 v[8]; float s = 0.f;
#pragma unroll
    for (int j = 0; j < 8; ++j) { v[j] = xr[64 * j]; s += (v[j].x * v[j].x + v[j].y * v[j].y) + (v[j].z * v[j].z + v[j].w * v[j].w); }
    float r = 1.f;
    if (MODE == 0) r = 1.0f / sqrtf(wave_sum(s) * (1.f / 2048.f) + EPS);
    u32x2* o8 = (u32x2*)orow + lane;
#pragma unroll
    for (int j = 0; j < 8; ++j) { f32x4 w = v[j] * r; if (MODE != 2) w = w * gr[64 * j];
        u32x2 o; o.x = cvt_pk_bf16(w.x, w.y); o.y = cvt_pk_bf16(w.z, w.w); o8[64 * j] = o; }
}
__device__ __forceinline__ void p0_wp_item(const float* wq, const float* keys1, const float* keys2, const float* gffn, bf16_t* WPT, int item, int lane) {
    const int hj = item >> 7, ib = item & 127, h = hj >> 1, j = hj & 1, i0 = 16 * ib, col0 = h * 256 + j * 128;
    const int lr = lane & 15, g = lane >> 4;
    const float* keys = (j ? keys2 : keys1) + (size_t)h * 128 * 128;
    const float gi = gffn[i0 + lr];
    bf16x8 af[4];
#pragma unroll
    for (int s = 0; s < 4; ++s) { const float* p = wq + (size_t)(i0 + lr) * 2048 + col0 + 32 * s + 8 * g;
        const f32x4 a = *(const f32x4*)p * gi, b = *(const f32x4*)(p + 4) * gi;
        u32x4 w; w.x = cvt_pk_bf16(a.x, a.y); w.y = cvt_pk_bf16(a.z, a.w); w.z = cvt_pk_bf16(b.x, b.y); w.w = cvt_pk_bf16(b.z, b.w); af[s] = as_bf16x8(w); }
    for (int kt = 0; kt < 8; ++kt) {
        f32x4 d = {0.f, 0.f, 0.f, 0.f};
#pragma unroll
        for (int s = 0; s < 4; ++s) { const float* p = keys + (size_t)(16 * kt + lr) * 128 + 32 * s + 8 * g;
            const f32x4 a = *(const f32x4*)p, b = *(const f32x4*)(p + 4);
            u32x4 w; w.x = cvt_pk_bf16(a.x, a.y); w.y = cvt_pk_bf16(a.z, a.w); w.z = cvt_pk_bf16(b.x, b.y); w.w = cvt_pk_bf16(b.z, b.w);
            d = MFMA16(af[s], as_bf16x8(w), d); }
        u32x2 o; o.x = cvt_pk_bf16(d[0], d[1]); o.y = cvt_pk_bf16(d[2], d[3]);
        *(u32x2*)(WPT + (size_t)(hj * 128 + 16 * kt + lr) * 2048 + i0 + 4 * g) = o;
    }
}
__device__ __forceinline__ int t5_bucket(int n) {
    if (n < 16) return n;
    const int large = 16 + (int)(logf((float)n / 16.f) / 4.852030263919617f * 16.f);
    return large < 31 ? large : 31;
}
__device__ __forceinline__ void p0_ssm_item(const Args& A, unsigned char* sp, int g, int lane) {
    const float* lam_re = A.in[6]; const float* lam_im = A.in[7]; const float* log_dt = A.in[8];
    const float* b_re = A.in[9]; const float* b_im = A.in[10]; const float* c_re = A.in[11]; const float* c_im = A.in[12];
    const int n = lane;
    const float dt = expf(log_dt[g]);
    const float lr = lam_re[g * 64 + n], li = lam_im[g * 64 + n];
    const float mag = expf(lr * dt);
    const float a_re = mag * cosf(li * dt), a_im = mag * sinf(li * dt);
    const float den = lr * lr + li * li;
    const float f_re = ((a_re - 1.f) * lr + a_im * li) / den, f_im = (a_im * lr - (a_re - 1.f) * li) / den;
    ((f32x2*)(sp + SSMP_ABAR))[g * 64 + n] = (f32x2){a_re, a_im};
    float pr = a_re, pi = a_im;
#pragma unroll
    for (int i = 0; i < 8; ++i) { const float nr = pr * pr - pi * pi, ni = 2.f * pr * pi; pr = nr; pi = ni; }
    ((f32x2*)(sp + SSMP_A256))[g * 64 + n] = (f32x2){pr, pi};
    float bbr[16], bbi[16];
#pragma unroll
    for (int q = 0; q < 4; ++q) { const f32x4 br = *(const f32x4*)(b_re + (size_t)(g * 64 + n) * 16 + 4 * q), bi = *(const f32x4*)(b_im + (size_t)(g * 64 + n) * 16 + 4 * q);
#pragma unroll
        for (int e = 0; e < 4; ++e) { bbr[4 * q + e] = f_re * br[e] - f_im * bi[e]; bbi[4 * q + e] = f_re * bi[e] + f_im * br[e]; } }
    bf16_t* bf = (bf16_t*)(sp + SSMP_BFRAG);
    const int jre = n >> 4, n16 = n & 15;
#pragma unroll
    for (int kg = 0; kg < 4; ++kg) {
        u32x4 wr = {0u, 0u, 0u, 0u}, wi = {0u, 0u, 0u, 0u};
        if (kg < 2) { const int c0 = (kg & 1) * 8;
            wr.x = cvt_pk_bf16(bbr[c0 + 0], bbr[c0 + 1]); wr.y = cvt_pk_bf16(bbr[c0 + 2], bbr[c0 + 3]); wr.z = cvt_pk_bf16(bbr[c0 + 4], bbr[c0 + 5]); wr.w = cvt_pk_bf16(bbr[c0 + 6], bbr[c0 + 7]);
            wi.x = cvt_pk_bf16(bbi[c0 + 0], bbi[c0 + 1]); wi.y = cvt_pk_bf16(bbi[c0 + 2], bbi[c0 + 3]); wi.z = cvt_pk_bf16(bbi[c0 + 4], bbi[c0 + 5]); wi.w = cvt_pk_bf16(bbi[c0 + 6], bbi[c0 + 7]); }
        *(u32x4*)(bf + ((size_t)(g * 8 + jre) * 64 + kg * 16 + n16) * 8) = wr;
        *(u32x4*)(bf + ((size_t)(g * 8 + 4 + jre) * 64 + kg * 16 + n16) * 8) = wi;
    }
    bf16_t* cf = (bf16_t*)(sp + SSMP_CFRAG);
    const int ch = lane & 15, kg = lane >> 4;
#pragma unroll
    for (int s = 0; s < 4; ++s) { const int k0 = 32 * s + 8 * kg;
        const float* src = (k0 < 64) ? (c_re + (size_t)(g * 16 + ch) * 64 + k0) : (c_im + (size_t)(g * 16 + ch) * 64 + (k0 - 64));
        const float sg = (k0 < 64) ? 1.f : -1.f;
        const f32x4 a = *(const f32x4*)src * sg, b = *(const f32x4*)(src + 4) * sg;
        u32x4 w; w.x = cvt_pk_bf16(a.x, a.y); w.y = cvt_pk_bf16(a.z, a.w); w.z = cvt_pk_bf16(b.x, b.y); w.w = cvt_pk_bf16(b.z, b.w);
        *(u32x4*)(cf + ((size_t)(g * 4 + s) * 64 + lane) * 8) = w; }
}
__device__ __forceinline__ void p0_btab_item(const Args& A, float* btab, int item, int lane) {
    const float* gq = A.in[3]; const float* gk = A.in[4]; const float* rel_bias = A.in[5];
    const int h = item / 3, br = item % 3, d = br == 0 ? 1 : (br == 1 ? 4 : 16);
    const float G = wave_max(fabsf(gq[lane] * gk[lane]));
    const float mb = wave_max(lane < 32 ? rel_bias[lane * 16 + h] : -1e30f);
    const float smax = 8.4f * G + mb;
    for (int idx = lane; idx < 192; idx += 64) { const int rel = idx - 31;
        float v = -1e30f;
        if (rel >= 0 && rel <= 128) v = LOG2E * (rel_bias[t5_bucket(rel * d) * 16 + h] - smax);
        btab[(h * 3 + br) * 192 + idx] = v; }
}

__device__ __forceinline__ void p0_prologue(const Args& A, LAS unsigned char* lds, int wave, int lane) {
    unsigned char* ws = A.ws;
    LAS float* scr = (LAS float*)(lds + wave * 16384);
    const int gw = blockIdx.x * 8 + wave, NGW = gridDim.x * 8;
    constexpr int I_WIN = (2048 / 64) * (4096 / 32), I_GLU = (1024 / 64) * (1024 / 32), I_WOUT = (2048 / 64) * (2048 / 32), I_WP = 2048;
    constexpr int I_H = 8192, I_U = 16384, I_V = 16384, I_SSM = 64, I_BT = 48;
    constexpr int NITEMS = I_WIN + I_GLU + I_WOUT + I_WP + I_H + I_U + I_V + I_SSM + I_BT;
    for (int it = gw; it < NITEMS; it += NGW) {
        int r = it;
        if (r < I_SSM) { p0_ssm_item(A, ws + WS_SSMP, r, lane); continue; } r -= I_SSM;
        if (r < I_BT) { p0_btab_item(A, (float*)(ws + WS_BTAB), r, lane); continue; } r -= I_BT;
        if (r < I_WP) { p0_wp_item(A.in[20], A.in[21], A.in[22], A.in[19], (bf16_t*)(ws + WS_WPT), r, lane); continue; } r -= I_WP;
        if (r < I_WIN) { p0_transpose_item(A.in[2], 2048, 4096, (bf16_t*)(ws + WS_WINT), nullptr, nullptr, scr, r, lane); continue; } r -= I_WIN;
        if (r < I_GLU) { p0_transpose_item(A.in[14], 1024, 1024, (bf16_t*)(ws + WS_GLUT), nullptr, nullptr, scr, r, lane); continue; } r -= I_GLU;
        if (r < I_WOUT) { p0_transpose_item(A.in[18], 2048, 2048, (bf16_t*)(ws + WS_WOUTT), A.in[16], A.in[17], scr, r, lane); continue; } r -= I_WOUT;
        if (r < I_H) { p0_row<0>(A.in[0] + (size_t)r * 2048, A.in[1], (bf16_t*)(ws + WS_HB) + (size_t)r * 2048, lane); continue; } r -= I_H;
        if (r < I_U) { p0_row<1>(A.in[23] + (size_t)r * 2048, A.in[19], (bf16_t*)(ws + WS_UB) + (size_t)r * 2048, lane); continue; } r -= I_U;
        p0_row<2>(A.in[24] + (size_t)r * 2048, A.in[19], (bf16_t*)(ws + WS_VB) + (size_t)r * 2048, lane);
    }
}

constexpr int SSM_WL = 8192 + 16 * 272;
__device__ __forceinline__ void ssm_unit(const Args& A, LAS unsigned char* lds, int b, int g, int wave, int lane) {
    unsigned char* ws = A.ws; unsigned char* sp = ws + WS_SSMP;
    const bf16_t* proj = (const bf16_t*)(ws + WS_PROJ); bf16_t* yb = (bf16_t*)(ws + WS_YB);
    LAS unsigned char* wl = lds + wave * SSM_WL;
    LAS f32x2* BU = (LAS f32x2*)wl; LAS unsigned char* XB = wl + 8192;
    LAS f32x2* carry = (LAS f32x2*)(lds + 8 * SSM_WL);
    const int lr = lane & 15, q = lane >> 4;
    bf16x8 bfr[8], cfr[4];
#pragma unroll
    for (int j = 0; j < 8; ++j) bfr[j] = as_bf16x8(*(const u32x4*)((const bf16_t*)(sp + SSMP_BFRAG) + ((size_t)(g * 8 + j) * 64 + lane) * 8));
#pragma unroll
    for (int s = 0; s < 4; ++s) cfr[s] = as_bf16x8(*(const u32x4*)((const bf16_t*)(sp + SSMP_CFRAG) + ((size_t)(g * 4 + s) * 64 + lane) * 8));
    const f32x2 ab = ((const f32x2*)(sp + SSMP_ABAR))[g * 64 + lane], a256 = ((const f32x2*)(sp + SSMP_A256))[g * 64 + lane];
    const float a_re = ab.x, a_im = ab.y;
    const float dsk = A.in[13][g * 16 + lr];
    const bf16_t* up = proj + (size_t)(b * SEQ + wave * 256) * DPROJ + 3072 + g * 16;
    float xr = 0.f, xi = 0.f;
#ifdef MK_DEBUG2
    unsigned long long hdd = 0ull, hbu = 0ull, hua = 0ull;
#endif
    for (int pass = 0; pass < 2; ++pass) {
        for (int blk = 0; blk < 16; ++blk) {
            u32x4 uraw = {0u, 0u, 0u, 0u};
            if (q < 2) uraw = *(const u32x4*)(up + (size_t)(blk * 16 + lr) * DPROJ + 8 * q);
            const bf16x8 ua = as_bf16x8(uraw);
            f32x4 dd[8];
#pragma unroll
            for (int j = 0; j < 8; ++j) dd[j] = MFMA16(ua, bfr[j], ((f32x4){0.f, 0.f, 0.f, 0.f}));
#pragma unroll
            for (int jj = 0; jj < 4; ++jj)
#pragma unroll
                for (int r = 0; r < 4; ++r) BU[(4 * q + r) * 64 + 16 * jj + lr] = (f32x2){dd[jj][r], dd[4 + jj][r]};
            LDS_WAIT(); CBAR();
            f32x2 bu[16];
#pragma unroll
            for (int t = 0; t < 16; ++t) bu[t] = BU[t * 64 + lane];
#ifdef MK_DEBUG2
            if (pass == 0) {
#pragma unroll
                for (int j = 0; j < 8; ++j)
#pragma unroll
                    for (int r = 0; r < 4; ++r) hdd = hdd * 0x100000001B3ull + __float_as_uint(dd[j][r]);
#pragma unroll
                for (int t = 0; t < 16; ++t) { hbu = hbu * 0x100000001B3ull + __float_as_uint(bu[t].x); hbu = hbu * 0x100000001B3ull + __float_as_uint(bu[t].y); }
                hua = hua * 0x100000001B3ull + uraw.x; hua = hua * 0x100000001B3ull + uraw.y; hua = hua * 0x100000001B3ull + uraw.z; hua = hua * 0x100000001B3ull + uraw.w; }
#endif
            if (pass == 0) {
#pragma unroll
                for (int t = 0; t < 16; ++t) { float nr = fmaf(a_re, xr, fmaf(-a_im, xi, bu[t].x)), ni = fmaf(a_re, xi, fmaf(a_im, xr, bu[t].y)); asm volatile("" : "+v"(nr)); asm volatile("" : "+v"(ni)); xr = nr; xi = ni; }
                asm volatile("" : "+v"(xr), "+v"(xi) :: "memory");
            } else {
#pragma unroll
                for (int t = 0; t < 16; ++t) { float nr = fmaf(a_re, xr, fmaf(-a_im, xi, bu[t].x)), ni = fmaf(a_re, xi, fmaf(a_im, xr, bu[t].y)); asm volatile("" : "+v"(nr)); asm volatile("" : "+v"(ni)); xr = nr; xi = ni;
                    const unsigned pk = cvt_pk_bf16(xr, xi);
                    *(LAS unsigned short*)(XB + t * 272 + lane * 2) = (unsigned short)(pk & 0xffffu);
                    *(LAS unsigned short*)(XB + t * 272 + 128 + lane * 2) = (unsigned short)(pk >> 16); }
                LDS_WAIT(); CBAR();
                f32x4 y = {0.f, 0.f, 0.f, 0.f};
#pragma unroll
                for (int s = 0; s < 4; ++s) { const bf16x8 xa = as_bf16x8(*(const LAS u32x4*)(XB + lr * 272 + (32 * s + 8 * q) * 2)); y = MFMA16(xa, cfr[s], y); }
#pragma unroll
                for (int r = 0; r < 4; ++r) { const int t = blk * 16 + 4 * q + r;
                    const float uv = __uint_as_float((unsigned)up[(size_t)t * DPROJ + lr] << 16);
                    const float yv = gelu_erf(y[r] + dsk * uv);
                    yb[(size_t)(b * SEQ + wave * 256 + t) * 1024 + g * 16 + lr] = (bf16_t)(cvt_pk_bf16(yv, 0.f) & 0xffffu); }
                asm volatile("" : "+v"(xr), "+v"(xi) :: "memory");
            }
        }
        if (pass == 0) {
            carry[wave * 64 + lane] = (f32x2){xr, xi};
#ifdef MK_DEBUG2
            { unsigned long long* hp = (unsigned long long*)(ws + WS_END + 99 * MB);
              const unsigned long long km = (2ull * (((unsigned long long)(b * 64 + g) * 8 + wave) * 64 + lane) + 1ull) * 0x9E3779B97F4A7C15ull;
              atomicAdd(hp + 0, hua * km); atomicAdd(hp + 1, hdd * km); atomicAdd(hp + 2, hbu * km); }
            ((f32x2*)(ws + WS_END + 108 * MB))[((size_t)(b * 64 + g) * 8 + wave) * 64 + lane] = (f32x2){xr, xi};
#endif
            __syncthreads();
            float sr = 0.f, si = 0.f;
            for (int w2 = 0; w2 < wave; ++w2) { const f32x2 e = carry[w2 * 64 + lane]; const float nr = a256.x * sr - a256.y * si + e.x, ni = a256.x * si + a256.y * sr + e.y; sr = nr; si = ni; }
            xr = sr; xi = si;
#ifdef MK_DEBUG2
            ((f32x2*)(ws + WS_END + 109 * MB))[((size_t)(b * 64 + g) * 8 + wave) * 64 + lane] = (f32x2){xr, xi};
#endif
        }
    }
    __syncthreads();
}

__device__ __forceinline__ void prep2_item(const Args& A, LAS unsigned char* wl, int item, int lane) {
    unsigned char* ws = A.ws;
    const bf16_t* proj = (const bf16_t*)(ws + WS_PROJ);
    const int pb = item & 31, h = (item >> 5) & 15, b = item >> 9, P0 = pb * 64;
    const int r8 = lane >> 3, c = lane & 7;
    const float* gq = A.in[3]; const float* gk = A.in[4];
#pragma unroll
    for (int which = 0; which < 2; ++which) {
        const float* gv = which ? gk : gq; const float cs = which ? 1.f : (LOG2E * 0.125f);
        float gl[8];
#pragma unroll
        for (int e = 0; e < 8; ++e) gl[e] = gv[8 * c + e] * cs;
        bf16_t* dst = (bf16_t*)(ws + (which ? WS_KN : WS_QN)) + ((size_t)(b * 16 + h) * SEQ + P0) * 64;
#pragma unroll
        for (int i = 0; i < 8; ++i) { const int row = 8 * i + r8;
            const u32x4 raw = *(const u32x4*)(proj + (size_t)(b * SEQ + P0 + row) * DPROJ + which * 1024 + h * 64 + 8 * c);
            float v[8] = {bflo(raw.x), bfhi(raw.x), bflo(raw.y), bfhi(raw.y), bflo(raw.z), bfhi(raw.z), bflo(raw.w), bfhi(raw.w)};
            float ss = 0.f;
#pragma unroll
            for (int e = 0; e < 8; ++e) ss += v[e] * v[e];
            ss += __shfl_xor(ss, 1); ss += __shfl_xor(ss, 2); ss += __shfl_xor(ss, 4);
            const float r = 1.0f / sqrtf(ss * (1.f / 64.f) + EPS);
            u32x4 w; w.x = cvt_pk_bf16(v[0] * r * gl[0], v[1] * r * gl[1]); w.y = cvt_pk_bf16(v[2] * r * gl[2], v[3] * r * gl[3]);
            w.z = cvt_pk_bf16(v[4] * r * gl[4], v[5] * r * gl[5]); w.w = cvt_pk_bf16(v[6] * r * gl[6], v[7] * r * gl[7]);
            *(u32x4*)(dst + (size_t)row * 64 + 8 * c) = w; }
    }
#pragma unroll
    for (int i = 0; i < 8; ++i) { const int row = 8 * i + r8;
        const u32x4 raw = *(const u32x4*)(proj + (size_t)(b * SEQ + P0 + row) * DPROJ + 2048 + h * 64 + 8 * c);
        *(LAS u32x2*)(wl + row * 136 + c * 16) = (u32x2){raw.x, raw.y}; *(LAS u32x2*)(wl + row * 136 + c * 16 + 8) = (u32x2){raw.z, raw.w}; }
    CBAR();
    unsigned v[64];
#pragma unroll
    for (int p = 0; p < 64; ++p) v[p] = *(const LAS unsigned short*)(wl + p * 136 + lane * 2);
    CBAR();
    bf16_t* vt = (bf16_t*)(ws + WS_VT);
    const size_t rowo = ((size_t)(b * 16 + h) * 64 + lane) * SEQ;
#pragma unroll
    for (int G = 0; G < 2; ++G)
#pragma unroll
        for (int kg = 0; kg < 4; ++kg) { const int a0 = 32 * G + 4 * kg, b0 = 32 * G + 16 + 4 * kg;
            u32x4 w; w.x = v[a0] | (v[a0 + 1] << 16); w.y = v[a0 + 2] | (v[a0 + 3] << 16); w.z = v[b0] | (v[b0 + 1] << 16); w.w = v[b0 + 2] | (v[b0 + 3] << 16);
            *(u32x4*)(vt + rowo + P0 + 32 * G + 8 * kg) = w; }
    { bf16_t* vt4 = vt + (size_t)4 * 16 * 64 * SEQ; const int l0 = P0 >> 2, tile = (l0 >> 4) & 1, grp = l0 >> 5;
#pragma unroll
        for (int r = 0; r < 4; ++r)
#pragma unroll
            for (int kg = 0; kg < 4; ++kg) { const int p0 = 4 * (4 * kg) + r;
                u32x2 w; w.x = v[p0] | (v[p0 + 4] << 16); w.y = v[p0 + 8] | (v[p0 + 12] << 16);
                *(u32x2*)(vt4 + rowo + r * 512 + 32 * grp + 8 * kg + 4 * tile) = w; } }
    { bf16_t* vt16 = vt + (size_t)2 * 4 * 16 * 64 * SEQ; const int l0 = P0 >> 4, w32 = l0 & 31, tile = (w32 >> 4) & 1, kg = (w32 & 15) >> 2, grp = l0 >> 5;
#pragma unroll
        for (int r = 0; r < 16; ++r) { u32x2 w; w.x = v[r] | (v[16 + r] << 16); w.y = v[32 + r] | (v[48 + r] << 16);
            *(u32x2*)(vt16 + rowo + r * 128 + 32 * grp + 8 * kg + 4 * tile) = w; } }
}

__device__ __forceinline__ void attn_unit(const Args& A, LAS unsigned char* lds, int unit, int tid, int wave, int lane) {
    unsigned char* ws = A.ws;
    const int blk = 7 - (unit >> 6), bh = unit & 63, b = bh >> 4, h = bh & 15, p0 = blk * 256;
    LAS float* Oacc = (LAS float*)lds; LAS float* lacc = (LAS float*)(lds + 65536); LAS float* tb = (LAS float*)(lds + 65536 + 1024);
    for (int i = tid; i < 256 * 64 + 256; i += 512) Oacc[i] = 0.f;
    { const float* bt = (const float*)(ws + WS_BTAB) + h * 3 * 192; for (int i = tid; i < 3 * 192; i += 512) tb[i] = bt[i]; }
    __syncthreads();
    const bf16_t* Qn = (const bf16_t*)(ws + WS_QN) + (size_t)bh * SEQ * 64;
    const bf16_t* Kn = (const bf16_t*)(ws + WS_KN) + (size_t)bh * SEQ * 64;
    const int qi = lane & 15, g = lane >> 4;
    for (int it = wave; it < 48; it += 8) {
        const int br = it >> 4, j = it & 15, sh = 2 * br, L = SEQ >> sh;
        int r, lfirst;
        if (br == 0) { r = 0; lfirst = p0 + 16 * j; } else if (br == 1) { r = j & 3; lfirst = (p0 >> 2) + 16 * (j >> 2); } else { r = j; lfirst = p0 >> 4; }
        const bf16_t* VT = (const bf16_t*)(ws + WS_VT) + (size_t)br * 4 * 16 * 64 * SEQ + (size_t)bh * 64 * SEQ + (size_t)r * L;
        const int qpos = ((lfirst + qi) << sh) + r;
        bf16x8 qf[2];
#pragma unroll
        for (int s = 0; s < 2; ++s) qf[s] = as_bf16x8(*(const u32x4*)(Qn + (size_t)qpos * 64 + 32 * s + 8 * g));
        f32x4 o[4];
#pragma unroll
        for (int nt = 0; nt < 4; ++nt) o[nt] = (f32x4){0.f, 0.f, 0.f, 0.f};
        float lsum = 0.f;
        const LAS float* tbb = tb + br * 192;
        int ks = (lfirst - 128) & ~31; if (ks < 0) ks = 0;
        for (int lk0 = ks; lk0 <= lfirst; lk0 += 32) {
            f32x4 sa = {0.f, 0.f, 0.f, 0.f}, sb = {0.f, 0.f, 0.f, 0.f};
            const int kpa = ((lk0 + qi) << sh) + r, kpb = ((lk0 + 16 + qi) << sh) + r;
#pragma unroll
            for (int s = 0; s < 2; ++s) {
                const bf16x8 ka = as_bf16x8(*(const u32x4*)(Kn + (size_t)kpa * 64 + 32 * s + 8 * g));
                const bf16x8 kb = as_bf16x8(*(const u32x4*)(Kn + (size_t)kpb * 64 + 32 * s + 8 * g));
                sa = MFMA16(ka, qf[s], sa); sb = MFMA16(kb, qf[s], sb); }
            const int ba = lfirst + qi - lk0 - 4 * g + 31;
            float pa[4], pb[4];
#pragma unroll
            for (int e = 0; e < 4; ++e) { pa[e] = __builtin_amdgcn_exp2f(sa[e] + tbb[ba - e]); pb[e] = __builtin_amdgcn_exp2f(sb[e] + tbb[ba - 16 - e]); }
            lsum += (pa[0] + pa[1]) + (pa[2] + pa[3]) + (pb[0] + pb[1]) + (pb[2] + pb[3]);
            u32x4 pw; pw.x = cvt_pk_bf16(pa[0], pa[1]); pw.y = cvt_pk_bf16(pa[2], pa[3]); pw.z = cvt_pk_bf16(pb[0], pb[1]); pw.w = cvt_pk_bf16(pb[2], pb[3]);
            const bf16x8 pf = as_bf16x8(pw);
#pragma unroll
            for (int nt = 0; nt < 4; ++nt) { const bf16x8 vf = as_bf16x8(*(const u32x4*)(VT + (size_t)(16 * nt + qi) * SEQ + lk0 + 8 * g)); o[nt] = MFMA16(pf, vf, o[nt]); }
        }
        lsum += __shfl_xor(lsum, 16); lsum += __shfl_xor(lsum, 32);
        if (g == 0) __hip_atomic_fetch_add(lacc + (qpos - p0), lsum, __ATOMIC_RELAXED, __HIP_MEMORY_SCOPE_WORKGROUP);
#pragma unroll
        for (int reg = 0; reg < 4; ++reg) { const int ql = (((lfirst + 4 * g + reg) << sh) + r) - p0;
#pragma unroll
            for (int nt = 0; nt < 4; ++nt) __hip_atomic_fetch_add(Oacc + ql * 64 + 16 * nt + qi, o[nt][reg], __ATOMIC_RELAXED, __HIP_MEMORY_SCOPE_WORKGROUP); }
    }
    __syncthreads();
    { const int ql = tid >> 1, half = tid & 1; const float inv = 1.0f / lacc[ql];
        bf16_t* dst = (bf16_t*)(ws + WS_MIXED) + (size_t)(b * SEQ + p0 + ql) * 2048 + h * 64 + 32 * half;
        float ss = 0.f;
#pragma unroll
        for (int c4 = 0; c4 < 4; ++c4) { float v[8];
#pragma unroll
            for (int e = 0; e < 8; ++e) { v[e] = Oacc[ql * 64 + 32 * half + 8 * c4 + e] * inv; ss += v[e] * v[e]; }
            u32x4 w; w.x = cvt_pk_bf16(v[0], v[1]); w.y = cvt_pk_bf16(v[2], v[3]); w.z = cvt_pk_bf16(v[4], v[5]); w.w = cvt_pk_bf16(v[6], v[7]);
            *(u32x4*)(dst + 8 * c4) = w; }
        ss += __shfl_xor(ss, 1);
        if (half == 0) unsafeAtomicAdd((float*)(ws + WS_CTL + CTL_RSS_ATTN) + b * SEQ + p0 + ql, ss); }
    __syncthreads();
}

__device__ __forceinline__ unsigned fkey(float f) { const unsigned u = __float_as_uint(f); return (u & 0x80000000u) ? ~u : (u | 0x80000000u); }
template <int R> __device__ __forceinline__ void select16(const unsigned (&key)[R], unsigned long long (&m)[R]) {
    unsigned T = 0u; int cnt = R * 64;
    for (int bit = 31; bit >= 0; --bit) { const unsigned cand = T | (1u << bit); int c = 0;
#pragma unroll
        for (int r = 0; r < R; ++r) c += __popcll(__ballot(key[r] >= cand));
        if (c >= 16) { T = cand; cnt = c; if (c == 16) break; } }
    if (cnt == 16) {
#pragma unroll
        for (int r = 0; r < R; ++r) m[r] = __ballot(key[r] >= T);
    } else {
        int need = 16;
#pragma unroll
        for (int r = 0; r < R; ++r) { m[r] = __ballot(key[r] > T); need -= __popcll(m[r]); }
#pragma unroll
        for (int r = 0; r < R; ++r) { unsigned long long eq = __ballot(key[r] == T);
            while (__popcll(eq) > need) eq &= ~(1ull << (63 - __builtin_clzll(eq)));
            need -= __popcll(eq); m[r] |= eq; }
    }
}
__device__ __forceinline__ void peer_topk(const float* sp, LAS float* sc, LAS int* exo, LAS float* gto, int lane) {
    LAS float* v1 = sc; LAS int* i1 = (LAS int*)(sc + 16); LAS float* v2 = sc + 32; LAS int* i2 = (LAS int*)(sc + 48); LAS float* sv = sc + 64; LAS int* si = (LAS int*)(sc + 80);
    const unsigned long long lt = (1ull << lane) - 1ull;
#pragma unroll
    for (int half = 0; half < 2; ++half) {
        const float a0 = sp[half * 128 + lane], a1 = sp[half * 128 + 64 + lane];
        const unsigned key[2] = {fkey(a0), fkey(a1)}; unsigned long long m[2];
        select16<2>(key, m);
        LAS float* vv = half ? v2 : v1; LAS int* ii = half ? i2 : i1;
        if ((m[0] >> lane) & 1ull) { const int pos = __popcll(m[0] & lt); vv[pos] = a0; ii[pos] = lane; }
        if ((m[1] >> lane) & 1ull) { const int pos = __popcll(m[0]) + __popcll(m[1] & lt); vv[pos] = a1; ii[pos] = 64 + lane; }
    }
    CBAR(); LDS_WAIT();
    const int a = lane >> 2, bb = (lane & 3) * 4;
    const float va = v1[a]; float cv[4]; unsigned key[4]; unsigned long long m[4];
#pragma unroll
    for (int e = 0; e < 4; ++e) { cv[e] = va + v2[bb + e]; key[e] = fkey(cv[e]); }
    select16<4>(key, m);
    int base = 0;
#pragma unroll
    for (int e = 0; e < 4; ++e) { if ((m[e] >> lane) & 1ull) { const int pos = base + __popcll(m[e] & lt); sv[pos] = cv[e]; si[pos] = a * 16 + bb + e; } base += __popcll(m[e]); }
    CBAR(); LDS_WAIT();
    if (lane < 16) {
        const float val = sv[lane]; const int fi = si[lane];
        float mx = val;
#pragma unroll
        for (int o = 1; o < 16; o <<= 1) mx = fmaxf(mx, __shfl_xor(mx, o));
        const float ex = expf(val - mx); float sum = ex;
#pragma unroll
        for (int o = 1; o < 16; o <<= 1) sum += __shfl_xor(sum, o);
        exo[lane] = i1[fi >> 4] * 128 + (i2[fi & 15] - 0);
        gto[lane] = ex / sum;
    }
    CBAR(); LDS_WAIT();
}

__device__ __forceinline__ float dot2bf(unsigned k, unsigned q, float acc) { return __builtin_amdgcn_fdot2_f32_bf16(__builtin_bit_cast(bf16x2v, k), __builtin_bit_cast(bf16x2v, q), acc, false); }
constexpr int PD = 4;
__device__ __forceinline__ void peer_wave(const Args& A, LAS unsigned char* lds, int wave, int lane) {
    unsigned char* ws = A.ws;
    const float* scores = (const float*)(ws + WS_PROJ);
    const bf16_t* ub = (const bf16_t*)(ws + WS_UB); const bf16_t* vb = (const bf16_t*)(ws + WS_VB); const bf16_t* x1b = (const bf16_t*)(ws + WS_HB);
    const float* rssx = (const float*)(ws + WS_CTL + CTL_RSS_X1);
    LAS int* exl = (LAS int*)(lds + wave * 4096);
    LAS float* gtl = (LAS float*)(lds + wave * 4096 + 2048);
    LAS float* sc = (LAS float*)(lds + 32768 + wave * 512);
    const int t0 = (blockIdx.x * 8 + wave) * 4;
    if (t0 >= NTOK) return;
    for (int tok = 0; tok < 4; ++tok)
        for (int h = 0; h < 8; ++h) peer_topk(scores + (size_t)(t0 + tok) * 2048 + h * 256, sc, exl + tok * 128 + h * 16, gtl + tok * 128 + h * 16, lane);
    CBAR(); LDS_WAIT();
#ifdef MK_DEBUG
    for (int i = lane; i < 512; i += 64) { ((int*)(ws + WS_END + 100 * MB))[(size_t)t0 * 128 + i] = exl[i]; ((float*)(ws + WS_END + 104 * MB))[(size_t)t0 * 128 + i] = gtl[i]; }
#endif
    u32x4 buf[PD][4];
#define ROWPTR(s) (((s) & 128 ? vb : ub) + (size_t)exl[((s) >> 8) * 128 + ((s) & 127)] * 2048 + 8 * lane)
#define ISSUE(slot, s) do { const bf16_t* _p = ROWPTR(s); _Pragma("unroll") for (int _j = 0; _j < 4; ++_j) buf[slot][_j] = *(const u32x4*)(_p + 512 * _j); } while (0)
#pragma unroll
    for (int i = 0; i < PD; ++i) ISSUE(i, i);
    for (int tok = 0; tok < 4; ++tok) {
        const int t = t0 + tok;
        u32x4 xq[4];
#pragma unroll
        for (int j = 0; j < 4; ++j) xq[j] = *(const u32x4*)(x1b + (size_t)t * 2048 + 8 * lane + 512 * j);
        const float r2 = 1.0f / sqrtf(rssx[t] * (1.f / 2048.f) + EPS);
        float a0 = 0.f, a1 = 0.f;
        for (int k0 = 0; k0 < 128; k0 += PD) {
#pragma unroll
            for (int i = 0; i < PD; ++i) {
                const int k = k0 + i, s = tok * 256 + k;
                float p = 0.f;
#pragma unroll
                for (int j = 0; j < 4; ++j) {
                    p = dot2bf(buf[i][j].x, xq[j].x, p); p = dot2bf(buf[i][j].y, xq[j].y, p); p = dot2bf(buf[i][j].z, xq[j].z, p); p = dot2bf(buf[i][j].w, xq[j].w, p); }
                if (s + PD < 4 * 256) ISSUE(i, s + PD);
                p = wave_sum(p);
                if (k < 64) a0 = (lane == k) ? p : a0; else a1 = (lane == k - 64) ? p : a1;
            }
        }
        const float w0 = gtl[tok * 128 + lane] * gelu_erf(a0 * r2), w1 = gtl[tok * 128 + 64 + lane] * gelu_erf(a1 * r2);
        float acc[32];
#pragma unroll
        for (int i = 0; i < 32; ++i) acc[i] = 0.f;
        for (int k0 = 0; k0 < 128; k0 += PD) {
#pragma unroll
            for (int i = 0; i < PD; ++i) {
                const int k = k0 + i, s = tok * 256 + 128 + k;
                const float w = __builtin_bit_cast(float, __builtin_amdgcn_readlane(__builtin_bit_cast(int, k < 64 ? w0 : w1), k & 63));
#pragma unroll
                for (int j = 0; j < 4; ++j) {
                    acc[8 * j + 0] += w * bflo(buf[i][j].x); acc[8 * j + 1] += w * bfhi(buf[i][j].x);
                    acc[8 * j + 2] += w * bflo(buf[i][j].y); acc[8 * j + 3] += w * bfhi(buf[i][j].y);
                    acc[8 * j + 4] += w * bflo(buf[i][j].z); acc[8 * j + 5] += w * bfhi(buf[i][j].z);
                    acc[8 * j + 6] += w * bflo(buf[i][j].w); acc[8 * j + 7] += w * bfhi(buf[i][j].w); }
                if (s + PD < 4 * 256) ISSUE(i, s + PD);
            }
        }
        float* op = A.out + (size_t)t * 2048 + 8 * lane;
#pragma unroll
        for (int j = 0; j < 4; ++j) {
            const f32x4 x0 = *(const f32x4*)(op + 512 * j), x1 = *(const f32x4*)(op + 512 * j + 4);
            *(f32x4*)(op + 512 * j) = x0 + (f32x4){acc[8 * j], acc[8 * j + 1], acc[8 * j + 2], acc[8 * j + 3]};
            *(f32x4*)(op + 512 * j + 4) = x1 + (f32x4){acc[8 * j + 4], acc[8 * j + 5], acc[8 * j + 6], acc[8 * j + 7]}; }
    }
#undef ROWPTR
#undef ISSUE
}

__global__ void __launch_bounds__(512, 2) mk_fwd(Args args) {
    extern __shared__ __attribute__((aligned(16))) unsigned char lds_raw[];
    LAS unsigned char* lds = (LAS unsigned char*)lds_raw;
    const int tid = threadIdx.x, lane = tid & 63, wave = __builtin_amdgcn_readfirstlane(tid >> 6);
    volatile LAS unsigned* MISC = (volatile LAS unsigned*)(lds + MISC_OFF);
    if (tid < 64) MISC[tid] = 0u;
    __syncthreads();
    unsigned char* ws = args.ws;
    const int lo = args.ph_lo, hi = args.ph_hi;
    XcdBarrier bar; bar.bar = (unsigned*)(ws + WS_CTL); bar.x = 0; bar.st = nullptr;
    if (hi - lo > 1) bar = xcd_barrier_post((unsigned*)(ws + WS_CTL), MISC + 8);
#ifndef PH_MASK
#define PH_MASK 0x7f
#endif
#define IN(k) (((PH_MASK >> (k)) & 1) && lo <= (k) && (k) < hi)
#define SEAM(k) do { if (IN(k) && IN((k) + 1)) xcd_barrier(bar); } while (0)

    if (IN(0)) { p0_prologue(args, lds, wave, lane); }
    SEAM(0);
    if (IN(1)) {
        pg8::Gemm g{(const bf16_t*)(ws + WS_HB), (const bf16_t*)(ws + WS_WINT), NTOK, DPROJ, DM}; pg8::StaticOrder S; S.init(NTOK, DPROJ, gridDim.x, (int)blockIdx.x);
        pg8::EpiProj E{(bf16_t*)(ws + WS_PROJ), DPROJ};
        pg8::gemm_phase<pg8::EpiProj, pg8::StaticOrder, false>(lds, g, S, E, nullptr);
    }
    SEAM(1);
    if (IN(2)) {
        for (int u = blockIdx.x; u < 256; u += gridDim.x) ssm_unit(args, lds, u >> 6, u & 63, wave, lane);
        for (int it = blockIdx.x * 8 + wave; it < 2048; it += gridDim.x * 8) prep2_item(args, lds + wave * SSM_WL, it, lane);
    }
    SEAM(2);
    if (IN(3)) {
        {
            pg8::Gemm g{(const bf16_t*)(ws + WS_YB), (const bf16_t*)(ws + WS_GLUT), NTOK, 1024, 1024}; pg8::StaticOrder S; S.init(NTOK, 1024, gridDim.x, (int)blockIdx.x);
            pg8::EpiGlu E{(const bf16_t*)(ws + WS_YB), (bf16_t*)(ws + WS_MIXED) + 1024, args.in[15], (float*)(ws + WS_CTL + CTL_RSS_SSM)};
            pg8::gemm_phase<pg8::EpiGlu, pg8::StaticOrder, false>(lds, g, S, E, nullptr);
        }
        __syncthreads();
        for (;;) {
            if (tid == 0) MISC[0] = atomicAdd((unsigned*)(ws + WS_CTL + CTL_QCTR), 1u);
            __syncthreads();
            const unsigned u = MISC[0];
            __syncthreads();
            if (u >= 512u) break;
            attn_unit(args, lds, (int)u, tid, wave, lane);
        }
    }
    SEAM(3);
    if (IN(4)) {
        pg8::Gemm g{(const bf16_t*)(ws + WS_MIXED), (const bf16_t*)(ws + WS_WOUTT), NTOK, DM, DM}; pg8::StaticOrder S; S.init(NTOK, DM, gridDim.x, (int)blockIdx.x);
        LAS float* tab = (LAS float*)(lds + 131072);
        { pg8::Unit u0; if (S.next(0, u0) && tid < 256) { const int row = u0.pm * 256 + tid;
            const float ra = 1.0f / sqrtf(((const float*)(ws + WS_CTL + CTL_RSS_ATTN))[row] * (1.f / 1024.f) + EPS), rs = 1.0f / sqrtf(((const float*)(ws + WS_CTL + CTL_RSS_SSM))[row] * (1.f / 1024.f) + EPS);
            tab[tid] = ra / rs; tab[256 + tid] = rs; } }
        __syncthreads();
        pg8::EpiWout E{args.in[0], args.out, (bf16_t*)(ws + WS_HB), (float*)(ws + WS_CTL + CTL_RSS_X1), tab};
        pg8::gemm_phase<pg8::EpiWout, pg8::StaticOrder, false>(lds, g, S, E, nullptr);
    }
    SEAM(4);
    if (IN(5)) {
        pg8::Gemm g{(const bf16_t*)(ws + WS_HB), (const bf16_t*)(ws + WS_WPT), NTOK, DM, DM}; pg8::StaticOrder S; S.init(NTOK, DM, gridDim.x, (int)blockIdx.x);
        pg8::EpiScores E{(float*)(ws + WS_PROJ), (const float*)(ws + WS_CTL + CTL_RSS_X1)};
        pg8::gemm_phase<pg8::EpiScores, pg8::StaticOrder, false>(lds, g, S, E, nullptr);
    }
    SEAM(5);
    if (IN(6)) { peer_wave(args, lds, wave, lane); }
#undef IN
#undef SEAM
}

#ifndef MK_DEBUG
#ifndef MK_PER_PHASE
#define MK_PER_PHASE 0
#endif
extern "C" void kernel_launch(void* const* d_in, const int* in_sizes, int n_in, void* d_out, int out_size, void* d_ws, size_t ws_size, hipStream_t stream) {
    static int grid = 0;
    if (grid == 0) {
        if (n_in != 25 || out_size != NTOK * DM || ws_size < WS_END) { fprintf(stderr, "kernel_launch: unexpected shapes / workspace (%d inputs, out %d, ws %zu < %zu)\n", n_in, out_size, ws_size, (size_t)WS_END); grid = -1; return; }
        int dev = 0, cus = 0, per_cu = 0;
        if (hipGetDevice(&dev) != hipSuccess || hipDeviceGetAttribute(&cus, hipDeviceAttributeMultiprocessorCount, dev) != hipSuccess) { grid = -1; return; }
        if (hipFuncSetAttribute((const void*)mk_fwd, hipFuncAttributeMaxDynamicSharedMemorySize, LDS_BYTES) != hipSuccess) { fprintf(stderr, "kernel_launch: hipFuncSetAttribute failed\n"); grid = -1; return; }
        if (hipOccupancyMaxActiveBlocksPerMultiprocessor(&per_cu, (const void*)mk_fwd, 512, LDS_BYTES) != hipSuccess || per_cu < 1) { fprintf(stderr, "kernel_launch: occupancy query reports %d\n", per_cu); }
        (void)hipGetLastError();
        grid = cus;
    }
    if (grid < 0) return;
    (void)hipMemsetAsync((char*)d_ws + WS_CTL, 0, CTL_BYTES, stream);
    Args a{};
    for (int i = 0; i < 25; ++i) a.in[i] = (const float*)d_in[i];
    a.out = (float*)d_out; a.ws = (unsigned char*)d_ws;
#if MK_PER_PHASE
    for (int p = 0; p < 7; ++p) { a.ph_lo = p; a.ph_hi = p + 1; hipLaunchKernelGGL(mk_fwd, dim3(grid), dim3(512), LDS_BYTES, stream, a); }
#else
    a.ph_lo = 0; a.ph_hi = 7;
    hipLaunchKernelGGL(mk_fwd, dim3(grid), dim3(512), LDS_BYTES, stream, a);
#endif
}
#endif
```

```cpp
#include <hip/hip_runtime.h>
#include <stdint.h>
#include <stdio.h>

typedef unsigned short bf16_t;
typedef float f32x2 __attribute__((ext_vector_type(2)));
typedef unsigned u32x2 __attribute__((ext_vector_type(2)));
using bf16x2v = __attribute__((ext_vector_type(2))) __bf16;

constexpr int NTOK = 8192, SEQ = 2048, DM = 2048, DPROJ = 4096;
constexpr float EPS = 1e-6f;
constexpr float LOG2E = 1.4426950408889634f;

constexpr size_t MB = 1024 * 1024;
constexpr size_t WS_CTL = 0;
constexpr size_t CTL_BYTES = 128 * 1024;
constexpr size_t CTL_QCTR = 16384;
constexpr size_t CTL_RSS_ATTN = 32768, CTL_RSS_SSM = 65536, CTL_RSS_X1 = 98304;
constexpr size_t WS_HB = 256 * 1024;
constexpr size_t WS_WINT = WS_HB + 32 * MB;
constexpr size_t WS_GLUT = WS_WINT + 16 * MB;
constexpr size_t WS_WOUTT = WS_GLUT + 2 * MB;
constexpr size_t WS_WPT = WS_WOUTT + 8 * MB;
constexpr size_t WS_UB = WS_WPT + 8 * MB;
constexpr size_t WS_VB = WS_UB + 32 * MB;
constexpr size_t WS_SU = WS_VB + 32 * MB;
constexpr size_t WS_SV = WS_SU + 65536;
constexpr size_t WS_PROJ = WS_SV + 65536;
constexpr size_t WS_QN = WS_PROJ + 64 * MB;
constexpr size_t WS_KN = WS_QN + 16 * MB;
constexpr size_t WS_VT = WS_KN + 16 * MB;
constexpr size_t WS_YB = WS_VT + 48 * MB + 4096;
constexpr size_t WS_MIXED = WS_YB + 16 * MB;
constexpr size_t WS_SSMP = WS_MIXED + 32 * MB;
constexpr size_t SSMP_ABAR = 0, SSMP_A256 = 32768, SSMP_BFRAG = 65536, SSMP_CFRAG = 65536 + 524288;
constexpr size_t WS_BTAB = WS_SSMP + 1 * MB;
constexpr size_t WS_END = WS_BTAB + 64 * 1024;

constexpr int LDS_BYTES = 147456;
constexpr int MISC_OFF = 147456 - 256;
#define XB_TMO      128
#define XB_XCNT(j)  (256  + 64 * (j))
#define XB_XSUB(j)  (1280 + 64 * (j))
#define XB_XGEN(j)  (2304 + 64 * (j))
#define XB_TOP      3328
#define XB_TOPGEN   3392
#define XCD_BAR_WORDS 3456
#define XB_SPIN_CAP (1u << 18)
#define LAS __attribute__((address_space(3)))

__device__ __forceinline__ unsigned xb_ld(unsigned* p)              { return __hip_atomic_load(p, __ATOMIC_RELAXED, __HIP_MEMORY_SCOPE_AGENT); }
__device__ __forceinline__ unsigned xb_add(unsigned* p, unsigned v) { return __hip_atomic_fetch_add(p, v, __ATOMIC_RELAXED, __HIP_MEMORY_SCOPE_AGENT); }
__device__ __forceinline__ unsigned xb_xcc_id() { return (unsigned)__builtin_amdgcn_s_getreg((3 << 11) | 20) & 0xFu; }
#define XB_SPIN(cond, bar) do { unsigned _sp = 0; while (cond) { __builtin_amdgcn_s_sleep(1); \
    if ((++_sp & 255u) == 0u) { if (xb_ld(&(bar)[XB_TMO])) break; if (_sp > XB_SPIN_CAP) { atomicAdd(&(bar)[XB_TMO], 1u); break; } } } } while (0)

struct XcdBarrier {
    unsigned* bar; unsigned x;
    volatile LAS unsigned* st;
};

__device__ __forceinline__ XcdBarrier xcd_barrier_post(unsigned* bar, volatile LAS unsigned* st) {
    XcdBarrier b; b.bar = bar; b.x = xb_xcc_id(); b.st = st;
    if (threadIdx.x == 0) (void)xb_add(&bar[XB_XCNT(b.x)], 1u);
    return b;
}
__device__ __forceinline__ void xcd_barrier_complete(unsigned* bar, unsigned x, unsigned& nloc, unsigned& nx) {
    const unsigned G = gridDim.x * gridDim.y * gridDim.z;
    unsigned sum, cnt, mine, sp = 0u;
    for (;;) {
        sum = 0u; cnt = 0u; mine = 0u;
#pragma unroll
        for (unsigned j = 0; j < 16; ++j) { const unsigned c = xb_ld(&bar[XB_XCNT(j)]); sum += c; cnt += (c > 0u) ? 1u : 0u; mine = (j == x) ? c : mine; }
        if (sum == G) break;
        __builtin_amdgcn_s_sleep(1);
        if ((++sp & 255u) == 0u) { if (xb_ld(&bar[XB_TMO])) break; if (sp > XB_SPIN_CAP) { atomicAdd(&bar[XB_TMO], 1u); break; } }
    }
    nloc = mine > 0u ? mine : 1u; nx = cnt > 0u ? cnt : 1u;
}

__device__ __forceinline__ void xcd_barrier(const XcdBarrier& b) {
    asm volatile("s_waitcnt vmcnt(0)" ::: "memory");
    __syncthreads();
    if (threadIdx.x == 0) {
        unsigned* bar = b.bar;
        __builtin_amdgcn_s_waitcnt(0);
        unsigned nloc = b.st[0], nx = b.st[1];
        if (nloc == 0u) { xcd_barrier_complete(bar, b.x, nloc, nx); b.st[0] = nloc; b.st[1] = nx; }
        const unsigned old = xb_add(&bar[XB_XSUB(b.x)], 1u);
        const unsigned gen = old / nloc;
        if (old + 1u == (gen + 1u) * nloc) {
            __builtin_amdgcn_fence(__ATOMIC_RELEASE, "agent");
            asm volatile("s_waitcnt vmcnt(0)" ::: "memory");
            const unsigned og = xb_add(&bar[XB_TOP], 1u);
            const unsigned tg = og / nx;
            if (og + 1u == (tg + 1u) * nx) xb_add(&bar[XB_TOPGEN], 1u);
            else XB_SPIN(xb_ld(&bar[XB_TOPGEN]) == tg, bar);
            __builtin_amdgcn_fence(__ATOMIC_ACQUIRE, "agent");
            xb_add(&bar[XB_XGEN(b.x)], 1u);
            asm volatile("s_waitcnt vmcnt(0)" ::: "memory");
        } else {
            XB_SPIN(xb_ld(&bar[XB_XGEN(b.x)]) == gen, bar);
            __builtin_amdgcn_fence(__ATOMIC_ACQUIRE, "agent");
            asm volatile("s_waitcnt vmcnt(0)" ::: "memory");
        }
    }
    __syncthreads();
}
namespace pg8 {
#define PG8_LAS __attribute__((address_space(3)))
typedef unsigned short bf16_t;
typedef short bf16x8 __attribute__((ext_vector_type(8)));
typedef float f32x4 __attribute__((ext_vector_type(4)));
typedef unsigned u32x4 __attribute__((ext_vector_type(4)));
constexpr int BM = 256, BK = 64, HALF = 128, HTB = HALF * BK * 2  , STAGE_BYTES = 8 * HTB, NXCD = 8, WGM = 8;

__host__ __device__ __forceinline__ int lds_byte(int r, int c) { const int st = (r >> 4) * 2 + (c >> 5), rr = r & 15, cc = c & 31, ob = rr * 64 + cc * 2; return st * 1024 + (ob ^ (((ob >> 9) & 1) << 5)); }
__host__ __device__ __forceinline__ void stage_rc(int b, int& R, int& C) { const int st = b / 1024, sb = b % 1024, swz = sb ^ (((sb >> 9) & 1) << 5); R = (st >> 1) * 16 + swz / 64; C = (st & 1) * 32 + (swz % 64) / 2; }
__host__ __device__ __forceinline__ int perm32(int rho) { const int n = rho >> 4, i = rho & 15; return 8 * (i >> 2) + 4 * n + (i & 3); }

struct Unit { int pm, pn; };
struct Gemm { const bf16_t* A; const bf16_t* Bt; int M, N, K; };

struct StaticOrder {
    int nM, nN, nwg, G, c;
    __host__ __device__ void init(int M, int N, int G_, int c_) { nM = M / BM; nN = N / BM; nwg = nM * nN; G = G_; c = c_; }
    __host__ __device__ bool next(int i, Unit& u) const {
        const long L = (long)i * G + c; if (L >= nwg) return false;
        int wgid = (int)L; { const int q = nwg / NXCD, r = nwg % NXCD, xcd = wgid % NXCD, off = wgid / NXCD; wgid = (xcd < r ? xcd * (q + 1) : r * (q + 1) + (xcd - r) * q) + off; }
        const int nig = WGM * nN, gid = wgid / nig, fm = gid * WGM, gsz = (nM - fm) < WGM ? (nM - fm) : WGM;
        u.pm = fm + ((wgid % nig) % gsz); u.pn = (wgid % nig) / gsz; return true;
    }
    __device__ __forceinline__ void a_ready(const Unit&) const {}
    __device__ __forceinline__ void done(const Unit&) const {}
};
typedef float cvt_f32x2 __attribute__((ext_vector_type(2)));
typedef __bf16 cvt_bf16x2 __attribute__((ext_vector_type(2)));
__device__ __forceinline__ unsigned cvt_pk_bf16(float lo, float hi) { return __builtin_bit_cast(unsigned, __builtin_convertvector((cvt_f32x2){lo, hi}, cvt_bf16x2)); }
__device__ __forceinline__ float bflo(unsigned u) { return __uint_as_float(u << 16); }
__device__ __forceinline__ float bfhi(unsigned u) { return __uint_as_float(u & 0xffff0000u); }

struct EpiProj {
    static constexpr bool PERM = true, AFTER_DRAIN = false, HAS_MID = false;
    bf16_t* O; int ldc;
    __device__ __forceinline__ void mid(f32x4 (&)[2][2][4][2], const Unit&, int, int, int, int) const {}
    __device__ __forceinline__ void operator()(const f32x4 (&acc)[2][2][4][2], const Unit& u, int wr, int wc, int fr, int fq) const {
        const int row0 = u.pm * BM + wr * 64 + fr, col0 = u.pn * BM + wc * 32 + 8 * fq;
#pragma unroll
        for (int ai = 0; ai < 2; ++ai)
#pragma unroll
            for (int m = 0; m < 4; ++m) { bf16_t* rowp = O + (size_t)(row0 + ai * HALF + m * 16) * ldc + col0;
#pragma unroll
                for (int bj = 0; bj < 2; ++bj) { const f32x4 v0 = acc[ai][bj][m][0], v1 = acc[ai][bj][m][1];
                    u32x4 w; w.x = cvt_pk_bf16(v0[0], v0[1]); w.y = cvt_pk_bf16(v0[2], v0[3]); w.z = cvt_pk_bf16(v1[0], v1[1]); w.w = cvt_pk_bf16(v1[2], v1[3]);
                    *(u32x4*)(rowp + bj * HALF) = w; } }
    }
};

struct EpiGlu {
    static constexpr bool PERM = true, AFTER_DRAIN = false, HAS_MID = false;
    const bf16_t* Y; bf16_t* O; const float* bias; float* rss;
    __device__ __forceinline__ void mid(f32x4 (&)[2][2][4][2], const Unit&, int, int, int, int) const {}
    __device__ __forceinline__ void operator()(const f32x4 (&acc)[2][2][4][2], const Unit& u, int wr, int wc, int fr, int fq) const {
        const int row0 = u.pm * BM + wr * 64 + fr, col0 = u.pn * BM + wc * 32 + 8 * fq;
        f32x4 bv[2][2];
#pragma unroll
        for (int bj = 0; bj < 2; ++bj)
#pragma unroll
            for (int n = 0; n < 2; ++n) bv[bj][n] = *(const f32x4*)(bias + col0 + bj * HALF + 4 * n);
#pragma unroll
        for (int ai = 0; ai < 2; ++ai)
#pragma unroll
            for (int m = 0; m < 4; ++m) { const int row = row0 + ai * HALF + m * 16; float ss = 0.f;
#pragma unroll
                for (int bj = 0; bj < 2; ++bj) {
                    const u32x4 yv = *(const u32x4*)(Y + (size_t)row * 1024 + col0 + bj * HALF);
                    const f32x4 g0 = acc[ai][bj][m][0] + bv[bj][0], g1 = acc[ai][bj][m][1] + bv[bj][1];
                    float y[8] = {bflo(yv.x), bfhi(yv.x), bflo(yv.y), bfhi(yv.y), bflo(yv.z), bfhi(yv.z), bflo(yv.w), bfhi(yv.w)};
                    float o[8];
#pragma unroll
                    for (int e = 0; e < 4; ++e) { o[e] = y[e] * __builtin_amdgcn_rcpf(1.f + __expf(-g0[e])); o[4 + e] = y[4 + e] * __builtin_amdgcn_rcpf(1.f + __expf(-g1[e])); }
#pragma unroll
                    for (int e = 0; e < 8; ++e) ss += o[e] * o[e];
                    u32x4 w; w.x = cvt_pk_bf16(o[0], o[1]); w.y = cvt_pk_bf16(o[2], o[3]); w.z = cvt_pk_bf16(o[4], o[5]); w.w = cvt_pk_bf16(o[6], o[7]);
                    *(u32x4*)(O + (size_t)row * 2048 + col0 + bj * HALF) = w; }
                ss += __shfl_xor(ss, 16); ss += __shfl_xor(ss, 32);
                if (fq == 0) unsafeAtomicAdd(rss + row, ss); }
    }
};

struct EpiWout {
    static constexpr bool PERM = true, AFTER_DRAIN = false, HAS_MID = true;
    const float* X; float* OUT; bf16_t* XB; float* rss_x; const PG8_LAS float* tab;
    __device__ __forceinline__ void mid(f32x4 (&acc)[2][2][4][2], const Unit& u, int wr, int wc, int fr, int fq) const {
        const PG8_LAS float* tp = tab + wr * 64 + fr;
#pragma unroll
        for (int ai = 0; ai < 2; ++ai)
#pragma unroll
            for (int m = 0; m < 4; ++m) { const float ratio = tp[ai * HALF + m * 16];
#pragma unroll
                for (int bj = 0; bj < 2; ++bj)
#pragma unroll
                    for (int n = 0; n < 2; ++n) acc[ai][bj][m][n] *= ratio; }
    }
    __device__ __forceinline__ void operator()(const f32x4 (&acc)[2][2][4][2], const Unit& u, int wr, int wc, int fr, int fq) const {
        const int row0 = u.pm * BM + wr * 64 + fr, col0 = u.pn * BM + wc * 32 + 8 * fq;
        const PG8_LAS float* tp = tab + 256 + wr * 64 + fr;
#pragma unroll
        for (int ai = 0; ai < 2; ++ai)
#pragma unroll
            for (int m = 0; m < 4; ++m) { const int row = row0 + ai * HALF + m * 16; float ss = 0.f;
                const float rs = tp[ai * HALF + m * 16];
#pragma unroll
                for (int bj = 0; bj < 2; ++bj) { const size_t o = (size_t)row * 2048 + col0 + bj * HALF;
                    const f32x4 x0 = *(const f32x4*)(X + o), x1 = *(const f32x4*)(X + o + 4);
                    const f32x4 v0 = x0 + rs * acc[ai][bj][m][0], v1 = x1 + rs * acc[ai][bj][m][1];
                    *(f32x4*)(OUT + o) = v0; *(f32x4*)(OUT + o + 4) = v1;
                    u32x4 w; w.x = cvt_pk_bf16(v0[0], v0[1]); w.y = cvt_pk_bf16(v0[2], v0[3]); w.z = cvt_pk_bf16(v1[0], v1[1]); w.w = cvt_pk_bf16(v1[2], v1[3]);
                    *(u32x4*)(XB + o) = w;
#pragma unroll
                    for (int e = 0; e < 4; ++e) ss += v0[e] * v0[e] + v1[e] * v1[e]; }
                ss += __shfl_xor(ss, 16); ss += __shfl_xor(ss, 32);
                if (fq == 0) unsafeAtomicAdd(rss_x + row, ss); }
    }
};

struct EpiScores {
    static constexpr bool PERM = false, AFTER_DRAIN = false, HAS_MID = false;
    float* C; const float* rss_x;
    __device__ __forceinline__ void mid(f32x4 (&)[2][2][4][2], const Unit&, int, int, int, int) const {}
    __device__ __forceinline__ void operator()(const f32x4 (&acc)[2][2][4][2], const Unit& u, int wr, int wc, int fr, int fq) const {
        const int row0 = u.pm * BM + wr * 64 + fr, col0 = u.pn * BM + wc * 32 + 4 * fq;
#pragma unroll
        for (int ai = 0; ai < 2; ++ai)
#pragma unroll
            for (int m = 0; m < 4; ++m) { const int row = row0 + ai * HALF + m * 16;
                const float r2 = __builtin_amdgcn_rsqf(rss_x[row] * (1.f / 2048.f) + 1e-6f);
                float* rowp = C + (size_t)row * 2048 + col0;
#pragma unroll
                for (int bj = 0; bj < 2; ++bj)
#pragma unroll
                    for (int n = 0; n < 2; ++n) *(f32x4*)(rowp + bj * HALF + n * 16) = acc[ai][bj][m][n] * r2; }
    }
};

template <class Epi, class Sched, bool STAMP = false>
__device__ __forceinline__ void gemm_phase(PG8_LAS unsigned char* lds, const Gemm g, const Sched& S, const Epi& E, unsigned long long* stamps) {
    const int tid = threadIdx.x, wid = __builtin_amdgcn_readfirstlane(tid >> 6), lane = tid & 63, wr = wid >> 2, wc = wid & 3, fr = lane & 15, fq = lane >> 4;
    const int K = g.K, nt = K / BK;
    int ts_lo = 0, ts_hi = 0, nts = 0; const unsigned long long rt_entry = STAMP ? (unsigned long long)wall_clock64() : 0ull;
#define PG8_STAMP() do { if (STAMP && wid == 0 && nts < 64) { const unsigned long long _c = (unsigned long long)clock64(); \
        ts_lo = (lane == nts) ? (int)(unsigned)_c : ts_lo; ts_hi = (lane == nts) ? (int)(unsigned)(_c >> 32) : ts_hi; ++nts; } } while (0)
    PG8_STAMP();
    unsigned voffA[2], voffB[2];
#pragma unroll
    for (int i = 0; i < 2; ++i) { int R, C; stage_rc(tid * 16 + i * 8192, R, C); const int Rb = Epi::PERM ? ((R & ~31) + perm32(R & 31)) : R;
        voffA[i] = (unsigned)(R * K + C) * 2u; voffB[i] = (unsigned)(Rb * K + C) * 2u; }
    const size_t kstep = (size_t)(BK * 2);
    const size_t hstep = (size_t)HALF * K * 2;
    const size_t tstep = 2 * hstep;
    const unsigned ldsw = (unsigned)wid * 1024u;
    const int aoff = lds_byte(wr * 64 + fr, fq * 8), boff = lds_byte(wc * 32 + fr, fq * 8);
#define PG8_SA(b, h) (((b) * 2 + (h)) * HTB)
#define PG8_SB(b, h) ((4 + (b) * 2 + (h)) * HTB)
#define PG8_STAGE(bufoff, gbase, voff) do { _Pragma("unroll") for (int _i = 0; _i < 2; ++_i) \
        __builtin_amdgcn_global_load_lds((const unsigned*)((const char*)(gbase) + (voff)[_i]), (PG8_LAS unsigned*)(lds + (bufoff) + ldsw + _i * 8192), 16, 0, 0); } while (0)
#define PG8_LDA(dst, b, h) do { _Pragma("unroll") for (int m = 0; m < 4; ++m) _Pragma("unroll") for (int k = 0; k < 2; ++k) dst[m][k] = *(const PG8_LAS bf16x8*)(lds + PG8_SA(b, h) + aoff + m * 2048 + k * 1024); } while (0)
#define PG8_LDB(dst, b, h) do { _Pragma("unroll") for (int n = 0; n < 2; ++n) _Pragma("unroll") for (int k = 0; k < 2; ++k) dst[n][k] = *(const PG8_LAS bf16x8*)(lds + PG8_SB(b, h) + boff + n * 2048 + k * 1024); } while (0)
#define PG8_MMA(ai, bj, At, Bt) do { __builtin_amdgcn_s_setprio(1); _Pragma("unroll") for (int m = 0; m < 4; ++m) _Pragma("unroll") for (int n = 0; n < 2; ++n) _Pragma("unroll") for (int k = 0; k < 2; ++k) \
        acc[ai][bj][m][n] = __builtin_amdgcn_mfma_f32_16x16x32_bf16(Bt[n][k], At[m][k], acc[ai][bj][m][n], 0, 0, 0); __builtin_amdgcn_s_setprio(0); } while (0)
#define PG8_WAIT_V(n) asm volatile("s_waitcnt vmcnt(" #n ")" ::: "memory")
#define PG8_WAIT_L(n) asm volatile("s_waitcnt lgkmcnt(" #n ")" ::: "memory")
#define PG8_BAR __builtin_amdgcn_s_barrier()
#define PG8_SCHED __builtin_amdgcn_sched_barrier(0)
    Unit cur, nxt; int ui = 0;
    if (!S.next(0, cur)) return;
    f32x4 acc[2][2][4][2];
#pragma unroll
    for (int a = 0; a < 2; ++a)
#pragma unroll
        for (int b = 0; b < 2; ++b)
#pragma unroll
            for (int m = 0; m < 4; ++m)
#pragma unroll
                for (int n = 0; n < 2; ++n) acc[a][b][m][n] = (f32x4){0.f, 0.f, 0.f, 0.f};
    bf16x8 At[4][2], B0[2][2], B1[2][2];
    const char* cA = (const char*)g.A + (size_t)cur.pm * tstep; const char* cB = (const char*)g.Bt + (size_t)cur.pn * tstep;
    S.a_ready(cur);
    PG8_STAGE(PG8_SB(0, 0), cB, voffB); PG8_STAGE(PG8_SA(0, 0), cA, voffA); PG8_STAGE(PG8_SB(0, 1), cB + hstep, voffB); PG8_STAGE(PG8_SA(0, 1), cA + hstep, voffA);
    if (wr == 1) PG8_BAR;
    PG8_WAIT_V(4); PG8_BAR;
    PG8_STAGE(PG8_SB(1, 0), cB + kstep, voffB); PG8_STAGE(PG8_SA(1, 0), cA + kstep, voffA); PG8_STAGE(PG8_SB(1, 1), cB + hstep + kstep, voffB);
    PG8_WAIT_V(6); PG8_BAR;
    PG8_STAMP();
    for (;;) {
        const bool has_next = S.next(ui + 1, nxt);
        const char* nA = has_next ? (const char*)g.A + (size_t)nxt.pm * tstep : cA; const char* nB = has_next ? (const char*)g.Bt + (size_t)nxt.pn * tstep : cB;
        for (int t = 0; t < nt; t += 2) {
            const bool last = (t == nt - 2);
            const char* a1 = cA + (size_t)(t + 1) * kstep;
            const char* a2 = last ? nA : cA + (size_t)(t + 2) * kstep; const char* b2 = last ? nB : cB + (size_t)(t + 2) * kstep;
            const char* a3 = a2 + kstep; const char* b3 = b2 + kstep;
            if (last && has_next) S.a_ready(nxt);
            if constexpr (Epi::HAS_MID) { if (t == (nt >> 1)) { E.mid(acc, cur, wr, wc, fr, fq); asm volatile("s_waitcnt lgkmcnt(0)" ::: "memory"); } }
            PG8_LDB(B0, 0, 0); PG8_SCHED; PG8_LDA(At, 0, 0); PG8_STAGE(PG8_SA(1, 1), a1 + hstep, voffA);
            PG8_WAIT_L(8); PG8_BAR; PG8_WAIT_L(0); PG8_MMA(0, 0, At, B0); PG8_BAR; PG8_SCHED;
            PG8_LDB(B1, 0, 1); PG8_STAGE(PG8_SB(0, 0), b2, voffB);
            PG8_BAR; PG8_WAIT_L(0); PG8_MMA(0, 1, At, B1); PG8_BAR;
            PG8_LDA(At, 0, 1); PG8_STAGE(PG8_SA(0, 0), a2, voffA);
            PG8_BAR; PG8_WAIT_L(0); PG8_MMA(1, 0, At, B0); PG8_BAR; PG8_SCHED;
            PG8_STAGE(PG8_SB(0, 1), b2 + hstep, voffB);
            PG8_WAIT_V(6); PG8_BAR; PG8_MMA(1, 1, At, B1); PG8_BAR;
            PG8_LDB(B0, 1, 0); PG8_SCHED; PG8_LDA(At, 1, 0); PG8_STAGE(PG8_SA(0, 1), a2 + hstep, voffA);
            PG8_WAIT_L(8); PG8_BAR; PG8_WAIT_L(0); PG8_MMA(0, 0, At, B0); PG8_BAR; PG8_SCHED;
            PG8_LDB(B1, 1, 1); PG8_STAGE(PG8_SB(1, 0), b3, voffB);
            PG8_BAR; PG8_WAIT_L(0); PG8_MMA(0, 1, At, B1); PG8_BAR;
            PG8_LDA(At, 1, 1); PG8_STAGE(PG8_SA(1, 0), a3, voffA);
            PG8_BAR; PG8_WAIT_L(0); PG8_MMA(1, 0, At, B0); PG8_BAR; PG8_SCHED;
            PG8_STAGE(PG8_SB(1, 1), b3 + hstep, voffB);
            PG8_WAIT_V(6); PG8_BAR; PG8_MMA(1, 1, At, B1); PG8_BAR;
        }
        PG8_STAMP();
        if constexpr (!Epi::AFTER_DRAIN) { E(acc, cur, wr, wc, fr, fq); S.done(cur); }
        PG8_STAMP();
        if (!has_next) break;
#pragma unroll
        for (int a = 0; a < 2; ++a)
#pragma unroll
            for (int b = 0; b < 2; ++b)
#pragma unroll
                for (int m = 0; m < 4; ++m)
#pragma unroll
                    for (int n = 0; n < 2; ++n) acc[a][b][m][n] = (f32x4){0.f, 0.f, 0.f, 0.f};
        cur = nxt; cA = nA; cB = nB; ++ui;
    }
    PG8_WAIT_V(0);
    if (wr == 0) PG8_BAR;
    PG8_BAR;
    if constexpr (Epi::AFTER_DRAIN) { E.fused(acc, cur, wr, wc, fr, fq, lds, wid, lane); S.done(cur); }
    PG8_STAMP();
    if (STAMP && wid == 0) { stamps[lane] = lane < nts ? (((unsigned long long)(unsigned)ts_hi << 32) | (unsigned)ts_lo) : 0ull;
        if (lane == 62) stamps[62] = rt_entry; if (lane == 63) stamps[63] = (unsigned long long)wall_clock64(); }
#undef PG8_STAMP
#undef PG8_SA
#undef PG8_SB
#undef PG8_STAGE
#undef PG8_LDA
#undef PG8_LDB
#undef PG8_MMA
#undef PG8_WAIT_V
#undef PG8_WAIT_L
#undef PG8_BAR
#undef PG8_SCHED
}
}

typedef short bf16x8 __attribute__((ext_vector_type(8)));
typedef float f32x4 __attribute__((ext_vector_type(4)));
typedef unsigned u32x4 __attribute__((ext_vector_type(4)));
using pg8::cvt_pk_bf16; using pg8::bflo; using pg8::bfhi;

#define LDS_WAIT() asm volatile("s_waitcnt lgkmcnt(0)" ::: "memory")
#define CBAR() asm volatile("" ::: "memory")
#define MFMA16(a, b, c) __builtin_amdgcn_mfma_f32_16x16x32_bf16((a), (b), (c), 0, 0, 0)

struct Args { const float* in[25]; float* out; unsigned char* ws; int ph_lo, ph_hi; };

__device__ __forceinline__ float wave_sum(float v) {
#pragma unroll
    for (int o = 1; o < 64; o <<= 1) v += __shfl_xor(v, o);
    return v;
}
__device__ __forceinline__ float wave_max(float v) {
#pragma unroll
    for (int o = 1; o < 64; o <<= 1) v = fmaxf(v, __shfl_xor(v, o));
    return v;
}
__device__ __forceinline__ float gelu_erf(float x) { return 0.5f * x * (1.0f + erff(x * 0.70710678118654752f)); }
__device__ __forceinline__ bf16x8 as_bf16x8(u32x4 v) { return __builtin_bit_cast(bf16x8, v); }

__device__ __forceinline__ void p0_transpose_item(const float* W, int K, int N, bf16_t* WT, const float* sc_a, const float* sc_b, LAS float* scr, int item, int lane) {
    const int nblk = N / 32, kb = item / nblk, nb = item % nblk, k0 = 64 * kb, n0 = 32 * nb;
#pragma unroll 8
    for (int i = 0; i < 32; ++i) { const int kk = 2 * i + (lane >> 5); const int k = k0 + kk;
        const float s = sc_a ? (k < 1024 ? sc_a[k] : sc_b[k - 1024]) : 1.f;
        scr[kk * 33 + (lane & 31)] = W[(size_t)k * N + n0 + (lane & 31)] * s; }
    LDS_WAIT();
    const int c = lane & 7;
#pragma unroll
    for (int j = 0; j < 4; ++j) { const int n = (lane >> 3) + 8 * j; const LAS float* s = scr + (8 * c) * 33 + n;
        u32x4 o; o.x = cvt_pk_bf16(s[0 * 33], s[1 * 33]); o.y = cvt_pk_bf16(s[2 * 33], s[3 * 33]); o.z = cvt_pk_bf16(s[4 * 33], s[5 * 33]); o.w = cvt_pk_bf16(s[6 * 33], s[7 * 33]);
        *(u32x4*)(WT + (size_t)(n0 + n) * K + k0 + 8 * c) = o; }
    LDS_WAIT();
}
template <int MODE> __device__ __forceinline__ void p0_row(const float* xrow, const float* g, bf16_t* orow, int lane) {
    const f32x4* xr = (const f32x4*)xrow + lane; const f32x4* gr = (const f32x4*)g + lane;
    f32x4 v[8]; float s = 0.f;
#pragma unroll
    for (int j = 0; j < 8; ++j) { v[j] = xr[64 * j]; s += (v[j].x * v[j].x + v[j].y * v[j].y) + (v[j].z * v[j].z + v[j].w * v[j].w); }
    float r = 1.f;
    if (MODE == 0) r = 1.0f / sqrtf(wave_sum(s) * (1.f / 2048.f) + EPS);
    u32x2* o8 = (u32x2*)orow + lane;
#pragma unroll
    for (int j = 0; j < 8; ++j) { f32x4 w = v[j] * r; if (MODE != 2) w = w * gr[64 * j];
        u32x2 o; o.x = cvt_pk_bf16(w.x, w.y); o.y = cvt_pk_bf16(w.z, w.w); o8[64 * j] = o; }
}
template <bool SCALE_G, bool OFFS> __device__ __forceinline__ void p0_row_q8(const float* xrow, const float* g, unsigned char* orow, float* sc, int lane) {
    const f32x4* xr = (const f32x4*)xrow + lane; const f32x4* gr = (const f32x4*)g + lane;
    f32x4 v[8]; float m = 0.f;
#pragma unroll
    for (int j = 0; j < 8; ++j) { v[j] = xr[64 * j]; if (SCALE_G) v[j] = v[j] * gr[64 * j];
        m = fmaxf(fmaxf(m, fmaxf(fabsf(v[j].x), fabsf(v[j].y))), fmaxf(fabsf(v[j].z), fabsf(v[j].w))); }
    m = fmaxf(wave_max(m), 1e-30f);
    const float inv = 127.f / m;
    if (lane == 0) *sc = m * (1.f / 127.f);
    unsigned* o4 = (unsigned*)orow + lane;
#pragma unroll
    for (int j = 0; j < 8; ++j) { const int a = (int)rintf(v[j].x * inv) + (OFFS ? 128 : 0), b = (int)rintf(v[j].y * inv) + (OFFS ? 128 : 0), c = (int)rintf(v[j].z * inv) + (OFFS ? 128 : 0), d = (int)rintf(v[j].w * inv) + (OFFS ? 128 : 0);
        o4[64 * j] = (unsigned)(a & 255) | ((unsigned)(b & 255) << 8) | ((unsigned)(c & 255) << 16) | ((unsigned)(d & 255) << 24); }
}
__device__ __forceinline__ void p0_wp_item(const float* wq, const float* keys1, const float* keys2, const float* gffn, bf16_t* WPT, int item, int lane) {
    const int hj = item >> 7, ib = item & 127, h = hj >> 1, j = hj & 1, i0 = 16 * ib, col0 = h * 256 + j * 128;
    const int lr = lane & 15, g = lane >> 4;
    const float* keys = (j ? keys2 : keys1) + (size_t)h * 128 * 128;
    const float gi = gffn[i0 + lr];
    bf16x8 af[4];
#pragma unroll
    for (int s = 0; s < 4; ++s) { const float* p = wq + (size_t)(i0 + lr) * 2048 + col0 + 32 * s + 8 * g;
        const f32x4 a = *(const f32x4*)p * gi, b = *(const f32x4*)(p + 4) * gi;
        u32x4 w; w.x = cvt_pk_bf16(a.x, a.y); w.y = cvt_pk_bf16(a.z, a.w); w.z = cvt_pk_bf16(b.x, b.y); w.w = cvt_pk_bf16(b.z, b.w); af[s] = as_bf16x8(w); }
    for (int kt = 0; kt < 8; ++kt) {
        f32x4 d = {0.f, 0.f, 0.f, 0.f};
#pragma unroll
        for (int s = 0; s < 4; ++s) { const float* p = keys + (size_t)(16 * kt + lr) * 128 + 32 * s + 8 * g;
            const f32x4 a = *(const f32x4*)p, b = *(const f32x4*)(p + 4);
            u32x4 w; w.x = cvt_pk_bf16(a.x, a.y); w.y = cvt_pk_bf16(a.z, a.w); w.z = cvt_pk_bf16(b.x, b.y); w.w = cvt_pk_bf16(b.z, b.w);
            d = MFMA16(af[s], as_bf16x8(w), d); }
        u32x2 o; o.x = cvt_pk_bf16(d[0], d[1]); o.y = cvt_pk_bf16(d[2], d[3]);
        *(u32x2*)(WPT + (size_t)(hj * 128 + 16 * kt + lr) * 2048 + i0 + 4 * g) = o;
    }
}
__device__ __forceinline__ int t5_bucket(int n) {
    if (n < 16) return n;
    const int large = 16 + (int)(logf((float)n / 16.f) / 4.852030263919617f * 16.f);
    return large < 31 ? large : 31;
}
__device__ __forceinline__ void p0_ssm_item(const Args& A, unsigned char* sp, int g, int lane) {
    const float* lam_re = A.in[6]; const float* lam_im = A.in[7]; const float* log_dt = A.in[8];
    const float* b_re = A.in[9]; const float* b_im = A.in[10]; const float* c_re = A.in[11]; const float* c_im = A.in[12];
    const int n = lane;
    const float dt = expf(log_dt[g]);
    const float lr = lam_re[g * 64 + n], li = lam_im[g * 64 + n];
    const float mag = expf(lr * dt);
    const float a_re = mag * cosf(li * dt), a_im = mag * sinf(li * dt);
    const float den = lr * lr + li * li;
    const float f_re = ((a_re - 1.f) * lr + a_im * li) / den, f_im = (a_im * lr - (a_re - 1.f) * li) / den;
    ((f32x2*)(sp + SSMP_ABAR))[g * 64 + n] = (f32x2){a_re, a_im};
    float pr = a_re, pi = a_im;
#pragma unroll
    for (int i = 0; i < 8; ++i) { const float nr = pr * pr - pi * pi, ni = 2.f * pr * pi; pr = nr; pi = ni; }
    ((f32x2*)(sp + SSMP_A256))[g * 64 + n] = (f32x2){pr, pi};
    float bbr[16], bbi[16];
#pragma unroll
    for (int q = 0; q < 4; ++q) { const f32x4 br = *(const f32x4*)(b_re + (size_t)(g * 64 + n) * 16 + 4 * q), bi = *(const f32x4*)(b_im + (size_t)(g * 64 + n) * 16 + 4 * q);
#pragma unroll
        for (int e = 0; e < 4; ++e) { bbr[4 * q + e] = f_re * br[e] - f_im * bi[e]; bbi[4 * q + e] = f_re * bi[e] + f_im * br[e]; } }
    bf16_t* bf = (bf16_t*)(sp + SSMP_BFRAG);
    const int jre = n >> 4, n16 = n & 15;
#pragma unroll
    for (int kg = 0; kg < 4; ++kg) {
        u32x4 wr = {0u, 0u, 0u, 0u}, wi = {0u, 0u, 0u, 0u};
        if (kg < 2) { const int c0 = (kg & 1) * 8;
            wr.x = cvt_pk_bf16(bbr[c0 + 0], bbr[c0 + 1]); wr.y = cvt_pk_bf16(bbr[c0 + 2], bbr[c0 + 3]); wr.z = cvt_pk_bf16(bbr[c0 + 4], bbr[c0 + 5]); wr.w = cvt_pk_bf16(bbr[c0 + 6], bbr[c0 + 7]);
            wi.x = cvt_pk_bf16(bbi[c0 + 0], bbi[c0 + 1]); wi.y = cvt_pk_bf16(bbi[c0 + 2], bbi[c0 + 3]); wi.z = cvt_pk_bf16(bbi[c0 + 4], bbi[c0 + 5]); wi.w = cvt_pk_bf16(bbi[c0 + 6], bbi[c0 + 7]); }
        *(u32x4*)(bf + ((size_t)(g * 8 + jre) * 64 + kg * 16 + n16) * 8) = wr;
        *(u32x4*)(bf + ((size_t)(g * 8 + 4 + jre) * 64 + kg * 16 + n16) * 8) = wi;
    }
    bf16_t* cf = (bf16_t*)(sp + SSMP_CFRAG);
    const int ch = lane & 15, kg = lane >> 4;
#pragma unroll
    for (int s = 0; s < 4; ++s) { const int k0 = 32 * s + 8 * kg;
        const float* src = (k0 < 64) ? (c_re + (size_t)(g * 16 + ch) * 64 + k0) : (c_im + (size_t)(g * 16 + ch) * 64 + (k0 - 64));
        const float sg = (k0 < 64) ? 1.f : -1.f;
        const f32x4 a = *(const f32x4*)src * sg, b = *(const f32x4*)(src + 4) * sg;
        u32x4 w; w.x = cvt_pk_bf16(a.x, a.y); w.y = cvt_pk_bf16(a.z, a.w); w.z = cvt_pk_bf16(b.x, b.y); w.w = cvt_pk_bf16(b.z, b.w);
        *(u32x4*)(cf + ((size_t)(g * 4 + s) * 64 + lane) * 8) = w; }
}
__device__ __forceinline__ void p0_btab_item(const Args& A, float* btab, int item, int lane) {
    const float* gq = A.in[3]; const float* gk = A.in[4]; const float* rel_bias = A.in[5];
    const int h = item / 3, br = item % 3, d = br == 0 ? 1 : (br == 1 ? 4 : 16);
    const float G = wave_max(fabsf(gq[lane] * gk[lane]));
    const float mb = wave_max(lane < 32 ? rel_bias[lane * 16 + h] : -1e30f);
    const float smax = 8.4f * G + mb;
    for (int idx = lane; idx < 192; idx += 64) { const int rel = idx - 31;
        float v = -1e30f;
        if (rel >= 0 && rel <= 128) v = LOG2E * (rel_bias[t5_bucket(rel * d) * 16 + h] - smax);
        btab[(h * 3 + br) * 192 + idx] = v; }
}

__device__ __forceinline__ void p0_prologue(const Args& A, LAS unsigned char* lds, int wave, int lane) {
    unsigned char* ws = A.ws;
    LAS float* scr = (LAS float*)(lds + wave * 16384);
    const int gw = blockIdx.x * 8 + wave, NGW = gridDim.x * 8;
    constexpr int I_WIN = (2048 / 64) * (4096 / 32), I_GLU = (1024 / 64) * (1024 / 32), I_WOUT = (2048 / 64) * (2048 / 32), I_WP = 2048;
    constexpr int I_H = 8192, I_U = 16384, I_V = 16384, I_SSM = 64, I_BT = 48;
    constexpr int NITEMS = I_WIN + I_GLU + I_WOUT + I_WP + I_H + I_U + I_V + I_SSM + I_BT;
    for (int it = gw; it < NITEMS; it += NGW) {
        int r = it;
        if (r < I_SSM) { p0_ssm_item(A, ws + WS_SSMP, r, lane); continue; } r -= I_SSM;
        if (r < I_BT) { p0_btab_item(A, (float*)(ws + WS_BTAB), r, lane); continue; } r -= I_BT;
        if (r < I_WP) { p0_wp_item(A.in[20], A.in[21], A.in[22], A.in[19], (bf16_t*)(ws + WS_WPT), r, lane); continue; } r -= I_WP;
        if (r < I_WIN) { p0_transpose_item(A.in[2], 2048, 4096, (bf16_t*)(ws + WS_WINT), nullptr, nullptr, scr, r, lane); continue; } r -= I_WIN;
        if (r < I_GLU) { p0_transpose_item(A.in[14], 1024, 1024, (bf16_t*)(ws + WS_GLUT), nullptr, nullptr, scr, r, lane); continue; } r -= I_GLU;
        if (r < I_WOUT) { p0_transpose_item(A.in[18], 2048, 2048, (bf16_t*)(ws + WS_WOUTT), A.in[16], A.in[17], scr, r, lane); continue; } r -= I_WOUT;
        if (r < I_H) { p0_row<0>(A.in[0] + (size_t)r * 2048, A.in[1], (bf16_t*)(ws + WS_HB) + (size_t)r * 2048, lane); continue; } r -= I_H;
        if (r < I_U) { p0_row_q8<true, false>(A.in[23] + (size_t)r * 2048, A.in[19], ws + WS_UB + (size_t)r * 2048, (float*)(ws + WS_SU) + r, lane); continue; } r -= I_U;
        p0_row_q8<false, true>(A.in[24] + (size_t)r * 2048, A.in[19], ws + WS_VB + (size_t)r * 2048, (float*)(ws + WS_SV) + r, lane);
    }
}

constexpr int SSM_WL = 8192 + 16 * 272;
__device__ __forceinline__ void ssm_unit(const Args& A, LAS unsigned char* lds, int b, int g, int wave, int lane) {
    unsigned char* ws = A.ws; unsigned char* sp = ws + WS_SSMP;
    const bf16_t* proj = (const bf16_t*)(ws + WS_PROJ); bf16_t* yb = (bf16_t*)(ws + WS_YB);
    LAS unsigned char* wl = lds + wave * SSM_WL;
    LAS f32x2* BU = (LAS f32x2*)wl; LAS unsigned char* XB = wl + 8192;
    LAS f32x2* carry = (LAS f32x2*)(lds + 8 * SSM_WL);
    const int lr = lane & 15, q = lane >> 4;
    bf16x8 bfr[8], cfr[4];
#pragma unroll
    for (int j = 0; j < 8; ++j) bfr[j] = as_bf16x8(*(const u32x4*)((const bf16_t*)(sp + SSMP_BFRAG) + ((size_t)(g * 8 + j) * 64 + lane) * 8));
#pragma unroll
    for (int s = 0; s < 4; ++s) cfr[s] = as_bf16x8(*(const u32x4*)((const bf16_t*)(sp + SSMP_CFRAG) + ((size_t)(g * 4 + s) * 64 + lane) * 8));
    const f32x2 ab = ((const f32x2*)(sp + SSMP_ABAR))[g * 64 + lane], a256 = ((const f32x2*)(sp + SSMP_A256))[g * 64 + lane];
    const float a_re = ab.x, a_im = ab.y;
    const float dsk = A.in[13][g * 16 + lr];
    const bf16_t* up = proj + (size_t)(b * SEQ + wave * 256) * DPROJ + 3072 + g * 16;
    float xr = 0.f, xi = 0.f;
#ifdef MK_DEBUG2
    unsigned long long hdd = 0ull, hbu = 0ull, hua = 0ull;
#endif
    for (int pass = 0; pass < 2; ++pass) {
        for (int blk = 0; blk < 16; ++blk) {
            u32x4 uraw = {0u, 0u, 0u, 0u};
            if (q < 2) uraw = *(const u32x4*)(up + (size_t)(blk * 16 + lr) * DPROJ + 8 * q);
            const bf16x8 ua = as_bf16x8(uraw);
            f32x4 dd[8];
#pragma unroll
            for (int j = 0; j < 8; ++j) dd[j] = MFMA16(ua, bfr[j], ((f32x4){0.f, 0.f, 0.f, 0.f}));
#pragma unroll
            for (int jj = 0; jj < 4; ++jj)
#pragma unroll
                for (int r = 0; r < 4; ++r) BU[(4 * q + r) * 64 + 16 * jj + lr] = (f32x2){dd[jj][r], dd[4 + jj][r]};
            LDS_WAIT(); CBAR();
            f32x2 bu[16];
#pragma unroll
            for (int t = 0; t < 16; ++t) bu[t] = BU[t * 64 + lane];
#ifdef MK_DEBUG2
            if (pass == 0) {
#pragma unroll
                for (int j = 0; j < 8; ++j)
#pragma unroll
                    for (int r = 0; r < 4; ++r) hdd = hdd * 0x100000001B3ull + __float_as_uint(dd[j][r]);
#pragma unroll
                for (int t = 0; t < 16; ++t) { hbu = hbu * 0x100000001B3ull + __float_as_uint(bu[t].x); hbu = hbu * 0x100000001B3ull + __float_as_uint(bu[t].y); }
                hua = hua * 0x100000001B3ull + uraw.x; hua = hua * 0x100000001B3ull + uraw.y; hua = hua * 0x100000001B3ull + uraw.z; hua = hua * 0x100000001B3ull + uraw.w; }
#endif
            if (pass == 0) {
#pragma unroll
                for (int t = 0; t < 16; ++t) { float nr = fmaf(a_re, xr, fmaf(-a_im, xi, bu[t].x)), ni = fmaf(a_re, xi, fmaf(a_im, xr, bu[t].y)); asm volatile("" : "+v"(nr)); asm volatile("" : "+v"(ni)); xr = nr; xi = ni; }
                asm volatile("" : "+v"(xr), "+v"(xi) :: "memory");
            } else {
#pragma unroll
                for (int t = 0; t < 16; ++t) { float nr = fmaf(a_re, xr, fmaf(-a_im, xi, bu[t].x)), ni = fmaf(a_re, xi, fmaf(a_im, xr, bu[t].y)); asm volatile("" : "+v"(nr)); asm volatile("" : "+v"(ni)); xr = nr; xi = ni;
                    const unsigned pk = cvt_pk_bf16(xr, xi);
                    *(LAS unsigned short*)(XB + t * 272 + lane * 2) = (unsigned short)(pk & 0xffffu);
                    *(LAS unsigned short*)(XB + t * 272 + 128 + lane * 2) = (unsigned short)(pk >> 16); }
                LDS_WAIT(); CBAR();
                f32x4 y = {0.f, 0.f, 0.f, 0.f};
#pragma unroll
                for (int s = 0; s < 4; ++s) { const bf16x8 xa = as_bf16x8(*(const LAS u32x4*)(XB + lr * 272 + (32 * s + 8 * q) * 2)); y = MFMA16(xa, cfr[s], y); }
#pragma unroll
                for (int r = 0; r < 4; ++r) { const int t = blk * 16 + 4 * q + r;
                    const float uv = __uint_as_float((unsigned)up[(size_t)t * DPROJ + lr] << 16);
                    const float yv = gelu_erf(y[r] + dsk * uv);
                    yb[(size_t)(b * SEQ + wave * 256 + t) * 1024 + g * 16 + lr] = (bf16_t)(cvt_pk_bf16(yv, 0.f) & 0xffffu); }
                asm volatile("" : "+v"(xr), "+v"(xi) :: "memory");
            }
        }
        if (pass == 0) {
            carry[wave * 64 + lane] = (f32x2){xr, xi};
#ifdef MK_DEBUG2
            { unsigned long long* hp = (unsigned long long*)(ws + WS_END + 99 * MB);
              const unsigned long long km = (2ull * (((unsigned long long)(b * 64 + g) * 8 + wave) * 64 + lane) + 1ull) * 0x9E3779B97F4A7C15ull;
              atomicAdd(hp + 0, hua * km); atomicAdd(hp + 1, hdd * km); atomicAdd(hp + 2, hbu * km); }
            ((f32x2*)(ws + WS_END + 108 * MB))[((size_t)(b * 64 + g) * 8 + wave) * 64 + lane] = (f32x2){xr, xi};
#endif
            __syncthreads();
            float sr = 0.f, si = 0.f;
            for (int w2 = 0; w2 < wave; ++w2) { const f32x2 e = carry[w2 * 64 + lane]; const float nr = a256.x * sr - a256.y * si + e.x, ni = a256.x * si + a256.y * sr + e.y; sr = nr; si = ni; }
            xr = sr; xi = si;
#ifdef MK_DEBUG2
            ((f32x2*)(ws + WS_END + 109 * MB))[((size_t)(b * 64 + g) * 8 + wave) * 64 + lane] = (f32x2){xr, xi};
#endif
        }
    }
    __syncthreads();
}

__device__ __forceinline__ void prep2_item(const Args& A, LAS unsigned char* wl, int item, int lane) {
    unsigned char* ws = A.ws;
    const bf16_t* proj = (const bf16_t*)(ws + WS_PROJ);
    const int pb = item & 31, h = (item >> 5) & 15, b = item >> 9, P0 = pb * 64;
    const int r8 = lane >> 3, c = lane & 7;
    const float* gq = A.in[3]; const float* gk = A.in[4];
#pragma unroll
    for (int which = 0; which < 2; ++which) {
        const float* gv = which ? gk : gq; const float cs = which ? 1.f : (LOG2E * 0.125f);
        float gl[8];
#pragma unroll
        for (int e = 0; e < 8; ++e) gl[e] = gv[8 * c + e] * cs;
        bf16_t* dst = (bf16_t*)(ws + (which ? WS_KN : WS_QN)) + ((size_t)(b * 16 + h) * SEQ + P0) * 64;
#pragma unroll
        for (int i = 0; i < 8; ++i) { const int row = 8 * i + r8;
            const u32x4 raw = *(const u32x4*)(proj + (size_t)(b * SEQ + P0 + row) * DPROJ + which * 1024 + h * 64 + 8 * c);
            float v[8] = {bflo(raw.x), bfhi(raw.x), bflo(raw.y), bfhi(raw.y), bflo(raw.z), bfhi(raw.z), bflo(raw.w), bfhi(raw.w)};
            float ss = 0.f;
#pragma unroll
            for (int e = 0; e < 8; ++e) ss += v[e] * v[e];
            ss += __shfl_xor(ss, 1); ss += __shfl_xor(ss, 2); ss += __shfl_xor(ss, 4);
            const float r = 1.0f / sqrtf(ss * (1.f / 64.f) + EPS);
            u32x4 w; w.x = cvt_pk_bf16(v[0] * r * gl[0], v[1] * r * gl[1]); w.y = cvt_pk_bf16(v[2] * r * gl[2], v[3] * r * gl[3]);
            w.z = cvt_pk_bf16(v[4] * r * gl[4], v[5] * r * gl[5]); w.w = cvt_pk_bf16(v[6] * r * gl[6], v[7] * r * gl[7]);
            *(u32x4*)(dst + (size_t)row * 64 + 8 * c) = w; }
    }
#pragma unroll
    for (int i = 0; i < 8; ++i) { const int row = 8 * i + r8;
        const u32x4 raw = *(const u32x4*)(proj + (size_t)(b * SEQ + P0 + row) * DPROJ + 2048 + h * 64 + 8 * c);
        *(LAS u32x2*)(wl + row * 136 + c * 16) = (u32x2){raw.x, raw.y}; *(LAS u32x2*)(wl + row * 136 + c * 16 + 8) = (u32x2){raw.z, raw.w}; }
    CBAR();
    unsigned v[64];
#pragma unroll
    for (int p = 0; p < 64; ++p) v[p] = *(const LAS unsigned short*)(wl + p * 136 + lane * 2);
    CBAR();
    bf16_t* vt = (bf16_t*)(ws + WS_VT);
    const size_t rowo = ((size_t)(b * 16 + h) * 64 + lane) * SEQ;
#pragma unroll
    for (int G = 0; G < 2; ++G)
#pragma unroll
        for (int kg = 0; kg < 4; ++kg) { const int a0 = 32 * G + 4 * kg, b0 = 32 * G + 16 + 4 * kg;
            u32x4 w; w.x = v[a0] | (v[a0 + 1] << 16); w.y = v[a0 + 2] | (v[a0 + 3] << 16); w.z = v[b0] | (v[b0 + 1] << 16); w.w = v[b0 + 2] | (v[b0 + 3] << 16);
            *(u32x4*)(vt + rowo + P0 + 32 * G + 8 * kg) = w; }
    { bf16_t* vt4 = vt + (size_t)4 * 16 * 64 * SEQ; const int l0 = P0 >> 2, tile = (l0 >> 4) & 1, grp = l0 >> 5;
#pragma unroll
        for (int r = 0; r < 4; ++r)
#pragma unroll
            for (int kg = 0; kg < 4; ++kg) { const int p0 = 4 * (4 * kg) + r;
                u32x2 w; w.x = v[p0] | (v[p0 + 4] << 16); w.y = v[p0 + 8] | (v[p0 + 12] << 16);
                *(u32x2*)(vt4 + rowo + r * 512 + 32 * grp + 8 * kg + 4 * tile) = w; } }
    { bf16_t* vt16 = vt + (size_t)2 * 4 * 16 * 64 * SEQ; const int l0 = P0 >> 4, w32 = l0 & 31, tile = (w32 >> 4) & 1, kg = (w32 & 15) >> 2, grp = l0 >> 5;
#pragma unroll
        for (int r = 0; r < 16; ++r) { u32x2 w; w.x = v[r] | (v[16 + r] << 16); w.y = v[32 + r] | (v[48 + r] << 16);
            *(u32x2*)(vt16 + rowo + r * 128 + 32 * grp + 8 * kg + 4 * tile) = w; } }
}

__device__ __forceinline__ void attn_unit(const Args& A, LAS unsigned char* lds, int unit, int tid, int wave, int lane) {
    unsigned char* ws = A.ws;
    const int blk = 7 - (unit >> 6), bh = unit & 63, b = bh >> 4, h = bh & 15, p0 = blk * 256;
    LAS float* Oacc = (LAS float*)lds; LAS float* lacc = (LAS float*)(lds + 65536); LAS float* tb = (LAS float*)(lds + 65536 + 1024);
    for (int i = tid; i < 256 * 64 + 256; i += 512) Oacc[i] = 0.f;
    { const float* bt = (const float*)(ws + WS_BTAB) + h * 3 * 192; for (int i = tid; i < 3 * 192; i += 512) tb[i] = bt[i]; }
    __syncthreads();
    const bf16_t* Qn = (const bf16_t*)(ws + WS_QN) + (size_t)bh * SEQ * 64;
    const bf16_t* Kn = (const bf16_t*)(ws + WS_KN) + (size_t)bh * SEQ * 64;
    const int qi = lane & 15, g = lane >> 4;
    for (int it = wave; it < 48; it += 8) {
        const int br = it >> 4, j = it & 15, sh = 2 * br, L = SEQ >> sh;
        int r, lfirst;
        if (br == 0) { r = 0; lfirst = p0 + 16 * j; } else if (br == 1) { r = j & 3; lfirst = (p0 >> 2) + 16 * (j >> 2); } else { r = j; lfirst = p0 >> 4; }
        const bf16_t* VT = (const bf16_t*)(ws + WS_VT) + (size_t)br * 4 * 16 * 64 * SEQ + (size_t)bh * 64 * SEQ + (size_t)r * L;
        const int qpos = ((lfirst + qi) << sh) + r;
        bf16x8 qf[2];
#pragma unroll
        for (int s = 0; s < 2; ++s) qf[s] = as_bf16x8(*(const u32x4*)(Qn + (size_t)qpos * 64 + 32 * s + 8 * g));
        f32x4 o[4];
#pragma unroll
        for (int nt = 0; nt < 4; ++nt) o[nt] = (f32x4){0.f, 0.f, 0.f, 0.f};
        float lsum = 0.f;
        const LAS float* tbb = tb + br * 192;
        int ks = (lfirst - 128) & ~31; if (ks < 0) ks = 0;
        for (int lk0 = ks; lk0 <= lfirst; lk0 += 32) {
            f32x4 sa = {0.f, 0.f, 0.f, 0.f}, sb = {0.f, 0.f, 0.f, 0.f};
            const int kpa = ((lk0 + qi) << sh) + r, kpb = ((lk0 + 16 + qi) << sh) + r;
#pragma unroll
            for (int s = 0; s < 2; ++s) {
                const bf16x8 ka = as_bf16x8(*(const u32x4*)(Kn + (size_t)kpa * 64 + 32 * s + 8 * g));
                const bf16x8 kb = as_bf16x8(*(const u32x4*)(Kn + (size_t)kpb * 64 + 32 * s + 8 * g));
                sa = MFMA16(ka, qf[s], sa); sb = MFMA16(kb, qf[s], sb); }
            const int ba = lfirst + qi - lk0 - 4 * g + 31;
            float pa[4], pb[4];
#pragma unroll
            for (int e = 0; e < 4; ++e) { pa[e] = __builtin_amdgcn_exp2f(sa[e] + tbb[ba - e]); pb[e] = __builtin_amdgcn_exp2f(sb[e] + tbb[ba - 16 - e]); }
            lsum += (pa[0] + pa[1]) + (pa[2] + pa[3]) + (pb[0] + pb[1]) + (pb[2] + pb[3]);
            u32x4 pw; pw.x = cvt_pk_bf16(pa[0], pa[1]); pw.y = cvt_pk_bf16(pa[2], pa[3]); pw.z = cvt_pk_bf16(pb[0], pb[1]); pw.w = cvt_pk_bf16(pb[2], pb[3]);
            const bf16x8 pf = as_bf16x8(pw);
#pragma unroll
            for (int nt = 0; nt < 4; ++nt) { const bf16x8 vf = as_bf16x8(*(const u32x4*)(VT + (size_t)(16 * nt + qi) * SEQ + lk0 + 8 * g)); o[nt] = MFMA16(pf, vf, o[nt]); }
        }
        lsum += __shfl_xor(lsum, 16); lsum += __shfl_xor(lsum, 32);
        if (g == 0) __hip_atomic_fetch_add(lacc + (qpos - p0), lsum, __ATOMIC_RELAXED, __HIP_MEMORY_SCOPE_WORKGROUP);
#pragma unroll
        for (int reg = 0; reg < 4; ++reg) { const int ql = (((lfirst + 4 * g + reg) << sh) + r) - p0;
#pragma unroll
            for (int nt = 0; nt < 4; ++nt) __hip_atomic_fetch_add(Oacc + ql * 64 + 16 * nt + qi, o[nt][reg], __ATOMIC_RELAXED, __HIP_MEMORY_SCOPE_WORKGROUP); }
    }
    __syncthreads();
    { const int ql = tid >> 1, half = tid & 1; const float inv = 1.0f / lacc[ql];
        bf16_t* dst = (bf16_t*)(ws + WS_MIXED) + (size_t)(b * SEQ + p0 + ql) * 2048 + h * 64 + 32 * half;
        float ss = 0.f;
#pragma unroll
        for (int c4 = 0; c4 < 4; ++c4) { float v[8];
#pragma unroll
            for (int e = 0; e < 8; ++e) { v[e] = Oacc[ql * 64 + 32 * half + 8 * c4 + e] * inv; ss += v[e] * v[e]; }
            u32x4 w; w.x = cvt_pk_bf16(v[0], v[1]); w.y = cvt_pk_bf16(v[2], v[3]); w.z = cvt_pk_bf16(v[4], v[5]); w.w = cvt_pk_bf16(v[6], v[7]);
            *(u32x4*)(dst + 8 * c4) = w; }
        ss += __shfl_xor(ss, 1);
        if (half == 0) unsafeAtomicAdd((float*)(ws + WS_CTL + CTL_RSS_ATTN) + b * SEQ + p0 + ql, ss); }
    __syncthreads();
}

__device__ __forceinline__ unsigned fkey(float f) { const unsigned u = __float_as_uint(f); return (u & 0x80000000u) ? ~u : (u | 0x80000000u); }
template <int R> __device__ __forceinline__ void select16(const unsigned (&key)[R], unsigned long long (&m)[R]) {
    unsigned T = 0u; int cnt = R * 64;
    for (int bit = 31; bit >= 0; --bit) { const unsigned cand = T | (1u << bit); int c = 0;
#pragma unroll
        for (int r = 0; r < R; ++r) c += __popcll(__ballot(key[r] >= cand));
        if (c >= 16) { T = cand; cnt = c; if (c == 16) break; } }
    if (cnt == 16) {
#pragma unroll
        for (int r = 0; r < R; ++r) m[r] = __ballot(key[r] >= T);
    } else {
        int need = 16;
#pragma unroll
        for (int r = 0; r < R; ++r) { m[r] = __ballot(key[r] > T); need -= __popcll(m[r]); }
#pragma unroll
        for (int r = 0; r < R; ++r) { unsigned long long eq = __ballot(key[r] == T);
            while (__popcll(eq) > need) eq &= ~(1ull << (63 - __builtin_clzll(eq)));
            need -= __popcll(eq); m[r] |= eq; }
    }
}
__device__ __forceinline__ void peer_topk(const float* sp, LAS float* sc, LAS int* exo, LAS float* gto, int lane) {
    LAS float* v1 = sc; LAS int* i1 = (LAS int*)(sc + 16); LAS float* v2 = sc + 32; LAS int* i2 = (LAS int*)(sc + 48); LAS float* sv = sc + 64; LAS int* si = (LAS int*)(sc + 80);
    const unsigned long long lt = (1ull << lane) - 1ull;
#pragma unroll
    for (int half = 0; half < 2; ++half) {
        const float a0 = sp[half * 128 + lane], a1 = sp[half * 128 + 64 + lane];
        const unsigned key[2] = {fkey(a0), fkey(a1)}; unsigned long long m[2];
        select16<2>(key, m);
        LAS float* vv = half ? v2 : v1; LAS int* ii = half ? i2 : i1;
        if ((m[0] >> lane) & 1ull) { const int pos = __popcll(m[0] & lt); vv[pos] = a0; ii[pos] = lane; }
        if ((m[1] >> lane) & 1ull) { const int pos = __popcll(m[0]) + __popcll(m[1] & lt); vv[pos] = a1; ii[pos] = 64 + lane; }
    }
    CBAR(); LDS_WAIT();
    const int a = lane >> 2, bb = (lane & 3) * 4;
    const float va = v1[a]; float cv[4]; unsigned key[4]; unsigned long long m[4];
#pragma unroll
    for (int e = 0; e < 4; ++e) { cv[e] = va + v2[bb + e]; key[e] = fkey(cv[e]); }
    select16<4>(key, m);
    int base = 0;
#pragma unroll
    for (int e = 0; e < 4; ++e) { if ((m[e] >> lane) & 1ull) { const int pos = base + __popcll(m[e] & lt); sv[pos] = cv[e]; si[pos] = a * 16 + bb + e; } base += __popcll(m[e]); }
    CBAR(); LDS_WAIT();
    if (lane < 16) {
        const float val = sv[lane]; const int fi = si[lane];
        float mx = val;
#pragma unroll
        for (int o = 1; o < 16; o <<= 1) mx = fmaxf(mx, __shfl_xor(mx, o));
        const float ex = expf(val - mx); float sum = ex;
#pragma unroll
        for (int o = 1; o < 16; o <<= 1) sum += __shfl_xor(sum, o);
        exo[lane] = i1[fi >> 4] * 128 + (i2[fi & 15] - 0);
        gto[lane] = ex / sum;
    }
    CBAR(); LDS_WAIT();
}

constexpr int PD = 8;
__device__ __forceinline__ float ubyte_f32(unsigned w, int i) { return (float)((w >> (8 * i)) & 0xffu); }
__device__ __forceinline__ void peer_wave(const Args& A, LAS unsigned char* lds, int wave, int lane) {
    unsigned char* ws = A.ws;
    const float* scores = (const float*)(ws + WS_PROJ);
    const unsigned char* ub = ws + WS_UB; const unsigned char* vb = ws + WS_VB; const bf16_t* x1b = (const bf16_t*)(ws + WS_HB);
    const float* su = (const float*)(ws + WS_SU); const float* sv = (const float*)(ws + WS_SV);
    const float* rssx = (const float*)(ws + WS_CTL + CTL_RSS_X1);
    LAS int* exl = (LAS int*)(lds + wave * 4096);
    LAS float* gtl = (LAS float*)(lds + wave * 4096 + 2048);
    LAS float* sc = (LAS float*)(lds + 32768 + wave * 512);
    LAS float* wts = (LAS float*)(lds + 36864 + wave * 512);
    const int t0 = (blockIdx.x * 8 + wave) * 4;
    if (t0 >= NTOK) return;
    for (int tok = 0; tok < 4; ++tok)
        for (int h = 0; h < 8; ++h) peer_topk(scores + (size_t)(t0 + tok) * 2048 + h * 256, sc, exl + tok * 128 + h * 16, gtl + tok * 128 + h * 16, lane);
    CBAR(); LDS_WAIT();
#ifdef MK_DEBUG
    for (int i = lane; i < 512; i += 64) { ((int*)(ws + WS_END + 100 * MB))[(size_t)t0 * 128 + i] = exl[i]; ((float*)(ws + WS_END + 104 * MB))[(size_t)t0 * 128 + i] = gtl[i]; }
#endif
    u32x4 buf[PD][2];
#define ROWPTR(s) (((s) & 128 ? vb : ub) + (size_t)exl[((s) >> 8) * 128 + ((s) & 127)] * 2048 + 16 * lane)
#define ISSUE(slot, s) do { const unsigned char* _p = ROWPTR(s); buf[slot][0] = *(const u32x4*)(_p); buf[slot][1] = *(const u32x4*)(_p + 1024); } while (0)
#pragma unroll
    for (int i = 0; i < PD; ++i) ISSUE(i, i);
    for (int tok = 0; tok < 4; ++tok) {
        const int t = t0 + tok;
        unsigned xq[8]; float sx;
        { float xf[32];
#pragma unroll
            for (int j = 0; j < 2; ++j)
#pragma unroll
                for (int hlf = 0; hlf < 2; ++hlf) { const u32x4 raw = *(const u32x4*)(x1b + (size_t)t * 2048 + 16 * lane + 1024 * j + 8 * hlf);
                    const unsigned rw[4] = {raw.x, raw.y, raw.z, raw.w};
#pragma unroll
                    for (int e = 0; e < 4; ++e) { xf[16 * j + 8 * hlf + 2 * e] = bflo(rw[e]); xf[16 * j + 8 * hlf + 2 * e + 1] = bfhi(rw[e]); } }
            float m = 0.f;
#pragma unroll
            for (int i = 0; i < 32; ++i) m = fmaxf(m, fabsf(xf[i]));
            m = fmaxf(wave_max(m), 1e-30f);
            const float inv = 127.f / m; sx = m * (1.f / 127.f);
#pragma unroll
            for (int d = 0; d < 8; ++d) { const int a = (int)rintf(xf[4 * d] * inv), b = (int)rintf(xf[4 * d + 1] * inv), c = (int)rintf(xf[4 * d + 2] * inv), e = (int)rintf(xf[4 * d + 3] * inv);
                xq[d] = (unsigned)(a & 255) | ((unsigned)(b & 255) << 8) | ((unsigned)(c & 255) << 16) | ((unsigned)(e & 255) << 24); } }
        const float r2 = 1.0f / sqrtf(rssx[t] * (1.f / 2048.f) + EPS);
        const float ascale = sx * r2;
        for (int k0 = 0; k0 < 128; k0 += PD) {
            int p[PD];
#pragma unroll
            for (int i = 0; i < PD; ++i) {
                const int s = tok * 256 + k0 + i;
                int acc = 0;
                { const unsigned w0[4] = {buf[i][0].x, buf[i][0].y, buf[i][0].z, buf[i][0].w}, w1[4] = {buf[i][1].x, buf[i][1].y, buf[i][1].z, buf[i][1].w};
#pragma unroll
                    for (int e = 0; e < 4; ++e) { acc = __builtin_amdgcn_sdot4((int)w0[e], (int)xq[e], acc, false); acc = __builtin_amdgcn_sdot4((int)w1[e], (int)xq[4 + e], acc, false); } }
                p[i] = acc;
                if (s + PD < 4 * 256) ISSUE(i, s + PD);
            }
            const bool b0 = lane & 1, b1 = lane & 2, b2 = lane & 4;
            int q4[4], q2[2], q1;
#pragma unroll
            for (int i = 0; i < 4; ++i) { const int keep = b0 ? p[i + 4] : p[i], send = b0 ? p[i] : p[i + 4]; q4[i] = keep + __shfl_xor(send, 1); }
#pragma unroll
            for (int i = 0; i < 2; ++i) { const int keep = b1 ? q4[i + 2] : q4[i], send = b1 ? q4[i] : q4[i + 2]; q2[i] = keep + __shfl_xor(send, 2); }
            { const int keep = b2 ? q2[1] : q2[0], send = b2 ? q2[0] : q2[1]; q1 = keep + __shfl_xor(send, 4); }
            q1 += __shfl_xor(q1, 8); q1 += __shfl_xor(q1, 16); q1 += __shfl_xor(q1, 32);
            if (lane < 8) { const int k = k0 + 4 * (lane & 1) + 2 * ((lane >> 1) & 1) + ((lane >> 2) & 1);
                const int e = exl[tok * 128 + k];
                const float a = (float)q1 * (ascale * su[e]);
                wts[k] = gtl[tok * 128 + k] * gelu_erf(a) * sv[e]; }
        }
        CBAR(); LDS_WAIT();
        float acc[32]; float wsum = 0.f;
#pragma unroll
        for (int i = 0; i < 32; ++i) acc[i] = 0.f;
        for (int k0 = 0; k0 < 128; k0 += PD) {
#pragma unroll
            for (int i = 0; i < PD; ++i) {
                const int k = k0 + i, s = tok * 256 + 128 + k;
                const float w = wts[k];
                wsum += w;
                { const unsigned w0[4] = {buf[i][0].x, buf[i][0].y, buf[i][0].z, buf[i][0].w}, w1[4] = {buf[i][1].x, buf[i][1].y, buf[i][1].z, buf[i][1].w};
#pragma unroll
                    for (int e = 0; e < 4; ++e)
#pragma unroll
                        for (int bb = 0; bb < 4; ++bb) { acc[4 * e + bb] += w * ubyte_f32(w0[e], bb); acc[16 + 4 * e + bb] += w * ubyte_f32(w1[e], bb); } }
                if (s + PD < 4 * 256) ISSUE(i, s + PD);
            }
        }
        CBAR();
        const float corr = -128.f * wsum;
        float* op = A.out + (size_t)t * 2048 + 16 * lane;
#pragma unroll
        for (int j = 0; j < 2; ++j)
#pragma unroll
            for (int c4 = 0; c4 < 4; ++c4) { const f32x4 x0 = *(const f32x4*)(op + 1024 * j + 4 * c4);
                *(f32x4*)(op + 1024 * j + 4 * c4) = x0 + (f32x4){acc[16 * j + 4 * c4] + corr, acc[16 * j + 4 * c4 + 1] + corr, acc[16 * j + 4 * c4 + 2] + corr, acc[16 * j + 4 * c4 + 3] + corr}; }
    }
#undef ROWPTR
#undef ISSUE
}

__global__ void __launch_bounds__(512, 2) mk_fwd(Args args) {
    extern __shared__ __attribute__((aligned(16))) unsigned char lds_raw[];
    LAS unsigned char* lds = (LAS unsigned char*)lds_raw;
    const int tid = threadIdx.x, lane = tid & 63, wave = __builtin_amdgcn_readfirstlane(tid >> 6);
    volatile LAS unsigned* MISC = (volatile LAS unsigned*)(lds + MISC_OFF);
    if (tid < 64) MISC[tid] = 0u;
    __syncthreads();
    unsigned char* ws = args.ws;
    const int lo = args.ph_lo, hi = args.ph_hi;
    XcdBarrier bar; bar.bar = (unsigned*)(ws + WS_CTL); bar.x = 0; bar.st = nullptr;
    if (hi - lo > 1) bar = xcd_barrier_post((unsigned*)(ws + WS_CTL), MISC + 8);
#ifndef PH_MASK
#define PH_MASK 0x7f
#endif
#define IN(k) (((PH_MASK >> (k)) & 1) && lo <= (k) && (k) < hi)
#define SEAM(k) do { if (IN(k) && IN((k) + 1)) xcd_barrier(bar); } while (0)

    if (IN(0)) { p0_prologue(args, lds, wave, lane); }
    SEAM(0);
    if (IN(1)) {
        pg8::Gemm g{(const bf16_t*)(ws + WS_HB), (const bf16_t*)(ws + WS_WINT), NTOK, DPROJ, DM}; pg8::StaticOrder S; S.init(NTOK, DPROJ, gridDim.x, (int)blockIdx.x);
        pg8::EpiProj E{(bf16_t*)(ws + WS_PROJ), DPROJ};
        pg8::gemm_phase<pg8::EpiProj, pg8::StaticOrder, false>(lds, g, S, E, nullptr);
    }
    SEAM(1);
    if (IN(2)) {
        for (int u = blockIdx.x; u < 256; u += gridDim.x) ssm_unit(args, lds, u >> 6, u & 63, wave, lane);
        for (int it = blockIdx.x * 8 + wave; it < 2048; it += gridDim.x * 8) prep2_item(args, lds + wave * SSM_WL, it, lane);
    }
    SEAM(2);
    if (IN(3)) {
        {
            pg8::Gemm g{(const bf16_t*)(ws + WS_YB), (const bf16_t*)(ws + WS_GLUT), NTOK, 1024, 1024}; pg8::StaticOrder S; S.init(NTOK, 1024, gridDim.x, (int)blockIdx.x);
            pg8::EpiGlu E{(const bf16_t*)(ws + WS_YB), (bf16_t*)(ws + WS_MIXED) + 1024, args.in[15], (float*)(ws + WS_CTL + CTL_RSS_SSM)};
            pg8::gemm_phase<pg8::EpiGlu, pg8::StaticOrder, false>(lds, g, S, E, nullptr);
        }
        __syncthreads();
        for (;;) {
            if (tid == 0) MISC[0] = atomicAdd((unsigned*)(ws + WS_CTL + CTL_QCTR), 1u);
            __syncthreads();
            const unsigned u = MISC[0];
            __syncthreads();
            if (u >= 512u) break;
            attn_unit(args, lds, (int)u, tid, wave, lane);
        }
    }
    SEAM(3);
    if (IN(4)) {
        pg8::Gemm g{(const bf16_t*)(ws + WS_MIXED), (const bf16_t*)(ws + WS_WOUTT), NTOK, DM, DM}; pg8::StaticOrder S; S.init(NTOK, DM, gridDim.x, (int)blockIdx.x);
        LAS float* tab = (LAS float*)(lds + 131072);
        { pg8::Unit u0; if (S.next(0, u0) && tid < 256) { const int row = u0.pm * 256 + tid;
            const float ra = 1.0f / sqrtf(((const float*)(ws + WS_CTL + CTL_RSS_ATTN))[row] * (1.f / 1024.f) + EPS), rs = 1.0f / sqrtf(((const float*)(ws + WS_CTL + CTL_RSS_SSM))[row] * (1.f / 1024.f) + EPS);
            tab[tid] = ra / rs; tab[256 + tid] = rs; } }
        __syncthreads();
        pg8::EpiWout E{args.in[0], args.out, (bf16_t*)(ws + WS_HB), (float*)(ws + WS_CTL + CTL_RSS_X1), tab};
        pg8::gemm_phase<pg8::EpiWout, pg8::StaticOrder, false>(lds, g, S, E, nullptr);
    }
    SEAM(4);
    if (IN(5)) {
        pg8::Gemm g{(const bf16_t*)(ws + WS_HB), (const bf16_t*)(ws + WS_WPT), NTOK, DM, DM}; pg8::StaticOrder S; S.init(NTOK, DM, gridDim.x, (int)blockIdx.x);
        pg8::EpiScores E{(float*)(ws + WS_PROJ), (const float*)(ws + WS_CTL + CTL_RSS_X1)};
        pg8::gemm_phase<pg8::EpiScores, pg8::StaticOrder, false>(lds, g, S, E, nullptr);
    }
    SEAM(5);
    if (IN(6)) { peer_wave(args, lds, wave, lane); }
#undef IN
#undef SEAM
}

#ifndef MK_DEBUG
#ifndef MK_PER_PHASE
#define MK_PER_PHASE 0
#endif
extern "C" void kernel_launch(void* const* d_in, const int* in_sizes, int n_in, void* d_out, int out_size, void* d_ws, size_t ws_size, hipStream_t stream) {
    static int grid = 0;
    if (grid == 0) {
        if (n_in != 25 || out_size != NTOK * DM || ws_size < WS_END) { fprintf(stderr, "kernel_launch: unexpected shapes / workspace (%d inputs, out %d, ws %zu < %zu)\n", n_in, out_size, ws_size, (size_t)WS_END); grid = -1; return; }
        int dev = 0, cus = 0, per_cu = 0;
        if (hipGetDevice(&dev) != hipSuccess || hipDeviceGetAttribute(&cus, hipDeviceAttributeMultiprocessorCount, dev) != hipSuccess) { grid = -1; return; }
        if (hipFuncSetAttribute((const void*)mk_fwd, hipFuncAttributeMaxDynamicSharedMemorySize, LDS_BYTES) != hipSuccess) { fprintf(stderr, "kernel_launch: hipFuncSetAttribute failed\n"); grid = -1; return; }
        if (hipOccupancyMaxActiveBlocksPerMultiprocessor(&per_cu, (const void*)mk_fwd, 512, LDS_BYTES) != hipSuccess || per_cu < 1) { fprintf(stderr, "kernel_launch: occupancy query reports %d\n", per_cu); }
        (void)hipGetLastError();
        grid = cus;
    }
    if (grid < 0) return;
    (void)hipMemsetAsync((char*)d_ws + WS_CTL, 0, CTL_BYTES, stream);
    Args a{};
    for (int i = 0; i < 25; ++i) a.in[i] = (const float*)d_in[i];
    a.out = (float*)d_out; a.ws = (unsigned char*)d_ws;
#if MK_PER_PHASE
    for (int p = 0; p < 7; ++p) { a.ph_lo = p; a.ph_hi = p + 1; hipLaunchKernelGGL(mk_fwd, dim3(grid), dim3(512), LDS_BYTES, stream, a); }
#else
    a.ph_lo = 0; a.ph_hi = 7;
    hipLaunchKernelGGL(mk_fwd, dim3(grid), dim3(512), LDS_BYTES, stream, a);
#endif
}
#endif
```

```cpp
#include <hip/hip_runtime.h>
#include <stdint.h>
#include <stdio.h>

typedef unsigned short bf16_t;
typedef float f32x2 __attribute__((ext_vector_type(2)));
typedef unsigned u32x2 __attribute__((ext_vector_type(2)));
using bf16x2v = __attribute__((ext_vector_type(2))) __bf16;

constexpr int NTOK = 8192, SEQ = 2048, DM = 2048, DPROJ = 4096;
constexpr float EPS = 1e-6f;
constexpr float LOG2E = 1.4426950408889634f;

constexpr size_t MB = 1024 * 1024;
constexpr size_t WS_CTL = 0;
constexpr size_t CTL_BYTES = 128 * 1024;
constexpr size_t CTL_QCTR = 16384;
constexpr size_t CTL_RSS_ATTN = 32768, CTL_RSS_SSM = 65536, CTL_RSS_X1 = 98304;
constexpr size_t WS_HB = 256 * 1024;
constexpr size_t WS_WINT = WS_HB + 32 * MB;
constexpr size_t WS_GLUT = WS_WINT + 16 * MB;
constexpr size_t WS_WOUTT = WS_GLUT + 2 * MB;
constexpr size_t WS_WPT = WS_WOUTT + 8 * MB;
constexpr size_t WS_UB = WS_WPT + 8 * MB;
constexpr size_t WS_VB = WS_UB + 32 * MB;
constexpr size_t WS_SU = WS_VB + 32 * MB;
constexpr size_t WS_SV = WS_SU + 65536;
constexpr size_t WS_PROJ = WS_SV + 65536;
constexpr size_t WS_QF = WS_PROJ + 64 * MB;
constexpr size_t WS_KF = WS_QF + 48 * MB;
constexpr size_t WS_VT = WS_KF + 48 * MB;
constexpr size_t WS_QN = WS_QF, WS_KN = WS_KF;
constexpr size_t WS_YB = WS_VT + 48 * MB + 4096;
constexpr size_t WS_MIXED = WS_YB + 16 * MB;
constexpr size_t WS_SSMP = WS_MIXED + 32 * MB;
constexpr size_t SSMP_ABAR = 0, SSMP_A256 = 32768, SSMP_BFRAG = 65536, SSMP_CFRAG = 65536 + 524288;
constexpr size_t WS_BTAB = WS_SSMP + 1 * MB;
constexpr size_t WS_END = WS_BTAB + 64 * 1024;

constexpr int LDS_BYTES = 147456;
constexpr int MISC_OFF = 147456 - 256;
#define XB_TMO      128
#define XB_XCNT(j)  (256  + 64 * (j))
#define XB_XSUB(j)  (1280 + 64 * (j))
#define XB_XGEN(j)  (2304 + 64 * (j))
#define XB_TOP      3328
#define XB_TOPGEN   3392
#define XCD_BAR_WORDS 3456
#define XB_SPIN_CAP (1u << 18)
#define LAS __attribute__((address_space(3)))

__device__ __forceinline__ unsigned xb_ld(unsigned* p)              { return __hip_atomic_load(p, __ATOMIC_RELAXED, __HIP_MEMORY_SCOPE_AGENT); }
__device__ __forceinline__ unsigned xb_add(unsigned* p, unsigned v) { return __hip_atomic_fetch_add(p, v, __ATOMIC_RELAXED, __HIP_MEMORY_SCOPE_AGENT); }
__device__ __forceinline__ unsigned xb_xcc_id() { return (unsigned)__builtin_amdgcn_s_getreg((3 << 11) | 20) & 0xFu; }
#define XB_SPIN(cond, bar) do { unsigned _sp = 0; while (cond) { __builtin_amdgcn_s_sleep(1); \
    if ((++_sp & 255u) == 0u) { if (xb_ld(&(bar)[XB_TMO])) break; if (_sp > XB_SPIN_CAP) { atomicAdd(&(bar)[XB_TMO], 1u); break; } } } } while (0)

struct XcdBarrier {
    unsigned* bar; unsigned x;
    volatile LAS unsigned* st;
};

__device__ __forceinline__ XcdBarrier xcd_barrier_post(unsigned* bar, volatile LAS unsigned* st) {
    XcdBarrier b; b.bar = bar; b.x = xb_xcc_id(); b.st = st;
    if (threadIdx.x == 0) (void)xb_add(&bar[XB_XCNT(b.x)], 1u);
    return b;
}
__device__ __forceinline__ void xcd_barrier_complete(unsigned* bar, unsigned x, unsigned& nloc, unsigned& nx) {
    const unsigned G = gridDim.x * gridDim.y * gridDim.z;
    unsigned sum, cnt, mine, sp = 0u;
    for (;;) {
        sum = 0u; cnt = 0u; mine = 0u;
#pragma unroll
        for (unsigned j = 0; j < 16; ++j) { const unsigned c = xb_ld(&bar[XB_XCNT(j)]); sum += c; cnt += (c > 0u) ? 1u : 0u; mine = (j == x) ? c : mine; }
        if (sum == G) break;
        __builtin_amdgcn_s_sleep(1);
        if ((++sp & 255u) == 0u) { if (xb_ld(&bar[XB_TMO])) break; if (sp > XB_SPIN_CAP) { atomicAdd(&bar[XB_TMO], 1u); break; } }
    }
    nloc = mine > 0u ? mine : 1u; nx = cnt > 0u ? cnt : 1u;
}

__device__ __forceinline__ void xcd_barrier(const XcdBarrier& b) {
    asm volatile("s_waitcnt vmcnt(0)" ::: "memory");
    __syncthreads();
    if (threadIdx.x == 0) {
        unsigned* bar = b.bar;
        __builtin_amdgcn_s_waitcnt(0);
        unsigned nloc = b.st[0], nx = b.st[1];
        if (nloc == 0u) { xcd_barrier_complete(bar, b.x, nloc, nx); b.st[0] = nloc; b.st[1] = nx; }
        const unsigned old = xb_add(&bar[XB_XSUB(b.x)], 1u);
        const unsigned gen = old / nloc;
        if (old + 1u == (gen + 1u) * nloc) {
            __builtin_amdgcn_fence(__ATOMIC_RELEASE, "agent");
            asm volatile("s_waitcnt vmcnt(0)" ::: "memory");
            const unsigned og = xb_add(&bar[XB_TOP], 1u);
            const unsigned tg = og / nx;
            if (og + 1u == (tg + 1u) * nx) xb_add(&bar[XB_TOPGEN], 1u);
            else XB_SPIN(xb_ld(&bar[XB_TOPGEN]) == tg, bar);
            __builtin_amdgcn_fence(__ATOMIC_ACQUIRE, "agent");
            xb_add(&bar[XB_XGEN(b.x)], 1u);
            asm volatile("s_waitcnt vmcnt(0)" ::: "memory");
        } else {
            XB_SPIN(xb_ld(&bar[XB_XGEN(b.x)]) == gen, bar);
            __builtin_amdgcn_fence(__ATOMIC_ACQUIRE, "agent");
            asm volatile("s_waitcnt vmcnt(0)" ::: "memory");
        }
    }
    __syncthreads();
}
namespace pg8 {
#define PG8_LAS __attribute__((address_space(3)))
typedef unsigned short bf16_t;
typedef short bf16x8 __attribute__((ext_vector_type(8)));
typedef float f32x4 __attribute__((ext_vector_type(4)));
typedef unsigned u32x4 __attribute__((ext_vector_type(4)));
constexpr int BM = 256, BK = 64, HALF = 128, HTB = HALF * BK * 2  , STAGE_BYTES = 8 * HTB, NXCD = 8, WGM = 8;

__host__ __device__ __forceinline__ int lds_byte(int r, int c) { const int st = (r >> 4) * 2 + (c >> 5), rr = r & 15, cc = c & 31, ob = rr * 64 + cc * 2; return st * 1024 + (ob ^ (((ob >> 9) & 1) << 5)); }
__host__ __device__ __forceinline__ void stage_rc(int b, int& R, int& C) { const int st = b / 1024, sb = b % 1024, swz = sb ^ (((sb >> 9) & 1) << 5); R = (st >> 1) * 16 + swz / 64; C = (st & 1) * 32 + (swz % 64) / 2; }
__host__ __device__ __forceinline__ int perm32(int rho) { const int n = rho >> 4, i = rho & 15; return 8 * (i >> 2) + 4 * n + (i & 3); }

struct Unit { int pm, pn; };
struct Gemm { const bf16_t* A; const bf16_t* Bt; int M, N, K; };

struct StaticOrder {
    int nM, nN, nwg, G, c;
    __host__ __device__ void init(int M, int N, int G_, int c_) { nM = M / BM; nN = N / BM; nwg = nM * nN; G = G_; c = c_; }
    __host__ __device__ bool next(int i, Unit& u) const {
        const long L = (long)i * G + c; if (L >= nwg) return false;
        int wgid = (int)L; { const int q = nwg / NXCD, r = nwg % NXCD, xcd = wgid % NXCD, off = wgid / NXCD; wgid = (xcd < r ? xcd * (q + 1) : r * (q + 1) + (xcd - r) * q) + off; }
        const int nig = WGM * nN, gid = wgid / nig, fm = gid * WGM, gsz = (nM - fm) < WGM ? (nM - fm) : WGM;
        u.pm = fm + ((wgid % nig) % gsz); u.pn = (wgid % nig) / gsz; return true;
    }
    __device__ __forceinline__ void a_ready(const Unit&) const {}
    __device__ __forceinline__ void done(const Unit&) const {}
};
typedef float cvt_f32x2 __attribute__((ext_vector_type(2)));
typedef __bf16 cvt_bf16x2 __attribute__((ext_vector_type(2)));
__device__ __forceinline__ unsigned cvt_pk_bf16(float lo, float hi) { return __builtin_bit_cast(unsigned, __builtin_convertvector((cvt_f32x2){lo, hi}, cvt_bf16x2)); }
__device__ __forceinline__ float bflo(unsigned u) { return __uint_as_float(u << 16); }
__device__ __forceinline__ float bfhi(unsigned u) { return __uint_as_float(u & 0xffff0000u); }

struct EpiProj {
    static constexpr bool PERM = true, AFTER_DRAIN = false, HAS_MID = false;
    bf16_t* O; int ldc;
    __device__ __forceinline__ void mid(f32x4 (&)[2][2][4][2], const Unit&, int, int, int, int) const {}
    __device__ __forceinline__ void operator()(const f32x4 (&acc)[2][2][4][2], const Unit& u, int wr, int wc, int fr, int fq) const {
        const int row0 = u.pm * BM + wr * 64 + fr, col0 = u.pn * BM + wc * 32 + 8 * fq;
#pragma unroll
        for (int ai = 0; ai < 2; ++ai)
#pragma unroll
            for (int m = 0; m < 4; ++m) { bf16_t* rowp = O + (size_t)(row0 + ai * HALF + m * 16) * ldc + col0;
#pragma unroll
                for (int bj = 0; bj < 2; ++bj) { const f32x4 v0 = acc[ai][bj][m][0], v1 = acc[ai][bj][m][1];
                    u32x4 w; w.x = cvt_pk_bf16(v0[0], v0[1]); w.y = cvt_pk_bf16(v0[2], v0[3]); w.z = cvt_pk_bf16(v1[0], v1[1]); w.w = cvt_pk_bf16(v1[2], v1[3]);
                    *(u32x4*)(rowp + bj * HALF) = w; } }
    }
};

struct EpiGlu {
    static constexpr bool PERM = true, AFTER_DRAIN = false, HAS_MID = false;
    const bf16_t* Y; bf16_t* O; const float* bias; float* rss;
    __device__ __forceinline__ void mid(f32x4 (&)[2][2][4][2], const Unit&, int, int, int, int) const {}
    __device__ __forceinline__ void operator()(const f32x4 (&acc)[2][2][4][2], const Unit& u, int wr, int wc, int fr, int fq) const {
        const int row0 = u.pm * BM + wr * 64 + fr, col0 = u.pn * BM + wc * 32 + 8 * fq;
        f32x4 bv[2][2];
#pragma unroll
        for (int bj = 0; bj < 2; ++bj)
#pragma unroll
            for (int n = 0; n < 2; ++n) bv[bj][n] = *(const f32x4*)(bias + col0 + bj * HALF + 4 * n);
#pragma unroll
        for (int ai = 0; ai < 2; ++ai)
#pragma unroll
            for (int m = 0; m < 4; ++m) { const int row = row0 + ai * HALF + m * 16; float ss = 0.f;
#pragma unroll
                for (int bj = 0; bj < 2; ++bj) {
                    const u32x4 yv = *(const u32x4*)(Y + (size_t)row * 1024 + col0 + bj * HALF);
                    const f32x4 g0 = acc[ai][bj][m][0] + bv[bj][0], g1 = acc[ai][bj][m][1] + bv[bj][1];
                    float y[8] = {bflo(yv.x), bfhi(yv.x), bflo(yv.y), bfhi(yv.y), bflo(yv.z), bfhi(yv.z), bflo(yv.w), bfhi(yv.w)};
                    float o[8];
#pragma unroll
                    for (int e = 0; e < 4; ++e) { o[e] = y[e] * __builtin_amdgcn_rcpf(1.f + __expf(-g0[e])); o[4 + e] = y[4 + e] * __builtin_amdgcn_rcpf(1.f + __expf(-g1[e])); }
#pragma unroll
                    for (int e = 0; e < 8; ++e) ss += o[e] * o[e];
                    u32x4 w; w.x = cvt_pk_bf16(o[0], o[1]); w.y = cvt_pk_bf16(o[2], o[3]); w.z = cvt_pk_bf16(o[4], o[5]); w.w = cvt_pk_bf16(o[6], o[7]);
                    *(u32x4*)(O + (size_t)row * 2048 + col0 + bj * HALF) = w; }
                ss += __shfl_xor(ss, 16); ss += __shfl_xor(ss, 32);
                if (fq == 0) unsafeAtomicAdd(rss + row, ss); }
    }
};

struct EpiWout {
    static constexpr bool PERM = true, AFTER_DRAIN = false, HAS_MID = true;
    const float* X; float* OUT; bf16_t* XB; float* rss_x; const PG8_LAS float* tab;
    __device__ __forceinline__ void mid(f32x4 (&acc)[2][2][4][2], const Unit& u, int wr, int wc, int fr, int fq) const {
        const PG8_LAS float* tp = tab + wr * 64 + fr;
#pragma unroll
        for (int ai = 0; ai < 2; ++ai)
#pragma unroll
            for (int m = 0; m < 4; ++m) { const float ratio = tp[ai * HALF + m * 16];
#pragma unroll
                for (int bj = 0; bj < 2; ++bj)
#pragma unroll
                    for (int n = 0; n < 2; ++n) acc[ai][bj][m][n] *= ratio; }
    }
    __device__ __forceinline__ void operator()(const f32x4 (&acc)[2][2][4][2], const Unit& u, int wr, int wc, int fr, int fq) const {
        const int row0 = u.pm * BM + wr * 64 + fr, col0 = u.pn * BM + wc * 32 + 8 * fq;
        const PG8_LAS float* tp = tab + 256 + wr * 64 + fr;
#pragma unroll
        for (int ai = 0; ai < 2; ++ai)
#pragma unroll
            for (int m = 0; m < 4; ++m) { const int row = row0 + ai * HALF + m * 16; float ss = 0.f;
                const float rs = tp[ai * HALF + m * 16];
#pragma unroll
                for (int bj = 0; bj < 2; ++bj) { const size_t o = (size_t)row * 2048 + col0 + bj * HALF;
                    const f32x4 x0 = *(const f32x4*)(X + o), x1 = *(const f32x4*)(X + o + 4);
                    const f32x4 v0 = x0 + rs * acc[ai][bj][m][0], v1 = x1 + rs * acc[ai][bj][m][1];
                    *(f32x4*)(OUT + o) = v0; *(f32x4*)(OUT + o + 4) = v1;
                    u32x4 w; w.x = cvt_pk_bf16(v0[0], v0[1]); w.y = cvt_pk_bf16(v0[2], v0[3]); w.z = cvt_pk_bf16(v1[0], v1[1]); w.w = cvt_pk_bf16(v1[2], v1[3]);
                    *(u32x4*)(XB + o) = w;
#pragma unroll
                    for (int e = 0; e < 4; ++e) ss += v0[e] * v0[e] + v1[e] * v1[e]; }
                ss += __shfl_xor(ss, 16); ss += __shfl_xor(ss, 32);
                if (fq == 0) unsafeAtomicAdd(rss_x + row, ss); }
    }
};

struct EpiScores {
    static constexpr bool PERM = false, AFTER_DRAIN = false, HAS_MID = false;
    float* C; const float* rss_x;
    __device__ __forceinline__ void mid(f32x4 (&)[2][2][4][2], const Unit&, int, int, int, int) const {}
    __device__ __forceinline__ void operator()(const f32x4 (&acc)[2][2][4][2], const Unit& u, int wr, int wc, int fr, int fq) const {
        const int row0 = u.pm * BM + wr * 64 + fr, col0 = u.pn * BM + wc * 32 + 4 * fq;
#pragma unroll
        for (int ai = 0; ai < 2; ++ai)
#pragma unroll
            for (int m = 0; m < 4; ++m) { const int row = row0 + ai * HALF + m * 16;
                const float r2 = __builtin_amdgcn_rsqf(rss_x[row] * (1.f / 2048.f) + 1e-6f);
                float* rowp = C + (size_t)row * 2048 + col0;
#pragma unroll
                for (int bj = 0; bj < 2; ++bj)
#pragma unroll
                    for (int n = 0; n < 2; ++n) *(f32x4*)(rowp + bj * HALF + n * 16) = acc[ai][bj][m][n] * r2; }
    }
};

template <class Epi, class Sched, bool STAMP = false>
__device__ __forceinline__ void gemm_phase(PG8_LAS unsigned char* lds, const Gemm g, const Sched& S, const Epi& E, unsigned long long* stamps) {
    const int tid = threadIdx.x, wid = __builtin_amdgcn_readfirstlane(tid >> 6), lane = tid & 63, wr = wid >> 2, wc = wid & 3, fr = lane & 15, fq = lane >> 4;
    const int K = g.K, nt = K / BK;
    int ts_lo = 0, ts_hi = 0, nts = 0; const unsigned long long rt_entry = STAMP ? (unsigned long long)wall_clock64() : 0ull;
#define PG8_STAMP() do { if (STAMP && wid == 0 && nts < 64) { const unsigned long long _c = (unsigned long long)clock64(); \
        ts_lo = (lane == nts) ? (int)(unsigned)_c : ts_lo; ts_hi = (lane == nts) ? (int)(unsigned)(_c >> 32) : ts_hi; ++nts; } } while (0)
    PG8_STAMP();
    unsigned voffA[2], voffB[2];
#pragma unroll
    for (int i = 0; i < 2; ++i) { int R, C; stage_rc(tid * 16 + i * 8192, R, C); const int Rb = Epi::PERM ? ((R & ~31) + perm32(R & 31)) : R;
        voffA[i] = (unsigned)(R * K + C) * 2u; voffB[i] = (unsigned)(Rb * K + C) * 2u; }
    const size_t kstep = (size_t)(BK * 2);
    const size_t hstep = (size_t)HALF * K * 2;
    const size_t tstep = 2 * hstep;
    const unsigned ldsw = (unsigned)wid * 1024u;
    const int aoff = lds_byte(wr * 64 + fr, fq * 8), boff = lds_byte(wc * 32 + fr, fq * 8);
#define PG8_SA(b, h) (((b) * 2 + (h)) * HTB)
#define PG8_SB(b, h) ((4 + (b) * 2 + (h)) * HTB)
#define PG8_STAGE(bufoff, gbase, voff) do { _Pragma("unroll") for (int _i = 0; _i < 2; ++_i) \
        __builtin_amdgcn_global_load_lds((const unsigned*)((const char*)(gbase) + (voff)[_i]), (PG8_LAS unsigned*)(lds + (bufoff) + ldsw + _i * 8192), 16, 0, 0); } while (0)
#define PG8_LDA(dst, b, h) do { _Pragma("unroll") for (int m = 0; m < 4; ++m) _Pragma("unroll") for (int k = 0; k < 2; ++k) dst[m][k] = *(const PG8_LAS bf16x8*)(lds + PG8_SA(b, h) + aoff + m * 2048 + k * 1024); } while (0)
#define PG8_LDB(dst, b, h) do { _Pragma("unroll") for (int n = 0; n < 2; ++n) _Pragma("unroll") for (int k = 0; k < 2; ++k) dst[n][k] = *(const PG8_LAS bf16x8*)(lds + PG8_SB(b, h) + boff + n * 2048 + k * 1024); } while (0)
#define PG8_MMA(ai, bj, At, Bt) do { __builtin_amdgcn_s_setprio(1); _Pragma("unroll") for (int m = 0; m < 4; ++m) _Pragma("unroll") for (int n = 0; n < 2; ++n) _Pragma("unroll") for (int k = 0; k < 2; ++k) \
        acc[ai][bj][m][n] = __builtin_amdgcn_mfma_f32_16x16x32_bf16(Bt[n][k], At[m][k], acc[ai][bj][m][n], 0, 0, 0); __builtin_amdgcn_s_setprio(0); } while (0)
#define PG8_WAIT_V(n) asm volatile("s_waitcnt vmcnt(" #n ")" ::: "memory")
#define PG8_WAIT_L(n) asm volatile("s_waitcnt lgkmcnt(" #n ")" ::: "memory")
#define PG8_BAR __builtin_amdgcn_s_barrier()
#define PG8_SCHED __builtin_amdgcn_sched_barrier(0)
    Unit cur, nxt; int ui = 0;
    if (!S.next(0, cur)) return;
    f32x4 acc[2][2][4][2];
#pragma unroll
    for (int a = 0; a < 2; ++a)
#pragma unroll
        for (int b = 0; b < 2; ++b)
#pragma unroll
            for (int m = 0; m < 4; ++m)
#pragma unroll
                for (int n = 0; n < 2; ++n) acc[a][b][m][n] = (f32x4){0.f, 0.f, 0.f, 0.f};
    bf16x8 At[4][2], B0[2][2], B1[2][2];
    const char* cA = (const char*)g.A + (size_t)cur.pm * tstep; const char* cB = (const char*)g.Bt + (size_t)cur.pn * tstep;
    S.a_ready(cur);
    PG8_STAGE(PG8_SB(0, 0), cB, voffB); PG8_STAGE(PG8_SA(0, 0), cA, voffA); PG8_STAGE(PG8_SB(0, 1), cB + hstep, voffB); PG8_STAGE(PG8_SA(0, 1), cA + hstep, voffA);
    if (wr == 1) PG8_BAR;
    PG8_WAIT_V(4); PG8_BAR;
    PG8_STAGE(PG8_SB(1, 0), cB + kstep, voffB); PG8_STAGE(PG8_SA(1, 0), cA + kstep, voffA); PG8_STAGE(PG8_SB(1, 1), cB + hstep + kstep, voffB);
    PG8_WAIT_V(6); PG8_BAR;
    PG8_STAMP();
    for (;;) {
        const bool has_next = S.next(ui + 1, nxt);
        const char* nA = has_next ? (const char*)g.A + (size_t)nxt.pm * tstep : cA; const char* nB = has_next ? (const char*)g.Bt + (size_t)nxt.pn * tstep : cB;
        for (int t = 0; t < nt; t += 2) {
            const bool last = (t == nt - 2);
            const char* a1 = cA + (size_t)(t + 1) * kstep;
            const char* a2 = last ? nA : cA + (size_t)(t + 2) * kstep; const char* b2 = last ? nB : cB + (size_t)(t + 2) * kstep;
            const char* a3 = a2 + kstep; const char* b3 = b2 + kstep;
            if (last && has_next) S.a_ready(nxt);
            if constexpr (Epi::HAS_MID) { if (t == (nt >> 1)) { E.mid(acc, cur, wr, wc, fr, fq); asm volatile("s_waitcnt lgkmcnt(0)" ::: "memory"); } }
            PG8_LDB(B0, 0, 0); PG8_SCHED; PG8_LDA(At, 0, 0); PG8_STAGE(PG8_SA(1, 1), a1 + hstep, voffA);
            PG8_WAIT_L(8); PG8_BAR; PG8_WAIT_L(0); PG8_MMA(0, 0, At, B0); PG8_BAR; PG8_SCHED;
            PG8_LDB(B1, 0, 1); PG8_STAGE(PG8_SB(0, 0), b2, voffB);
            PG8_BAR; PG8_WAIT_L(0); PG8_MMA(0, 1, At, B1); PG8_BAR;
            PG8_LDA(At, 0, 1); PG8_STAGE(PG8_SA(0, 0), a2, voffA);
            PG8_BAR; PG8_WAIT_L(0); PG8_MMA(1, 0, At, B0); PG8_BAR; PG8_SCHED;
            PG8_STAGE(PG8_SB(0, 1), b2 + hstep, voffB);
            PG8_WAIT_V(6); PG8_BAR; PG8_MMA(1, 1, At, B1); PG8_BAR;
            PG8_LDB(B0, 1, 0); PG8_SCHED; PG8_LDA(At, 1, 0); PG8_STAGE(PG8_SA(0, 1), a2 + hstep, voffA);
            PG8_WAIT_L(8); PG8_BAR; PG8_WAIT_L(0); PG8_MMA(0, 0, At, B0); PG8_BAR; PG8_SCHED;
            PG8_LDB(B1, 1, 1); PG8_STAGE(PG8_SB(1, 0), b3, voffB);
            PG8_BAR; PG8_WAIT_L(0); PG8_MMA(0, 1, At, B1); PG8_BAR;
            PG8_LDA(At, 1, 1); PG8_STAGE(PG8_SA(1, 0), a3, voffA);
            PG8_BAR; PG8_WAIT_L(0); PG8_MMA(1, 0, At, B0); PG8_BAR; PG8_SCHED;
            PG8_STAGE(PG8_SB(1, 1), b3 + hstep, voffB);
            PG8_WAIT_V(6); PG8_BAR; PG8_MMA(1, 1, At, B1); PG8_BAR;
        }
        PG8_STAMP();
        if constexpr (!Epi::AFTER_DRAIN) { E(acc, cur, wr, wc, fr, fq); S.done(cur); }
        PG8_STAMP();
        if (!has_next) break;
#pragma unroll
        for (int a = 0; a < 2; ++a)
#pragma unroll
            for (int b = 0; b < 2; ++b)
#pragma unroll
                for (int m = 0; m < 4; ++m)
#pragma unroll
                    for (int n = 0; n < 2; ++n) acc[a][b][m][n] = (f32x4){0.f, 0.f, 0.f, 0.f};
        cur = nxt; cA = nA; cB = nB; ++ui;
    }
    PG8_WAIT_V(0);
    if (wr == 0) PG8_BAR;
    PG8_BAR;
    if constexpr (Epi::AFTER_DRAIN) { E.fused(acc, cur, wr, wc, fr, fq, lds, wid, lane); S.done(cur); }
    PG8_STAMP();
    if (STAMP && wid == 0) { stamps[lane] = lane < nts ? (((unsigned long long)(unsigned)ts_hi << 32) | (unsigned)ts_lo) : 0ull;
        if (lane == 62) stamps[62] = rt_entry; if (lane == 63) stamps[63] = (unsigned long long)wall_clock64(); }
#undef PG8_STAMP
#undef PG8_SA
#undef PG8_SB
#undef PG8_STAGE
#undef PG8_LDA
#undef PG8_LDB
#undef PG8_MMA
#undef PG8_WAIT_V
#undef PG8_WAIT_L
#undef PG8_BAR
#undef PG8_SCHED
}
}

typedef short bf16x8 __attribute__((ext_vector_type(8)));
typedef float f32x4 __attribute__((ext_vector_type(4)));
typedef unsigned u32x4 __attribute__((ext_vector_type(4)));
using pg8::cvt_pk_bf16; using pg8::bflo; using pg8::bfhi;

#define LDS_WAIT() asm volatile("s_waitcnt lgkmcnt(0)" ::: "memory")
#define CBAR() asm volatile("" ::: "memory")
#define MFMA16(a, b, c) __builtin_amdgcn_mfma_f32_16x16x32_bf16((a), (b), (c), 0, 0, 0)

struct Args { const float* in[25]; float* out; unsigned char* ws; int ph_lo, ph_hi; };

__device__ __forceinline__ float wave_sum(float v) {
#pragma unroll
    for (int o = 1; o < 64; o <<= 1) v += __shfl_xor(v, o);
    return v;
}
__device__ __forceinline__ float wave_max(float v) {
#pragma unroll
    for (int o = 1; o < 64; o <<= 1) v = fmaxf(v, __shfl_xor(v, o));
    return v;
}
__device__ __forceinline__ float gelu_erf(float x) { return 0.5f * x * (1.0f + erff(x * 0.70710678118654752f)); }
__device__ __forceinline__ bf16x8 as_bf16x8(u32x4 v) { return __builtin_bit_cast(bf16x8, v); }

__device__ __forceinline__ void p0_transpose_item(const float* W, int K, int N, bf16_t* WT, const float* sc_a, const float* sc_b, LAS float* scr, int item, int lane) {
    const int nblk = N / 32, kb = item / nblk, nb = item % nblk, k0 = 64 * kb, n0 = 32 * nb;
#pragma unroll 8
    for (int i = 0; i < 32; ++i) { const int kk = 2 * i + (lane >> 5); const int k = k0 + kk;
        const float s = sc_a ? (k < 1024 ? sc_a[k] : sc_b[k - 1024]) : 1.f;
        scr[kk * 33 + (lane & 31)] = W[(size_t)k * N + n0 + (lane & 31)] * s; }
    LDS_WAIT();
    const int c = lane & 7;
#pragma unroll
    for (int j = 0; j < 4; ++j) { const int n = (lane >> 3) + 8 * j; const LAS float* s = scr + (8 * c) * 33 + n;
        u32x4 o; o.x = cvt_pk_bf16(s[0 * 33], s[1 * 33]); o.y = cvt_pk_bf16(s[2 * 33], s[3 * 33]); o.z = cvt_pk_bf16(s[4 * 33], s[5 * 33]); o.w = cvt_pk_bf16(s[6 * 33], s[7 * 33]);
        *(u32x4*)(WT + (size_t)(n0 + n) * K + k0 + 8 * c) = o; }
    LDS_WAIT();
}
template <int MODE> __device__ __forceinline__ void p0_row(const float* xrow, const float* g, bf16_t* orow, int lane) {
    const f32x4* xr = (const f32x4*)xrow + lane; const f32x4* gr = (const f32x4*)g + lane;
    f32x4 v[8]; float s = 0.f;
#pragma unroll
    for (int j = 0; j < 8; ++j) { v[j] = xr[64 * j]; s += (v[j].x * v[j].x + v[j].y * v[j].y) + (v[j].z * v[j].z + v[j].w * v[j].w); }
    float r = 1.f;
    if (MODE == 0) r = 1.0f / sqrtf(wave_sum(s) * (1.f / 2048.f) + EPS);
    u32x2* o8 = (u32x2*)orow + lane;
#pragma unroll
    for (int j = 0; j < 8; ++j) { f32x4 w = v[j] * r; if (MODE != 2) w = w * gr[64 * j];
        u32x2 o; o.x = cvt_pk_bf16(w.x, w.y); o.y = cvt_pk_bf16(w.z, w.w); o8[64 * j] = o; }
}
template <bool SCALE_G, bool OFFS> __device__ __forceinline__ void p0_row_q8(const float* xrow, const float* g, unsigned char* orow, float* sc, int lane) {
    const f32x4* xr = (const f32x4*)xrow + lane; const f32x4* gr = (const f32x4*)g + lane;
    f32x4 v[8]; float m = 0.f;
#pragma unroll
    for (int j = 0; j < 8; ++j) { v[j] = xr[64 * j]; if (SCALE_G) v[j] = v[j] * gr[64 * j];
        m = fmaxf(fmaxf(m, fmaxf(fabsf(v[j].x), fabsf(v[j].y))), fmaxf(fabsf(v[j].z), fabsf(v[j].w))); }
    m = fmaxf(wave_max(m), 1e-30f);
    const float inv = 127.f / m;
    if (lane == 0) *sc = m * (1.f / 127.f);
    unsigned* o4 = (unsigned*)orow + lane;
#pragma unroll
    for (int j = 0; j < 8; ++j) { const int a = (int)rintf(v[j].x * inv) + (OFFS ? 128 : 0), b = (int)rintf(v[j].y * inv) + (OFFS ? 128 : 0), c = (int)rintf(v[j].z * inv) + (OFFS ? 128 : 0), d = (int)rintf(v[j].w * inv) + (OFFS ? 128 : 0);
        o4[64 * j] = (unsigned)(a & 255) | ((unsigned)(b & 255) << 8) | ((unsigned)(c & 255) << 16) | ((unsigned)(d & 255) << 24); }
}
__device__ __forceinline__ void p0_wp_item(const float* wq, const float* keys1, const float* keys2, const float* gffn, bf16_t* WPT, int item, int lane) {
    const int hj = item >> 7, ib = item & 127, h = hj >> 1, j = hj & 1, i0 = 16 * ib, col0 = h * 256 + j * 128;
    const int lr = lane & 15, g = lane >> 4;
    const float* keys = (j ? keys2 : keys1) + (size_t)h * 128 * 128;
    const float gi = gffn[i0 + lr];
    bf16x8 af[4];
#pragma unroll
    for (int s = 0; s < 4; ++s) { const float* p = wq + (size_t)(i0 + lr) * 2048 + col0 + 32 * s + 8 * g;
        const f32x4 a = *(const f32x4*)p * gi, b = *(const f32x4*)(p + 4) * gi;
        u32x4 w; w.x = cvt_pk_bf16(a.x, a.y); w.y = cvt_pk_bf16(a.z, a.w); w.z = cvt_pk_bf16(b.x, b.y); w.w = cvt_pk_bf16(b.z, b.w); af[s] = as_bf16x8(w); }
    for (int kt = 0; kt < 8; ++kt) {
        f32x4 d = {0.f, 0.f, 0.f, 0.f};
#pragma unroll
        for (int s = 0; s < 4; ++s) { const float* p = keys + (size_t)(16 * kt + lr) * 128 + 32 * s + 8 * g;
            const f32x4 a = *(const f32x4*)p, b = *(const f32x4*)(p + 4);
            u32x4 w; w.x = cvt_pk_bf16(a.x, a.y); w.y = cvt_pk_bf16(a.z, a.w); w.z = cvt_pk_bf16(b.x, b.y); w.w = cvt_pk_bf16(b.z, b.w);
            d = MFMA16(af[s], as_bf16x8(w), d); }
        u32x2 o; o.x = cvt_pk_bf16(d[0], d[1]); o.y = cvt_pk_bf16(d[2], d[3]);
        *(u32x2*)(WPT + (size_t)(hj * 128 + 16 * kt + lr) * 2048 + i0 + 4 * g) = o;
    }
}
__device__ __forceinline__ int t5_bucket(int n) {
    if (n < 16) return n;
    const int large = 16 + (int)(logf((float)n / 16.f) / 4.852030263919617f * 16.f);
    return large < 31 ? large : 31;
}
__device__ __forceinline__ void p0_ssm_item(const Args& A, unsigned char* sp, int g, int lane) {
    const float* lam_re = A.in[6]; const float* lam_im = A.in[7]; const float* log_dt = A.in[8];
    const float* b_re = A.in[9]; const float* b_im = A.in[10]; const float* c_re = A.in[11]; const float* c_im = A.in[12];
    const int n = lane;
    const float dt = expf(log_dt[g]);
    const float lr = lam_re[g * 64 + n], li = lam_im[g * 64 + n];
    const float mag = expf(lr * dt);
    const float a_re = mag * cosf(li * dt), a_im = mag * sinf(li * dt);
    const float den = lr * lr + li * li;
    const float f_re = ((a_re - 1.f) * lr + a_im * li) / den, f_im = (a_im * lr - (a_re - 1.f) * li) / den;
    ((f32x2*)(sp + SSMP_ABAR))[g * 64 + n] = (f32x2){a_re, a_im};
    float pr = a_re, pi = a_im;
#pragma unroll
    for (int i = 0; i < 8; ++i) { const float nr = pr * pr - pi * pi, ni = 2.f * pr * pi; pr = nr; pi = ni; }
    ((f32x2*)(sp + SSMP_A256))[g * 64 + n] = (f32x2){pr, pi};
    float bbr[16], bbi[16];
#pragma unroll
    for (int q = 0; q < 4; ++q) { const f32x4 br = *(const f32x4*)(b_re + (size_t)(g * 64 + n) * 16 + 4 * q), bi = *(const f32x4*)(b_im + (size_t)(g * 64 + n) * 16 + 4 * q);
#pragma unroll
        for (int e = 0; e < 4; ++e) { bbr[4 * q + e] = f_re * br[e] - f_im * bi[e]; bbi[4 * q + e] = f_re * bi[e] + f_im * br[e]; } }
    bf16_t* bf = (bf16_t*)(sp + SSMP_BFRAG);
    const int jre = n >> 4, n16 = n & 15;
#pragma unroll
    for (int kg = 0; kg < 4; ++kg) {
        u32x4 wr = {0u, 0u, 0u, 0u}, wi = {0u, 0u, 0u, 0u};
        if (kg < 2) { const int c0 = (kg & 1) * 8;
            wr.x = cvt_pk_bf16(bbr[c0 + 0], bbr[c0 + 1]); wr.y = cvt_pk_bf16(bbr[c0 + 2], bbr[c0 + 3]); wr.z = cvt_pk_bf16(bbr[c0 + 4], bbr[c0 + 5]); wr.w = cvt_pk_bf16(bbr[c0 + 6], bbr[c0 + 7]);
            wi.x = cvt_pk_bf16(bbi[c0 + 0], bbi[c0 + 1]); wi.y = cvt_pk_bf16(bbi[c0 + 2], bbi[c0 + 3]); wi.z = cvt_pk_bf16(bbi[c0 + 4], bbi[c0 + 5]); wi.w = cvt_pk_bf16(bbi[c0 + 6], bbi[c0 + 7]); }
        *(u32x4*)(bf + ((size_t)(g * 8 + jre) * 64 + kg * 16 + n16) * 8) = wr;
        *(u32x4*)(bf + ((size_t)(g * 8 + 4 + jre) * 64 + kg * 16 + n16) * 8) = wi;
    }
    bf16_t* cf = (bf16_t*)(sp + SSMP_CFRAG);
    const int ch = lane & 15, kg = lane >> 4;
#pragma unroll
    for (int s = 0; s < 4; ++s) { const int k0 = 32 * s + 8 * kg;
        const float* src = (k0 < 64) ? (c_re + (size_t)(g * 16 + ch) * 64 + k0) : (c_im + (size_t)(g * 16 + ch) * 64 + (k0 - 64));
        const float sg = (k0 < 64) ? 1.f : -1.f;
        const f32x4 a = *(const f32x4*)src * sg, b = *(const f32x4*)(src + 4) * sg;
        u32x4 w; w.x = cvt_pk_bf16(a.x, a.y); w.y = cvt_pk_bf16(a.z, a.w); w.z = cvt_pk_bf16(b.x, b.y); w.w = cvt_pk_bf16(b.z, b.w);
        *(u32x4*)(cf + ((size_t)(g * 4 + s) * 64 + lane) * 8) = w; }
}
__device__ __forceinline__ void p0_btab_item(const Args& A, float* btab, int item, int lane) {
    const float* gq = A.in[3]; const float* gk = A.in[4]; const float* rel_bias = A.in[5];
    const int h = item / 3, br = item % 3, d = br == 0 ? 1 : (br == 1 ? 4 : 16);
    const float G = wave_max(fabsf(gq[lane] * gk[lane]));
    const float mb = wave_max(lane < 32 ? rel_bias[lane * 16 + h] : -1e30f);
    const float smax = 8.4f * G + mb;
    for (int idx = lane; idx < 192; idx += 64) { const int rel = idx - 31;
        float v = -1e30f;
        if (rel >= 0 && rel <= 128) v = LOG2E * (rel_bias[t5_bucket(rel * d) * 16 + h] - smax);
        btab[(h * 3 + br) * 192 + idx] = v; }
}

__device__ __forceinline__ void p0_prologue(const Args& A, LAS unsigned char* lds, int wave, int lane) {
    unsigned char* ws = A.ws;
    LAS float* scr = (LAS float*)(lds + wave * 16384);
    const int gw = blockIdx.x * 8 + wave, NGW = gridDim.x * 8;
    constexpr int I_WIN = (2048 / 64) * (4096 / 32), I_GLU = (1024 / 64) * (1024 / 32), I_WOUT = (2048 / 64) * (2048 / 32), I_WP = 2048;
    constexpr int I_H = 8192, I_U = 16384, I_V = 16384, I_SSM = 64, I_BT = 48;
    constexpr int NITEMS = I_WIN + I_GLU + I_WOUT + I_WP + I_H + I_U + I_V + I_SSM + I_BT;
    for (int it = gw; it < NITEMS; it += NGW) {
        int r = it;
        if (r < I_SSM) { p0_ssm_item(A, ws + WS_SSMP, r, lane); continue; } r -= I_SSM;
        if (r < I_BT) { p0_btab_item(A, (float*)(ws + WS_BTAB), r, lane); continue; } r -= I_BT;
        if (r < I_WP) { p0_wp_item(A.in[20], A.in[21], A.in[22], A.in[19], (bf16_t*)(ws + WS_WPT), r, lane); continue; } r -= I_WP;
        if (r < I_WIN) { p0_transpose_item(A.in[2], 2048, 4096, (bf16_t*)(ws + WS_WINT), nullptr, nullptr, scr, r, lane); continue; } r -= I_WIN;
        if (r < I_GLU) { p0_transpose_item(A.in[14], 1024, 1024, (bf16_t*)(ws + WS_GLUT), nullptr, nullptr, scr, r, lane); continue; } r -= I_GLU;
        if (r < I_WOUT) { p0_transpose_item(A.in[18], 2048, 2048, (bf16_t*)(ws + WS_WOUTT), A.in[16], A.in[17], scr, r, lane); continue; } r -= I_WOUT;
        if (r < I_H) { p0_row<0>(A.in[0] + (size_t)r * 2048, A.in[1], (bf16_t*)(ws + WS_HB) + (size_t)r * 2048, lane); continue; } r -= I_H;
        if (r < I_U) { p0_row_q8<true, false>(A.in[23] + (size_t)r * 2048, A.in[19], ws + WS_UB + (size_t)r * 2048, (float*)(ws + WS_SU) + r, lane); continue; } r -= I_U;
        p0_row_q8<false, true>(A.in[24] + (size_t)r * 2048, A.in[19], ws + WS_VB + (size_t)r * 2048, (float*)(ws + WS_SV) + r, lane);
    }
}

constexpr int SSM_WL = 8192 + 16 * 272;
__device__ __forceinline__ void ssm_unit(const Args& A, LAS unsigned char* lds, int b, int g, int wave, int lane) {
    unsigned char* ws = A.ws; unsigned char* sp = ws + WS_SSMP;
    const bf16_t* proj = (const bf16_t*)(ws + WS_PROJ); bf16_t* yb = (bf16_t*)(ws + WS_YB);
    LAS unsigned char* wl = lds + wave * SSM_WL;
    LAS f32x2* BU = (LAS f32x2*)wl; LAS unsigned char* XB = wl + 8192;
    LAS f32x2* carry = (LAS f32x2*)(lds + 8 * SSM_WL);
    const int lr = lane & 15, q = lane >> 4;
    bf16x8 bfr[8], cfr[4];
#pragma unroll
    for (int j = 0; j < 8; ++j) bfr[j] = as_bf16x8(*(const u32x4*)((const bf16_t*)(sp + SSMP_BFRAG) + ((size_t)(g * 8 + j) * 64 + lane) * 8));
#pragma unroll
    for (int s = 0; s < 4; ++s) cfr[s] = as_bf16x8(*(const u32x4*)((const bf16_t*)(sp + SSMP_CFRAG) + ((size_t)(g * 4 + s) * 64 + lane) * 8));
    const f32x2 ab = ((const f32x2*)(sp + SSMP_ABAR))[g * 64 + lane], a256 = ((const f32x2*)(sp + SSMP_A256))[g * 64 + lane];
    const float a_re = ab.x, a_im = ab.y;
    const float dsk = A.in[13][g * 16 + lr];
    const bf16_t* up = proj + (size_t)(b * SEQ + wave * 256) * DPROJ + 3072 + g * 16;
    float xr = 0.f, xi = 0.f;
#ifdef MK_DEBUG2
    unsigned long long hdd = 0ull, hbu = 0ull, hua = 0ull;
#endif
    for (int pass = 0; pass < 2; ++pass) {
        for (int blk = 0; blk < 16; ++blk) {
            u32x4 uraw = {0u, 0u, 0u, 0u};
            if (q < 2) uraw = *(const u32x4*)(up + (size_t)(blk * 16 + lr) * DPROJ + 8 * q);
            const bf16x8 ua = as_bf16x8(uraw);
            f32x4 dd[8];
#pragma unroll
            for (int j = 0; j < 8; ++j) dd[j] = MFMA16(ua, bfr[j], ((f32x4){0.f, 0.f, 0.f, 0.f}));
#pragma unroll
            for (int jj = 0; jj < 4; ++jj)
#pragma unroll
                for (int r = 0; r < 4; ++r) BU[(4 * q + r) * 64 + 16 * jj + lr] = (f32x2){dd[jj][r], dd[4 + jj][r]};
            LDS_WAIT(); CBAR();
            f32x2 bu[16];
#pragma unroll
            for (int t = 0; t < 16; ++t) bu[t] = BU[t * 64 + lane];
#ifdef MK_DEBUG2
            if (pass == 0) {
#pragma unroll
                for (int j = 0; j < 8; ++j)
#pragma unroll
                    for (int r = 0; r < 4; ++r) hdd = hdd * 0x100000001B3ull + __float_as_uint(dd[j][r]);
#pragma unroll
                for (int t = 0; t < 16; ++t) { hbu = hbu * 0x100000001B3ull + __float_as_uint(bu[t].x); hbu = hbu * 0x100000001B3ull + __float_as_uint(bu[t].y); }
                hua = hua * 0x100000001B3ull + uraw.x; hua = hua * 0x100000001B3ull + uraw.y; hua = hua * 0x100000001B3ull + uraw.z; hua = hua * 0x100000001B3ull + uraw.w; }
#endif
            if (pass == 0) {
#pragma unroll
                for (int t = 0; t < 16; ++t) { float nr = fmaf(a_re, xr, fmaf(-a_im, xi, bu[t].x)), ni = fmaf(a_re, xi, fmaf(a_im, xr, bu[t].y)); asm volatile("" : "+v"(nr)); asm volatile("" : "+v"(ni)); xr = nr; xi = ni; }
                asm volatile("" : "+v"(xr), "+v"(xi) :: "memory");
            } else {
#pragma unroll
                for (int t = 0; t < 16; ++t) { float nr = fmaf(a_re, xr, fmaf(-a_im, xi, bu[t].x)), ni = fmaf(a_re, xi, fmaf(a_im, xr, bu[t].y)); asm volatile("" : "+v"(nr)); asm volatile("" : "+v"(ni)); xr = nr; xi = ni;
                    const unsigned pk = cvt_pk_bf16(xr, xi);
                    *(LAS unsigned short*)(XB + t * 272 + lane * 2) = (unsigned short)(pk & 0xffffu);
                    *(LAS unsigned short*)(XB + t * 272 + 128 + lane * 2) = (unsigned short)(pk >> 16); }
                LDS_WAIT(); CBAR();
                f32x4 y = {0.f, 0.f, 0.f, 0.f};
#pragma unroll
                for (int s = 0; s < 4; ++s) { const bf16x8 xa = as_bf16x8(*(const LAS u32x4*)(XB + lr * 272 + (32 * s + 8 * q) * 2)); y = MFMA16(xa, cfr[s], y); }
#pragma unroll
                for (int r = 0; r < 4; ++r) { const int t = blk * 16 + 4 * q + r;
                    const float uv = __uint_as_float((unsigned)up[(size_t)t * DPROJ + lr] << 16);
                    const float yv = gelu_erf(y[r] + dsk * uv);
                    yb[(size_t)(b * SEQ + wave * 256 + t) * 1024 + g * 16 + lr] = (bf16_t)(cvt_pk_bf16(yv, 0.f) & 0xffffu); }
                asm volatile("" : "+v"(xr), "+v"(xi) :: "memory");
            }
        }
        if (pass == 0) {
            carry[wave * 64 + lane] = (f32x2){xr, xi};
#ifdef MK_DEBUG2
            { unsigned long long* hp = (unsigned long long*)(ws + WS_END + 99 * MB);
              const unsigned long long km = (2ull * (((unsigned long long)(b * 64 + g) * 8 + wave) * 64 + lane) + 1ull) * 0x9E3779B97F4A7C15ull;
              atomicAdd(hp + 0, hua * km); atomicAdd(hp + 1, hdd * km); atomicAdd(hp + 2, hbu * km); }
            ((f32x2*)(ws + WS_END + 108 * MB))[((size_t)(b * 64 + g) * 8 + wave) * 64 + lane] = (f32x2){xr, xi};
#endif
            __syncthreads();
            float sr = 0.f, si = 0.f;
            for (int w2 = 0; w2 < wave; ++w2) { const f32x2 e = carry[w2 * 64 + lane]; const float nr = a256.x * sr - a256.y * si + e.x, ni = a256.x * si + a256.y * sr + e.y; sr = nr; si = ni; }
            xr = sr; xi = si;
#ifdef MK_DEBUG2
            ((f32x2*)(ws + WS_END + 109 * MB))[((size_t)(b * 64 + g) * 8 + wave) * 64 + lane] = (f32x2){xr, xi};
#endif
        }
    }
    __syncthreads();
}

__device__ __forceinline__ void prep2_item(const Args& A, LAS unsigned char* wl, int item, int lane) {
    unsigned char* ws = A.ws;
    const bf16_t* proj = (const bf16_t*)(ws + WS_PROJ);
    const int pb = item & 31, h = (item >> 5) & 15, b = item >> 9, P0 = pb * 64, bh = b * 16 + h;
    const int r8 = lane >> 3, c = lane & 7;
    const float* gq = A.in[3]; const float* gk = A.in[4];
    const int fs = c >> 2, fg = c & 3;
#pragma unroll 1
    for (int which = 0; which < 2; ++which) {
        const float* gv = which ? gk : gq; const float cs = which ? 1.f : (LOG2E * 0.125f);
        float gl[8];
#pragma unroll
        for (int e = 0; e < 8; ++e) gl[e] = gv[8 * c + e] * cs;
        bf16_t* F = (bf16_t*)(ws + (which ? WS_KF : WS_QF));
#pragma unroll 2
        for (int i = 0; i < 8; ++i) { const int row = 8 * i + r8, pos = P0 + row;
            const u32x4 raw = *(const u32x4*)(proj + (size_t)(b * SEQ + pos) * DPROJ + which * 1024 + h * 64 + 8 * c);
            float v[8] = {bflo(raw.x), bfhi(raw.x), bflo(raw.y), bfhi(raw.y), bflo(raw.z), bfhi(raw.z), bflo(raw.w), bfhi(raw.w)};
            float ss = 0.f;
#pragma unroll
            for (int e = 0; e < 8; ++e) ss += v[e] * v[e];
            ss += __shfl_xor(ss, 1); ss += __shfl_xor(ss, 2); ss += __shfl_xor(ss, 4);
            const float r = 1.0f / sqrtf(ss * (1.f / 64.f) + EPS);
            u32x4 w; w.x = cvt_pk_bf16(v[0] * r * gl[0], v[1] * r * gl[1]); w.y = cvt_pk_bf16(v[2] * r * gl[2], v[3] * r * gl[3]);
            w.z = cvt_pk_bf16(v[4] * r * gl[4], v[5] * r * gl[5]); w.w = cvt_pk_bf16(v[6] * r * gl[6], v[7] * r * gl[7]);
#pragma unroll
            for (int br = 0; br < 3; ++br) { const int sh = 2 * br, rr = pos & ((1 << sh) - 1), l = pos >> sh;
                *(u32x4*)(F + (size_t)br * 4 * 16 * SEQ * 64 + ((((size_t)(bh << sh) + rr) * (SEQ >> (sh + 4)) + (l >> 4)) * 2 + fs) * 512 + (fg * 16 + (l & 15)) * 8) = w; } }
    }
#pragma unroll
    for (int i = 0; i < 8; ++i) { const int row = 8 * i + r8;
        const u32x4 raw = *(const u32x4*)(proj + (size_t)(b * SEQ + P0 + row) * DPROJ + 2048 + h * 64 + 8 * c);
        *(LAS u32x2*)(wl + row * 136 + c * 16) = (u32x2){raw.x, raw.y}; *(LAS u32x2*)(wl + row * 136 + c * 16 + 8) = (u32x2){raw.z, raw.w}; }
    CBAR();
    unsigned v[64];
#pragma unroll
    for (int p = 0; p < 64; ++p) v[p] = *(const LAS unsigned short*)(wl + p * 136 + lane * 2);
    CBAR();
    bf16_t* vt = (bf16_t*)(ws + WS_VT);
    const int nt = lane >> 4, dl = lane & 15;
#pragma unroll
    for (int G = 0; G < 2; ++G) { bf16_t* tp = vt + ((((size_t)bh * 64 + (P0 >> 5) + G) * 4 + nt) * 64 + dl) * 8;
#pragma unroll
        for (int kg = 0; kg < 4; ++kg) { const int a0 = 32 * G + 4 * kg, b0 = 32 * G + 16 + 4 * kg;
            u32x4 w; w.x = v[a0] | (v[a0 + 1] << 16); w.y = v[a0 + 2] | (v[a0 + 3] << 16); w.z = v[b0] | (v[b0 + 1] << 16); w.w = v[b0 + 2] | (v[b0 + 3] << 16);
            *(u32x4*)(tp + kg * 128) = w; } }
    { bf16_t* vt4 = vt + (size_t)4 * 16 * 64 * SEQ; const int l0 = P0 >> 2, tile = (l0 >> 4) & 1, grp = l0 >> 5;
#pragma unroll
        for (int r = 0; r < 4; ++r) { bf16_t* tp = vt4 + (((((size_t)bh * 4 + r) * 16 + grp) * 4 + nt) * 64 + dl) * 8;
#pragma unroll
            for (int kg = 0; kg < 4; ++kg) { const int p0 = 4 * (4 * kg) + r;
                u32x2 w; w.x = v[p0] | (v[p0 + 4] << 16); w.y = v[p0 + 8] | (v[p0 + 12] << 16);
                *(u32x2*)(tp + kg * 128 + 4 * tile) = w; } } }
    { bf16_t* vt16 = vt + (size_t)2 * 4 * 16 * 64 * SEQ; const int l0 = P0 >> 4, w32 = l0 & 31, tile = (w32 >> 4) & 1, kg = (w32 & 15) >> 2, grp = l0 >> 5;
#pragma unroll
        for (int r = 0; r < 16; ++r) { u32x2 w; w.x = v[r] | (v[16 + r] << 16); w.y = v[32 + r] | (v[48 + r] << 16);
            *(u32x2*)(vt16 + (((((size_t)bh * 16 + r) * 4 + grp) * 4 + nt) * 64 + kg * 16 + dl) * 8 + 4 * tile) = w; } }
}

struct AttnItem { int sh, r, lfirst, ks, tbo; size_t qk_off, v_off; };
__device__ __forceinline__ AttnItem attn_item(int it, int p0, int bh) {
    AttnItem I; const int br = it >> 4, j = it & 15; I.sh = 2 * br; I.tbo = br * 192;
    I.r = j & ((1 << I.sh) - 1); I.lfirst = (p0 >> I.sh) + 16 * (j >> I.sh);
    const size_t rc = (size_t)br * 4 * 16 * SEQ * 64 + ((size_t)(bh << I.sh) + I.r) * (size_t)(SEQ >> I.sh) * 64;
    I.qk_off = rc; I.v_off = rc;
    int ks = (I.lfirst - 128) & ~31; I.ks = ks < 0 ? 0 : ks;
    return I;
}
__device__ __forceinline__ void attn_unit(const Args& A, LAS unsigned char* lds, int unit, int tid, int wave, int lane, int pflags) {
    unsigned char* ws = A.ws;
    const int blk = 7 - (unit >> 6), bh = unit & 63, b = bh >> 4, h = bh & 15, p0 = blk * 256;
    constexpr int OST = 68;
    LAS float* Oacc = (LAS float*)lds; LAS float* lacc = (LAS float*)(lds + 256 * OST * 4); LAS float* tb = (LAS float*)(lds + 256 * OST * 4 + 1024);
    { const float* bt = (const float*)(ws + WS_BTAB) + h * 3 * 192; for (int i = tid; i < 3 * 192; i += 512) tb[i] = bt[i]; }
    __syncthreads();
    const bf16_t* QF = (const bf16_t*)(ws + WS_QF); const bf16_t* KF = (const bf16_t*)(ws + WS_KF); const bf16_t* VF = (const bf16_t*)(ws + WS_VT);
    const int qi = lane & 15, g = lane >> 4;
#define ATT_LOAD(IT, LK, B) do { const AttnItem _I = attn_item(IT, p0, bh); const bf16_t* _kp = KF + _I.qk_off + (size_t)((LK) >> 4) * 1024 + lane * 8; \
        B[0] = *(const u32x4*)(_kp); B[1] = *(const u32x4*)(_kp + 512); B[2] = *(const u32x4*)(_kp + 1024); B[3] = *(const u32x4*)(_kp + 1536); \
        const bf16_t* _vp = VF + _I.v_off + (size_t)((LK) >> 5) * 2048 + lane * 8; \
        B[4] = *(const u32x4*)(_vp); B[5] = *(const u32x4*)(_vp + 512); B[6] = *(const u32x4*)(_vp + 1024); B[7] = *(const u32x4*)(_vp + 1536); \
        const bf16_t* _qp = QF + _I.qk_off + (size_t)(_I.lfirst >> 4) * 1024 + lane * 8; B[8] = *(const u32x4*)(_qp); B[9] = *(const u32x4*)(_qp + 512); } while (0)
#define ATT_ADV(IT, LK, NIT, NLK) do { const AttnItem _J = attn_item(IT, p0, bh); if ((LK) + 32 <= _J.lfirst) { (NIT) = (IT); (NLK) = (LK) + 32; } else { (NIT) = (IT) + 8; (NLK) = 0; if ((NIT) < 48) { const AttnItem _N = attn_item(NIT, p0, bh); (NLK) = _N.ks; } } } while (0)
#define ATT_STEP(CIT, CLK, BC, NIT, NLK, NNIT, NNLK, BNN) { \
        NNIT = 64; NNLK = 0; \
        if ((NIT) < 48) { ATT_ADV(NIT, NLK, NNIT, NNLK); if ((NNIT) < 48) ATT_LOAD(NNIT, NNLK, BNN); } \
        const AttnItem cI = attn_item(CIT, p0, bh); \
        f32x4 sa = {0.f, 0.f, 0.f, 0.f}, sb = {0.f, 0.f, 0.f, 0.f}; \
        sa = MFMA16(as_bf16x8(BC[0]), as_bf16x8(BC[8]), sa); sb = MFMA16(as_bf16x8(BC[2]), as_bf16x8(BC[8]), sb); \
        sa = MFMA16(as_bf16x8(BC[1]), as_bf16x8(BC[9]), sa); sb = MFMA16(as_bf16x8(BC[3]), as_bf16x8(BC[9]), sb); \
        const LAS float* tbb = tb + cI.tbo; \
        const int ba = cI.lfirst + qi - (CLK) - 4 * g + 31; \
        float pa[4], pb[4]; \
        _Pragma("unroll") for (int e = 0; e < 4; ++e) { pa[e] = __builtin_amdgcn_exp2f(sa[e] + tbb[ba - e]); pb[e] = __builtin_amdgcn_exp2f(sb[e] + tbb[ba - 16 - e]); } \
        lsum += (pa[0] + pa[1]) + (pa[2] + pa[3]) + (pb[0] + pb[1]) + (pb[2] + pb[3]); \
        u32x4 pw; pw.x = cvt_pk_bf16(pa[0], pa[1]); pw.y = cvt_pk_bf16(pa[2], pa[3]); pw.z = cvt_pk_bf16(pb[0], pb[1]); pw.w = cvt_pk_bf16(pb[2], pb[3]); \
        const bf16x8 pf = as_bf16x8(pw); \
        _Pragma("unroll") for (int nt = 0; nt < 4; ++nt) o[nt] = MFMA16(pf, as_bf16x8(BC[4 + nt]), o[nt]); \
        if ((CLK) + 32 > cI.lfirst) {     \
            lsum += __shfl_xor(lsum, 16); lsum += __shfl_xor(lsum, 32); \
            const bool first = (CIT) < 16; \
            if (g == 0) { LAS float* lp = lacc + ((((cI.lfirst + qi) << cI.sh) + cI.r) - p0); *lp = first ? lsum : *lp + lsum; } \
            _Pragma("unroll") for (int reg = 0; reg < 4; ++reg) { LAS float* op = Oacc + (((((cI.lfirst + 4 * g + reg) << cI.sh) + cI.r) - p0)) * OST + qi; \
                _Pragma("unroll") for (int nt = 0; nt < 4; ++nt) op[16 * nt] = first ? o[nt][reg] : op[16 * nt] + o[nt][reg]; } \
            _Pragma("unroll") for (int nt = 0; nt < 4; ++nt) o[nt] = (f32x4){0.f, 0.f, 0.f, 0.f}; \
            lsum = 0.f; \
            if (((CIT) >> 3) & 1) __syncthreads();     \
        } \
        if ((NIT) >= 48) break; }
    if (!(pflags & 16)) {
    int itA = wave, lkA, itB, lkB, itC = 64, lkC = 0;
    { const AttnItem I0 = attn_item(wave, p0, bh); lkA = I0.ks; }
    ATT_ADV(itA, lkA, itB, lkB);
    u32x4 bA[10], bB[10], bC[10];
    ATT_LOAD(itA, lkA, bA); if (itB < 48) ATT_LOAD(itB, lkB, bB);
    f32x4 o[4];
#pragma unroll
    for (int nt = 0; nt < 4; ++nt) o[nt] = (f32x4){0.f, 0.f, 0.f, 0.f};
    float lsum = 0.f;
    for (;;) {
        ATT_STEP(itA, lkA, bA, itB, lkB, itC, lkC, bC)
        ATT_STEP(itB, lkB, bB, itC, lkC, itA, lkA, bA)
        ATT_STEP(itC, lkC, bC, itA, lkA, itB, lkB, bB)
    }
    }
#undef ATT_LOAD
#undef ATT_ADV
#undef ATT_STEP
    if (!(pflags & (16 | 32 | 64))) { const int ql = tid >> 1, half = tid & 1; const float inv = 1.0f / lacc[ql];
        bf16_t* dst = (bf16_t*)(ws + WS_MIXED) + (size_t)(b * SEQ + p0 + ql) * 2048 + h * 64 + 32 * half;
        float ss = 0.f;
#pragma unroll
        for (int c4 = 0; c4 < 4; ++c4) { float v[8];
#pragma unroll
            for (int e = 0; e < 8; ++e) { v[e] = Oacc[ql * OST + 32 * half + 8 * c4 + e] * inv; ss += v[e] * v[e]; }
            u32x4 w; w.x = cvt_pk_bf16(v[0], v[1]); w.y = cvt_pk_bf16(v[2], v[3]); w.z = cvt_pk_bf16(v[4], v[5]); w.w = cvt_pk_bf16(v[6], v[7]);
            *(u32x4*)(dst + 8 * c4) = w; }
        ss += __shfl_xor(ss, 1);
        if (half == 0) unsafeAtomicAdd((float*)(ws + WS_CTL + CTL_RSS_ATTN) + b * SEQ + p0 + ql, ss); }
    __syncthreads();
}

__device__ __forceinline__ unsigned fkey(float f) { const unsigned u = __float_as_uint(f); return (u & 0x80000000u) ? ~u : (u | 0x80000000u); }
template <int R> __device__ __forceinline__ void select16(const unsigned (&key)[R], unsigned long long (&m)[R]) {
    unsigned T = 0u; int cnt = R * 64;
    for (int bit = 31; bit >= 0; --bit) { const unsigned cand = T | (1u << bit); int c = 0;
#pragma unroll
        for (int r = 0; r < R; ++r) c += __popcll(__ballot(key[r] >= cand));
        if (c >= 16) { T = cand; cnt = c; if (c == 16) break; } }
    if (cnt == 16) {
#pragma unroll
        for (int r = 0; r < R; ++r) m[r] = __ballot(key[r] >= T);
    } else {
        int need = 16;
#pragma unroll
        for (int r = 0; r < R; ++r) { m[r] = __ballot(key[r] > T); need -= __popcll(m[r]); }
#pragma unroll
        for (int r = 0; r < R; ++r) { unsigned long long eq = __ballot(key[r] == T);
            while (__popcll(eq) > need) eq &= ~(1ull << (63 - __builtin_clzll(eq)));
            need -= __popcll(eq); m[r] |= eq; }
    }
}
__device__ __forceinline__ void peer_topk(const float* sp, LAS float* sc, LAS int* exo, LAS float* gto, int lane) {
    LAS float* v1 = sc; LAS int* i1 = (LAS int*)(sc + 16); LAS float* v2 = sc + 32; LAS int* i2 = (LAS int*)(sc + 48); LAS float* sv = sc + 64; LAS int* si = (LAS int*)(sc + 80);
    const unsigned long long lt = (1ull << lane) - 1ull;
#pragma unroll
    for (int half = 0; half < 2; ++half) {
        const float a0 = sp[half * 128 + lane], a1 = sp[half * 128 + 64 + lane];
        const unsigned key[2] = {fkey(a0), fkey(a1)}; unsigned long long m[2];
        select16<2>(key, m);
        LAS float* vv = half ? v2 : v1; LAS int* ii = half ? i2 : i1;
        if ((m[0] >> lane) & 1ull) { const int pos = __popcll(m[0] & lt); vv[pos] = a0; ii[pos] = lane; }
        if ((m[1] >> lane) & 1ull) { const int pos = __popcll(m[0]) + __popcll(m[1] & lt); vv[pos] = a1; ii[pos] = 64 + lane; }
    }
    CBAR(); LDS_WAIT();
    const int a = lane >> 2, bb = (lane & 3) * 4;
    const float va = v1[a]; float cv[4]; unsigned key[4]; unsigned long long m[4];
#pragma unroll
    for (int e = 0; e < 4; ++e) { cv[e] = va + v2[bb + e]; key[e] = fkey(cv[e]); }
    select16<4>(key, m);
    int base = 0;
#pragma unroll
    for (int e = 0; e < 4; ++e) { if ((m[e] >> lane) & 1ull) { const int pos = base + __popcll(m[e] & lt); sv[pos] = cv[e]; si[pos] = a * 16 + bb + e; } base += __popcll(m[e]); }
    CBAR(); LDS_WAIT();
    if (lane < 16) {
        const float val = sv[lane]; const int fi = si[lane];
        float mx = val;
#pragma unroll
        for (int o = 1; o < 16; o <<= 1) mx = fmaxf(mx, __shfl_xor(mx, o));
        const float ex = expf(val - mx); float sum = ex;
#pragma unroll
        for (int o = 1; o < 16; o <<= 1) sum += __shfl_xor(sum, o);
        exo[lane] = i1[fi >> 4] * 128 + (i2[fi & 15] - 0);
        gto[lane] = ex / sum;
    }
    CBAR(); LDS_WAIT();
}

constexpr int PD = 8;
__device__ __forceinline__ float ubyte_f32(unsigned w, int i) { return (float)((w >> (8 * i)) & 0xffu); }
__device__ __forceinline__ void peer_wave(const Args& A, LAS unsigned char* lds, int wave, int lane) {
    unsigned char* ws = A.ws;
    const float* scores = (const float*)(ws + WS_PROJ);
    const unsigned char* ub = ws + WS_UB; const unsigned char* vb = ws + WS_VB; const bf16_t* x1b = (const bf16_t*)(ws + WS_HB);
    const float* su = (const float*)(ws + WS_SU); const float* sv = (const float*)(ws + WS_SV);
    const float* rssx = (const float*)(ws + WS_CTL + CTL_RSS_X1);
    LAS int* exl = (LAS int*)(lds + wave * 4096);
    LAS float* gtl = (LAS float*)(lds + wave * 4096 + 2048);
    LAS float* sc = (LAS float*)(lds + 32768 + wave * 512);
    LAS float* wts = (LAS float*)(lds + 36864 + wave * 512);
    const int t0 = (blockIdx.x * 8 + wave) * 4;
    if (t0 >= NTOK) return;
    for (int tok = 0; tok < 4; ++tok)
        for (int h = 0; h < 8; ++h) peer_topk(scores + (size_t)(t0 + tok) * 2048 + h * 256, sc, exl + tok * 128 + h * 16, gtl + tok * 128 + h * 16, lane);
    CBAR(); LDS_WAIT();
#ifdef MK_DEBUG
    for (int i = lane; i < 512; i += 64) { ((int*)(ws + WS_END + 100 * MB))[(size_t)t0 * 128 + i] = exl[i]; ((float*)(ws + WS_END + 104 * MB))[(size_t)t0 * 128 + i] = gtl[i]; }
#endif
    u32x4 buf[PD][2];
#define ROWPTR(s) (((s) & 128 ? vb : ub) + (size_t)exl[((s) >> 8) * 128 + ((s) & 127)] * 2048 + 16 * lane)
#define ISSUE(slot, s) do { const unsigned char* _p = ROWPTR(s); buf[slot][0] = *(const u32x4*)(_p); buf[slot][1] = *(const u32x4*)(_p + 1024); } while (0)
#pragma unroll
    for (int i = 0; i < PD; ++i) ISSUE(i, i);
    for (int tok = 0; tok < 4; ++tok) {
        const int t = t0 + tok;
        unsigned xq[8]; float sx;
        { float xf[32];
#pragma unroll
            for (int j = 0; j < 2; ++j)
#pragma unroll
                for (int hlf = 0; hlf < 2; ++hlf) { const u32x4 raw = *(const u32x4*)(x1b + (size_t)t * 2048 + 16 * lane + 1024 * j + 8 * hlf);
                    const unsigned rw[4] = {raw.x, raw.y, raw.z, raw.w};
#pragma unroll
                    for (int e = 0; e < 4; ++e) { xf[16 * j + 8 * hlf + 2 * e] = bflo(rw[e]); xf[16 * j + 8 * hlf + 2 * e + 1] = bfhi(rw[e]); } }
            float m = 0.f;
#pragma unroll
            for (int i = 0; i < 32; ++i) m = fmaxf(m, fabsf(xf[i]));
            m = fmaxf(wave_max(m), 1e-30f);
            const float inv = 127.f / m; sx = m * (1.f / 127.f);
#pragma unroll
            for (int d = 0; d < 8; ++d) { const int a = (int)rintf(xf[4 * d] * inv), b = (int)rintf(xf[4 * d + 1] * inv), c = (int)rintf(xf[4 * d + 2] * inv), e = (int)rintf(xf[4 * d + 3] * inv);
                xq[d] = (unsigned)(a & 255) | ((unsigned)(b & 255) << 8) | ((unsigned)(c & 255) << 16) | ((unsigned)(e & 255) << 24); } }
        const float r2 = 1.0f / sqrtf(rssx[t] * (1.f / 2048.f) + EPS);
        const float ascale = sx * r2;
        for (int k0 = 0; k0 < 128; k0 += PD) {
            int p[PD];
#pragma unroll
            for (int i = 0; i < PD; ++i) {
                const int s = tok * 256 + k0 + i;
                int acc = 0;
                { const unsigned w0[4] = {buf[i][0].x, buf[i][0].y, buf[i][0].z, buf[i][0].w}, w1[4] = {buf[i][1].x, buf[i][1].y, buf[i][1].z, buf[i][1].w};
#pragma unroll
                    for (int e = 0; e < 4; ++e) { acc = __builtin_amdgcn_sdot4((int)w0[e], (int)xq[e], acc, false); acc = __builtin_amdgcn_sdot4((int)w1[e], (int)xq[4 + e], acc, false); } }
                p[i] = acc;
                if (s + PD < 4 * 256) ISSUE(i, s + PD);
            }
            const bool b0 = lane & 1, b1 = lane & 2, b2 = lane & 4;
            int q4[4], q2[2], q1;
#pragma unroll
            for (int i = 0; i < 4; ++i) { const int keep = b0 ? p[i + 4] : p[i], send = b0 ? p[i] : p[i + 4]; q4[i] = keep + __shfl_xor(send, 1); }
#pragma unroll
            for (int i = 0; i < 2; ++i) { const int keep = b1 ? q4[i + 2] : q4[i], send = b1 ? q4[i] : q4[i + 2]; q2[i] = keep + __shfl_xor(send, 2); }
            { const int keep = b2 ? q2[1] : q2[0], send = b2 ? q2[0] : q2[1]; q1 = keep + __shfl_xor(send, 4); }
            q1 += __shfl_xor(q1, 8); q1 += __shfl_xor(q1, 16); q1 += __shfl_xor(q1, 32);
            if (lane < 8) { const int k = k0 + 4 * (lane & 1) + 2 * ((lane >> 1) & 1) + ((lane >> 2) & 1);
                const int e = exl[tok * 128 + k];
                const float a = (float)q1 * (ascale * su[e]);
                wts[k] = gtl[tok * 128 + k] * gelu_erf(a) * sv[e]; }
        }
        CBAR(); LDS_WAIT();
        float acc[32]; float wsum = 0.f;
#pragma unroll
        for (int i = 0; i < 32; ++i) acc[i] = 0.f;
        for (int k0 = 0; k0 < 128; k0 += PD) {
#pragma unroll
            for (int i = 0; i < PD; ++i) {
                const int k = k0 + i, s = tok * 256 + 128 + k;
                const float w = wts[k];
                wsum += w;
                { const unsigned w0[4] = {buf[i][0].x, buf[i][0].y, buf[i][0].z, buf[i][0].w}, w1[4] = {buf[i][1].x, buf[i][1].y, buf[i][1].z, buf[i][1].w};
#pragma unroll
                    for (int e = 0; e < 4; ++e)
#pragma unroll
                        for (int bb = 0; bb < 4; ++bb) { acc[4 * e + bb] += w * ubyte_f32(w0[e], bb); acc[16 + 4 * e + bb] += w * ubyte_f32(w1[e], bb); } }
                if (s + PD < 4 * 256) ISSUE(i, s + PD);
            }
        }
        CBAR();
        const float corr = -128.f * wsum;
        float* op = A.out + (size_t)t * 2048 + 16 * lane;
#pragma unroll
        for (int j = 0; j < 2; ++j)
#pragma unroll
            for (int c4 = 0; c4 < 4; ++c4) { const f32x4 x0 = *(const f32x4*)(op + 1024 * j + 4 * c4);
                *(f32x4*)(op + 1024 * j + 4 * c4) = x0 + (f32x4){acc[16 * j + 4 * c4] + corr, acc[16 * j + 4 * c4 + 1] + corr, acc[16 * j + 4 * c4 + 2] + corr, acc[16 * j + 4 * c4 + 3] + corr}; }
    }
#undef ROWPTR
#undef ISSUE
}

__global__ void __launch_bounds__(512, 2) mk_fwd(Args args) {
    extern __shared__ __attribute__((aligned(16))) unsigned char lds_raw[];
    LAS unsigned char* lds = (LAS unsigned char*)lds_raw;
    const int tid = threadIdx.x, lane = tid & 63, wave = __builtin_amdgcn_readfirstlane(tid >> 6);
    volatile LAS unsigned* MISC = (volatile LAS unsigned*)(lds + MISC_OFF);
    if (tid < 64) MISC[tid] = 0u;
    __syncthreads();
    unsigned char* ws = args.ws;
    const int lo = args.ph_lo, hi = args.ph_hi & 0xff, pflags = args.ph_hi >> 8;
    XcdBarrier bar; bar.bar = (unsigned*)(ws + WS_CTL); bar.x = 0; bar.st = nullptr;
    if (hi - lo > 1) bar = xcd_barrier_post((unsigned*)(ws + WS_CTL), MISC + 8);
#ifndef PH_MASK
#define PH_MASK 0x7f
#endif
#define IN(k) (((PH_MASK >> (k)) & 1) && lo <= (k) && (k) < hi)
#define SEAM(k) do { if (IN(k) && IN((k) + 1)) xcd_barrier(bar); } while (0)

    if (IN(0)) { p0_prologue(args, lds, wave, lane); }
    SEAM(0);
    if (IN(1)) {
        pg8::Gemm g{(const bf16_t*)(ws + WS_HB), (const bf16_t*)(ws + WS_WINT), NTOK, DPROJ, DM}; pg8::StaticOrder S; S.init(NTOK, DPROJ, gridDim.x, (int)blockIdx.x);
        pg8::EpiProj E{(bf16_t*)(ws + WS_PROJ), DPROJ};
        pg8::gemm_phase<pg8::EpiProj, pg8::StaticOrder, false>(lds, g, S, E, nullptr);
    }
    SEAM(1);
    if (IN(2)) {
        if (!(pflags & 4)) for (int u = blockIdx.x; u < 256; u += gridDim.x) ssm_unit(args, lds, u >> 6, u & 63, wave, lane);
        if (!(pflags & 8)) for (int it = blockIdx.x * 8 + wave; it < 2048; it += gridDim.x * 8) prep2_item(args, lds + wave * SSM_WL, it, lane);
    }
    SEAM(2);
    if (IN(3)) {
        if (!(pflags & 2)) {
            pg8::Gemm g{(const bf16_t*)(ws + WS_YB), (const bf16_t*)(ws + WS_GLUT), NTOK, 1024, 1024}; pg8::StaticOrder S; S.init(NTOK, 1024, gridDim.x, (int)blockIdx.x);
            pg8::EpiGlu E{(const bf16_t*)(ws + WS_YB), (bf16_t*)(ws + WS_MIXED) + 1024, args.in[15], (float*)(ws + WS_CTL + CTL_RSS_SSM)};
            pg8::gemm_phase<pg8::EpiGlu, pg8::StaticOrder, false>(lds, g, S, E, nullptr);
        }
        __syncthreads();
        if (!(pflags & 1)) for (;;) {
            if (tid == 0) MISC[0] = atomicAdd((unsigned*)(ws + WS_CTL + CTL_QCTR), 1u);
            __syncthreads();
            const unsigned u = MISC[0];
            __syncthreads();
            if (u >= 512u) break;
            attn_unit(args, lds, (int)u, tid, wave, lane, pflags);
        }
    }
    SEAM(3);
    if (IN(4)) {
        pg8::Gemm g{(const bf16_t*)(ws + WS_MIXED), (const bf16_t*)(ws + WS_WOUTT), NTOK, DM, DM}; pg8::StaticOrder S; S.init(NTOK, DM, gridDim.x, (int)blockIdx.x);
        LAS float* tab = (LAS float*)(lds + 131072);
        { pg8::Unit u0; if (S.next(0, u0) && tid < 256) { const int row = u0.pm * 256 + tid;
            const float ra = 1.0f / sqrtf(((const float*)(ws + WS_CTL + CTL_RSS_ATTN))[row] * (1.f / 1024.f) + EPS), rs = 1.0f / sqrtf(((const float*)(ws + WS_CTL + CTL_RSS_SSM))[row] * (1.f / 1024.f) + EPS);
            tab[tid] = ra / rs; tab[256 + tid] = rs; } }
        __syncthreads();
        pg8::EpiWout E{args.in[0], args.out, (bf16_t*)(ws + WS_HB), (float*)(ws + WS_CTL + CTL_RSS_X1), tab};
        pg8::gemm_phase<pg8::EpiWout, pg8::StaticOrder, false>(lds, g, S, E, nullptr);
    }
    SEAM(4);
    if (IN(5)) {
        pg8::Gemm g{(const bf16_t*)(ws + WS_HB), (const bf16_t*)(ws + WS_WPT), NTOK, DM, DM}; pg8::StaticOrder S; S.init(NTOK, DM, gridDim.x, (int)blockIdx.x);
        pg8::EpiScores E{(float*)(ws + WS_PROJ), (const float*)(ws + WS_CTL + CTL_RSS_X1)};
        pg8::gemm_phase<pg8::EpiScores, pg8::StaticOrder, false>(lds, g, S, E, nullptr);
    }
    SEAM(5);
    if (IN(6)) { peer_wave(args, lds, wave, lane); }
#undef IN
#undef SEAM
}

#ifndef MK_DEBUG
#ifndef MK_PER_PHASE
#define MK_PER_PHASE 0
#endif
extern "C" void kernel_launch(void* const* d_in, const int* in_sizes, int n_in, void* d_out, int out_size, void* d_ws, size_t ws_size, hipStream_t stream) {
    static int grid = 0;
    if (grid == 0) {
        if (n_in != 25 || out_size != NTOK * DM || ws_size < WS_END) { fprintf(stderr, "kernel_launch: unexpected shapes / workspace (%d inputs, out %d, ws %zu < %zu)\n", n_in, out_size, ws_size, (size_t)WS_END); grid = -1; return; }
        int dev = 0, cus = 0, per_cu = 0;
        if (hipGetDevice(&dev) != hipSuccess || hipDeviceGetAttribute(&cus, hipDeviceAttributeMultiprocessorCount, dev) != hipSuccess) { grid = -1; return; }
        if (hipFuncSetAttribute((const void*)mk_fwd, hipFuncAttributeMaxDynamicSharedMemorySize, LDS_BYTES) != hipSuccess) { fprintf(stderr, "kernel_launch: hipFuncSetAttribute failed\n"); grid = -1; return; }
        if (hipOccupancyMaxActiveBlocksPerMultiprocessor(&per_cu, (const void*)mk_fwd, 512, LDS_BYTES) != hipSuccess || per_cu < 1) { fprintf(stderr, "kernel_launch: occupancy query reports %d\n", per_cu); }
        (void)hipGetLastError();
        grid = cus;
    }
    if (grid < 0) return;
    (void)hipMemsetAsync((char*)d_ws + WS_CTL, 0, CTL_BYTES, stream);
    Args a{};
    for (int i = 0; i < 25; ++i) a.in[i] = (const float*)d_in[i];
    a.out = (float*)d_out; a.ws = (unsigned char*)d_ws;
#if MK_PER_PHASE
#ifndef MK_DUP
#define MK_DUP -1
#endif
    for (int p = 0; p < 7; ++p) { a.ph_lo = p; a.ph_hi = p + 1; hipLaunchKernelGGL(mk_fwd, dim3(grid), dim3(512), LDS_BYTES, stream, a);
        if (p == MK_DUP) {
            (void)hipMemsetAsync((char*)d_ws + WS_CTL + CTL_QCTR, 0, 256, stream);
#ifndef MK_DUP_FLAGS
#define MK_DUP_FLAGS 0
#endif
            if (p == 3 && !((MK_DUP_FLAGS) & (1 | 16 | 32 | 64))) (void)hipMemsetAsync((char*)d_ws + WS_CTL + CTL_RSS_ATTN, 0, 32768, stream);
            if (p == 3 && !((MK_DUP_FLAGS) & 2)) (void)hipMemsetAsync((char*)d_ws + WS_CTL + CTL_RSS_SSM, 0, 32768, stream);
            if (p == 4) (void)hipMemsetAsync((char*)d_ws + WS_CTL + CTL_RSS_X1, 0, 32768, stream);
            a.ph_hi |= (MK_DUP_FLAGS) << 8;
            hipLaunchKernelGGL(mk_fwd, dim3(grid), dim3(512), LDS_BYTES, stream, a); } }
#else
    a.ph_lo = 0; a.ph_hi = 7;
    hipLaunchKernelGGL(mk_fwd, dim3(grid), dim3(512), LDS_BYTES, stream, a);
#endif
}
#endif
```

```cpp
#include <hip/hip_runtime.h>
#include <stdint.h>
#include <stdio.h>

typedef unsigned short bf16_t;
typedef float f32x2 __attribute__((ext_vector_type(2)));
typedef unsigned u32x2 __attribute__((ext_vector_type(2)));
using bf16x2v = __attribute__((ext_vector_type(2))) __bf16;

constexpr int NTOK = 8192, SEQ = 2048, DM = 2048, DPROJ = 4096;
constexpr float EPS = 1e-6f;
constexpr float LOG2E = 1.4426950408889634f;

constexpr size_t MB = 1024 * 1024;
constexpr size_t WS_CTL = 0;
constexpr size_t CTL_BYTES = 128 * 1024;
constexpr size_t CTL_QCTR = 16384;
constexpr size_t CTL_RSS_ATTN = 32768, CTL_RSS_SSM = 65536, CTL_RSS_X1 = 98304;
constexpr size_t WS_HB = 256 * 1024;
constexpr size_t WS_WINT = WS_HB + 32 * MB;
constexpr size_t WS_GLUT = WS_WINT + 16 * MB;
constexpr size_t WS_WOUTT = WS_GLUT + 2 * MB;
constexpr size_t WS_WPT = WS_WOUTT + 8 * MB;
constexpr size_t WS_UB = WS_WPT + 8 * MB;
constexpr size_t WS_VB = WS_UB + 32 * MB;
constexpr size_t WS_SU = WS_VB + 32 * MB;
constexpr size_t WS_SV = WS_SU + 65536;
constexpr size_t WS_PROJ = WS_SV + 65536;
constexpr size_t WS_QF = WS_PROJ + 64 * MB;
constexpr size_t WS_KF = WS_QF + 48 * MB;
constexpr size_t WS_VT = WS_KF + 48 * MB;
constexpr size_t WS_QN = WS_QF, WS_KN = WS_KF;
constexpr size_t WS_YB = WS_VT + 48 * MB + 4096;
constexpr size_t WS_MIXED = WS_YB + 16 * MB;
constexpr size_t WS_SSMP = WS_MIXED + 32 * MB;
constexpr size_t SSMP_ABAR = 0, SSMP_A256 = 32768, SSMP_BFRAG = 65536, SSMP_CFRAG = 65536 + 524288;
constexpr size_t WS_BTAB = WS_SSMP + 1 * MB;
constexpr size_t WS_END = WS_BTAB + 64 * 1024;

constexpr int LDS_BYTES = 147456;
constexpr int MISC_OFF = 147456 - 256;
#define XB_TMO      128
#define XB_XCNT(j)  (256  + 64 * (j))
#define XB_XSUB(j)  (1280 + 64 * (j))
#define XB_XGEN(j)  (2304 + 64 * (j))
#define XB_TOP      3328
#define XB_TOPGEN   3392
#define XCD_BAR_WORDS 3456
#define XB_SPIN_CAP (1u << 18)
#define LAS __attribute__((address_space(3)))

__device__ __forceinline__ unsigned xb_ld(unsigned* p)              { return __hip_atomic_load(p, __ATOMIC_RELAXED, __HIP_MEMORY_SCOPE_AGENT); }
__device__ __forceinline__ unsigned xb_add(unsigned* p, unsigned v) { return __hip_atomic_fetch_add(p, v, __ATOMIC_RELAXED, __HIP_MEMORY_SCOPE_AGENT); }
__device__ __forceinline__ unsigned xb_xcc_id() { return (unsigned)__builtin_amdgcn_s_getreg((3 << 11) | 20) & 0xFu; }
#define XB_SPIN(cond, bar) do { unsigned _sp = 0; while (cond) { __builtin_amdgcn_s_sleep(1); \
    if ((++_sp & 255u) == 0u) { if (xb_ld(&(bar)[XB_TMO])) break; if (_sp > XB_SPIN_CAP) { atomicAdd(&(bar)[XB_TMO], 1u); break; } } } } while (0)

struct XcdBarrier {
    unsigned* bar; unsigned x;
    volatile LAS unsigned* st;
};

__device__ __forceinline__ XcdBarrier xcd_barrier_post(unsigned* bar, volatile LAS unsigned* st) {
    XcdBarrier b; b.bar = bar; b.x = xb_xcc_id(); b.st = st;
    if (threadIdx.x == 0) (void)xb_add(&bar[XB_XCNT(b.x)], 1u);
    return b;
}
__device__ __forceinline__ void xcd_barrier_complete(unsigned* bar, unsigned x, unsigned& nloc, unsigned& nx) {
    const unsigned G = gridDim.x * gridDim.y * gridDim.z;
    unsigned sum, cnt, mine, sp = 0u;
    for (;;) {
        sum = 0u; cnt = 0u; mine = 0u;
#pragma unroll
        for (unsigned j = 0; j < 16; ++j) { const unsigned c = xb_ld(&bar[XB_XCNT(j)]); sum += c; cnt += (c > 0u) ? 1u : 0u; mine = (j == x) ? c : mine; }
        if (sum == G) break;
        __builtin_amdgcn_s_sleep(1);
        if ((++sp & 255u) == 0u) { if (xb_ld(&bar[XB_TMO])) break; if (sp > XB_SPIN_CAP) { atomicAdd(&bar[XB_TMO], 1u); break; } }
    }
    nloc = mine > 0u ? mine : 1u; nx = cnt > 0u ? cnt : 1u;
}

__device__ __forceinline__ void xcd_barrier(const XcdBarrier& b) {
    asm volatile("s_waitcnt vmcnt(0)" ::: "memory");
    __syncthreads();
    if (threadIdx.x == 0) {
        unsigned* bar = b.bar;
        __builtin_amdgcn_s_waitcnt(0);
        unsigned nloc = b.st[0], nx = b.st[1];
        if (nloc == 0u) { xcd_barrier_complete(bar, b.x, nloc, nx); b.st[0] = nloc; b.st[1] = nx; }
        const unsigned old = xb_add(&bar[XB_XSUB(b.x)], 1u);
        const unsigned gen = old / nloc;
        if (old + 1u == (gen + 1u) * nloc) {
            __builtin_amdgcn_fence(__ATOMIC_RELEASE, "agent");
            asm volatile("s_waitcnt vmcnt(0)" ::: "memory");
            const unsigned og = xb_add(&bar[XB_TOP], 1u);
            const unsigned tg = og / nx;
            if (og + 1u == (tg + 1u) * nx) xb_add(&bar[XB_TOPGEN], 1u);
            else XB_SPIN(xb_ld(&bar[XB_TOPGEN]) == tg, bar);
            __builtin_amdgcn_fence(__ATOMIC_ACQUIRE, "agent");
            xb_add(&bar[XB_XGEN(b.x)], 1u);
            asm volatile("s_waitcnt vmcnt(0)" ::: "memory");
        } else {
            XB_SPIN(xb_ld(&bar[XB_XGEN(b.x)]) == gen, bar);
            __builtin_amdgcn_fence(__ATOMIC_ACQUIRE, "agent");
            asm volatile("s_waitcnt vmcnt(0)" ::: "memory");
        }
    }
    __syncthreads();
}
namespace pg8 {
#define PG8_LAS __attribute__((address_space(3)))
typedef unsigned short bf16_t;
typedef short bf16x8 __attribute__((ext_vector_type(8)));
typedef float f32x4 __attribute__((ext_vector_type(4)));
typedef unsigned u32x4 __attribute__((ext_vector_type(4)));
constexpr int BM = 256, BK = 64, HALF = 128, HTB = HALF * BK * 2  , STAGE_BYTES = 8 * HTB, NXCD = 8, WGM = 8;

__host__ __device__ __forceinline__ int lds_byte(int r, int c) { const int st = (r >> 4) * 2 + (c >> 5), rr = r & 15, cc = c & 31, ob = rr * 64 + cc * 2; return st * 1024 + (ob ^ (((ob >> 9) & 1) << 5)); }
__host__ __device__ __forceinline__ void stage_rc(int b, int& R, int& C) { const int st = b / 1024, sb = b % 1024, swz = sb ^ (((sb >> 9) & 1) << 5); R = (st >> 1) * 16 + swz / 64; C = (st & 1) * 32 + (swz % 64) / 2; }
__host__ __device__ __forceinline__ int perm32(int rho) { const int n = rho >> 4, i = rho & 15; return 8 * (i >> 2) + 4 * n + (i & 3); }

struct Unit { int pm, pn; };
struct Gemm { const bf16_t* A; const bf16_t* Bt; int M, N, K; };

struct StaticOrder {
    int nM, nN, nwg, G, c;
    __host__ __device__ void init(int M, int N, int G_, int c_) { nM = M / BM; nN = N / BM; nwg = nM * nN; G = G_; c = c_; }
    __host__ __device__ bool next(int i, Unit& u) const {
        const long L = (long)i * G + c; if (L >= nwg) return false;
        int wgid = (int)L; { const int q = nwg / NXCD, r = nwg % NXCD, xcd = wgid % NXCD, off = wgid / NXCD; wgid = (xcd < r ? xcd * (q + 1) : r * (q + 1) + (xcd - r) * q) + off; }
        const int nig = WGM * nN, gid = wgid / nig, fm = gid * WGM, gsz = (nM - fm) < WGM ? (nM - fm) : WGM;
        u.pm = fm + ((wgid % nig) % gsz); u.pn = (wgid % nig) / gsz; return true;
    }
    __device__ __forceinline__ void a_ready(const Unit&) const {}
    __device__ __forceinline__ void done(const Unit&) const {}
};
typedef float cvt_f32x2 __attribute__((ext_vector_type(2)));
typedef __bf16 cvt_bf16x2 __attribute__((ext_vector_type(2)));
__device__ __forceinline__ unsigned cvt_pk_bf16(float lo, float hi) { return __builtin_bit_cast(unsigned, __builtin_convertvector((cvt_f32x2){lo, hi}, cvt_bf16x2)); }
__device__ __forceinline__ float bflo(unsigned u) { return __uint_as_float(u << 16); }
__device__ __forceinline__ float bfhi(unsigned u) { return __uint_as_float(u & 0xffff0000u); }

struct EpiProj {
    static constexpr bool PERM = true, AFTER_DRAIN = false, HAS_MID = false;
    bf16_t* O; int ldc;
    __device__ __forceinline__ void mid(f32x4 (&)[2][2][4][2], const Unit&, int, int, int, int) const {}
    __device__ __forceinline__ void operator()(const f32x4 (&acc)[2][2][4][2], const Unit& u, int wr, int wc, int fr, int fq) const {
        const int row0 = u.pm * BM + wr * 64 + fr, col0 = u.pn * BM + wc * 32 + 8 * fq;
#pragma unroll
        for (int ai = 0; ai < 2; ++ai)
#pragma unroll
            for (int m = 0; m < 4; ++m) { bf16_t* rowp = O + (size_t)(row0 + ai * HALF + m * 16) * ldc + col0;
#pragma unroll
                for (int bj = 0; bj < 2; ++bj) { const f32x4 v0 = acc[ai][bj][m][0], v1 = acc[ai][bj][m][1];
                    u32x4 w; w.x = cvt_pk_bf16(v0[0], v0[1]); w.y = cvt_pk_bf16(v0[2], v0[3]); w.z = cvt_pk_bf16(v1[0], v1[1]); w.w = cvt_pk_bf16(v1[2], v1[3]);
                    *(u32x4*)(rowp + bj * HALF) = w; } }
    }
};

struct EpiGlu {
    static constexpr bool PERM = true, AFTER_DRAIN = false, HAS_MID = false;
    const bf16_t* Y; bf16_t* O; const float* bias; float* rss;
    __device__ __forceinline__ void mid(f32x4 (&)[2][2][4][2], const Unit&, int, int, int, int) const {}
    __device__ __forceinline__ void operator()(const f32x4 (&acc)[2][2][4][2], const Unit& u, int wr, int wc, int fr, int fq) const {
        const int row0 = u.pm * BM + wr * 64 + fr, col0 = u.pn * BM + wc * 32 + 8 * fq;
        f32x4 bv[2][2];
#pragma unroll
        for (int bj = 0; bj < 2; ++bj)
#pragma unroll
            for (int n = 0; n < 2; ++n) bv[bj][n] = *(const f32x4*)(bias + col0 + bj * HALF + 4 * n);
#pragma unroll
        for (int ai = 0; ai < 2; ++ai)
#pragma unroll
            for (int m = 0; m < 4; ++m) { const int row = row0 + ai * HALF + m * 16; float ss = 0.f;
#pragma unroll
                for (int bj = 0; bj < 2; ++bj) {
                    const u32x4 yv = *(const u32x4*)(Y + (size_t)row * 1024 + col0 + bj * HALF);
                    const f32x4 g0 = acc[ai][bj][m][0] + bv[bj][0], g1 = acc[ai][bj][m][1] + bv[bj][1];
                    float y[8] = {bflo(yv.x), bfhi(yv.x), bflo(yv.y), bfhi(yv.y), bflo(yv.z), bfhi(yv.z), bflo(yv.w), bfhi(yv.w)};
                    float o[8];
#pragma unroll
                    for (int e = 0; e < 4; ++e) { o[e] = y[e] * __builtin_amdgcn_rcpf(1.f + __expf(-g0[e])); o[4 + e] = y[4 + e] * __builtin_amdgcn_rcpf(1.f + __expf(-g1[e])); }
#pragma unroll
                    for (int e = 0; e < 8; ++e) ss += o[e] * o[e];
                    u32x4 w; w.x = cvt_pk_bf16(o[0], o[1]); w.y = cvt_pk_bf16(o[2], o[3]); w.z = cvt_pk_bf16(o[4], o[5]); w.w = cvt_pk_bf16(o[6], o[7]);
                    *(u32x4*)(O + (size_t)row * 2048 + col0 + bj * HALF) = w; }
                ss += __shfl_xor(ss, 16); ss += __shfl_xor(ss, 32);
                if (fq == 0) unsafeAtomicAdd(rss + row, ss); }
    }
};

struct EpiWout {
    static constexpr bool PERM = true, AFTER_DRAIN = false, HAS_MID = true;
    const float* X; float* OUT; bf16_t* XB; float* rss_x; const PG8_LAS float* tab;
    __device__ __forceinline__ void mid(f32x4 (&acc)[2][2][4][2], const Unit& u, int wr, int wc, int fr, int fq) const {
        const PG8_LAS float* tp = tab + wr * 64 + fr;
#pragma unroll
        for (int ai = 0; ai < 2; ++ai)
#pragma unroll
            for (int m = 0; m < 4; ++m) { const float ratio = tp[ai * HALF + m * 16];
#pragma unroll
                for (int bj = 0; bj < 2; ++bj)
#pragma unroll
                    for (int n = 0; n < 2; ++n) acc[ai][bj][m][n] *= ratio; }
    }
    __device__ __forceinline__ void operator()(const f32x4 (&acc)[2][2][4][2], const Unit& u, int wr, int wc, int fr, int fq) const {
        const int row0 = u.pm * BM + wr * 64 + fr, col0 = u.pn * BM + wc * 32 + 8 * fq;
        const PG8_LAS float* tp = tab + 256 + wr * 64 + fr;
#pragma unroll
        for (int ai = 0; ai < 2; ++ai)
#pragma unroll
            for (int m = 0; m < 4; ++m) { const int row = row0 + ai * HALF + m * 16; float ss = 0.f;
                const float rs = tp[ai * HALF + m * 16];
#pragma unroll
                for (int bj = 0; bj < 2; ++bj) { const size_t o = (size_t)row * 2048 + col0 + bj * HALF;
                    const f32x4 x0 = *(const f32x4*)(X + o), x1 = *(const f32x4*)(X + o + 4);
                    const f32x4 v0 = x0 + rs * acc[ai][bj][m][0], v1 = x1 + rs * acc[ai][bj][m][1];
                    *(f32x4*)(OUT + o) = v0; *(f32x4*)(OUT + o + 4) = v1;
                    u32x4 w; w.x = cvt_pk_bf16(v0[0], v0[1]); w.y = cvt_pk_bf16(v0[2], v0[3]); w.z = cvt_pk_bf16(v1[0], v1[1]); w.w = cvt_pk_bf16(v1[2], v1[3]);
                    *(u32x4*)(XB + o) = w;
#pragma unroll
                    for (int e = 0; e < 4; ++e) ss += v0[e] * v0[e] + v1[e] * v1[e]; }
                ss += __shfl_xor(ss, 16); ss += __shfl_xor(ss, 32);
                if (fq == 0) unsafeAtomicAdd(rss_x + row, ss); }
    }
};

struct EpiScores {
    static constexpr bool PERM = false, AFTER_DRAIN = false, HAS_MID = false;
    float* C; const float* rss_x;
    __device__ __forceinline__ void mid(f32x4 (&)[2][2][4][2], const Unit&, int, int, int, int) const {}
    __device__ __forceinline__ void operator()(const f32x4 (&acc)[2][2][4][2], const Unit& u, int wr, int wc, int fr, int fq) const {
        const int row0 = u.pm * BM + wr * 64 + fr, col0 = u.pn * BM + wc * 32 + 4 * fq;
#pragma unroll
        for (int ai = 0; ai < 2; ++ai)
#pragma unroll
            for (int m = 0; m < 4; ++m) { const int row = row0 + ai * HALF + m * 16;
                const float r2 = __builtin_amdgcn_rsqf(rss_x[row] * (1.f / 2048.f) + 1e-6f);
                float* rowp = C + (size_t)row * 2048 + col0;
#pragma unroll
                for (int bj = 0; bj < 2; ++bj)
#pragma unroll
                    for (int n = 0; n < 2; ++n) *(f32x4*)(rowp + bj * HALF + n * 16) = acc[ai][bj][m][n] * r2; }
    }
};

template <class Epi, class Sched, bool STAMP = false>
__device__ __forceinline__ void gemm_phase(PG8_LAS unsigned char* lds, const Gemm g, const Sched& S, const Epi& E, unsigned long long* stamps) {
    const int tid = threadIdx.x, wid = __builtin_amdgcn_readfirstlane(tid >> 6), lane = tid & 63, wr = wid >> 2, wc = wid & 3, fr = lane & 15, fq = lane >> 4;
    const int K = g.K, nt = K / BK;
    int ts_lo = 0, ts_hi = 0, nts = 0; const unsigned long long rt_entry = STAMP ? (unsigned long long)wall_clock64() : 0ull;
#define PG8_STAMP() do { if (STAMP && wid == 0 && nts < 64) { const unsigned long long _c = (unsigned long long)clock64(); \
        ts_lo = (lane == nts) ? (int)(unsigned)_c : ts_lo; ts_hi = (lane == nts) ? (int)(unsigned)(_c >> 32) : ts_hi; ++nts; } } while (0)
    PG8_STAMP();
    unsigned voffA[2], voffB[2];
#pragma unroll
    for (int i = 0; i < 2; ++i) { int R, C; stage_rc(tid * 16 + i * 8192, R, C); const int Rb = Epi::PERM ? ((R & ~31) + perm32(R & 31)) : R;
        voffA[i] = (unsigned)(R * K + C) * 2u; voffB[i] = (unsigned)(Rb * K + C) * 2u; }
    const size_t kstep = (size_t)(BK * 2);
    const size_t hstep = (size_t)HALF * K * 2;
    const size_t tstep = 2 * hstep;
    const unsigned ldsw = (unsigned)wid * 1024u;
    const int aoff = lds_byte(wr * 64 + fr, fq * 8), boff = lds_byte(wc * 32 + fr, fq * 8);
#define PG8_SA(b, h) (((b) * 2 + (h)) * HTB)
#define PG8_SB(b, h) ((4 + (b) * 2 + (h)) * HTB)
#define PG8_STAGE(bufoff, gbase, voff) do { _Pragma("unroll") for (int _i = 0; _i < 2; ++_i) \
        __builtin_amdgcn_global_load_lds((const unsigned*)((const char*)(gbase) + (voff)[_i]), (PG8_LAS unsigned*)(lds + (bufoff) + ldsw + _i * 8192), 16, 0, 0); } while (0)
#define PG8_LDA(dst, b, h) do { _Pragma("unroll") for (int m = 0; m < 4; ++m) _Pragma("unroll") for (int k = 0; k < 2; ++k) dst[m][k] = *(const PG8_LAS bf16x8*)(lds + PG8_SA(b, h) + aoff + m * 2048 + k * 1024); } while (0)
#define PG8_LDB(dst, b, h) do { _Pragma("unroll") for (int n = 0; n < 2; ++n) _Pragma("unroll") for (int k = 0; k < 2; ++k) dst[n][k] = *(const PG8_LAS bf16x8*)(lds + PG8_SB(b, h) + boff + n * 2048 + k * 1024); } while (0)
#define PG8_MMA(ai, bj, At, Bt) do { __builtin_amdgcn_s_setprio(1); _Pragma("unroll") for (int m = 0; m < 4; ++m) _Pragma("unroll") for (int n = 0; n < 2; ++n) _Pragma("unroll") for (int k = 0; k < 2; ++k) \
        acc[ai][bj][m][n] = __builtin_amdgcn_mfma_f32_16x16x32_bf16(Bt[n][k], At[m][k], acc[ai][bj][m][n], 0, 0, 0); __builtin_amdgcn_s_setprio(0); } while (0)
#define PG8_WAIT_V(n) asm volatile("s_waitcnt vmcnt(" #n ")" ::: "memory")
#define PG8_WAIT_L(n) asm volatile("s_waitcnt lgkmcnt(" #n ")" ::: "memory")
#define PG8_BAR __builtin_amdgcn_s_barrier()
#define PG8_SCHED __builtin_amdgcn_sched_barrier(0)
    Unit cur, nxt; int ui = 0;
    if (!S.next(0, cur)) return;
    f32x4 acc[2][2][4][2];
#pragma unroll
    for (int a = 0; a < 2; ++a)
#pragma unroll
        for (int b = 0; b < 2; ++b)
#pragma unroll
            for (int m = 0; m < 4; ++m)
#pragma unroll
                for (int n = 0; n < 2; ++n) acc[a][b][m][n] = (f32x4){0.f, 0.f, 0.f, 0.f};
    bf16x8 At[4][2], B0[2][2], B1[2][2];
    const char* cA = (const char*)g.A + (size_t)cur.pm * tstep; const char* cB = (const char*)g.Bt + (size_t)cur.pn * tstep;
    S.a_ready(cur);
    PG8_STAGE(PG8_SB(0, 0), cB, voffB); PG8_STAGE(PG8_SA(0, 0), cA, voffA); PG8_STAGE(PG8_SB(0, 1), cB + hstep, voffB); PG8_STAGE(PG8_SA(0, 1), cA + hstep, voffA);
    if (wr == 1) PG8_BAR;
    PG8_WAIT_V(4); PG8_BAR;
    PG8_STAGE(PG8_SB(1, 0), cB + kstep, voffB); PG8_STAGE(PG8_SA(1, 0), cA + kstep, voffA); PG8_STAGE(PG8_SB(1, 1), cB + hstep + kstep, voffB);
    PG8_WAIT_V(6); PG8_BAR;
    PG8_STAMP();
    for (;;) {
        const bool has_next = S.next(ui + 1, nxt);
        const char* nA = has_next ? (const char*)g.A + (size_t)nxt.pm * tstep : cA; const char* nB = has_next ? (const char*)g.Bt + (size_t)nxt.pn * tstep : cB;
        for (int t = 0; t < nt; t += 2) {
            const bool last = (t == nt - 2);
            const char* a1 = cA + (size_t)(t + 1) * kstep;
            const char* a2 = last ? nA : cA + (size_t)(t + 2) * kstep; const char* b2 = last ? nB : cB + (size_t)(t + 2) * kstep;
            const char* a3 = a2 + kstep; const char* b3 = b2 + kstep;
            if (last && has_next) S.a_ready(nxt);
            if constexpr (Epi::HAS_MID) { if (t == (nt >> 1)) { E.mid(acc, cur, wr, wc, fr, fq); asm volatile("s_waitcnt lgkmcnt(0)" ::: "memory"); } }
            PG8_LDB(B0, 0, 0); PG8_SCHED; PG8_LDA(At, 0, 0); PG8_STAGE(PG8_SA(1, 1), a1 + hstep, voffA);
            PG8_WAIT_L(8); PG8_BAR; PG8_WAIT_L(0); PG8_MMA(0, 0, At, B0); PG8_BAR; PG8_SCHED;
            PG8_LDB(B1, 0, 1); PG8_STAGE(PG8_SB(0, 0), b2, voffB);
            PG8_BAR; PG8_WAIT_L(0); PG8_MMA(0, 1, At, B1); PG8_BAR;
            PG8_LDA(At, 0, 1); PG8_STAGE(PG8_SA(0, 0), a2, voffA);
            PG8_BAR; PG8_WAIT_L(0); PG8_MMA(1, 0, At, B0); PG8_BAR; PG8_SCHED;
            PG8_STAGE(PG8_SB(0, 1), b2 + hstep, voffB);
            PG8_WAIT_V(6); PG8_BAR; PG8_MMA(1, 1, At, B1); PG8_BAR;
            PG8_LDB(B0, 1, 0); PG8_SCHED; PG8_LDA(At, 1, 0); PG8_STAGE(PG8_SA(0, 1), a2 + hstep, voffA);
            PG8_WAIT_L(8); PG8_BAR; PG8_WAIT_L(0); PG8_MMA(0, 0, At, B0); PG8_BAR; PG8_SCHED;
            PG8_LDB(B1, 1, 1); PG8_STAGE(PG8_SB(1, 0), b3, voffB);
            PG8_BAR; PG8_WAIT_L(0); PG8_MMA(0, 1, At, B1); PG8_BAR;
            PG8_LDA(At, 1, 1); PG8_STAGE(PG8_SA(1, 0), a3, voffA);
            PG8_BAR; PG8_WAIT_L(0); PG8_MMA(1, 0, At, B0); PG8_BAR; PG8_SCHED;
            PG8_STAGE(PG8_SB(1, 1), b3 + hstep, voffB);
            PG8_WAIT_V(6); PG8_BAR; PG8_MMA(1, 1, At, B1); PG8_BAR;
        }
        PG8_STAMP();
        if constexpr (!Epi::AFTER_DRAIN) { E(acc, cur, wr, wc, fr, fq); S.done(cur); }
        PG8_STAMP();
        if (!has_next) break;
#pragma unroll
        for (int a = 0; a < 2; ++a)
#pragma unroll
            for (int b = 0; b < 2; ++b)
#pragma unroll
                for (int m = 0; m < 4; ++m)
#pragma unroll
                    for (int n = 0; n < 2; ++n) acc[a][b][m][n] = (f32x4){0.f, 0.f, 0.f, 0.f};
        cur = nxt; cA = nA; cB = nB; ++ui;
    }
    PG8_WAIT_V(0);
    if (wr == 0) PG8_BAR;
    PG8_BAR;
    if constexpr (Epi::AFTER_DRAIN) { E.fused(acc, cur, wr, wc, fr, fq, lds, wid, lane); S.done(cur); }
    PG8_STAMP();
    if (STAMP && wid == 0) { stamps[lane] = lane < nts ? (((unsigned long long)(unsigned)ts_hi << 32) | (unsigned)ts_lo) : 0ull;
        if (lane == 62) stamps[62] = rt_entry; if (lane == 63) stamps[63] = (unsigned long long)wall_clock64(); }
#undef PG8_STAMP
#undef PG8_SA
#undef PG8_SB
#undef PG8_STAGE
#undef PG8_LDA
#undef PG8_LDB
#undef PG8_MMA
#undef PG8_WAIT_V
#undef PG8_WAIT_L
#undef PG8_BAR
#undef PG8_SCHED
}
}

typedef short bf16x8 __attribute__((ext_vector_type(8)));
typedef float f32x4 __attribute__((ext_vector_type(4)));
typedef unsigned u32x4 __attribute__((ext_vector_type(4)));
using pg8::cvt_pk_bf16; using pg8::bflo; using pg8::bfhi;

#define LDS_WAIT() asm volatile("s_waitcnt lgkmcnt(0)" ::: "memory")
#define CBAR() asm volatile("" ::: "memory")
#define MFMA16(a, b, c) __builtin_amdgcn_mfma_f32_16x16x32_bf16((a), (b), (c), 0, 0, 0)

struct Args { const float* in[25]; float* out; unsigned char* ws; int ph_lo, ph_hi; };

__device__ __forceinline__ float wave_sum(float v) {
#pragma unroll
    for (int o = 1; o < 64; o <<= 1) v += __shfl_xor(v, o);
    return v;
}
__device__ __forceinline__ float wave_max(float v) {
#pragma unroll
    for (int o = 1; o < 64; o <<= 1) v = fmaxf(v, __shfl_xor(v, o));
    return v;
}
__device__ __forceinline__ float gelu_erf(float x) { return 0.5f * x * (1.0f + erff(x * 0.70710678118654752f)); }
__device__ __forceinline__ bf16x8 as_bf16x8(u32x4 v) { return __builtin_bit_cast(bf16x8, v); }

__device__ __forceinline__ void p0_transpose_item(const float* W, int K, int N, bf16_t* WT, const float* sc_a, const float* sc_b, LAS float* scr, int item, int lane) {
    const int nblk = N / 32, kb = item / nblk, nb = item % nblk, k0 = 64 * kb, n0 = 32 * nb;
#pragma unroll 8
    for (int i = 0; i < 32; ++i) { const int kk = 2 * i + (lane >> 5); const int k = k0 + kk;
        const float s = sc_a ? (k < 1024 ? sc_a[k] : sc_b[k - 1024]) : 1.f;
        scr[kk * 33 + (lane & 31)] = W[(size_t)k * N + n0 + (lane & 31)] * s; }
    LDS_WAIT();
    const int c = lane & 7;
#pragma unroll
    for (int j = 0; j < 4; ++j) { const int n = (lane >> 3) + 8 * j; const LAS float* s = scr + (8 * c) * 33 + n;
        u32x4 o; o.x = cvt_pk_bf16(s[0 * 33], s[1 * 33]); o.y = cvt_pk_bf16(s[2 * 33], s[3 * 33]); o.z = cvt_pk_bf16(s[4 * 33], s[5 * 33]); o.w = cvt_pk_bf16(s[6 * 33], s[7 * 33]);
        *(u32x4*)(WT + (size_t)(n0 + n) * K + k0 + 8 * c) = o; }
    LDS_WAIT();
}
template <int MODE> __device__ __forceinline__ void p0_row(const float* xrow, const float* g, bf16_t* orow, int lane) {
    const f32x4* xr = (const f32x4*)xrow + lane; const f32x4* gr = (const f32x4*)g + lane;
    f32x4 v[8]; float s = 0.f;
#pragma unroll
    for (int j = 0; j < 8; ++j) { v[j] = xr[64 * j]; s += (v[j].x * v[j].x + v[j].y * v[j].y) + (v[j].z * v[j].z + v[j].w * v[j].w); }
    float r = 1.f;
    if (MODE == 0) r = 1.0f / sqrtf(wave_sum(s) * (1.f / 2048.f) + EPS);
    u32x2* o8 = (u32x2*)orow + lane;
#pragma unroll
    for (int j = 0; j < 8; ++j) { f32x4 w = v[j] * r; if (MODE != 2) w = w * gr[64 * j];
        u32x2 o; o.x = cvt_pk_bf16(w.x, w.y); o.y = cvt_pk_bf16(w.z, w.w); o8[64 * j] = o; }
}
template <bool SCALE_G, bool OFFS> __device__ __forceinline__ void p0_row_q8(const float* xrow, const float* g, unsigned char* orow, float* sc, int lane) {
    const f32x4* xr = (const f32x4*)xrow + lane; const f32x4* gr = (const f32x4*)g + lane;
    f32x4 v[8]; float m = 0.f;
#pragma unroll
    for (int j = 0; j < 8; ++j) { v[j] = xr[64 * j]; if (SCALE_G) v[j] = v[j] * gr[64 * j];
        m = fmaxf(fmaxf(m, fmaxf(fabsf(v[j].x), fabsf(v[j].y))), fmaxf(fabsf(v[j].z), fabsf(v[j].w))); }
    m = fmaxf(wave_max(m), 1e-30f);
    const float inv = 127.f / m;
    if (lane == 0) *sc = m * (1.f / 127.f);
    unsigned* o4 = (unsigned*)orow + lane;
#pragma unroll
    for (int j = 0; j < 8; ++j) { const int a = (int)rintf(v[j].x * inv) + (OFFS ? 128 : 0), b = (int)rintf(v[j].y * inv) + (OFFS ? 128 : 0), c = (int)rintf(v[j].z * inv) + (OFFS ? 128 : 0), d = (int)rintf(v[j].w * inv) + (OFFS ? 128 : 0);
        o4[64 * j] = (unsigned)(a & 255) | ((unsigned)(b & 255) << 8) | ((unsigned)(c & 255) << 16) | ((unsigned)(d & 255) << 24); }
}
__device__ __forceinline__ void p0_wp_item(const float* wq, const float* keys1, const float* keys2, const float* gffn, bf16_t* WPT, int item, int lane) {
    const int hj = item >> 7, ib = item & 127, h = hj >> 1, j = hj & 1, i0 = 16 * ib, col0 = h * 256 + j * 128;
    const int lr = lane & 15, g = lane >> 4;
    const float* keys = (j ? keys2 : keys1) + (size_t)h * 128 * 128;
    const float gi = gffn[i0 + lr];
    bf16x8 af[4];
#pragma unroll
    for (int s = 0; s < 4; ++s) { const float* p = wq + (size_t)(i0 + lr) * 2048 + col0 + 32 * s + 8 * g;
        const f32x4 a = *(const f32x4*)p * gi, b = *(const f32x4*)(p + 4) * gi;
        u32x4 w; w.x = cvt_pk_bf16(a.x, a.y); w.y = cvt_pk_bf16(a.z, a.w); w.z = cvt_pk_bf16(b.x, b.y); w.w = cvt_pk_bf16(b.z, b.w); af[s] = as_bf16x8(w); }
    for (int kt = 0; kt < 8; ++kt) {
        f32x4 d = {0.f, 0.f, 0.f, 0.f};
#pragma unroll
        for (int s = 0; s < 4; ++s) { const float* p = keys + (size_t)(16 * kt + lr) * 128 + 32 * s + 8 * g;
            const f32x4 a = *(const f32x4*)p, b = *(const f32x4*)(p + 4);
            u32x4 w; w.x = cvt_pk_bf16(a.x, a.y); w.y = cvt_pk_bf16(a.z, a.w); w.z = cvt_pk_bf16(b.x, b.y); w.w = cvt_pk_bf16(b.z, b.w);
            d = MFMA16(af[s], as_bf16x8(w), d); }
        u32x2 o; o.x = cvt_pk_bf16(d[0], d[1]); o.y = cvt_pk_bf16(d[2], d[3]);
        *(u32x2*)(WPT + (size_t)(hj * 128 + 16 * kt + lr) * 2048 + i0 + 4 * g) = o;
    }
}
__device__ __forceinline__ int t5_bucket(int n) {
    if (n < 16) return n;
    const int large = 16 + (int)(logf((float)n / 16.f) / 4.852030263919617f * 16.f);
    return large < 31 ? large : 31;
}
__device__ __forceinline__ void p0_ssm_item(const Args& A, unsigned char* sp, int g, int lane) {
    const float* lam_re = A.in[6]; const float* lam_im = A.in[7]; const float* log_dt = A.in[8];
    const float* b_re = A.in[9]; const float* b_im = A.in[10]; const float* c_re = A.in[11]; const float* c_im = A.in[12];
    const int n = lane;
    const float dt = expf(log_dt[g]);
    const float lr = lam_re[g * 64 + n], li = lam_im[g * 64 + n];
    const float mag = expf(lr * dt);
    const float a_re = mag * cosf(li * dt), a_im = mag * sinf(li * dt);
    const float den = lr * lr + li * li;
    const float f_re = ((a_re - 1.f) * lr + a_im * li) / den, f_im = (a_im * lr - (a_re - 1.f) * li) / den;
    ((f32x2*)(sp + SSMP_ABAR))[g * 64 + n] = (f32x2){a_re, a_im};
    float pr = a_re, pi = a_im;
#pragma unroll
    for (int i = 0; i < 8; ++i) { const float nr = pr * pr - pi * pi, ni = 2.f * pr * pi; pr = nr; pi = ni; }
    ((f32x2*)(sp + SSMP_A256))[g * 64 + n] = (f32x2){pr, pi};
    float bbr[16], bbi[16];
#pragma unroll
    for (int q = 0; q < 4; ++q) { const f32x4 br = *(const f32x4*)(b_re + (size_t)(g * 64 + n) * 16 + 4 * q), bi = *(const f32x4*)(b_im + (size_t)(g * 64 + n) * 16 + 4 * q);
#pragma unroll
        for (int e = 0; e < 4; ++e) { bbr[4 * q + e] = f_re * br[e] - f_im * bi[e]; bbi[4 * q + e] = f_re * bi[e] + f_im * br[e]; } }
    bf16_t* bf = (bf16_t*)(sp + SSMP_BFRAG);
    const int jre = n >> 4, n16 = n & 15;
#pragma unroll
    for (int kg = 0; kg < 4; ++kg) {
        u32x4 wr = {0u, 0u, 0u, 0u}, wi = {0u, 0u, 0u, 0u};
        if (kg < 2) { const int c0 = (kg & 1) * 8;
            wr.x = cvt_pk_bf16(bbr[c0 + 0], bbr[c0 + 1]); wr.y = cvt_pk_bf16(bbr[c0 + 2], bbr[c0 + 3]); wr.z = cvt_pk_bf16(bbr[c0 + 4], bbr[c0 + 5]); wr.w = cvt_pk_bf16(bbr[c0 + 6], bbr[c0 + 7]);
            wi.x = cvt_pk_bf16(bbi[c0 + 0], bbi[c0 + 1]); wi.y = cvt_pk_bf16(bbi[c0 + 2], bbi[c0 + 3]); wi.z = cvt_pk_bf16(bbi[c0 + 4], bbi[c0 + 5]); wi.w = cvt_pk_bf16(bbi[c0 + 6], bbi[c0 + 7]); }
        *(u32x4*)(bf + ((size_t)(g * 8 + jre) * 64 + kg * 16 + n16) * 8) = wr;
        *(u32x4*)(bf + ((size_t)(g * 8 + 4 + jre) * 64 + kg * 16 + n16) * 8) = wi;
    }
    bf16_t* cf = (bf16_t*)(sp + SSMP_CFRAG);
    const int ch = lane & 15, kg = lane >> 4;
#pragma unroll
    for (int s = 0; s < 4; ++s) { const int k0 = 32 * s + 8 * kg;
        const float* src = (k0 < 64) ? (c_re + (size_t)(g * 16 + ch) * 64 + k0) : (c_im + (size_t)(g * 16 + ch) * 64 + (k0 - 64));
        const float sg = (k0 < 64) ? 1.f : -1.f;
        const f32x4 a = *(const f32x4*)src * sg, b = *(const f32x4*)(src + 4) * sg;
        u32x4 w; w.x = cvt_pk_bf16(a.x, a.y); w.y = cvt_pk_bf16(a.z, a.w); w.z = cvt_pk_bf16(b.x, b.y); w.w = cvt_pk_bf16(b.z, b.w);
        *(u32x4*)(cf + ((size_t)(g * 4 + s) * 64 + lane) * 8) = w; }
}
__device__ __forceinline__ void p0_btab_item(const Args& A, float* btab, int item, int lane) {
    const float* gq = A.in[3]; const float* gk = A.in[4]; const float* rel_bias = A.in[5];
    const int h = item / 3, br = item % 3, d = br == 0 ? 1 : (br == 1 ? 4 : 16);
    const float G = wave_max(fabsf(gq[lane] * gk[lane]));
    const float mb = wave_max(lane < 32 ? rel_bias[lane * 16 + h] : -1e30f);
    const float smax = 8.4f * G + mb;
    for (int idx = lane; idx < 192; idx += 64) { const int rel = idx - 31;
        float v = -1e30f;
        if (rel >= 0 && rel <= 128) v = LOG2E * (rel_bias[t5_bucket(rel * d) * 16 + h] - smax);
        btab[(h * 3 + br) * 192 + idx] = v; }
}

__device__ __forceinline__ void p0_prologue(const Args& A, LAS unsigned char* lds, int wave, int lane) {
    unsigned char* ws = A.ws;
    LAS float* scr = (LAS float*)(lds + wave * 16384);
    const int gw = blockIdx.x * 8 + wave, NGW = gridDim.x * 8;
    constexpr int I_WIN = (2048 / 64) * (4096 / 32), I_GLU = (1024 / 64) * (1024 / 32), I_WOUT = (2048 / 64) * (2048 / 32), I_WP = 2048;
    constexpr int I_H = 8192, I_U = 16384, I_V = 16384, I_SSM = 64, I_BT = 48;
    constexpr int NITEMS = I_WIN + I_GLU + I_WOUT + I_WP + I_H + I_U + I_V + I_SSM + I_BT;
    for (int it = gw; it < NITEMS; it += NGW) {
        int r = it;
        if (r < I_SSM) { p0_ssm_item(A, ws + WS_SSMP, r, lane); continue; } r -= I_SSM;
        if (r < I_BT) { p0_btab_item(A, (float*)(ws + WS_BTAB), r, lane); continue; } r -= I_BT;
        if (r < I_WP) { p0_wp_item(A.in[20], A.in[21], A.in[22], A.in[19], (bf16_t*)(ws + WS_WPT), r, lane); continue; } r -= I_WP;
        if (r < I_WIN) { p0_transpose_item(A.in[2], 2048, 4096, (bf16_t*)(ws + WS_WINT), nullptr, nullptr, scr, r, lane); continue; } r -= I_WIN;
        if (r < I_GLU) { p0_transpose_item(A.in[14], 1024, 1024, (bf16_t*)(ws + WS_GLUT), nullptr, nullptr, scr, r, lane); continue; } r -= I_GLU;
        if (r < I_WOUT) { p0_transpose_item(A.in[18], 2048, 2048, (bf16_t*)(ws + WS_WOUTT), A.in[16], A.in[17], scr, r, lane); continue; } r -= I_WOUT;
        if (r < I_H) { p0_row<0>(A.in[0] + (size_t)r * 2048, A.in[1], (bf16_t*)(ws + WS_HB) + (size_t)r * 2048, lane); continue; } r -= I_H;
        if (r < I_U) { p0_row_q8<true, false>(A.in[23] + (size_t)r * 2048, A.in[19], ws + WS_UB + (size_t)r * 2048, (float*)(ws + WS_SU) + r, lane); continue; } r -= I_U;
        p0_row_q8<false, true>(A.in[24] + (size_t)r * 2048, A.in[19], ws + WS_VB + (size_t)r * 2048, (float*)(ws + WS_SV) + r, lane);
    }
}

constexpr int SSM_WL = 8192 + 16 * 272;
__device__ __forceinline__ void ssm_unit(const Args& A, LAS unsigned char* lds, int b, int g, int wave, int lane) {
    unsigned char* ws = A.ws; unsigned char* sp = ws + WS_SSMP;
    const bf16_t* proj = (const bf16_t*)(ws + WS_PROJ); bf16_t* yb = (bf16_t*)(ws + WS_YB);
    LAS unsigned char* wl = lds + wave * SSM_WL;
    LAS f32x2* BU = (LAS f32x2*)wl; LAS unsigned char* XB = wl + 8192;
    LAS f32x2* carry = (LAS f32x2*)(lds + 8 * SSM_WL);
    const int lr = lane & 15, q = lane >> 4;
    bf16x8 bfr[8], cfr[4];
#pragma unroll
    for (int j = 0; j < 8; ++j) bfr[j] = as_bf16x8(*(const u32x4*)((const bf16_t*)(sp + SSMP_BFRAG) + ((size_t)(g * 8 + j) * 64 + lane) * 8));
#pragma unroll
    for (int s = 0; s < 4; ++s) cfr[s] = as_bf16x8(*(const u32x4*)((const bf16_t*)(sp + SSMP_CFRAG) + ((size_t)(g * 4 + s) * 64 + lane) * 8));
    const f32x2 ab = ((const f32x2*)(sp + SSMP_ABAR))[g * 64 + lane], a256 = ((const f32x2*)(sp + SSMP_A256))[g * 64 + lane];
    const float a_re = ab.x, a_im = ab.y;
    const float dsk = A.in[13][g * 16 + lr];
    const bf16_t* up = proj + (size_t)(b * SEQ + wave * 256) * DPROJ + 3072 + g * 16;
    float xr = 0.f, xi = 0.f;
#ifdef MK_DEBUG2
    unsigned long long hdd = 0ull, hbu = 0ull, hua = 0ull;
#endif
    for (int pass = 0; pass < 2; ++pass) {
        for (int blk = 0; blk < 16; ++blk) {
            u32x4 uraw = {0u, 0u, 0u, 0u};
            if (q < 2) uraw = *(const u32x4*)(up + (size_t)(blk * 16 + lr) * DPROJ + 8 * q);
            const bf16x8 ua = as_bf16x8(uraw);
            f32x4 dd[8];
#pragma unroll
            for (int j = 0; j < 8; ++j) dd[j] = MFMA16(ua, bfr[j], ((f32x4){0.f, 0.f, 0.f, 0.f}));
#pragma unroll
            for (int jj = 0; jj < 4; ++jj)
#pragma unroll
                for (int r = 0; r < 4; ++r) BU[(4 * q + r) * 64 + 16 * jj + lr] = (f32x2){dd[jj][r], dd[4 + jj][r]};
            LDS_WAIT(); CBAR();
            f32x2 bu[16];
#pragma unroll
            for (int t = 0; t < 16; ++t) bu[t] = BU[t * 64 + lane];
#ifdef MK_DEBUG2
            if (pass == 0) {
#pragma unroll
                for (int j = 0; j < 8; ++j)
#pragma unroll
                    for (int r = 0; r < 4; ++r) hdd = hdd * 0x100000001B3ull + __float_as_uint(dd[j][r]);
#pragma unroll
                for (int t = 0; t < 16; ++t) { hbu = hbu * 0x100000001B3ull + __float_as_uint(bu[t].x); hbu = hbu * 0x100000001B3ull + __float_as_uint(bu[t].y); }
                hua = hua * 0x100000001B3ull + uraw.x; hua = hua * 0x100000001B3ull + uraw.y; hua = hua * 0x100000001B3ull + uraw.z; hua = hua * 0x100000001B3ull + uraw.w; }
#endif
            if (pass == 0) {
#pragma unroll
                for (int t = 0; t < 16; ++t) { float nr = fmaf(a_re, xr, fmaf(-a_im, xi, bu[t].x)), ni = fmaf(a_re, xi, fmaf(a_im, xr, bu[t].y)); asm volatile("" : "+v"(nr)); asm volatile("" : "+v"(ni)); xr = nr; xi = ni; }
                asm volatile("" : "+v"(xr), "+v"(xi) :: "memory");
            } else {
#pragma unroll
                for (int t = 0; t < 16; ++t) { float nr = fmaf(a_re, xr, fmaf(-a_im, xi, bu[t].x)), ni = fmaf(a_re, xi, fmaf(a_im, xr, bu[t].y)); asm volatile("" : "+v"(nr)); asm volatile("" : "+v"(ni)); xr = nr; xi = ni;
                    const unsigned pk = cvt_pk_bf16(xr, xi);
                    *(LAS unsigned short*)(XB + t * 272 + lane * 2) = (unsigned short)(pk & 0xffffu);
                    *(LAS unsigned short*)(XB + t * 272 + 128 + lane * 2) = (unsigned short)(pk >> 16); }
                LDS_WAIT(); CBAR();
                f32x4 y = {0.f, 0.f, 0.f, 0.f};
#pragma unroll
                for (int s = 0; s < 4; ++s) { const bf16x8 xa = as_bf16x8(*(const LAS u32x4*)(XB + lr * 272 + (32 * s + 8 * q) * 2)); y = MFMA16(xa, cfr[s], y); }
#pragma unroll
                for (int r = 0; r < 4; ++r) { const int t = blk * 16 + 4 * q + r;
                    const float uv = __uint_as_float((unsigned)up[(size_t)t * DPROJ + lr] << 16);
                    const float yv = gelu_erf(y[r] + dsk * uv);
                    yb[(size_t)(b * SEQ + wave * 256 + t) * 1024 + g * 16 + lr] = (bf16_t)(cvt_pk_bf16(yv, 0.f) & 0xffffu); }
                asm volatile("" : "+v"(xr), "+v"(xi) :: "memory");
            }
        }
        if (pass == 0) {
            carry[wave * 64 + lane] = (f32x2){xr, xi};
#ifdef MK_DEBUG2
            { unsigned long long* hp = (unsigned long long*)(ws + WS_END + 99 * MB);
              const unsigned long long km = (2ull * (((unsigned long long)(b * 64 + g) * 8 + wave) * 64 + lane) + 1ull) * 0x9E3779B97F4A7C15ull;
              atomicAdd(hp + 0, hua * km); atomicAdd(hp + 1, hdd * km); atomicAdd(hp + 2, hbu * km); }
            ((f32x2*)(ws + WS_END + 108 * MB))[((size_t)(b * 64 + g) * 8 + wave) * 64 + lane] = (f32x2){xr, xi};
#endif
            __syncthreads();
            float sr = 0.f, si = 0.f;
            for (int w2 = 0; w2 < wave; ++w2) { const f32x2 e = carry[w2 * 64 + lane]; const float nr = a256.x * sr - a256.y * si + e.x, ni = a256.x * si + a256.y * sr + e.y; sr = nr; si = ni; }
            xr = sr; xi = si;
#ifdef MK_DEBUG2
            ((f32x2*)(ws + WS_END + 109 * MB))[((size_t)(b * 64 + g) * 8 + wave) * 64 + lane] = (f32x2){xr, xi};
#endif
        }
    }
    __syncthreads();
}

__device__ __forceinline__ void prep2_item(const Args& A, LAS unsigned char* wl, int item, int lane) {
    unsigned char* ws = A.ws;
    const bf16_t* proj = (const bf16_t*)(ws + WS_PROJ);
    const int pb = item & 31, h = (item >> 5) & 15, b = item >> 9, P0 = pb * 64, bh = b * 16 + h;
    const int r8 = lane >> 3, c = lane & 7;
    const float* gq = A.in[3]; const float* gk = A.in[4];
    const int fs = c >> 2, fg = c & 3;
#pragma unroll 1
    for (int which = 0; which < 2; ++which) {
        const float* gv = which ? gk : gq; const float cs = which ? 1.f : (LOG2E * 0.125f);
        float gl[8];
#pragma unroll
        for (int e = 0; e < 8; ++e) gl[e] = gv[8 * c + e] * cs;
        bf16_t* F = (bf16_t*)(ws + (which ? WS_KF : WS_QF));
#pragma unroll 2
        for (int i = 0; i < 8; ++i) { const int row = 8 * i + r8, pos = P0 + row;
            const u32x4 raw = *(const u32x4*)(proj + (size_t)(b * SEQ + pos) * DPROJ + which * 1024 + h * 64 + 8 * c);
            float v[8] = {bflo(raw.x), bfhi(raw.x), bflo(raw.y), bfhi(raw.y), bflo(raw.z), bfhi(raw.z), bflo(raw.w), bfhi(raw.w)};
            float ss = 0.f;
#pragma unroll
            for (int e = 0; e < 8; ++e) ss += v[e] * v[e];
            ss += __shfl_xor(ss, 1); ss += __shfl_xor(ss, 2); ss += __shfl_xor(ss, 4);
            const float r = 1.0f / sqrtf(ss * (1.f / 64.f) + EPS);
            u32x4 w; w.x = cvt_pk_bf16(v[0] * r * gl[0], v[1] * r * gl[1]); w.y = cvt_pk_bf16(v[2] * r * gl[2], v[3] * r * gl[3]);
            w.z = cvt_pk_bf16(v[4] * r * gl[4], v[5] * r * gl[5]); w.w = cvt_pk_bf16(v[6] * r * gl[6], v[7] * r * gl[7]);
#pragma unroll
            for (int br = 0; br < 3; ++br) { const int sh = 2 * br, rr = pos & ((1 << sh) - 1), l = pos >> sh;
                *(u32x4*)(F + (size_t)br * 4 * 16 * SEQ * 64 + ((((size_t)(bh << sh) + rr) * (SEQ >> (sh + 4)) + (l >> 4)) * 2 + fs) * 512 + (fg * 16 + (l & 15)) * 8) = w; } }
    }
#pragma unroll
    for (int i = 0; i < 8; ++i) { const int row = 8 * i + r8;
        const u32x4 raw = *(const u32x4*)(proj + (size_t)(b * SEQ + P0 + row) * DPROJ + 2048 + h * 64 + 8 * c);
        *(LAS u32x2*)(wl + row * 136 + c * 16) = (u32x2){raw.x, raw.y}; *(LAS u32x2*)(wl + row * 136 + c * 16 + 8) = (u32x2){raw.z, raw.w}; }
    CBAR();
    unsigned v[64];
#pragma unroll
    for (int p = 0; p < 64; ++p) v[p] = *(const LAS unsigned short*)(wl + p * 136 + lane * 2);
    CBAR();
    bf16_t* vt = (bf16_t*)(ws + WS_VT);
    const int nt = lane >> 4, dl = lane & 15;
#pragma unroll
    for (int G = 0; G < 2; ++G) { bf16_t* tp = vt + ((((size_t)bh * 64 + (P0 >> 5) + G) * 4 + nt) * 64 + dl) * 8;
#pragma unroll
        for (int kg = 0; kg < 4; ++kg) { const int a0 = 32 * G + 4 * kg, b0 = 32 * G + 16 + 4 * kg;
            u32x4 w; w.x = v[a0] | (v[a0 + 1] << 16); w.y = v[a0 + 2] | (v[a0 + 3] << 16); w.z = v[b0] | (v[b0 + 1] << 16); w.w = v[b0 + 2] | (v[b0 + 3] << 16);
            *(u32x4*)(tp + kg * 128) = w; } }
    { bf16_t* vt4 = vt + (size_t)4 * 16 * 64 * SEQ; const int l0 = P0 >> 2, tile = (l0 >> 4) & 1, grp = l0 >> 5;
#pragma unroll
        for (int r = 0; r < 4; ++r) { bf16_t* tp = vt4 + (((((size_t)bh * 4 + r) * 16 + grp) * 4 + nt) * 64 + dl) * 8;
#pragma unroll
            for (int kg = 0; kg < 4; ++kg) { const int p0 = 4 * (4 * kg) + r;
                u32x2 w; w.x = v[p0] | (v[p0 + 4] << 16); w.y = v[p0 + 8] | (v[p0 + 12] << 16);
                *(u32x2*)(tp + kg * 128 + 4 * tile) = w; } } }
    { bf16_t* vt16 = vt + (size_t)2 * 4 * 16 * 64 * SEQ; const int l0 = P0 >> 4, w32 = l0 & 31, tile = (w32 >> 4) & 1, kg = (w32 & 15) >> 2, grp = l0 >> 5;
#pragma unroll
        for (int r = 0; r < 16; ++r) { u32x2 w; w.x = v[r] | (v[16 + r] << 16); w.y = v[32 + r] | (v[48 + r] << 16);
            *(u32x2*)(vt16 + (((((size_t)bh * 16 + r) * 4 + grp) * 4 + nt) * 64 + kg * 16 + dl) * 8 + 4 * tile) = w; } }
}

struct AttnItem { int sh, r, lfirst, ks, tbo; size_t qk_off, v_off; };
__device__ __forceinline__ AttnItem attn_item(int it, int p0, int bh) {
    AttnItem I; const int br = it >> 4, j = it & 15; I.sh = 2 * br; I.tbo = br * 192;
    I.r = j & ((1 << I.sh) - 1); I.lfirst = (p0 >> I.sh) + 16 * (j >> I.sh);
    const size_t rc = (size_t)br * 4 * 16 * SEQ * 64 + ((size_t)(bh << I.sh) + I.r) * (size_t)(SEQ >> I.sh) * 64;
    I.qk_off = rc; I.v_off = rc;
    int ks = (I.lfirst - 128) & ~31; I.ks = ks < 0 ? 0 : ks;
    return I;
}
__device__ __forceinline__ void attn_unit(const Args& A, LAS unsigned char* lds, int unit, int tid, int wave, int lane, int pflags) {
    unsigned char* ws = A.ws;
    const int blk = 7 - (unit >> 6), bh = unit & 63, b = bh >> 4, h = bh & 15, p0 = blk * 256;
    constexpr int OST = 68;
    LAS float* Oacc = (LAS float*)lds; LAS float* lacc = (LAS float*)(lds + 256 * OST * 4); LAS float* tb = (LAS float*)(lds + 256 * OST * 4 + 1024);
    { const float* bt = (const float*)(ws + WS_BTAB) + h * 3 * 192; for (int i = tid; i < 3 * 192; i += 512) tb[i] = bt[i]; }
    __syncthreads();
    const bf16_t* QF = (const bf16_t*)(ws + WS_QF); const bf16_t* KF = (const bf16_t*)(ws + WS_KF); const bf16_t* VF = (const bf16_t*)(ws + WS_VT);
    const int qi = lane & 15, g = lane >> 4;
#define ATT_LOAD(IT, LK, B) do { const AttnItem _I = attn_item(IT, p0, bh); const bf16_t* _kp = KF + _I.qk_off + (size_t)((LK) >> 4) * 1024 + lane * 8; \
        B[0] = *(const u32x4*)(_kp); B[1] = *(const u32x4*)(_kp + 512); B[2] = *(const u32x4*)(_kp + 1024); B[3] = *(const u32x4*)(_kp + 1536); \
        const bf16_t* _vp = VF + _I.v_off + (size_t)((LK) >> 5) * 2048 + lane * 8; \
        B[4] = *(const u32x4*)(_vp); B[5] = *(const u32x4*)(_vp + 512); B[6] = *(const u32x4*)(_vp + 1024); B[7] = *(const u32x4*)(_vp + 1536); \
        const bf16_t* _qp = QF + _I.qk_off + (size_t)(_I.lfirst >> 4) * 1024 + lane * 8; B[8] = *(const u32x4*)(_qp); B[9] = *(const u32x4*)(_qp + 512); } while (0)
#define ATT_ADV(IT, LK, NIT, NLK) do { const AttnItem _J = attn_item(IT, p0, bh); if ((LK) + 32 <= _J.lfirst) { (NIT) = (IT); (NLK) = (LK) + 32; } else { (NIT) = (IT) + 8; (NLK) = 0; if ((NIT) < 48) { const AttnItem _N = attn_item(NIT, p0, bh); (NLK) = _N.ks; } } } while (0)
#define ATT_STEP(CIT, CLK, BC, NIT, NLK, NNIT, NNLK, BNN) { \
        NNIT = 64; NNLK = 0; \
        if ((NIT) < 48) { ATT_ADV(NIT, NLK, NNIT, NNLK); if ((NNIT) < 48) ATT_LOAD(NNIT, NNLK, BNN); } \
        const AttnItem cI = attn_item(CIT, p0, bh); \
        f32x4 sa = {0.f, 0.f, 0.f, 0.f}, sb = {0.f, 0.f, 0.f, 0.f}; \
        sa = MFMA16(as_bf16x8(BC[0]), as_bf16x8(BC[8]), sa); sb = MFMA16(as_bf16x8(BC[2]), as_bf16x8(BC[8]), sb); \
        sa = MFMA16(as_bf16x8(BC[1]), as_bf16x8(BC[9]), sa); sb = MFMA16(as_bf16x8(BC[3]), as_bf16x8(BC[9]), sb); \
        const LAS float* tbb = tb + cI.tbo; \
        const int ba = cI.lfirst + qi - (CLK) - 4 * g + 31; \
        float pa[4], pb[4]; \
        _Pragma("unroll") for (int e = 0; e < 4; ++e) { pa[e] = __builtin_amdgcn_exp2f(sa[e] + tbb[ba - e]); pb[e] = __builtin_amdgcn_exp2f(sb[e] + tbb[ba - 16 - e]); } \
        lsum += (pa[0] + pa[1]) + (pa[2] + pa[3]) + (pb[0] + pb[1]) + (pb[2] + pb[3]); \
        u32x4 pw; pw.x = cvt_pk_bf16(pa[0], pa[1]); pw.y = cvt_pk_bf16(pa[2], pa[3]); pw.z = cvt_pk_bf16(pb[0], pb[1]); pw.w = cvt_pk_bf16(pb[2], pb[3]); \
        const bf16x8 pf = as_bf16x8(pw); \
        _Pragma("unroll") for (int nt = 0; nt < 4; ++nt) o[nt] = MFMA16(pf, as_bf16x8(BC[4 + nt]), o[nt]); \
        if ((CLK) + 32 > cI.lfirst) {     \
            lsum += __shfl_xor(lsum, 16); lsum += __shfl_xor(lsum, 32); \
            const bool first = (CIT) < 16; \
            if (g == 0) { LAS float* lp = lacc + ((((cI.lfirst + qi) << cI.sh) + cI.r) - p0); *lp = first ? lsum : *lp + lsum; } \
            _Pragma("unroll") for (int reg = 0; reg < 4; ++reg) { LAS float* op = Oacc + (((((cI.lfirst + 4 * g + reg) << cI.sh) + cI.r) - p0)) * OST + qi; \
                _Pragma("unroll") for (int nt = 0; nt < 4; ++nt) op[16 * nt] = first ? o[nt][reg] : op[16 * nt] + o[nt][reg]; } \
            _Pragma("unroll") for (int nt = 0; nt < 4; ++nt) o[nt] = (f32x4){0.f, 0.f, 0.f, 0.f}; \
            lsum = 0.f; \
            if (((CIT) >> 3) & 1) __syncthreads();     \
        } \
        if ((NIT) >= 48) break; }
    if (!(pflags & 16)) {
    int itA = wave, lkA, itB, lkB, itC = 64, lkC = 0;
    { const AttnItem I0 = attn_item(wave, p0, bh); lkA = I0.ks; }
    ATT_ADV(itA, lkA, itB, lkB);
    u32x4 bA[10], bB[10], bC[10];
    ATT_LOAD(itA, lkA, bA); if (itB < 48) ATT_LOAD(itB, lkB, bB);
    f32x4 o[4];
#pragma unroll
    for (int nt = 0; nt < 4; ++nt) o[nt] = (f32x4){0.f, 0.f, 0.f, 0.f};
    float lsum = 0.f;
    for (;;) {
        ATT_STEP(itA, lkA, bA, itB, lkB, itC, lkC, bC)
        ATT_STEP(itB, lkB, bB, itC, lkC, itA, lkA, bA)
        ATT_STEP(itC, lkC, bC, itA, lkA, itB, lkB, bB)
    }
    }
#undef ATT_LOAD
#undef ATT_ADV
#undef ATT_STEP
    if (!(pflags & (16 | 32 | 64))) { const int ql = tid >> 1, half = tid & 1; const float inv = 1.0f / lacc[ql];
        bf16_t* dst = (bf16_t*)(ws + WS_MIXED) + (size_t)(b * SEQ + p0 + ql) * 2048 + h * 64 + 32 * half;
        float ss = 0.f;
#pragma unroll
        for (int c4 = 0; c4 < 4; ++c4) { float v[8];
#pragma unroll
            for (int e = 0; e < 8; ++e) { v[e] = Oacc[ql * OST + 32 * half + 8 * c4 + e] * inv; ss += v[e] * v[e]; }
            u32x4 w; w.x = cvt_pk_bf16(v[0], v[1]); w.y = cvt_pk_bf16(v[2], v[3]); w.z = cvt_pk_bf16(v[4], v[5]); w.w = cvt_pk_bf16(v[6], v[7]);
            *(u32x4*)(dst + 8 * c4) = w; }
        ss += __shfl_xor(ss, 1);
        if (half == 0) unsafeAtomicAdd((float*)(ws + WS_CTL + CTL_RSS_ATTN) + b * SEQ + p0 + ql, ss); }
    __syncthreads();
}

__device__ __forceinline__ unsigned fkey(float f) { const unsigned u = __float_as_uint(f); return (u & 0x80000000u) ? ~u : (u | 0x80000000u); }
template <int R> __device__ __forceinline__ void select16(const unsigned (&key)[R], unsigned long long (&m)[R]) {
    unsigned T = 0u; int cnt = R * 64;
    for (int bit = 31; bit >= 0; --bit) { const unsigned cand = T | (1u << bit); int c = 0;
#pragma unroll
        for (int r = 0; r < R; ++r) c += __popcll(__ballot(key[r] >= cand));
        if (c >= 16) { T = cand; cnt = c; if (c == 16) break; } }
    if (cnt == 16) {
#pragma unroll
        for (int r = 0; r < R; ++r) m[r] = __ballot(key[r] >= T);
    } else {
        int need = 16;
#pragma unroll
        for (int r = 0; r < R; ++r) { m[r] = __ballot(key[r] > T); need -= __popcll(m[r]); }
#pragma unroll
        for (int r = 0; r < R; ++r) { unsigned long long eq = __ballot(key[r] == T);
            while (__popcll(eq) > need) eq &= ~(1ull << (63 - __builtin_clzll(eq)));
            need -= __popcll(eq); m[r] |= eq; }
    }
}
__device__ __forceinline__ void peer_topk(const float* sp, LAS float* sc, LAS int* exo, LAS float* gto, int lane) {
    LAS float* v1 = sc; LAS int* i1 = (LAS int*)(sc + 16); LAS float* v2 = sc + 32; LAS int* i2 = (LAS int*)(sc + 48); LAS float* sv = sc + 64; LAS int* si = (LAS int*)(sc + 80);
    const unsigned long long lt = (1ull << lane) - 1ull;
#pragma unroll
    for (int half = 0; half < 2; ++half) {
        const float a0 = sp[half * 128 + lane], a1 = sp[half * 128 + 64 + lane];
        const unsigned key[2] = {fkey(a0), fkey(a1)}; unsigned long long m[2];
        select16<2>(key, m);
        LAS float* vv = half ? v2 : v1; LAS int* ii = half ? i2 : i1;
        if ((m[0] >> lane) & 1ull) { const int pos = __popcll(m[0] & lt); vv[pos] = a0; ii[pos] = lane; }
        if ((m[1] >> lane) & 1ull) { const int pos = __popcll(m[0]) + __popcll(m[1] & lt); vv[pos] = a1; ii[pos] = 64 + lane; }
    }
    CBAR(); LDS_WAIT();
    const int a = lane >> 2, bb = (lane & 3) * 4;
    const float va = v1[a]; float cv[4]; unsigned key[4]; unsigned long long m[4];
#pragma unroll
    for (int e = 0; e < 4; ++e) { cv[e] = va + v2[bb + e]; key[e] = fkey(cv[e]); }
    select16<4>(key, m);
    int base = 0;
#pragma unroll
    for (int e = 0; e < 4; ++e) { if ((m[e] >> lane) & 1ull) { const int pos = base + __popcll(m[e] & lt); sv[pos] = cv[e]; si[pos] = a * 16 + bb + e; } base += __popcll(m[e]); }
    CBAR(); LDS_WAIT();
    if (lane < 16) {
        const float val = sv[lane]; const int fi = si[lane];
        float mx = val;
#pragma unroll
        for (int o = 1; o < 16; o <<= 1) mx = fmaxf(mx, __shfl_xor(mx, o));
        const float ex = expf(val - mx); float sum = ex;
#pragma unroll
        for (int o = 1; o < 16; o <<= 1) sum += __shfl_xor(sum, o);
        exo[lane] = i1[fi >> 4] * 128 + (i2[fi & 15] - 0);
        gto[lane] = ex / sum;
    }
    CBAR(); LDS_WAIT();
}

constexpr int PD = 8;
__device__ __forceinline__ float ubyte_f32(unsigned w, int i) { return (float)((w >> (8 * i)) & 0xffu); }
__device__ __forceinline__ void peer_wave(const Args& A, LAS unsigned char* lds, int wave, int lane, int pflags) {
    unsigned char* ws = A.ws;
    const float* scores = (const float*)(ws + WS_PROJ);
    const unsigned char* ub = ws + WS_UB; const unsigned char* vb = ws + WS_VB; const bf16_t* x1b = (const bf16_t*)(ws + WS_HB);
    const float* su = (const float*)(ws + WS_SU); const float* sv = (const float*)(ws + WS_SV);
    const float* rssx = (const float*)(ws + WS_CTL + CTL_RSS_X1);
    LAS int* exl = (LAS int*)(lds + wave * 4096);
    LAS float* gtl = (LAS float*)(lds + wave * 4096 + 2048);
    LAS float* sc = (LAS float*)(lds + 32768 + wave * 512);
    LAS float* wts = (LAS float*)(lds + 36864 + wave * 512);
    const int t0 = (blockIdx.x * 8 + wave) * 4;
    if (t0 >= NTOK) return;
    for (int h = 0; h < 8; ++h) peer_topk(scores + (size_t)t0 * 2048 + h * 256, sc, exl + h * 16, gtl + h * 16, lane);
    CBAR(); LDS_WAIT();
#ifdef MK_DEBUG_EXPERTS
    for (int i = lane; i < 512; i += 64) { ((int*)(ws + WS_END + 100 * MB))[(size_t)t0 * 128 + i] = exl[i]; ((float*)(ws + WS_END + 104 * MB))[(size_t)t0 * 128 + i] = gtl[i]; }
#endif
    if (pflags & 256) return;
    u32x4 buf[PD][2];
#define ROWPTR(s) (((s) & 128 ? vb : ub) + (size_t)exl[((s) >> 8) * 128 + ((s) & 127)] * 2048 + 16 * lane)
#define ISSUE(slot, s) do { const unsigned char* _p = ROWPTR(s); buf[slot][0] = *(const u32x4*)(_p); buf[slot][1] = *(const u32x4*)(_p + 1024); } while (0)
#pragma unroll
    for (int i = 0; i < PD; ++i) ISSUE(i, i);
    for (int tok = 0; tok < 4; ++tok) {
        const int t = t0 + tok;
        unsigned xq[8]; float sx;
        { float xf[32];
#pragma unroll
            for (int j = 0; j < 2; ++j)
#pragma unroll
                for (int hlf = 0; hlf < 2; ++hlf) { const u32x4 raw = *(const u32x4*)(x1b + (size_t)t * 2048 + 16 * lane + 1024 * j + 8 * hlf);
                    const unsigned rw[4] = {raw.x, raw.y, raw.z, raw.w};
#pragma unroll
                    for (int e = 0; e < 4; ++e) { xf[16 * j + 8 * hlf + 2 * e] = bflo(rw[e]); xf[16 * j + 8 * hlf + 2 * e + 1] = bfhi(rw[e]); } }
            float m = 0.f;
#pragma unroll
            for (int i = 0; i < 32; ++i) m = fmaxf(m, fabsf(xf[i]));
            m = fmaxf(wave_max(m), 1e-30f);
            const float inv = 127.f / m; sx = m * (1.f / 127.f);
#pragma unroll
            for (int d = 0; d < 8; ++d) { const int a = (int)rintf(xf[4 * d] * inv), b = (int)rintf(xf[4 * d + 1] * inv), c = (int)rintf(xf[4 * d + 2] * inv), e = (int)rintf(xf[4 * d + 3] * inv);
                xq[d] = (unsigned)(a & 255) | ((unsigned)(b & 255) << 8) | ((unsigned)(c & 255) << 16) | ((unsigned)(e & 255) << 24); } }
        const float r2 = 1.0f / sqrtf(rssx[t] * (1.f / 2048.f) + EPS);
        const float ascale = sx * r2;
        for (int k0 = 0; k0 < 128; k0 += PD) {
            int p[PD];
#pragma unroll
            for (int i = 0; i < PD; ++i) {
                const int s = tok * 256 + k0 + i;
                int acc = 0;
                { const unsigned w0[4] = {buf[i][0].x, buf[i][0].y, buf[i][0].z, buf[i][0].w}, w1[4] = {buf[i][1].x, buf[i][1].y, buf[i][1].z, buf[i][1].w};
#pragma unroll
                    for (int e = 0; e < 4; ++e) { acc = __builtin_amdgcn_sdot4((int)w0[e], (int)xq[e], acc, false); acc = __builtin_amdgcn_sdot4((int)w1[e], (int)xq[4 + e], acc, false); } }
                p[i] = acc;
                if (s + PD < 4 * 256) ISSUE(i, s + PD);
            }
            const bool b0 = lane & 1, b1 = lane & 2, b2 = lane & 4;
            int q4[4], q2[2], q1;
#pragma unroll
            for (int i = 0; i < 4; ++i) { const int keep = b0 ? p[i + 4] : p[i], send = b0 ? p[i] : p[i + 4]; q4[i] = keep + __shfl_xor(send, 1); }
#pragma unroll
            for (int i = 0; i < 2; ++i) { const int keep = b1 ? q4[i + 2] : q4[i], send = b1 ? q4[i] : q4[i + 2]; q2[i] = keep + __shfl_xor(send, 2); }
            { const int keep = b2 ? q2[1] : q2[0], send = b2 ? q2[0] : q2[1]; q1 = keep + __shfl_xor(send, 4); }
            q1 += __shfl_xor(q1, 8); q1 += __shfl_xor(q1, 16); q1 += __shfl_xor(q1, 32);
            if (lane < 8) { const int k = k0 + 4 * (lane & 1) + 2 * ((lane >> 1) & 1) + ((lane >> 2) & 1);
                const int e = exl[tok * 128 + k];
                const float a = (float)q1 * (ascale * su[e]);
                wts[k] = gtl[tok * 128 + k] * gelu_erf(a) * sv[e]; }
            if (tok < 3 && (k0 & 8)) { const int hh = k0 >> 4;
                peer_topk(scores + (size_t)(t + 1) * 2048 + hh * 256, sc, exl + (tok + 1) * 128 + hh * 16, gtl + (tok + 1) * 128 + hh * 16, lane); }
        }
        CBAR(); LDS_WAIT();
        float acc[32]; float wsum = 0.f;
#pragma unroll
        for (int i = 0; i < 32; ++i) acc[i] = 0.f;
        for (int k0 = 0; k0 < 128; k0 += PD) {
#pragma unroll
            for (int i = 0; i < PD; ++i) {
                const int k = k0 + i, s = tok * 256 + 128 + k;
                const float w = wts[k];
                wsum += w;
                { const unsigned w0[4] = {buf[i][0].x, buf[i][0].y, buf[i][0].z, buf[i][0].w}, w1[4] = {buf[i][1].x, buf[i][1].y, buf[i][1].z, buf[i][1].w};
#pragma unroll
                    for (int e = 0; e < 4; ++e)
#pragma unroll
                        for (int bb = 0; bb < 4; ++bb) { acc[4 * e + bb] += w * ubyte_f32(w0[e], bb); acc[16 + 4 * e + bb] += w * ubyte_f32(w1[e], bb); } }
                if (s + PD < 4 * 256) ISSUE(i, s + PD);
            }
        }
        CBAR();
        const float corr = -128.f * wsum;
        float* op = A.out + (size_t)t * 2048 + 16 * lane;
        if (pflags & 128) { if (corr == 12345.678f) op[0] = acc[0]; continue; }
#pragma unroll
        for (int j = 0; j < 2; ++j)
#pragma unroll
            for (int c4 = 0; c4 < 4; ++c4) { const f32x4 x0 = *(const f32x4*)(op + 1024 * j + 4 * c4);
                *(f32x4*)(op + 1024 * j + 4 * c4) = x0 + (f32x4){acc[16 * j + 4 * c4] + corr, acc[16 * j + 4 * c4 + 1] + corr, acc[16 * j + 4 * c4 + 2] + corr, acc[16 * j + 4 * c4 + 3] + corr}; }
    }
#undef ROWPTR
#undef ISSUE
}

__global__ void __launch_bounds__(512, 2) mk_fwd(Args args) {
    extern __shared__ __attribute__((aligned(16))) unsigned char lds_raw[];
    LAS unsigned char* lds = (LAS unsigned char*)lds_raw;
    const int tid = threadIdx.x, lane = tid & 63, wave = __builtin_amdgcn_readfirstlane(tid >> 6);
    volatile LAS unsigned* MISC = (volatile LAS unsigned*)(lds + MISC_OFF);
    if (tid < 64) MISC[tid] = 0u;
    __syncthreads();
    unsigned char* ws = args.ws;
    const int lo = args.ph_lo, hi = args.ph_hi & 0xff, pflags = args.ph_hi >> 8;
    XcdBarrier bar; bar.bar = (unsigned*)(ws + WS_CTL); bar.x = 0; bar.st = nullptr;
    if (hi - lo > 1) bar = xcd_barrier_post((unsigned*)(ws + WS_CTL), MISC + 8);
#ifndef PH_MASK
#define PH_MASK 0x7f
#endif
#define IN(k) (((PH_MASK >> (k)) & 1) && lo <= (k) && (k) < hi)
#define SEAM(k) do { if (IN(k) && IN((k) + 1)) xcd_barrier(bar); } while (0)

    if (IN(0)) { p0_prologue(args, lds, wave, lane); }
    SEAM(0);
    if (IN(1)) {
        pg8::Gemm g{(const bf16_t*)(ws + WS_HB), (const bf16_t*)(ws + WS_WINT), NTOK, DPROJ, DM}; pg8::StaticOrder S; S.init(NTOK, DPROJ, gridDim.x, (int)blockIdx.x);
        pg8::EpiProj E{(bf16_t*)(ws + WS_PROJ), DPROJ};
        pg8::gemm_phase<pg8::EpiProj, pg8::StaticOrder, false>(lds, g, S, E, nullptr);
    }
    SEAM(1);
    if (IN(2)) {
        if (!(pflags & 4)) for (int u = blockIdx.x; u < 256; u += gridDim.x) ssm_unit(args, lds, u >> 6, u & 63, wave, lane);
        if (!(pflags & 8)) for (int it = blockIdx.x * 8 + wave; it < 2048; it += gridDim.x * 8) prep2_item(args, lds + wave * SSM_WL, it, lane);
    }
    SEAM(2);
    if (IN(3)) {
        if (!(pflags & 2)) {
            pg8::Gemm g{(const bf16_t*)(ws + WS_YB), (const bf16_t*)(ws + WS_GLUT), NTOK, 1024, 1024}; pg8::StaticOrder S; S.init(NTOK, 1024, gridDim.x, (int)blockIdx.x);
            pg8::EpiGlu E{(const bf16_t*)(ws + WS_YB), (bf16_t*)(ws + WS_MIXED) + 1024, args.in[15], (float*)(ws + WS_CTL + CTL_RSS_SSM)};
            pg8::gemm_phase<pg8::EpiGlu, pg8::StaticOrder, false>(lds, g, S, E, nullptr);
        }
        __syncthreads();
        if (!(pflags & 1)) for (;;) {
            if (tid == 0) MISC[0] = atomicAdd((unsigned*)(ws + WS_CTL + CTL_QCTR), 1u);
            __syncthreads();
            const unsigned u = MISC[0];
            __syncthreads();
            if (u >= 512u) break;
            attn_unit(args, lds, (int)u, tid, wave, lane, pflags);
        }
    }
    SEAM(3);
    if (IN(4)) {
        pg8::Gemm g{(const bf16_t*)(ws + WS_MIXED), (const bf16_t*)(ws + WS_WOUTT), NTOK, DM, DM}; pg8::StaticOrder S; S.init(NTOK, DM, gridDim.x, (int)blockIdx.x);
        LAS float* tab = (LAS float*)(lds + 131072);
        { pg8::Unit u0; if (S.next(0, u0) && tid < 256) { const int row = u0.pm * 256 + tid;
            const float ra = 1.0f / sqrtf(((const float*)(ws + WS_CTL + CTL_RSS_ATTN))[row] * (1.f / 1024.f) + EPS), rs = 1.0f / sqrtf(((const float*)(ws + WS_CTL + CTL_RSS_SSM))[row] * (1.f / 1024.f) + EPS);
            tab[tid] = ra / rs; tab[256 + tid] = rs; } }
        __syncthreads();
        pg8::EpiWout E{args.in[0], args.out, (bf16_t*)(ws + WS_HB), (float*)(ws + WS_CTL + CTL_RSS_X1), tab};
        pg8::gemm_phase<pg8::EpiWout, pg8::StaticOrder, false>(lds, g, S, E, nullptr);
    }
    SEAM(4);
    if (IN(5)) {
        pg8::Gemm g{(const bf16_t*)(ws + WS_HB), (const bf16_t*)(ws + WS_WPT), NTOK, DM, DM}; pg8::StaticOrder S; S.init(NTOK, DM, gridDim.x, (int)blockIdx.x);
        pg8::EpiScores E{(float*)(ws + WS_PROJ), (const float*)(ws + WS_CTL + CTL_RSS_X1)};
        pg8::gemm_phase<pg8::EpiScores, pg8::StaticOrder, false>(lds, g, S, E, nullptr);
    }
    SEAM(5);
    if (IN(6)) { peer_wave(args, lds, wave, lane, pflags); }
#undef IN
#undef SEAM
}

#ifndef MK_DEBUG
#ifndef MK_PER_PHASE
#define MK_PER_PHASE 0
#endif
extern "C" void kernel_launch(void* const* d_in, const int* in_sizes, int n_in, void* d_out, int out_size, void* d_ws, size_t ws_size, hipStream_t stream) {
    static int grid = 0;
    if (grid == 0) {
        if (n_in != 25 || out_size != NTOK * DM || ws_size < WS_END) { fprintf(stderr, "kernel_launch: unexpected shapes / workspace (%d inputs, out %d, ws %zu < %zu)\n", n_in, out_size, ws_size, (size_t)WS_END); grid = -1; return; }
        int dev = 0, cus = 0, per_cu = 0;
        if (hipGetDevice(&dev) != hipSuccess || hipDeviceGetAttribute(&cus, hipDeviceAttributeMultiprocessorCount, dev) != hipSuccess) { grid = -1; return; }
        if (hipFuncSetAttribute((const void*)mk_fwd, hipFuncAttributeMaxDynamicSharedMemorySize, LDS_BYTES) != hipSuccess) { fprintf(stderr, "kernel_launch: hipFuncSetAttribute failed\n"); grid = -1; return; }
        if (hipOccupancyMaxActiveBlocksPerMultiprocessor(&per_cu, (const void*)mk_fwd, 512, LDS_BYTES) != hipSuccess || per_cu < 1) { fprintf(stderr, "kernel_launch: occupancy query reports %d\n", per_cu); }
        (void)hipGetLastError();
        grid = cus;
    }
    if (grid < 0) return;
    (void)hipMemsetAsync((char*)d_ws + WS_CTL, 0, CTL_BYTES, stream);
    Args a{};
    for (int i = 0; i < 25; ++i) a.in[i] = (const float*)d_in[i];
    a.out = (float*)d_out; a.ws = (unsigned char*)d_ws;
#if MK_PER_PHASE
#ifndef MK_DUP
#define MK_DUP -1
#endif
    for (int p = 0; p < 7; ++p) { a.ph_lo = p; a.ph_hi = p + 1; hipLaunchKernelGGL(mk_fwd, dim3(grid), dim3(512), LDS_BYTES, stream, a);
        if (p == MK_DUP) {
            (void)hipMemsetAsync((char*)d_ws + WS_CTL + CTL_QCTR, 0, 256, stream);
#ifndef MK_DUP_FLAGS
#define MK_DUP_FLAGS 0
#endif
            if (p == 3 && !((MK_DUP_FLAGS) & (1 | 16 | 32 | 64))) (void)hipMemsetAsync((char*)d_ws + WS_CTL + CTL_RSS_ATTN, 0, 32768, stream);
            if (p == 3 && !((MK_DUP_FLAGS) & 2)) (void)hipMemsetAsync((char*)d_ws + WS_CTL + CTL_RSS_SSM, 0, 32768, stream);
            if (p == 4) (void)hipMemsetAsync((char*)d_ws + WS_CTL + CTL_RSS_X1, 0, 32768, stream);
            a.ph_hi |= (MK_DUP_FLAGS) << 8;
            hipLaunchKernelGGL(mk_fwd, dim3(grid), dim3(512), LDS_BYTES, stream, a); } }
#else
    a.ph_lo = 0; a.ph_hi = 7;
    hipLaunchKernelGGL(mk_fwd, dim3(grid), dim3(512), LDS_BYTES, stream, a);
#endif
}
#endif
```

```cpp
#include <hip/hip_runtime.h>
#include <stdint.h>
#include <stdio.h>

typedef unsigned short bf16_t;
typedef float f32x2 __attribute__((ext_vector_type(2)));
typedef unsigned u32x2 __attribute__((ext_vector_type(2)));
using bf16x2v = __attribute__((ext_vector_type(2))) __bf16;

constexpr int NTOK = 8192, SEQ = 2048, DM = 2048, DPROJ = 4096;
constexpr float EPS = 1e-6f;
constexpr float LOG2E = 1.4426950408889634f;

constexpr size_t MB = 1024 * 1024;
constexpr size_t WS_CTL = 0;
constexpr size_t CTL_BYTES = 128 * 1024;
constexpr size_t CTL_QCTR = 16384;
constexpr size_t CTL_RSS_ATTN = 32768, CTL_RSS_SSM = 65536, CTL_RSS_X1 = 98304;
constexpr size_t WS_HB = 256 * 1024;
constexpr size_t WS_WINT = WS_HB + 32 * MB;
constexpr size_t WS_GLUT = WS_WINT + 16 * MB;
constexpr size_t WS_WOUTT = WS_GLUT + 2 * MB;
constexpr size_t WS_WPT = WS_WOUTT + 8 * MB;
constexpr size_t WS_UB = WS_WPT + 8 * MB;
constexpr size_t WS_VB = WS_UB + 32 * MB;
constexpr size_t WS_SU = WS_VB + 32 * MB;
constexpr size_t WS_SV = WS_SU + 65536;
constexpr size_t WS_PROJ = WS_SV + 65536;
constexpr size_t WS_QF = WS_PROJ + 64 * MB;
constexpr size_t WS_KF = WS_QF + 48 * MB;
constexpr size_t WS_VT = WS_KF + 48 * MB;
constexpr size_t WS_QN = WS_QF, WS_KN = WS_KF;
constexpr size_t WS_YB = WS_VT + 48 * MB + 4096;
constexpr size_t WS_MIXED = WS_YB + 16 * MB;
constexpr size_t WS_SSMP = WS_MIXED + 32 * MB;
constexpr size_t SSMP_ABAR = 0, SSMP_A256 = 32768, SSMP_BFRAG = 65536, SSMP_CFRAG = 65536 + 524288;
constexpr size_t WS_BTAB = WS_SSMP + 1 * MB;
constexpr size_t WS_END = WS_BTAB + 64 * 1024;

constexpr int LDS_BYTES = 147456;
constexpr int MISC_OFF = 147456 - 256;
#define XB_TMO      128
#define XB_XCNT(j)  (256  + 64 * (j))
#define XB_XSUB(j)  (1280 + 64 * (j))
#define XB_XGEN(j)  (2304 + 64 * (j))
#define XB_TOP      3328
#define XB_TOPGEN   3392
#define XCD_BAR_WORDS 3456
#define XB_SPIN_CAP (1u << 18)
#define LAS __attribute__((address_space(3)))

__device__ __forceinline__ unsigned xb_ld(unsigned* p)              { return __hip_atomic_load(p, __ATOMIC_RELAXED, __HIP_MEMORY_SCOPE_AGENT); }
__device__ __forceinline__ unsigned xb_add(unsigned* p, unsigned v) { return __hip_atomic_fetch_add(p, v, __ATOMIC_RELAXED, __HIP_MEMORY_SCOPE_AGENT); }
__device__ __forceinline__ unsigned xb_xcc_id() { return (unsigned)__builtin_amdgcn_s_getreg((3 << 11) | 20) & 0xFu; }
#define XB_SPIN(cond, bar) do { unsigned _sp = 0; while (cond) { __builtin_amdgcn_s_sleep(1); \
    if ((++_sp & 255u) == 0u) { if (xb_ld(&(bar)[XB_TMO])) break; if (_sp > XB_SPIN_CAP) { atomicAdd(&(bar)[XB_TMO], 1u); break; } } } } while (0)

struct XcdBarrier {
    unsigned* bar; unsigned x;
    volatile LAS unsigned* st;
};

__device__ __forceinline__ XcdBarrier xcd_barrier_post(unsigned* bar, volatile LAS unsigned* st) {
    XcdBarrier b; b.bar = bar; b.x = xb_xcc_id(); b.st = st;
    if (threadIdx.x == 0) (void)xb_add(&bar[XB_XCNT(b.x)], 1u);
    return b;
}
__device__ __forceinline__ void xcd_barrier_complete(unsigned* bar, unsigned x, unsigned& nloc, unsigned& nx) {
    const unsigned G = gridDim.x * gridDim.y * gridDim.z;
    unsigned sum, cnt, mine, sp = 0u;
    for (;;) {
        sum = 0u; cnt = 0u; mine = 0u;
#pragma unroll
        for (unsigned j = 0; j < 16; ++j) { const unsigned c = xb_ld(&bar[XB_XCNT(j)]); sum += c; cnt += (c > 0u) ? 1u : 0u; mine = (j == x) ? c : mine; }
        if (sum == G) break;
        __builtin_amdgcn_s_sleep(1);
        if ((++sp & 255u) == 0u) { if (xb_ld(&bar[XB_TMO])) break; if (sp > XB_SPIN_CAP) { atomicAdd(&bar[XB_TMO], 1u); break; } }
    }
    nloc = mine > 0u ? mine : 1u; nx = cnt > 0u ? cnt : 1u;
}

__device__ __forceinline__ void xcd_barrier(const XcdBarrier& b) {
    asm volatile("s_waitcnt vmcnt(0)" ::: "memory");
    __syncthreads();
    if (threadIdx.x == 0) {
        unsigned* bar = b.bar;
        __builtin_amdgcn_s_waitcnt(0);
        unsigned nloc = b.st[0], nx = b.st[1];
        if (nloc == 0u) { xcd_barrier_complete(bar, b.x, nloc, nx); b.st[0] = nloc; b.st[1] = nx; }
        const unsigned old = xb_add(&bar[XB_XSUB(b.x)], 1u);
        const unsigned gen = old / nloc;
        if (old + 1u == (gen + 1u) * nloc) {
            __builtin_amdgcn_fence(__ATOMIC_RELEASE, "agent");
            asm volatile("s_waitcnt vmcnt(0)" ::: "memory");
            const unsigned og = xb_add(&bar[XB_TOP], 1u);
            const unsigned tg = og / nx;
            if (og + 1u == (tg + 1u) * nx) xb_add(&bar[XB_TOPGEN], 1u);
            else XB_SPIN(xb_ld(&bar[XB_TOPGEN]) == tg, bar);
            __builtin_amdgcn_fence(__ATOMIC_ACQUIRE, "agent");
            xb_add(&bar[XB_XGEN(b.x)], 1u);
            asm volatile("s_waitcnt vmcnt(0)" ::: "memory");
        } else {
            XB_SPIN(xb_ld(&bar[XB_XGEN(b.x)]) == gen, bar);
            __builtin_amdgcn_fence(__ATOMIC_ACQUIRE, "agent");
            asm volatile("s_waitcnt vmcnt(0)" ::: "memory");
        }
    }
    __syncthreads();
}
namespace pg8 {
#define PG8_LAS __attribute__((address_space(3)))
typedef unsigned short bf16_t;
typedef short bf16x8 __attribute__((ext_vector_type(8)));
typedef float f32x4 __attribute__((ext_vector_type(4)));
typedef unsigned u32x4 __attribute__((ext_vector_type(4)));
constexpr int BM = 256, BK = 64, HALF = 128, HTB = HALF * BK * 2  , STAGE_BYTES = 8 * HTB, NXCD = 8, WGM = 8;

__host__ __device__ __forceinline__ int lds_byte(int r, int c) { const int st = (r >> 4) * 2 + (c >> 5), rr = r & 15, cc = c & 31, ob = rr * 64 + cc * 2; return st * 1024 + (ob ^ (((ob >> 9) & 1) << 5)); }
__host__ __device__ __forceinline__ void stage_rc(int b, int& R, int& C) { const int st = b / 1024, sb = b % 1024, swz = sb ^ (((sb >> 9) & 1) << 5); R = (st >> 1) * 16 + swz / 64; C = (st & 1) * 32 + (swz % 64) / 2; }
__host__ __device__ __forceinline__ int perm32(int rho) { const int n = rho >> 4, i = rho & 15; return 8 * (i >> 2) + 4 * n + (i & 3); }

struct Unit { int pm, pn; };
struct Gemm { const bf16_t* A; const bf16_t* Bt; int M, N, K; };

struct StaticOrder {
    int nM, nN, nwg, G, c;
    __host__ __device__ void init(int M, int N, int G_, int c_) { nM = M / BM; nN = N / BM; nwg = nM * nN; G = G_; c = c_; }
    __host__ __device__ bool next(int i, Unit& u) const {
        const long L = (long)i * G + c; if (L >= nwg) return false;
        int wgid = (int)L; { const int q = nwg / NXCD, r = nwg % NXCD, xcd = wgid % NXCD, off = wgid / NXCD; wgid = (xcd < r ? xcd * (q + 1) : r * (q + 1) + (xcd - r) * q) + off; }
        const int nig = WGM * nN, gid = wgid / nig, fm = gid * WGM, gsz = (nM - fm) < WGM ? (nM - fm) : WGM;
        u.pm = fm + ((wgid % nig) % gsz); u.pn = (wgid % nig) / gsz; return true;
    }
    __device__ __forceinline__ void a_ready(const Unit&) const {}
    __device__ __forceinline__ void done(const Unit&) const {}
};
typedef float cvt_f32x2 __attribute__((ext_vector_type(2)));
typedef __bf16 cvt_bf16x2 __attribute__((ext_vector_type(2)));
__device__ __forceinline__ unsigned cvt_pk_bf16(float lo, float hi) { return __builtin_bit_cast(unsigned, __builtin_convertvector((cvt_f32x2){lo, hi}, cvt_bf16x2)); }
__device__ __forceinline__ float bflo(unsigned u) { return __uint_as_float(u << 16); }
__device__ __forceinline__ float bfhi(unsigned u) { return __uint_as_float(u & 0xffff0000u); }

struct EpiProj {
    static constexpr bool PERM = true, AFTER_DRAIN = false, HAS_MID = false;
    bf16_t* O; int ldc;
    __device__ __forceinline__ void mid(f32x4 (&)[2][2][4][2], const Unit&, int, int, int, int) const {}
    __device__ __forceinline__ void operator()(const f32x4 (&acc)[2][2][4][2], const Unit& u, int wr, int wc, int fr, int fq) const {
        const int row0 = u.pm * BM + wr * 64 + fr, col0 = u.pn * BM + wc * 32 + 8 * fq;
#pragma unroll
        for (int ai = 0; ai < 2; ++ai)
#pragma unroll
            for (int m = 0; m < 4; ++m) { bf16_t* rowp = O + (size_t)(row0 + ai * HALF + m * 16) * ldc + col0;
#pragma unroll
                for (int bj = 0; bj < 2; ++bj) { const f32x4 v0 = acc[ai][bj][m][0], v1 = acc[ai][bj][m][1];
                    u32x4 w; w.x = cvt_pk_bf16(v0[0], v0[1]); w.y = cvt_pk_bf16(v0[2], v0[3]); w.z = cvt_pk_bf16(v1[0], v1[1]); w.w = cvt_pk_bf16(v1[2], v1[3]);
                    *(u32x4*)(rowp + bj * HALF) = w; } }
    }
};

struct EpiGlu {
    static constexpr bool PERM = true, AFTER_DRAIN = false, HAS_MID = false;
    const bf16_t* Y; bf16_t* O; const float* bias; float* rss;
    __device__ __forceinline__ void mid(f32x4 (&)[2][2][4][2], const Unit&, int, int, int, int) const {}
    __device__ __forceinline__ void operator()(const f32x4 (&acc)[2][2][4][2], const Unit& u, int wr, int wc, int fr, int fq) const {
        const int row0 = u.pm * BM + wr * 64 + fr, col0 = u.pn * BM + wc * 32 + 8 * fq;
        f32x4 bv[2][2];
#pragma unroll
        for (int bj = 0; bj < 2; ++bj)
#pragma unroll
            for (int n = 0; n < 2; ++n) bv[bj][n] = *(const f32x4*)(bias + col0 + bj * HALF + 4 * n);
        u32x4 yq[2][2];
#pragma unroll
        for (int bj = 0; bj < 2; ++bj) yq[0][bj] = *(const u32x4*)(Y + (size_t)row0 * 1024 + col0 + bj * HALF);
#pragma unroll
        for (int idx = 0; idx < 8; ++idx) { const int ai = idx >> 2, m = idx & 3, row = row0 + ai * HALF + m * 16; float ss = 0.f;
            if (idx < 7) { const int nrow = row0 + ((idx + 1) >> 2) * HALF + ((idx + 1) & 3) * 16;
#pragma unroll
                for (int bj = 0; bj < 2; ++bj) yq[(idx + 1) & 1][bj] = *(const u32x4*)(Y + (size_t)nrow * 1024 + col0 + bj * HALF); }
#pragma unroll
            for (int bj = 0; bj < 2; ++bj) {
                const u32x4 yv = yq[idx & 1][bj];
                const f32x4 g0 = acc[ai][bj][m][0] + bv[bj][0], g1 = acc[ai][bj][m][1] + bv[bj][1];
                float y[8] = {bflo(yv.x), bfhi(yv.x), bflo(yv.y), bfhi(yv.y), bflo(yv.z), bfhi(yv.z), bflo(yv.w), bfhi(yv.w)};
                float o[8];
#pragma unroll
                for (int e = 0; e < 4; ++e) { o[e] = y[e] * __builtin_amdgcn_rcpf(1.f + __expf(-g0[e])); o[4 + e] = y[4 + e] * __builtin_amdgcn_rcpf(1.f + __expf(-g1[e])); }
#pragma unroll
                for (int e = 0; e < 8; ++e) ss += o[e] * o[e];
                u32x4 w; w.x = cvt_pk_bf16(o[0], o[1]); w.y = cvt_pk_bf16(o[2], o[3]); w.z = cvt_pk_bf16(o[4], o[5]); w.w = cvt_pk_bf16(o[6], o[7]);
                *(u32x4*)(O + (size_t)row * 2048 + col0 + bj * HALF) = w; }
            ss += __shfl_xor(ss, 16); ss += __shfl_xor(ss, 32);
            if (fq == 0) unsafeAtomicAdd(rss + row, ss); }
    }
};

struct EpiWout {
    static constexpr bool PERM = true, AFTER_DRAIN = false, HAS_MID = true;
    const float* X; float* OUT; bf16_t* XB; float* rss_x; const PG8_LAS float* tab;
    __device__ __forceinline__ void mid(f32x4 (&acc)[2][2][4][2], const Unit& u, int wr, int wc, int fr, int fq) const {
        const PG8_LAS float* tp = tab + wr * 64 + fr;
#pragma unroll
        for (int ai = 0; ai < 2; ++ai)
#pragma unroll
            for (int m = 0; m < 4; ++m) { const float ratio = tp[ai * HALF + m * 16];
#pragma unroll
                for (int bj = 0; bj < 2; ++bj)
#pragma unroll
                    for (int n = 0; n < 2; ++n) acc[ai][bj][m][n] *= ratio; }
    }
    __device__ __forceinline__ void operator()(const f32x4 (&acc)[2][2][4][2], const Unit& u, int wr, int wc, int fr, int fq) const {
        const int row0 = u.pm * BM + wr * 64 + fr, col0 = u.pn * BM + wc * 32 + 8 * fq;
        const PG8_LAS float* tp = tab + 256 + wr * 64 + fr;
        f32x4 xq[2][2][2];
#pragma unroll
        for (int bj = 0; bj < 2; ++bj) { const size_t o = (size_t)row0 * 2048 + col0 + bj * HALF; xq[0][bj][0] = *(const f32x4*)(X + o); xq[0][bj][1] = *(const f32x4*)(X + o + 4); }
#pragma unroll
        for (int idx = 0; idx < 8; ++idx) { const int ai = idx >> 2, m = idx & 3, row = row0 + ai * HALF + m * 16; float ss = 0.f;
            if (idx < 7) { const int nrow = row0 + ((idx + 1) >> 2) * HALF + ((idx + 1) & 3) * 16;
#pragma unroll
                for (int bj = 0; bj < 2; ++bj) { const size_t o = (size_t)nrow * 2048 + col0 + bj * HALF; xq[(idx + 1) & 1][bj][0] = *(const f32x4*)(X + o); xq[(idx + 1) & 1][bj][1] = *(const f32x4*)(X + o + 4); } }
            const float rs = tp[ai * HALF + m * 16];
#pragma unroll
            for (int bj = 0; bj < 2; ++bj) { const size_t o = (size_t)row * 2048 + col0 + bj * HALF;
                const f32x4 v0 = xq[idx & 1][bj][0] + rs * acc[ai][bj][m][0], v1 = xq[idx & 1][bj][1] + rs * acc[ai][bj][m][1];
                u32x4 w; w.x = cvt_pk_bf16(v0[0], v0[1]); w.y = cvt_pk_bf16(v0[2], v0[3]); w.z = cvt_pk_bf16(v1[0], v1[1]); w.w = cvt_pk_bf16(v1[2], v1[3]);
                *(u32x4*)(XB + o) = w;
#pragma unroll
                for (int e = 0; e < 4; ++e) ss += v0[e] * v0[e] + v1[e] * v1[e]; }
            ss += __shfl_xor(ss, 16); ss += __shfl_xor(ss, 32);
            if (fq == 0) unsafeAtomicAdd(rss_x + row, ss); }
    }
};

struct EpiScores {
    static constexpr bool PERM = false, AFTER_DRAIN = false, HAS_MID = false;
    float* C; const float* rss_x;
    __device__ __forceinline__ void mid(f32x4 (&)[2][2][4][2], const Unit&, int, int, int, int) const {}
    __device__ __forceinline__ void operator()(const f32x4 (&acc)[2][2][4][2], const Unit& u, int wr, int wc, int fr, int fq) const {
        const int row0 = u.pm * BM + wr * 64 + fr, col0 = u.pn * BM + wc * 32 + 4 * fq;
        float r2v[8];
#pragma unroll
        for (int idx = 0; idx < 8; ++idx) r2v[idx] = rss_x[row0 + (idx >> 2) * HALF + (idx & 3) * 16];
#pragma unroll
        for (int ai = 0; ai < 2; ++ai)
#pragma unroll
            for (int m = 0; m < 4; ++m) { const int row = row0 + ai * HALF + m * 16;
                const float r2 = __builtin_amdgcn_rsqf(r2v[ai * 4 + m] * (1.f / 2048.f) + 1e-6f);
                float* rowp = C + (size_t)row * 2048 + col0;
#pragma unroll
                for (int bj = 0; bj < 2; ++bj)
#pragma unroll
                    for (int n = 0; n < 2; ++n) *(f32x4*)(rowp + bj * HALF + n * 16) = acc[ai][bj][m][n] * r2; }
    }
};

template <class Epi, class Sched, bool STAMP = false>
__device__ __forceinline__ void gemm_phase(PG8_LAS unsigned char* lds, const Gemm g, const Sched& S, const Epi& E, unsigned long long* stamps) {
    const int tid = threadIdx.x, wid = __builtin_amdgcn_readfirstlane(tid >> 6), lane = tid & 63, wr = wid >> 2, wc = wid & 3, fr = lane & 15, fq = lane >> 4;
    const int K = g.K, nt = K / BK;
    int ts_lo = 0, ts_hi = 0, nts = 0; const unsigned long long rt_entry = STAMP ? (unsigned long long)wall_clock64() : 0ull;
#define PG8_STAMP() do { if (STAMP && wid == 0 && nts < 64) { const unsigned long long _c = (unsigned long long)clock64(); \
        ts_lo = (lane == nts) ? (int)(unsigned)_c : ts_lo; ts_hi = (lane == nts) ? (int)(unsigned)(_c >> 32) : ts_hi; ++nts; } } while (0)
    PG8_STAMP();
    unsigned voffA[2], voffB[2];
#pragma unroll
    for (int i = 0; i < 2; ++i) { int R, C; stage_rc(tid * 16 + i * 8192, R, C); const int Rb = Epi::PERM ? ((R & ~31) + perm32(R & 31)) : R;
        voffA[i] = (unsigned)(R * K + C) * 2u; voffB[i] = (unsigned)(Rb * K + C) * 2u; }
    const size_t kstep = (size_t)(BK * 2);
    const size_t hstep = (size_t)HALF * K * 2;
    const size_t tstep = 2 * hstep;
    const unsigned ldsw = (unsigned)wid * 1024u;
    const int aoff = lds_byte(wr * 64 + fr, fq * 8), boff = lds_byte(wc * 32 + fr, fq * 8);
#define PG8_SA(b, h) (((b) * 2 + (h)) * HTB)
#define PG8_SB(b, h) ((4 + (b) * 2 + (h)) * HTB)
#define PG8_STAGE(bufoff, gbase, voff) do { _Pragma("unroll") for (int _i = 0; _i < 2; ++_i) \
        __builtin_amdgcn_global_load_lds((const unsigned*)((const char*)(gbase) + (voff)[_i]), (PG8_LAS unsigned*)(lds + (bufoff) + ldsw + _i * 8192), 16, 0, 0); } while (0)
#define PG8_LDA(dst, b, h) do { _Pragma("unroll") for (int m = 0; m < 4; ++m) _Pragma("unroll") for (int k = 0; k < 2; ++k) dst[m][k] = *(const PG8_LAS bf16x8*)(lds + PG8_SA(b, h) + aoff + m * 2048 + k * 1024); } while (0)
#define PG8_LDB(dst, b, h) do { _Pragma("unroll") for (int n = 0; n < 2; ++n) _Pragma("unroll") for (int k = 0; k < 2; ++k) dst[n][k] = *(const PG8_LAS bf16x8*)(lds + PG8_SB(b, h) + boff + n * 2048 + k * 1024); } while (0)
#define PG8_MMA(ai, bj, At, Bt) do { __builtin_amdgcn_s_setprio(1); _Pragma("unroll") for (int m = 0; m < 4; ++m) _Pragma("unroll") for (int n = 0; n < 2; ++n) _Pragma("unroll") for (int k = 0; k < 2; ++k) \
        acc[ai][bj][m][n] = __builtin_amdgcn_mfma_f32_16x16x32_bf16(Bt[n][k], At[m][k], acc[ai][bj][m][n], 0, 0, 0); __builtin_amdgcn_s_setprio(0); } while (0)
#define PG8_WAIT_V(n) asm volatile("s_waitcnt vmcnt(" #n ")" ::: "memory")
#define PG8_WAIT_L(n) asm volatile("s_waitcnt lgkmcnt(" #n ")" ::: "memory")
#define PG8_BAR __builtin_amdgcn_s_barrier()
#define PG8_SCHED __builtin_amdgcn_sched_barrier(0)
    Unit cur, nxt; int ui = 0;
    if (!S.next(0, cur)) return;
    f32x4 acc[2][2][4][2];
#pragma unroll
    for (int a = 0; a < 2; ++a)
#pragma unroll
        for (int b = 0; b < 2; ++b)
#pragma unroll
            for (int m = 0; m < 4; ++m)
#pragma unroll
                for (int n = 0; n < 2; ++n) acc[a][b][m][n] = (f32x4){0.f, 0.f, 0.f, 0.f};
    bf16x8 At[4][2], B0[2][2], B1[2][2];
    const char* cA = (const char*)g.A + (size_t)cur.pm * tstep; const char* cB = (const char*)g.Bt + (size_t)cur.pn * tstep;
    S.a_ready(cur);
    PG8_STAGE(PG8_SB(0, 0), cB, voffB); PG8_STAGE(PG8_SA(0, 0), cA, voffA); PG8_STAGE(PG8_SB(0, 1), cB + hstep, voffB); PG8_STAGE(PG8_SA(0, 1), cA + hstep, voffA);
    if (wr == 1) PG8_BAR;
    PG8_WAIT_V(4); PG8_BAR;
    PG8_STAGE(PG8_SB(1, 0), cB + kstep, voffB); PG8_STAGE(PG8_SA(1, 0), cA + kstep, voffA); PG8_STAGE(PG8_SB(1, 1), cB + hstep + kstep, voffB);
    PG8_WAIT_V(6); PG8_BAR;
    PG8_STAMP();
    for (;;) {
        const bool has_next = S.next(ui + 1, nxt);
        const char* nA = has_next ? (const char*)g.A + (size_t)nxt.pm * tstep : cA; const char* nB = has_next ? (const char*)g.Bt + (size_t)nxt.pn * tstep : cB;
        for (int t = 0; t < nt; t += 2) {
            const bool last = (t == nt - 2);
            const char* a1 = cA + (size_t)(t + 1) * kstep;
            const char* a2 = last ? nA : cA + (size_t)(t + 2) * kstep; const char* b2 = last ? nB : cB + (size_t)(t + 2) * kstep;
            const char* a3 = a2 + kstep; const char* b3 = b2 + kstep;
            if (last && has_next) S.a_ready(nxt);
            if constexpr (Epi::HAS_MID) { if (t == (nt >> 1)) { E.mid(acc, cur, wr, wc, fr, fq); asm volatile("s_waitcnt lgkmcnt(0)" ::: "memory"); } }
            PG8_LDB(B0, 0, 0); PG8_SCHED; PG8_LDA(At, 0, 0); PG8_STAGE(PG8_SA(1, 1), a1 + hstep, voffA);
            PG8_WAIT_L(8); PG8_BAR; PG8_WAIT_L(0); PG8_MMA(0, 0, At, B0); PG8_BAR; PG8_SCHED;
            PG8_LDB(B1, 0, 1); PG8_STAGE(PG8_SB(0, 0), b2, voffB);
            PG8_BAR; PG8_WAIT_L(0); PG8_MMA(0, 1, At, B1); PG8_BAR;
            PG8_LDA(At, 0, 1); PG8_STAGE(PG8_SA(0, 0), a2, voffA);
            PG8_BAR; PG8_WAIT_L(0); PG8_MMA(1, 0, At, B0); PG8_BAR; PG8_SCHED;
            PG8_STAGE(PG8_SB(0, 1), b2 + hstep, voffB);
            PG8_WAIT_V(6); PG8_BAR; PG8_MMA(1, 1, At, B1); PG8_BAR;
            PG8_LDB(B0, 1, 0); PG8_SCHED; PG8_LDA(At, 1, 0); PG8_STAGE(PG8_SA(0, 1), a2 + hstep, voffA);
            PG8_WAIT_L(8); PG8_BAR; PG8_WAIT_L(0); PG8_MMA(0, 0, At, B0); PG8_BAR; PG8_SCHED;
            PG8_LDB(B1, 1, 1); PG8_STAGE(PG8_SB(1, 0), b3, voffB);
            PG8_BAR; PG8_WAIT_L(0); PG8_MMA(0, 1, At, B1); PG8_BAR;
            PG8_LDA(At, 1, 1); PG8_STAGE(PG8_SA(1, 0), a3, voffA);
            PG8_BAR; PG8_WAIT_L(0); PG8_MMA(1, 0, At, B0); PG8_BAR; PG8_SCHED;
            PG8_STAGE(PG8_SB(1, 1), b3 + hstep, voffB);
            PG8_WAIT_V(6); PG8_BAR; PG8_MMA(1, 1, At, B1); PG8_BAR;
        }
        PG8_STAMP();
        if constexpr (!Epi::AFTER_DRAIN) { E(acc, cur, wr, wc, fr, fq); S.done(cur); }
        PG8_STAMP();
        if (!has_next) break;
#pragma unroll
        for (int a = 0; a < 2; ++a)
#pragma unroll
            for (int b = 0; b < 2; ++b)
#pragma unroll
                for (int m = 0; m < 4; ++m)
#pragma unroll
                    for (int n = 0; n < 2; ++n) acc[a][b][m][n] = (f32x4){0.f, 0.f, 0.f, 0.f};
        cur = nxt; cA = nA; cB = nB; ++ui;
    }
    PG8_WAIT_V(0);
    if (wr == 0) PG8_BAR;
    PG8_BAR;
    if constexpr (Epi::AFTER_DRAIN) { E.fused(acc, cur, wr, wc, fr, fq, lds, wid, lane); S.done(cur); }
    PG8_STAMP();
    if (STAMP && wid == 0) { stamps[lane] = lane < nts ? (((unsigned long long)(unsigned)ts_hi << 32) | (unsigned)ts_lo) : 0ull;
        if (lane == 62) stamps[62] = rt_entry; if (lane == 63) stamps[63] = (unsigned long long)wall_clock64(); }
#undef PG8_STAMP
#undef PG8_SA
#undef PG8_SB
#undef PG8_STAGE
#undef PG8_LDA
#undef PG8_LDB
#undef PG8_MMA
#undef PG8_WAIT_V
#undef PG8_WAIT_L
#undef PG8_BAR
#undef PG8_SCHED
}
}

typedef short bf16x8 __attribute__((ext_vector_type(8)));
typedef float f32x4 __attribute__((ext_vector_type(4)));
typedef unsigned u32x4 __attribute__((ext_vector_type(4)));
using pg8::cvt_pk_bf16; using pg8::bflo; using pg8::bfhi;

#define LDS_WAIT() asm volatile("s_waitcnt lgkmcnt(0)" ::: "memory")
#define CBAR() asm volatile("" ::: "memory")
#define MFMA16(a, b, c) __builtin_amdgcn_mfma_f32_16x16x32_bf16((a), (b), (c), 0, 0, 0)

struct Args { const float* in[25]; float* out; unsigned char* ws; int ph_lo, ph_hi; };

__device__ __forceinline__ float wave_sum(float v) {
#pragma unroll
    for (int o = 1; o < 64; o <<= 1) v += __shfl_xor(v, o);
    return v;
}
__device__ __forceinline__ float wave_max(float v) {
#pragma unroll
    for (int o = 1; o < 64; o <<= 1) v = fmaxf(v, __shfl_xor(v, o));
    return v;
}
__device__ __forceinline__ float gelu_erf(float x) { return 0.5f * x * (1.0f + erff(x * 0.70710678118654752f)); }
__device__ __forceinline__ bf16x8 as_bf16x8(u32x4 v) { return __builtin_bit_cast(bf16x8, v); }

__device__ __forceinline__ void p0_transpose_item(const float* W, int K, int N, bf16_t* WT, const float* sc_a, const float* sc_b, LAS float* scr, int item, int lane) {
    const int nblk = N / 32, kb = item / nblk, nb = item % nblk, k0 = 64 * kb, n0 = 32 * nb;
#pragma unroll 8
    for (int i = 0; i < 32; ++i) { const int kk = 2 * i + (lane >> 5); const int k = k0 + kk;
        const float s = sc_a ? (k < 1024 ? sc_a[k] : sc_b[k - 1024]) : 1.f;
        scr[kk * 33 + (lane & 31)] = W[(size_t)k * N + n0 + (lane & 31)] * s; }
    LDS_WAIT();
    const int c = lane & 7;
#pragma unroll
    for (int j = 0; j < 4; ++j) { const int n = (lane >> 3) + 8 * j; const LAS float* s = scr + (8 * c) * 33 + n;
        u32x4 o; o.x = cvt_pk_bf16(s[0 * 33], s[1 * 33]); o.y = cvt_pk_bf16(s[2 * 33], s[3 * 33]); o.z = cvt_pk_bf16(s[4 * 33], s[5 * 33]); o.w = cvt_pk_bf16(s[6 * 33], s[7 * 33]);
        *(u32x4*)(WT + (size_t)(n0 + n) * K + k0 + 8 * c) = o; }
    LDS_WAIT();
}
template <int MODE> __device__ __forceinline__ void p0_row(const float* xrow, const float* g, bf16_t* orow, int lane) {
    const f32x4* xr = (const f32x4*)xrow + lane; const f32x4* gr = (const f32x4*)g + lane;
    f32x4 v[8]; float s = 0.f;
#pragma unroll
    for (int j = 0; j < 8; ++j) { v[j] = xr[64 * j]; s += (v[j].x * v[j].x + v[j].y * v[j].y) + (v[j].z * v[j].z + v[j].w * v[j].w); }
    float r = 1.f;
    if (MODE == 0) r = 1.0f / sqrtf(wave_sum(s) * (1.f / 2048.f) + EPS);
    u32x2* o8 = (u32x2*)orow + lane;
#pragma unroll
    for (int j = 0; j < 8; ++j) { f32x4 w = v[j] * r; if (MODE != 2) w = w * gr[64 * j];
        u32x2 o; o.x = cvt_pk_bf16(w.x, w.y); o.y = cvt_pk_bf16(w.z, w.w); o8[64 * j] = o; }
}
template <bool SCALE_G, bool OFFS> __device__ __forceinline__ void p0_row_q8(const float* xrow, const float* g, unsigned char* orow, float* sc, int lane) {
    const f32x4* xr = (const f32x4*)xrow + lane; const f32x4* gr = (const f32x4*)g + lane;
    f32x4 v[8]; float m = 0.f;
#pragma unroll
    for (int j = 0; j < 8; ++j) { v[j] = xr[64 * j]; if (SCALE_G) v[j] = v[j] * gr[64 * j];
        m = fmaxf(fmaxf(m, fmaxf(fabsf(v[j].x), fabsf(v[j].y))), fmaxf(fabsf(v[j].z), fabsf(v[j].w))); }
    m = fmaxf(wave_max(m), 1e-30f);
    const float inv = 127.f / m;
    if (lane == 0) *sc = m * (1.f / 127.f);
    unsigned* o4 = (unsigned*)orow + lane;
#pragma unroll
    for (int j = 0; j < 8; ++j) { const int a = (int)rintf(v[j].x * inv) + (OFFS ? 128 : 0), b = (int)rintf(v[j].y * inv) + (OFFS ? 128 : 0), c = (int)rintf(v[j].z * inv) + (OFFS ? 128 : 0), d = (int)rintf(v[j].w * inv) + (OFFS ? 128 : 0);
        o4[64 * j] = (unsigned)(a & 255) | ((unsigned)(b & 255) << 8) | ((unsigned)(c & 255) << 16) | ((unsigned)(d & 255) << 24); }
}
template <int KIND> __device__ __forceinline__ void p0_rows(const float* src, const float* g, void* dst, float* sc, int first, int stride, int nrows, int lane) {
    const f32x4* gr = (const f32x4*)g + lane;
    f32x4 cur[8], nxt[8];
    int r = first;
    if (r >= nrows) return;
    { const f32x4* xr = (const f32x4*)(src + (size_t)r * 2048) + lane;
#pragma unroll
        for (int j = 0; j < 8; ++j) cur[j] = xr[64 * j]; }
    for (; r < nrows; r += stride) {
        const int rn = r + stride;
        if (rn < nrows) { const f32x4* xr = (const f32x4*)(src + (size_t)rn * 2048) + lane;
#pragma unroll
            for (int j = 0; j < 8; ++j) nxt[j] = xr[64 * j]; }
        if (KIND == 0) {
            float s = 0.f;
#pragma unroll
            for (int j = 0; j < 8; ++j) s += (cur[j].x * cur[j].x + cur[j].y * cur[j].y) + (cur[j].z * cur[j].z + cur[j].w * cur[j].w);
            const float rr = 1.0f / sqrtf(wave_sum(s) * (1.f / 2048.f) + EPS);
            u32x2* o8 = (u32x2*)((bf16_t*)dst + (size_t)r * 2048) + lane;
#pragma unroll
            for (int j = 0; j < 8; ++j) { const f32x4 w = cur[j] * rr * gr[64 * j]; u32x2 o; o.x = cvt_pk_bf16(w.x, w.y); o.y = cvt_pk_bf16(w.z, w.w); o8[64 * j] = o; }
        } else {
            float m = 0.f;
#pragma unroll
            for (int j = 0; j < 8; ++j) { if (KIND == 1) cur[j] = cur[j] * gr[64 * j];
                m = fmaxf(fmaxf(m, fmaxf(fabsf(cur[j].x), fabsf(cur[j].y))), fmaxf(fabsf(cur[j].z), fabsf(cur[j].w))); }
            m = fmaxf(wave_max(m), 1e-30f);
            const float inv = 127.f / m; const int off = KIND == 2 ? 128 : 0;
            if (lane == 0) sc[r] = m * (1.f / 127.f);
            unsigned* o4 = (unsigned*)((unsigned char*)dst + (size_t)r * 2048) + lane;
#pragma unroll
            for (int j = 0; j < 8; ++j) { const int a = (int)rintf(cur[j].x * inv) + off, b = (int)rintf(cur[j].y * inv) + off, c = (int)rintf(cur[j].z * inv) + off, d = (int)rintf(cur[j].w * inv) + off;
                o4[64 * j] = (unsigned)(a & 255) | ((unsigned)(b & 255) << 8) | ((unsigned)(c & 255) << 16) | ((unsigned)(d & 255) << 24); }
        }
#pragma unroll
        for (int j = 0; j < 8; ++j) cur[j] = nxt[j];
    }
}
__device__ __forceinline__ void p0_wp_item(const float* wq, const float* keys1, const float* keys2, const float* gffn, bf16_t* WPT, int item, int lane) {
    const int hj = item >> 7, ib = item & 127, h = hj >> 1, j = hj & 1, i0 = 16 * ib, col0 = h * 256 + j * 128;
    const int lr = lane & 15, g = lane >> 4;
    const float* keys = (j ? keys2 : keys1) + (size_t)h * 128 * 128;
    const float gi = gffn[i0 + lr];
    bf16x8 af[4];
#pragma unroll
    for (int s = 0; s < 4; ++s) { const float* p = wq + (size_t)(i0 + lr) * 2048 + col0 + 32 * s + 8 * g;
        const f32x4 a = *(const f32x4*)p * gi, b = *(const f32x4*)(p + 4) * gi;
        u32x4 w; w.x = cvt_pk_bf16(a.x, a.y); w.y = cvt_pk_bf16(a.z, a.w); w.z = cvt_pk_bf16(b.x, b.y); w.w = cvt_pk_bf16(b.z, b.w); af[s] = as_bf16x8(w); }
    for (int kt = 0; kt < 8; ++kt) {
        f32x4 d = {0.f, 0.f, 0.f, 0.f};
#pragma unroll
        for (int s = 0; s < 4; ++s) { const float* p = keys + (size_t)(16 * kt + lr) * 128 + 32 * s + 8 * g;
            const f32x4 a = *(const f32x4*)p, b = *(const f32x4*)(p + 4);
            u32x4 w; w.x = cvt_pk_bf16(a.x, a.y); w.y = cvt_pk_bf16(a.z, a.w); w.z = cvt_pk_bf16(b.x, b.y); w.w = cvt_pk_bf16(b.z, b.w);
            d = MFMA16(af[s], as_bf16x8(w), d); }
        u32x2 o; o.x = cvt_pk_bf16(d[0], d[1]); o.y = cvt_pk_bf16(d[2], d[3]);
        *(u32x2*)(WPT + (size_t)(hj * 128 + 16 * kt + lr) * 2048 + i0 + 4 * g) = o;
    }
}
__device__ __forceinline__ int t5_bucket(int n) {
    if (n < 16) return n;
    const int large = 16 + (int)(logf((float)n / 16.f) / 4.852030263919617f * 16.f);
    return large < 31 ? large : 31;
}
__device__ __forceinline__ void p0_ssm_item(const Args& A, unsigned char* sp, int g, int lane) {
    const float* lam_re = A.in[6]; const float* lam_im = A.in[7]; const float* log_dt = A.in[8];
    const float* b_re = A.in[9]; const float* b_im = A.in[10]; const float* c_re = A.in[11]; const float* c_im = A.in[12];
    const int n = lane;
    const float dt = expf(log_dt[g]);
    const float lr = lam_re[g * 64 + n], li = lam_im[g * 64 + n];
    const float mag = expf(lr * dt);
    const float a_re = mag * cosf(li * dt), a_im = mag * sinf(li * dt);
    const float den = lr * lr + li * li;
    const float f_re = ((a_re - 1.f) * lr + a_im * li) / den, f_im = (a_im * lr - (a_re - 1.f) * li) / den;
    ((f32x2*)(sp + SSMP_ABAR))[g * 64 + n] = (f32x2){a_re, a_im};
    float pr = a_re, pi = a_im;
#pragma unroll
    for (int i = 0; i < 8; ++i) { const float nr = pr * pr - pi * pi, ni = 2.f * pr * pi; pr = nr; pi = ni; }
    ((f32x2*)(sp + SSMP_A256))[g * 64 + n] = (f32x2){pr, pi};
    float bbr[16], bbi[16];
#pragma unroll
    for (int q = 0; q < 4; ++q) { const f32x4 br = *(const f32x4*)(b_re + (size_t)(g * 64 + n) * 16 + 4 * q), bi = *(const f32x4*)(b_im + (size_t)(g * 64 + n) * 16 + 4 * q);
#pragma unroll
        for (int e = 0; e < 4; ++e) { bbr[4 * q + e] = f_re * br[e] - f_im * bi[e]; bbi[4 * q + e] = f_re * bi[e] + f_im * br[e]; } }
    bf16_t* bf = (bf16_t*)(sp + SSMP_BFRAG);
    const int jre = n >> 4, n16 = n & 15;
#pragma unroll
    for (int kg = 0; kg < 4; ++kg) {
        u32x4 wr = {0u, 0u, 0u, 0u}, wi = {0u, 0u, 0u, 0u};
        if (kg < 2) { const int c0 = (kg & 1) * 8;
            wr.x = cvt_pk_bf16(bbr[c0 + 0], bbr[c0 + 1]); wr.y = cvt_pk_bf16(bbr[c0 + 2], bbr[c0 + 3]); wr.z = cvt_pk_bf16(bbr[c0 + 4], bbr[c0 + 5]); wr.w = cvt_pk_bf16(bbr[c0 + 6], bbr[c0 + 7]);
            wi.x = cvt_pk_bf16(bbi[c0 + 0], bbi[c0 + 1]); wi.y = cvt_pk_bf16(bbi[c0 + 2], bbi[c0 + 3]); wi.z = cvt_pk_bf16(bbi[c0 + 4], bbi[c0 + 5]); wi.w = cvt_pk_bf16(bbi[c0 + 6], bbi[c0 + 7]); }
        *(u32x4*)(bf + ((size_t)(g * 8 + jre) * 64 + kg * 16 + n16) * 8) = wr;
        *(u32x4*)(bf + ((size_t)(g * 8 + 4 + jre) * 64 + kg * 16 + n16) * 8) = wi;
    }
    bf16_t* cf = (bf16_t*)(sp + SSMP_CFRAG);
    const int ch = lane & 15, kg = lane >> 4;
#pragma unroll
    for (int s = 0; s < 4; ++s) { const int k0 = 32 * s + 8 * kg;
        const float* src = (k0 < 64) ? (c_re + (size_t)(g * 16 + ch) * 64 + k0) : (c_im + (size_t)(g * 16 + ch) * 64 + (k0 - 64));
        const float sg = (k0 < 64) ? 1.f : -1.f;
        const f32x4 a = *(const f32x4*)src * sg, b = *(const f32x4*)(src + 4) * sg;
        u32x4 w; w.x = cvt_pk_bf16(a.x, a.y); w.y = cvt_pk_bf16(a.z, a.w); w.z = cvt_pk_bf16(b.x, b.y); w.w = cvt_pk_bf16(b.z, b.w);
        *(u32x4*)(cf + ((size_t)(g * 4 + s) * 64 + lane) * 8) = w; }
}
__device__ __forceinline__ void p0_btab_item(const Args& A, float* btab, int item, int lane) {
    const float* gq = A.in[3]; const float* gk = A.in[4]; const float* rel_bias = A.in[5];
    const int h = item / 3, br = item % 3, d = br == 0 ? 1 : (br == 1 ? 4 : 16);
    const float G = wave_max(fabsf(gq[lane] * gk[lane]));
    const float mb = wave_max(lane < 32 ? rel_bias[lane * 16 + h] : -1e30f);
    const float smax = 8.4f * G + mb;
    for (int idx = lane; idx < 192; idx += 64) { const int rel = idx - 31;
        float v = -1e30f;
        if (rel >= 0 && rel <= 128) v = LOG2E * (rel_bias[t5_bucket(rel * d) * 16 + h] - smax);
        btab[(h * 3 + br) * 192 + idx] = v; }
}

__device__ __forceinline__ void p0_prologue(const Args& A, LAS unsigned char* lds, int wave, int lane) {
    unsigned char* ws = A.ws;
    LAS float* scr = (LAS float*)(lds + wave * 16384);
    const int gw = blockIdx.x * 8 + wave, NGW = gridDim.x * 8;
    constexpr int I_WIN = (2048 / 64) * (4096 / 32), I_GLU = (1024 / 64) * (1024 / 32), I_WOUT = (2048 / 64) * (2048 / 32), I_WP = 2048;
    constexpr int I_SSM = 64, I_BT = 48;
    constexpr int NITEMS = I_WIN + I_GLU + I_WOUT + I_WP + I_SSM + I_BT;
    for (int it = gw; it < NITEMS; it += NGW) {
        int r = it;
        if (r < I_SSM) { p0_ssm_item(A, ws + WS_SSMP, r, lane); continue; } r -= I_SSM;
        if (r < I_BT) { p0_btab_item(A, (float*)(ws + WS_BTAB), r, lane); continue; } r -= I_BT;
        if (r < I_WP) { p0_wp_item(A.in[20], A.in[21], A.in[22], A.in[19], (bf16_t*)(ws + WS_WPT), r, lane); continue; } r -= I_WP;
        if (r < I_WIN) { p0_transpose_item(A.in[2], 2048, 4096, (bf16_t*)(ws + WS_WINT), nullptr, nullptr, scr, r, lane); continue; } r -= I_WIN;
        if (r < I_GLU) { p0_transpose_item(A.in[14], 1024, 1024, (bf16_t*)(ws + WS_GLUT), nullptr, nullptr, scr, r, lane); continue; } r -= I_GLU;
        p0_transpose_item(A.in[18], 2048, 2048, (bf16_t*)(ws + WS_WOUTT), A.in[16], A.in[17], scr, r, lane);
    }
    p0_rows<0>(A.in[0], A.in[1], ws + WS_HB, nullptr, gw, NGW, 8192, lane);
    p0_rows<1>(A.in[23], A.in[19], ws + WS_UB, (float*)(ws + WS_SU), gw, NGW, 16384, lane);
    p0_rows<2>(A.in[24], A.in[19], ws + WS_VB, (float*)(ws + WS_SV), gw, NGW, 16384, lane);
}

constexpr int SSM_WL = 8192 + 16 * 272;
__device__ __forceinline__ void ssm_unit(const Args& A, LAS unsigned char* lds, int b, int g, int wave, int lane) {
    unsigned char* ws = A.ws; unsigned char* sp = ws + WS_SSMP;
    const bf16_t* proj = (const bf16_t*)(ws + WS_PROJ); bf16_t* yb = (bf16_t*)(ws + WS_YB);
    LAS unsigned char* wl = lds + wave * SSM_WL;
    LAS f32x2* BU = (LAS f32x2*)wl; LAS unsigned char* XB = wl + 8192;
    LAS f32x2* carry = (LAS f32x2*)(lds + 8 * SSM_WL);
    const int lr = lane & 15, q = lane >> 4;
    bf16x8 bfr[8], cfr[4];
#pragma unroll
    for (int j = 0; j < 8; ++j) bfr[j] = as_bf16x8(*(const u32x4*)((const bf16_t*)(sp + SSMP_BFRAG) + ((size_t)(g * 8 + j) * 64 + lane) * 8));
#pragma unroll
    for (int s = 0; s < 4; ++s) cfr[s] = as_bf16x8(*(const u32x4*)((const bf16_t*)(sp + SSMP_CFRAG) + ((size_t)(g * 4 + s) * 64 + lane) * 8));
    const f32x2 ab = ((const f32x2*)(sp + SSMP_ABAR))[g * 64 + lane], a256 = ((const f32x2*)(sp + SSMP_A256))[g * 64 + lane];
    const float a_re = ab.x, a_im = ab.y;
    const float dsk = A.in[13][g * 16 + lr];
    const bf16_t* up = proj + (size_t)(b * SEQ + wave * 256) * DPROJ + 3072 + g * 16;
    float xr = 0.f, xi = 0.f;
#ifdef MK_DEBUG2
    unsigned long long hdd = 0ull, hbu = 0ull, hua = 0ull;
#endif
    for (int pass = 0; pass < 2; ++pass) {
        for (int blk = 0; blk < 16; ++blk) {
            u32x4 uraw = {0u, 0u, 0u, 0u};
            if (q < 2) uraw = *(const u32x4*)(up + (size_t)(blk * 16 + lr) * DPROJ + 8 * q);
            const bf16x8 ua = as_bf16x8(uraw);
            f32x4 dd[8];
#pragma unroll
            for (int j = 0; j < 8; ++j) dd[j] = MFMA16(ua, bfr[j], ((f32x4){0.f, 0.f, 0.f, 0.f}));
#pragma unroll
            for (int jj = 0; jj < 4; ++jj)
#pragma unroll
                for (int r = 0; r < 4; ++r) BU[(4 * q + r) * 64 + 16 * jj + lr] = (f32x2){dd[jj][r], dd[4 + jj][r]};
            LDS_WAIT(); CBAR();
            f32x2 bu[16];
#pragma unroll
            for (int t = 0; t < 16; ++t) bu[t] = BU[t * 64 + lane];
#ifdef MK_DEBUG2
            if (pass == 0) {
#pragma unroll
                for (int j = 0; j < 8; ++j)
#pragma unroll
                    for (int r = 0; r < 4; ++r) hdd = hdd * 0x100000001B3ull + __float_as_uint(dd[j][r]);
#pragma unroll
                for (int t = 0; t < 16; ++t) { hbu = hbu * 0x100000001B3ull + __float_as_uint(bu[t].x); hbu = hbu * 0x100000001B3ull + __float_as_uint(bu[t].y); }
                hua = hua * 0x100000001B3ull + uraw.x; hua = hua * 0x100000001B3ull + uraw.y; hua = hua * 0x100000001B3ull + uraw.z; hua = hua * 0x100000001B3ull + uraw.w; }
#endif
            if (pass == 0) {
#pragma unroll
                for (int t = 0; t < 16; ++t) { float nr = fmaf(a_re, xr, fmaf(-a_im, xi, bu[t].x)), ni = fmaf(a_re, xi, fmaf(a_im, xr, bu[t].y)); asm volatile("" : "+v"(nr)); asm volatile("" : "+v"(ni)); xr = nr; xi = ni; }
                asm volatile("" : "+v"(xr), "+v"(xi) :: "memory");
            } else {
#pragma unroll
                for (int t = 0; t < 16; ++t) { float nr = fmaf(a_re, xr, fmaf(-a_im, xi, bu[t].x)), ni = fmaf(a_re, xi, fmaf(a_im, xr, bu[t].y)); asm volatile("" : "+v"(nr)); asm volatile("" : "+v"(ni)); xr = nr; xi = ni;
                    const unsigned pk = cvt_pk_bf16(xr, xi);
                    *(LAS unsigned short*)(XB + t * 272 + lane * 2) = (unsigned short)(pk & 0xffffu);
                    *(LAS unsigned short*)(XB + t * 272 + 128 + lane * 2) = (unsigned short)(pk >> 16); }
                LDS_WAIT(); CBAR();
                f32x4 y = {0.f, 0.f, 0.f, 0.f};
#pragma unroll
                for (int s = 0; s < 4; ++s) { const bf16x8 xa = as_bf16x8(*(const LAS u32x4*)(XB + lr * 272 + (32 * s + 8 * q) * 2)); y = MFMA16(xa, cfr[s], y); }
#pragma unroll
                for (int r = 0; r < 4; ++r) { const int t = blk * 16 + 4 * q + r;
                    const float uv = __uint_as_float((unsigned)up[(size_t)t * DPROJ + lr] << 16);
                    const float yv = gelu_erf(y[r] + dsk * uv);
                    yb[(size_t)(b * SEQ + wave * 256 + t) * 1024 + g * 16 + lr] = (bf16_t)(cvt_pk_bf16(yv, 0.f) & 0xffffu); }
                asm volatile("" : "+v"(xr), "+v"(xi) :: "memory");
            }
        }
        if (pass == 0) {
            carry[wave * 64 + lane] = (f32x2){xr, xi};
#ifdef MK_DEBUG2
            { unsigned long long* hp = (unsigned long long*)(ws + WS_END + 99 * MB);
              const unsigned long long km = (2ull * (((unsigned long long)(b * 64 + g) * 8 + wave) * 64 + lane) + 1ull) * 0x9E3779B97F4A7C15ull;
              atomicAdd(hp + 0, hua * km); atomicAdd(hp + 1, hdd * km); atomicAdd(hp + 2, hbu * km); }
            ((f32x2*)(ws + WS_END + 108 * MB))[((size_t)(b * 64 + g) * 8 + wave) * 64 + lane] = (f32x2){xr, xi};
#endif
            __syncthreads();
            float sr = 0.f, si = 0.f;
            for (int w2 = 0; w2 < wave; ++w2) { const f32x2 e = carry[w2 * 64 + lane]; const float nr = a256.x * sr - a256.y * si + e.x, ni = a256.x * si + a256.y * sr + e.y; sr = nr; si = ni; }
            xr = sr; xi = si;
#ifdef MK_DEBUG2
            ((f32x2*)(ws + WS_END + 109 * MB))[((size_t)(b * 64 + g) * 8 + wave) * 64 + lane] = (f32x2){xr, xi};
#endif
        }
    }
    __syncthreads();
}

__device__ __forceinline__ void prep2_item(const Args& A, LAS unsigned char* wl, int item, int lane) {
    unsigned char* ws = A.ws;
    const bf16_t* proj = (const bf16_t*)(ws + WS_PROJ);
    const int pb = item & 31, h = (item >> 5) & 15, b = item >> 9, P0 = pb * 64, bh = b * 16 + h;
    const int r8 = lane >> 3, c = lane & 7;
    const float* gq = A.in[3]; const float* gk = A.in[4];
    const int fs = c >> 2, fg = c & 3;
#pragma unroll 1
    for (int which = 0; which < 2; ++which) {
        const float* gv = which ? gk : gq; const float cs = which ? 1.f : (LOG2E * 0.125f);
        float gl[8];
#pragma unroll
        for (int e = 0; e < 8; ++e) gl[e] = gv[8 * c + e] * cs;
        bf16_t* F = (bf16_t*)(ws + (which ? WS_KF : WS_QF));
#pragma unroll 2
        for (int i = 0; i < 8; ++i) { const int row = 8 * i + r8, pos = P0 + row;
            const u32x4 raw = *(const u32x4*)(proj + (size_t)(b * SEQ + pos) * DPROJ + which * 1024 + h * 64 + 8 * c);
            float v[8] = {bflo(raw.x), bfhi(raw.x), bflo(raw.y), bfhi(raw.y), bflo(raw.z), bfhi(raw.z), bflo(raw.w), bfhi(raw.w)};
            float ss = 0.f;
#pragma unroll
            for (int e = 0; e < 8; ++e) ss += v[e] * v[e];
            ss += __shfl_xor(ss, 1); ss += __shfl_xor(ss, 2); ss += __shfl_xor(ss, 4);
            const float r = 1.0f / sqrtf(ss * (1.f / 64.f) + EPS);
            u32x4 w; w.x = cvt_pk_bf16(v[0] * r * gl[0], v[1] * r * gl[1]); w.y = cvt_pk_bf16(v[2] * r * gl[2], v[3] * r * gl[3]);
            w.z = cvt_pk_bf16(v[4] * r * gl[4], v[5] * r * gl[5]); w.w = cvt_pk_bf16(v[6] * r * gl[6], v[7] * r * gl[7]);
#pragma unroll
            for (int br = 0; br < 3; ++br) { const int sh = 2 * br, rr = pos & ((1 << sh) - 1), l = pos >> sh;
                *(u32x4*)(F + (size_t)br * 4 * 16 * SEQ * 64 + ((((size_t)(bh << sh) + rr) * (SEQ >> (sh + 4)) + (l >> 4)) * 2 + fs) * 512 + (fg * 16 + (l & 15)) * 8) = w; } }
    }
#pragma unroll
    for (int i = 0; i < 8; ++i) { const int row = 8 * i + r8;
        const u32x4 raw = *(const u32x4*)(proj + (size_t)(b * SEQ + P0 + row) * DPROJ + 2048 + h * 64 + 8 * c);
        *(LAS u32x2*)(wl + row * 136 + c * 16) = (u32x2){raw.x, raw.y}; *(LAS u32x2*)(wl + row * 136 + c * 16 + 8) = (u32x2){raw.z, raw.w}; }
    CBAR();
    unsigned v[64];
#pragma unroll
    for (int p = 0; p < 64; ++p) v[p] = *(const LAS unsigned short*)(wl + p * 136 + lane * 2);
    CBAR();
    bf16_t* vt = (bf16_t*)(ws + WS_VT);
    const int nt = lane >> 4, dl = lane & 15;
#pragma unroll
    for (int G = 0; G < 2; ++G) { bf16_t* tp = vt + ((((size_t)bh * 64 + (P0 >> 5) + G) * 4 + nt) * 64 + dl) * 8;
#pragma unroll
        for (int kg = 0; kg < 4; ++kg) { const int a0 = 32 * G + 4 * kg, b0 = 32 * G + 16 + 4 * kg;
            u32x4 w; w.x = v[a0] | (v[a0 + 1] << 16); w.y = v[a0 + 2] | (v[a0 + 3] << 16); w.z = v[b0] | (v[b0 + 1] << 16); w.w = v[b0 + 2] | (v[b0 + 3] << 16);
            *(u32x4*)(tp + kg * 128) = w; } }
    { bf16_t* vt4 = vt + (size_t)4 * 16 * 64 * SEQ; const int l0 = P0 >> 2, tile = (l0 >> 4) & 1, grp = l0 >> 5;
#pragma unroll
        for (int r = 0; r < 4; ++r) { bf16_t* tp = vt4 + (((((size_t)bh * 4 + r) * 16 + grp) * 4 + nt) * 64 + dl) * 8;
#pragma unroll
            for (int kg = 0; kg < 4; ++kg) { const int p0 = 4 * (4 * kg) + r;
                u32x2 w; w.x = v[p0] | (v[p0 + 4] << 16); w.y = v[p0 + 8] | (v[p0 + 12] << 16);
                *(u32x2*)(tp + kg * 128 + 4 * tile) = w; } } }
    { bf16_t* vt16 = vt + (size_t)2 * 4 * 16 * 64 * SEQ; const int l0 = P0 >> 4, w32 = l0 & 31, tile = (w32 >> 4) & 1, kg = (w32 & 15) >> 2, grp = l0 >> 5;
#pragma unroll
        for (int r = 0; r < 16; ++r) { u32x2 w; w.x = v[r] | (v[16 + r] << 16); w.y = v[32 + r] | (v[48 + r] << 16);
            *(u32x2*)(vt16 + (((((size_t)bh * 16 + r) * 4 + grp) * 4 + nt) * 64 + kg * 16 + dl) * 8 + 4 * tile) = w; } }
}

struct AttnItem { int sh, r, lfirst, ks, tbo; size_t qk_off, v_off; };
__device__ __forceinline__ AttnItem attn_item(int it, int p0, int bh) {
    AttnItem I; const int br = it >> 4, j = it & 15; I.sh = 2 * br; I.tbo = br * 192;
    I.r = j & ((1 << I.sh) - 1); I.lfirst = (p0 >> I.sh) + 16 * (j >> I.sh);
    const size_t rc = (size_t)br * 4 * 16 * SEQ * 64 + ((size_t)(bh << I.sh) + I.r) * (size_t)(SEQ >> I.sh) * 64;
    I.qk_off = rc; I.v_off = rc;
    int ks = (I.lfirst - 128) & ~31; I.ks = ks < 0 ? 0 : ks;
    return I;
}
__device__ __forceinline__ void attn_unit(const Args& A, LAS unsigned char* lds, int unit, int tid, int wave, int lane, int pflags) {
    unsigned char* ws = A.ws;
    const int blk = 7 - (unit >> 6), bh = unit & 63, b = bh >> 4, h = bh & 15, p0 = blk * 256;
    constexpr int OST = 68;
    LAS float* Oacc = (LAS float*)lds; LAS float* lacc = (LAS float*)(lds + 256 * OST * 4); LAS float* tb = (LAS float*)(lds + 256 * OST * 4 + 1024);
    { const float* bt = (const float*)(ws + WS_BTAB) + h * 3 * 192; for (int i = tid; i < 3 * 192; i += 512) tb[i] = bt[i]; }
    __syncthreads();
    const bf16_t* QF = (const bf16_t*)(ws + WS_QF); const bf16_t* KF = (const bf16_t*)(ws + WS_KF); const bf16_t* VF = (const bf16_t*)(ws + WS_VT);
    const int qi = lane & 15, g = lane >> 4;
#define ATT_LOAD(IT, LK, B) do { const AttnItem _I = attn_item(IT, p0, bh); const bf16_t* _kp = KF + _I.qk_off + (size_t)((LK) >> 4) * 1024 + lane * 8; \
        B[0] = *(const u32x4*)(_kp); B[1] = *(const u32x4*)(_kp + 512); B[2] = *(const u32x4*)(_kp + 1024); B[3] = *(const u32x4*)(_kp + 1536); \
        const bf16_t* _vp = VF + _I.v_off + (size_t)((LK) >> 5) * 2048 + lane * 8; \
        B[4] = *(const u32x4*)(_vp); B[5] = *(const u32x4*)(_vp + 512); B[6] = *(const u32x4*)(_vp + 1024); B[7] = *(const u32x4*)(_vp + 1536); \
        const bf16_t* _qp = QF + _I.qk_off + (size_t)(_I.lfirst >> 4) * 1024 + lane * 8; B[8] = *(const u32x4*)(_qp); B[9] = *(const u32x4*)(_qp + 512); } while (0)
#define ATT_ADV(IT, LK, NIT, NLK) do { const AttnItem _J = attn_item(IT, p0, bh); if ((LK) + 32 <= _J.lfirst) { (NIT) = (IT); (NLK) = (LK) + 32; } else { (NIT) = (IT) + 8; (NLK) = 0; if ((NIT) < 48) { const AttnItem _N = attn_item(NIT, p0, bh); (NLK) = _N.ks; } } } while (0)
#define ATT_STEP(CIT, CLK, BC, NIT, NLK, NNIT, NNLK, BNN) { \
        NNIT = 64; NNLK = 0; \
        if ((NIT) < 48) { ATT_ADV(NIT, NLK, NNIT, NNLK); if ((NNIT) < 48) ATT_LOAD(NNIT, NNLK, BNN); } \
        const AttnItem cI = attn_item(CIT, p0, bh); \
        f32x4 sa = {0.f, 0.f, 0.f, 0.f}, sb = {0.f, 0.f, 0.f, 0.f}; \
        sa = MFMA16(as_bf16x8(BC[0]), as_bf16x8(BC[8]), sa); sb = MFMA16(as_bf16x8(BC[2]), as_bf16x8(BC[8]), sb); \
        sa = MFMA16(as_bf16x8(BC[1]), as_bf16x8(BC[9]), sa); sb = MFMA16(as_bf16x8(BC[3]), as_bf16x8(BC[9]), sb); \
        const LAS float* tbb = tb + cI.tbo; \
        const int ba = cI.lfirst + qi - (CLK) - 4 * g + 31; \
        float pa[4], pb[4]; \
        _Pragma("unroll") for (int e = 0; e < 4; ++e) { pa[e] = __builtin_amdgcn_exp2f(sa[e] + tbb[ba - e]); pb[e] = __builtin_amdgcn_exp2f(sb[e] + tbb[ba - 16 - e]); } \
        lsum += (pa[0] + pa[1]) + (pa[2] + pa[3]) + (pb[0] + pb[1]) + (pb[2] + pb[3]); \
        u32x4 pw; pw.x = cvt_pk_bf16(pa[0], pa[1]); pw.y = cvt_pk_bf16(pa[2], pa[3]); pw.z = cvt_pk_bf16(pb[0], pb[1]); pw.w = cvt_pk_bf16(pb[2], pb[3]); \
        const bf16x8 pf = as_bf16x8(pw); \
        _Pragma("unroll") for (int nt = 0; nt < 4; ++nt) o[nt] = MFMA16(pf, as_bf16x8(BC[4 + nt]), o[nt]); \
        if ((CLK) + 32 > cI.lfirst) {     \
            lsum += __shfl_xor(lsum, 16); lsum += __shfl_xor(lsum, 32); \
            const bool first = (CIT) < 16; \
            if (g == 0) { LAS float* lp = lacc + ((((cI.lfirst + qi) << cI.sh) + cI.r) - p0); *lp = first ? lsum : *lp + lsum; } \
            _Pragma("unroll") for (int reg = 0; reg < 4; ++reg) { LAS float* op = Oacc + (((((cI.lfirst + 4 * g + reg) << cI.sh) + cI.r) - p0)) * OST + qi; \
                _Pragma("unroll") for (int nt = 0; nt < 4; ++nt) op[16 * nt] = first ? o[nt][reg] : op[16 * nt] + o[nt][reg]; } \
            _Pragma("unroll") for (int nt = 0; nt < 4; ++nt) o[nt] = (f32x4){0.f, 0.f, 0.f, 0.f}; \
            lsum = 0.f; \
            if (((CIT) >> 3) & 1) __syncthreads();     \
        } \
        if ((NIT) >= 48) break; }
    if (!(pflags & 16)) {
    int itA = wave, lkA, itB, lkB, itC = 64, lkC = 0;
    { const AttnItem I0 = attn_item(wave, p0, bh); lkA = I0.ks; }
    ATT_ADV(itA, lkA, itB, lkB);
    u32x4 bA[10], bB[10], bC[10];
    ATT_LOAD(itA, lkA, bA); if (itB < 48) ATT_LOAD(itB, lkB, bB);
    f32x4 o[4];
#pragma unroll
    for (int nt = 0; nt < 4; ++nt) o[nt] = (f32x4){0.f, 0.f, 0.f, 0.f};
    float lsum = 0.f;
    for (;;) {
        ATT_STEP(itA, lkA, bA, itB, lkB, itC, lkC, bC)
        ATT_STEP(itB, lkB, bB, itC, lkC, itA, lkA, bA)
        ATT_STEP(itC, lkC, bC, itA, lkA, itB, lkB, bB)
    }
    }
#undef ATT_LOAD
#undef ATT_ADV
#undef ATT_STEP
    if (!(pflags & (16 | 32 | 64))) { const int ql = tid >> 1, half = tid & 1; const float inv = 1.0f / lacc[ql];
        bf16_t* dst = (bf16_t*)(ws + WS_MIXED) + (size_t)(b * SEQ + p0 + ql) * 2048 + h * 64 + 32 * half;
        float ss = 0.f;
#pragma unroll
        for (int c4 = 0; c4 < 4; ++c4) { float v[8];
#pragma unroll
            for (int e = 0; e < 8; ++e) { v[e] = Oacc[ql * OST + 32 * half + 8 * c4 + e] * inv; ss += v[e] * v[e]; }
            u32x4 w; w.x = cvt_pk_bf16(v[0], v[1]); w.y = cvt_pk_bf16(v[2], v[3]); w.z = cvt_pk_bf16(v[4], v[5]); w.w = cvt_pk_bf16(v[6], v[7]);
            *(u32x4*)(dst + 8 * c4) = w; }
        ss += __shfl_xor(ss, 1);
        if (half == 0) unsafeAtomicAdd((float*)(ws + WS_CTL + CTL_RSS_ATTN) + b * SEQ + p0 + ql, ss); }
    __syncthreads();
}

__device__ __forceinline__ unsigned fkey(float f) { const unsigned u = __float_as_uint(f); return (u & 0x80000000u) ? ~u : (u | 0x80000000u); }
template <int R> __device__ __forceinline__ void select16(const unsigned (&key)[R], unsigned long long (&m)[R]) {
    unsigned T = 0u; int cnt = R * 64;
    for (int bit = 31; bit >= 0; --bit) { const unsigned cand = T | (1u << bit); int c = 0;
#pragma unroll
        for (int r = 0; r < R; ++r) c += __popcll(__ballot(key[r] >= cand));
        if (c >= 16) { T = cand; cnt = c; if (c == 16) break; } }
    if (cnt == 16) {
#pragma unroll
        for (int r = 0; r < R; ++r) m[r] = __ballot(key[r] >= T);
    } else {
        int need = 16;
#pragma unroll
        for (int r = 0; r < R; ++r) { m[r] = __ballot(key[r] > T); need -= __popcll(m[r]); }
#pragma unroll
        for (int r = 0; r < R; ++r) { unsigned long long eq = __ballot(key[r] == T);
            while (__popcll(eq) > need) eq &= ~(1ull << (63 - __builtin_clzll(eq)));
            need -= __popcll(eq); m[r] |= eq; }
    }
}
__device__ __forceinline__ void peer_topk(const float* sp, LAS float* sc, LAS int* exo, LAS float* gto, int lane) {
    LAS float* v1 = sc; LAS int* i1 = (LAS int*)(sc + 16); LAS float* v2 = sc + 32; LAS int* i2 = (LAS int*)(sc + 48); LAS float* sv = sc + 64; LAS int* si = (LAS int*)(sc + 80);
    const unsigned long long lt = (1ull << lane) - 1ull;
#pragma unroll
    for (int half = 0; half < 2; ++half) {
        const float a0 = sp[half * 128 + lane], a1 = sp[half * 128 + 64 + lane];
        const unsigned key[2] = {fkey(a0), fkey(a1)}; unsigned long long m[2];
        select16<2>(key, m);
        LAS float* vv = half ? v2 : v1; LAS int* ii = half ? i2 : i1;
        if ((m[0] >> lane) & 1ull) { const int pos = __popcll(m[0] & lt); vv[pos] = a0; ii[pos] = lane; }
        if ((m[1] >> lane) & 1ull) { const int pos = __popcll(m[0]) + __popcll(m[1] & lt); vv[pos] = a1; ii[pos] = 64 + lane; }
    }
    CBAR(); LDS_WAIT();
    const int a = lane >> 2, bb = (lane & 3) * 4;
    const float va = v1[a]; float cv[4]; unsigned key[4]; unsigned long long m[4];
#pragma unroll
    for (int e = 0; e < 4; ++e) { cv[e] = va + v2[bb + e]; key[e] = fkey(cv[e]); }
    select16<4>(key, m);
    int base = 0;
#pragma unroll
    for (int e = 0; e < 4; ++e) { if ((m[e] >> lane) & 1ull) { const int pos = base + __popcll(m[e] & lt); sv[pos] = cv[e]; si[pos] = a * 16 + bb + e; } base += __popcll(m[e]); }
    CBAR(); LDS_WAIT();
    if (lane < 16) {
        const float val = sv[lane]; const int fi = si[lane];
        float mx = val;
#pragma unroll
        for (int o = 1; o < 16; o <<= 1) mx = fmaxf(mx, __shfl_xor(mx, o));
        const float ex = expf(val - mx); float sum = ex;
#pragma unroll
        for (int o = 1; o < 16; o <<= 1) sum += __shfl_xor(sum, o);
        exo[lane] = i1[fi >> 4] * 128 + (i2[fi & 15] - 0);
        gto[lane] = ex / sum;
    }
    CBAR(); LDS_WAIT();
}

constexpr int PD = 8;
__device__ __forceinline__ float ubyte_f32(unsigned w, int i) { return (float)((w >> (8 * i)) & 0xffu); }
__device__ __forceinline__ void peer_wave(const Args& A, LAS unsigned char* lds, int wave, int lane, int pflags) {
    unsigned char* ws = A.ws;
    const float* scores = (const float*)(ws + WS_PROJ);
    const unsigned char* ub = ws + WS_UB; const unsigned char* vb = ws + WS_VB; const bf16_t* x1b = (const bf16_t*)(ws + WS_HB);
    const float* su = (const float*)(ws + WS_SU); const float* sv = (const float*)(ws + WS_SV);
    const float* rssx = (const float*)(ws + WS_CTL + CTL_RSS_X1);
    LAS int* exl = (LAS int*)(lds + wave * 4096);
    LAS float* gtl = (LAS float*)(lds + wave * 4096 + 2048);
    LAS float* sc = (LAS float*)(lds + 32768 + wave * 512);
    LAS float* wts = (LAS float*)(lds + 36864 + wave * 512);
    const int t0 = (blockIdx.x * 8 + wave) * 4;
    if (t0 >= NTOK) return;
    for (int h = 0; h < 8; ++h) peer_topk(scores + (size_t)t0 * 2048 + h * 256, sc, exl + h * 16, gtl + h * 16, lane);
    CBAR(); LDS_WAIT();
#ifdef MK_DEBUG_EXPERTS
    for (int i = lane; i < 512; i += 64) { ((int*)(ws + WS_END + 100 * MB))[(size_t)t0 * 128 + i] = exl[i]; ((float*)(ws + WS_END + 104 * MB))[(size_t)t0 * 128 + i] = gtl[i]; }
#endif
    if (pflags & 256) return;
    u32x4 buf[PD][2];
#define ROWPTR(s) (((s) & 128 ? vb : ub) + (size_t)exl[((s) >> 8) * 128 + ((s) & 127)] * 2048 + 16 * lane)
#define ISSUE(slot, s) do { const unsigned char* _p = ROWPTR(s); buf[slot][0] = *(const u32x4*)(_p); buf[slot][1] = *(const u32x4*)(_p + 1024); } while (0)
#pragma unroll
    for (int i = 0; i < PD; ++i) ISSUE(i, i);
    for (int tok = 0; tok < 4; ++tok) {
        const int t = t0 + tok;
        unsigned xq[8]; float sx;
        { float xf[32];
#pragma unroll
            for (int j = 0; j < 2; ++j)
#pragma unroll
                for (int hlf = 0; hlf < 2; ++hlf) { const u32x4 raw = *(const u32x4*)(x1b + (size_t)t * 2048 + 16 * lane + 1024 * j + 8 * hlf);
                    const unsigned rw[4] = {raw.x, raw.y, raw.z, raw.w};
#pragma unroll
                    for (int e = 0; e < 4; ++e) { xf[16 * j + 8 * hlf + 2 * e] = bflo(rw[e]); xf[16 * j + 8 * hlf + 2 * e + 1] = bfhi(rw[e]); } }
            float m = 0.f;
#pragma unroll
            for (int i = 0; i < 32; ++i) m = fmaxf(m, fabsf(xf[i]));
            m = fmaxf(wave_max(m), 1e-30f);
            const float inv = 127.f / m; sx = m * (1.f / 127.f);
#pragma unroll
            for (int d = 0; d < 8; ++d) { const int a = (int)rintf(xf[4 * d] * inv), b = (int)rintf(xf[4 * d + 1] * inv), c = (int)rintf(xf[4 * d + 2] * inv), e = (int)rintf(xf[4 * d + 3] * inv);
                xq[d] = (unsigned)(a & 255) | ((unsigned)(b & 255) << 8) | ((unsigned)(c & 255) << 16) | ((unsigned)(e & 255) << 24); } }
        const float r2 = 1.0f / sqrtf(rssx[t] * (1.f / 2048.f) + EPS);
        const float ascale = sx * r2;
        for (int k0 = 0; k0 < 128; k0 += PD) {
            int p[PD];
#pragma unroll
            for (int i = 0; i < PD; ++i) {
                const int s = tok * 256 + k0 + i;
                int acc = 0;
                { const unsigned w0[4] = {buf[i][0].x, buf[i][0].y, buf[i][0].z, buf[i][0].w}, w1[4] = {buf[i][1].x, buf[i][1].y, buf[i][1].z, buf[i][1].w};
#pragma unroll
                    for (int e = 0; e < 4; ++e) { acc = __builtin_amdgcn_sdot4((int)w0[e], (int)xq[e], acc, false); acc = __builtin_amdgcn_sdot4((int)w1[e], (int)xq[4 + e], acc, false); } }
                p[i] = acc;
                if (s + PD < 4 * 256) ISSUE(i, s + PD);
            }
            const bool b0 = lane & 1, b1 = lane & 2, b2 = lane & 4;
            int q4[4], q2[2], q1;
#pragma unroll
            for (int i = 0; i < 4; ++i) { const int keep = b0 ? p[i + 4] : p[i], send = b0 ? p[i] : p[i + 4]; q4[i] = keep + __shfl_xor(send, 1); }
#pragma unroll
            for (int i = 0; i < 2; ++i) { const int keep = b1 ? q4[i + 2] : q4[i], send = b1 ? q4[i] : q4[i + 2]; q2[i] = keep + __shfl_xor(send, 2); }
            { const int keep = b2 ? q2[1] : q2[0], send = b2 ? q2[0] : q2[1]; q1 = keep + __shfl_xor(send, 4); }
            q1 += __shfl_xor(q1, 8); q1 += __shfl_xor(q1, 16); q1 += __shfl_xor(q1, 32);
            if (lane < 8) { const int k = k0 + 4 * (lane & 1) + 2 * ((lane >> 1) & 1) + ((lane >> 2) & 1);
                const int e = exl[tok * 128 + k];
                const float a = (float)q1 * (ascale * su[e]);
                wts[k] = gtl[tok * 128 + k] * gelu_erf(a) * sv[e]; }
            if (tok < 3 && (k0 & 8)) { const int hh = k0 >> 4;
                peer_topk(scores + (size_t)(t + 1) * 2048 + hh * 256, sc, exl + (tok + 1) * 128 + hh * 16, gtl + (tok + 1) * 128 + hh * 16, lane); }
        }
        CBAR(); LDS_WAIT();
        float acc[32]; float wsum = 0.f;
#pragma unroll
        for (int i = 0; i < 32; ++i) acc[i] = 0.f;
        for (int k0 = 0; k0 < 128; k0 += PD) {
#pragma unroll
            for (int i = 0; i < PD; ++i) {
                const int k = k0 + i, s = tok * 256 + 128 + k;
                const float w = wts[k];
                wsum += w;
                { const unsigned w0[4] = {buf[i][0].x, buf[i][0].y, buf[i][0].z, buf[i][0].w}, w1[4] = {buf[i][1].x, buf[i][1].y, buf[i][1].z, buf[i][1].w};
#pragma unroll
                    for (int e = 0; e < 4; ++e)
#pragma unroll
                        for (int bb = 0; bb < 4; ++bb) { acc[4 * e + bb] += w * ubyte_f32(w0[e], bb); acc[16 + 4 * e + bb] += w * ubyte_f32(w1[e], bb); } }
                if (s + PD < 4 * 256) ISSUE(i, s + PD);
            }
        }
        CBAR();
        const float corr = -128.f * wsum;
        float* op = A.out + (size_t)t * 2048 + 16 * lane;
        if (pflags & 128) { if (corr == 12345.678f) op[0] = acc[0]; continue; }
#pragma unroll
        for (int j = 0; j < 2; ++j)
#pragma unroll
            for (int hlf = 0; hlf < 2; ++hlf) { const u32x4 raw = *(const u32x4*)(x1b + (size_t)t * 2048 + 16 * lane + 1024 * j + 8 * hlf);
                const int a0 = 16 * j + 8 * hlf;
                *(f32x4*)(op + 1024 * j + 8 * hlf) = (f32x4){bflo(raw.x) + acc[a0] + corr, bfhi(raw.x) + acc[a0 + 1] + corr, bflo(raw.y) + acc[a0 + 2] + corr, bfhi(raw.y) + acc[a0 + 3] + corr};
                *(f32x4*)(op + 1024 * j + 8 * hlf + 4) = (f32x4){bflo(raw.z) + acc[a0 + 4] + corr, bfhi(raw.z) + acc[a0 + 5] + corr, bflo(raw.w) + acc[a0 + 6] + corr, bfhi(raw.w) + acc[a0 + 7] + corr}; }
    }
#undef ROWPTR
#undef ISSUE
}

__global__ void __launch_bounds__(512, 2) mk_fwd(Args args) {
    extern __shared__ __attribute__((aligned(16))) unsigned char lds_raw[];
    LAS unsigned char* lds = (LAS unsigned char*)lds_raw;
    const int tid = threadIdx.x, lane = tid & 63, wave = __builtin_amdgcn_readfirstlane(tid >> 6);
    volatile LAS unsigned* MISC = (volatile LAS unsigned*)(lds + MISC_OFF);
    if (tid < 64) MISC[tid] = 0u;
    __syncthreads();
    unsigned char* ws = args.ws;
    const int lo = args.ph_lo, hi = args.ph_hi & 0xff, pflags = args.ph_hi >> 8;
    XcdBarrier bar; bar.bar = (unsigned*)(ws + WS_CTL); bar.x = 0; bar.st = nullptr;
    if (hi - lo > 1) bar = xcd_barrier_post((unsigned*)(ws + WS_CTL), MISC + 8);
#ifndef PH_MASK
#define PH_MASK 0x7f
#endif
#define IN(k) (((PH_MASK >> (k)) & 1) && lo <= (k) && (k) < hi)
#define SEAM(k) do { if (IN(k) && IN((k) + 1)) xcd_barrier(bar); } while (0)

    if (IN(0)) { p0_prologue(args, lds, wave, lane); }
    SEAM(0);
    if (IN(1)) {
        pg8::Gemm g{(const bf16_t*)(ws + WS_HB), (const bf16_t*)(ws + WS_WINT), NTOK, DPROJ, DM}; pg8::StaticOrder S; S.init(NTOK, DPROJ, gridDim.x, (int)blockIdx.x);
        pg8::EpiProj E{(bf16_t*)(ws + WS_PROJ), DPROJ};
        pg8::gemm_phase<pg8::EpiProj, pg8::StaticOrder, false>(lds, g, S, E, nullptr);
    }
    SEAM(1);
    if (IN(2)) {
        if (!(pflags & 4)) for (int u = blockIdx.x; u < 256; u += gridDim.x) ssm_unit(args, lds, u >> 6, u & 63, wave, lane);
        if (!(pflags & 8)) for (int it = blockIdx.x * 8 + wave; it < 2048; it += gridDim.x * 8) prep2_item(args, lds + wave * SSM_WL, it, lane);
    }
    SEAM(2);
    if (IN(3)) {
        if (!(pflags & 2)) {
            pg8::Gemm g{(const bf16_t*)(ws + WS_YB), (const bf16_t*)(ws + WS_GLUT), NTOK, 1024, 1024}; pg8::StaticOrder S; S.init(NTOK, 1024, gridDim.x, (int)blockIdx.x);
            pg8::EpiGlu E{(const bf16_t*)(ws + WS_YB), (bf16_t*)(ws + WS_MIXED) + 1024, args.in[15], (float*)(ws + WS_CTL + CTL_RSS_SSM)};
            pg8::gemm_phase<pg8::EpiGlu, pg8::StaticOrder, false>(lds, g, S, E, nullptr);
        }
        __syncthreads();
        if (!(pflags & 1)) for (;;) {
            if (tid == 0) MISC[0] = atomicAdd((unsigned*)(ws + WS_CTL + CTL_QCTR), 1u);
            __syncthreads();
            const unsigned u = MISC[0];
            __syncthreads();
            if (u >= 512u) break;
            attn_unit(args, lds, (int)u, tid, wave, lane, pflags);
        }
    }
    SEAM(3);
    if (IN(4)) {
        pg8::Gemm g{(const bf16_t*)(ws + WS_MIXED), (const bf16_t*)(ws + WS_WOUTT), NTOK, DM, DM}; pg8::StaticOrder S; S.init(NTOK, DM, gridDim.x, (int)blockIdx.x);
        LAS float* tab = (LAS float*)(lds + 131072);
        { pg8::Unit u0; if (S.next(0, u0) && tid < 256) { const int row = u0.pm * 256 + tid;
            const float ra = 1.0f / sqrtf(((const float*)(ws + WS_CTL + CTL_RSS_ATTN))[row] * (1.f / 1024.f) + EPS), rs = 1.0f / sqrtf(((const float*)(ws + WS_CTL + CTL_RSS_SSM))[row] * (1.f / 1024.f) + EPS);
            tab[tid] = ra / rs; tab[256 + tid] = rs; } }
        __syncthreads();
        pg8::EpiWout E{args.in[0], args.out, (bf16_t*)(ws + WS_HB), (float*)(ws + WS_CTL + CTL_RSS_X1), tab};
        pg8::gemm_phase<pg8::EpiWout, pg8::StaticOrder, false>(lds, g, S, E, nullptr);
    }
    SEAM(4);
    if (IN(5)) {
        pg8::Gemm g{(const bf16_t*)(ws + WS_HB), (const bf16_t*)(ws + WS_WPT), NTOK, DM, DM}; pg8::StaticOrder S; S.init(NTOK, DM, gridDim.x, (int)blockIdx.x);
        pg8::EpiScores E{(float*)(ws + WS_PROJ), (const float*)(ws + WS_CTL + CTL_RSS_X1)};
        pg8::gemm_phase<pg8::EpiScores, pg8::StaticOrder, false>(lds, g, S, E, nullptr);
    }
    SEAM(5);
    if (IN(6)) { peer_wave(args, lds, wave, lane, pflags); }
#undef IN
#undef SEAM
}

#ifndef MK_DEBUG
#ifndef MK_PER_PHASE
#define MK_PER_PHASE 0
#endif
extern "C" void kernel_launch(void* const* d_in, const int* in_sizes, int n_in, void* d_out, int out_size, void* d_ws, size_t ws_size, hipStream_t stream) {
    static int grid = 0;
    if (grid == 0) {
        if (n_in != 25 || out_size != NTOK * DM || ws_size < WS_END) { fprintf(stderr, "kernel_launch: unexpected shapes / workspace (%d inputs, out %d, ws %zu < %zu)\n", n_in, out_size, ws_size, (size_t)WS_END); grid = -1; return; }
        int dev = 0, cus = 0, per_cu = 0;
        if (hipGetDevice(&dev) != hipSuccess || hipDeviceGetAttribute(&cus, hipDeviceAttributeMultiprocessorCount, dev) != hipSuccess) { grid = -1; return; }
        if (hipFuncSetAttribute((const void*)mk_fwd, hipFuncAttributeMaxDynamicSharedMemorySize, LDS_BYTES) != hipSuccess) { fprintf(stderr, "kernel_launch: hipFuncSetAttribute failed\n"); grid = -1; return; }
        if (hipOccupancyMaxActiveBlocksPerMultiprocessor(&per_cu, (const void*)mk_fwd, 512, LDS_BYTES) != hipSuccess || per_cu < 1) { fprintf(stderr, "kernel_launch: occupancy query reports %d\n", per_cu); }
        (void)hipGetLastError();
        grid = cus;
    }
    if (grid < 0) return;
    (void)hipMemsetAsync((char*)d_ws + WS_CTL, 0, CTL_BYTES, stream);
    Args a{};
    for (int i = 0; i < 25; ++i) a.in[i] = (const float*)d_in[i];
    a.out = (float*)d_out; a.ws = (unsigned char*)d_ws;
#if MK_PER_PHASE
#ifndef MK_DUP
#define MK_DUP -1
#endif
    for (int p = 0; p < 7; ++p) { a.ph_lo = p; a.ph_hi = p + 1; hipLaunchKernelGGL(mk_fwd, dim3(grid), dim3(512), LDS_BYTES, stream, a);
        if (p == MK_DUP) {
            (void)hipMemsetAsync((char*)d_ws + WS_CTL + CTL_QCTR, 0, 256, stream);
#ifndef MK_DUP_FLAGS
#define MK_DUP_FLAGS 0
#endif
            if (p == 3 && !((MK_DUP_FLAGS) & (1 | 16 | 32 | 64))) (void)hipMemsetAsync((char*)d_ws + WS_CTL + CTL_RSS_ATTN, 0, 32768, stream);
            if (p == 3 && !((MK_DUP_FLAGS) & 2)) (void)hipMemsetAsync((char*)d_ws + WS_CTL + CTL_RSS_SSM, 0, 32768, stream);
            if (p == 4) (void)hipMemsetAsync((char*)d_ws + WS_CTL + CTL_RSS_X1, 0, 32768, stream);
            a.ph_hi |= (MK_DUP_FLAGS) << 8;
            hipLaunchKernelGGL(mk_fwd, dim3(grid), dim3(512), LDS_BYTES, stream, a); } }
#else
    a.ph_lo = 0; a.ph_hi = 7;
    hipLaunchKernelGGL(mk_fwd, dim3(grid), dim3(512), LDS_BYTES, stream, a);
#endif
}
#endif
```

```cpp
#include <hip/hip_runtime.h>
#include <stdint.h>
#include <stdio.h>

typedef unsigned short bf16_t;
typedef float f32x2 __attribute__((ext_vector_type(2)));
typedef unsigned u32x2 __attribute__((ext_vector_type(2)));
using bf16x2v = __attribute__((ext_vector_type(2))) __bf16;

constexpr int NTOK = 8192, SEQ = 2048, DM = 2048, DPROJ = 4096;
constexpr float EPS = 1e-6f;
constexpr float LOG2E = 1.4426950408889634f;

constexpr size_t MB = 1024 * 1024;
constexpr size_t WS_CTL = 0;
constexpr size_t CTL_BYTES = 128 * 1024;
constexpr size_t CTL_QCTR = 16384;
constexpr size_t CTL_RSS_ATTN = 32768, CTL_RSS_SSM = 65536, CTL_RSS_X1 = 98304;
constexpr size_t WS_HB = 256 * 1024;
constexpr size_t WS_WINT = WS_HB + 32 * MB;
constexpr size_t WS_GLUT = WS_WINT + 16 * MB;
constexpr size_t WS_WOUTT = WS_GLUT + 2 * MB;
constexpr size_t WS_WPT = WS_WOUTT + 8 * MB;
constexpr size_t WS_UB = WS_WPT + 8 * MB;
constexpr size_t WS_VB = WS_UB + 32 * MB;
constexpr size_t WS_SU = WS_VB + 32 * MB;
constexpr size_t WS_SV = WS_SU + 65536;
constexpr size_t WS_PROJ = WS_SV + 65536;
constexpr size_t WS_QF = WS_PROJ + 64 * MB;
constexpr size_t WS_KF = WS_QF + 48 * MB;
constexpr size_t WS_VT = WS_KF + 48 * MB;
constexpr size_t WS_QN = WS_QF, WS_KN = WS_KF;
constexpr size_t WS_YB = WS_VT + 48 * MB + 4096;
constexpr size_t WS_MIXED = WS_YB + 16 * MB;
constexpr size_t WS_SSMP = WS_MIXED + 32 * MB;
constexpr size_t SSMP_ABAR = 0, SSMP_A256 = 32768, SSMP_BFRAG = 65536, SSMP_CFRAG = 65536 + 524288;
constexpr size_t WS_BTAB = WS_SSMP + 1 * MB;
constexpr size_t WS_END = WS_BTAB + 64 * 1024;

constexpr int LDS_BYTES = 147456;
constexpr int MISC_OFF = 147456 - 256;
#define XB_TMO      128
#define XB_XCNT(j)  (256  + 64 * (j))
#define XB_XSUB(j)  (1280 + 64 * (j))
#define XB_XGEN(j)  (2304 + 64 * (j))
#define XB_TOP      3328
#define XB_TOPGEN   3392
#define XCD_BAR_WORDS 3456
#define XB_SPIN_CAP (1u << 18)
#define LAS __attribute__((address_space(3)))

__device__ __forceinline__ unsigned xb_ld(unsigned* p)              { return __hip_atomic_load(p, __ATOMIC_RELAXED, __HIP_MEMORY_SCOPE_AGENT); }
__device__ __forceinline__ unsigned xb_add(unsigned* p, unsigned v) { return __hip_atomic_fetch_add(p, v, __ATOMIC_RELAXED, __HIP_MEMORY_SCOPE_AGENT); }
__device__ __forceinline__ unsigned xb_xcc_id() { return (unsigned)__builtin_amdgcn_s_getreg((3 << 11) | 20) & 0xFu; }
#define XB_SPIN(cond, bar) do { unsigned _sp = 0; while (cond) { __builtin_amdgcn_s_sleep(1); \
    if ((++_sp & 255u) == 0u) { if (xb_ld(&(bar)[XB_TMO])) break; if (_sp > XB_SPIN_CAP) { atomicAdd(&(bar)[XB_TMO], 1u); break; } } } } while (0)

struct XcdBarrier {
    unsigned* bar; unsigned x;
    volatile LAS unsigned* st;
};

__device__ __forceinline__ XcdBarrier xcd_barrier_post(unsigned* bar, volatile LAS unsigned* st) {
    XcdBarrier b; b.bar = bar; b.x = xb_xcc_id(); b.st = st;
    if (threadIdx.x == 0) (void)xb_add(&bar[XB_XCNT(b.x)], 1u);
    return b;
}
__device__ __forceinline__ void xcd_barrier_complete(unsigned* bar, unsigned x, unsigned& nloc, unsigned& nx) {
    const unsigned G = gridDim.x * gridDim.y * gridDim.z;
    unsigned sum, cnt, mine, sp = 0u;
    for (;;) {
        sum = 0u; cnt = 0u; mine = 0u;
#pragma unroll
        for (unsigned j = 0; j < 16; ++j) { const unsigned c = xb_ld(&bar[XB_XCNT(j)]); sum += c; cnt += (c > 0u) ? 1u : 0u; mine = (j == x) ? c : mine; }
        if (sum == G) break;
        __builtin_amdgcn_s_sleep(1);
        if ((++sp & 255u) == 0u) { if (xb_ld(&bar[XB_TMO])) break; if (sp > XB_SPIN_CAP) { atomicAdd(&bar[XB_TMO], 1u); break; } }
    }
    nloc = mine > 0u ? mine : 1u; nx = cnt > 0u ? cnt : 1u;
}

__device__ __forceinline__ void xcd_barrier(const XcdBarrier& b) {
    asm volatile("s_waitcnt vmcnt(0)" ::: "memory");
    __syncthreads();
    if (threadIdx.x == 0) {
        unsigned* bar = b.bar;
        __builtin_amdgcn_s_waitcnt(0);
        unsigned nloc = b.st[0], nx = b.st[1];
        if (nloc == 0u) { xcd_barrier_complete(bar, b.x, nloc, nx); b.st[0] = nloc; b.st[1] = nx; }
        const unsigned old = xb_add(&bar[XB_XSUB(b.x)], 1u);
        const unsigned gen = old / nloc;
        if (old + 1u == (gen + 1u) * nloc) {
            __builtin_amdgcn_fence(__ATOMIC_RELEASE, "agent");
            asm volatile("s_waitcnt vmcnt(0)" ::: "memory");
            const unsigned og = xb_add(&bar[XB_TOP], 1u);
            const unsigned tg = og / nx;
            if (og + 1u == (tg + 1u) * nx) xb_add(&bar[XB_TOPGEN], 1u);
            else XB_SPIN(xb_ld(&bar[XB_TOPGEN]) == tg, bar);
            __builtin_amdgcn_fence(__ATOMIC_ACQUIRE, "agent");
            xb_add(&bar[XB_XGEN(b.x)], 1u);
            asm volatile("s_waitcnt vmcnt(0)" ::: "memory");
        } else {
            XB_SPIN(xb_ld(&bar[XB_XGEN(b.x)]) == gen, bar);
            __builtin_amdgcn_fence(__ATOMIC_ACQUIRE, "agent");
            asm volatile("s_waitcnt vmcnt(0)" ::: "memory");
        }
    }
    __syncthreads();
}
namespace pg8 {
#define PG8_LAS __attribute__((address_space(3)))
typedef unsigned short bf16_t;
typedef short bf16x8 __attribute__((ext_vector_type(8)));
typedef float f32x4 __attribute__((ext_vector_type(4)));
typedef unsigned u32x4 __attribute__((ext_vector_type(4)));
constexpr int BM = 256, BK = 64, HALF = 128, HTB = HALF * BK * 2  , STAGE_BYTES = 8 * HTB, NXCD = 8, WGM = 8;

__host__ __device__ __forceinline__ int lds_byte(int r, int c) { const int st = (r >> 4) * 2 + (c >> 5), rr = r & 15, cc = c & 31, ob = rr * 64 + cc * 2; return st * 1024 + (ob ^ (((ob >> 9) & 1) << 5)); }
__host__ __device__ __forceinline__ void stage_rc(int b, int& R, int& C) { const int st = b / 1024, sb = b % 1024, swz = sb ^ (((sb >> 9) & 1) << 5); R = (st >> 1) * 16 + swz / 64; C = (st & 1) * 32 + (swz % 64) / 2; }
__host__ __device__ __forceinline__ int perm32(int rho) { const int n = rho >> 4, i = rho & 15; return 8 * (i >> 2) + 4 * n + (i & 3); }

struct Unit { int pm, pn; };
struct Gemm { const bf16_t* A; const bf16_t* Bt; int M, N, K; };

struct StaticOrder {
    int nM, nN, nwg, G, c;
    __host__ __device__ void init(int M, int N, int G_, int c_) { nM = M / BM; nN = N / BM; nwg = nM * nN; G = G_; c = c_; }
    __host__ __device__ bool next(int i, Unit& u) const {
        const long L = (long)i * G + c; if (L >= nwg) return false;
        int wgid = (int)L; { const int q = nwg / NXCD, r = nwg % NXCD, xcd = wgid % NXCD, off = wgid / NXCD; wgid = (xcd < r ? xcd * (q + 1) : r * (q + 1) + (xcd - r) * q) + off; }
        const int nig = WGM * nN, gid = wgid / nig, fm = gid * WGM, gsz = (nM - fm) < WGM ? (nM - fm) : WGM;
        u.pm = fm + ((wgid % nig) % gsz); u.pn = (wgid % nig) / gsz; return true;
    }
    __device__ __forceinline__ void a_ready(const Unit&) const {}
    __device__ __forceinline__ void done(const Unit&) const {}
};
typedef float cvt_f32x2 __attribute__((ext_vector_type(2)));
typedef __bf16 cvt_bf16x2 __attribute__((ext_vector_type(2)));
__device__ __forceinline__ unsigned cvt_pk_bf16(float lo, float hi) { return __builtin_bit_cast(unsigned, __builtin_convertvector((cvt_f32x2){lo, hi}, cvt_bf16x2)); }
__device__ __forceinline__ float bflo(unsigned u) { return __uint_as_float(u << 16); }
__device__ __forceinline__ float bfhi(unsigned u) { return __uint_as_float(u & 0xffff0000u); }

struct EpiProj {
    static constexpr bool PERM = true, AFTER_DRAIN = false, HAS_MID = false;
    bf16_t* O; int ldc;
    __device__ __forceinline__ void mid(f32x4 (&)[2][2][4][2], const Unit&, int, int, int, int) const {}
    __device__ __forceinline__ void operator()(const f32x4 (&acc)[2][2][4][2], const Unit& u, int wr, int wc, int fr, int fq) const {
        const int row0 = u.pm * BM + wr * 64 + fr, col0 = u.pn * BM + wc * 32 + 8 * fq;
#pragma unroll
        for (int ai = 0; ai < 2; ++ai)
#pragma unroll
            for (int m = 0; m < 4; ++m) { bf16_t* rowp = O + (size_t)(row0 + ai * HALF + m * 16) * ldc + col0;
#pragma unroll
                for (int bj = 0; bj < 2; ++bj) { const f32x4 v0 = acc[ai][bj][m][0], v1 = acc[ai][bj][m][1];
                    u32x4 w; w.x = cvt_pk_bf16(v0[0], v0[1]); w.y = cvt_pk_bf16(v0[2], v0[3]); w.z = cvt_pk_bf16(v1[0], v1[1]); w.w = cvt_pk_bf16(v1[2], v1[3]);
                    *(u32x4*)(rowp + bj * HALF) = w; } }
    }
};

struct EpiGlu {
    static constexpr bool PERM = true, AFTER_DRAIN = false, HAS_MID = false;
    const bf16_t* Y; bf16_t* O; const float* bias; float* rss;
    __device__ __forceinline__ void mid(f32x4 (&)[2][2][4][2], const Unit&, int, int, int, int) const {}
    __device__ __forceinline__ void operator()(const f32x4 (&acc)[2][2][4][2], const Unit& u, int wr, int wc, int fr, int fq) const {
        const int row0 = u.pm * BM + wr * 64 + fr, col0 = u.pn * BM + wc * 32 + 8 * fq;
        f32x4 bv[2][2];
#pragma unroll
        for (int bj = 0; bj < 2; ++bj)
#pragma unroll
            for (int n = 0; n < 2; ++n) bv[bj][n] = *(const f32x4*)(bias + col0 + bj * HALF + 4 * n);
        u32x4 yq[2][2];
#pragma unroll
        for (int bj = 0; bj < 2; ++bj) yq[0][bj] = *(const u32x4*)(Y + (size_t)row0 * 1024 + col0 + bj * HALF);
#pragma unroll
        for (int idx = 0; idx < 8; ++idx) { const int ai = idx >> 2, m = idx & 3, row = row0 + ai * HALF + m * 16; float ss = 0.f;
            if (idx < 7) { const int nrow = row0 + ((idx + 1) >> 2) * HALF + ((idx + 1) & 3) * 16;
#pragma unroll
                for (int bj = 0; bj < 2; ++bj) yq[(idx + 1) & 1][bj] = *(const u32x4*)(Y + (size_t)nrow * 1024 + col0 + bj * HALF); }
#pragma unroll
            for (int bj = 0; bj < 2; ++bj) {
                const u32x4 yv = yq[idx & 1][bj];
                const f32x4 g0 = acc[ai][bj][m][0] + bv[bj][0], g1 = acc[ai][bj][m][1] + bv[bj][1];
                float y[8] = {bflo(yv.x), bfhi(yv.x), bflo(yv.y), bfhi(yv.y), bflo(yv.z), bfhi(yv.z), bflo(yv.w), bfhi(yv.w)};
                float o[8];
#pragma unroll
                for (int e = 0; e < 4; ++e) { o[e] = y[e] * __builtin_amdgcn_rcpf(1.f + __expf(-g0[e])); o[4 + e] = y[4 + e] * __builtin_amdgcn_rcpf(1.f + __expf(-g1[e])); }
#pragma unroll
                for (int e = 0; e < 8; ++e) ss += o[e] * o[e];
                u32x4 w; w.x = cvt_pk_bf16(o[0], o[1]); w.y = cvt_pk_bf16(o[2], o[3]); w.z = cvt_pk_bf16(o[4], o[5]); w.w = cvt_pk_bf16(o[6], o[7]);
                *(u32x4*)(O + (size_t)row * 2048 + col0 + bj * HALF) = w; }
            ss += __shfl_xor(ss, 16); ss += __shfl_xor(ss, 32);
            if (fq == 0) unsafeAtomicAdd(rss + row, ss); }
    }
};

struct EpiWout {
    static constexpr bool PERM = true, AFTER_DRAIN = false, HAS_MID = true;
    const float* X; float* OUT; bf16_t* XB; float* rss_x; const PG8_LAS float* tab;
    __device__ __forceinline__ void mid(f32x4 (&acc)[2][2][4][2], const Unit& u, int wr, int wc, int fr, int fq) const {
        const PG8_LAS float* tp = tab + wr * 64 + fr;
#pragma unroll
        for (int ai = 0; ai < 2; ++ai)
#pragma unroll
            for (int m = 0; m < 4; ++m) { const float ratio = tp[ai * HALF + m * 16];
#pragma unroll
                for (int bj = 0; bj < 2; ++bj)
#pragma unroll
                    for (int n = 0; n < 2; ++n) acc[ai][bj][m][n] *= ratio; }
    }
    __device__ __forceinline__ void operator()(const f32x4 (&acc)[2][2][4][2], const Unit& u, int wr, int wc, int fr, int fq) const {
        const int row0 = u.pm * BM + wr * 64 + fr, col0 = u.pn * BM + wc * 32 + 8 * fq;
        const PG8_LAS float* tp = tab + 256 + wr * 64 + fr;
        f32x4 xq[2][2][2];
#pragma unroll
        for (int bj = 0; bj < 2; ++bj) { const size_t o = (size_t)row0 * 2048 + col0 + bj * HALF; xq[0][bj][0] = *(const f32x4*)(X + o); xq[0][bj][1] = *(const f32x4*)(X + o + 4); }
#pragma unroll
        for (int idx = 0; idx < 8; ++idx) { const int ai = idx >> 2, m = idx & 3, row = row0 + ai * HALF + m * 16; float ss = 0.f;
            if (idx < 7) { const int nrow = row0 + ((idx + 1) >> 2) * HALF + ((idx + 1) & 3) * 16;
#pragma unroll
                for (int bj = 0; bj < 2; ++bj) { const size_t o = (size_t)nrow * 2048 + col0 + bj * HALF; xq[(idx + 1) & 1][bj][0] = *(const f32x4*)(X + o); xq[(idx + 1) & 1][bj][1] = *(const f32x4*)(X + o + 4); } }
            const float rs = tp[ai * HALF + m * 16];
#pragma unroll
            for (int bj = 0; bj < 2; ++bj) { const size_t o = (size_t)row * 2048 + col0 + bj * HALF;
                const f32x4 v0 = xq[idx & 1][bj][0] + rs * acc[ai][bj][m][0], v1 = xq[idx & 1][bj][1] + rs * acc[ai][bj][m][1];
                u32x4 w; w.x = cvt_pk_bf16(v0[0], v0[1]); w.y = cvt_pk_bf16(v0[2], v0[3]); w.z = cvt_pk_bf16(v1[0], v1[1]); w.w = cvt_pk_bf16(v1[2], v1[3]);
                *(u32x4*)(XB + o) = w;
#pragma unroll
                for (int e = 0; e < 4; ++e) ss += v0[e] * v0[e] + v1[e] * v1[e]; }
            ss += __shfl_xor(ss, 16); ss += __shfl_xor(ss, 32);
            if (fq == 0) unsafeAtomicAdd(rss_x + row, ss); }
    }
};

struct EpiScores {
    static constexpr bool PERM = false, AFTER_DRAIN = false, HAS_MID = false;
    float* C; const float* rss_x;
    __device__ __forceinline__ void mid(f32x4 (&)[2][2][4][2], const Unit&, int, int, int, int) const {}
    __device__ __forceinline__ void operator()(const f32x4 (&acc)[2][2][4][2], const Unit& u, int wr, int wc, int fr, int fq) const {
        const int row0 = u.pm * BM + wr * 64 + fr, col0 = u.pn * BM + wc * 32 + 4 * fq;
        float r2v[8];
#pragma unroll
        for (int idx = 0; idx < 8; ++idx) r2v[idx] = rss_x[row0 + (idx >> 2) * HALF + (idx & 3) * 16];
#pragma unroll
        for (int ai = 0; ai < 2; ++ai)
#pragma unroll
            for (int m = 0; m < 4; ++m) { const int row = row0 + ai * HALF + m * 16;
                const float r2 = __builtin_amdgcn_rsqf(r2v[ai * 4 + m] * (1.f / 2048.f) + 1e-6f);
                float* rowp = C + (size_t)row * 2048 + col0;
#pragma unroll
                for (int bj = 0; bj < 2; ++bj)
#pragma unroll
                    for (int n = 0; n < 2; ++n) *(f32x4*)(rowp + bj * HALF + n * 16) = acc[ai][bj][m][n] * r2; }
    }
};

template <class Epi, class Sched, bool STAMP = false>
__device__ __forceinline__ void gemm_phase(PG8_LAS unsigned char* lds, const Gemm g, const Sched& S, const Epi& E, unsigned long long* stamps) {
    const int tid = threadIdx.x, wid = __builtin_amdgcn_readfirstlane(tid >> 6), lane = tid & 63, wr = wid >> 2, wc = wid & 3, fr = lane & 15, fq = lane >> 4;
    const int K = g.K, nt = K / BK;
    int ts_lo = 0, ts_hi = 0, nts = 0; const unsigned long long rt_entry = STAMP ? (unsigned long long)wall_clock64() : 0ull;
#define PG8_STAMP() do { if (STAMP && wid == 0 && nts < 64) { const unsigned long long _c = (unsigned long long)clock64(); \
        ts_lo = (lane == nts) ? (int)(unsigned)_c : ts_lo; ts_hi = (lane == nts) ? (int)(unsigned)(_c >> 32) : ts_hi; ++nts; } } while (0)
    PG8_STAMP();
    unsigned voffA[2], voffB[2];
#pragma unroll
    for (int i = 0; i < 2; ++i) { int R, C; stage_rc(tid * 16 + i * 8192, R, C); const int Rb = Epi::PERM ? ((R & ~31) + perm32(R & 31)) : R;
        voffA[i] = (unsigned)(R * K + C) * 2u; voffB[i] = (unsigned)(Rb * K + C) * 2u; }
    const size_t kstep = (size_t)(BK * 2);
    const size_t hstep = (size_t)HALF * K * 2;
    const size_t tstep = 2 * hstep;
    const unsigned ldsw = (unsigned)wid * 1024u;
    const int aoff = lds_byte(wr * 64 + fr, fq * 8), boff = lds_byte(wc * 32 + fr, fq * 8);
#define PG8_SA(b, h) (((b) * 2 + (h)) * HTB)
#define PG8_SB(b, h) ((4 + (b) * 2 + (h)) * HTB)
#define PG8_STAGE(bufoff, gbase, voff) do { _Pragma("unroll") for (int _i = 0; _i < 2; ++_i) \
        __builtin_amdgcn_global_load_lds((const unsigned*)((const char*)(gbase) + (voff)[_i]), (PG8_LAS unsigned*)(lds + (bufoff) + ldsw + _i * 8192), 16, 0, 0); } while (0)
#define PG8_LDA(dst, b, h) do { _Pragma("unroll") for (int m = 0; m < 4; ++m) _Pragma("unroll") for (int k = 0; k < 2; ++k) dst[m][k] = *(const PG8_LAS bf16x8*)(lds + PG8_SA(b, h) + aoff + m * 2048 + k * 1024); } while (0)
#define PG8_LDB(dst, b, h) do { _Pragma("unroll") for (int n = 0; n < 2; ++n) _Pragma("unroll") for (int k = 0; k < 2; ++k) dst[n][k] = *(const PG8_LAS bf16x8*)(lds + PG8_SB(b, h) + boff + n * 2048 + k * 1024); } while (0)
#define PG8_MMA(ai, bj, At, Bt) do { __builtin_amdgcn_s_setprio(1); _Pragma("unroll") for (int m = 0; m < 4; ++m) _Pragma("unroll") for (int n = 0; n < 2; ++n) _Pragma("unroll") for (int k = 0; k < 2; ++k) \
        acc[ai][bj][m][n] = __builtin_amdgcn_mfma_f32_16x16x32_bf16(Bt[n][k], At[m][k], acc[ai][bj][m][n], 0, 0, 0); __builtin_amdgcn_s_setprio(0); } while (0)
#define PG8_WAIT_V(n) asm volatile("s_waitcnt vmcnt(" #n ")" ::: "memory")
#define PG8_WAIT_L(n) asm volatile("s_waitcnt lgkmcnt(" #n ")" ::: "memory")
#define PG8_BAR __builtin_amdgcn_s_barrier()
#define PG8_SCHED __builtin_amdgcn_sched_barrier(0)
    Unit cur, nxt; int ui = 0;
    if (!S.next(0, cur)) return;
    f32x4 acc[2][2][4][2];
#pragma unroll
    for (int a = 0; a < 2; ++a)
#pragma unroll
        for (int b = 0; b < 2; ++b)
#pragma unroll
            for (int m = 0; m < 4; ++m)
#pragma unroll
                for (int n = 0; n < 2; ++n) acc[a][b][m][n] = (f32x4){0.f, 0.f, 0.f, 0.f};
    bf16x8 At[4][2], B0[2][2], B1[2][2];
    const char* cA = (const char*)g.A + (size_t)cur.pm * tstep; const char* cB = (const char*)g.Bt + (size_t)cur.pn * tstep;
    S.a_ready(cur);
    PG8_STAGE(PG8_SB(0, 0), cB, voffB); PG8_STAGE(PG8_SA(0, 0), cA, voffA); PG8_STAGE(PG8_SB(0, 1), cB + hstep, voffB); PG8_STAGE(PG8_SA(0, 1), cA + hstep, voffA);
    if (wr == 1) PG8_BAR;
    PG8_WAIT_V(4); PG8_BAR;
    PG8_STAGE(PG8_SB(1, 0), cB + kstep, voffB); PG8_STAGE(PG8_SA(1, 0), cA + kstep, voffA); PG8_STAGE(PG8_SB(1, 1), cB + hstep + kstep, voffB);
    PG8_WAIT_V(6); PG8_BAR;
    PG8_STAMP();
    for (;;) {
        const bool has_next = S.next(ui + 1, nxt);
        const char* nA = has_next ? (const char*)g.A + (size_t)nxt.pm * tstep : cA; const char* nB = has_next ? (const char*)g.Bt + (size_t)nxt.pn * tstep : cB;
        for (int t = 0; t < nt; t += 2) {
            const bool last = (t == nt - 2);
            const char* a1 = cA + (size_t)(t + 1) * kstep;
            const char* a2 = last ? nA : cA + (size_t)(t + 2) * kstep; const char* b2 = last ? nB : cB + (size_t)(t + 2) * kstep;
            const char* a3 = a2 + kstep; const char* b3 = b2 + kstep;
            if (last && has_next) S.a_ready(nxt);
            if constexpr (Epi::HAS_MID) { if (t == (nt >> 1)) { E.mid(acc, cur, wr, wc, fr, fq); asm volatile("s_waitcnt lgkmcnt(0)" ::: "memory"); } }
            PG8_LDB(B0, 0, 0); PG8_SCHED; PG8_LDA(At, 0, 0); PG8_STAGE(PG8_SA(1, 1), a1 + hstep, voffA);
            PG8_WAIT_L(8); PG8_BAR; PG8_WAIT_L(0); PG8_MMA(0, 0, At, B0); PG8_BAR; PG8_SCHED;
            PG8_LDB(B1, 0, 1); PG8_STAGE(PG8_SB(0, 0), b2, voffB);
            PG8_BAR; PG8_WAIT_L(0); PG8_MMA(0, 1, At, B1); PG8_BAR;
            PG8_LDA(At, 0, 1); PG8_STAGE(PG8_SA(0, 0), a2, voffA);
            PG8_BAR; PG8_WAIT_L(0); PG8_MMA(1, 0, At, B0); PG8_BAR; PG8_SCHED;
            PG8_STAGE(PG8_SB(0, 1), b2 + hstep, voffB);
            PG8_WAIT_V(6); PG8_BAR; PG8_MMA(1, 1, At, B1); PG8_BAR;
            PG8_LDB(B0, 1, 0); PG8_SCHED; PG8_LDA(At, 1, 0); PG8_STAGE(PG8_SA(0, 1), a2 + hstep, voffA);
            PG8_WAIT_L(8); PG8_BAR; PG8_WAIT_L(0); PG8_MMA(0, 0, At, B0); PG8_BAR; PG8_SCHED;
            PG8_LDB(B1, 1, 1); PG8_STAGE(PG8_SB(1, 0), b3, voffB);
            PG8_BAR; PG8_WAIT_L(0); PG8_MMA(0, 1, At, B1); PG8_BAR;
            PG8_LDA(At, 1, 1); PG8_STAGE(PG8_SA(1, 0), a3, voffA);
            PG8_BAR; PG8_WAIT_L(0); PG8_MMA(1, 0, At, B0); PG8_BAR; PG8_SCHED;
            PG8_STAGE(PG8_SB(1, 1), b3 + hstep, voffB);
            PG8_WAIT_V(6); PG8_BAR; PG8_MMA(1, 1, At, B1); PG8_BAR;
        }
        PG8_STAMP();
        if constexpr (!Epi::AFTER_DRAIN) { E(acc, cur, wr, wc, fr, fq); S.done(cur); }
        PG8_STAMP();
        if (!has_next) break;
#pragma unroll
        for (int a = 0; a < 2; ++a)
#pragma unroll
            for (int b = 0; b < 2; ++b)
#pragma unroll
                for (int m = 0; m < 4; ++m)
#pragma unroll
                    for (int n = 0; n < 2; ++n) acc[a][b][m][n] = (f32x4){0.f, 0.f, 0.f, 0.f};
        cur = nxt; cA = nA; cB = nB; ++ui;
    }
    PG8_WAIT_V(0);
    if (wr == 0) PG8_BAR;
    PG8_BAR;
    if constexpr (Epi::AFTER_DRAIN) { E.fused(acc, cur, wr, wc, fr, fq, lds, wid, lane); S.done(cur); }
    PG8_STAMP();
    if (STAMP && wid == 0) { stamps[lane] = lane < nts ? (((unsigned long long)(unsigned)ts_hi << 32) | (unsigned)ts_lo) : 0ull;
        if (lane == 62) stamps[62] = rt_entry; if (lane == 63) stamps[63] = (unsigned long long)wall_clock64(); }
#undef PG8_STAMP
#undef PG8_SA
#undef PG8_SB
#undef PG8_STAGE
#undef PG8_LDA
#undef PG8_LDB
#undef PG8_MMA
#undef PG8_WAIT_V
#undef PG8_WAIT_L
#undef PG8_BAR
#undef PG8_SCHED
}
}

typedef short bf16x8 __attribute__((ext_vector_type(8)));
typedef float f32x4 __attribute__((ext_vector_type(4)));
typedef unsigned u32x4 __attribute__((ext_vector_type(4)));
using pg8::cvt_pk_bf16; using pg8::bflo; using pg8::bfhi;

#define LDS_WAIT() asm volatile("s_waitcnt lgkmcnt(0)" ::: "memory")
#define CBAR() asm volatile("" ::: "memory")
#define MFMA16(a, b, c) __builtin_amdgcn_mfma_f32_16x16x32_bf16((a), (b), (c), 0, 0, 0)

struct Args { const float* in[25]; float* out; unsigned char* ws; int ph_lo, ph_hi; };

__device__ __forceinline__ float wave_sum(float v) {
#pragma unroll
    for (int o = 1; o < 64; o <<= 1) v += __shfl_xor(v, o);
    return v;
}
__device__ __forceinline__ float wave_max(float v) {
#pragma unroll
    for (int o = 1; o < 64; o <<= 1) v = fmaxf(v, __shfl_xor(v, o));
    return v;
}
__device__ __forceinline__ float gelu_erf(float x) { return 0.5f * x * (1.0f + erff(x * 0.70710678118654752f)); }
__device__ __forceinline__ float gelu_as(float v) {
    const float av = fabsf(v), t = __builtin_amdgcn_rcpf(fmaf(av, 0.2316418882f, 1.0f));
    float q = fmaf(t, 0.5307027145f, -0.7265760135f); q = fmaf(q, t, 0.7107068705f); q = fmaf(q, t, -0.142248368f); q = fmaf(q, t, 0.127414796f); q *= t;
    const float e = __builtin_amdgcn_exp2f(v * v * -0.72134752044f), m = v * (q * e);
    return v < 0.f ? m : v - m;
}
__device__ __forceinline__ bf16x8 as_bf16x8(u32x4 v) { return __builtin_bit_cast(bf16x8, v); }

__device__ __forceinline__ void p0_transpose_item(const float* W, int K, int N, bf16_t* WT, const float* sc_a, const float* sc_b, LAS float* scr, int item, int lane) {
    const int nblk = N / 32, kb = item / nblk, nb = item % nblk, k0 = 64 * kb, n0 = 32 * nb;
#pragma unroll 8
    for (int i = 0; i < 32; ++i) { const int kk = 2 * i + (lane >> 5); const int k = k0 + kk;
        const float s = sc_a ? (k < 1024 ? sc_a[k] : sc_b[k - 1024]) : 1.f;
        scr[kk * 33 + (lane & 31)] = W[(size_t)k * N + n0 + (lane & 31)] * s; }
    LDS_WAIT();
    const int c = lane & 7;
#pragma unroll
    for (int j = 0; j < 4; ++j) { const int n = (lane >> 3) + 8 * j; const LAS float* s = scr + (8 * c) * 33 + n;
        u32x4 o; o.x = cvt_pk_bf16(s[0 * 33], s[1 * 33]); o.y = cvt_pk_bf16(s[2 * 33], s[3 * 33]); o.z = cvt_pk_bf16(s[4 * 33], s[5 * 33]); o.w = cvt_pk_bf16(s[6 * 33], s[7 * 33]);
        *(u32x4*)(WT + (size_t)(n0 + n) * K + k0 + 8 * c) = o; }
    LDS_WAIT();
}
template <int MODE> __device__ __forceinline__ void p0_row(const float* xrow, const float* g, bf16_t* orow, int lane) {
    const f32x4* xr = (const f32x4*)xrow + lane; const f32x4* gr = (const f32x4*)g + lane;
    f32x4 v[8]; float s = 0.f;
#pragma unroll
    for (int j = 0; j < 8; ++j) { v[j] = xr[64 * j]; s += (v[j].x * v[j].x + v[j].y * v[j].y) + (v[j].z * v[j].z + v[j].w * v[j].w); }
    float r = 1.f;
    if (MODE == 0) r = 1.0f / sqrtf(wave_sum(s) * (1.f / 2048.f) + EPS);
    u32x2* o8 = (u32x2*)orow + lane;
#pragma unroll
    for (int j = 0; j < 8; ++j) { f32x4 w = v[j] * r; if (MODE != 2) w = w * gr[64 * j];
        u32x2 o; o.x = cvt_pk_bf16(w.x, w.y); o.y = cvt_pk_bf16(w.z, w.w); o8[64 * j] = o; }
}
template <bool SCALE_G, bool OFFS> __device__ __forceinline__ void p0_row_q8(const float* xrow, const float* g, unsigned char* orow, float* sc, int lane) {
    const f32x4* xr = (const f32x4*)xrow + lane; const f32x4* gr = (const f32x4*)g + lane;
    f32x4 v[8]; float m = 0.f;
#pragma unroll
    for (int j = 0; j < 8; ++j) { v[j] = xr[64 * j]; if (SCALE_G) v[j] = v[j] * gr[64 * j];
        m = fmaxf(fmaxf(m, fmaxf(fabsf(v[j].x), fabsf(v[j].y))), fmaxf(fabsf(v[j].z), fabsf(v[j].w))); }
    m = fmaxf(wave_max(m), 1e-30f);
    const float inv = 127.f / m;
    if (lane == 0) *sc = m * (1.f / 127.f);
    unsigned* o4 = (unsigned*)orow + lane;
#pragma unroll
    for (int j = 0; j < 8; ++j) { const int a = (int)rintf(v[j].x * inv) + (OFFS ? 128 : 0), b = (int)rintf(v[j].y * inv) + (OFFS ? 128 : 0), c = (int)rintf(v[j].z * inv) + (OFFS ? 128 : 0), d = (int)rintf(v[j].w * inv) + (OFFS ? 128 : 0);
        o4[64 * j] = (unsigned)(a & 255) | ((unsigned)(b & 255) << 8) | ((unsigned)(c & 255) << 16) | ((unsigned)(d & 255) << 24); }
}
template <int KIND> __device__ __forceinline__ void p0_rows(const float* src, const float* g, void* dst, float* sc, int first, int stride, int nrows, int lane) {
    const f32x4* gr = (const f32x4*)g + lane;
    f32x4 cur[8], nxt[8], nx2[8];
    int r = first;
    if (r >= nrows) return;
    { const f32x4* xr = (const f32x4*)(src + (size_t)r * 2048) + lane;
#pragma unroll
        for (int j = 0; j < 8; ++j) cur[j] = xr[64 * j]; }
    if (r + stride < nrows) { const f32x4* xr = (const f32x4*)(src + (size_t)(r + stride) * 2048) + lane;
#pragma unroll
        for (int j = 0; j < 8; ++j) nxt[j] = xr[64 * j]; }
    for (; r < nrows; r += stride) {
        const int rn = r + 2 * stride;
        if (rn < nrows) { const f32x4* xr = (const f32x4*)(src + (size_t)rn * 2048) + lane;
#pragma unroll
            for (int j = 0; j < 8; ++j) nx2[j] = xr[64 * j]; }
        if (KIND == 0) {
            float s = 0.f;
#pragma unroll
            for (int j = 0; j < 8; ++j) s += (cur[j].x * cur[j].x + cur[j].y * cur[j].y) + (cur[j].z * cur[j].z + cur[j].w * cur[j].w);
            const float rr = 1.0f / sqrtf(wave_sum(s) * (1.f / 2048.f) + EPS);
            u32x2* o8 = (u32x2*)((bf16_t*)dst + (size_t)r * 2048) + lane;
#pragma unroll
            for (int j = 0; j < 8; ++j) { const f32x4 w = cur[j] * rr * gr[64 * j]; u32x2 o; o.x = cvt_pk_bf16(w.x, w.y); o.y = cvt_pk_bf16(w.z, w.w); o8[64 * j] = o; }
        } else if (KIND >= 3) {
            float ssq = 0.f;
#pragma unroll
            for (int j = 0; j < 8; ++j) { if (KIND == 3) cur[j] = cur[j] * gr[64 * j]; ssq += (cur[j].x * cur[j].x + cur[j].y * cur[j].y) + (cur[j].z * cur[j].z + cur[j].w * cur[j].w); }
            const float rms = sqrtf(fmaxf(wave_sum(ssq) * (1.f / 2048.f), 1e-30f));
            const float sq = 0.1676f * rms, inv = 0.5f / sq;
            if (lane == 0) sc[r] = sq;
            unsigned* o4 = (unsigned*)((unsigned char*)dst + (size_t)r * 1024) + lane;
#pragma unroll
            for (int j = 0; j < 4; ++j) { unsigned w = 0u;
#pragma unroll
                for (int e = 0; e < 4; ++e) { const float lo = cur[j][e], hi = cur[j + 4][e];
                    int nl = (int)rintf(fmaf(lo, inv, 7.5f)), nh = (int)rintf(fmaf(hi, inv, 7.5f));
                    nl = nl < 0 ? 0 : (nl > 15 ? 15 : nl); nh = nh < 0 ? 0 : (nh > 15 ? 15 : nh);
                    w |= ((unsigned)nl << (8 * e)) | ((unsigned)nh << (8 * e + 4)); }
                o4[64 * j] = w; }
        } else {
            float m = 0.f;
#pragma unroll
            for (int j = 0; j < 8; ++j) { if (KIND == 1) cur[j] = cur[j] * gr[64 * j];
                m = fmaxf(fmaxf(m, fmaxf(fabsf(cur[j].x), fabsf(cur[j].y))), fmaxf(fabsf(cur[j].z), fabsf(cur[j].w))); }
            m = fmaxf(wave_max(m), 1e-30f);
            const float inv = 127.f / m; const int off = KIND == 2 ? 128 : 0;
            if (lane == 0) sc[r] = m * (1.f / 127.f);
            unsigned* o4 = (unsigned*)((unsigned char*)dst + (size_t)r * 2048) + lane;
#pragma unroll
            for (int j = 0; j < 8; ++j) { const int a = (int)rintf(cur[j].x * inv) + off, b = (int)rintf(cur[j].y * inv) + off, c = (int)rintf(cur[j].z * inv) + off, d = (int)rintf(cur[j].w * inv) + off;
                o4[64 * j] = (unsigned)(a & 255) | ((unsigned)(b & 255) << 8) | ((unsigned)(c & 255) << 16) | ((unsigned)(d & 255) << 24); }
        }
#pragma unroll
        for (int j = 0; j < 8; ++j) { cur[j] = nxt[j]; nxt[j] = nx2[j]; }
    }
}
__device__ __forceinline__ void p0_wp_item(const float* wq, const float* keys1, const float* keys2, const float* gffn, bf16_t* WPT, int item, int lane) {
    const int hj = item >> 7, ib = item & 127, h = hj >> 1, j = hj & 1, i0 = 16 * ib, col0 = h * 256 + j * 128;
    const int lr = lane & 15, g = lane >> 4;
    const float* keys = (j ? keys2 : keys1) + (size_t)h * 128 * 128;
    const float gi = gffn[i0 + lr];
    bf16x8 af[4];
#pragma unroll
    for (int s = 0; s < 4; ++s) { const float* p = wq + (size_t)(i0 + lr) * 2048 + col0 + 32 * s + 8 * g;
        const f32x4 a = *(const f32x4*)p * gi, b = *(const f32x4*)(p + 4) * gi;
        u32x4 w; w.x = cvt_pk_bf16(a.x, a.y); w.y = cvt_pk_bf16(a.z, a.w); w.z = cvt_pk_bf16(b.x, b.y); w.w = cvt_pk_bf16(b.z, b.w); af[s] = as_bf16x8(w); }
    for (int kt = 0; kt < 8; ++kt) {
        f32x4 d = {0.f, 0.f, 0.f, 0.f};
#pragma unroll
        for (int s = 0; s < 4; ++s) { const float* p = keys + (size_t)(16 * kt + lr) * 128 + 32 * s + 8 * g;
            const f32x4 a = *(const f32x4*)p, b = *(const f32x4*)(p + 4);
            u32x4 w; w.x = cvt_pk_bf16(a.x, a.y); w.y = cvt_pk_bf16(a.z, a.w); w.z = cvt_pk_bf16(b.x, b.y); w.w = cvt_pk_bf16(b.z, b.w);
            d = MFMA16(af[s], as_bf16x8(w), d); }
        u32x2 o; o.x = cvt_pk_bf16(d[0], d[1]); o.y = cvt_pk_bf16(d[2], d[3]);
        *(u32x2*)(WPT + (size_t)(hj * 128 + 16 * kt + lr) * 2048 + i0 + 4 * g) = o;
    }
}
__device__ __forceinline__ int t5_bucket(int n) {
    if (n < 16) return n;
    const int large = 16 + (int)(logf((float)n / 16.f) / 4.852030263919617f * 16.f);
    return large < 31 ? large : 31;
}
__device__ __forceinline__ void p0_ssm_item(const Args& A, unsigned char* sp, int g, int lane) {
    const float* lam_re = A.in[6]; const float* lam_im = A.in[7]; const float* log_dt = A.in[8];
    const float* b_re = A.in[9]; const float* b_im = A.in[10]; const float* c_re = A.in[11]; const float* c_im = A.in[12];
    const int n = lane;
    const float dt = expf(log_dt[g]);
    const float lr = lam_re[g * 64 + n], li = lam_im[g * 64 + n];
    const float mag = expf(lr * dt);
    const float a_re = mag * cosf(li * dt), a_im = mag * sinf(li * dt);
    const float den = lr * lr + li * li;
    const float f_re = ((a_re - 1.f) * lr + a_im * li) / den, f_im = (a_im * lr - (a_re - 1.f) * li) / den;
    ((f32x2*)(sp + SSMP_ABAR))[g * 64 + n] = (f32x2){a_re, a_im};
    float pr = a_re, pi = a_im;
#pragma unroll
    for (int i = 0; i < 8; ++i) { const float nr = pr * pr - pi * pi, ni = 2.f * pr * pi; pr = nr; pi = ni; }
    ((f32x2*)(sp + SSMP_A256))[g * 64 + n] = (f32x2){pr, pi};
    float bbr[16], bbi[16];
#pragma unroll
    for (int q = 0; q < 4; ++q) { const f32x4 br = *(const f32x4*)(b_re + (size_t)(g * 64 + n) * 16 + 4 * q), bi = *(const f32x4*)(b_im + (size_t)(g * 64 + n) * 16 + 4 * q);
#pragma unroll
        for (int e = 0; e < 4; ++e) { bbr[4 * q + e] = f_re * br[e] - f_im * bi[e]; bbi[4 * q + e] = f_re * bi[e] + f_im * br[e]; } }
    bf16_t* bf = (bf16_t*)(sp + SSMP_BFRAG);
    const int jre = n >> 4, n16 = n & 15;
#pragma unroll
    for (int kg = 0; kg < 4; ++kg) {
        u32x4 wr = {0u, 0u, 0u, 0u}, wi = {0u, 0u, 0u, 0u};
        if (kg < 2) { const int c0 = (kg & 1) * 8;
            wr.x = cvt_pk_bf16(bbr[c0 + 0], bbr[c0 + 1]); wr.y = cvt_pk_bf16(bbr[c0 + 2], bbr[c0 + 3]); wr.z = cvt_pk_bf16(bbr[c0 + 4], bbr[c0 + 5]); wr.w = cvt_pk_bf16(bbr[c0 + 6], bbr[c0 + 7]);
            wi.x = cvt_pk_bf16(bbi[c0 + 0], bbi[c0 + 1]); wi.y = cvt_pk_bf16(bbi[c0 + 2], bbi[c0 + 3]); wi.z = cvt_pk_bf16(bbi[c0 + 4], bbi[c0 + 5]); wi.w = cvt_pk_bf16(bbi[c0 + 6], bbi[c0 + 7]); }
        *(u32x4*)(bf + ((size_t)(g * 8 + jre) * 64 + kg * 16 + n16) * 8) = wr;
        *(u32x4*)(bf + ((size_t)(g * 8 + 4 + jre) * 64 + kg * 16 + n16) * 8) = wi;
    }
    bf16_t* cf = (bf16_t*)(sp + SSMP_CFRAG);
    const int ch = lane & 15, kg = lane >> 4;
#pragma unroll
    for (int s = 0; s < 4; ++s) { const int k0 = 32 * s + 8 * kg;
        const float* src = (k0 < 64) ? (c_re + (size_t)(g * 16 + ch) * 64 + k0) : (c_im + (size_t)(g * 16 + ch) * 64 + (k0 - 64));
        const float sg = (k0 < 64) ? 1.f : -1.f;
        const f32x4 a = *(const f32x4*)src * sg, b = *(const f32x4*)(src + 4) * sg;
        u32x4 w; w.x = cvt_pk_bf16(a.x, a.y); w.y = cvt_pk_bf16(a.z, a.w); w.z = cvt_pk_bf16(b.x, b.y); w.w = cvt_pk_bf16(b.z, b.w);
        *(u32x4*)(cf + ((size_t)(g * 4 + s) * 64 + lane) * 8) = w; }
}
__device__ __forceinline__ void p0_btab_item(const Args& A, float* btab, int item, int lane) {
    const float* gq = A.in[3]; const float* gk = A.in[4]; const float* rel_bias = A.in[5];
    const int h = item / 3, br = item % 3, d = br == 0 ? 1 : (br == 1 ? 4 : 16);
    const float G = wave_max(fabsf(gq[lane] * gk[lane]));
    const float mb = wave_max(lane < 32 ? rel_bias[lane * 16 + h] : -1e30f);
    const float smax = 8.4f * G + mb;
    for (int idx = lane; idx < 192; idx += 64) { const int rel = idx - 31;
        float v = -1e30f;
        if (rel >= 0 && rel <= 128) v = LOG2E * (rel_bias[t5_bucket(rel * d) * 16 + h] - smax);
        btab[(h * 3 + br) * 192 + idx] = v; }
}

__device__ __forceinline__ void p0_prologue(const Args& A, LAS unsigned char* lds, int wave, int lane) {
    unsigned char* ws = A.ws;
    LAS float* scr = (LAS float*)(lds + wave * 16384);
    const int gw = blockIdx.x * 8 + wave, NGW = gridDim.x * 8;
    constexpr int I_WIN = (2048 / 64) * (4096 / 32), I_GLU = (1024 / 64) * (1024 / 32), I_WOUT = (2048 / 64) * (2048 / 32), I_WP = 2048;
    constexpr int I_SSM = 64, I_BT = 48;
    constexpr int NITEMS = I_WIN + I_GLU + I_WOUT + I_WP + I_SSM + I_BT;
    for (int it = gw; it < NITEMS; it += NGW) {
        int r = it;
        if (r < I_SSM) { p0_ssm_item(A, ws + WS_SSMP, r, lane); continue; } r -= I_SSM;
        if (r < I_BT) { p0_btab_item(A, (float*)(ws + WS_BTAB), r, lane); continue; } r -= I_BT;
        if (r < I_WP) { p0_wp_item(A.in[20], A.in[21], A.in[22], A.in[19], (bf16_t*)(ws + WS_WPT), r, lane); continue; } r -= I_WP;
        if (r < I_WIN) { p0_transpose_item(A.in[2], 2048, 4096, (bf16_t*)(ws + WS_WINT), nullptr, nullptr, scr, r, lane); continue; } r -= I_WIN;
        if (r < I_GLU) { p0_transpose_item(A.in[14], 1024, 1024, (bf16_t*)(ws + WS_GLUT), nullptr, nullptr, scr, r, lane); continue; } r -= I_GLU;
        p0_transpose_item(A.in[18], 2048, 2048, (bf16_t*)(ws + WS_WOUTT), A.in[16], A.in[17], scr, r, lane);
    }
    p0_rows<0>(A.in[0], A.in[1], ws + WS_HB, nullptr, gw, NGW, 8192, lane);
    p0_rows<3>(A.in[23], A.in[19], ws + WS_UB, (float*)(ws + WS_SU), gw, NGW, 16384, lane);
    p0_rows<4>(A.in[24], A.in[19], ws + WS_VB, (float*)(ws + WS_SV), gw, NGW, 16384, lane);
}

constexpr int SSM_WL = 8192 + 16 * 272 + 512;
__device__ __forceinline__ void ssm_unit(const Args& A, LAS unsigned char* lds, int b, int g, int wave, int lane) {
    unsigned char* ws = A.ws; unsigned char* sp = ws + WS_SSMP;
    const bf16_t* proj = (const bf16_t*)(ws + WS_PROJ); bf16_t* yb = (bf16_t*)(ws + WS_YB);
    LAS unsigned char* wl = lds + wave * SSM_WL;
    LAS f32x2* BU = (LAS f32x2*)wl; LAS unsigned char* XB = wl + 8192; LAS unsigned char* UL = wl + 8192 + 16 * 272;
    LAS f32x2* carry = (LAS f32x2*)(lds + 8 * SSM_WL);
    const int lr = lane & 15, q = lane >> 4;
    bf16x8 bfr[8], cfr[4];
#pragma unroll
    for (int j = 0; j < 8; ++j) bfr[j] = as_bf16x8(*(const u32x4*)((const bf16_t*)(sp + SSMP_BFRAG) + ((size_t)(g * 8 + j) * 64 + lane) * 8));
#pragma unroll
    for (int s = 0; s < 4; ++s) cfr[s] = as_bf16x8(*(const u32x4*)((const bf16_t*)(sp + SSMP_CFRAG) + ((size_t)(g * 4 + s) * 64 + lane) * 8));
    const f32x2 ab = ((const f32x2*)(sp + SSMP_ABAR))[g * 64 + lane], a256 = ((const f32x2*)(sp + SSMP_A256))[g * 64 + lane];
    const float a_re = ab.x, a_im = ab.y;
    const float dsk = A.in[13][g * 16 + lr];
    const bf16_t* up = proj + (size_t)(b * SEQ + wave * 256) * DPROJ + 3072 + g * 16;
    float xr = 0.f, xi = 0.f;
    for (int pass = 0; pass < 2; ++pass) {
        u32x4 unext = {0u, 0u, 0u, 0u};
        if (q < 2) unext = *(const u32x4*)(up + (size_t)lr * DPROJ + 8 * q);
        for (int blk = 0; blk < 16; ++blk) {
            const u32x4 uraw = unext;
            if (q < 2 && blk < 15) unext = *(const u32x4*)(up + (size_t)((blk + 1) * 16 + lr) * DPROJ + 8 * q);
            const bf16x8 ua = as_bf16x8(uraw);
            if (pass == 1 && q < 2) *(LAS u32x4*)(UL + lr * 32 + q * 16) = uraw;
            f32x4 dd[8];
#pragma unroll
            for (int j = 0; j < 8; ++j) dd[j] = MFMA16(ua, bfr[j], ((f32x4){0.f, 0.f, 0.f, 0.f}));
#pragma unroll
            for (int jj = 0; jj < 4; ++jj)
#pragma unroll
                for (int r = 0; r < 4; ++r) BU[(4 * q + r) * 64 + 16 * jj + lr] = (f32x2){dd[jj][r], dd[4 + jj][r]};
            CBAR();
            f32x2 bu[16];
#pragma unroll
            for (int t = 0; t < 16; ++t) bu[t] = BU[t * 64 + lane];
            if (pass == 0) {
#pragma unroll
                for (int t = 0; t < 16; ++t) { float nr = fmaf(a_re, xr, fmaf(-a_im, xi, bu[t].x)), ni = fmaf(a_re, xi, fmaf(a_im, xr, bu[t].y)); asm volatile("" : "+v"(nr)); asm volatile("" : "+v"(ni)); xr = nr; xi = ni; }
                asm volatile("" : "+v"(xr), "+v"(xi) :: "memory");
            } else {
#pragma unroll
                for (int t = 0; t < 16; ++t) { float nr = fmaf(a_re, xr, fmaf(-a_im, xi, bu[t].x)), ni = fmaf(a_re, xi, fmaf(a_im, xr, bu[t].y)); asm volatile("" : "+v"(nr)); asm volatile("" : "+v"(ni)); xr = nr; xi = ni;
                    const unsigned pk = cvt_pk_bf16(xr, xi);
                    *(LAS unsigned short*)(XB + t * 272 + lane * 2) = (unsigned short)(pk & 0xffffu);
                    *(LAS unsigned short*)(XB + t * 272 + 128 + lane * 2) = (unsigned short)(pk >> 16); }
                CBAR();
                f32x4 y = {0.f, 0.f, 0.f, 0.f};
#pragma unroll
                for (int s = 0; s < 4; ++s) { const bf16x8 xa = as_bf16x8(*(const LAS u32x4*)(XB + lr * 272 + (32 * s + 8 * q) * 2)); y = MFMA16(xa, cfr[s], y); }
#pragma unroll
                for (int r = 0; r < 4; ++r) { const int t = blk * 16 + 4 * q + r;
                    const float uv = __uint_as_float((unsigned)(*(const LAS unsigned short*)(UL + (4 * q + r) * 32 + lr * 2)) << 16);
                    const float yv = gelu_as(y[r] + dsk * uv);
                    yb[(size_t)(b * SEQ + wave * 256 + t) * 1024 + g * 16 + lr] = (bf16_t)(cvt_pk_bf16(yv, 0.f) & 0xffffu); }
                asm volatile("" : "+v"(xr), "+v"(xi) :: "memory");
            }
        }
        if (pass == 0) {
            carry[wave * 64 + lane] = (f32x2){xr, xi};
            __syncthreads();
            float sr = 0.f, si = 0.f;
            for (int w2 = 0; w2 < wave; ++w2) { const f32x2 e = carry[w2 * 64 + lane]; const float nr = a256.x * sr - a256.y * si + e.x, ni = a256.x * si + a256.y * sr + e.y; sr = nr; si = ni; }
            xr = sr; xi = si;
        }
    }
    __syncthreads();
}

__device__ __forceinline__ void prep2_item(const Args& A, LAS unsigned char* wl, int item, int lane) {
    unsigned char* ws = A.ws;
    const bf16_t* proj = (const bf16_t*)(ws + WS_PROJ);
    const int pb = item & 31, h = (item >> 5) & 15, b = item >> 9, P0 = pb * 64, bh = b * 16 + h;
    const int r8 = lane >> 3, c = lane & 7;
    const float* gq = A.in[3]; const float* gk = A.in[4];
    const int fs = c >> 2, fg = c & 3;
#pragma unroll 1
    for (int which = 0; which < 2; ++which) {
        const float* gv = which ? gk : gq; const float cs = which ? 1.f : (LOG2E * 0.125f);
        float gl[8];
#pragma unroll
        for (int e = 0; e < 8; ++e) gl[e] = gv[8 * c + e] * cs;
        bf16_t* F = (bf16_t*)(ws + (which ? WS_KF : WS_QF));
#pragma unroll 2
        for (int i = 0; i < 8; ++i) { const int row = 8 * i + r8, pos = P0 + row;
            const u32x4 raw = *(const u32x4*)(proj + (size_t)(b * SEQ + pos) * DPROJ + which * 1024 + h * 64 + 8 * c);
            float v[8] = {bflo(raw.x), bfhi(raw.x), bflo(raw.y), bfhi(raw.y), bflo(raw.z), bfhi(raw.z), bflo(raw.w), bfhi(raw.w)};
            float ss = 0.f;
#pragma unroll
            for (int e = 0; e < 8; ++e) ss += v[e] * v[e];
            ss += __shfl_xor(ss, 1); ss += __shfl_xor(ss, 2); ss += __shfl_xor(ss, 4);
            const float r = 1.0f / sqrtf(ss * (1.f / 64.f) + EPS);
            u32x4 w; w.x = cvt_pk_bf16(v[0] * r * gl[0], v[1] * r * gl[1]); w.y = cvt_pk_bf16(v[2] * r * gl[2], v[3] * r * gl[3]);
            w.z = cvt_pk_bf16(v[4] * r * gl[4], v[5] * r * gl[5]); w.w = cvt_pk_bf16(v[6] * r * gl[6], v[7] * r * gl[7]);
#pragma unroll
            for (int br = 0; br < 3; ++br) { const int sh = 2 * br, rr = pos & ((1 << sh) - 1), l = pos >> sh;
                *(u32x4*)(F + (size_t)br * 4 * 16 * SEQ * 64 + ((((size_t)(bh << sh) + rr) * (SEQ >> (sh + 4)) + (l >> 4)) * 2 + fs) * 512 + (fg * 16 + (l & 15)) * 8) = w; } }
    }
#pragma unroll
    for (int i = 0; i < 8; ++i) { const int row = 8 * i + r8;
        const u32x4 raw = *(const u32x4*)(proj + (size_t)(b * SEQ + P0 + row) * DPROJ + 2048 + h * 64 + 8 * c);
        *(LAS u32x2*)(wl + row * 136 + c * 16) = (u32x2){raw.x, raw.y}; *(LAS u32x2*)(wl + row * 136 + c * 16 + 8) = (u32x2){raw.z, raw.w}; }
    CBAR();
    unsigned v[64];
#pragma unroll
    for (int p = 0; p < 64; ++p) v[p] = *(const LAS unsigned short*)(wl + p * 136 + lane * 2);
    CBAR();
    bf16_t* vt = (bf16_t*)(ws + WS_VT);
    const int nt = lane >> 4, dl = lane & 15;
#pragma unroll
    for (int G = 0; G < 2; ++G) { bf16_t* tp = vt + ((((size_t)bh * 64 + (P0 >> 5) + G) * 4 + nt) * 64 + dl) * 8;
#pragma unroll
        for (int kg = 0; kg < 4; ++kg) { const int a0 = 32 * G + 4 * kg, b0 = 32 * G + 16 + 4 * kg;
            u32x4 w; w.x = v[a0] | (v[a0 + 1] << 16); w.y = v[a0 + 2] | (v[a0 + 3] << 16); w.z = v[b0] | (v[b0 + 1] << 16); w.w = v[b0 + 2] | (v[b0 + 3] << 16);
            *(u32x4*)(tp + kg * 128) = w; } }
    { bf16_t* vt4 = vt + (size_t)4 * 16 * 64 * SEQ; const int l0 = P0 >> 2, tile = (l0 >> 4) & 1, grp = l0 >> 5;
#pragma unroll
        for (int r = 0; r < 4; ++r) { bf16_t* tp = vt4 + (((((size_t)bh * 4 + r) * 16 + grp) * 4 + nt) * 64 + dl) * 8;
#pragma unroll
            for (int kg = 0; kg < 4; ++kg) { const int p0 = 4 * (4 * kg) + r;
                u32x2 w; w.x = v[p0] | (v[p0 + 4] << 16); w.y = v[p0 + 8] | (v[p0 + 12] << 16);
                *(u32x2*)(tp + kg * 128 + 4 * tile) = w; } } }
    { bf16_t* vt16 = vt + (size_t)2 * 4 * 16 * 64 * SEQ; const int l0 = P0 >> 4, w32 = l0 & 31, tile = (w32 >> 4) & 1, kg = (w32 & 15) >> 2, grp = l0 >> 5;
#pragma unroll
        for (int r = 0; r < 16; ++r) { u32x2 w; w.x = v[r] | (v[16 + r] << 16); w.y = v[32 + r] | (v[48 + r] << 16);
            *(u32x2*)(vt16 + (((((size_t)bh * 16 + r) * 4 + grp) * 4 + nt) * 64 + kg * 16 + dl) * 8 + 4 * tile) = w; } }
}

struct AttnItem { int sh, r, lfirst, ks, tbo; size_t qk_off, v_off; };
__device__ __forceinline__ AttnItem attn_item(int it, int p0, int bh) {
    AttnItem I; const int br = it >> 4, j = it & 15; I.sh = 2 * br; I.tbo = br * 192;
    I.r = j & ((1 << I.sh) - 1); I.lfirst = (p0 >> I.sh) + 16 * (j >> I.sh);
    const size_t rc = (size_t)br * 4 * 16 * SEQ * 64 + ((size_t)(bh << I.sh) + I.r) * (size_t)(SEQ >> I.sh) * 64;
    I.qk_off = rc; I.v_off = rc;
    int ks = (I.lfirst - 128) & ~31; I.ks = ks < 0 ? 0 : ks;
    return I;
}
__device__ __forceinline__ void attn_unit(const Args& A, LAS unsigned char* lds, int unit, int tid, int wave, int lane, int pflags) {
    unsigned char* ws = A.ws;
    const int blk = 7 - (unit >> 6), bh = unit & 63, b = bh >> 4, h = bh & 15, p0 = blk * 256;
    constexpr int OST = 68;
    LAS float* Oacc = (LAS float*)lds; LAS float* lacc = (LAS float*)(lds + 256 * OST * 4); LAS float* tb = (LAS float*)(lds + 256 * OST * 4 + 1024);
    { const float* bt = (const float*)(ws + WS_BTAB) + h * 3 * 192; for (int i = tid; i < 3 * 192; i += 512) tb[i] = bt[i]; }
    __syncthreads();
    const bf16_t* QF = (const bf16_t*)(ws + WS_QF); const bf16_t* KF = (const bf16_t*)(ws + WS_KF); const bf16_t* VF = (const bf16_t*)(ws + WS_VT);
    const int qi = lane & 15, g = lane >> 4;
#define ATT_LOAD(IT, LK, B) do { const AttnItem _I = attn_item(IT, p0, bh); const bf16_t* _kp = KF + _I.qk_off + (size_t)((LK) >> 4) * 1024 + lane * 8; \
        B[0] = *(const u32x4*)(_kp); B[1] = *(const u32x4*)(_kp + 512); B[2] = *(const u32x4*)(_kp + 1024); B[3] = *(const u32x4*)(_kp + 1536); \
        const bf16_t* _vp = VF + _I.v_off + (size_t)((LK) >> 5) * 2048 + lane * 8; \
        B[4] = *(const u32x4*)(_vp); B[5] = *(const u32x4*)(_vp + 512); B[6] = *(const u32x4*)(_vp + 1024); B[7] = *(const u32x4*)(_vp + 1536); \
        const bf16_t* _qp = QF + _I.qk_off + (size_t)(_I.lfirst >> 4) * 1024 + lane * 8; B[8] = *(const u32x4*)(_qp); B[9] = *(const u32x4*)(_qp + 512); } while (0)
#define ATT_ADV(IT, LK, NIT, NLK) do { const AttnItem _J = attn_item(IT, p0, bh); if ((LK) + 32 <= _J.lfirst) { (NIT) = (IT); (NLK) = (LK) + 32; } else { (NIT) = (IT) + 8; (NLK) = 0; if ((NIT) < 48) { const AttnItem _N = attn_item(NIT, p0, bh); (NLK) = _N.ks; } } } while (0)
#define ATT_STEP(CIT, CLK, BC, NIT, NLK, NNIT, NNLK, BNN) { \
        NNIT = 64; NNLK = 0; \
        if ((NIT) < 48) { ATT_ADV(NIT, NLK, NNIT, NNLK); if ((NNIT) < 48) ATT_LOAD(NNIT, NNLK, BNN); } \
        const AttnItem cI = attn_item(CIT, p0, bh); \
        f32x4 sa = {0.f, 0.f, 0.f, 0.f}, sb = {0.f, 0.f, 0.f, 0.f}; \
        sa = MFMA16(as_bf16x8(BC[0]), as_bf16x8(BC[8]), sa); sb = MFMA16(as_bf16x8(BC[2]), as_bf16x8(BC[8]), sb); \
        sa = MFMA16(as_bf16x8(BC[1]), as_bf16x8(BC[9]), sa); sb = MFMA16(as_bf16x8(BC[3]), as_bf16x8(BC[9]), sb); \
        const LAS float* tbb = tb + cI.tbo; \
        const int ba = cI.lfirst + qi - (CLK) - 4 * g + 31; \
        float pa[4], pb[4]; \
        _Pragma("unroll") for (int e = 0; e < 4; ++e) { pa[e] = __builtin_amdgcn_exp2f(sa[e] + tbb[ba - e]); pb[e] = __builtin_amdgcn_exp2f(sb[e] + tbb[ba - 16 - e]); } \
        lsum += (pa[0] + pa[1]) + (pa[2] + pa[3]) + (pb[0] + pb[1]) + (pb[2] + pb[3]); \
        u32x4 pw; pw.x = cvt_pk_bf16(pa[0], pa[1]); pw.y = cvt_pk_bf16(pa[2], pa[3]); pw.z = cvt_pk_bf16(pb[0], pb[1]); pw.w = cvt_pk_bf16(pb[2], pb[3]); \
        const bf16x8 pf = as_bf16x8(pw); \
        _Pragma("unroll") for (int nt = 0; nt < 4; ++nt) o[nt] = MFMA16(pf, as_bf16x8(BC[4 + nt]), o[nt]); \
        if ((CLK) + 32 > cI.lfirst) {     \
            lsum += __shfl_xor(lsum, 16); lsum += __shfl_xor(lsum, 32); \
            const bool first = (CIT) < 16; \
            if (g == 0) { LAS float* lp = lacc + ((((cI.lfirst + qi) << cI.sh) + cI.r) - p0); *lp = first ? lsum : *lp + lsum; } \
            _Pragma("unroll") for (int reg = 0; reg < 4; ++reg) { LAS float* op = Oacc + (((((cI.lfirst + 4 * g + reg) << cI.sh) + cI.r) - p0)) * OST + qi; \
                _Pragma("unroll") for (int nt = 0; nt < 4; ++nt) op[16 * nt] = first ? o[nt][reg] : op[16 * nt] + o[nt][reg]; } \
            _Pragma("unroll") for (int nt = 0; nt < 4; ++nt) o[nt] = (f32x4){0.f, 0.f, 0.f, 0.f}; \
            lsum = 0.f; \
            if (((CIT) >> 3) & 1) __syncthreads();     \
        } \
        if ((NIT) >= 48) break; }
    if (!(pflags & 16)) {
    int itA = wave, lkA, itB, lkB, itC = 64, lkC = 0;
    { const AttnItem I0 = attn_item(wave, p0, bh); lkA = I0.ks; }
    ATT_ADV(itA, lkA, itB, lkB);
    u32x4 bA[10], bB[10], bC[10];
    ATT_LOAD(itA, lkA, bA); if (itB < 48) ATT_LOAD(itB, lkB, bB);
    f32x4 o[4];
#pragma unroll
    for (int nt = 0; nt < 4; ++nt) o[nt] = (f32x4){0.f, 0.f, 0.f, 0.f};
    float lsum = 0.f;
    for (;;) {
        ATT_STEP(itA, lkA, bA, itB, lkB, itC, lkC, bC)
        ATT_STEP(itB, lkB, bB, itC, lkC, itA, lkA, bA)
        ATT_STEP(itC, lkC, bC, itA, lkA, itB, lkB, bB)
    }
    }
#undef ATT_LOAD
#undef ATT_ADV
#undef ATT_STEP
    if (!(pflags & (16 | 32 | 64))) { const int ql = tid >> 1, half = tid & 1; const float inv = 1.0f / lacc[ql];
        bf16_t* dst = (bf16_t*)(ws + WS_MIXED) + (size_t)(b * SEQ + p0 + ql) * 2048 + h * 64 + 32 * half;
        float ss = 0.f;
#pragma unroll
        for (int c4 = 0; c4 < 4; ++c4) { float v[8];
#pragma unroll
            for (int e = 0; e < 8; ++e) { v[e] = Oacc[ql * OST + 32 * half + 8 * c4 + e] * inv; ss += v[e] * v[e]; }
            u32x4 w; w.x = cvt_pk_bf16(v[0], v[1]); w.y = cvt_pk_bf16(v[2], v[3]); w.z = cvt_pk_bf16(v[4], v[5]); w.w = cvt_pk_bf16(v[6], v[7]);
            *(u32x4*)(dst + 8 * c4) = w; }
        ss += __shfl_xor(ss, 1);
        if (half == 0) unsafeAtomicAdd((float*)(ws + WS_CTL + CTL_RSS_ATTN) + b * SEQ + p0 + ql, ss); }
    __syncthreads();
}

__device__ __forceinline__ unsigned fkey(float f) { const unsigned u = __float_as_uint(f); return (u & 0x80000000u) ? ~u : (u | 0x80000000u); }
template <int R> __device__ __forceinline__ void select16(const unsigned (&key)[R], unsigned long long (&m)[R]) {
    unsigned mx = key[0];
#pragma unroll
    for (int r = 1; r < R; ++r) mx = key[r] > mx ? key[r] : mx;
#pragma unroll
    for (int o = 1; o < 64; o <<= 1) { const unsigned t = (unsigned)__shfl_xor((int)mx, o); mx = t > mx ? t : mx; }
    unsigned lo = mx > (3u << 23) ? mx - (3u << 23) : 0u, hi = mx + 1u;
    int cnt = 0;
#pragma unroll
    for (int r = 0; r < R; ++r) cnt += __popcll(__ballot(key[r] >= lo));
    if (cnt < 16) { lo = 0u; cnt = R * 64; }
    while (cnt != 16 && hi - lo > 1u) { const unsigned mid = lo + ((hi - lo) >> 1); int c = 0;
#pragma unroll
        for (int r = 0; r < R; ++r) c += __popcll(__ballot(key[r] >= mid));
        if (c >= 16) { lo = mid; cnt = c; } else hi = mid; }
    const unsigned T = lo;
    if (cnt == 16) {
#pragma unroll
        for (int r = 0; r < R; ++r) m[r] = __ballot(key[r] >= T);
    } else {
        int need = 16;
#pragma unroll
        for (int r = 0; r < R; ++r) { m[r] = __ballot(key[r] > T); need -= __popcll(m[r]); }
#pragma unroll
        for (int r = 0; r < R; ++r) { unsigned long long eq = __ballot(key[r] == T);
            while (__popcll(eq) > need) eq &= ~(1ull << (63 - __builtin_clzll(eq)));
            need -= __popcll(eq); m[r] |= eq; }
    }
}
__device__ __forceinline__ void peer_topk(const float* sp, LAS float* sc, LAS int* exo, LAS float* gto, int lane) {
    LAS float* v1 = sc; LAS int* i1 = (LAS int*)(sc + 16); LAS float* v2 = sc + 32; LAS int* i2 = (LAS int*)(sc + 48); LAS float* sv = sc + 64; LAS int* si = (LAS int*)(sc + 80);
    const unsigned long long lt = (1ull << lane) - 1ull;
    const float sv4[4] = {sp[lane], sp[64 + lane], sp[128 + lane], sp[192 + lane]};
#pragma unroll
    for (int half = 0; half < 2; ++half) {
        const float a0 = sv4[2 * half], a1 = sv4[2 * half + 1];
        const unsigned key[2] = {fkey(a0), fkey(a1)}; unsigned long long m[2];
        select16<2>(key, m);
        LAS float* vv = half ? v2 : v1; LAS int* ii = half ? i2 : i1;
        if ((m[0] >> lane) & 1ull) { const int pos = __popcll(m[0] & lt); vv[pos] = a0; ii[pos] = lane; }
        if ((m[1] >> lane) & 1ull) { const int pos = __popcll(m[0]) + __popcll(m[1] & lt); vv[pos] = a1; ii[pos] = 64 + lane; }
    }
    CBAR(); LDS_WAIT();
    const int a = lane >> 2, bb = (lane & 3) * 4;
    const float va = v1[a]; float cv[4]; unsigned key[4]; unsigned long long m[4];
#pragma unroll
    for (int e = 0; e < 4; ++e) { cv[e] = va + v2[bb + e]; key[e] = fkey(cv[e]); }
    select16<4>(key, m);
    int base = 0;
#pragma unroll
    for (int e = 0; e < 4; ++e) { if ((m[e] >> lane) & 1ull) { const int pos = base + __popcll(m[e] & lt); sv[pos] = cv[e]; si[pos] = a * 16 + bb + e; } base += __popcll(m[e]); }
    CBAR(); LDS_WAIT();
    if (lane < 16) {
        const float val = sv[lane]; const int fi = si[lane];
        float mx = val;
#pragma unroll
        for (int o = 1; o < 16; o <<= 1) mx = fmaxf(mx, __shfl_xor(mx, o));
        const float ex = expf(val - mx); float sum = ex;
#pragma unroll
        for (int o = 1; o < 16; o <<= 1) sum += __shfl_xor(sum, o);
        exo[lane] = i1[fi >> 4] * 128 + (i2[fi & 15] - 0);
        gto[lane] = ex / sum;
    }
    CBAR(); LDS_WAIT();
}

constexpr int PD = 16;
__device__ __forceinline__ float ubyte_f32(unsigned w, int i) { return (float)((w >> (8 * i)) & 0xffu); }
__device__ __forceinline__ void peer_wave(const Args& A, LAS unsigned char* lds, int wave, int lane, int pflags) {
    unsigned char* ws = A.ws;
    const float* scores = (const float*)(ws + WS_PROJ);
    const unsigned char* ub = ws + WS_UB; const unsigned char* vb = ws + WS_VB; const bf16_t* x1b = (const bf16_t*)(ws + WS_HB);
    const float* su = (const float*)(ws + WS_SU); const float* sv = (const float*)(ws + WS_SV);
    const float* rssx = (const float*)(ws + WS_CTL + CTL_RSS_X1);
    LAS int* exl = (LAS int*)(lds + wave * 4096);
    LAS float* gtl = (LAS float*)(lds + wave * 4096 + 2048);
    LAS float* sc = (LAS float*)(lds + 32768 + wave * 512);
    LAS float* wts = (LAS float*)(lds + 36864 + wave * 512);
    const int t0 = (blockIdx.x * 8 + wave) * 4;
    if (t0 >= NTOK) return;
    for (int h = 0; h < 8; ++h) peer_topk(scores + (size_t)t0 * 2048 + h * 256, sc, exl + h * 16, gtl + h * 16, lane);
    CBAR(); LDS_WAIT();
    if (pflags & 256) return;
    u32x4 buf[PD];
#define ROWPTR(s) (((s) & 128 ? vb : ub) + (size_t)exl[((s) >> 8) * 128 + ((s) & 127)] * 1024 + 16 * lane)
#define ISSUE(slot, s) do { buf[slot] = *(const u32x4*)ROWPTR(s); } while (0)
#pragma unroll
    for (int i = 0; i < PD; ++i) ISSUE(i, i);
    for (int tok = 0; tok < 4; ++tok) {
        const int t = t0 + tok;
        unsigned xq[8]; float sx; int xsum;
        { float xf[32];
#pragma unroll
            for (int j = 0; j < 2; ++j)
#pragma unroll
                for (int hlf = 0; hlf < 2; ++hlf) { const u32x4 raw = *(const u32x4*)(x1b + (size_t)t * 2048 + 16 * lane + 1024 * j + 8 * hlf);
                    const unsigned rw[4] = {raw.x, raw.y, raw.z, raw.w};
#pragma unroll
                    for (int e = 0; e < 4; ++e) { xf[16 * j + 8 * hlf + 2 * e] = bflo(rw[e]); xf[16 * j + 8 * hlf + 2 * e + 1] = bfhi(rw[e]); } }
            float m = 0.f;
#pragma unroll
            for (int i = 0; i < 32; ++i) m = fmaxf(m, fabsf(xf[i]));
            m = fmaxf(wave_max(m), 1e-30f);
            const float inv = 127.f / m; sx = m * (1.f / 127.f);
            int ls = 0;
#pragma unroll
            for (int d = 0; d < 8; ++d) { const int a = (int)rintf(xf[4 * d] * inv), b = (int)rintf(xf[4 * d + 1] * inv), c = (int)rintf(xf[4 * d + 2] * inv), e = (int)rintf(xf[4 * d + 3] * inv);
                ls += (a + b) + (c + e);
                xq[d] = (unsigned)(a & 255) | ((unsigned)(b & 255) << 8) | ((unsigned)(c & 255) << 16) | ((unsigned)(e & 255) << 24); }
#pragma unroll
            for (int o = 1; o < 64; o <<= 1) ls += __shfl_xor(ls, o);
            xsum = ls; }
        const float r2 = 1.0f / sqrtf(rssx[t] * (1.f / 2048.f) + EPS);
        const float ascale = sx * r2;
        for (int k00 = 0; k00 < 128; k00 += PD) {
#pragma unroll
          for (int hb = 0; hb < 2; ++hb) { const int k0 = k00 + 8 * hb;
            int p[8];
#pragma unroll
            for (int i = 0; i < 8; ++i) {
                const int s = tok * 256 + k0 + i, slot = 8 * hb + i;
                int acc = 0;
                { const unsigned w4[4] = {buf[slot].x, buf[slot].y, buf[slot].z, buf[slot].w};
#pragma unroll
                    for (int e = 0; e < 4; ++e) { acc = __builtin_amdgcn_sdot4((int)(w4[e] & 0x0F0F0F0Fu), (int)xq[e], acc, false); acc = __builtin_amdgcn_sdot4((int)((w4[e] >> 4) & 0x0F0F0F0Fu), (int)xq[4 + e], acc, false); } }
                p[i] = acc;
                if (s + PD < 4 * 256) ISSUE(slot, s + PD);
            }
            const bool b0 = lane & 1, b1 = lane & 2, b2 = lane & 4;
            int q4[4], q2[2], q1;
#pragma unroll
            for (int i = 0; i < 4; ++i) { const int keep = b0 ? p[i + 4] : p[i], send = b0 ? p[i] : p[i + 4]; q4[i] = keep + __shfl_xor(send, 1); }
#pragma unroll
            for (int i = 0; i < 2; ++i) { const int keep = b1 ? q4[i + 2] : q4[i], send = b1 ? q4[i] : q4[i + 2]; q2[i] = keep + __shfl_xor(send, 2); }
            { const int keep = b2 ? q2[1] : q2[0], send = b2 ? q2[0] : q2[1]; q1 = keep + __shfl_xor(send, 4); }
            q1 += __shfl_xor(q1, 8); q1 += __shfl_xor(q1, 16); q1 += __shfl_xor(q1, 32);
            if (lane < 8) { const int k = k0 + 4 * (lane & 1) + 2 * ((lane >> 1) & 1) + ((lane >> 2) & 1);
                const int e = exl[tok * 128 + k];
                const float a = (float)(2 * q1 - 15 * xsum) * (ascale * su[e]);
                wts[k] = 2.f * gtl[tok * 128 + k] * gelu_erf(a) * sv[e]; }
          }
            if (tok < 3) { const int hh = k00 >> 4;
                peer_topk(scores + (size_t)(t + 1) * 2048 + hh * 256, sc, exl + (tok + 1) * 128 + hh * 16, gtl + (tok + 1) * 128 + hh * 16, lane); }
        }
        CBAR(); LDS_WAIT();
        float acc[32]; float wsum = 0.f;
#pragma unroll
        for (int i = 0; i < 32; ++i) acc[i] = 0.f;
        for (int k0 = 0; k0 < 128; k0 += PD) {
#pragma unroll
            for (int i = 0; i < PD; ++i) {
                const int k = k0 + i, s = tok * 256 + 128 + k;
                const float w = wts[k];
                wsum += w;
                { const unsigned w4[4] = {buf[i].x, buf[i].y, buf[i].z, buf[i].w};
#pragma unroll
                    for (int e = 0; e < 4; ++e) { const unsigned lo = w4[e] & 0x0F0F0F0Fu, hi = (w4[e] >> 4) & 0x0F0F0F0Fu;
#pragma unroll
                        for (int bb = 0; bb < 4; ++bb) { acc[4 * e + bb] += w * ubyte_f32(lo, bb); acc[16 + 4 * e + bb] += w * ubyte_f32(hi, bb); } } }
                if (s + PD < 4 * 256) ISSUE(i, s + PD);
            }
        }
        CBAR();
        const float corr = -7.5f * wsum;
        float* op = A.out + (size_t)t * 2048 + 16 * lane;
        if (pflags & 128) { if (corr == 12345.678f) op[0] = acc[0]; continue; }
#pragma unroll
        for (int j = 0; j < 2; ++j)
#pragma unroll
            for (int hlf = 0; hlf < 2; ++hlf) { const u32x4 raw = *(const u32x4*)(x1b + (size_t)t * 2048 + 16 * lane + 1024 * j + 8 * hlf);
                const int a0 = 16 * j + 8 * hlf;
                *(f32x4*)(op + 1024 * j + 8 * hlf) = (f32x4){bflo(raw.x) + acc[a0] + corr, bfhi(raw.x) + acc[a0 + 1] + corr, bflo(raw.y) + acc[a0 + 2] + corr, bfhi(raw.y) + acc[a0 + 3] + corr};
                *(f32x4*)(op + 1024 * j + 8 * hlf + 4) = (f32x4){bflo(raw.z) + acc[a0 + 4] + corr, bfhi(raw.z) + acc[a0 + 5] + corr, bflo(raw.w) + acc[a0 + 6] + corr, bfhi(raw.w) + acc[a0 + 7] + corr}; }
    }
#undef ROWPTR
#undef ISSUE
}

__global__ void __launch_bounds__(512, 2) mk_fwd(Args args) {
    extern __shared__ __attribute__((aligned(16))) unsigned char lds_raw[];
    LAS unsigned char* lds = (LAS unsigned char*)lds_raw;
    const int tid = threadIdx.x, lane = tid & 63, wave = __builtin_amdgcn_readfirstlane(tid >> 6);
    volatile LAS unsigned* MISC = (volatile LAS unsigned*)(lds + MISC_OFF);
    if (tid < 64) MISC[tid] = 0u;
    __syncthreads();
    unsigned char* ws = args.ws;
    const int lo = args.ph_lo, hi = args.ph_hi & 0xff, pflags = args.ph_hi >> 8;
    XcdBarrier bar; bar.bar = (unsigned*)(ws + WS_CTL); bar.x = 0; bar.st = nullptr;
    if (hi - lo > 1) bar = xcd_barrier_post((unsigned*)(ws + WS_CTL), MISC + 8);
#ifndef PH_MASK
#define PH_MASK 0x7f
#endif
#define IN(k) (((PH_MASK >> (k)) & 1) && lo <= (k) && (k) < hi)
#define SEAM(k) do { if (IN(k) && IN((k) + 1)) xcd_barrier(bar); } while (0)

    if (IN(0)) { p0_prologue(args, lds, wave, lane); }
    SEAM(0);
    if (IN(1)) {
        pg8::Gemm g{(const bf16_t*)(ws + WS_HB), (const bf16_t*)(ws + WS_WINT), NTOK, DPROJ, DM}; pg8::StaticOrder S; S.init(NTOK, DPROJ, gridDim.x, (int)blockIdx.x);
        pg8::EpiProj E{(bf16_t*)(ws + WS_PROJ), DPROJ};
        pg8::gemm_phase<pg8::EpiProj, pg8::StaticOrder, false>(lds, g, S, E, nullptr);
    }
    SEAM(1);
    if (IN(2)) {
        if (!(pflags & 4)) for (int u = blockIdx.x; u < 256; u += gridDim.x) ssm_unit(args, lds, u >> 6, u & 63, wave, lane);
        if (!(pflags & 8)) for (int it = blockIdx.x * 8 + wave; it < 2048; it += gridDim.x * 8) prep2_item(args, lds + wave * SSM_WL, it, lane);
    }
    SEAM(2);
    if (IN(3)) {
        if (!(pflags & 2)) {
            pg8::Gemm g{(const bf16_t*)(ws + WS_YB), (const bf16_t*)(ws + WS_GLUT), NTOK, 1024, 1024}; pg8::StaticOrder S; S.init(NTOK, 1024, gridDim.x, (int)blockIdx.x);
            pg8::EpiGlu E{(const bf16_t*)(ws + WS_YB), (bf16_t*)(ws + WS_MIXED) + 1024, args.in[15], (float*)(ws + WS_CTL + CTL_RSS_SSM)};
            pg8::gemm_phase<pg8::EpiGlu, pg8::StaticOrder, false>(lds, g, S, E, nullptr);
        }
        __syncthreads();
        if (!(pflags & 1)) for (;;) {
            if (tid == 0) MISC[0] = atomicAdd((unsigned*)(ws + WS_CTL + CTL_QCTR), 1u);
            __syncthreads();
            const unsigned u = MISC[0];
            __syncthreads();
            if (u >= 512u) break;
            attn_unit(args, lds, (int)u, tid, wave, lane, pflags);
        }
    }
    SEAM(3);
    if (IN(4)) {
        pg8::Gemm g{(const bf16_t*)(ws + WS_MIXED), (const bf16_t*)(ws + WS_WOUTT), NTOK, DM, DM}; pg8::StaticOrder S; S.init(NTOK, DM, gridDim.x, (int)blockIdx.x);
        LAS float* tab = (LAS float*)(lds + 131072);
        { pg8::Unit u0; if (S.next(0, u0) && tid < 256) { const int row = u0.pm * 256 + tid;
            const float ra = 1.0f / sqrtf(((const float*)(ws + WS_CTL + CTL_RSS_ATTN))[row] * (1.f / 1024.f) + EPS), rs = 1.0f / sqrtf(((const float*)(ws + WS_CTL + CTL_RSS_SSM))[row] * (1.f / 1024.f) + EPS);
            tab[tid] = ra / rs; tab[256 + tid] = rs; } }
        __syncthreads();
        pg8::EpiWout E{args.in[0], args.out, (bf16_t*)(ws + WS_HB), (float*)(ws + WS_CTL + CTL_RSS_X1), tab};
        pg8::gemm_phase<pg8::EpiWout, pg8::StaticOrder, false>(lds, g, S, E, nullptr);
    }
    SEAM(4);
    if (IN(5)) {
        pg8::Gemm g{(const bf16_t*)(ws + WS_HB), (const bf16_t*)(ws + WS_WPT), NTOK, DM, DM}; pg8::StaticOrder S; S.init(NTOK, DM, gridDim.x, (int)blockIdx.x);
        pg8::EpiScores E{(float*)(ws + WS_PROJ), (const float*)(ws + WS_CTL + CTL_RSS_X1)};
        pg8::gemm_phase<pg8::EpiScores, pg8::StaticOrder, false>(lds, g, S, E, nullptr);
    }
    SEAM(5);
    if (IN(6)) { peer_wave(args, lds, wave, lane, pflags); }
#undef IN
#undef SEAM
}

#ifndef MK_DEBUG
#ifndef MK_PER_PHASE
#define MK_PER_PHASE 0
#endif
extern "C" void kernel_launch(void* const* d_in, const int* in_sizes, int n_in, void* d_out, int out_size, void* d_ws, size_t ws_size, hipStream_t stream) {
    static int grid = 0;
    if (grid == 0) {
        if (n_in != 25 || out_size != NTOK * DM || ws_size < WS_END) { fprintf(stderr, "kernel_launch: unexpected shapes / workspace (%d inputs, out %d, ws %zu < %zu)\n", n_in, out_size, ws_size, (size_t)WS_END); grid = -1; return; }
        int dev = 0, cus = 0, per_cu = 0;
        if (hipGetDevice(&dev) != hipSuccess || hipDeviceGetAttribute(&cus, hipDeviceAttributeMultiprocessorCount, dev) != hipSuccess) { grid = -1; return; }
        if (hipFuncSetAttribute((const void*)mk_fwd, hipFuncAttributeMaxDynamicSharedMemorySize, LDS_BYTES) != hipSuccess) { fprintf(stderr, "kernel_launch: hipFuncSetAttribute failed\n"); grid = -1; return; }
        if (hipOccupancyMaxActiveBlocksPerMultiprocessor(&per_cu, (const void*)mk_fwd, 512, LDS_BYTES) != hipSuccess || per_cu < 1) { fprintf(stderr, "kernel_launch: occupancy query reports %d\n", per_cu); }
        (void)hipGetLastError();
        grid = cus;
    }
    if (grid < 0) return;
    (void)hipMemsetAsync((char*)d_ws + WS_CTL, 0, CTL_BYTES, stream);
    Args a{};
    for (int i = 0; i < 25; ++i) a.in[i] = (const float*)d_in[i];
    a.out = (float*)d_out; a.ws = (unsigned char*)d_ws;
#if MK_PER_PHASE
#ifndef MK_DUP
#define MK_DUP -1
#endif
    for (int p = 0; p < 7; ++p) { a.ph_lo = p; a.ph_hi = p + 1; hipLaunchKernelGGL(mk_fwd, dim3(grid), dim3(512), LDS_BYTES, stream, a);
        if (p == MK_DUP) {
            (void)hipMemsetAsync((char*)d_ws + WS_CTL + CTL_QCTR, 0, 256, stream);
#ifndef MK_DUP_FLAGS
#define MK_DUP_FLAGS 0
#endif
            if (p == 3 && !((MK_DUP_FLAGS) & (1 | 16 | 32 | 64))) (void)hipMemsetAsync((char*)d_ws + WS_CTL + CTL_RSS_ATTN, 0, 32768, stream);
            if (p == 3 && !((MK_DUP_FLAGS) & 2)) (void)hipMemsetAsync((char*)d_ws + WS_CTL + CTL_RSS_SSM, 0, 32768, stream);
            if (p == 4) (void)hipMemsetAsync((char*)d_ws + WS_CTL + CTL_RSS_X1, 0, 32768, stream);
            a.ph_hi |= (MK_DUP_FLAGS) << 8;
            hipLaunchKernelGGL(mk_fwd, dim3(grid), dim3(512), LDS_BYTES, stream, a); } }
#else
    a.ph_lo = 0; a.ph_hi = 7;
    hipLaunchKernelGGL(mk_fwd, dim3(grid), dim3(512), LDS_BYTES, stream, a);
#endif
}
#endif
```

```cpp
#include <hip/hip_runtime.h>
#include <stdint.h>
#include <stdio.h>

typedef unsigned short bf16_t;
typedef float f32x2 __attribute__((ext_vector_type(2)));
typedef unsigned u32x2 __attribute__((ext_vector_type(2)));
using bf16x2v = __attribute__((ext_vector_type(2))) __bf16;

constexpr int NTOK = 8192, SEQ = 2048, DM = 2048, DPROJ = 4096;
constexpr float EPS = 1e-6f;
constexpr float LOG2E = 1.4426950408889634f;

constexpr size_t MB = 1024 * 1024;
constexpr size_t WS_CTL = 0;
constexpr size_t CTL_BYTES = 128 * 1024;
constexpr size_t CTL_QCTR = 16384;
constexpr size_t CTL_RSS_ATTN = 32768, CTL_RSS_SSM = 65536, CTL_RSS_X1 = 98304;
constexpr size_t WS_HB = 256 * 1024;
constexpr size_t WS_WINT = WS_HB + 32 * MB;
constexpr size_t WS_GLUT = WS_WINT + 16 * MB;
constexpr size_t WS_WOUTT = WS_GLUT + 2 * MB;
constexpr size_t WS_WPT = WS_WOUTT + 8 * MB;
constexpr size_t WS_UB = WS_WPT + 8 * MB;
constexpr size_t WS_VB = WS_UB + 32 * MB;
constexpr size_t WS_SU = WS_VB + 32 * MB;
constexpr size_t WS_SV = WS_SU + 65536;
constexpr size_t WS_PROJ = WS_SV + 65536;
constexpr size_t WS_QF = WS_PROJ + 64 * MB;
constexpr size_t WS_KF = WS_QF + 48 * MB;
constexpr size_t WS_VT = WS_KF + 48 * MB;
constexpr size_t WS_QN = WS_QF, WS_KN = WS_KF;
constexpr size_t WS_YB = WS_VT + 48 * MB + 4096;
constexpr size_t WS_MIXED = WS_YB + 16 * MB;
constexpr size_t WS_SSMP = WS_MIXED + 32 * MB;
constexpr size_t SSMP_ABAR = 0, SSMP_A256 = 32768, SSMP_BFRAG = 65536, SSMP_CFRAG = 65536 + 524288;
constexpr size_t WS_BTAB = WS_SSMP + 1 * MB;
constexpr size_t WS_END = WS_BTAB + 64 * 1024;

constexpr int LDS_BYTES = 147456;
constexpr int MISC_OFF = 147456 - 256;
#define XB_TMO      128
#define XB_XCNT(j)  (256  + 64 * (j))
#define XB_XSUB(j)  (1280 + 64 * (j))
#define XB_XGEN(j)  (2304 + 64 * (j))
#define XB_TOP      3328
#define XB_TOPGEN   3392
#define XCD_BAR_WORDS 3456
#define XB_SPIN_CAP (1u << 18)
#define LAS __attribute__((address_space(3)))

__device__ __forceinline__ unsigned xb_ld(unsigned* p)              { return __hip_atomic_load(p, __ATOMIC_RELAXED, __HIP_MEMORY_SCOPE_AGENT); }
__device__ __forceinline__ unsigned xb_add(unsigned* p, unsigned v) { return __hip_atomic_fetch_add(p, v, __ATOMIC_RELAXED, __HIP_MEMORY_SCOPE_AGENT); }
__device__ __forceinline__ unsigned xb_xcc_id() { return (unsigned)__builtin_amdgcn_s_getreg((3 << 11) | 20) & 0xFu; }
#define XB_SPIN(cond, bar) do { unsigned _sp = 0; while (cond) { __builtin_amdgcn_s_sleep(1); \
    if ((++_sp & 255u) == 0u) { if (xb_ld(&(bar)[XB_TMO])) break; if (_sp > XB_SPIN_CAP) { atomicAdd(&(bar)[XB_TMO], 1u); break; } } } } while (0)

struct XcdBarrier {
    unsigned* bar; unsigned x;
    volatile LAS unsigned* st;
};

__device__ __forceinline__ XcdBarrier xcd_barrier_post(unsigned* bar, volatile LAS unsigned* st) {
    XcdBarrier b; b.bar = bar; b.x = xb_xcc_id(); b.st = st;
    if (threadIdx.x == 0) (void)xb_add(&bar[XB_XCNT(b.x)], 1u);
    return b;
}
__device__ __forceinline__ void xcd_barrier_complete(unsigned* bar, unsigned x, unsigned& nloc, unsigned& nx) {
    const unsigned G = gridDim.x * gridDim.y * gridDim.z;
    unsigned sum, cnt, mine, sp = 0u;
    for (;;) {
        sum = 0u; cnt = 0u; mine = 0u;
#pragma unroll
        for (unsigned j = 0; j < 16; ++j) { const unsigned c = xb_ld(&bar[XB_XCNT(j)]); sum += c; cnt += (c > 0u) ? 1u : 0u; mine = (j == x) ? c : mine; }
        if (sum == G) break;
        __builtin_amdgcn_s_sleep(1);
        if ((++sp & 255u) == 0u) { if (xb_ld(&bar[XB_TMO])) break; if (sp > XB_SPIN_CAP) { atomicAdd(&bar[XB_TMO], 1u); break; } }
    }
    nloc = mine > 0u ? mine : 1u; nx = cnt > 0u ? cnt : 1u;
}

__device__ __forceinline__ void xcd_barrier(const XcdBarrier& b) {
    asm volatile("s_waitcnt vmcnt(0)" ::: "memory");
    __syncthreads();
    if (threadIdx.x == 0) {
        unsigned* bar = b.bar;
        __builtin_amdgcn_s_waitcnt(0);
        unsigned nloc = b.st[0], nx = b.st[1];
        if (nloc == 0u) { xcd_barrier_complete(bar, b.x, nloc, nx); b.st[0] = nloc; b.st[1] = nx; }
        const unsigned old = xb_add(&bar[XB_XSUB(b.x)], 1u);
        const unsigned gen = old / nloc;
        if (old + 1u == (gen + 1u) * nloc) {
            __builtin_amdgcn_fence(__ATOMIC_RELEASE, "agent");
            asm volatile("s_waitcnt vmcnt(0)" ::: "memory");
            const unsigned og = xb_add(&bar[XB_TOP], 1u);
            const unsigned tg = og / nx;
            if (og + 1u == (tg + 1u) * nx) xb_add(&bar[XB_TOPGEN], 1u);
            else XB_SPIN(xb_ld(&bar[XB_TOPGEN]) == tg, bar);
            __builtin_amdgcn_fence(__ATOMIC_ACQUIRE, "agent");
            xb_add(&bar[XB_XGEN(b.x)], 1u);
            asm volatile("s_waitcnt vmcnt(0)" ::: "memory");
        } else {
            XB_SPIN(xb_ld(&bar[XB_XGEN(b.x)]) == gen, bar);
            __builtin_amdgcn_fence(__ATOMIC_ACQUIRE, "agent");
            asm volatile("s_waitcnt vmcnt(0)" ::: "memory");
        }
    }
    __syncthreads();
}
namespace pg8 {
#define PG8_LAS __attribute__((address_space(3)))
typedef unsigned short bf16_t;
typedef short bf16x8 __attribute__((ext_vector_type(8)));
typedef float f32x4 __attribute__((ext_vector_type(4)));
typedef unsigned u32x4 __attribute__((ext_vector_type(4)));
constexpr int BM = 256, BK = 64, HALF = 128, HTB = HALF * BK * 2  , STAGE_BYTES = 8 * HTB, NXCD = 8, WGM = 8;

__host__ __device__ __forceinline__ int lds_byte(int r, int c) { const int st = (r >> 4) * 2 + (c >> 5), rr = r & 15, cc = c & 31, ob = rr * 64 + cc * 2; return st * 1024 + (ob ^ (((ob >> 9) & 1) << 5)); }
__host__ __device__ __forceinline__ void stage_rc(int b, int& R, int& C) { const int st = b / 1024, sb = b % 1024, swz = sb ^ (((sb >> 9) & 1) << 5); R = (st >> 1) * 16 + swz / 64; C = (st & 1) * 32 + (swz % 64) / 2; }
__host__ __device__ __forceinline__ int perm32(int rho) { const int n = rho >> 4, i = rho & 15; return 8 * (i >> 2) + 4 * n + (i & 3); }

struct Unit { int pm, pn; };
struct Gemm { const bf16_t* A; const bf16_t* Bt; int M, N, K; };

struct StaticOrder {
    int nM, nN, nwg, G, c;
    __host__ __device__ void init(int M, int N, int G_, int c_) { nM = M / BM; nN = N / BM; nwg = nM * nN; G = G_; c = c_; }
    __host__ __device__ bool next(int i, Unit& u) const {
        const long L = (long)i * G + c; if (L >= nwg) return false;
        int wgid = (int)L; { const int q = nwg / NXCD, r = nwg % NXCD, xcd = wgid % NXCD, off = wgid / NXCD; wgid = (xcd < r ? xcd * (q + 1) : r * (q + 1) + (xcd - r) * q) + off; }
        const int nig = WGM * nN, gid = wgid / nig, fm = gid * WGM, gsz = (nM - fm) < WGM ? (nM - fm) : WGM;
        u.pm = fm + ((wgid % nig) % gsz); u.pn = (wgid % nig) / gsz; return true;
    }
    __device__ __forceinline__ void a_ready(const Unit&) const {}
    __device__ __forceinline__ void done(const Unit&) const {}
};
typedef float cvt_f32x2 __attribute__((ext_vector_type(2)));
typedef __bf16 cvt_bf16x2 __attribute__((ext_vector_type(2)));
__device__ __forceinline__ unsigned cvt_pk_bf16(float lo, float hi) { return __builtin_bit_cast(unsigned, __builtin_convertvector((cvt_f32x2){lo, hi}, cvt_bf16x2)); }
__device__ __forceinline__ float bflo(unsigned u) { return __uint_as_float(u << 16); }
__device__ __forceinline__ float bfhi(unsigned u) { return __uint_as_float(u & 0xffff0000u); }

struct EpiProj {
    static constexpr bool PERM = true, AFTER_DRAIN = false, HAS_MID = false;
    bf16_t* O; int ldc;
    __device__ __forceinline__ void mid(f32x4 (&)[2][2][4][2], const Unit&, int, int, int, int) const {}
    __device__ __forceinline__ void operator()(const f32x4 (&acc)[2][2][4][2], const Unit& u, int wr, int wc, int fr, int fq) const {
        const int row0 = u.pm * BM + wr * 64 + fr, col0 = u.pn * BM + wc * 32 + 8 * fq;
#pragma unroll
        for (int ai = 0; ai < 2; ++ai)
#pragma unroll
            for (int m = 0; m < 4; ++m) { bf16_t* rowp = O + (size_t)(row0 + ai * HALF + m * 16) * ldc + col0;
#pragma unroll
                for (int bj = 0; bj < 2; ++bj) { const f32x4 v0 = acc[ai][bj][m][0], v1 = acc[ai][bj][m][1];
                    u32x4 w; w.x = cvt_pk_bf16(v0[0], v0[1]); w.y = cvt_pk_bf16(v0[2], v0[3]); w.z = cvt_pk_bf16(v1[0], v1[1]); w.w = cvt_pk_bf16(v1[2], v1[3]);
                    *(u32x4*)(rowp + bj * HALF) = w; } }
    }
};

struct EpiGlu {
    static constexpr bool PERM = true, AFTER_DRAIN = false, HAS_MID = false;
    const bf16_t* Y; bf16_t* O; const float* bias; float* rss;
    __device__ __forceinline__ void mid(f32x4 (&)[2][2][4][2], const Unit&, int, int, int, int) const {}
    __device__ __forceinline__ void operator()(const f32x4 (&acc)[2][2][4][2], const Unit& u, int wr, int wc, int fr, int fq) const {
        const int row0 = u.pm * BM + wr * 64 + fr, col0 = u.pn * BM + wc * 32 + 8 * fq;
        f32x4 bv[2][2];
#pragma unroll
        for (int bj = 0; bj < 2; ++bj)
#pragma unroll
            for (int n = 0; n < 2; ++n) bv[bj][n] = *(const f32x4*)(bias + col0 + bj * HALF + 4 * n);
        u32x4 yq[2][2];
#pragma unroll
        for (int bj = 0; bj < 2; ++bj) yq[0][bj] = *(const u32x4*)(Y + (size_t)row0 * 1024 + col0 + bj * HALF);
#pragma unroll
        for (int idx = 0; idx < 8; ++idx) { const int ai = idx >> 2, m = idx & 3, row = row0 + ai * HALF + m * 16; float ss = 0.f;
            if (idx < 7) { const int nrow = row0 + ((idx + 1) >> 2) * HALF + ((idx + 1) & 3) * 16;
#pragma unroll
                for (int bj = 0; bj < 2; ++bj) yq[(idx + 1) & 1][bj] = *(const u32x4*)(Y + (size_t)nrow * 1024 + col0 + bj * HALF); }
#pragma unroll
            for (int bj = 0; bj < 2; ++bj) {
                const u32x4 yv = yq[idx & 1][bj];
                const f32x4 g0 = acc[ai][bj][m][0] + bv[bj][0], g1 = acc[ai][bj][m][1] + bv[bj][1];
                float y[8] = {bflo(yv.x), bfhi(yv.x), bflo(yv.y), bfhi(yv.y), bflo(yv.z), bfhi(yv.z), bflo(yv.w), bfhi(yv.w)};
                float o[8];
#pragma unroll
                for (int e = 0; e < 4; ++e) { o[e] = y[e] * __builtin_amdgcn_rcpf(1.f + __expf(-g0[e])); o[4 + e] = y[4 + e] * __builtin_amdgcn_rcpf(1.f + __expf(-g1[e])); }
#pragma unroll
                for (int e = 0; e < 8; ++e) ss += o[e] * o[e];
                u32x4 w; w.x = cvt_pk_bf16(o[0], o[1]); w.y = cvt_pk_bf16(o[2], o[3]); w.z = cvt_pk_bf16(o[4], o[5]); w.w = cvt_pk_bf16(o[6], o[7]);
                *(u32x4*)(O + (size_t)row * 2048 + col0 + bj * HALF) = w; }
            ss += __shfl_xor(ss, 16); ss += __shfl_xor(ss, 32);
            if (fq == 0) unsafeAtomicAdd(rss + row, ss); }
    }
};

struct EpiWout {
    static constexpr bool PERM = true, AFTER_DRAIN = false, HAS_MID = true;
    const float* X; float* OUT; bf16_t* XB; float* rss_x; const PG8_LAS float* tab;
    __device__ __forceinline__ void mid(f32x4 (&acc)[2][2][4][2], const Unit& u, int wr, int wc, int fr, int fq) const {
        const PG8_LAS float* tp = tab + wr * 64 + fr;
#pragma unroll
        for (int ai = 0; ai < 2; ++ai)
#pragma unroll
            for (int m = 0; m < 4; ++m) { const float ratio = tp[ai * HALF + m * 16];
#pragma unroll
                for (int bj = 0; bj < 2; ++bj)
#pragma unroll
                    for (int n = 0; n < 2; ++n) acc[ai][bj][m][n] *= ratio; }
    }
    __device__ __forceinline__ void operator()(const f32x4 (&acc)[2][2][4][2], const Unit& u, int wr, int wc, int fr, int fq) const {
        const int row0 = u.pm * BM + wr * 64 + fr, col0 = u.pn * BM + wc * 32 + 8 * fq;
        const PG8_LAS float* tp = tab + 256 + wr * 64 + fr;
        f32x4 xq[2][2][2];
#pragma unroll
        for (int bj = 0; bj < 2; ++bj) { const size_t o = (size_t)row0 * 2048 + col0 + bj * HALF; xq[0][bj][0] = *(const f32x4*)(X + o); xq[0][bj][1] = *(const f32x4*)(X + o + 4); }
#pragma unroll
        for (int idx = 0; idx < 8; ++idx) { const int ai = idx >> 2, m = idx & 3, row = row0 + ai * HALF + m * 16; float ss = 0.f;
            if (idx < 7) { const int nrow = row0 + ((idx + 1) >> 2) * HALF + ((idx + 1) & 3) * 16;
#pragma unroll
                for (int bj = 0; bj < 2; ++bj) { const size_t o = (size_t)nrow * 2048 + col0 + bj * HALF; xq[(idx + 1) & 1][bj][0] = *(const f32x4*)(X + o); xq[(idx + 1) & 1][bj][1] = *(const f32x4*)(X + o + 4); } }
            const float rs = tp[ai * HALF + m * 16];
#pragma unroll
            for (int bj = 0; bj < 2; ++bj) { const size_t o = (size_t)row * 2048 + col0 + bj * HALF;
                const f32x4 v0 = xq[idx & 1][bj][0] + rs * acc[ai][bj][m][0], v1 = xq[idx & 1][bj][1] + rs * acc[ai][bj][m][1];
                u32x4 w; w.x = cvt_pk_bf16(v0[0], v0[1]); w.y = cvt_pk_bf16(v0[2], v0[3]); w.z = cvt_pk_bf16(v1[0], v1[1]); w.w = cvt_pk_bf16(v1[2], v1[3]);
                *(u32x4*)(XB + o) = w;
#pragma unroll
                for (int e = 0; e < 4; ++e) ss += v0[e] * v0[e] + v1[e] * v1[e]; }
            ss += __shfl_xor(ss, 16); ss += __shfl_xor(ss, 32);
            if (fq == 0) unsafeAtomicAdd(rss_x + row, ss); }
    }
};

struct EpiScores {
    static constexpr bool PERM = false, AFTER_DRAIN = false, HAS_MID = false;
    float* C; const float* rss_x;
    __device__ __forceinline__ void mid(f32x4 (&)[2][2][4][2], const Unit&, int, int, int, int) const {}
    __device__ __forceinline__ void operator()(const f32x4 (&acc)[2][2][4][2], const Unit& u, int wr, int wc, int fr, int fq) const {
        const int row0 = u.pm * BM + wr * 64 + fr, col0 = u.pn * BM + wc * 32 + 4 * fq;
        float r2v[8];
#pragma unroll
        for (int idx = 0; idx < 8; ++idx) r2v[idx] = rss_x[row0 + (idx >> 2) * HALF + (idx & 3) * 16];
#pragma unroll
        for (int ai = 0; ai < 2; ++ai)
#pragma unroll
            for (int m = 0; m < 4; ++m) { const int row = row0 + ai * HALF + m * 16;
                const float r2 = __builtin_amdgcn_rsqf(r2v[ai * 4 + m] * (1.f / 2048.f) + 1e-6f);
                float* rowp = C + (size_t)row * 2048 + col0;
#pragma unroll
                for (int bj = 0; bj < 2; ++bj)
#pragma unroll
                    for (int n = 0; n < 2; ++n) *(f32x4*)(rowp + bj * HALF + n * 16) = acc[ai][bj][m][n] * r2; }
    }
};

template <class Epi, class Sched, bool STAMP = false>
__device__ __forceinline__ void gemm_phase(PG8_LAS unsigned char* lds, const Gemm g, const Sched& S, const Epi& E, unsigned long long* stamps) {
    const int tid = threadIdx.x, wid = __builtin_amdgcn_readfirstlane(tid >> 6), lane = tid & 63, wr = wid >> 2, wc = wid & 3, fr = lane & 15, fq = lane >> 4;
    const int K = g.K, nt = K / BK;
    int ts_lo = 0, ts_hi = 0, nts = 0; const unsigned long long rt_entry = STAMP ? (unsigned long long)wall_clock64() : 0ull;
#define PG8_STAMP() do { if (STAMP && wid == 0 && nts < 64) { const unsigned long long _c = (unsigned long long)clock64(); \
        ts_lo = (lane == nts) ? (int)(unsigned)_c : ts_lo; ts_hi = (lane == nts) ? (int)(unsigned)(_c >> 32) : ts_hi; ++nts; } } while (0)
    PG8_STAMP();
    unsigned voffA[2], voffB[2];
#pragma unroll
    for (int i = 0; i < 2; ++i) { int R, C; stage_rc(tid * 16 + i * 8192, R, C); const int Rb = Epi::PERM ? ((R & ~31) + perm32(R & 31)) : R;
        voffA[i] = (unsigned)(R * K + C) * 2u; voffB[i] = (unsigned)(Rb * K + C) * 2u; }
    const size_t kstep = (size_t)(BK * 2);
    const size_t hstep = (size_t)HALF * K * 2;
    const size_t tstep = 2 * hstep;
    const unsigned ldsw = (unsigned)wid * 1024u;
    const int aoff = lds_byte(wr * 64 + fr, fq * 8), boff = lds_byte(wc * 32 + fr, fq * 8);
#define PG8_SA(b, h) (((b) * 2 + (h)) * HTB)
#define PG8_SB(b, h) ((4 + (b) * 2 + (h)) * HTB)
#define PG8_STAGE(bufoff, gbase, voff) do { _Pragma("unroll") for (int _i = 0; _i < 2; ++_i) \
        __builtin_amdgcn_global_load_lds((const unsigned*)((const char*)(gbase) + (voff)[_i]), (PG8_LAS unsigned*)(lds + (bufoff) + ldsw + _i * 8192), 16, 0, 0); } while (0)
#define PG8_LDA(dst, b, h) do { _Pragma("unroll") for (int m = 0; m < 4; ++m) _Pragma("unroll") for (int k = 0; k < 2; ++k) dst[m][k] = *(const PG8_LAS bf16x8*)(lds + PG8_SA(b, h) + aoff + m * 2048 + k * 1024); } while (0)
#define PG8_LDB(dst, b, h) do { _Pragma("unroll") for (int n = 0; n < 2; ++n) _Pragma("unroll") for (int k = 0; k < 2; ++k) dst[n][k] = *(const PG8_LAS bf16x8*)(lds + PG8_SB(b, h) + boff + n * 2048 + k * 1024); } while (0)
#define PG8_MMA(ai, bj, At, Bt) do { __builtin_amdgcn_s_setprio(1); _Pragma("unroll") for (int m = 0; m < 4; ++m) _Pragma("unroll") for (int n = 0; n < 2; ++n) _Pragma("unroll") for (int k = 0; k < 2; ++k) \
        acc[ai][bj][m][n] = __builtin_amdgcn_mfma_f32_16x16x32_bf16(Bt[n][k], At[m][k], acc[ai][bj][m][n], 0, 0, 0); __builtin_amdgcn_s_setprio(0); } while (0)
#define PG8_WAIT_V(n) asm volatile("s_waitcnt vmcnt(" #n ")" ::: "memory")
#define PG8_WAIT_L(n) asm volatile("s_waitcnt lgkmcnt(" #n ")" ::: "memory")
#define PG8_BAR __builtin_amdgcn_s_barrier()
#define PG8_SCHED __builtin_amdgcn_sched_barrier(0)
    Unit cur, nxt; int ui = 0;
    if (!S.next(0, cur)) return;
    f32x4 acc[2][2][4][2];
#pragma unroll
    for (int a = 0; a < 2; ++a)
#pragma unroll
        for (int b = 0; b < 2; ++b)
#pragma unroll
            for (int m = 0; m < 4; ++m)
#pragma unroll
                for (int n = 0; n < 2; ++n) acc[a][b][m][n] = (f32x4){0.f, 0.f, 0.f, 0.f};
    bf16x8 At[4][2], B0[2][2], B1[2][2];
    const char* cA = (const char*)g.A + (size_t)cur.pm * tstep; const char* cB = (const char*)g.Bt + (size_t)cur.pn * tstep;
    S.a_ready(cur);
    PG8_STAGE(PG8_SB(0, 0), cB, voffB); PG8_STAGE(PG8_SA(0, 0), cA, voffA); PG8_STAGE(PG8_SB(0, 1), cB + hstep, voffB); PG8_STAGE(PG8_SA(0, 1), cA + hstep, voffA);
    if (wr == 1) PG8_BAR;
    PG8_WAIT_V(4); PG8_BAR;
    PG8_STAGE(PG8_SB(1, 0), cB + kstep, voffB); PG8_STAGE(PG8_SA(1, 0), cA + kstep, voffA); PG8_STAGE(PG8_SB(1, 1), cB + hstep + kstep, voffB);
    PG8_WAIT_V(6); PG8_BAR;
    PG8_STAMP();
    for (;;) {
        const bool has_next = S.next(ui + 1, nxt);
        const char* nA = has_next ? (const char*)g.A + (size_t)nxt.pm * tstep : cA; const char* nB = has_next ? (const char*)g.Bt + (size_t)nxt.pn * tstep : cB;
        for (int t = 0; t < nt; t += 2) {
            const bool last = (t == nt - 2);
            const char* a1 = cA + (size_t)(t + 1) * kstep;
            const char* a2 = last ? nA : cA + (size_t)(t + 2) * kstep; const char* b2 = last ? nB : cB + (size_t)(t + 2) * kstep;
            const char* a3 = a2 + kstep; const char* b3 = b2 + kstep;
            if (last && has_next) S.a_ready(nxt);
            if constexpr (Epi::HAS_MID) { if (t == (nt >> 1)) { E.mid(acc, cur, wr, wc, fr, fq); asm volatile("s_waitcnt lgkmcnt(0)" ::: "memory"); } }
            PG8_LDB(B0, 0, 0); PG8_SCHED; PG8_LDA(At, 0, 0); PG8_STAGE(PG8_SA(1, 1), a1 + hstep, voffA);
            PG8_WAIT_L(8); PG8_BAR; PG8_WAIT_L(0); PG8_MMA(0, 0, At, B0); PG8_BAR; PG8_SCHED;
            PG8_LDB(B1, 0, 1); PG8_STAGE(PG8_SB(0, 0), b2, voffB);
            PG8_BAR; PG8_WAIT_L(0); PG8_MMA(0, 1, At, B1); PG8_BAR;
            PG8_LDA(At, 0, 1); PG8_STAGE(PG8_SA(0, 0), a2, voffA);
            PG8_BAR; PG8_WAIT_L(0); PG8_MMA(1, 0, At, B0); PG8_BAR; PG8_SCHED;
            PG8_STAGE(PG8_SB(0, 1), b2 + hstep, voffB);
            PG8_WAIT_V(6); PG8_BAR; PG8_MMA(1, 1, At, B1); PG8_BAR;
            PG8_LDB(B0, 1, 0); PG8_SCHED; PG8_LDA(At, 1, 0); PG8_STAGE(PG8_SA(0, 1), a2 + hstep, voffA);
            PG8_WAIT_L(8); PG8_BAR; PG8_WAIT_L(0); PG8_MMA(0, 0, At, B0); PG8_BAR; PG8_SCHED;
            PG8_LDB(B1, 1, 1); PG8_STAGE(PG8_SB(1, 0), b3, voffB);
            PG8_BAR; PG8_WAIT_L(0); PG8_MMA(0, 1, At, B1); PG8_BAR;
            PG8_LDA(At, 1, 1); PG8_STAGE(PG8_SA(1, 0), a3, voffA);
            PG8_BAR; PG8_WAIT_L(0); PG8_MMA(1, 0, At, B0); PG8_BAR; PG8_SCHED;
            PG8_STAGE(PG8_SB(1, 1), b3 + hstep, voffB);
            PG8_WAIT_V(6); PG8_BAR; PG8_MMA(1, 1, At, B1); PG8_BAR;
        }
        PG8_STAMP();
        if constexpr (!Epi::AFTER_DRAIN) { E(acc, cur, wr, wc, fr, fq); S.done(cur); }
        PG8_STAMP();
        if (!has_next) break;
#pragma unroll
        for (int a = 0; a < 2; ++a)
#pragma unroll
            for (int b = 0; b < 2; ++b)
#pragma unroll
                for (int m = 0; m < 4; ++m)
#pragma unroll
                    for (int n = 0; n < 2; ++n) acc[a][b][m][n] = (f32x4){0.f, 0.f, 0.f, 0.f};
        cur = nxt; cA = nA; cB = nB; ++ui;
    }
    PG8_WAIT_V(0);
    if (wr == 0) PG8_BAR;
    PG8_BAR;
    if constexpr (Epi::AFTER_DRAIN) { E.fused(acc, cur, wr, wc, fr, fq, lds, wid, lane); S.done(cur); }
    PG8_STAMP();
    if (STAMP && wid == 0) { stamps[lane] = lane < nts ? (((unsigned long long)(unsigned)ts_hi << 32) | (unsigned)ts_lo) : 0ull;
        if (lane == 62) stamps[62] = rt_entry; if (lane == 63) stamps[63] = (unsigned long long)wall_clock64(); }
#undef PG8_STAMP
#undef PG8_SA
#undef PG8_SB
#undef PG8_STAGE
#undef PG8_LDA
#undef PG8_LDB
#undef PG8_MMA
#undef PG8_WAIT_V
#undef PG8_WAIT_L
#undef PG8_BAR
#undef PG8_SCHED
}
}

typedef short bf16x8 __attribute__((ext_vector_type(8)));
typedef float f32x4 __attribute__((ext_vector_type(4)));
typedef unsigned u32x4 __attribute__((ext_vector_type(4)));
using pg8::cvt_pk_bf16; using pg8::bflo; using pg8::bfhi;

#define LDS_WAIT() asm volatile("s_waitcnt lgkmcnt(0)" ::: "memory")
#define CBAR() asm volatile("" ::: "memory")
#define MFMA16(a, b, c) __builtin_amdgcn_mfma_f32_16x16x32_bf16((a), (b), (c), 0, 0, 0)

struct Args { const float* in[25]; float* out; unsigned char* ws; int ph_lo, ph_hi; };

__device__ __forceinline__ float wave_sum(float v) {
#pragma unroll
    for (int o = 1; o < 64; o <<= 1) v += __shfl_xor(v, o);
    return v;
}
__device__ __forceinline__ float wave_max(float v) {
#pragma unroll
    for (int o = 1; o < 64; o <<= 1) v = fmaxf(v, __shfl_xor(v, o));
    return v;
}
__device__ __forceinline__ float gelu_erf(float x) { return 0.5f * x * (1.0f + erff(x * 0.70710678118654752f)); }
__device__ __forceinline__ float gelu_as(float v) {
    const float av = fabsf(v), t = __builtin_amdgcn_rcpf(fmaf(av, 0.2316418882f, 1.0f));
    float q = fmaf(t, 0.5307027145f, -0.7265760135f); q = fmaf(q, t, 0.7107068705f); q = fmaf(q, t, -0.142248368f); q = fmaf(q, t, 0.127414796f); q *= t;
    const float e = __builtin_amdgcn_exp2f(v * v * -0.72134752044f), m = v * (q * e);
    return v < 0.f ? m : v - m;
}
__device__ __forceinline__ bf16x8 as_bf16x8(u32x4 v) { return __builtin_bit_cast(bf16x8, v); }

__device__ __forceinline__ void p0_transpose_item(const float* W, int K, int N, bf16_t* WT, const float* sc_a, const float* sc_b, LAS float* scr, int item, int lane) {
    const int nblk = N / 32, kb = item / nblk, nb = item % nblk, k0 = 64 * kb, n0 = 32 * nb;
#pragma unroll 8
    for (int i = 0; i < 32; ++i) { const int kk = 2 * i + (lane >> 5); const int k = k0 + kk;
        const float s = sc_a ? (k < 1024 ? sc_a[k] : sc_b[k - 1024]) : 1.f;
        scr[kk * 33 + (lane & 31)] = W[(size_t)k * N + n0 + (lane & 31)] * s; }
    LDS_WAIT();
    const int c = lane & 7;
#pragma unroll
    for (int j = 0; j < 4; ++j) { const int n = (lane >> 3) + 8 * j; const LAS float* s = scr + (8 * c) * 33 + n;
        u32x4 o; o.x = cvt_pk_bf16(s[0 * 33], s[1 * 33]); o.y = cvt_pk_bf16(s[2 * 33], s[3 * 33]); o.z = cvt_pk_bf16(s[4 * 33], s[5 * 33]); o.w = cvt_pk_bf16(s[6 * 33], s[7 * 33]);
        *(u32x4*)(WT + (size_t)(n0 + n) * K + k0 + 8 * c) = o; }
    LDS_WAIT();
}
template <int MODE> __device__ __forceinline__ void p0_row(const float* xrow, const float* g, bf16_t* orow, int lane) {
    const f32x4* xr = (const f32x4*)xrow + lane; const f32x4* gr = (const f32x4*)g + lane;
    f32x4 v[8]; float s = 0.f;
#pragma unroll
    for (int j = 0; j < 8; ++j) { v[j] = xr[64 * j]; s += (v[j].x * v[j].x + v[j].y * v[j].y) + (v[j].z * v[j].z + v[j].w * v[j].w); }
    float r = 1.f;
    if (MODE == 0) r = 1.0f / sqrtf(wave_sum(s) * (1.f / 2048.f) + EPS);
    u32x2* o8 = (u32x2*)orow + lane;
#pragma unroll
    for (int j = 0; j < 8; ++j) { f32x4 w = v[j] * r; if (MODE != 2) w = w * gr[64 * j];
        u32x2 o; o.x = cvt_pk_bf16(w.x, w.y); o.y = cvt_pk_bf16(w.z, w.w); o8[64 * j] = o; }
}
template <bool SCALE_G, bool OFFS> __device__ __forceinline__ void p0_row_q8(const float* xrow, const float* g, unsigned char* orow, float* sc, int lane) {
    const f32x4* xr = (const f32x4*)xrow + lane; const f32x4* gr = (const f32x4*)g + lane;
    f32x4 v[8]; float m = 0.f;
#pragma unroll
    for (int j = 0; j < 8; ++j) { v[j] = xr[64 * j]; if (SCALE_G) v[j] = v[j] * gr[64 * j];
        m = fmaxf(fmaxf(m, fmaxf(fabsf(v[j].x), fabsf(v[j].y))), fmaxf(fabsf(v[j].z), fabsf(v[j].w))); }
    m = fmaxf(wave_max(m), 1e-30f);
    const float inv = 127.f / m;
    if (lane == 0) *sc = m * (1.f / 127.f);
    unsigned* o4 = (unsigned*)orow + lane;
#pragma unroll
    for (int j = 0; j < 8; ++j) { const int a = (int)rintf(v[j].x * inv) + (OFFS ? 128 : 0), b = (int)rintf(v[j].y * inv) + (OFFS ? 128 : 0), c = (int)rintf(v[j].z * inv) + (OFFS ? 128 : 0), d = (int)rintf(v[j].w * inv) + (OFFS ? 128 : 0);
        o4[64 * j] = (unsigned)(a & 255) | ((unsigned)(b & 255) << 8) | ((unsigned)(c & 255) << 16) | ((unsigned)(d & 255) << 24); }
}
template <int KIND> __device__ __forceinline__ void p0_rows(const float* src, const float* g, void* dst, float* sc, int first, int stride, int nrows, int lane) {
    const f32x4* gr = (const f32x4*)g + lane;
    f32x4 cur[8], nxt[8], nx2[8];
    int r = first;
    if (r >= nrows) return;
    { const f32x4* xr = (const f32x4*)(src + (size_t)r * 2048) + lane;
#pragma unroll
        for (int j = 0; j < 8; ++j) cur[j] = xr[64 * j]; }
    if (r + stride < nrows) { const f32x4* xr = (const f32x4*)(src + (size_t)(r + stride) * 2048) + lane;
#pragma unroll
        for (int j = 0; j < 8; ++j) nxt[j] = xr[64 * j]; }
    for (; r < nrows; r += stride) {
        const int rn = r + 2 * stride;
        if (rn < nrows) { const f32x4* xr = (const f32x4*)(src + (size_t)rn * 2048) + lane;
#pragma unroll
            for (int j = 0; j < 8; ++j) nx2[j] = xr[64 * j]; }
        if (KIND == 0) {
            float s = 0.f;
#pragma unroll
            for (int j = 0; j < 8; ++j) s += (cur[j].x * cur[j].x + cur[j].y * cur[j].y) + (cur[j].z * cur[j].z + cur[j].w * cur[j].w);
            const float rr = 1.0f / sqrtf(wave_sum(s) * (1.f / 2048.f) + EPS);
            u32x2* o8 = (u32x2*)((bf16_t*)dst + (size_t)r * 2048) + lane;
#pragma unroll
            for (int j = 0; j < 8; ++j) { const f32x4 w = cur[j] * rr * gr[64 * j]; u32x2 o; o.x = cvt_pk_bf16(w.x, w.y); o.y = cvt_pk_bf16(w.z, w.w); o8[64 * j] = o; }
        } else if (KIND >= 3) {
            float ssq = 0.f;
#pragma unroll
            for (int j = 0; j < 8; ++j) { if (KIND == 3) cur[j] = cur[j] * gr[64 * j]; ssq += (cur[j].x * cur[j].x + cur[j].y * cur[j].y) + (cur[j].z * cur[j].z + cur[j].w * cur[j].w); }
            const float rms = sqrtf(fmaxf(wave_sum(ssq) * (1.f / 2048.f), 1e-30f));
            const float sq = 0.1676f * rms, inv = 0.5f / sq;
            if (lane == 0) sc[r] = sq;
            unsigned* o4 = (unsigned*)((unsigned char*)dst + (size_t)r * 1024) + lane;
#pragma unroll
            for (int j = 0; j < 4; ++j) { unsigned w = 0u;
#pragma unroll
                for (int e = 0; e < 4; ++e) { const float lo = cur[j][e], hi = cur[j + 4][e];
                    int nl = (int)rintf(fmaf(lo, inv, 7.5f)), nh = (int)rintf(fmaf(hi, inv, 7.5f));
                    nl = nl < 0 ? 0 : (nl > 15 ? 15 : nl); nh = nh < 0 ? 0 : (nh > 15 ? 15 : nh);
                    w |= ((unsigned)nl << (8 * e)) | ((unsigned)nh << (8 * e + 4)); }
                o4[64 * j] = w; }
        } else {
            float m = 0.f;
#pragma unroll
            for (int j = 0; j < 8; ++j) { if (KIND == 1) cur[j] = cur[j] * gr[64 * j];
                m = fmaxf(fmaxf(m, fmaxf(fabsf(cur[j].x), fabsf(cur[j].y))), fmaxf(fabsf(cur[j].z), fabsf(cur[j].w))); }
            m = fmaxf(wave_max(m), 1e-30f);
            const float inv = 127.f / m; const int off = KIND == 2 ? 128 : 0;
            if (lane == 0) sc[r] = m * (1.f / 127.f);
            unsigned* o4 = (unsigned*)((unsigned char*)dst + (size_t)r * 2048) + lane;
#pragma unroll
            for (int j = 0; j < 8; ++j) { const int a = (int)rintf(cur[j].x * inv) + off, b = (int)rintf(cur[j].y * inv) + off, c = (int)rintf(cur[j].z * inv) + off, d = (int)rintf(cur[j].w * inv) + off;
                o4[64 * j] = (unsigned)(a & 255) | ((unsigned)(b & 255) << 8) | ((unsigned)(c & 255) << 16) | ((unsigned)(d & 255) << 24); }
        }
#pragma unroll
        for (int j = 0; j < 8; ++j) { cur[j] = nxt[j]; nxt[j] = nx2[j]; }
    }
}
__device__ __forceinline__ void p0_wp_item(const float* wq, const float* keys1, const float* keys2, const float* gffn, bf16_t* WPT, int item, int lane) {
    const int hj = item >> 7, ib = item & 127, h = hj >> 1, j = hj & 1, i0 = 16 * ib, col0 = h * 256 + j * 128;
    const int lr = lane & 15, g = lane >> 4;
    const float* keys = (j ? keys2 : keys1) + (size_t)h * 128 * 128;
    const float gi = gffn[i0 + lr];
    bf16x8 af[4];
#pragma unroll
    for (int s = 0; s < 4; ++s) { const float* p = wq + (size_t)(i0 + lr) * 2048 + col0 + 32 * s + 8 * g;
        const f32x4 a = *(const f32x4*)p * gi, b = *(const f32x4*)(p + 4) * gi;
        u32x4 w; w.x = cvt_pk_bf16(a.x, a.y); w.y = cvt_pk_bf16(a.z, a.w); w.z = cvt_pk_bf16(b.x, b.y); w.w = cvt_pk_bf16(b.z, b.w); af[s] = as_bf16x8(w); }
    for (int kt = 0; kt < 8; ++kt) {
        f32x4 d = {0.f, 0.f, 0.f, 0.f};
#pragma unroll
        for (int s = 0; s < 4; ++s) { const float* p = keys + (size_t)(16 * kt + lr) * 128 + 32 * s + 8 * g;
            const f32x4 a = *(const f32x4*)p, b = *(const f32x4*)(p + 4);
            u32x4 w; w.x = cvt_pk_bf16(a.x, a.y); w.y = cvt_pk_bf16(a.z, a.w); w.z = cvt_pk_bf16(b.x, b.y); w.w = cvt_pk_bf16(b.z, b.w);
            d = MFMA16(af[s], as_bf16x8(w), d); }
        u32x2 o; o.x = cvt_pk_bf16(d[0], d[1]); o.y = cvt_pk_bf16(d[2], d[3]);
        *(u32x2*)(WPT + (size_t)(hj * 128 + 16 * kt + lr) * 2048 + i0 + 4 * g) = o;
    }
}
__device__ __forceinline__ int t5_bucket(int n) {
    if (n < 16) return n;
    const int large = 16 + (int)(logf((float)n / 16.f) / 4.852030263919617f * 16.f);
    return large < 31 ? large : 31;
}
__device__ __forceinline__ void p0_ssm_item(const Args& A, unsigned char* sp, int g, int lane) {
    const float* lam_re = A.in[6]; const float* lam_im = A.in[7]; const float* log_dt = A.in[8];
    const float* b_re = A.in[9]; const float* b_im = A.in[10]; const float* c_re = A.in[11]; const float* c_im = A.in[12];
    const int n = lane;
    const float dt = expf(log_dt[g]);
    const float lr = lam_re[g * 64 + n], li = lam_im[g * 64 + n];
    const float mag = expf(lr * dt);
    const float a_re = mag * cosf(li * dt), a_im = mag * sinf(li * dt);
    const float den = lr * lr + li * li;
    const float f_re = ((a_re - 1.f) * lr + a_im * li) / den, f_im = (a_im * lr - (a_re - 1.f) * li) / den;
    ((f32x2*)(sp + SSMP_ABAR))[g * 64 + n] = (f32x2){a_re, a_im};
    float pr = a_re, pi = a_im;
#pragma unroll
    for (int i = 0; i < 8; ++i) { const float nr = pr * pr - pi * pi, ni = 2.f * pr * pi; pr = nr; pi = ni; }
    ((f32x2*)(sp + SSMP_A256))[g * 64 + n] = (f32x2){pr, pi};
    float bbr[16], bbi[16];
#pragma unroll
    for (int q = 0; q < 4; ++q) { const f32x4 br = *(const f32x4*)(b_re + (size_t)(g * 64 + n) * 16 + 4 * q), bi = *(const f32x4*)(b_im + (size_t)(g * 64 + n) * 16 + 4 * q);
#pragma unroll
        for (int e = 0; e < 4; ++e) { bbr[4 * q + e] = f_re * br[e] - f_im * bi[e]; bbi[4 * q + e] = f_re * bi[e] + f_im * br[e]; } }
    bf16_t* bf = (bf16_t*)(sp + SSMP_BFRAG);
    const int jre = n >> 4, n16 = n & 15;
#pragma unroll
    for (int kg = 0; kg < 4; ++kg) {
        u32x4 wr = {0u, 0u, 0u, 0u}, wi = {0u, 0u, 0u, 0u};
        if (kg < 2) { const int c0 = (kg & 1) * 8;
            wr.x = cvt_pk_bf16(bbr[c0 + 0], bbr[c0 + 1]); wr.y = cvt_pk_bf16(bbr[c0 + 2], bbr[c0 + 3]); wr.z = cvt_pk_bf16(bbr[c0 + 4], bbr[c0 + 5]); wr.w = cvt_pk_bf16(bbr[c0 + 6], bbr[c0 + 7]);
            wi.x = cvt_pk_bf16(bbi[c0 + 0], bbi[c0 + 1]); wi.y = cvt_pk_bf16(bbi[c0 + 2], bbi[c0 + 3]); wi.z = cvt_pk_bf16(bbi[c0 + 4], bbi[c0 + 5]); wi.w = cvt_pk_bf16(bbi[c0 + 6], bbi[c0 + 7]); }
        *(u32x4*)(bf + ((size_t)(g * 8 + jre) * 64 + kg * 16 + n16) * 8) = wr;
        *(u32x4*)(bf + ((size_t)(g * 8 + 4 + jre) * 64 + kg * 16 + n16) * 8) = wi;
    }
    bf16_t* cf = (bf16_t*)(sp + SSMP_CFRAG);
    const int ch = lane & 15, kg = lane >> 4;
#pragma unroll
    for (int s = 0; s < 4; ++s) { const int k0 = 32 * s + 8 * kg;
        const float* src = (k0 < 64) ? (c_re + (size_t)(g * 16 + ch) * 64 + k0) : (c_im + (size_t)(g * 16 + ch) * 64 + (k0 - 64));
        const float sg = (k0 < 64) ? 1.f : -1.f;
        const f32x4 a = *(const f32x4*)src * sg, b = *(const f32x4*)(src + 4) * sg;
        u32x4 w; w.x = cvt_pk_bf16(a.x, a.y); w.y = cvt_pk_bf16(a.z, a.w); w.z = cvt_pk_bf16(b.x, b.y); w.w = cvt_pk_bf16(b.z, b.w);
        *(u32x4*)(cf + ((size_t)(g * 4 + s) * 64 + lane) * 8) = w; }
}
__device__ __forceinline__ void p0_btab_item(const Args& A, float* btab, int item, int lane) {
    const float* gq = A.in[3]; const float* gk = A.in[4]; const float* rel_bias = A.in[5];
    const int h = item / 3, br = item % 3, d = br == 0 ? 1 : (br == 1 ? 4 : 16);
    const float G = wave_max(fabsf(gq[lane] * gk[lane]));
    const float mb = wave_max(lane < 32 ? rel_bias[lane * 16 + h] : -1e30f);
    const float smax = 8.4f * G + mb;
    for (int idx = lane; idx < 192; idx += 64) { const int rel = idx - 31;
        float v = -1e30f;
        if (rel >= 0 && rel <= 128) v = LOG2E * (rel_bias[t5_bucket(rel * d) * 16 + h] - smax);
        btab[(h * 3 + br) * 192 + idx] = v; }
}

__device__ __forceinline__ void p0_prologue(const Args& A, LAS unsigned char* lds, int wave, int lane) {
    unsigned char* ws = A.ws;
    LAS float* scr = (LAS float*)(lds + wave * 16384);
    const int gw = blockIdx.x * 8 + wave, NGW = gridDim.x * 8;
    constexpr int I_WIN = (2048 / 64) * (4096 / 32), I_GLU = (1024 / 64) * (1024 / 32), I_WOUT = (2048 / 64) * (2048 / 32), I_WP = 2048;
    constexpr int I_SSM = 64, I_BT = 48;
    constexpr int NITEMS = I_WIN + I_GLU + I_WOUT + I_WP + I_SSM + I_BT;
    for (int it = gw; it < NITEMS; it += NGW) {
        int r = it;
        if (r < I_SSM) { p0_ssm_item(A, ws + WS_SSMP, r, lane); continue; } r -= I_SSM;
        if (r < I_BT) { p0_btab_item(A, (float*)(ws + WS_BTAB), r, lane); continue; } r -= I_BT;
        if (r < I_WP) { p0_wp_item(A.in[20], A.in[21], A.in[22], A.in[19], (bf16_t*)(ws + WS_WPT), r, lane); continue; } r -= I_WP;
        if (r < I_WIN) { p0_transpose_item(A.in[2], 2048, 4096, (bf16_t*)(ws + WS_WINT), nullptr, nullptr, scr, r, lane); continue; } r -= I_WIN;
        if (r < I_GLU) { p0_transpose_item(A.in[14], 1024, 1024, (bf16_t*)(ws + WS_GLUT), nullptr, nullptr, scr, r, lane); continue; } r -= I_GLU;
        p0_transpose_item(A.in[18], 2048, 2048, (bf16_t*)(ws + WS_WOUTT), A.in[16], A.in[17], scr, r, lane);
    }
    p0_rows<0>(A.in[0], A.in[1], ws + WS_HB, nullptr, gw, NGW, 8192, lane);
    p0_rows<3>(A.in[23], A.in[19], ws + WS_UB, (float*)(ws + WS_SU), gw, NGW, 16384, lane);
    p0_rows<4>(A.in[24], A.in[19], ws + WS_VB, (float*)(ws + WS_SV), gw, NGW, 16384, lane);
}

constexpr int SSM_WL = 8192 + 16 * 272 + 512;
__device__ __forceinline__ void ssm_unit(const Args& A, LAS unsigned char* lds, int b, int g, int wave, int lane) {
    unsigned char* ws = A.ws; unsigned char* sp = ws + WS_SSMP;
    const bf16_t* proj = (const bf16_t*)(ws + WS_PROJ); bf16_t* yb = (bf16_t*)(ws + WS_YB);
    LAS unsigned char* wl = lds + wave * SSM_WL;
    LAS f32x2* BU = (LAS f32x2*)wl; LAS unsigned char* XB = wl + 8192; LAS unsigned char* UL = wl + 8192 + 16 * 272;
    LAS f32x2* carry = (LAS f32x2*)(lds + 8 * SSM_WL);
    const int lr = lane & 15, q = lane >> 4;
    bf16x8 bfr[8], cfr[4];
#pragma unroll
    for (int j = 0; j < 8; ++j) bfr[j] = as_bf16x8(*(const u32x4*)((const bf16_t*)(sp + SSMP_BFRAG) + ((size_t)(g * 8 + j) * 64 + lane) * 8));
#pragma unroll
    for (int s = 0; s < 4; ++s) cfr[s] = as_bf16x8(*(const u32x4*)((const bf16_t*)(sp + SSMP_CFRAG) + ((size_t)(g * 4 + s) * 64 + lane) * 8));
    const f32x2 ab = ((const f32x2*)(sp + SSMP_ABAR))[g * 64 + lane], a256 = ((const f32x2*)(sp + SSMP_A256))[g * 64 + lane];
    const float a_re = ab.x, a_im = ab.y;
    const float dsk = A.in[13][g * 16 + lr];
    const bf16_t* up = proj + (size_t)(b * SEQ + wave * 256) * DPROJ + 3072 + g * 16;
    float xr = 0.f, xi = 0.f;
    for (int pass = 0; pass < 2; ++pass) {
        u32x4 unext = {0u, 0u, 0u, 0u};
        if (q < 2) unext = *(const u32x4*)(up + (size_t)lr * DPROJ + 8 * q);
        for (int blk = 0; blk < 16; ++blk) {
            const u32x4 uraw = unext;
            if (q < 2 && blk < 15) unext = *(const u32x4*)(up + (size_t)((blk + 1) * 16 + lr) * DPROJ + 8 * q);
            const bf16x8 ua = as_bf16x8(uraw);
            if (pass == 1 && q < 2) *(LAS u32x4*)(UL + lr * 32 + q * 16) = uraw;
            f32x4 dd[8];
#pragma unroll
            for (int j = 0; j < 8; ++j) dd[j] = MFMA16(ua, bfr[j], ((f32x4){0.f, 0.f, 0.f, 0.f}));
#pragma unroll
            for (int jj = 0; jj < 4; ++jj)
#pragma unroll
                for (int r = 0; r < 4; ++r) BU[(4 * q + r) * 64 + 16 * jj + lr] = (f32x2){dd[jj][r], dd[4 + jj][r]};
            CBAR();
            f32x2 bu[16];
#pragma unroll
            for (int t = 0; t < 16; ++t) bu[t] = BU[t * 64 + lane];
            if (pass == 0) {
#pragma unroll
                for (int t = 0; t < 16; ++t) { float nr = fmaf(a_re, xr, fmaf(-a_im, xi, bu[t].x)), ni = fmaf(a_re, xi, fmaf(a_im, xr, bu[t].y)); asm volatile("" : "+v"(nr)); asm volatile("" : "+v"(ni)); xr = nr; xi = ni; }
                asm volatile("" : "+v"(xr), "+v"(xi) :: "memory");
            } else {
#pragma unroll
                for (int t = 0; t < 16; ++t) { float nr = fmaf(a_re, xr, fmaf(-a_im, xi, bu[t].x)), ni = fmaf(a_re, xi, fmaf(a_im, xr, bu[t].y)); asm volatile("" : "+v"(nr)); asm volatile("" : "+v"(ni)); xr = nr; xi = ni;
                    const unsigned pk = cvt_pk_bf16(xr, xi);
                    *(LAS unsigned short*)(XB + t * 272 + lane * 2) = (unsigned short)(pk & 0xffffu);
                    *(LAS unsigned short*)(XB + t * 272 + 128 + lane * 2) = (unsigned short)(pk >> 16); }
                CBAR();
                f32x4 y = {0.f, 0.f, 0.f, 0.f};
#pragma unroll
                for (int s = 0; s < 4; ++s) { const bf16x8 xa = as_bf16x8(*(const LAS u32x4*)(XB + lr * 272 + (32 * s + 8 * q) * 2)); y = MFMA16(xa, cfr[s], y); }
#pragma unroll
                for (int r = 0; r < 4; ++r) { const int t = blk * 16 + 4 * q + r;
                    const float uv = __uint_as_float((unsigned)(*(const LAS unsigned short*)(UL + (4 * q + r) * 32 + lr * 2)) << 16);
                    const float yv = gelu_as(y[r] + dsk * uv);
                    yb[(size_t)(b * SEQ + wave * 256 + t) * 1024 + g * 16 + lr] = (bf16_t)(cvt_pk_bf16(yv, 0.f) & 0xffffu); }
                asm volatile("" : "+v"(xr), "+v"(xi) :: "memory");
            }
        }
        if (pass == 0) {
            carry[wave * 64 + lane] = (f32x2){xr, xi};
            __syncthreads();
            float sr = 0.f, si = 0.f;
            for (int w2 = 0; w2 < wave; ++w2) { const f32x2 e = carry[w2 * 64 + lane]; const float nr = a256.x * sr - a256.y * si + e.x, ni = a256.x * si + a256.y * sr + e.y; sr = nr; si = ni; }
            xr = sr; xi = si;
        }
    }
    __syncthreads();
}

__device__ __forceinline__ void prep2_item(const Args& A, LAS unsigned char* wl, int item, int lane) {
    unsigned char* ws = A.ws;
    const bf16_t* proj = (const bf16_t*)(ws + WS_PROJ);
    const int pb = item & 31, h = (item >> 5) & 15, b = item >> 9, P0 = pb * 64, bh = b * 16 + h;
    const int r8 = lane >> 3, c = lane & 7;
    const float* gq = A.in[3]; const float* gk = A.in[4];
    const int fs = c >> 2, fg = c & 3;
#pragma unroll 1
    for (int which = 0; which < 2; ++which) {
        const float* gv = which ? gk : gq; const float cs = which ? 1.f : (LOG2E * 0.125f);
        float gl[8];
#pragma unroll
        for (int e = 0; e < 8; ++e) gl[e] = gv[8 * c + e] * cs;
        bf16_t* F = (bf16_t*)(ws + (which ? WS_KF : WS_QF));
#pragma unroll 2
        for (int i = 0; i < 8; ++i) { const int row = 8 * i + r8, pos = P0 + row;
            const u32x4 raw = *(const u32x4*)(proj + (size_t)(b * SEQ + pos) * DPROJ + which * 1024 + h * 64 + 8 * c);
            float v[8] = {bflo(raw.x), bfhi(raw.x), bflo(raw.y), bfhi(raw.y), bflo(raw.z), bfhi(raw.z), bflo(raw.w), bfhi(raw.w)};
            float ss = 0.f;
#pragma unroll
            for (int e = 0; e < 8; ++e) ss += v[e] * v[e];
            ss += __shfl_xor(ss, 1); ss += __shfl_xor(ss, 2); ss += __shfl_xor(ss, 4);
            const float r = 1.0f / sqrtf(ss * (1.f / 64.f) + EPS);
            u32x4 w; w.x = cvt_pk_bf16(v[0] * r * gl[0], v[1] * r * gl[1]); w.y = cvt_pk_bf16(v[2] * r * gl[2], v[3] * r * gl[3]);
            w.z = cvt_pk_bf16(v[4] * r * gl[4], v[5] * r * gl[5]); w.w = cvt_pk_bf16(v[6] * r * gl[6], v[7] * r * gl[7]);
#pragma unroll
            for (int br = 0; br < 3; ++br) { const int sh = 2 * br, rr = pos & ((1 << sh) - 1), l = pos >> sh;
                *(u32x4*)(F + (size_t)br * 4 * 16 * SEQ * 64 + ((((size_t)(bh << sh) + rr) * (SEQ >> (sh + 4)) + (l >> 4)) * 2 + fs) * 512 + (fg * 16 + (l & 15)) * 8) = w; } }
    }
#pragma unroll
    for (int i = 0; i < 8; ++i) { const int row = 8 * i + r8;
        const u32x4 raw = *(const u32x4*)(proj + (size_t)(b * SEQ + P0 + row) * DPROJ + 2048 + h * 64 + 8 * c);
        *(LAS u32x2*)(wl + row * 136 + c * 16) = (u32x2){raw.x, raw.y}; *(LAS u32x2*)(wl + row * 136 + c * 16 + 8) = (u32x2){raw.z, raw.w}; }
    CBAR();
    unsigned v[64];
#pragma unroll
    for (int p = 0; p < 64; ++p) v[p] = *(const LAS unsigned short*)(wl + p * 136 + lane * 2);
    CBAR();
    bf16_t* vt = (bf16_t*)(ws + WS_VT);
    const int nt = lane >> 4, dl = lane & 15;
#pragma unroll
    for (int G = 0; G < 2; ++G) { bf16_t* tp = vt + ((((size_t)bh * 64 + (P0 >> 5) + G) * 4 + nt) * 64 + dl) * 8;
#pragma unroll
        for (int kg = 0; kg < 4; ++kg) { const int a0 = 32 * G + 4 * kg, b0 = 32 * G + 16 + 4 * kg;
            u32x4 w; w.x = v[a0] | (v[a0 + 1] << 16); w.y = v[a0 + 2] | (v[a0 + 3] << 16); w.z = v[b0] | (v[b0 + 1] << 16); w.w = v[b0 + 2] | (v[b0 + 3] << 16);
            *(u32x4*)(tp + kg * 128) = w; } }
    { bf16_t* vt4 = vt + (size_t)4 * 16 * 64 * SEQ; const int l0 = P0 >> 2, tile = (l0 >> 4) & 1, grp = l0 >> 5;
#pragma unroll
        for (int r = 0; r < 4; ++r) { bf16_t* tp = vt4 + (((((size_t)bh * 4 + r) * 16 + grp) * 4 + nt) * 64 + dl) * 8;
#pragma unroll
            for (int kg = 0; kg < 4; ++kg) { const int p0 = 4 * (4 * kg) + r;
                u32x2 w; w.x = v[p0] | (v[p0 + 4] << 16); w.y = v[p0 + 8] | (v[p0 + 12] << 16);
                *(u32x2*)(tp + kg * 128 + 4 * tile) = w; } } }
    { bf16_t* vt16 = vt + (size_t)2 * 4 * 16 * 64 * SEQ; const int l0 = P0 >> 4, w32 = l0 & 31, tile = (w32 >> 4) & 1, kg = (w32 & 15) >> 2, grp = l0 >> 5;
#pragma unroll
        for (int r = 0; r < 16; ++r) { u32x2 w; w.x = v[r] | (v[16 + r] << 16); w.y = v[32 + r] | (v[48 + r] << 16);
            *(u32x2*)(vt16 + (((((size_t)bh * 16 + r) * 4 + grp) * 4 + nt) * 64 + kg * 16 + dl) * 8 + 4 * tile) = w; } }
}

struct AttnItem { int sh, r, lfirst, ks, tbo; size_t qk_off, v_off; };
__device__ __forceinline__ AttnItem attn_item(int it, int p0, int bh) {
    AttnItem I; const int br = it >> 4, j = it & 15; I.sh = 2 * br; I.tbo = br * 192;
    I.r = j & ((1 << I.sh) - 1); I.lfirst = (p0 >> I.sh) + 16 * (j >> I.sh);
    const size_t rc = (size_t)br * 4 * 16 * SEQ * 64 + ((size_t)(bh << I.sh) + I.r) * (size_t)(SEQ >> I.sh) * 64;
    I.qk_off = rc; I.v_off = rc;
    int ks = (I.lfirst - 128) & ~31; I.ks = ks < 0 ? 0 : ks;
    return I;
}
__device__ __forceinline__ void attn_unit(const Args& A, LAS unsigned char* lds, int unit, int tid, int wave, int lane, int pflags) {
    unsigned char* ws = A.ws;
    const int blk = 7 - (unit >> 6), bh = unit & 63, b = bh >> 4, h = bh & 15, p0 = blk * 256;
    constexpr int OST = 68;
    LAS float* Oacc = (LAS float*)lds; LAS float* lacc = (LAS float*)(lds + 256 * OST * 4); LAS float* tb = (LAS float*)(lds + 256 * OST * 4 + 1024);
    { const float* bt = (const float*)(ws + WS_BTAB) + h * 3 * 192; for (int i = tid; i < 3 * 192; i += 512) tb[i] = bt[i]; }
    __syncthreads();
    const bf16_t* QF = (const bf16_t*)(ws + WS_QF); const bf16_t* KF = (const bf16_t*)(ws + WS_KF); const bf16_t* VF = (const bf16_t*)(ws + WS_VT);
    const int qi = lane & 15, g = lane >> 4;
#define ATT_LOAD(IT, LK, B) do { const AttnItem _I = attn_item(IT, p0, bh); const bf16_t* _kp = KF + _I.qk_off + (size_t)((LK) >> 4) * 1024 + lane * 8; \
        B[0] = *(const u32x4*)(_kp); B[1] = *(const u32x4*)(_kp + 512); B[2] = *(const u32x4*)(_kp + 1024); B[3] = *(const u32x4*)(_kp + 1536); \
        const bf16_t* _vp = VF + _I.v_off + (size_t)((LK) >> 5) * 2048 + lane * 8; \
        B[4] = *(const u32x4*)(_vp); B[5] = *(const u32x4*)(_vp + 512); B[6] = *(const u32x4*)(_vp + 1024); B[7] = *(const u32x4*)(_vp + 1536); \
        const bf16_t* _qp = QF + _I.qk_off + (size_t)(_I.lfirst >> 4) * 1024 + lane * 8; B[8] = *(const u32x4*)(_qp); B[9] = *(const u32x4*)(_qp + 512); } while (0)
#define ATT_ADV(IT, LK, NIT, NLK) do { const AttnItem _J = attn_item(IT, p0, bh); if ((LK) + 32 <= _J.lfirst) { (NIT) = (IT); (NLK) = (LK) + 32; } else { (NIT) = (IT) + 8; (NLK) = 0; if ((NIT) < 48) { const AttnItem _N = attn_item(NIT, p0, bh); (NLK) = _N.ks; } } } while (0)
#define ATT_STEP(CIT, CLK, BC, NIT, NLK, NNIT, NNLK, BNN) { \
        NNIT = 64; NNLK = 0; \
        if ((NIT) < 48) { ATT_ADV(NIT, NLK, NNIT, NNLK); if ((NNIT) < 48) ATT_LOAD(NNIT, NNLK, BNN); } \
        const AttnItem cI = attn_item(CIT, p0, bh); \
        f32x4 sa = {0.f, 0.f, 0.f, 0.f}, sb = {0.f, 0.f, 0.f, 0.f}; \
        sa = MFMA16(as_bf16x8(BC[0]), as_bf16x8(BC[8]), sa); sb = MFMA16(as_bf16x8(BC[2]), as_bf16x8(BC[8]), sb); \
        sa = MFMA16(as_bf16x8(BC[1]), as_bf16x8(BC[9]), sa); sb = MFMA16(as_bf16x8(BC[3]), as_bf16x8(BC[9]), sb); \
        const LAS float* tbb = tb + cI.tbo; \
        const int ba = cI.lfirst + qi - (CLK) - 4 * g + 31; \
        float pa[4], pb[4]; \
        _Pragma("unroll") for (int e = 0; e < 4; ++e) { pa[e] = __builtin_amdgcn_exp2f(sa[e] + tbb[ba - e]); pb[e] = __builtin_amdgcn_exp2f(sb[e] + tbb[ba - 16 - e]); } \
        lsum += (pa[0] + pa[1]) + (pa[2] + pa[3]) + (pb[0] + pb[1]) + (pb[2] + pb[3]); \
        u32x4 pw; pw.x = cvt_pk_bf16(pa[0], pa[1]); pw.y = cvt_pk_bf16(pa[2], pa[3]); pw.z = cvt_pk_bf16(pb[0], pb[1]); pw.w = cvt_pk_bf16(pb[2], pb[3]); \
        const bf16x8 pf = as_bf16x8(pw); \
        _Pragma("unroll") for (int nt = 0; nt < 4; ++nt) o[nt] = MFMA16(pf, as_bf16x8(BC[4 + nt]), o[nt]); \
        if ((CLK) + 32 > cI.lfirst) {     \
            lsum += __shfl_xor(lsum, 16); lsum += __shfl_xor(lsum, 32); \
            const bool first = (CIT) < 16; \
            if (g == 0) { LAS float* lp = lacc + ((((cI.lfirst + qi) << cI.sh) + cI.r) - p0); *lp = first ? lsum : *lp + lsum; } \
            _Pragma("unroll") for (int reg = 0; reg < 4; ++reg) { LAS float* op = Oacc + (((((cI.lfirst + 4 * g + reg) << cI.sh) + cI.r) - p0)) * OST + qi; \
                _Pragma("unroll") for (int nt = 0; nt < 4; ++nt) op[16 * nt] = first ? o[nt][reg] : op[16 * nt] + o[nt][reg]; } \
            _Pragma("unroll") for (int nt = 0; nt < 4; ++nt) o[nt] = (f32x4){0.f, 0.f, 0.f, 0.f}; \
            lsum = 0.f; \
            if (((CIT) >> 3) & 1) __syncthreads();     \
        } \
        if ((NIT) >= 48) break; }
    if (!(pflags & 16)) {
    int itA = wave, lkA, itB, lkB, itC = 64, lkC = 0;
    { const AttnItem I0 = attn_item(wave, p0, bh); lkA = I0.ks; }
    ATT_ADV(itA, lkA, itB, lkB);
    u32x4 bA[10], bB[10], bC[10];
    ATT_LOAD(itA, lkA, bA); if (itB < 48) ATT_LOAD(itB, lkB, bB);
    f32x4 o[4];
#pragma unroll
    for (int nt = 0; nt < 4; ++nt) o[nt] = (f32x4){0.f, 0.f, 0.f, 0.f};
    float lsum = 0.f;
    for (;;) {
        ATT_STEP(itA, lkA, bA, itB, lkB, itC, lkC, bC)
        ATT_STEP(itB, lkB, bB, itC, lkC, itA, lkA, bA)
        ATT_STEP(itC, lkC, bC, itA, lkA, itB, lkB, bB)
    }
    }
#undef ATT_LOAD
#undef ATT_ADV
#undef ATT_STEP
    if (!(pflags & (16 | 32 | 64))) { const int ql = tid >> 1, half = tid & 1; const float inv = 1.0f / lacc[ql];
        bf16_t* dst = (bf16_t*)(ws + WS_MIXED) + (size_t)(b * SEQ + p0 + ql) * 2048 + h * 64 + 32 * half;
        float ss = 0.f;
#pragma unroll
        for (int c4 = 0; c4 < 4; ++c4) { float v[8];
#pragma unroll
            for (int e = 0; e < 8; ++e) { v[e] = Oacc[ql * OST + 32 * half + 8 * c4 + e] * inv; ss += v[e] * v[e]; }
            u32x4 w; w.x = cvt_pk_bf16(v[0], v[1]); w.y = cvt_pk_bf16(v[2], v[3]); w.z = cvt_pk_bf16(v[4], v[5]); w.w = cvt_pk_bf16(v[6], v[7]);
            *(u32x4*)(dst + 8 * c4) = w; }
        ss += __shfl_xor(ss, 1);
        if (half == 0) unsafeAtomicAdd((float*)(ws + WS_CTL + CTL_RSS_ATTN) + b * SEQ + p0 + ql, ss); }
    __syncthreads();
}

__device__ __forceinline__ unsigned fkey(float f) { const unsigned u = __float_as_uint(f); return (u & 0x80000000u) ? ~u : (u | 0x80000000u); }
template <int R> __device__ __forceinline__ void select16(const unsigned (&key)[R], unsigned long long (&m)[R]) {
    unsigned mx = key[0];
#pragma unroll
    for (int r = 1; r < R; ++r) mx = key[r] > mx ? key[r] : mx;
#pragma unroll
    for (int o = 1; o < 64; o <<= 1) { const unsigned t = (unsigned)__shfl_xor((int)mx, o); mx = t > mx ? t : mx; }
    unsigned lo = mx > (3u << 23) ? mx - (3u << 23) : 0u, hi = mx + 1u;
    int cnt = 0;
#pragma unroll
    for (int r = 0; r < R; ++r) cnt += __popcll(__ballot(key[r] >= lo));
    if (cnt < 16) { lo = 0u; cnt = R * 64; }
    while (cnt != 16 && hi - lo > 1u) { const unsigned mid = lo + ((hi - lo) >> 1); int c = 0;
#pragma unroll
        for (int r = 0; r < R; ++r) c += __popcll(__ballot(key[r] >= mid));
        if (c >= 16) { lo = mid; cnt = c; } else hi = mid; }
    const unsigned T = lo;
    if (cnt == 16) {
#pragma unroll
        for (int r = 0; r < R; ++r) m[r] = __ballot(key[r] >= T);
    } else {
        int need = 16;
#pragma unroll
        for (int r = 0; r < R; ++r) { m[r] = __ballot(key[r] > T); need -= __popcll(m[r]); }
#pragma unroll
        for (int r = 0; r < R; ++r) { unsigned long long eq = __ballot(key[r] == T);
            while (__popcll(eq) > need) eq &= ~(1ull << (63 - __builtin_clzll(eq)));
            need -= __popcll(eq); m[r] |= eq; }
    }
}
__device__ __forceinline__ void peer_topk(const float (&sv4)[4], LAS float* sc, LAS int* exo, LAS float* gto, int lane) {
    LAS float* v1 = sc; LAS int* i1 = (LAS int*)(sc + 16); LAS float* v2 = sc + 32; LAS int* i2 = (LAS int*)(sc + 48); LAS float* sv = sc + 64; LAS int* si = (LAS int*)(sc + 80);
    const unsigned long long lt = (1ull << lane) - 1ull;
#pragma unroll
    for (int half = 0; half < 2; ++half) {
        const float a0 = sv4[2 * half], a1 = sv4[2 * half + 1];
        const unsigned key[2] = {fkey(a0), fkey(a1)}; unsigned long long m[2];
        select16<2>(key, m);
        LAS float* vv = half ? v2 : v1; LAS int* ii = half ? i2 : i1;
        if ((m[0] >> lane) & 1ull) { const int pos = __popcll(m[0] & lt); vv[pos] = a0; ii[pos] = lane; }
        if ((m[1] >> lane) & 1ull) { const int pos = __popcll(m[0]) + __popcll(m[1] & lt); vv[pos] = a1; ii[pos] = 64 + lane; }
    }
    CBAR(); LDS_WAIT();
    const int a = lane >> 2, bb = (lane & 3) * 4;
    const float va = v1[a]; float cv[4]; unsigned key[4]; unsigned long long m[4];
#pragma unroll
    for (int e = 0; e < 4; ++e) { cv[e] = va + v2[bb + e]; key[e] = fkey(cv[e]); }
    select16<4>(key, m);
    int base = 0;
#pragma unroll
    for (int e = 0; e < 4; ++e) { if ((m[e] >> lane) & 1ull) { const int pos = base + __popcll(m[e] & lt); sv[pos] = cv[e]; si[pos] = a * 16 + bb + e; } base += __popcll(m[e]); }
    CBAR(); LDS_WAIT();
    if (lane < 16) {
        const float val = sv[lane]; const int fi = si[lane];
        float mx = val;
#pragma unroll
        for (int o = 1; o < 16; o <<= 1) mx = fmaxf(mx, __shfl_xor(mx, o));
        const float ex = expf(val - mx); float sum = ex;
#pragma unroll
        for (int o = 1; o < 16; o <<= 1) sum += __shfl_xor(sum, o);
        exo[lane] = i1[fi >> 4] * 128 + (i2[fi & 15] - 0);
        gto[lane] = ex / sum;
    }
    CBAR(); LDS_WAIT();
}

constexpr int PD = 16;
__device__ __forceinline__ float ubyte_f32(unsigned w, int i) { return (float)((w >> (8 * i)) & 0xffu); }
__device__ __forceinline__ void peer_wave(const Args& A, LAS unsigned char* lds, int wave, int lane, int pflags) {
    unsigned char* ws = A.ws;
    const float* scores = (const float*)(ws + WS_PROJ);
    const unsigned char* ub = ws + WS_UB; const unsigned char* vb = ws + WS_VB; const bf16_t* x1b = (const bf16_t*)(ws + WS_HB);
    const float* su = (const float*)(ws + WS_SU); const float* sv = (const float*)(ws + WS_SV);
    const float* rssx = (const float*)(ws + WS_CTL + CTL_RSS_X1);
    LAS int* exl = (LAS int*)(lds + wave * 4096);
    LAS float* gtl = (LAS float*)(lds + wave * 4096 + 2048);
    LAS float* sc = (LAS float*)(lds + 32768 + wave * 512);
    LAS float* wts = (LAS float*)(lds + 36864 + wave * 512);
    LAS float* cul = (LAS float*)(lds + 40960 + wave * 1024);
    const int t0 = (blockIdx.x * 8 + wave) * 4;
    if (t0 >= NTOK) return;
#define LOAD_SCORES(dst, t, h) do { const float* _sp = scores + (size_t)(t) * 2048 + (h) * 256 + lane; dst[0] = _sp[0]; dst[1] = _sp[64]; dst[2] = _sp[128]; dst[3] = _sp[192]; } while (0)
    { float nx[4]; LOAD_SCORES(nx, t0, 0);
#pragma unroll 1
        for (int h = 0; h < 8; ++h) { const float cs[4] = {nx[0], nx[1], nx[2], nx[3]};
            if (h < 7) LOAD_SCORES(nx, t0, h + 1);
            peer_topk(cs, sc, exl + h * 16, gtl + h * 16, lane); } }
    CBAR(); LDS_WAIT();
    if (pflags & 256) return;
    int ex0 = exl[lane], ex1 = exl[64 + lane];
    u32x4 xraw[4];
#pragma unroll
    for (int j = 0; j < 2; ++j)
#pragma unroll
        for (int hlf = 0; hlf < 2; ++hlf) xraw[2 * j + hlf] = *(const u32x4*)(x1b + (size_t)t0 * 2048 + 16 * lane + 1024 * j + 8 * hlf);
    float rss = rssx[t0], su0 = su[ex0], su1 = su[ex1], sv0 = sv[ex0], sv1 = sv[ex1];
    float sn[4] = {0.f, 0.f, 0.f, 0.f};
    LOAD_SCORES(sn, t0 + 1, 0);
    u32x4 buf[PD];
#define ISSUE_E(slot, isv, e0r, e1r, k) do { const int _e = __builtin_amdgcn_readlane((k) < 64 ? (e0r) : (e1r), (k) & 63); \
        buf[slot] = *(const u32x4*)(((isv) ? vb : ub) + (size_t)_e * 1024 + 16 * lane); } while (0)
#pragma unroll
    for (int i = 0; i < PD; ++i) ISSUE_E(i, false, ex0, ex1, i);
    for (int tok = 0; tok < 4; ++tok) {
        const int t = t0 + tok;
        unsigned xq[8]; float sx; int xsum;
        { float xf[32];
#pragma unroll
            for (int v4 = 0; v4 < 4; ++v4) { const unsigned rw[4] = {xraw[v4].x, xraw[v4].y, xraw[v4].z, xraw[v4].w};
#pragma unroll
                for (int e = 0; e < 4; ++e) { xf[8 * v4 + 2 * e] = bflo(rw[e]); xf[8 * v4 + 2 * e + 1] = bfhi(rw[e]); } }
            float m = 0.f;
#pragma unroll
            for (int i = 0; i < 32; ++i) m = fmaxf(m, fabsf(xf[i]));
            m = fmaxf(wave_max(m), 1e-30f);
            const float inv = 127.f / m; sx = m * (1.f / 127.f);
            int ls = 0;
#pragma unroll
            for (int d = 0; d < 8; ++d) { const int a = (int)rintf(xf[4 * d] * inv), b = (int)rintf(xf[4 * d + 1] * inv), c = (int)rintf(xf[4 * d + 2] * inv), e = (int)rintf(xf[4 * d + 3] * inv);
                ls += (a + b) + (c + e);
                xq[d] = (unsigned)(a & 255) | ((unsigned)(b & 255) << 8) | ((unsigned)(c & 255) << 16) | ((unsigned)(e & 255) << 24); }
#pragma unroll
            for (int o = 1; o < 64; o <<= 1) ls += __shfl_xor(ls, o);
            xsum = ls; }
        const float ascale = sx / sqrtf(rss * (1.f / 2048.f) + EPS);
        cul[lane] = ascale * su0; cul[64 + lane] = ascale * su1;
        cul[128 + lane] = 2.f * gtl[tok * 128 + lane] * sv0; cul[192 + lane] = 2.f * gtl[tok * 128 + 64 + lane] * sv1;
        CBAR(); LDS_WAIT();
        for (int k00 = 0; k00 < 128; k00 += PD) {
#pragma unroll
          for (int hb = 0; hb < 2; ++hb) { const int k0 = k00 + 8 * hb;
            int p[8];
#pragma unroll
            for (int i = 0; i < 8; ++i) {
                const int slot = 8 * hb + i;
                int acc = 0;
                { const unsigned w4[4] = {buf[slot].x, buf[slot].y, buf[slot].z, buf[slot].w};
#pragma unroll
                    for (int e = 0; e < 4; ++e) { acc = __builtin_amdgcn_sdot4((int)(w4[e] & 0x0F0F0F0Fu), (int)xq[e], acc, false); acc = __builtin_amdgcn_sdot4((int)((w4[e] >> 4) & 0x0F0F0F0Fu), (int)xq[4 + e], acc, false); } }
                p[i] = acc;
                { const int kn = k0 + i + PD; if (kn < 128) ISSUE_E(slot, false, ex0, ex1, kn); else ISSUE_E(slot, true, ex0, ex1, kn - 128); }
            }
            const bool b0 = lane & 1, b1 = lane & 2, b2 = lane & 4;
            int q4[4], q2[2], q1;
#pragma unroll
            for (int i = 0; i < 4; ++i) { const int keep = b0 ? p[i + 4] : p[i], send = b0 ? p[i] : p[i + 4]; q4[i] = keep + __shfl_xor(send, 1); }
#pragma unroll
            for (int i = 0; i < 2; ++i) { const int keep = b1 ? q4[i + 2] : q4[i], send = b1 ? q4[i] : q4[i + 2]; q2[i] = keep + __shfl_xor(send, 2); }
            { const int keep = b2 ? q2[1] : q2[0], send = b2 ? q2[0] : q2[1]; q1 = keep + __shfl_xor(send, 4); }
            q1 += __shfl_xor(q1, 8); q1 += __shfl_xor(q1, 16); q1 += __shfl_xor(q1, 32);
            if (lane < 8) { const int k = k0 + 4 * (lane & 1) + 2 * ((lane >> 1) & 1) + ((lane >> 2) & 1);
                const float a = (float)(2 * q1 - 15 * xsum) * cul[k];
                wts[k] = cul[128 + k] * gelu_as(a); }
          }
            if (tok < 3) { const int hh = k00 >> 4;
                const float cs[4] = {sn[0], sn[1], sn[2], sn[3]};
                if (hh < 7) LOAD_SCORES(sn, t + 1, hh + 1);
                peer_topk(cs, sc, exl + (tok + 1) * 128 + hh * 16, gtl + (tok + 1) * 128 + hh * 16, lane); }
        }
        CBAR(); LDS_WAIT();
        const float w0 = wts[lane], w1 = wts[64 + lane];
        float acc[32]; float wsum = 0.f;
#pragma unroll
        for (int v4 = 0; v4 < 4; ++v4) { const unsigned rw[4] = {xraw[v4].x, xraw[v4].y, xraw[v4].z, xraw[v4].w};
#pragma unroll
            for (int e = 0; e < 4; ++e) { acc[8 * v4 + 2 * e] = bflo(rw[e]); acc[8 * v4 + 2 * e + 1] = bfhi(rw[e]); } }
        int nex0 = 0, nex1 = 0; float nrss = 1.f, nsu0 = 0.f, nsu1 = 0.f, nsv0 = 0.f, nsv1 = 0.f;
        if (tok < 3) { nex0 = exl[(tok + 1) * 128 + lane]; nex1 = exl[(tok + 1) * 128 + 64 + lane];
#pragma unroll
            for (int j = 0; j < 2; ++j)
#pragma unroll
                for (int hlf = 0; hlf < 2; ++hlf) xraw[2 * j + hlf] = *(const u32x4*)(x1b + (size_t)(t + 1) * 2048 + 16 * lane + 1024 * j + 8 * hlf);
            nrss = rssx[t + 1]; nsu0 = su[nex0]; nsu1 = su[nex1]; nsv0 = sv[nex0]; nsv1 = sv[nex1];
            if (tok < 2) LOAD_SCORES(sn, t + 2, 0); }
        for (int k0 = 0; k0 < 128; k0 += PD) {
#pragma unroll
            for (int i = 0; i < PD; ++i) {
                const int k = k0 + i;
                const float w = __builtin_bit_cast(float, __builtin_amdgcn_readlane(__builtin_bit_cast(int, k < 64 ? w0 : w1), k & 63));
                wsum += w;
                { const unsigned w4[4] = {buf[i].x, buf[i].y, buf[i].z, buf[i].w};
#pragma unroll
                    for (int e = 0; e < 4; ++e) { const unsigned lo = w4[e] & 0x0F0F0F0Fu, hi = (w4[e] >> 4) & 0x0F0F0F0Fu;
#pragma unroll
                        for (int bb = 0; bb < 4; ++bb) { acc[4 * e + bb] += w * ubyte_f32(lo, bb); acc[16 + 4 * e + bb] += w * ubyte_f32(hi, bb); } } }
                { const int kn = k + PD; if (kn < 128) ISSUE_E(i, true, ex0, ex1, kn); else if (tok < 3) ISSUE_E(i, false, nex0, nex1, kn - 128); }
            }
        }
        const float corr = -7.5f * wsum;
        float* op = A.out + (size_t)t * 2048 + 16 * lane;
        if (!(pflags & 128)) {
#pragma unroll
        for (int j = 0; j < 2; ++j)
#pragma unroll
            for (int c4 = 0; c4 < 4; ++c4) { const int a0 = 16 * j + 4 * c4;
                *(f32x4*)(op + 1024 * j + 4 * c4) = (f32x4){acc[a0] + corr, acc[a0 + 1] + corr, acc[a0 + 2] + corr, acc[a0 + 3] + corr}; }
        } else if (corr == 12345.678f) op[0] = acc[0];
        ex0 = nex0; ex1 = nex1; rss = nrss; su0 = nsu0; su1 = nsu1; sv0 = nsv0; sv1 = nsv1;
    }
#undef ISSUE_E
#undef LOAD_SCORES
}

__global__ void __launch_bounds__(512, 2) mk_fwd(Args args) {
    extern __shared__ __attribute__((aligned(16))) unsigned char lds_raw[];
    LAS unsigned char* lds = (LAS unsigned char*)lds_raw;
    const int tid = threadIdx.x, lane = tid & 63, wave = __builtin_amdgcn_readfirstlane(tid >> 6);
    volatile LAS unsigned* MISC = (volatile LAS unsigned*)(lds + MISC_OFF);
    if (tid < 64) MISC[tid] = 0u;
    __syncthreads();
    unsigned char* ws = args.ws;
    const int lo = args.ph_lo, hi = args.ph_hi & 0xff, pflags = args.ph_hi >> 8;
    XcdBarrier bar; bar.bar = (unsigned*)(ws + WS_CTL); bar.x = 0; bar.st = nullptr;
    if (hi - lo > 1) bar = xcd_barrier_post((unsigned*)(ws + WS_CTL), MISC + 8);
#ifndef PH_MASK
#define PH_MASK 0x7f
#endif
#define IN(k) (((PH_MASK >> (k)) & 1) && lo <= (k) && (k) < hi)
#define SEAM(k) do { if (IN(k) && IN((k) + 1)) xcd_barrier(bar); } while (0)

    if (IN(0)) { p0_prologue(args, lds, wave, lane); }
    SEAM(0);
    if (IN(1)) {
        pg8::Gemm g{(const bf16_t*)(ws + WS_HB), (const bf16_t*)(ws + WS_WINT), NTOK, DPROJ, DM}; pg8::StaticOrder S; S.init(NTOK, DPROJ, gridDim.x, (int)blockIdx.x);
        pg8::EpiProj E{(bf16_t*)(ws + WS_PROJ), DPROJ};
        pg8::gemm_phase<pg8::EpiProj, pg8::StaticOrder, false>(lds, g, S, E, nullptr);
    }
    SEAM(1);
    if (IN(2)) {
        if (!(pflags & 4)) for (int u = blockIdx.x; u < 256; u += gridDim.x) ssm_unit(args, lds, u >> 6, u & 63, wave, lane);
        if (!(pflags & 8)) for (int it = blockIdx.x * 8 + wave; it < 2048; it += gridDim.x * 8) prep2_item(args, lds + wave * SSM_WL, it, lane);
    }
    SEAM(2);
    if (IN(3)) {
        if (!(pflags & 2)) {
            pg8::Gemm g{(const bf16_t*)(ws + WS_YB), (const bf16_t*)(ws + WS_GLUT), NTOK, 1024, 1024}; pg8::StaticOrder S; S.init(NTOK, 1024, gridDim.x, (int)blockIdx.x);
            pg8::EpiGlu E{(const bf16_t*)(ws + WS_YB), (bf16_t*)(ws + WS_MIXED) + 1024, args.in[15], (float*)(ws + WS_CTL + CTL_RSS_SSM)};
            pg8::gemm_phase<pg8::EpiGlu, pg8::StaticOrder, false>(lds, g, S, E, nullptr);
        }
        __syncthreads();
        if (!(pflags & 1)) for (;;) {
            if (tid == 0) MISC[0] = atomicAdd((unsigned*)(ws + WS_CTL + CTL_QCTR), 1u);
            __syncthreads();
            const unsigned u = MISC[0];
            __syncthreads();
            if (u >= 512u) break;
            attn_unit(args, lds, (int)u, tid, wave, lane, pflags);
        }
    }
    SEAM(3);
    if (IN(4)) {
        pg8::Gemm g{(const bf16_t*)(ws + WS_MIXED), (const bf16_t*)(ws + WS_WOUTT), NTOK, DM, DM}; pg8::StaticOrder S; S.init(NTOK, DM, gridDim.x, (int)blockIdx.x);
        LAS float* tab = (LAS float*)(lds + 131072);
        { pg8::Unit u0; if (S.next(0, u0) && tid < 256) { const int row = u0.pm * 256 + tid;
            const float ra = 1.0f / sqrtf(((const float*)(ws + WS_CTL + CTL_RSS_ATTN))[row] * (1.f / 1024.f) + EPS), rs = 1.0f / sqrtf(((const float*)(ws + WS_CTL + CTL_RSS_SSM))[row] * (1.f / 1024.f) + EPS);
            tab[tid] = ra / rs; tab[256 + tid] = rs; } }
        __syncthreads();
        pg8::EpiWout E{args.in[0], args.out, (bf16_t*)(ws + WS_HB), (float*)(ws + WS_CTL + CTL_RSS_X1), tab};
        pg8::gemm_phase<pg8::EpiWout, pg8::StaticOrder, false>(lds, g, S, E, nullptr);
    }
    SEAM(4);
    if (IN(5)) {
        pg8::Gemm g{(const bf16_t*)(ws + WS_HB), (const bf16_t*)(ws + WS_WPT), NTOK, DM, DM}; pg8::StaticOrder S; S.init(NTOK, DM, gridDim.x, (int)blockIdx.x);
        pg8::EpiScores E{(float*)(ws + WS_PROJ), (const float*)(ws + WS_CTL + CTL_RSS_X1)};
        pg8::gemm_phase<pg8::EpiScores, pg8::StaticOrder, false>(lds, g, S, E, nullptr);
    }
    SEAM(5);
    if (IN(6)) { peer_wave(args, lds, wave, lane, pflags); }
#undef IN
#undef SEAM
}

#ifndef MK_DEBUG
#ifndef MK_PER_PHASE
#define MK_PER_PHASE 0
#endif
extern "C" void kernel_launch(void* const* d_in, const int* in_sizes, int n_in, void* d_out, int out_size, void* d_ws, size_t ws_size, hipStream_t stream) {
    static int grid = 0;
    if (grid == 0) {
        if (n_in != 25 || out_size != NTOK * DM || ws_size < WS_END) { fprintf(stderr, "kernel_launch: unexpected shapes / workspace (%d inputs, out %d, ws %zu < %zu)\n", n_in, out_size, ws_size, (size_t)WS_END); grid = -1; return; }
        int dev = 0, cus = 0, per_cu = 0;
        if (hipGetDevice(&dev) != hipSuccess || hipDeviceGetAttribute(&cus, hipDeviceAttributeMultiprocessorCount, dev) != hipSuccess) { grid = -1; return; }
        if (hipFuncSetAttribute((const void*)mk_fwd, hipFuncAttributeMaxDynamicSharedMemorySize, LDS_BYTES) != hipSuccess) { fprintf(stderr, "kernel_launch: hipFuncSetAttribute failed\n"); grid = -1; return; }
        if (hipOccupancyMaxActiveBlocksPerMultiprocessor(&per_cu, (const void*)mk_fwd, 512, LDS_BYTES) != hipSuccess || per_cu < 1) { fprintf(stderr, "kernel_launch: occupancy query reports %d\n", per_cu); }
        (void)hipGetLastError();
        grid = cus;
    }
    if (grid < 0) return;
    (void)hipMemsetAsync((char*)d_ws + WS_CTL, 0, CTL_BYTES, stream);
    Args a{};
    for (int i = 0; i < 25; ++i) a.in[i] = (const float*)d_in[i];
    a.out = (float*)d_out; a.ws = (unsigned char*)d_ws;
#if MK_PER_PHASE
#ifndef MK_DUP
#define MK_DUP -1
#endif
    for (int p = 0; p < 7; ++p) { a.ph_lo = p; a.ph_hi = p + 1; hipLaunchKernelGGL(mk_fwd, dim3(grid), dim3(512), LDS_BYTES, stream, a);
        if (p == MK_DUP) {
            (void)hipMemsetAsync((char*)d_ws + WS_CTL + CTL_QCTR, 0, 256, stream);
#ifndef MK_DUP_FLAGS
#define MK_DUP_FLAGS 0
#endif
            if (p == 3 && !((MK_DUP_FLAGS) & (1 | 16 | 32 | 64))) (void)hipMemsetAsync((char*)d_ws + WS_CTL + CTL_RSS_ATTN, 0, 32768, stream);
            if (p == 3 && !((MK_DUP_FLAGS) & 2)) (void)hipMemsetAsync((char*)d_ws + WS_CTL + CTL_RSS_SSM, 0, 32768, stream);
            if (p == 4) (void)hipMemsetAsync((char*)d_ws + WS_CTL + CTL_RSS_X1, 0, 32768, stream);
            a.ph_hi |= (MK_DUP_FLAGS) << 8;
            hipLaunchKernelGGL(mk_fwd, dim3(grid), dim3(512), LDS_BYTES, stream, a); } }
#else
    a.ph_lo = 0; a.ph_hi = 7;
    hipLaunchKernelGGL(mk_fwd, dim3(grid), dim3(512), LDS_BYTES, stream, a);
#endif
}
#endif
```

```cpp
#include <hip/hip_runtime.h>
#include <stdint.h>
#include <stdio.h>

typedef unsigned short bf16_t;
typedef float f32x2 __attribute__((ext_vector_type(2)));
typedef unsigned u32x2 __attribute__((ext_vector_type(2)));
using bf16x2v = __attribute__((ext_vector_type(2))) __bf16;

constexpr int NTOK = 8192, SEQ = 2048, DM = 2048, DPROJ = 4096;
constexpr float EPS = 1e-6f;
constexpr float LOG2E = 1.4426950408889634f;

constexpr size_t MB = 1024 * 1024;
constexpr size_t WS_CTL = 0;
constexpr size_t CTL_BYTES = 128 * 1024;
constexpr size_t CTL_QCTR = 16384;
constexpr size_t CTL_RSS_ATTN = 32768, CTL_RSS_SSM = 65536, CTL_RSS_X1 = 98304;
constexpr size_t WS_HB = 256 * 1024;
constexpr size_t WS_WINT = WS_HB + 32 * MB;
constexpr size_t WS_GLUT = WS_WINT + 16 * MB;
constexpr size_t WS_WOUTT = WS_GLUT + 2 * MB;
constexpr size_t WS_WPT = WS_WOUTT + 8 * MB;
constexpr size_t WS_UB = WS_WPT + 8 * MB;
constexpr size_t WS_VB = WS_UB + 32 * MB;
constexpr size_t WS_SU = WS_VB + 32 * MB;
constexpr size_t WS_SV = WS_SU + 65536;
constexpr size_t WS_PROJ = WS_SV + 65536;
constexpr size_t WS_QF = WS_PROJ + 64 * MB;
constexpr size_t WS_KF = WS_QF + 48 * MB;
constexpr size_t WS_VT = WS_KF + 48 * MB;
constexpr size_t WS_QN = WS_QF, WS_KN = WS_KF;
constexpr size_t WS_YB = WS_VT + 48 * MB + 4096;
constexpr size_t WS_MIXED = WS_YB + 16 * MB;
constexpr size_t WS_SSMP = WS_MIXED + 32 * MB;
constexpr size_t SSMP_ABAR = 0, SSMP_A256 = 32768, SSMP_BFRAG = 65536, SSMP_CFRAG = 65536 + 524288;
constexpr size_t WS_BTAB = WS_SSMP + 1 * MB;
constexpr size_t WS_END = WS_BTAB + 64 * 1024;

constexpr int LDS_BYTES = 147456;
constexpr int MISC_OFF = 147456 - 256;
#define XB_TMO      128
#define XB_XCNT(j)  (256  + 64 * (j))
#define XB_XSUB(j)  (1280 + 64 * (j))
#define XB_XGEN(j)  (2304 + 64 * (j))
#define XB_TOP      3328
#define XB_TOPGEN   3392
#define XCD_BAR_WORDS 3456
#define XB_SPIN_CAP (1u << 18)
#define LAS __attribute__((address_space(3)))

__device__ __forceinline__ unsigned xb_ld(unsigned* p)              { return __hip_atomic_load(p, __ATOMIC_RELAXED, __HIP_MEMORY_SCOPE_AGENT); }
__device__ __forceinline__ unsigned xb_add(unsigned* p, unsigned v) { return __hip_atomic_fetch_add(p, v, __ATOMIC_RELAXED, __HIP_MEMORY_SCOPE_AGENT); }
__device__ __forceinline__ unsigned xb_xcc_id() { return (unsigned)__builtin_amdgcn_s_getreg((3 << 11) | 20) & 0xFu; }
#define XB_SPIN(cond, bar) do { unsigned _sp = 0; while (cond) { __builtin_amdgcn_s_sleep(1); \
    if ((++_sp & 255u) == 0u) { if (xb_ld(&(bar)[XB_TMO])) break; if (_sp > XB_SPIN_CAP) { atomicAdd(&(bar)[XB_TMO], 1u); break; } } } } while (0)

struct XcdBarrier {
    unsigned* bar; unsigned x;
    volatile LAS unsigned* st;
};

__device__ __forceinline__ XcdBarrier xcd_barrier_post(unsigned* bar, volatile LAS unsigned* st) {
    XcdBarrier b; b.bar = bar; b.x = xb_xcc_id(); b.st = st;
    if (threadIdx.x == 0) (void)xb_add(&bar[XB_XCNT(b.x)], 1u);
    return b;
}
__device__ __forceinline__ void xcd_barrier_complete(unsigned* bar, unsigned x, unsigned& nloc, unsigned& nx) {
    const unsigned G = gridDim.x * gridDim.y * gridDim.z;
    unsigned sum, cnt, mine, sp = 0u;
    for (;;) {
        sum = 0u; cnt = 0u; mine = 0u;
#pragma unroll
        for (unsigned j = 0; j < 16; ++j) { const unsigned c = xb_ld(&bar[XB_XCNT(j)]); sum += c; cnt += (c > 0u) ? 1u : 0u; mine = (j == x) ? c : mine; }
        if (sum == G) break;
        __builtin_amdgcn_s_sleep(1);
        if ((++sp & 255u) == 0u) { if (xb_ld(&bar[XB_TMO])) break; if (sp > XB_SPIN_CAP) { atomicAdd(&bar[XB_TMO], 1u); break; } }
    }
    nloc = mine > 0u ? mine : 1u; nx = cnt > 0u ? cnt : 1u;
}

__device__ __forceinline__ void xcd_barrier(const XcdBarrier& b) {
    asm volatile("s_waitcnt vmcnt(0)" ::: "memory");
    __syncthreads();
    if (threadIdx.x == 0) {
        unsigned* bar = b.bar;
        __builtin_amdgcn_s_waitcnt(0);
        unsigned nloc = b.st[0], nx = b.st[1];
        if (nloc == 0u) { xcd_barrier_complete(bar, b.x, nloc, nx); b.st[0] = nloc; b.st[1] = nx; }
        const unsigned old = xb_add(&bar[XB_XSUB(b.x)], 1u);
        const unsigned gen = old / nloc;
        if (old + 1u == (gen + 1u) * nloc) {
            __builtin_amdgcn_fence(__ATOMIC_RELEASE, "agent");
            asm volatile("s_waitcnt vmcnt(0)" ::: "memory");
            const unsigned og = xb_add(&bar[XB_TOP], 1u);
            const unsigned tg = og / nx;
            if (og + 1u == (tg + 1u) * nx) xb_add(&bar[XB_TOPGEN], 1u);
            else XB_SPIN(xb_ld(&bar[XB_TOPGEN]) == tg, bar);
            __builtin_amdgcn_fence(__ATOMIC_ACQUIRE, "agent");
            xb_add(&bar[XB_XGEN(b.x)], 1u);
            asm volatile("s_waitcnt vmcnt(0)" ::: "memory");
        } else {
            XB_SPIN(xb_ld(&bar[XB_XGEN(b.x)]) == gen, bar);
            __builtin_amdgcn_fence(__ATOMIC_ACQUIRE, "agent");
            asm volatile("s_waitcnt vmcnt(0)" ::: "memory");
        }
    }
    __syncthreads();
}
namespace pg8 {
#define PG8_LAS __attribute__((address_space(3)))
typedef unsigned short bf16_t;
typedef short bf16x8 __attribute__((ext_vector_type(8)));
typedef float f32x4 __attribute__((ext_vector_type(4)));
typedef unsigned u32x4 __attribute__((ext_vector_type(4)));
constexpr int BM = 256, BK = 64, HALF = 128, HTB = HALF * BK * 2  , STAGE_BYTES = 8 * HTB, NXCD = 8, WGM = 8;

__host__ __device__ __forceinline__ int lds_byte(int r, int c) { const int st = (r >> 4) * 2 + (c >> 5), rr = r & 15, cc = c & 31, ob = rr * 64 + cc * 2; return st * 1024 + (ob ^ (((ob >> 9) & 1) << 5)); }
__host__ __device__ __forceinline__ void stage_rc(int b, int& R, int& C) { const int st = b / 1024, sb = b % 1024, swz = sb ^ (((sb >> 9) & 1) << 5); R = (st >> 1) * 16 + swz / 64; C = (st & 1) * 32 + (swz % 64) / 2; }
__host__ __device__ __forceinline__ int perm32(int rho) { const int n = rho >> 4, i = rho & 15; return 8 * (i >> 2) + 4 * n + (i & 3); }

struct Unit { int pm, pn; };
struct Gemm { const bf16_t* A; const bf16_t* Bt; int M, N, K; };

struct StaticOrder {
    int nM, nN, nwg, G, c;
    __host__ __device__ void init(int M, int N, int G_, int c_) { nM = M / BM; nN = N / BM; nwg = nM * nN; G = G_; c = c_; }
    __host__ __device__ bool next(int i, Unit& u) const {
        const long L = (long)i * G + c; if (L >= nwg) return false;
        int wgid = (int)L; { const int q = nwg / NXCD, r = nwg % NXCD, xcd = wgid % NXCD, off = wgid / NXCD; wgid = (xcd < r ? xcd * (q + 1) : r * (q + 1) + (xcd - r) * q) + off; }
        const int nig = WGM * nN, gid = wgid / nig, fm = gid * WGM, gsz = (nM - fm) < WGM ? (nM - fm) : WGM;
        u.pm = fm + ((wgid % nig) % gsz); u.pn = (wgid % nig) / gsz; return true;
    }
    __device__ __forceinline__ void a_ready(const Unit&) const {}
    __device__ __forceinline__ void done(const Unit&) const {}
};
typedef float cvt_f32x2 __attribute__((ext_vector_type(2)));
typedef __bf16 cvt_bf16x2 __attribute__((ext_vector_type(2)));
__device__ __forceinline__ unsigned cvt_pk_bf16(float lo, float hi) { return __builtin_bit_cast(unsigned, __builtin_convertvector((cvt_f32x2){lo, hi}, cvt_bf16x2)); }
__device__ __forceinline__ float bflo(unsigned u) { return __uint_as_float(u << 16); }
__device__ __forceinline__ float bfhi(unsigned u) { return __uint_as_float(u & 0xffff0000u); }

struct EpiProj {
    static constexpr bool PERM = true, AFTER_DRAIN = false, HAS_MID = false;
    bf16_t* O; int ldc;
    __device__ __forceinline__ void mid(f32x4 (&)[2][2][4][2], const Unit&, int, int, int, int) const {}
    __device__ __forceinline__ void operator()(const f32x4 (&acc)[2][2][4][2], const Unit& u, int wr, int wc, int fr, int fq) const {
        const int row0 = u.pm * BM + wr * 64 + fr, col0 = u.pn * BM + wc * 32 + 8 * fq;
#pragma unroll
        for (int ai = 0; ai < 2; ++ai)
#pragma unroll
            for (int m = 0; m < 4; ++m) { bf16_t* rowp = O + (size_t)(row0 + ai * HALF + m * 16) * ldc + col0;
#pragma unroll
                for (int bj = 0; bj < 2; ++bj) { const f32x4 v0 = acc[ai][bj][m][0], v1 = acc[ai][bj][m][1];
                    u32x4 w; w.x = cvt_pk_bf16(v0[0], v0[1]); w.y = cvt_pk_bf16(v0[2], v0[3]); w.z = cvt_pk_bf16(v1[0], v1[1]); w.w = cvt_pk_bf16(v1[2], v1[3]);
                    *(u32x4*)(rowp + bj * HALF) = w; } }
    }
};

struct EpiGlu {
    static constexpr bool PERM = true, AFTER_DRAIN = false, HAS_MID = false;
    const bf16_t* Y; bf16_t* O; const float* bias; float* rss;
    __device__ __forceinline__ void mid(f32x4 (&)[2][2][4][2], const Unit&, int, int, int, int) const {}
    __device__ __forceinline__ void operator()(const f32x4 (&acc)[2][2][4][2], const Unit& u, int wr, int wc, int fr, int fq) const {
        const int row0 = u.pm * BM + wr * 64 + fr, col0 = u.pn * BM + wc * 32 + 8 * fq;
        f32x4 bv[2][2];
#pragma unroll
        for (int bj = 0; bj < 2; ++bj)
#pragma unroll
            for (int n = 0; n < 2; ++n) bv[bj][n] = *(const f32x4*)(bias + col0 + bj * HALF + 4 * n);
        u32x4 yq[2][2];
#pragma unroll
        for (int bj = 0; bj < 2; ++bj) yq[0][bj] = *(const u32x4*)(Y + (size_t)row0 * 1024 + col0 + bj * HALF);
#pragma unroll
        for (int idx = 0; idx < 8; ++idx) { const int ai = idx >> 2, m = idx & 3, row = row0 + ai * HALF + m * 16; float ss = 0.f;
            if (idx < 7) { const int nrow = row0 + ((idx + 1) >> 2) * HALF + ((idx + 1) & 3) * 16;
#pragma unroll
                for (int bj = 0; bj < 2; ++bj) yq[(idx + 1) & 1][bj] = *(const u32x4*)(Y + (size_t)nrow * 1024 + col0 + bj * HALF); }
#pragma unroll
            for (int bj = 0; bj < 2; ++bj) {
                const u32x4 yv = yq[idx & 1][bj];
                const f32x4 g0 = acc[ai][bj][m][0] + bv[bj][0], g1 = acc[ai][bj][m][1] + bv[bj][1];
                float y[8] = {bflo(yv.x), bfhi(yv.x), bflo(yv.y), bfhi(yv.y), bflo(yv.z), bfhi(yv.z), bflo(yv.w), bfhi(yv.w)};
                float o[8];
#pragma unroll
                for (int e = 0; e < 4; ++e) { o[e] = y[e] * __builtin_amdgcn_rcpf(1.f + __expf(-g0[e])); o[4 + e] = y[4 + e] * __builtin_amdgcn_rcpf(1.f + __expf(-g1[e])); }
#pragma unroll
                for (int e = 0; e < 8; ++e) ss += o[e] * o[e];
                u32x4 w; w.x = cvt_pk_bf16(o[0], o[1]); w.y = cvt_pk_bf16(o[2], o[3]); w.z = cvt_pk_bf16(o[4], o[5]); w.w = cvt_pk_bf16(o[6], o[7]);
                *(u32x4*)(O + (size_t)row * 2048 + col0 + bj * HALF) = w; }
            ss += __shfl_xor(ss, 16); ss += __shfl_xor(ss, 32);
            if (fq == 0) unsafeAtomicAdd(rss + row, ss); }
    }
};

struct EpiWout {
    static constexpr bool PERM = true, AFTER_DRAIN = false, HAS_MID = true;
    const float* X; float* OUT; bf16_t* XB; float* rss_x; const PG8_LAS float* tab;
    __device__ __forceinline__ void mid(f32x4 (&acc)[2][2][4][2], const Unit& u, int wr, int wc, int fr, int fq) const {
        const PG8_LAS float* tp = tab + wr * 64 + fr;
#pragma unroll
        for (int ai = 0; ai < 2; ++ai)
#pragma unroll
            for (int m = 0; m < 4; ++m) { const float ratio = tp[ai * HALF + m * 16];
#pragma unroll
                for (int bj = 0; bj < 2; ++bj)
#pragma unroll
                    for (int n = 0; n < 2; ++n) acc[ai][bj][m][n] *= ratio; }
    }
    __device__ __forceinline__ void operator()(const f32x4 (&acc)[2][2][4][2], const Unit& u, int wr, int wc, int fr, int fq) const {
        const int row0 = u.pm * BM + wr * 64 + fr, col0 = u.pn * BM + wc * 32 + 8 * fq;
        const PG8_LAS float* tp = tab + 256 + wr * 64 + fr;
        f32x4 xq[2][2][2];
#pragma unroll
        for (int bj = 0; bj < 2; ++bj) { const size_t o = (size_t)row0 * 2048 + col0 + bj * HALF; xq[0][bj][0] = *(const f32x4*)(X + o); xq[0][bj][1] = *(const f32x4*)(X + o + 4); }
#pragma unroll
        for (int idx = 0; idx < 8; ++idx) { const int ai = idx >> 2, m = idx & 3, row = row0 + ai * HALF + m * 16; float ss = 0.f;
            if (idx < 7) { const int nrow = row0 + ((idx + 1) >> 2) * HALF + ((idx + 1) & 3) * 16;
#pragma unroll
                for (int bj = 0; bj < 2; ++bj) { const size_t o = (size_t)nrow * 2048 + col0 + bj * HALF; xq[(idx + 1) & 1][bj][0] = *(const f32x4*)(X + o); xq[(idx + 1) & 1][bj][1] = *(const f32x4*)(X + o + 4); } }
            const float rs = tp[ai * HALF + m * 16];
#pragma unroll
            for (int bj = 0; bj < 2; ++bj) { const size_t o = (size_t)row * 2048 + col0 + bj * HALF;
                const f32x4 v0 = xq[idx & 1][bj][0] + rs * acc[ai][bj][m][0], v1 = xq[idx & 1][bj][1] + rs * acc[ai][bj][m][1];
                u32x4 w; w.x = cvt_pk_bf16(v0[0], v0[1]); w.y = cvt_pk_bf16(v0[2], v0[3]); w.z = cvt_pk_bf16(v1[0], v1[1]); w.w = cvt_pk_bf16(v1[2], v1[3]);
                *(u32x4*)(XB + o) = w;
#pragma unroll
                for (int e = 0; e < 4; ++e) ss += v0[e] * v0[e] + v1[e] * v1[e]; }
            ss += __shfl_xor(ss, 16); ss += __shfl_xor(ss, 32);
            if (fq == 0) unsafeAtomicAdd(rss_x + row, ss); }
    }
};

struct EpiScores {
    static constexpr bool PERM = false, AFTER_DRAIN = false, HAS_MID = false;
    float* C; const float* rss_x;
    __device__ __forceinline__ void mid(f32x4 (&)[2][2][4][2], const Unit&, int, int, int, int) const {}
    __device__ __forceinline__ void operator()(const f32x4 (&acc)[2][2][4][2], const Unit& u, int wr, int wc, int fr, int fq) const {
        const int row0 = u.pm * BM + wr * 64 + fr, col0 = u.pn * BM + wc * 32 + 4 * fq;
        float r2v[8];
#pragma unroll
        for (int idx = 0; idx < 8; ++idx) r2v[idx] = rss_x[row0 + (idx >> 2) * HALF + (idx & 3) * 16];
#pragma unroll
        for (int ai = 0; ai < 2; ++ai)
#pragma unroll
            for (int m = 0; m < 4; ++m) { const int row = row0 + ai * HALF + m * 16;
                const float r2 = __builtin_amdgcn_rsqf(r2v[ai * 4 + m] * (1.f / 2048.f) + 1e-6f);
                float* rowp = C + (size_t)row * 2048 + col0;
#pragma unroll
                for (int bj = 0; bj < 2; ++bj)
#pragma unroll
                    for (int n = 0; n < 2; ++n) *(f32x4*)(rowp + bj * HALF + n * 16) = acc[ai][bj][m][n] * r2; }
    }
};

template <class Epi, class Sched, bool STAMP = false>
__device__ __forceinline__ void gemm_phase(PG8_LAS unsigned char* lds, const Gemm g, const Sched& S, const Epi& E, unsigned long long* stamps) {
    const int tid = threadIdx.x, wid = __builtin_amdgcn_readfirstlane(tid >> 6), lane = tid & 63, wr = wid >> 2, wc = wid & 3, fr = lane & 15, fq = lane >> 4;
    const int K = g.K, nt = K / BK;
    int ts_lo = 0, ts_hi = 0, nts = 0; const unsigned long long rt_entry = STAMP ? (unsigned long long)wall_clock64() : 0ull;
#define PG8_STAMP() do { if (STAMP && wid == 0 && nts < 64) { const unsigned long long _c = (unsigned long long)clock64(); \
        ts_lo = (lane == nts) ? (int)(unsigned)_c : ts_lo; ts_hi = (lane == nts) ? (int)(unsigned)(_c >> 32) : ts_hi; ++nts; } } while (0)
    PG8_STAMP();
    unsigned voffA[2], voffB[2];
#pragma unroll
    for (int i = 0; i < 2; ++i) { int R, C; stage_rc(tid * 16 + i * 8192, R, C); const int Rb = Epi::PERM ? ((R & ~31) + perm32(R & 31)) : R;
        voffA[i] = (unsigned)(R * K + C) * 2u; voffB[i] = (unsigned)(Rb * K + C) * 2u; }
    const size_t kstep = (size_t)(BK * 2);
    const size_t hstep = (size_t)HALF * K * 2;
    const size_t tstep = 2 * hstep;
    const unsigned ldsw = (unsigned)wid * 1024u;
    const int aoff = lds_byte(wr * 64 + fr, fq * 8), boff = lds_byte(wc * 32 + fr, fq * 8);
#define PG8_SA(b, h) (((b) * 2 + (h)) * HTB)
#define PG8_SB(b, h) ((4 + (b) * 2 + (h)) * HTB)
#define PG8_STAGE(bufoff, gbase, voff) do { _Pragma("unroll") for (int _i = 0; _i < 2; ++_i) \
        __builtin_amdgcn_global_load_lds((const unsigned*)((const char*)(gbase) + (voff)[_i]), (PG8_LAS unsigned*)(lds + (bufoff) + ldsw + _i * 8192), 16, 0, 0); } while (0)
#define PG8_LDA(dst, b, h) do { _Pragma("unroll") for (int m = 0; m < 4; ++m) _Pragma("unroll") for (int k = 0; k < 2; ++k) dst[m][k] = *(const PG8_LAS bf16x8*)(lds + PG8_SA(b, h) + aoff + m * 2048 + k * 1024); } while (0)
#define PG8_LDB(dst, b, h) do { _Pragma("unroll") for (int n = 0; n < 2; ++n) _Pragma("unroll") for (int k = 0; k < 2; ++k) dst[n][k] = *(const PG8_LAS bf16x8*)(lds + PG8_SB(b, h) + boff + n * 2048 + k * 1024); } while (0)
#define PG8_MMA(ai, bj, At, Bt) do { __builtin_amdgcn_s_setprio(1); _Pragma("unroll") for (int m = 0; m < 4; ++m) _Pragma("unroll") for (int n = 0; n < 2; ++n) _Pragma("unroll") for (int k = 0; k < 2; ++k) \
        acc[ai][bj][m][n] = __builtin_amdgcn_mfma_f32_16x16x32_bf16(Bt[n][k], At[m][k], acc[ai][bj][m][n], 0, 0, 0); __builtin_amdgcn_s_setprio(0); } while (0)
#define PG8_WAIT_V(n) asm volatile("s_waitcnt vmcnt(" #n ")" ::: "memory")
#define PG8_WAIT_L(n) asm volatile("s_waitcnt lgkmcnt(" #n ")" ::: "memory")
#define PG8_BAR __builtin_amdgcn_s_barrier()
#define PG8_SCHED __builtin_amdgcn_sched_barrier(0)
    Unit cur, nxt; int ui = 0;
    if (!S.next(0, cur)) return;
    f32x4 acc[2][2][4][2];
#pragma unroll
    for (int a = 0; a < 2; ++a)
#pragma unroll
        for (int b = 0; b < 2; ++b)
#pragma unroll
            for (int m = 0; m < 4; ++m)
#pragma unroll
                for (int n = 0; n < 2; ++n) acc[a][b][m][n] = (f32x4){0.f, 0.f, 0.f, 0.f};
    bf16x8 At[4][2], B0[2][2], B1[2][2];
    const char* cA = (const char*)g.A + (size_t)cur.pm * tstep; const char* cB = (const char*)g.Bt + (size_t)cur.pn * tstep;
    S.a_ready(cur);
    PG8_STAGE(PG8_SB(0, 0), cB, voffB); PG8_STAGE(PG8_SA(0, 0), cA, voffA); PG8_STAGE(PG8_SB(0, 1), cB + hstep, voffB); PG8_STAGE(PG8_SA(0, 1), cA + hstep, voffA);
    if (wr == 1) PG8_BAR;
    PG8_WAIT_V(4); PG8_BAR;
    PG8_STAGE(PG8_SB(1, 0), cB + kstep, voffB); PG8_STAGE(PG8_SA(1, 0), cA + kstep, voffA); PG8_STAGE(PG8_SB(1, 1), cB + hstep + kstep, voffB);
    PG8_WAIT_V(6); PG8_BAR;
    PG8_STAMP();
    for (;;) {
        const bool has_next = S.next(ui + 1, nxt);
        const char* nA = has_next ? (const char*)g.A + (size_t)nxt.pm * tstep : cA; const char* nB = has_next ? (const char*)g.Bt + (size_t)nxt.pn * tstep : cB;
        for (int t = 0; t < nt; t += 2) {
            const bool last = (t == nt - 2);
            const char* a1 = cA + (size_t)(t + 1) * kstep;
            const char* a2 = last ? nA : cA + (size_t)(t + 2) * kstep; const char* b2 = last ? nB : cB + (size_t)(t + 2) * kstep;
            const char* a3 = a2 + kstep; const char* b3 = b2 + kstep;
            if (last && has_next) S.a_ready(nxt);
            if constexpr (Epi::HAS_MID) { if (t == (nt >> 1)) { E.mid(acc, cur, wr, wc, fr, fq); asm volatile("s_waitcnt lgkmcnt(0)" ::: "memory"); } }
            PG8_LDB(B0, 0, 0); PG8_SCHED; PG8_LDA(At, 0, 0); PG8_STAGE(PG8_SA(1, 1), a1 + hstep, voffA);
            PG8_WAIT_L(8); PG8_BAR; PG8_WAIT_L(0); PG8_MMA(0, 0, At, B0); PG8_BAR; PG8_SCHED;
            PG8_LDB(B1, 0, 1); PG8_STAGE(PG8_SB(0, 0), b2, voffB);
            PG8_BAR; PG8_WAIT_L(0); PG8_MMA(0, 1, At, B1); PG8_BAR;
            PG8_LDA(At, 0, 1); PG8_STAGE(PG8_SA(0, 0), a2, voffA);
            PG8_BAR; PG8_WAIT_L(0); PG8_MMA(1, 0, At, B0); PG8_BAR; PG8_SCHED;
            PG8_STAGE(PG8_SB(0, 1), b2 + hstep, voffB);
            PG8_WAIT_V(6); PG8_BAR; PG8_MMA(1, 1, At, B1); PG8_BAR;
            PG8_LDB(B0, 1, 0); PG8_SCHED; PG8_LDA(At, 1, 0); PG8_STAGE(PG8_SA(0, 1), a2 + hstep, voffA);
            PG8_WAIT_L(8); PG8_BAR; PG8_WAIT_L(0); PG8_MMA(0, 0, At, B0); PG8_BAR; PG8_SCHED;
            PG8_LDB(B1, 1, 1); PG8_STAGE(PG8_SB(1, 0), b3, voffB);
            PG8_BAR; PG8_WAIT_L(0); PG8_MMA(0, 1, At, B1); PG8_BAR;
            PG8_LDA(At, 1, 1); PG8_STAGE(PG8_SA(1, 0), a3, voffA);
            PG8_BAR; PG8_WAIT_L(0); PG8_MMA(1, 0, At, B0); PG8_BAR; PG8_SCHED;
            PG8_STAGE(PG8_SB(1, 1), b3 + hstep, voffB);
            PG8_WAIT_V(6); PG8_BAR; PG8_MMA(1, 1, At, B1); PG8_BAR;
        }
        PG8_STAMP();
        if constexpr (!Epi::AFTER_DRAIN) { E(acc, cur, wr, wc, fr, fq); S.done(cur); }
        PG8_STAMP();
        if (!has_next) break;
#pragma unroll
        for (int a = 0; a < 2; ++a)
#pragma unroll
            for (int b = 0; b < 2; ++b)
#pragma unroll
                for (int m = 0; m < 4; ++m)
#pragma unroll
                    for (int n = 0; n < 2; ++n) acc[a][b][m][n] = (f32x4){0.f, 0.f, 0.f, 0.f};
        cur = nxt; cA = nA; cB = nB; ++ui;
    }
    PG8_WAIT_V(0);
    if (wr == 0) PG8_BAR;
    PG8_BAR;
    if constexpr (Epi::AFTER_DRAIN) { E.fused(acc, cur, wr, wc, fr, fq, lds, wid, lane); S.done(cur); }
    PG8_STAMP();
    if (STAMP && wid == 0) { stamps[lane] = lane < nts ? (((unsigned long long)(unsigned)ts_hi << 32) | (unsigned)ts_lo) : 0ull;
        if (lane == 62) stamps[62] = rt_entry; if (lane == 63) stamps[63] = (unsigned long long)wall_clock64(); }
#undef PG8_STAMP
#undef PG8_SA
#undef PG8_SB
#undef PG8_STAGE
#undef PG8_LDA
#undef PG8_LDB
#undef PG8_MMA
#undef PG8_WAIT_V
#undef PG8_WAIT_L
#undef PG8_BAR
#undef PG8_SCHED
}
}

typedef short bf16x8 __attribute__((ext_vector_type(8)));
typedef float f32x4 __attribute__((ext_vector_type(4)));
typedef unsigned u32x4 __attribute__((ext_vector_type(4)));
using pg8::cvt_pk_bf16; using pg8::bflo; using pg8::bfhi;

#define LDS_WAIT() asm volatile("s_waitcnt lgkmcnt(0)" ::: "memory")
#define CBAR() asm volatile("" ::: "memory")
#define MFMA16(a, b, c) __builtin_amdgcn_mfma_f32_16x16x32_bf16((a), (b), (c), 0, 0, 0)

struct Args { const float* in[25]; float* out; unsigned char* ws; int ph_lo, ph_hi; };

__device__ __forceinline__ float wave_sum(float v) {
#pragma unroll
    for (int o = 1; o < 64; o <<= 1) v += __shfl_xor(v, o);
    return v;
}
__device__ __forceinline__ float wave_max(float v) {
#pragma unroll
    for (int o = 1; o < 64; o <<= 1) v = fmaxf(v, __shfl_xor(v, o));
    return v;
}
__device__ __forceinline__ float gelu_erf(float x) { return 0.5f * x * (1.0f + erff(x * 0.70710678118654752f)); }
__device__ __forceinline__ float gelu_as(float v) {
    const float av = fabsf(v), t = __builtin_amdgcn_rcpf(fmaf(av, 0.2316418882f, 1.0f));
    float q = fmaf(t, 0.5307027145f, -0.7265760135f); q = fmaf(q, t, 0.7107068705f); q = fmaf(q, t, -0.142248368f); q = fmaf(q, t, 0.127414796f); q *= t;
    const float e = __builtin_amdgcn_exp2f(v * v * -0.72134752044f), m = v * (q * e);
    return v < 0.f ? m : v - m;
}
__device__ __forceinline__ bf16x8 as_bf16x8(u32x4 v) { return __builtin_bit_cast(bf16x8, v); }

__device__ __forceinline__ void p0_transpose_item(const float* W, int K, int N, bf16_t* WT, const float* sc_a, const float* sc_b, LAS float* scr, int item, int lane) {
    const int nblk = N / 32, kb = item / nblk, nb = item % nblk, k0 = 64 * kb, n0 = 32 * nb;
#pragma unroll 8
    for (int i = 0; i < 32; ++i) { const int kk = 2 * i + (lane >> 5); const int k = k0 + kk;
        const float s = sc_a ? (k < 1024 ? sc_a[k] : sc_b[k - 1024]) : 1.f;
        scr[kk * 33 + (lane & 31)] = W[(size_t)k * N + n0 + (lane & 31)] * s; }
    LDS_WAIT();
    const int c = lane & 7;
#pragma unroll
    for (int j = 0; j < 4; ++j) { const int n = (lane >> 3) + 8 * j; const LAS float* s = scr + (8 * c) * 33 + n;
        u32x4 o; o.x = cvt_pk_bf16(s[0 * 33], s[1 * 33]); o.y = cvt_pk_bf16(s[2 * 33], s[3 * 33]); o.z = cvt_pk_bf16(s[4 * 33], s[5 * 33]); o.w = cvt_pk_bf16(s[6 * 33], s[7 * 33]);
        *(u32x4*)(WT + (size_t)(n0 + n) * K + k0 + 8 * c) = o; }
    LDS_WAIT();
}
template <int MODE> __device__ __forceinline__ void p0_row(const float* xrow, const float* g, bf16_t* orow, int lane) {
    const f32x4* xr = (const f32x4*)xrow + lane; const f32x4* gr = (const f32x4*)g + lane;
    f32x4 v[8]; float s = 0.f;
#pragma unroll
    for (int j = 0; j < 8; ++j) { v[j] = xr[64 * j]; s += (v[j].x * v[j].x + v[j].y * v[j].y) + (v[j].z * v[j].z + v[j].w * v[j].w); }
    float r = 1.f;
    if (MODE == 0) r = 1.0f / sqrtf(wave_sum(s) * (1.f / 2048.f) + EPS);
    u32x2* o8 = (u32x2*)orow + lane;
#pragma unroll
    for (int j = 0; j < 8; ++j) { f32x4 w = v[j] * r; if (MODE != 2) w = w * gr[64 * j];
        u32x2 o; o.x = cvt_pk_bf16(w.x, w.y); o.y = cvt_pk_bf16(w.z, w.w); o8[64 * j] = o; }
}
template <bool SCALE_G, bool OFFS> __device__ __forceinline__ void p0_row_q8(const float* xrow, const float* g, unsigned char* orow, float* sc, int lane) {
    const f32x4* xr = (const f32x4*)xrow + lane; const f32x4* gr = (const f32x4*)g + lane;
    f32x4 v[8]; float m = 0.f;
#pragma unroll
    for (int j = 0; j < 8; ++j) { v[j] = xr[64 * j]; if (SCALE_G) v[j] = v[j] * gr[64 * j];
        m = fmaxf(fmaxf(m, fmaxf(fabsf(v[j].x), fabsf(v[j].y))), fmaxf(fabsf(v[j].z), fabsf(v[j].w))); }
    m = fmaxf(wave_max(m), 1e-30f);
    const float inv = 127.f / m;
    if (lane == 0) *sc = m * (1.f / 127.f);
    unsigned* o4 = (unsigned*)orow + lane;
#pragma unroll
    for (int j = 0; j < 8; ++j) { const int a = (int)rintf(v[j].x * inv) + (OFFS ? 128 : 0), b = (int)rintf(v[j].y * inv) + (OFFS ? 128 : 0), c = (int)rintf(v[j].z * inv) + (OFFS ? 128 : 0), d = (int)rintf(v[j].w * inv) + (OFFS ? 128 : 0);
        o4[64 * j] = (unsigned)(a & 255) | ((unsigned)(b & 255) << 8) | ((unsigned)(c & 255) << 16) | ((unsigned)(d & 255) << 24); }
}
template <int KIND> __device__ __forceinline__ void p0_rows(const float* src, const float* g, void* dst, float* sc, int first, int stride, int nrows, int lane) {
    const f32x4* gr = (const f32x4*)g + lane;
    f32x4 cur[8], nxt[8], nx2[8];
    int r = first;
    if (r >= nrows) return;
    { const f32x4* xr = (const f32x4*)(src + (size_t)r * 2048) + lane;
#pragma unroll
        for (int j = 0; j < 8; ++j) cur[j] = xr[64 * j]; }
    if (r + stride < nrows) { const f32x4* xr = (const f32x4*)(src + (size_t)(r + stride) * 2048) + lane;
#pragma unroll
        for (int j = 0; j < 8; ++j) nxt[j] = xr[64 * j]; }
    for (; r < nrows; r += stride) {
        const int rn = r + 2 * stride;
        if (rn < nrows) { const f32x4* xr = (const f32x4*)(src + (size_t)rn * 2048) + lane;
#pragma unroll
            for (int j = 0; j < 8; ++j) nx2[j] = xr[64 * j]; }
        if (KIND == 0) {
            float s = 0.f;
#pragma unroll
            for (int j = 0; j < 8; ++j) s += (cur[j].x * cur[j].x + cur[j].y * cur[j].y) + (cur[j].z * cur[j].z + cur[j].w * cur[j].w);
            const float rr = 1.0f / sqrtf(wave_sum(s) * (1.f / 2048.f) + EPS);
            u32x2* o8 = (u32x2*)((bf16_t*)dst + (size_t)r * 2048) + lane;
#pragma unroll
            for (int j = 0; j < 8; ++j) { const f32x4 w = cur[j] * rr * gr[64 * j]; u32x2 o; o.x = cvt_pk_bf16(w.x, w.y); o.y = cvt_pk_bf16(w.z, w.w); o8[64 * j] = o; }
        } else if (KIND >= 3) {
            float ssq = 0.f;
#pragma unroll
            for (int j = 0; j < 8; ++j) { if (KIND == 3) cur[j] = cur[j] * gr[64 * j]; ssq += (cur[j].x * cur[j].x + cur[j].y * cur[j].y) + (cur[j].z * cur[j].z + cur[j].w * cur[j].w); }
            const float rms = sqrtf(fmaxf(wave_sum(ssq) * (1.f / 2048.f), 1e-30f));
            const float sq = 0.1676f * rms, inv = 0.5f / sq;
            if (lane == 0) sc[r] = sq;
            unsigned* o4 = (unsigned*)((unsigned char*)dst + (size_t)r * 2048) + lane;
#pragma unroll
            for (int j = 0; j < 4; ++j) { unsigned w = 0u;
#pragma unroll
                for (int e = 0; e < 4; ++e) { const float lo = cur[j][e], hi = cur[j + 4][e];
                    int nl = (int)rintf(fmaf(lo, inv, 7.5f)), nh = (int)rintf(fmaf(hi, inv, 7.5f));
                    nl = nl < 0 ? 0 : (nl > 15 ? 15 : nl); nh = nh < 0 ? 0 : (nh > 15 ? 15 : nh);
                    w |= ((unsigned)nl << (8 * e)) | ((unsigned)nh << (8 * e + 4)); }
                o4[64 * j] = w; }
        } else {
            float m = 0.f;
#pragma unroll
            for (int j = 0; j < 8; ++j) { if (KIND == 1) cur[j] = cur[j] * gr[64 * j];
                m = fmaxf(fmaxf(m, fmaxf(fabsf(cur[j].x), fabsf(cur[j].y))), fmaxf(fabsf(cur[j].z), fabsf(cur[j].w))); }
            m = fmaxf(wave_max(m), 1e-30f);
            const float inv = 127.f / m; const int off = KIND == 2 ? 128 : 0;
            if (lane == 0) sc[r] = m * (1.f / 127.f);
            unsigned* o4 = (unsigned*)((unsigned char*)dst + (size_t)r * 2048) + lane;
#pragma unroll
            for (int j = 0; j < 8; ++j) { const int a = (int)rintf(cur[j].x * inv) + off, b = (int)rintf(cur[j].y * inv) + off, c = (int)rintf(cur[j].z * inv) + off, d = (int)rintf(cur[j].w * inv) + off;
                o4[64 * j] = (unsigned)(a & 255) | ((unsigned)(b & 255) << 8) | ((unsigned)(c & 255) << 16) | ((unsigned)(d & 255) << 24); }
        }
#pragma unroll
        for (int j = 0; j < 8; ++j) { cur[j] = nxt[j]; nxt[j] = nx2[j]; }
    }
}
__device__ __forceinline__ void p0_wp_item(const float* wq, const float* keys1, const float* keys2, const float* gffn, bf16_t* WPT, int item, int lane) {
    const int hj = item >> 7, ib = item & 127, h = hj >> 1, j = hj & 1, i0 = 16 * ib, col0 = h * 256 + j * 128;
    const int lr = lane & 15, g = lane >> 4;
    const float* keys = (j ? keys2 : keys1) + (size_t)h * 128 * 128;
    const float gi = gffn[i0 + lr];
    bf16x8 af[4];
#pragma unroll
    for (int s = 0; s < 4; ++s) { const float* p = wq + (size_t)(i0 + lr) * 2048 + col0 + 32 * s + 8 * g;
        const f32x4 a = *(const f32x4*)p * gi, b = *(const f32x4*)(p + 4) * gi;
        u32x4 w; w.x = cvt_pk_bf16(a.x, a.y); w.y = cvt_pk_bf16(a.z, a.w); w.z = cvt_pk_bf16(b.x, b.y); w.w = cvt_pk_bf16(b.z, b.w); af[s] = as_bf16x8(w); }
    for (int kt = 0; kt < 8; ++kt) {
        f32x4 d = {0.f, 0.f, 0.f, 0.f};
#pragma unroll
        for (int s = 0; s < 4; ++s) { const float* p = keys + (size_t)(16 * kt + lr) * 128 + 32 * s + 8 * g;
            const f32x4 a = *(const f32x4*)p, b = *(const f32x4*)(p + 4);
            u32x4 w; w.x = cvt_pk_bf16(a.x, a.y); w.y = cvt_pk_bf16(a.z, a.w); w.z = cvt_pk_bf16(b.x, b.y); w.w = cvt_pk_bf16(b.z, b.w);
            d = MFMA16(af[s], as_bf16x8(w), d); }
        u32x2 o; o.x = cvt_pk_bf16(d[0], d[1]); o.y = cvt_pk_bf16(d[2], d[3]);
        *(u32x2*)(WPT + (size_t)(hj * 128 + 16 * kt + lr) * 2048 + i0 + 4 * g) = o;
    }
}
__device__ __forceinline__ int t5_bucket(int n) {
    if (n < 16) return n;
    const int large = 16 + (int)(logf((float)n / 16.f) / 4.852030263919617f * 16.f);
    return large < 31 ? large : 31;
}
__device__ __forceinline__ void p0_ssm_item(const Args& A, unsigned char* sp, int g, int lane) {
    const float* lam_re = A.in[6]; const float* lam_im = A.in[7]; const float* log_dt = A.in[8];
    const float* b_re = A.in[9]; const float* b_im = A.in[10]; const float* c_re = A.in[11]; const float* c_im = A.in[12];
    const int n = lane;
    const float dt = expf(log_dt[g]);
    const float lr = lam_re[g * 64 + n], li = lam_im[g * 64 + n];
    const float mag = expf(lr * dt);
    const float a_re = mag * cosf(li * dt), a_im = mag * sinf(li * dt);
    const float den = lr * lr + li * li;
    const float f_re = ((a_re - 1.f) * lr + a_im * li) / den, f_im = (a_im * lr - (a_re - 1.f) * li) / den;
    ((f32x2*)(sp + SSMP_ABAR))[g * 64 + n] = (f32x2){a_re, a_im};
    float pr = a_re, pi = a_im;
#pragma unroll
    for (int i = 0; i < 8; ++i) { const float nr = pr * pr - pi * pi, ni = 2.f * pr * pi; pr = nr; pi = ni; }
    ((f32x2*)(sp + SSMP_A256))[g * 64 + n] = (f32x2){pr, pi};
    float bbr[16], bbi[16];
#pragma unroll
    for (int q = 0; q < 4; ++q) { const f32x4 br = *(const f32x4*)(b_re + (size_t)(g * 64 + n) * 16 + 4 * q), bi = *(const f32x4*)(b_im + (size_t)(g * 64 + n) * 16 + 4 * q);
#pragma unroll
        for (int e = 0; e < 4; ++e) { bbr[4 * q + e] = f_re * br[e] - f_im * bi[e]; bbi[4 * q + e] = f_re * bi[e] + f_im * br[e]; } }
    bf16_t* bf = (bf16_t*)(sp + SSMP_BFRAG);
    const int jre = n >> 4, n16 = n & 15;
#pragma unroll
    for (int kg = 0; kg < 4; ++kg) {
        u32x4 wr = {0u, 0u, 0u, 0u}, wi = {0u, 0u, 0u, 0u};
        if (kg < 2) { const int c0 = (kg & 1) * 8;
            wr.x = cvt_pk_bf16(bbr[c0 + 0], bbr[c0 + 1]); wr.y = cvt_pk_bf16(bbr[c0 + 2], bbr[c0 + 3]); wr.z = cvt_pk_bf16(bbr[c0 + 4], bbr[c0 + 5]); wr.w = cvt_pk_bf16(bbr[c0 + 6], bbr[c0 + 7]);
            wi.x = cvt_pk_bf16(bbi[c0 + 0], bbi[c0 + 1]); wi.y = cvt_pk_bf16(bbi[c0 + 2], bbi[c0 + 3]); wi.z = cvt_pk_bf16(bbi[c0 + 4], bbi[c0 + 5]); wi.w = cvt_pk_bf16(bbi[c0 + 6], bbi[c0 + 7]); }
        *(u32x4*)(bf + ((size_t)(g * 8 + jre) * 64 + kg * 16 + n16) * 8) = wr;
        *(u32x4*)(bf + ((size_t)(g * 8 + 4 + jre) * 64 + kg * 16 + n16) * 8) = wi;
    }
    bf16_t* cf = (bf16_t*)(sp + SSMP_CFRAG);
    const int ch = lane & 15, kg = lane >> 4;
#pragma unroll
    for (int s = 0; s < 4; ++s) { const int k0 = 32 * s + 8 * kg;
        const float* src = (k0 < 64) ? (c_re + (size_t)(g * 16 + ch) * 64 + k0) : (c_im + (size_t)(g * 16 + ch) * 64 + (k0 - 64));
        const float sg = (k0 < 64) ? 1.f : -1.f;
        const f32x4 a = *(const f32x4*)src * sg, b = *(const f32x4*)(src + 4) * sg;
        u32x4 w; w.x = cvt_pk_bf16(a.x, a.y); w.y = cvt_pk_bf16(a.z, a.w); w.z = cvt_pk_bf16(b.x, b.y); w.w = cvt_pk_bf16(b.z, b.w);
        *(u32x4*)(cf + ((size_t)(g * 4 + s) * 64 + lane) * 8) = w; }
}
__device__ __forceinline__ void p0_btab_item(const Args& A, float* btab, int item, int lane) {
    const float* gq = A.in[3]; const float* gk = A.in[4]; const float* rel_bias = A.in[5];
    const int h = item / 3, br = item % 3, d = br == 0 ? 1 : (br == 1 ? 4 : 16);
    const float G = wave_max(fabsf(gq[lane] * gk[lane]));
    const float mb = wave_max(lane < 32 ? rel_bias[lane * 16 + h] : -1e30f);
    const float smax = 8.4f * G + mb;
    for (int idx = lane; idx < 192; idx += 64) { const int rel = idx - 31;
        float v = -1e30f;
        if (rel >= 0 && rel <= 128) v = LOG2E * (rel_bias[t5_bucket(rel * d) * 16 + h] - smax);
        btab[(h * 3 + br) * 192 + idx] = v; }
}

__device__ __forceinline__ void p0_prologue(const Args& A, LAS unsigned char* lds, int wave, int lane) {
    unsigned char* ws = A.ws;
    LAS float* scr = (LAS float*)(lds + wave * 16384);
    const int gw = blockIdx.x * 8 + wave, NGW = gridDim.x * 8;
    constexpr int I_WIN = (2048 / 64) * (4096 / 32), I_GLU = (1024 / 64) * (1024 / 32), I_WOUT = (2048 / 64) * (2048 / 32), I_WP = 2048;
    constexpr int I_SSM = 64, I_BT = 48;
    constexpr int NITEMS = I_WIN + I_GLU + I_WOUT + I_WP + I_SSM + I_BT;
    for (int it = gw; it < NITEMS; it += NGW) {
        int r = it;
        if (r < I_SSM) { p0_ssm_item(A, ws + WS_SSMP, r, lane); continue; } r -= I_SSM;
        if (r < I_BT) { p0_btab_item(A, (float*)(ws + WS_BTAB), r, lane); continue; } r -= I_BT;
        if (r < I_WP) { p0_wp_item(A.in[20], A.in[21], A.in[22], A.in[19], (bf16_t*)(ws + WS_WPT), r, lane); continue; } r -= I_WP;
        if (r < I_WIN) { p0_transpose_item(A.in[2], 2048, 4096, (bf16_t*)(ws + WS_WINT), nullptr, nullptr, scr, r, lane); continue; } r -= I_WIN;
        if (r < I_GLU) { p0_transpose_item(A.in[14], 1024, 1024, (bf16_t*)(ws + WS_GLUT), nullptr, nullptr, scr, r, lane); continue; } r -= I_GLU;
        p0_transpose_item(A.in[18], 2048, 2048, (bf16_t*)(ws + WS_WOUTT), A.in[16], A.in[17], scr, r, lane);
    }
    p0_rows<0>(A.in[0], A.in[1], ws + WS_HB, nullptr, gw, NGW, 8192, lane);
    p0_rows<3>(A.in[23], A.in[19], ws + WS_UB, (float*)(ws + WS_SU), gw, NGW, 16384, lane);
    p0_rows<4>(A.in[24], A.in[19], ws + WS_UB + 1024, (float*)(ws + WS_SV), gw, NGW, 16384, lane);
}

constexpr int SSM_WL = 8192 + 16 * 272 + 512;
__device__ __forceinline__ void ssm_unit(const Args& A, LAS unsigned char* lds, int b, int g, int wave, int lane) {
    unsigned char* ws = A.ws; unsigned char* sp = ws + WS_SSMP;
    const bf16_t* proj = (const bf16_t*)(ws + WS_PROJ); bf16_t* yb = (bf16_t*)(ws + WS_YB);
    LAS unsigned char* wl = lds + wave * SSM_WL;
    LAS f32x2* BU = (LAS f32x2*)wl; LAS unsigned char* XB = wl + 8192; LAS unsigned char* UL = wl + 8192 + 16 * 272;
    LAS f32x2* carry = (LAS f32x2*)(lds + 8 * SSM_WL);
    const int lr = lane & 15, q = lane >> 4;
    bf16x8 bfr[8], cfr[4];
#pragma unroll
    for (int j = 0; j < 8; ++j) bfr[j] = as_bf16x8(*(const u32x4*)((const bf16_t*)(sp + SSMP_BFRAG) + ((size_t)(g * 8 + j) * 64 + lane) * 8));
#pragma unroll
    for (int s = 0; s < 4; ++s) cfr[s] = as_bf16x8(*(const u32x4*)((const bf16_t*)(sp + SSMP_CFRAG) + ((size_t)(g * 4 + s) * 64 + lane) * 8));
    const f32x2 ab = ((const f32x2*)(sp + SSMP_ABAR))[g * 64 + lane], a256 = ((const f32x2*)(sp + SSMP_A256))[g * 64 + lane];
    const float a_re = ab.x, a_im = ab.y;
    const float dsk = A.in[13][g * 16 + lr];
    const bf16_t* up = proj + (size_t)(b * SEQ + wave * 256) * DPROJ + 3072 + g * 16;
    float xr = 0.f, xi = 0.f;
    for (int pass = 0; pass < 2; ++pass) {
        u32x4 unext = {0u, 0u, 0u, 0u};
        if (q < 2) unext = *(const u32x4*)(up + (size_t)lr * DPROJ + 8 * q);
        for (int blk = 0; blk < 16; ++blk) {
            const u32x4 uraw = unext;
            if (q < 2 && blk < 15) unext = *(const u32x4*)(up + (size_t)((blk + 1) * 16 + lr) * DPROJ + 8 * q);
            const bf16x8 ua = as_bf16x8(uraw);
            if (pass == 1 && q < 2) *(LAS u32x4*)(UL + lr * 32 + q * 16) = uraw;
            f32x4 dd[8];
#pragma unroll
            for (int j = 0; j < 8; ++j) dd[j] = MFMA16(ua, bfr[j], ((f32x4){0.f, 0.f, 0.f, 0.f}));
#pragma unroll
            for (int jj = 0; jj < 4; ++jj)
#pragma unroll
                for (int r = 0; r < 4; ++r) BU[(4 * q + r) * 64 + 16 * jj + lr] = (f32x2){dd[jj][r], dd[4 + jj][r]};
            CBAR();
            f32x2 bu[16];
#pragma unroll
            for (int t = 0; t < 16; ++t) bu[t] = BU[t * 64 + lane];
            if (pass == 0) {
#pragma unroll
                for (int t = 0; t < 16; ++t) { float nr = fmaf(a_re, xr, fmaf(-a_im, xi, bu[t].x)), ni = fmaf(a_re, xi, fmaf(a_im, xr, bu[t].y)); asm volatile("" : "+v"(nr)); asm volatile("" : "+v"(ni)); xr = nr; xi = ni; }
                asm volatile("" : "+v"(xr), "+v"(xi) :: "memory");
            } else {
#pragma unroll
                for (int t = 0; t < 16; ++t) { float nr = fmaf(a_re, xr, fmaf(-a_im, xi, bu[t].x)), ni = fmaf(a_re, xi, fmaf(a_im, xr, bu[t].y)); asm volatile("" : "+v"(nr)); asm volatile("" : "+v"(ni)); xr = nr; xi = ni;
                    const unsigned pk = cvt_pk_bf16(xr, xi);
                    *(LAS unsigned short*)(XB + t * 272 + lane * 2) = (unsigned short)(pk & 0xffffu);
                    *(LAS unsigned short*)(XB + t * 272 + 128 + lane * 2) = (unsigned short)(pk >> 16); }
                CBAR();
                f32x4 y = {0.f, 0.f, 0.f, 0.f};
#pragma unroll
                for (int s = 0; s < 4; ++s) { const bf16x8 xa = as_bf16x8(*(const LAS u32x4*)(XB + lr * 272 + (32 * s + 8 * q) * 2)); y = MFMA16(xa, cfr[s], y); }
#pragma unroll
                for (int r = 0; r < 4; ++r) { const int t = blk * 16 + 4 * q + r;
                    const float uv = __uint_as_float((unsigned)(*(const LAS unsigned short*)(UL + (4 * q + r) * 32 + lr * 2)) << 16);
                    const float yv = gelu_as(y[r] + dsk * uv);
                    yb[(size_t)(b * SEQ + wave * 256 + t) * 1024 + g * 16 + lr] = (bf16_t)(cvt_pk_bf16(yv, 0.f) & 0xffffu); }
                asm volatile("" : "+v"(xr), "+v"(xi) :: "memory");
            }
        }
        if (pass == 0) {
            carry[wave * 64 + lane] = (f32x2){xr, xi};
            __syncthreads();
            float sr = 0.f, si = 0.f;
            for (int w2 = 0; w2 < wave; ++w2) { const f32x2 e = carry[w2 * 64 + lane]; const float nr = a256.x * sr - a256.y * si + e.x, ni = a256.x * si + a256.y * sr + e.y; sr = nr; si = ni; }
            xr = sr; xi = si;
        }
    }
    __syncthreads();
}

__device__ __forceinline__ void prep2_item(const Args& A, LAS unsigned char* wl, int item, int lane) {
    unsigned char* ws = A.ws;
    const bf16_t* proj = (const bf16_t*)(ws + WS_PROJ);
    const int pb = item & 31, h = (item >> 5) & 15, b = item >> 9, P0 = pb * 64, bh = b * 16 + h;
    const int r8 = lane >> 3, c = lane & 7;
    const float* gq = A.in[3]; const float* gk = A.in[4];
    const int fs = c >> 2, fg = c & 3;
#pragma unroll 1
    for (int which = 0; which < 2; ++which) {
        const float* gv = which ? gk : gq; const float cs = which ? 1.f : (LOG2E * 0.125f);
        float gl[8];
#pragma unroll
        for (int e = 0; e < 8; ++e) gl[e] = gv[8 * c + e] * cs;
        bf16_t* F = (bf16_t*)(ws + (which ? WS_KF : WS_QF));
#pragma unroll 2
        for (int i = 0; i < 8; ++i) { const int row = 8 * i + r8, pos = P0 + row;
            const u32x4 raw = *(const u32x4*)(proj + (size_t)(b * SEQ + pos) * DPROJ + which * 1024 + h * 64 + 8 * c);
            float v[8] = {bflo(raw.x), bfhi(raw.x), bflo(raw.y), bfhi(raw.y), bflo(raw.z), bfhi(raw.z), bflo(raw.w), bfhi(raw.w)};
            float ss = 0.f;
#pragma unroll
            for (int e = 0; e < 8; ++e) ss += v[e] * v[e];
            ss += __shfl_xor(ss, 1); ss += __shfl_xor(ss, 2); ss += __shfl_xor(ss, 4);
            const float r = 1.0f / sqrtf(ss * (1.f / 64.f) + EPS);
            u32x4 w; w.x = cvt_pk_bf16(v[0] * r * gl[0], v[1] * r * gl[1]); w.y = cvt_pk_bf16(v[2] * r * gl[2], v[3] * r * gl[3]);
            w.z = cvt_pk_bf16(v[4] * r * gl[4], v[5] * r * gl[5]); w.w = cvt_pk_bf16(v[6] * r * gl[6], v[7] * r * gl[7]);
#pragma unroll
            for (int br = 0; br < 3; ++br) { const int sh = 2 * br, rr = pos & ((1 << sh) - 1), l = pos >> sh;
                *(u32x4*)(F + (size_t)br * 4 * 16 * SEQ * 64 + ((((size_t)(bh << sh) + rr) * (SEQ >> (sh + 4)) + (l >> 4)) * 2 + fs) * 512 + (fg * 16 + (l & 15)) * 8) = w; } }
    }
#pragma unroll
    for (int i = 0; i < 8; ++i) { const int row = 8 * i + r8;
        const u32x4 raw = *(const u32x4*)(proj + (size_t)(b * SEQ + P0 + row) * DPROJ + 2048 + h * 64 + 8 * c);
        *(LAS u32x2*)(wl + row * 136 + c * 16) = (u32x2){raw.x, raw.y}; *(LAS u32x2*)(wl + row * 136 + c * 16 + 8) = (u32x2){raw.z, raw.w}; }
    CBAR();
    unsigned v[64];
#pragma unroll
    for (int p = 0; p < 64; ++p) v[p] = *(const LAS unsigned short*)(wl + p * 136 + lane * 2);
    CBAR();
    bf16_t* vt = (bf16_t*)(ws + WS_VT);
    const int nt = lane >> 4, dl = lane & 15;
#pragma unroll
    for (int G = 0; G < 2; ++G) { bf16_t* tp = vt + ((((size_t)bh * 64 + (P0 >> 5) + G) * 4 + nt) * 64 + dl) * 8;
#pragma unroll
        for (int kg = 0; kg < 4; ++kg) { const int a0 = 32 * G + 4 * kg, b0 = 32 * G + 16 + 4 * kg;
            u32x4 w; w.x = v[a0] | (v[a0 + 1] << 16); w.y = v[a0 + 2] | (v[a0 + 3] << 16); w.z = v[b0] | (v[b0 + 1] << 16); w.w = v[b0 + 2] | (v[b0 + 3] << 16);
            *(u32x4*)(tp + kg * 128) = w; } }
    { bf16_t* vt4 = vt + (size_t)4 * 16 * 64 * SEQ; const int l0 = P0 >> 2, tile = (l0 >> 4) & 1, grp = l0 >> 5;
#pragma unroll
        for (int r = 0; r < 4; ++r) { bf16_t* tp = vt4 + (((((size_t)bh * 4 + r) * 16 + grp) * 4 + nt) * 64 + dl) * 8;
#pragma unroll
            for (int kg = 0; kg < 4; ++kg) { const int p0 = 4 * (4 * kg) + r;
                u32x2 w; w.x = v[p0] | (v[p0 + 4] << 16); w.y = v[p0 + 8] | (v[p0 + 12] << 16);
                *(u32x2*)(tp + kg * 128 + 4 * tile) = w; } } }
    { bf16_t* vt16 = vt + (size_t)2 * 4 * 16 * 64 * SEQ; const int l0 = P0 >> 4, w32 = l0 & 31, tile = (w32 >> 4) & 1, kg = (w32 & 15) >> 2, grp = l0 >> 5;
#pragma unroll
        for (int r = 0; r < 16; ++r) { u32x2 w; w.x = v[r] | (v[16 + r] << 16); w.y = v[32 + r] | (v[48 + r] << 16);
            *(u32x2*)(vt16 + (((((size_t)bh * 16 + r) * 4 + grp) * 4 + nt) * 64 + kg * 16 + dl) * 8 + 4 * tile) = w; } }
}

struct AttnItem { int sh, r, lfirst, ks, tbo; size_t qk_off, v_off; };
__device__ __forceinline__ AttnItem attn_item(int it, int p0, int bh) {
    AttnItem I; const int br = it >> 4, j = it & 15; I.sh = 2 * br; I.tbo = br * 192;
    I.r = j & ((1 << I.sh) - 1); I.lfirst = (p0 >> I.sh) + 16 * (j >> I.sh);
    const size_t rc = (size_t)br * 4 * 16 * SEQ * 64 + ((size_t)(bh << I.sh) + I.r) * (size_t)(SEQ >> I.sh) * 64;
    I.qk_off = rc; I.v_off = rc;
    int ks = (I.lfirst - 128) & ~31; I.ks = ks < 0 ? 0 : ks;
    return I;
}
__device__ __forceinline__ void attn_unit(const Args& A, LAS unsigned char* lds, int unit, int tid, int wave, int lane, int pflags) {
    unsigned char* ws = A.ws;
    const int blk = 7 - (unit >> 6), bh = unit & 63, b = bh >> 4, h = bh & 15, p0 = blk * 256;
    constexpr int OST = 68;
    LAS float* Oacc = (LAS float*)lds; LAS float* lacc = (LAS float*)(lds + 256 * OST * 4); LAS float* tb = (LAS float*)(lds + 256 * OST * 4 + 1024);
    { const float* bt = (const float*)(ws + WS_BTAB) + h * 3 * 192; for (int i = tid; i < 3 * 192; i += 512) tb[i] = bt[i]; }
    __syncthreads();
    const bf16_t* QF = (const bf16_t*)(ws + WS_QF); const bf16_t* KF = (const bf16_t*)(ws + WS_KF); const bf16_t* VF = (const bf16_t*)(ws + WS_VT);
    const int qi = lane & 15, g = lane >> 4;
#define ATT_LOAD(IT, LK, B) do { const AttnItem _I = attn_item(IT, p0, bh); const bf16_t* _kp = KF + _I.qk_off + (size_t)((LK) >> 4) * 1024 + lane * 8; \
        B[0] = *(const u32x4*)(_kp); B[1] = *(const u32x4*)(_kp + 512); B[2] = *(const u32x4*)(_kp + 1024); B[3] = *(const u32x4*)(_kp + 1536); \
        const bf16_t* _vp = VF + _I.v_off + (size_t)((LK) >> 5) * 2048 + lane * 8; \
        B[4] = *(const u32x4*)(_vp); B[5] = *(const u32x4*)(_vp + 512); B[6] = *(const u32x4*)(_vp + 1024); B[7] = *(const u32x4*)(_vp + 1536); \
        const bf16_t* _qp = QF + _I.qk_off + (size_t)(_I.lfirst >> 4) * 1024 + lane * 8; B[8] = *(const u32x4*)(_qp); B[9] = *(const u32x4*)(_qp + 512); } while (0)
#define ATT_ADV(IT, LK, NIT, NLK) do { const AttnItem _J = attn_item(IT, p0, bh); if ((LK) + 32 <= _J.lfirst) { (NIT) = (IT); (NLK) = (LK) + 32; } else { (NIT) = (IT) + 8; (NLK) = 0; if ((NIT) < 48) { const AttnItem _N = attn_item(NIT, p0, bh); (NLK) = _N.ks; } } } while (0)
#define ATT_STEP(CIT, CLK, BC, NIT, NLK, NNIT, NNLK, BNN) { \
        NNIT = 64; NNLK = 0; \
        if ((NIT) < 48) { ATT_ADV(NIT, NLK, NNIT, NNLK); if ((NNIT) < 48) ATT_LOAD(NNIT, NNLK, BNN); } \
        const AttnItem cI = attn_item(CIT, p0, bh); \
        f32x4 sa = {0.f, 0.f, 0.f, 0.f}, sb = {0.f, 0.f, 0.f, 0.f}; \
        sa = MFMA16(as_bf16x8(BC[0]), as_bf16x8(BC[8]), sa); sb = MFMA16(as_bf16x8(BC[2]), as_bf16x8(BC[8]), sb); \
        sa = MFMA16(as_bf16x8(BC[1]), as_bf16x8(BC[9]), sa); sb = MFMA16(as_bf16x8(BC[3]), as_bf16x8(BC[9]), sb); \
        const LAS float* tbb = tb + cI.tbo; \
        const int ba = cI.lfirst + qi - (CLK) - 4 * g + 31; \
        float pa[4], pb[4]; \
        _Pragma("unroll") for (int e = 0; e < 4; ++e) { pa[e] = __builtin_amdgcn_exp2f(sa[e] + tbb[ba - e]); pb[e] = __builtin_amdgcn_exp2f(sb[e] + tbb[ba - 16 - e]); } \
        lsum += (pa[0] + pa[1]) + (pa[2] + pa[3]) + (pb[0] + pb[1]) + (pb[2] + pb[3]); \
        u32x4 pw; pw.x = cvt_pk_bf16(pa[0], pa[1]); pw.y = cvt_pk_bf16(pa[2], pa[3]); pw.z = cvt_pk_bf16(pb[0], pb[1]); pw.w = cvt_pk_bf16(pb[2], pb[3]); \
        const bf16x8 pf = as_bf16x8(pw); \
        _Pragma("unroll") for (int nt = 0; nt < 4; ++nt) o[nt] = MFMA16(pf, as_bf16x8(BC[4 + nt]), o[nt]); \
        if ((CLK) + 32 > cI.lfirst) {     \
            lsum += __shfl_xor(lsum, 16); lsum += __shfl_xor(lsum, 32); \
            const bool first = (CIT) < 16; \
            if (g == 0) { LAS float* lp = lacc + ((((cI.lfirst + qi) << cI.sh) + cI.r) - p0); *lp = first ? lsum : *lp + lsum; } \
            _Pragma("unroll") for (int reg = 0; reg < 4; ++reg) { LAS float* op = Oacc + (((((cI.lfirst + 4 * g + reg) << cI.sh) + cI.r) - p0)) * OST + qi; \
                _Pragma("unroll") for (int nt = 0; nt < 4; ++nt) op[16 * nt] = first ? o[nt][reg] : op[16 * nt] + o[nt][reg]; } \
            _Pragma("unroll") for (int nt = 0; nt < 4; ++nt) o[nt] = (f32x4){0.f, 0.f, 0.f, 0.f}; \
            lsum = 0.f; \
            if (((CIT) >> 3) & 1) __syncthreads();     \
        } \
        if ((NIT) >= 48) break; }
    if (!(pflags & 16)) {
    int itA = wave, lkA, itB, lkB, itC = 64, lkC = 0;
    { const AttnItem I0 = attn_item(wave, p0, bh); lkA = I0.ks; }
    ATT_ADV(itA, lkA, itB, lkB);
    u32x4 bA[10], bB[10], bC[10];
    ATT_LOAD(itA, lkA, bA); if (itB < 48) ATT_LOAD(itB, lkB, bB);
    f32x4 o[4];
#pragma unroll
    for (int nt = 0; nt < 4; ++nt) o[nt] = (f32x4){0.f, 0.f, 0.f, 0.f};
    float lsum = 0.f;
    for (;;) {
        ATT_STEP(itA, lkA, bA, itB, lkB, itC, lkC, bC)
        ATT_STEP(itB, lkB, bB, itC, lkC, itA, lkA, bA)
        ATT_STEP(itC, lkC, bC, itA, lkA, itB, lkB, bB)
    }
    }
#undef ATT_LOAD
#undef ATT_ADV
#undef ATT_STEP
    if (!(pflags & (16 | 32 | 64))) { const int ql = tid >> 1, half = tid & 1; const float inv = 1.0f / lacc[ql];
        bf16_t* dst = (bf16_t*)(ws + WS_MIXED) + (size_t)(b * SEQ + p0 + ql) * 2048 + h * 64 + 32 * half;
        float ss = 0.f;
#pragma unroll
        for (int c4 = 0; c4 < 4; ++c4) { float v[8];
#pragma unroll
            for (int e = 0; e < 8; ++e) { v[e] = Oacc[ql * OST + 32 * half + 8 * c4 + e] * inv; ss += v[e] * v[e]; }
            u32x4 w; w.x = cvt_pk_bf16(v[0], v[1]); w.y = cvt_pk_bf16(v[2], v[3]); w.z = cvt_pk_bf16(v[4], v[5]); w.w = cvt_pk_bf16(v[6], v[7]);
            *(u32x4*)(dst + 8 * c4) = w; }
        ss += __shfl_xor(ss, 1);
        if (half == 0) unsafeAtomicAdd((float*)(ws + WS_CTL + CTL_RSS_ATTN) + b * SEQ + p0 + ql, ss); }
    __syncthreads();
}

__device__ __forceinline__ unsigned fkey(float f) { const unsigned u = __float_as_uint(f); return (u & 0x80000000u) ? ~u : (u | 0x80000000u); }
#define DPP_U(x, ctrl) ((unsigned)__builtin_amdgcn_update_dpp((int)(x), (int)(x), ctrl, 0xf, 0xf, false))
__device__ __forceinline__ unsigned row16_umax(unsigned v) { unsigned t;
    t = DPP_U(v, 0xB1); v = t > v ? t : v; t = DPP_U(v, 0x4E); v = t > v ? t : v; t = DPP_U(v, 0x141); v = t > v ? t : v; t = DPP_U(v, 0x140); v = t > v ? t : v; return v; }
__device__ __forceinline__ float row16_fmax(float v) { float t;
    t = __uint_as_float(DPP_U(__float_as_uint(v), 0xB1)); v = fmaxf(v, t); t = __uint_as_float(DPP_U(__float_as_uint(v), 0x4E)); v = fmaxf(v, t);
    t = __uint_as_float(DPP_U(__float_as_uint(v), 0x141)); v = fmaxf(v, t); t = __uint_as_float(DPP_U(__float_as_uint(v), 0x140)); v = fmaxf(v, t); return v; }
__device__ __forceinline__ float row16_fsum(float v) {
    v += __uint_as_float(DPP_U(__float_as_uint(v), 0xB1)); v += __uint_as_float(DPP_U(__float_as_uint(v), 0x4E));
    v += __uint_as_float(DPP_U(__float_as_uint(v), 0x141)); v += __uint_as_float(DPP_U(__float_as_uint(v), 0x140)); return v; }
__device__ __forceinline__ unsigned wave_umax(unsigned v) { v = row16_umax(v);
    const unsigned a = (unsigned)__builtin_amdgcn_readlane((int)v, 0), b = (unsigned)__builtin_amdgcn_readlane((int)v, 16), c = (unsigned)__builtin_amdgcn_readlane((int)v, 32), d = (unsigned)__builtin_amdgcn_readlane((int)v, 48);
    const unsigned ab = a > b ? a : b, cd = c > d ? c : d; return ab > cd ? ab : cd; }
template <int R> __device__ __forceinline__ void select16(const unsigned (&key)[R], unsigned long long (&m)[R]) {
    unsigned mx = key[0];
#pragma unroll
    for (int r = 1; r < R; ++r) mx = key[r] > mx ? key[r] : mx;
    mx = wave_umax(mx);
    unsigned lo = mx > (3u << 23) ? mx - (3u << 23) : 0u, hi = mx + 1u;
    int cnt = 0;
#pragma unroll
    for (int r = 0; r < R; ++r) cnt += __popcll(__ballot(key[r] >= lo));
    if (cnt < 16) { lo = 0u; cnt = R * 64; }
    while (cnt != 16 && hi - lo > 1u) { const unsigned mid = lo + ((hi - lo) >> 1); int c = 0;
#pragma unroll
        for (int r = 0; r < R; ++r) c += __popcll(__ballot(key[r] >= mid));
        if (c >= 16) { lo = mid; cnt = c; } else hi = mid; }
    const unsigned T = lo;
    if (cnt == 16) {
#pragma unroll
        for (int r = 0; r < R; ++r) m[r] = __ballot(key[r] >= T);
    } else {
        int need = 16;
#pragma unroll
        for (int r = 0; r < R; ++r) { m[r] = __ballot(key[r] > T); need -= __popcll(m[r]); }
#pragma unroll
        for (int r = 0; r < R; ++r) { unsigned long long eq = __ballot(key[r] == T);
            while (__popcll(eq) > need) eq &= ~(1ull << (63 - __builtin_clzll(eq)));
            need -= __popcll(eq); m[r] |= eq; }
    }
}
__device__ __forceinline__ void peer_topk(const float (&sv4)[4], LAS float* sc, LAS int* exo, LAS float* gto, int lane) {
    LAS float* v1 = sc; LAS int* i1 = (LAS int*)(sc + 16); LAS float* v2 = sc + 32; LAS int* i2 = (LAS int*)(sc + 48); LAS float* sv = sc + 64; LAS int* si = (LAS int*)(sc + 80);
    const unsigned long long lt = (1ull << lane) - 1ull;
#pragma unroll
    for (int half = 0; half < 2; ++half) {
        const float a0 = sv4[2 * half], a1 = sv4[2 * half + 1];
        const unsigned key[2] = {fkey(a0), fkey(a1)}; unsigned long long m[2];
        select16<2>(key, m);
        LAS float* vv = half ? v2 : v1; LAS int* ii = half ? i2 : i1;
        if ((m[0] >> lane) & 1ull) { const int pos = __popcll(m[0] & lt); vv[pos] = a0; ii[pos] = lane; }
        if ((m[1] >> lane) & 1ull) { const int pos = __popcll(m[0]) + __popcll(m[1] & lt); vv[pos] = a1; ii[pos] = 64 + lane; }
    }
    CBAR(); LDS_WAIT();
    const int a = lane >> 2, bb = (lane & 3) * 4;
    const float va = v1[a]; float cv[4]; unsigned key[4]; unsigned long long m[4];
#pragma unroll
    for (int e = 0; e < 4; ++e) { cv[e] = va + v2[bb + e]; key[e] = fkey(cv[e]); }
    select16<4>(key, m);
    int base = 0;
#pragma unroll
    for (int e = 0; e < 4; ++e) { if ((m[e] >> lane) & 1ull) { const int pos = base + __popcll(m[e] & lt); sv[pos] = cv[e]; si[pos] = a * 16 + bb + e; } base += __popcll(m[e]); }
    CBAR(); LDS_WAIT();
    if (lane < 16) {
        const float val = sv[lane]; const int fi = si[lane];
        const float mx = row16_fmax(val);
        const float ex = __expf(val - mx); const float sum = row16_fsum(ex);
        exo[lane] = i1[fi >> 4] * 128 + (i2[fi & 15] - 0);
        gto[lane] = ex / sum;
    }
    CBAR(); LDS_WAIT();
}

__device__ __forceinline__ float ubyte_f32(unsigned w, int i) { return (float)((w >> (8 * i)) & 0xffu); }
__device__ __forceinline__ void peer_wave(const Args& A, LAS unsigned char* lds, int wave, int lane, int pflags) {
    unsigned char* ws = A.ws;
    const float* scores = (const float*)(ws + WS_PROJ);
    const unsigned char* uv = ws + WS_UB; const bf16_t* x1b = (const bf16_t*)(ws + WS_HB);
    const float* su = (const float*)(ws + WS_SU); const float* sv = (const float*)(ws + WS_SV);
    const float* rssx = (const float*)(ws + WS_CTL + CTL_RSS_X1);
    LAS int* exl = (LAS int*)(lds + wave * 4096);
    LAS float* gtl = (LAS float*)(lds + wave * 4096 + 2048);
    LAS float* sc = (LAS float*)(lds + 32768 + wave * 512);
    LAS float* cul = (LAS float*)(lds + 40960 + wave * 1024);
    const int t0 = (blockIdx.x * 8 + wave) * 4;
    if (t0 >= NTOK) return;
#define LOAD_SCORES(dst, t, h) do { const float* _sp = scores + (size_t)(t) * 2048 + (h) * 256 + lane; dst[0] = _sp[0]; dst[1] = _sp[64]; dst[2] = _sp[128]; dst[3] = _sp[192]; } while (0)
    { float nx[4]; LOAD_SCORES(nx, t0, 0);
#pragma unroll 1
        for (int h = 0; h < 8; ++h) { const float cs[4] = {nx[0], nx[1], nx[2], nx[3]};
            if (h < 7) LOAD_SCORES(nx, t0, h + 1);
            peer_topk(cs, sc, exl + h * 16, gtl + h * 16, lane); } }
    CBAR(); LDS_WAIT();
    if (pflags & 256) return;
    int ex0 = exl[lane], ex1 = exl[64 + lane];
    float rss = rssx[t0], su0 = su[ex0], su1 = su[ex1], sv0 = sv[ex0], sv1 = sv[ex1];
    float sn[4] = {0.f, 0.f, 0.f, 0.f};
    LOAD_SCORES(sn, t0 + 1, 0);
    u32x4 bu[8], bv[8];
    volatile LAS u32x4* vls = (volatile LAS u32x4*)(lds + 49152 + wave * 8192);
#define ISSUE_E(slot, e0r, e1r, k) do { const int _e = __builtin_amdgcn_readlane((k) < 64 ? (e0r) : (e1r), (k) & 63); \
        const unsigned char* _p = uv + (size_t)_e * 2048 + 16 * lane; bu[slot] = *(const u32x4*)_p; bv[slot] = *(const u32x4*)(_p + 1024); } while (0)
#pragma unroll
    for (int i = 0; i < 8; ++i) ISSUE_E(i, ex0, ex1, i);
    float acc[32];
#pragma unroll 1
    for (int tok = 0; tok < 4; ++tok) {
        const int t = t0 + tok;
        unsigned xq[8]; float sx; int xsum;
        { float xf[32];
#pragma unroll
            for (int v4 = 0; v4 < 4; ++v4) { const u32x4 xr4 = *(const u32x4*)(x1b + (size_t)t * 2048 + 16 * lane + 1024 * (v4 >> 1) + 8 * (v4 & 1));
                const unsigned rw[4] = {xr4.x, xr4.y, xr4.z, xr4.w};
#pragma unroll
                for (int e = 0; e < 4; ++e) { xf[8 * v4 + 2 * e] = bflo(rw[e]); xf[8 * v4 + 2 * e + 1] = bfhi(rw[e]); } }
            float m = 0.f;
#pragma unroll
            for (int i = 0; i < 32; ++i) { m = fmaxf(m, fabsf(xf[i])); acc[i] = xf[i]; }
            m = fmaxf(wave_max(m), 1e-30f);
            const float inv = 127.f / m; sx = m * (1.f / 127.f);
            int ls = 0;
#pragma unroll
            for (int d = 0; d < 8; ++d) { const int a = (int)rintf(xf[4 * d] * inv), b = (int)rintf(xf[4 * d + 1] * inv), c = (int)rintf(xf[4 * d + 2] * inv), e = (int)rintf(xf[4 * d + 3] * inv);
                ls += (a + b) + (c + e);
                xq[d] = (unsigned)(a & 255) | ((unsigned)(b & 255) << 8) | ((unsigned)(c & 255) << 16) | ((unsigned)(e & 255) << 24); }
#pragma unroll
            for (int o = 1; o < 64; o <<= 1) ls += __shfl_xor(ls, o);
            xsum = ls; }
        const float ascale = sx / sqrtf(rss * (1.f / 2048.f) + EPS);
        cul[lane] = ascale * su0; cul[64 + lane] = ascale * su1;
        cul[128 + lane] = 2.f * gtl[tok * 128 + lane] * sv0; cul[192 + lane] = 2.f * gtl[tok * 128 + 64 + lane] * sv1;
        CBAR(); LDS_WAIT();
        float wsum = 0.f;
        int nex0 = ex0, nex1 = ex1; float nrss = 1.f, nsu0 = 0.f, nsu1 = 0.f, nsv0 = 0.f, nsv1 = 0.f;
#pragma unroll 1
        for (int k0 = 0; k0 < 128; k0 += 8) {
            if (tok < 3 && k0 == 120) {
                nex0 = exl[(tok + 1) * 128 + lane]; nex1 = exl[(tok + 1) * 128 + 64 + lane];
                nrss = rssx[t + 1]; nsu0 = su[nex0]; nsu1 = su[nex1]; nsv0 = sv[nex0]; nsv1 = sv[nex1];
                if (tok < 2) LOAD_SCORES(sn, t + 2, 0); }
            int p[8];
#pragma unroll
            for (int i = 0; i < 8; ++i) { int ac = 0;
                const unsigned w4[4] = {bu[i].x, bu[i].y, bu[i].z, bu[i].w};
#pragma unroll
                for (int e = 0; e < 4; ++e) { ac = __builtin_amdgcn_sdot4((int)(w4[e] & 0x0F0F0F0Fu), (int)xq[e], ac, false); ac = __builtin_amdgcn_sdot4((int)((w4[e] >> 4) & 0x0F0F0F0Fu), (int)xq[4 + e], ac, false); }
                p[i] = ac; { volatile LAS unsigned* vp = (volatile LAS unsigned*)(vls + i * 64 + lane); vp[0] = bv[i].x; vp[1] = bv[i].y; vp[2] = bv[i].z; vp[3] = bv[i].w; } __builtin_amdgcn_sched_barrier(0); }
            { const bool nxt = (k0 + 8) >= 128;
              const int kb = (k0 + 8) & 127; const int sel = nxt ? (kb < 64 ? nex0 : nex1) : (kb < 64 ? ex0 : ex1);
#pragma unroll
              for (int i = 0; i < 8; ++i) { const int _e = __builtin_amdgcn_readlane(sel, (kb & 63) + i);
                  const unsigned char* _p = uv + (size_t)_e * 2048 + 16 * lane; bu[i] = *(const u32x4*)_p; bv[i] = *(const u32x4*)(_p + 1024); } }
            float wcur;
            { const bool b0 = lane & 1, b1 = lane & 2, b2 = lane & 4;
            int q4[4], q2[2], q1;
#pragma unroll
            for (int i = 0; i < 4; ++i) { const int keep = b0 ? p[i + 4] : p[i], send = b0 ? p[i] : p[i + 4]; q4[i] = keep + __shfl_xor(send, 1); }
#pragma unroll
            for (int i = 0; i < 2; ++i) { const int keep = b1 ? q4[i + 2] : q4[i], send = b1 ? q4[i] : q4[i + 2]; q2[i] = keep + __shfl_xor(send, 2); }
            { const int keep = b2 ? q2[1] : q2[0], send = b2 ? q2[0] : q2[1]; q1 = keep + __shfl_xor(send, 4); }
            q1 += __shfl_xor(q1, 8); q1 += __shfl_xor(q1, 16); q1 += __shfl_xor(q1, 32);
            const int k = (k0 + 4 * (lane & 1) + 2 * ((lane >> 1) & 1) + ((lane >> 2) & 1)) & 127;
            const float a = (float)(2 * q1 - 15 * xsum) * cul[k];
            wcur = cul[128 + k] * gelu_as(a); }
            CBAR();
#pragma unroll 1
            for (int i = 0; i < 8; ++i) { const int rl = ((i & 1) << 2) | (i & 2) | ((i >> 2) & 1);
                const float w = __builtin_bit_cast(float, __builtin_amdgcn_readlane(__builtin_bit_cast(int, wcur), rl));
                wsum += w;
                u32x4 vv; { volatile LAS unsigned* vp = (volatile LAS unsigned*)(vls + i * 64 + lane); vv.x = vp[0]; vv.y = vp[1]; vv.z = vp[2]; vv.w = vp[3]; }
                const unsigned w4[4] = {vv.x, vv.y, vv.z, vv.w};
#pragma unroll
                for (int e = 0; e < 4; ++e) { const unsigned lo = w4[e] & 0x0F0F0F0Fu, hi = (w4[e] >> 4) & 0x0F0F0F0Fu;
#pragma unroll
                    for (int bb = 0; bb < 4; ++bb) { acc[4 * e + bb] += w * ubyte_f32(lo, bb); acc[16 + 4 * e + bb] += w * ubyte_f32(hi, bb); } }
                __builtin_amdgcn_sched_barrier(0); }
            CBAR();
            if (tok < 3 && !(k0 & 8)) { const int hh = k0 >> 4;
                const float cs[4] = {sn[0], sn[1], sn[2], sn[3]};
                if (hh < 7) LOAD_SCORES(sn, t + 1, hh + 1);
                peer_topk(cs, sc, exl + (tok + 1) * 128 + hh * 16, gtl + (tok + 1) * 128 + hh * 16, lane); }
        }
        const float corr = -7.5f * wsum;
        float* op = A.out + (size_t)t * 2048 + 16 * lane;
        if (!(pflags & 128)) {
#pragma unroll
        for (int j = 0; j < 2; ++j)
#pragma unroll
            for (int c4 = 0; c4 < 4; ++c4) { const int a0 = 16 * j + 4 * c4;
                *(f32x4*)(op + 1024 * j + 4 * c4) = (f32x4){acc[a0] + corr, acc[a0 + 1] + corr, acc[a0 + 2] + corr, acc[a0 + 3] + corr}; }
        } else if (corr == 12345.678f) op[0] = acc[0];
        ex0 = nex0; ex1 = nex1; rss = nrss; su0 = nsu0; su1 = nsu1; sv0 = nsv0; sv1 = nsv1;
    }
#undef ISSUE_E
#undef LOAD_SCORES
}

__global__ void __launch_bounds__(512, 2) mk_fwd(Args args) {
    extern __shared__ __attribute__((aligned(16))) unsigned char lds_raw[];
    LAS unsigned char* lds = (LAS unsigned char*)lds_raw;
    const int tid = threadIdx.x, lane = tid & 63, wave = __builtin_amdgcn_readfirstlane(tid >> 6);
    volatile LAS unsigned* MISC = (volatile LAS unsigned*)(lds + MISC_OFF);
    if (tid < 64) MISC[tid] = 0u;
    __syncthreads();
    unsigned char* ws = args.ws;
    const int lo = args.ph_lo, hi = args.ph_hi & 0xff, pflags = args.ph_hi >> 8;
    XcdBarrier bar; bar.bar = (unsigned*)(ws + WS_CTL); bar.x = 0; bar.st = nullptr;
    if (hi - lo > 1) bar = xcd_barrier_post((unsigned*)(ws + WS_CTL), MISC + 8);
#ifndef PH_MASK
#define PH_MASK 0x7f
#endif
#define IN(k) (((PH_MASK >> (k)) & 1) && lo <= (k) && (k) < hi)
#define SEAM(k) do { if (IN(k) && IN((k) + 1)) xcd_barrier(bar); } while (0)

    if (IN(0)) { p0_prologue(args, lds, wave, lane); }
    SEAM(0);
    if (IN(1)) {
        pg8::Gemm g{(const bf16_t*)(ws + WS_HB), (const bf16_t*)(ws + WS_WINT), NTOK, DPROJ, DM}; pg8::StaticOrder S; S.init(NTOK, DPROJ, gridDim.x, (int)blockIdx.x);
        pg8::EpiProj E{(bf16_t*)(ws + WS_PROJ), DPROJ};
        pg8::gemm_phase<pg8::EpiProj, pg8::StaticOrder, false>(lds, g, S, E, nullptr);
    }
    SEAM(1);
    if (IN(2)) {
        if (!(pflags & 4)) for (int u = blockIdx.x; u < 256; u += gridDim.x) ssm_unit(args, lds, u >> 6, u & 63, wave, lane);
        if (!(pflags & 8)) for (int it = blockIdx.x * 8 + wave; it < 2048; it += gridDim.x * 8) prep2_item(args, lds + wave * SSM_WL, it, lane);
    }
    SEAM(2);
    if (IN(3)) {
        if (!(pflags & 2)) {
            pg8::Gemm g{(const bf16_t*)(ws + WS_YB), (const bf16_t*)(ws + WS_GLUT), NTOK, 1024, 1024}; pg8::StaticOrder S; S.init(NTOK, 1024, gridDim.x, (int)blockIdx.x);
            pg8::EpiGlu E{(const bf16_t*)(ws + WS_YB), (bf16_t*)(ws + WS_MIXED) + 1024, args.in[15], (float*)(ws + WS_CTL + CTL_RSS_SSM)};
            pg8::gemm_phase<pg8::EpiGlu, pg8::StaticOrder, false>(lds, g, S, E, nullptr);
        }
        __syncthreads();
        if (!(pflags & 1)) for (;;) {
            if (tid == 0) MISC[0] = atomicAdd((unsigned*)(ws + WS_CTL + CTL_QCTR), 1u);
            __syncthreads();
            const unsigned u = MISC[0];
            __syncthreads();
            if (u >= 512u) break;
            attn_unit(args, lds, (int)u, tid, wave, lane, pflags);
        }
    }
    SEAM(3);
    if (IN(4)) {
        pg8::Gemm g{(const bf16_t*)(ws + WS_MIXED), (const bf16_t*)(ws + WS_WOUTT), NTOK, DM, DM}; pg8::StaticOrder S; S.init(NTOK, DM, gridDim.x, (int)blockIdx.x);
        LAS float* tab = (LAS float*)(lds + 131072);
        { pg8::Unit u0; if (S.next(0, u0) && tid < 256) { const int row = u0.pm * 256 + tid;
            const float ra = 1.0f / sqrtf(((const float*)(ws + WS_CTL + CTL_RSS_ATTN))[row] * (1.f / 1024.f) + EPS), rs = 1.0f / sqrtf(((const float*)(ws + WS_CTL + CTL_RSS_SSM))[row] * (1.f / 1024.f) + EPS);
            tab[tid] = ra / rs; tab[256 + tid] = rs; } }
        __syncthreads();
        pg8::EpiWout E{args.in[0], args.out, (bf16_t*)(ws + WS_HB), (float*)(ws + WS_CTL + CTL_RSS_X1), tab};
        pg8::gemm_phase<pg8::EpiWout, pg8::StaticOrder, false>(lds, g, S, E, nullptr);
    }
    SEAM(4);
    if (IN(5)) {
        pg8::Gemm g{(const bf16_t*)(ws + WS_HB), (const bf16_t*)(ws + WS_WPT), NTOK, DM, DM}; pg8::StaticOrder S; S.init(NTOK, DM, gridDim.x, (int)blockIdx.x);
        pg8::EpiScores E{(float*)(ws + WS_PROJ), (const float*)(ws + WS_CTL + CTL_RSS_X1)};
        pg8::gemm_phase<pg8::EpiScores, pg8::StaticOrder, false>(lds, g, S, E, nullptr);
    }
    SEAM(5);
    if (IN(6)) { peer_wave(args, lds, wave, lane, pflags); }
#undef IN
#undef SEAM
}

#ifndef MK_DEBUG
#ifndef MK_PER_PHASE
#define MK_PER_PHASE 0
#endif
extern "C" void kernel_launch(void* const* d_in, const int* in_sizes, int n_in, void* d_out, int out_size, void* d_ws, size_t ws_size, hipStream_t stream) {
    static int grid = 0;
    if (grid == 0) {
        if (n_in != 25 || out_size != NTOK * DM || ws_size < WS_END) { fprintf(stderr, "kernel_launch: unexpected shapes / workspace (%d inputs, out %d, ws %zu < %zu)\n", n_in, out_size, ws_size, (size_t)WS_END); grid = -1; return; }
        int dev = 0, cus = 0, per_cu = 0;
        if (hipGetDevice(&dev) != hipSuccess || hipDeviceGetAttribute(&cus, hipDeviceAttributeMultiprocessorCount, dev) != hipSuccess) { grid = -1; return; }
        if (hipFuncSetAttribute((const void*)mk_fwd, hipFuncAttributeMaxDynamicSharedMemorySize, LDS_BYTES) != hipSuccess) { fprintf(stderr, "kernel_launch: hipFuncSetAttribute failed\n"); grid = -1; return; }
        if (hipOccupancyMaxActiveBlocksPerMultiprocessor(&per_cu, (const void*)mk_fwd, 512, LDS_BYTES) != hipSuccess || per_cu < 1) { fprintf(stderr, "kernel_launch: occupancy query reports %d\n", per_cu); }
        (void)hipGetLastError();
        grid = cus;
    }
    if (grid < 0) return;
    (void)hipMemsetAsync((char*)d_ws + WS_CTL, 0, CTL_BYTES, stream);
    Args a{};
    for (int i = 0; i < 25; ++i) a.in[i] = (const float*)d_in[i];
    a.out = (float*)d_out; a.ws = (unsigned char*)d_ws;
#if MK_PER_PHASE
#ifndef MK_DUP
#define MK_DUP -1
#endif
    for (int p = 0; p < 7; ++p) { a.ph_lo = p; a.ph_hi = p + 1; hipLaunchKernelGGL(mk_fwd, dim3(grid), dim3(512), LDS_BYTES, stream, a);
        if (p == MK_DUP) {
            (void)hipMemsetAsync((char*)d_ws + WS_CTL + CTL_QCTR, 0, 256, stream);
#ifndef MK_DUP_FLAGS
#define MK_DUP_FLAGS 0
#endif
            if (p == 3 && !((MK_DUP_FLAGS) & (1 | 16 | 32 | 64))) (void)hipMemsetAsync((char*)d_ws + WS_CTL + CTL_RSS_ATTN, 0, 32768, stream);
            if (p == 3 && !((MK_DUP_FLAGS) & 2)) (void)hipMemsetAsync((char*)d_ws + WS_CTL + CTL_RSS_SSM, 0, 32768, stream);
            if (p == 4) (void)hipMemsetAsync((char*)d_ws + WS_CTL + CTL_RSS_X1, 0, 32768, stream);
            a.ph_hi |= (MK_DUP_FLAGS) << 8;
            hipLaunchKernelGGL(mk_fwd, dim3(grid), dim3(512), LDS_BYTES, stream, a); } }
#else
    a.ph_lo = 0; a.ph_hi = 7;
    hipLaunchKernelGGL(mk_fwd, dim3(grid), dim3(512), LDS_BYTES, stream, a);
#endif
}
#endif
```

```cpp
#include <hip/hip_runtime.h>
#include <stdint.h>
#include <stdio.h>

typedef unsigned short bf16_t;
typedef float f32x2 __attribute__((ext_vector_type(2)));
typedef unsigned u32x2 __attribute__((ext_vector_type(2)));
using bf16x2v = __attribute__((ext_vector_type(2))) __bf16;

constexpr int NTOK = 8192, SEQ = 2048, DM = 2048, DPROJ = 4096;
constexpr float EPS = 1e-6f;
constexpr float LOG2E = 1.4426950408889634f;

constexpr size_t MB = 1024 * 1024;
constexpr size_t WS_CTL = 0;
constexpr size_t CTL_BYTES = 128 * 1024;
constexpr size_t CTL_QCTR = 16384;
constexpr size_t CTL_RSS_ATTN = 32768, CTL_RSS_SSM = 65536, CTL_RSS_X1 = 98304;
constexpr size_t WS_HB = 256 * 1024;
constexpr size_t WS_WINT = WS_HB + 32 * MB;
constexpr size_t WS_GLUT = WS_WINT + 16 * MB;
constexpr size_t WS_WOUTT = WS_GLUT + 2 * MB;
constexpr size_t WS_WPT = WS_WOUTT + 8 * MB;
constexpr size_t WS_UB = WS_WPT + 8 * MB;
constexpr size_t WS_VB = WS_UB + 32 * MB;
constexpr size_t WS_SU = WS_VB + 32 * MB;
constexpr size_t WS_SV = WS_SU + 65536;
constexpr size_t WS_PROJ = WS_SV + 65536;
constexpr size_t WS_QF = WS_PROJ + 64 * MB;
constexpr size_t WS_KF = WS_QF + 48 * MB;
constexpr size_t WS_VT = WS_KF + 48 * MB;
constexpr size_t WS_QN = WS_QF, WS_KN = WS_KF;
constexpr size_t WS_YB = WS_VT + 48 * MB + 4096;
constexpr size_t WS_MIXED = WS_YB + 16 * MB;
constexpr size_t WS_SSMP = WS_MIXED + 32 * MB;
constexpr size_t SSMP_ABAR = 0, SSMP_A256 = 32768, SSMP_BFRAG = 65536, SSMP_CFRAG = 65536 + 524288;
constexpr size_t WS_BTAB = WS_SSMP + 1 * MB;
constexpr size_t WS_END = WS_BTAB + 64 * 1024;

constexpr int LDS_BYTES = 147456;
constexpr int MISC_OFF = 147456 - 256;
#define XB_TMO      128
#define XB_XCNT(j)  (256  + 64 * (j))
#define XB_XSUB(j)  (1280 + 64 * (j))
#define XB_XGEN(j)  (2304 + 64 * (j))
#define XB_TOP      3328
#define XB_TOPGEN   3392
#define XCD_BAR_WORDS 3456
#define XB_SPIN_CAP (1u << 18)
#define LAS __attribute__((address_space(3)))

__device__ __forceinline__ unsigned xb_ld(unsigned* p)              { return __hip_atomic_load(p, __ATOMIC_RELAXED, __HIP_MEMORY_SCOPE_AGENT); }
__device__ __forceinline__ unsigned xb_add(unsigned* p, unsigned v) { return __hip_atomic_fetch_add(p, v, __ATOMIC_RELAXED, __HIP_MEMORY_SCOPE_AGENT); }
__device__ __forceinline__ unsigned xb_xcc_id() { return (unsigned)__builtin_amdgcn_s_getreg((3 << 11) | 20) & 0xFu; }
#define XB_SPIN(cond, bar) do { unsigned _sp = 0; while (cond) { __builtin_amdgcn_s_sleep(1); \
    if ((++_sp & 255u) == 0u) { if (xb_ld(&(bar)[XB_TMO])) break; if (_sp > XB_SPIN_CAP) { atomicAdd(&(bar)[XB_TMO], 1u); break; } } } } while (0)

struct XcdBarrier {
    unsigned* bar; unsigned x;
    volatile LAS unsigned* st;
};

__device__ __forceinline__ XcdBarrier xcd_barrier_post(unsigned* bar, volatile LAS unsigned* st) {
    XcdBarrier b; b.bar = bar; b.x = xb_xcc_id(); b.st = st;
    if (threadIdx.x == 0) (void)xb_add(&bar[XB_XCNT(b.x)], 1u);
    return b;
}
__device__ __forceinline__ void xcd_barrier_complete(unsigned* bar, unsigned x, unsigned& nloc, unsigned& nx) {
    const unsigned G = gridDim.x * gridDim.y * gridDim.z;
    unsigned sum, cnt, mine, sp = 0u;
    for (;;) {
        sum = 0u; cnt = 0u; mine = 0u;
#pragma unroll
        for (unsigned j = 0; j < 16; ++j) { const unsigned c = xb_ld(&bar[XB_XCNT(j)]); sum += c; cnt += (c > 0u) ? 1u : 0u; mine = (j == x) ? c : mine; }
        if (sum == G) break;
        __builtin_amdgcn_s_sleep(1);
        if ((++sp & 255u) == 0u) { if (xb_ld(&bar[XB_TMO])) break; if (sp > XB_SPIN_CAP) { atomicAdd(&bar[XB_TMO], 1u); break; } }
    }
    nloc = mine > 0u ? mine : 1u; nx = cnt > 0u ? cnt : 1u;
}

__device__ __forceinline__ void xcd_barrier(const XcdBarrier& b) {
    asm volatile("s_waitcnt vmcnt(0)" ::: "memory");
    __syncthreads();
    if (threadIdx.x == 0) {
        unsigned* bar = b.bar;
        __builtin_amdgcn_s_waitcnt(0);
        unsigned nloc = b.st[0], nx = b.st[1];
        if (nloc == 0u) { xcd_barrier_complete(bar, b.x, nloc, nx); b.st[0] = nloc; b.st[1] = nx; }
        const unsigned old = xb_add(&bar[XB_XSUB(b.x)], 1u);
        const unsigned gen = old / nloc;
        if (old + 1u == (gen + 1u) * nloc) {
            __builtin_amdgcn_fence(__ATOMIC_RELEASE, "agent");
            asm volatile("s_waitcnt vmcnt(0)" ::: "memory");
            const unsigned og = xb_add(&bar[XB_TOP], 1u);
            const unsigned tg = og / nx;
            if (og + 1u == (tg + 1u) * nx) xb_add(&bar[XB_TOPGEN], 1u);
            else XB_SPIN(xb_ld(&bar[XB_TOPGEN]) == tg, bar);
            __builtin_amdgcn_fence(__ATOMIC_ACQUIRE, "agent");
            xb_add(&bar[XB_XGEN(b.x)], 1u);
            asm volatile("s_waitcnt vmcnt(0)" ::: "memory");
        } else {
            XB_SPIN(xb_ld(&bar[XB_XGEN(b.x)]) == gen, bar);
            __builtin_amdgcn_fence(__ATOMIC_ACQUIRE, "agent");
            asm volatile("s_waitcnt vmcnt(0)" ::: "memory");
        }
    }
    __syncthreads();
}
namespace pg8 {
#define PG8_LAS __attribute__((address_space(3)))
typedef unsigned short bf16_t;
typedef short bf16x8 __attribute__((ext_vector_type(8)));
typedef float f32x4 __attribute__((ext_vector_type(4)));
typedef unsigned u32x4 __attribute__((ext_vector_type(4)));
constexpr int BM = 256, BK = 64, HALF = 128, HTB = HALF * BK * 2  , STAGE_BYTES = 8 * HTB, NXCD = 8, WGM = 8;

__host__ __device__ __forceinline__ int lds_byte(int r, int c) { const int st = (r >> 4) * 2 + (c >> 5), rr = r & 15, cc = c & 31, ob = rr * 64 + cc * 2; return st * 1024 + (ob ^ (((ob >> 9) & 1) << 5)); }
__host__ __device__ __forceinline__ void stage_rc(int b, int& R, int& C) { const int st = b / 1024, sb = b % 1024, swz = sb ^ (((sb >> 9) & 1) << 5); R = (st >> 1) * 16 + swz / 64; C = (st & 1) * 32 + (swz % 64) / 2; }
__host__ __device__ __forceinline__ int perm32(int rho) { const int n = rho >> 4, i = rho & 15; return 8 * (i >> 2) + 4 * n + (i & 3); }

struct Unit { int pm, pn; };
struct Gemm { const bf16_t* A; const bf16_t* Bt; int M, N, K; };

struct StaticOrder {
    int nM, nN, nwg, G, c;
    __host__ __device__ void init(int M, int N, int G_, int c_) { nM = M / BM; nN = N / BM; nwg = nM * nN; G = G_; c = c_; }
    __host__ __device__ bool next(int i, Unit& u) const {
        const long L = (long)i * G + c; if (L >= nwg) return false;
        int wgid = (int)L; { const int q = nwg / NXCD, r = nwg % NXCD, xcd = wgid % NXCD, off = wgid / NXCD; wgid = (xcd < r ? xcd * (q + 1) : r * (q + 1) + (xcd - r) * q) + off; }
        const int nig = WGM * nN, gid = wgid / nig, fm = gid * WGM, gsz = (nM - fm) < WGM ? (nM - fm) : WGM;
        u.pm = fm + ((wgid % nig) % gsz); u.pn = (wgid % nig) / gsz; return true;
    }
    __device__ __forceinline__ void a_ready(const Unit&) const {}
    __device__ __forceinline__ void done(const Unit&) const {}
};
typedef float cvt_f32x2 __attribute__((ext_vector_type(2)));
typedef __bf16 cvt_bf16x2 __attribute__((ext_vector_type(2)));
__device__ __forceinline__ unsigned cvt_pk_bf16(float lo, float hi) { return __builtin_bit_cast(unsigned, __builtin_convertvector((cvt_f32x2){lo, hi}, cvt_bf16x2)); }
__device__ __forceinline__ float bflo(unsigned u) { return __uint_as_float(u << 16); }
__device__ __forceinline__ float bfhi(unsigned u) { return __uint_as_float(u & 0xffff0000u); }

struct EpiProj {
    static constexpr bool PERM = true, AFTER_DRAIN = false, HAS_MID = false;
    bf16_t* O; int ldc;
    __device__ __forceinline__ void mid(f32x4 (&)[2][2][4][2], const Unit&, int, int, int, int) const {}
    __device__ __forceinline__ void operator()(const f32x4 (&acc)[2][2][4][2], const Unit& u, int wr, int wc, int fr, int fq) const {
        const int row0 = u.pm * BM + wr * 64 + fr, col0 = u.pn * BM + wc * 32 + 8 * fq;
#pragma unroll
        for (int ai = 0; ai < 2; ++ai)
#pragma unroll
            for (int m = 0; m < 4; ++m) { bf16_t* rowp = O + (size_t)(row0 + ai * HALF + m * 16) * ldc + col0;
#pragma unroll
                for (int bj = 0; bj < 2; ++bj) { const f32x4 v0 = acc[ai][bj][m][0], v1 = acc[ai][bj][m][1];
                    u32x4 w; w.x = cvt_pk_bf16(v0[0], v0[1]); w.y = cvt_pk_bf16(v0[2], v0[3]); w.z = cvt_pk_bf16(v1[0], v1[1]); w.w = cvt_pk_bf16(v1[2], v1[3]);
                    *(u32x4*)(rowp + bj * HALF) = w; } }
    }
};

struct EpiGlu {
    static constexpr bool PERM = true, AFTER_DRAIN = false, HAS_MID = false;
    const bf16_t* Y; bf16_t* O; const float* bias; float* rss;
    __device__ __forceinline__ void mid(f32x4 (&)[2][2][4][2], const Unit&, int, int, int, int) const {}
    __device__ __forceinline__ void operator()(const f32x4 (&acc)[2][2][4][2], const Unit& u, int wr, int wc, int fr, int fq) const {
        const int row0 = u.pm * BM + wr * 64 + fr, col0 = u.pn * BM + wc * 32 + 8 * fq;
        f32x4 bv[2][2];
#pragma unroll
        for (int bj = 0; bj < 2; ++bj)
#pragma unroll
            for (int n = 0; n < 2; ++n) bv[bj][n] = *(const f32x4*)(bias + col0 + bj * HALF + 4 * n);
        u32x4 yq[2][2];
#pragma unroll
        for (int bj = 0; bj < 2; ++bj) yq[0][bj] = *(const u32x4*)(Y + (size_t)row0 * 1024 + col0 + bj * HALF);
#pragma unroll
        for (int idx = 0; idx < 8; ++idx) { const int ai = idx >> 2, m = idx & 3, row = row0 + ai * HALF + m * 16; float ss = 0.f;
            if (idx < 7) { const int nrow = row0 + ((idx + 1) >> 2) * HALF + ((idx + 1) & 3) * 16;
#pragma unroll
                for (int bj = 0; bj < 2; ++bj) yq[(idx + 1) & 1][bj] = *(const u32x4*)(Y + (size_t)nrow * 1024 + col0 + bj * HALF); }
#pragma unroll
            for (int bj = 0; bj < 2; ++bj) {
                const u32x4 yv = yq[idx & 1][bj];
                const f32x4 g0 = acc[ai][bj][m][0] + bv[bj][0], g1 = acc[ai][bj][m][1] + bv[bj][1];
                float y[8] = {bflo(yv.x), bfhi(yv.x), bflo(yv.y), bfhi(yv.y), bflo(yv.z), bfhi(yv.z), bflo(yv.w), bfhi(yv.w)};
                float o[8];
#pragma unroll
                for (int e = 0; e < 4; ++e) { o[e] = y[e] * __builtin_amdgcn_rcpf(1.f + __expf(-g0[e])); o[4 + e] = y[4 + e] * __builtin_amdgcn_rcpf(1.f + __expf(-g1[e])); }
#pragma unroll
                for (int e = 0; e < 8; ++e) ss += o[e] * o[e];
                u32x4 w; w.x = cvt_pk_bf16(o[0], o[1]); w.y = cvt_pk_bf16(o[2], o[3]); w.z = cvt_pk_bf16(o[4], o[5]); w.w = cvt_pk_bf16(o[6], o[7]);
                *(u32x4*)(O + (size_t)row * 2048 + col0 + bj * HALF) = w; }
            ss += __shfl_xor(ss, 16); ss += __shfl_xor(ss, 32);
            if (fq == 0) unsafeAtomicAdd(rss + row, ss); }
    }
};

struct EpiWout {
    static constexpr bool PERM = true, AFTER_DRAIN = false, HAS_MID = true;
    const float* X; float* OUT; bf16_t* XB; float* rss_x; const PG8_LAS float* tab;
    __device__ __forceinline__ void mid(f32x4 (&acc)[2][2][4][2], const Unit& u, int wr, int wc, int fr, int fq) const {
        const PG8_LAS float* tp = tab + wr * 64 + fr;
#pragma unroll
        for (int ai = 0; ai < 2; ++ai)
#pragma unroll
            for (int m = 0; m < 4; ++m) { const float ratio = tp[ai * HALF + m * 16];
#pragma unroll
                for (int bj = 0; bj < 2; ++bj)
#pragma unroll
                    for (int n = 0; n < 2; ++n) acc[ai][bj][m][n] *= ratio; }
    }
    __device__ __forceinline__ void operator()(const f32x4 (&acc)[2][2][4][2], const Unit& u, int wr, int wc, int fr, int fq) const {
        const int row0 = u.pm * BM + wr * 64 + fr, col0 = u.pn * BM + wc * 32 + 8 * fq;
        const PG8_LAS float* tp = tab + 256 + wr * 64 + fr;
        f32x4 xq[2][2][2];
#pragma unroll
        for (int bj = 0; bj < 2; ++bj) { const size_t o = (size_t)row0 * 2048 + col0 + bj * HALF; xq[0][bj][0] = *(const f32x4*)(X + o); xq[0][bj][1] = *(const f32x4*)(X + o + 4); }
#pragma unroll
        for (int idx = 0; idx < 8; ++idx) { const int ai = idx >> 2, m = idx & 3, row = row0 + ai * HALF + m * 16; float ss = 0.f;
            if (idx < 7) { const int nrow = row0 + ((idx + 1) >> 2) * HALF + ((idx + 1) & 3) * 16;
#pragma unroll
                for (int bj = 0; bj < 2; ++bj) { const size_t o = (size_t)nrow * 2048 + col0 + bj * HALF; xq[(idx + 1) & 1][bj][0] = *(const f32x4*)(X + o); xq[(idx + 1) & 1][bj][1] = *(const f32x4*)(X + o + 4); } }
            const float rs = tp[ai * HALF + m * 16];
#pragma unroll
            for (int bj = 0; bj < 2; ++bj) { const size_t o = (size_t)row * 2048 + col0 + bj * HALF;
                const f32x4 v0 = xq[idx & 1][bj][0] + rs * acc[ai][bj][m][0], v1 = xq[idx & 1][bj][1] + rs * acc[ai][bj][m][1];
                u32x4 w; w.x = cvt_pk_bf16(v0[0], v0[1]); w.y = cvt_pk_bf16(v0[2], v0[3]); w.z = cvt_pk_bf16(v1[0], v1[1]); w.w = cvt_pk_bf16(v1[2], v1[3]);
                *(u32x4*)(XB + o) = w;
#pragma unroll
                for (int e = 0; e < 4; ++e) ss += v0[e] * v0[e] + v1[e] * v1[e]; }
            ss += __shfl_xor(ss, 16); ss += __shfl_xor(ss, 32);
            if (fq == 0) unsafeAtomicAdd(rss_x + row, ss); }
    }
};

struct EpiScores {
    static constexpr bool PERM = false, AFTER_DRAIN = false, HAS_MID = false;
    float* C; const float* rss_x;
    __device__ __forceinline__ void mid(f32x4 (&)[2][2][4][2], const Unit&, int, int, int, int) const {}
    __device__ __forceinline__ void operator()(const f32x4 (&acc)[2][2][4][2], const Unit& u, int wr, int wc, int fr, int fq) const {
        const int row0 = u.pm * BM + wr * 64 + fr, col0 = u.pn * BM + wc * 32 + 4 * fq;
        float r2v[8];
#pragma unroll
        for (int idx = 0; idx < 8; ++idx) r2v[idx] = rss_x[row0 + (idx >> 2) * HALF + (idx & 3) * 16];
#pragma unroll
        for (int ai = 0; ai < 2; ++ai)
#pragma unroll
            for (int m = 0; m < 4; ++m) { const int row = row0 + ai * HALF + m * 16;
                const float r2 = __builtin_amdgcn_rsqf(r2v[ai * 4 + m] * (1.f / 2048.f) + 1e-6f);
                float* rowp = C + (size_t)row * 2048 + col0;
#pragma unroll
                for (int bj = 0; bj < 2; ++bj)
#pragma unroll
                    for (int n = 0; n < 2; ++n) *(f32x4*)(rowp + bj * HALF + n * 16) = acc[ai][bj][m][n] * r2; }
    }
};

template <class Epi, class Sched, bool STAMP = false>
__device__ __forceinline__ void gemm_phase(PG8_LAS unsigned char* lds, const Gemm g, const Sched& S, const Epi& E, unsigned long long* stamps) {
    const int tid = threadIdx.x, wid = __builtin_amdgcn_readfirstlane(tid >> 6), lane = tid & 63, wr = wid >> 2, wc = wid & 3, fr = lane & 15, fq = lane >> 4;
    const int K = g.K, nt = K / BK;
    int ts_lo = 0, ts_hi = 0, nts = 0; const unsigned long long rt_entry = STAMP ? (unsigned long long)wall_clock64() : 0ull;
#define PG8_STAMP() do { if (STAMP && wid == 0 && nts < 64) { const unsigned long long _c = (unsigned long long)clock64(); \
        ts_lo = (lane == nts) ? (int)(unsigned)_c : ts_lo; ts_hi = (lane == nts) ? (int)(unsigned)(_c >> 32) : ts_hi; ++nts; } } while (0)
    PG8_STAMP();
    unsigned voffA[2], voffB[2];
#pragma unroll
    for (int i = 0; i < 2; ++i) { int R, C; stage_rc(tid * 16 + i * 8192, R, C); const int Rb = Epi::PERM ? ((R & ~31) + perm32(R & 31)) : R;
        voffA[i] = (unsigned)(R * K + C) * 2u; voffB[i] = (unsigned)(Rb * K + C) * 2u; }
    const size_t kstep = (size_t)(BK * 2);
    const size_t hstep = (size_t)HALF * K * 2;
    const size_t tstep = 2 * hstep;
    const unsigned ldsw = (unsigned)wid * 1024u;
    const int aoff = lds_byte(wr * 64 + fr, fq * 8), boff = lds_byte(wc * 32 + fr, fq * 8);
#define PG8_SA(b, h) (((b) * 2 + (h)) * HTB)
#define PG8_SB(b, h) ((4 + (b) * 2 + (h)) * HTB)
#define PG8_STAGE(bufoff, gbase, voff) do { _Pragma("unroll") for (int _i = 0; _i < 2; ++_i) \
        __builtin_amdgcn_global_load_lds((const unsigned*)((const char*)(gbase) + (voff)[_i]), (PG8_LAS unsigned*)(lds + (bufoff) + ldsw + _i * 8192), 16, 0, 0); } while (0)
#define PG8_LDA(dst, b, h) do { _Pragma("unroll") for (int m = 0; m < 4; ++m) _Pragma("unroll") for (int k = 0; k < 2; ++k) dst[m][k] = *(const PG8_LAS bf16x8*)(lds + PG8_SA(b, h) + aoff + m * 2048 + k * 1024); } while (0)
#define PG8_LDB(dst, b, h) do { _Pragma("unroll") for (int n = 0; n < 2; ++n) _Pragma("unroll") for (int k = 0; k < 2; ++k) dst[n][k] = *(const PG8_LAS bf16x8*)(lds + PG8_SB(b, h) + boff + n * 2048 + k * 1024); } while (0)
#define PG8_MMA(ai, bj, At, Bt) do { __builtin_amdgcn_s_setprio(1); _Pragma("unroll") for (int m = 0; m < 4; ++m) _Pragma("unroll") for (int n = 0; n < 2; ++n) _Pragma("unroll") for (int k = 0; k < 2; ++k) \
        acc[ai][bj][m][n] = __builtin_amdgcn_mfma_f32_16x16x32_bf16(Bt[n][k], At[m][k], acc[ai][bj][m][n], 0, 0, 0); __builtin_amdgcn_s_setprio(0); } while (0)
#define PG8_WAIT_V(n) asm volatile("s_waitcnt vmcnt(" #n ")" ::: "memory")
#define PG8_WAIT_L(n) asm volatile("s_waitcnt lgkmcnt(" #n ")" ::: "memory")
#define PG8_BAR __builtin_amdgcn_s_barrier()
#define PG8_SCHED __builtin_amdgcn_sched_barrier(0)
    Unit cur, nxt; int ui = 0;
    if (!S.next(0, cur)) return;
    f32x4 acc[2][2][4][2];
#pragma unroll
    for (int a = 0; a < 2; ++a)
#pragma unroll
        for (int b = 0; b < 2; ++b)
#pragma unroll
            for (int m = 0; m < 4; ++m)
#pragma unroll
                for (int n = 0; n < 2; ++n) acc[a][b][m][n] = (f32x4){0.f, 0.f, 0.f, 0.f};
    bf16x8 At[4][2], B0[2][2], B1[2][2];
    const char* cA = (const char*)g.A + (size_t)cur.pm * tstep; const char* cB = (const char*)g.Bt + (size_t)cur.pn * tstep;
    S.a_ready(cur);
    PG8_STAGE(PG8_SB(0, 0), cB, voffB); PG8_STAGE(PG8_SA(0, 0), cA, voffA); PG8_STAGE(PG8_SB(0, 1), cB + hstep, voffB); PG8_STAGE(PG8_SA(0, 1), cA + hstep, voffA);
    if (wr == 1) PG8_BAR;
    PG8_WAIT_V(4); PG8_BAR;
    PG8_STAGE(PG8_SB(1, 0), cB + kstep, voffB); PG8_STAGE(PG8_SA(1, 0), cA + kstep, voffA); PG8_STAGE(PG8_SB(1, 1), cB + hstep + kstep, voffB);
    PG8_WAIT_V(6); PG8_BAR;
    PG8_STAMP();
    for (;;) {
        const bool has_next = S.next(ui + 1, nxt);
        const char* nA = has_next ? (const char*)g.A + (size_t)nxt.pm * tstep : cA; const char* nB = has_next ? (const char*)g.Bt + (size_t)nxt.pn * tstep : cB;
        for (int t = 0; t < nt; t += 2) {
            const bool last = (t == nt - 2);
            const char* a1 = cA + (size_t)(t + 1) * kstep;
            const char* a2 = last ? nA : cA + (size_t)(t + 2) * kstep; const char* b2 = last ? nB : cB + (size_t)(t + 2) * kstep;
            const char* a3 = a2 + kstep; const char* b3 = b2 + kstep;
            if (last && has_next) S.a_ready(nxt);
            if constexpr (Epi::HAS_MID) { if (t == (nt >> 1)) { E.mid(acc, cur, wr, wc, fr, fq); asm volatile("s_waitcnt lgkmcnt(0)" ::: "memory"); } }
            PG8_LDB(B0, 0, 0); PG8_SCHED; PG8_LDA(At, 0, 0); PG8_STAGE(PG8_SA(1, 1), a1 + hstep, voffA);
            PG8_WAIT_L(8); PG8_BAR; PG8_WAIT_L(0); PG8_MMA(0, 0, At, B0); PG8_BAR; PG8_SCHED;
            PG8_LDB(B1, 0, 1); PG8_STAGE(PG8_SB(0, 0), b2, voffB);
            PG8_BAR; PG8_WAIT_L(0); PG8_MMA(0, 1, At, B1); PG8_BAR;
            PG8_LDA(At, 0, 1); PG8_STAGE(PG8_SA(0, 0), a2, voffA);
            PG8_BAR; PG8_WAIT_L(0); PG8_MMA(1, 0, At, B0); PG8_BAR; PG8_SCHED;
            PG8_STAGE(PG8_SB(0, 1), b2 + hstep, voffB);
            PG8_WAIT_V(6); PG8_BAR; PG8_MMA(1, 1, At, B1); PG8_BAR;
            PG8_LDB(B0, 1, 0); PG8_SCHED; PG8_LDA(At, 1, 0); PG8_STAGE(PG8_SA(0, 1), a2 + hstep, voffA);
            PG8_WAIT_L(8); PG8_BAR; PG8_WAIT_L(0); PG8_MMA(0, 0, At, B0); PG8_BAR; PG8_SCHED;
            PG8_LDB(B1, 1, 1); PG8_STAGE(PG8_SB(1, 0), b3, voffB);
            PG8_BAR; PG8_WAIT_L(0); PG8_MMA(0, 1, At, B1); PG8_BAR;
            PG8_LDA(At, 1, 1); PG8_STAGE(PG8_SA(1, 0), a3, voffA);
            PG8_BAR; PG8_WAIT_L(0); PG8_MMA(1, 0, At, B0); PG8_BAR; PG8_SCHED;
            PG8_STAGE(PG8_SB(1, 1), b3 + hstep, voffB);
            PG8_WAIT_V(6); PG8_BAR; PG8_MMA(1, 1, At, B1); PG8_BAR;
        }
        PG8_STAMP();
        if constexpr (!Epi::AFTER_DRAIN) { E(acc, cur, wr, wc, fr, fq); S.done(cur); }
        PG8_STAMP();
        if (!has_next) break;
#pragma unroll
        for (int a = 0; a < 2; ++a)
#pragma unroll
            for (int b = 0; b < 2; ++b)
#pragma unroll
                for (int m = 0; m < 4; ++m)
#pragma unroll
                    for (int n = 0; n < 2; ++n) acc[a][b][m][n] = (f32x4){0.f, 0.f, 0.f, 0.f};
        cur = nxt; cA = nA; cB = nB; ++ui;
    }
    PG8_WAIT_V(0);
    if (wr == 0) PG8_BAR;
    PG8_BAR;
    if constexpr (Epi::AFTER_DRAIN) { E.fused(acc, cur, wr, wc, fr, fq, lds, wid, lane); S.done(cur); }
    PG8_STAMP();
    if (STAMP && wid == 0) { stamps[lane] = lane < nts ? (((unsigned long long)(unsigned)ts_hi << 32) | (unsigned)ts_lo) : 0ull;
        if (lane == 62) stamps[62] = rt_entry; if (lane == 63) stamps[63] = (unsigned long long)wall_clock64(); }
#undef PG8_STAMP
#undef PG8_SA
#undef PG8_SB
#undef PG8_STAGE
#undef PG8_LDA
#undef PG8_LDB
#undef PG8_MMA
#undef PG8_WAIT_V
#undef PG8_WAIT_L
#undef PG8_BAR
#undef PG8_SCHED
}
}

typedef short bf16x8 __attribute__((ext_vector_type(8)));
typedef float f32x4 __attribute__((ext_vector_type(4)));
typedef unsigned u32x4 __attribute__((ext_vector_type(4)));
using pg8::cvt_pk_bf16; using pg8::bflo; using pg8::bfhi;

#define LDS_WAIT() asm volatile("s_waitcnt lgkmcnt(0)" ::: "memory")
#define CBAR() asm volatile("" ::: "memory")
#define MFMA16(a, b, c) __builtin_amdgcn_mfma_f32_16x16x32_bf16((a), (b), (c), 0, 0, 0)

struct Args { const float* in[25]; float* out; unsigned char* ws; int ph_lo, ph_hi; };

__device__ __forceinline__ float wave_sum(float v) {
#pragma unroll
    for (int o = 1; o < 64; o <<= 1) v += __shfl_xor(v, o);
    return v;
}
__device__ __forceinline__ float wave_max(float v) {
#pragma unroll
    for (int o = 1; o < 64; o <<= 1) v = fmaxf(v, __shfl_xor(v, o));
    return v;
}
__device__ __forceinline__ float gelu_erf(float x) { return 0.5f * x * (1.0f + erff(x * 0.70710678118654752f)); }
__device__ __forceinline__ float gelu_as(float v) {
    const float av = fabsf(v), t = __builtin_amdgcn_rcpf(fmaf(av, 0.2316418882f, 1.0f));
    float q = fmaf(t, 0.5307027145f, -0.7265760135f); q = fmaf(q, t, 0.7107068705f); q = fmaf(q, t, -0.142248368f); q = fmaf(q, t, 0.127414796f); q *= t;
    const float e = __builtin_amdgcn_exp2f(v * v * -0.72134752044f), m = v * (q * e);
    return v < 0.f ? m : v - m;
}
__device__ __forceinline__ bf16x8 as_bf16x8(u32x4 v) { return __builtin_bit_cast(bf16x8, v); }

__device__ __forceinline__ void p0_transpose_item(const float* W, int K, int N, bf16_t* WT, const float* sc_a, const float* sc_b, LAS float* scr, int item, int lane) {
    const int nblk = N / 32, kb = item / nblk, nb = item % nblk, k0 = 64 * kb, n0 = 32 * nb;
#pragma unroll 8
    for (int i = 0; i < 32; ++i) { const int kk = 2 * i + (lane >> 5); const int k = k0 + kk;
        const float s = sc_a ? (k < 1024 ? sc_a[k] : sc_b[k - 1024]) : 1.f;
        scr[kk * 33 + (lane & 31)] = W[(size_t)k * N + n0 + (lane & 31)] * s; }
    LDS_WAIT();
    const int c = lane & 7;
#pragma unroll
    for (int j = 0; j < 4; ++j) { const int n = (lane >> 3) + 8 * j; const LAS float* s = scr + (8 * c) * 33 + n;
        u32x4 o; o.x = cvt_pk_bf16(s[0 * 33], s[1 * 33]); o.y = cvt_pk_bf16(s[2 * 33], s[3 * 33]); o.z = cvt_pk_bf16(s[4 * 33], s[5 * 33]); o.w = cvt_pk_bf16(s[6 * 33], s[7 * 33]);
        *(u32x4*)(WT + (size_t)(n0 + n) * K + k0 + 8 * c) = o; }
    LDS_WAIT();
}
template <int MODE> __device__ __forceinline__ void p0_row(const float* xrow, const float* g, bf16_t* orow, int lane) {
    const f32x4* xr = (const f32x4*)xrow + lane; const f32x4* gr = (const f32x4*)g + lane;
    f32x4 v[8]; float s = 0.f;
#pragma unroll
    for (int j = 0; j < 8; ++j) { v[j] = xr[64 * j]; s += (v[j].x * v[j].x + v[j].y * v[j].y) + (v[j].z * v[j].z + v[j].w * v[j].w); }
    float r = 1.f;
    if (MODE == 0) r = 1.0f / sqrtf(wave_sum(s) * (1.f / 2048.f) + EPS);
    u32x2* o8 = (u32x2*)orow + lane;
#pragma unroll
    for (int j = 0; j < 8; ++j) { f32x4 w = v[j] * r; if (MODE != 2) w = w * gr[64 * j];
        u32x2 o; o.x = cvt_pk_bf16(w.x, w.y); o.y = cvt_pk_bf16(w.z, w.w); o8[64 * j] = o; }
}
template <bool SCALE_G, bool OFFS> __device__ __forceinline__ void p0_row_q8(const float* xrow, const float* g, unsigned char* orow, float* sc, int lane) {
    const f32x4* xr = (const f32x4*)xrow + lane; const f32x4* gr = (const f32x4*)g + lane;
    f32x4 v[8]; float m = 0.f;
#pragma unroll
    for (int j = 0; j < 8; ++j) { v[j] = xr[64 * j]; if (SCALE_G) v[j] = v[j] * gr[64 * j];
        m = fmaxf(fmaxf(m, fmaxf(fabsf(v[j].x), fabsf(v[j].y))), fmaxf(fabsf(v[j].z), fabsf(v[j].w))); }
    m = fmaxf(wave_max(m), 1e-30f);
    const float inv = 127.f / m;
    if (lane == 0) *sc = m * (1.f / 127.f);
    unsigned* o4 = (unsigned*)orow + lane;
#pragma unroll
    for (int j = 0; j < 8; ++j) { const int a = (int)rintf(v[j].x * inv) + (OFFS ? 128 : 0), b = (int)rintf(v[j].y * inv) + (OFFS ? 128 : 0), c = (int)rintf(v[j].z * inv) + (OFFS ? 128 : 0), d = (int)rintf(v[j].w * inv) + (OFFS ? 128 : 0);
        o4[64 * j] = (unsigned)(a & 255) | ((unsigned)(b & 255) << 8) | ((unsigned)(c & 255) << 16) | ((unsigned)(d & 255) << 24); }
}
template <int KIND> __device__ __forceinline__ void p0_rows(const float* src, const float* g, void* dst, float* sc, int first, int stride, int nrows, int lane) {
    const f32x4* gr = (const f32x4*)g + lane;
    f32x4 cur[8], nxt[8], nx2[8];
    int r = first;
    if (r >= nrows) return;
    { const f32x4* xr = (const f32x4*)(src + (size_t)r * 2048) + lane;
#pragma unroll
        for (int j = 0; j < 8; ++j) cur[j] = xr[64 * j]; }
    if (r + stride < nrows) { const f32x4* xr = (const f32x4*)(src + (size_t)(r + stride) * 2048) + lane;
#pragma unroll
        for (int j = 0; j < 8; ++j) nxt[j] = xr[64 * j]; }
    for (; r < nrows; r += stride) {
        const int rn = r + 2 * stride;
        if (rn < nrows) { const f32x4* xr = (const f32x4*)(src + (size_t)rn * 2048) + lane;
#pragma unroll
            for (int j = 0; j < 8; ++j) nx2[j] = xr[64 * j]; }
        if (KIND == 0) {
            float s = 0.f;
#pragma unroll
            for (int j = 0; j < 8; ++j) s += (cur[j].x * cur[j].x + cur[j].y * cur[j].y) + (cur[j].z * cur[j].z + cur[j].w * cur[j].w);
            const float rr = 1.0f / sqrtf(wave_sum(s) * (1.f / 2048.f) + EPS);
            u32x2* o8 = (u32x2*)((bf16_t*)dst + (size_t)r * 2048) + lane;
#pragma unroll
            for (int j = 0; j < 8; ++j) { const f32x4 w = cur[j] * rr * gr[64 * j]; u32x2 o; o.x = cvt_pk_bf16(w.x, w.y); o.y = cvt_pk_bf16(w.z, w.w); o8[64 * j] = o; }
        } else if (KIND >= 3) {
            float ssq = 0.f;
#pragma unroll
            for (int j = 0; j < 8; ++j) { if (KIND == 3) cur[j] = cur[j] * gr[64 * j]; ssq += (cur[j].x * cur[j].x + cur[j].y * cur[j].y) + (cur[j].z * cur[j].z + cur[j].w * cur[j].w); }
            const float rms = sqrtf(fmaxf(wave_sum(ssq) * (1.f / 2048.f), 1e-30f));
            const float sq = 0.1676f * rms, inv = 0.5f / sq;
            if (lane == 0) sc[r] = sq;
            unsigned* o4 = (unsigned*)((unsigned char*)dst + (size_t)r * 2048) + lane;
#pragma unroll
            for (int j = 0; j < 4; ++j) { unsigned w = 0u;
#pragma unroll
                for (int e = 0; e < 4; ++e) { const float lo = cur[j][e], hi = cur[j + 4][e];
                    int nl = (int)rintf(fmaf(lo, inv, 7.5f)), nh = (int)rintf(fmaf(hi, inv, 7.5f));
                    nl = nl < 0 ? 0 : (nl > 15 ? 15 : nl); nh = nh < 0 ? 0 : (nh > 15 ? 15 : nh);
                    w |= ((unsigned)nl << (8 * e)) | ((unsigned)nh << (8 * e + 4)); }
                o4[64 * j] = w; }
        } else {
            float m = 0.f;
#pragma unroll
            for (int j = 0; j < 8; ++j) { if (KIND == 1) cur[j] = cur[j] * gr[64 * j];
                m = fmaxf(fmaxf(m, fmaxf(fabsf(cur[j].x), fabsf(cur[j].y))), fmaxf(fabsf(cur[j].z), fabsf(cur[j].w))); }
            m = fmaxf(wave_max(m), 1e-30f);
            const float inv = 127.f / m; const int off = KIND == 2 ? 128 : 0;
            if (lane == 0) sc[r] = m * (1.f / 127.f);
            unsigned* o4 = (unsigned*)((unsigned char*)dst + (size_t)r * 2048) + lane;
#pragma unroll
            for (int j = 0; j < 8; ++j) { const int a = (int)rintf(cur[j].x * inv) + off, b = (int)rintf(cur[j].y * inv) + off, c = (int)rintf(cur[j].z * inv) + off, d = (int)rintf(cur[j].w * inv) + off;
                o4[64 * j] = (unsigned)(a & 255) | ((unsigned)(b & 255) << 8) | ((unsigned)(c & 255) << 16) | ((unsigned)(d & 255) << 24); }
        }
#pragma unroll
        for (int j = 0; j < 8; ++j) { cur[j] = nxt[j]; nxt[j] = nx2[j]; }
    }
}
__device__ __forceinline__ void p0_wp_item(const float* wq, const float* keys1, const float* keys2, const float* gffn, bf16_t* WPT, int item, int lane) {
    const int hj = item >> 7, ib = item & 127, h = hj >> 1, j = hj & 1, i0 = 16 * ib, col0 = h * 256 + j * 128;
    const int lr = lane & 15, g = lane >> 4;
    const float* keys = (j ? keys2 : keys1) + (size_t)h * 128 * 128;
    const float gi = gffn[i0 + lr];
    bf16x8 af[4];
#pragma unroll
    for (int s = 0; s < 4; ++s) { const float* p = wq + (size_t)(i0 + lr) * 2048 + col0 + 32 * s + 8 * g;
        const f32x4 a = *(const f32x4*)p * gi, b = *(const f32x4*)(p + 4) * gi;
        u32x4 w; w.x = cvt_pk_bf16(a.x, a.y); w.y = cvt_pk_bf16(a.z, a.w); w.z = cvt_pk_bf16(b.x, b.y); w.w = cvt_pk_bf16(b.z, b.w); af[s] = as_bf16x8(w); }
    for (int kt = 0; kt < 8; ++kt) {
        f32x4 d = {0.f, 0.f, 0.f, 0.f};
#pragma unroll
        for (int s = 0; s < 4; ++s) { const float* p = keys + (size_t)(16 * kt + lr) * 128 + 32 * s + 8 * g;
            const f32x4 a = *(const f32x4*)p, b = *(const f32x4*)(p + 4);
            u32x4 w; w.x = cvt_pk_bf16(a.x, a.y); w.y = cvt_pk_bf16(a.z, a.w); w.z = cvt_pk_bf16(b.x, b.y); w.w = cvt_pk_bf16(b.z, b.w);
            d = MFMA16(af[s], as_bf16x8(w), d); }
        u32x2 o; o.x = cvt_pk_bf16(d[0], d[1]); o.y = cvt_pk_bf16(d[2], d[3]);
        *(u32x2*)(WPT + (size_t)(hj * 128 + 16 * kt + lr) * 2048 + i0 + 4 * g) = o;
    }
}
__device__ __forceinline__ int t5_bucket(int n) {
    if (n < 16) return n;
    const int large = 16 + (int)(logf((float)n / 16.f) / 4.852030263919617f * 16.f);
    return large < 31 ? large : 31;
}
__device__ __forceinline__ void p0_ssm_item(const Args& A, unsigned char* sp, int g, int lane) {
    const float* lam_re = A.in[6]; const float* lam_im = A.in[7]; const float* log_dt = A.in[8];
    const float* b_re = A.in[9]; const float* b_im = A.in[10]; const float* c_re = A.in[11]; const float* c_im = A.in[12];
    const int n = lane;
    const float dt = expf(log_dt[g]);
    const float lr = lam_re[g * 64 + n], li = lam_im[g * 64 + n];
    const float mag = expf(lr * dt);
    const float a_re = mag * cosf(li * dt), a_im = mag * sinf(li * dt);
    const float den = lr * lr + li * li;
    const float f_re = ((a_re - 1.f) * lr + a_im * li) / den, f_im = (a_im * lr - (a_re - 1.f) * li) / den;
    ((f32x2*)(sp + SSMP_ABAR))[g * 64 + n] = (f32x2){a_re, a_im};
    float pr = a_re, pi = a_im;
#pragma unroll
    for (int i = 0; i < 8; ++i) { const float nr = pr * pr - pi * pi, ni = 2.f * pr * pi; pr = nr; pi = ni; }
    ((f32x2*)(sp + SSMP_A256))[g * 64 + n] = (f32x2){pr, pi};
    float bbr[16], bbi[16];
#pragma unroll
    for (int q = 0; q < 4; ++q) { const f32x4 br = *(const f32x4*)(b_re + (size_t)(g * 64 + n) * 16 + 4 * q), bi = *(const f32x4*)(b_im + (size_t)(g * 64 + n) * 16 + 4 * q);
#pragma unroll
        for (int e = 0; e < 4; ++e) { bbr[4 * q + e] = f_re * br[e] - f_im * bi[e]; bbi[4 * q + e] = f_re * bi[e] + f_im * br[e]; } }
    bf16_t* bf = (bf16_t*)(sp + SSMP_BFRAG);
    const int jre = n >> 4, n16 = n & 15;
#pragma unroll
    for (int kg = 0; kg < 4; ++kg) {
        u32x4 wr = {0u, 0u, 0u, 0u}, wi = {0u, 0u, 0u, 0u};
        if (kg < 2) { const int c0 = (kg & 1) * 8;
            wr.x = cvt_pk_bf16(bbr[c0 + 0], bbr[c0 + 1]); wr.y = cvt_pk_bf16(bbr[c0 + 2], bbr[c0 + 3]); wr.z = cvt_pk_bf16(bbr[c0 + 4], bbr[c0 + 5]); wr.w = cvt_pk_bf16(bbr[c0 + 6], bbr[c0 + 7]);
            wi.x = cvt_pk_bf16(bbi[c0 + 0], bbi[c0 + 1]); wi.y = cvt_pk_bf16(bbi[c0 + 2], bbi[c0 + 3]); wi.z = cvt_pk_bf16(bbi[c0 + 4], bbi[c0 + 5]); wi.w = cvt_pk_bf16(bbi[c0 + 6], bbi[c0 + 7]); }
        *(u32x4*)(bf + ((size_t)(g * 8 + jre) * 64 + kg * 16 + n16) * 8) = wr;
        *(u32x4*)(bf + ((size_t)(g * 8 + 4 + jre) * 64 + kg * 16 + n16) * 8) = wi;
    }
    bf16_t* cf = (bf16_t*)(sp + SSMP_CFRAG);
    const int ch = lane & 15, kg = lane >> 4;
#pragma unroll
    for (int s = 0; s < 4; ++s) { const int k0 = 32 * s + 8 * kg;
        const float* src = (k0 < 64) ? (c_re + (size_t)(g * 16 + ch) * 64 + k0) : (c_im + (size_t)(g * 16 + ch) * 64 + (k0 - 64));
        const float sg = (k0 < 64) ? 1.f : -1.f;
        const f32x4 a = *(const f32x4*)src * sg, b = *(const f32x4*)(src + 4) * sg;
        u32x4 w; w.x = cvt_pk_bf16(a.x, a.y); w.y = cvt_pk_bf16(a.z, a.w); w.z = cvt_pk_bf16(b.x, b.y); w.w = cvt_pk_bf16(b.z, b.w);
        *(u32x4*)(cf + ((size_t)(g * 4 + s) * 64 + lane) * 8) = w; }
}
__device__ __forceinline__ void p0_btab_item(const Args& A, float* btab, int item, int lane) {
    const float* gq = A.in[3]; const float* gk = A.in[4]; const float* rel_bias = A.in[5];
    const int h = item / 3, br = item % 3, d = br == 0 ? 1 : (br == 1 ? 4 : 16);
    const float G = wave_max(fabsf(gq[lane] * gk[lane]));
    const float mb = wave_max(lane < 32 ? rel_bias[lane * 16 + h] : -1e30f);
    const float smax = 8.4f * G + mb;
    for (int idx = lane; idx < 192; idx += 64) { const int rel = idx - 31;
        float v = -1e30f;
        if (rel >= 0 && rel <= 128) v = LOG2E * (rel_bias[t5_bucket(rel * d) * 16 + h] - smax);
        btab[(h * 3 + br) * 192 + idx] = v; }
}

__device__ __forceinline__ void p0_prologue(const Args& A, LAS unsigned char* lds, int wave, int lane) {
    unsigned char* ws = A.ws;
    LAS float* scr = (LAS float*)(lds + wave * 16384);
    const int gw = blockIdx.x * 8 + wave, NGW = gridDim.x * 8;
    constexpr int I_WIN = (2048 / 64) * (4096 / 32), I_GLU = (1024 / 64) * (1024 / 32), I_WOUT = (2048 / 64) * (2048 / 32), I_WP = 2048;
    constexpr int I_SSM = 64, I_BT = 48;
    constexpr int NITEMS = I_WIN + I_GLU + I_WOUT + I_WP + I_SSM + I_BT;
    for (int it = gw; it < NITEMS; it += NGW) {
        int r = it;
        if (r < I_SSM) { p0_ssm_item(A, ws + WS_SSMP, r, lane); continue; } r -= I_SSM;
        if (r < I_BT) { p0_btab_item(A, (float*)(ws + WS_BTAB), r, lane); continue; } r -= I_BT;
        if (r < I_WP) { p0_wp_item(A.in[20], A.in[21], A.in[22], A.in[19], (bf16_t*)(ws + WS_WPT), r, lane); continue; } r -= I_WP;
        if (r < I_WIN) { p0_transpose_item(A.in[2], 2048, 4096, (bf16_t*)(ws + WS_WINT), nullptr, nullptr, scr, r, lane); continue; } r -= I_WIN;
        if (r < I_GLU) { p0_transpose_item(A.in[14], 1024, 1024, (bf16_t*)(ws + WS_GLUT), nullptr, nullptr, scr, r, lane); continue; } r -= I_GLU;
        p0_transpose_item(A.in[18], 2048, 2048, (bf16_t*)(ws + WS_WOUTT), A.in[16], A.in[17], scr, r, lane);
    }
    p0_rows<0>(A.in[0], A.in[1], ws + WS_HB, nullptr, gw, NGW, 8192, lane);
    p0_rows<3>(A.in[23], A.in[19], ws + WS_UB, (float*)(ws + WS_SU), gw, NGW, 16384, lane);
    p0_rows<4>(A.in[24], A.in[19], ws + WS_UB + 1024, (float*)(ws + WS_SV), gw, NGW, 16384, lane);
}

constexpr int SSM_WL = 8192 + 16 * 272 + 512;
__device__ __forceinline__ void ssm_unit(const Args& A, LAS unsigned char* lds, int b, int g, int wave, int lane) {
    unsigned char* ws = A.ws; unsigned char* sp = ws + WS_SSMP;
    const bf16_t* proj = (const bf16_t*)(ws + WS_PROJ); bf16_t* yb = (bf16_t*)(ws + WS_YB);
    LAS unsigned char* wl = lds + wave * SSM_WL;
    LAS f32x2* BU = (LAS f32x2*)wl; LAS unsigned char* XB = wl + 8192; LAS unsigned char* UL = wl + 8192 + 16 * 272;
    LAS f32x2* carry = (LAS f32x2*)(lds + 8 * SSM_WL);
    const int lr = lane & 15, q = lane >> 4;
    bf16x8 bfr[8], cfr[4];
#pragma unroll
    for (int j = 0; j < 8; ++j) bfr[j] = as_bf16x8(*(const u32x4*)((const bf16_t*)(sp + SSMP_BFRAG) + ((size_t)(g * 8 + j) * 64 + lane) * 8));
#pragma unroll
    for (int s = 0; s < 4; ++s) cfr[s] = as_bf16x8(*(const u32x4*)((const bf16_t*)(sp + SSMP_CFRAG) + ((size_t)(g * 4 + s) * 64 + lane) * 8));
    const f32x2 ab = ((const f32x2*)(sp + SSMP_ABAR))[g * 64 + lane], a256 = ((const f32x2*)(sp + SSMP_A256))[g * 64 + lane];
    const float a_re = ab.x, a_im = ab.y;
    const float dsk = A.in[13][g * 16 + lr];
    const bf16_t* up = proj + (size_t)(b * SEQ + wave * 256) * DPROJ + 3072 + g * 16;
    float xr = 0.f, xi = 0.f;
    for (int pass = 0; pass < 2; ++pass) {
        u32x4 unext = {0u, 0u, 0u, 0u};
        if (q < 2) unext = *(const u32x4*)(up + (size_t)lr * DPROJ + 8 * q);
        for (int blk = 0; blk < 16; ++blk) {
            const u32x4 uraw = unext;
            if (q < 2 && blk < 15) unext = *(const u32x4*)(up + (size_t)((blk + 1) * 16 + lr) * DPROJ + 8 * q);
            const bf16x8 ua = as_bf16x8(uraw);
            if (pass == 1 && q < 2) *(LAS u32x4*)(UL + lr * 32 + q * 16) = uraw;
            f32x4 dd[8];
#pragma unroll
            for (int j = 0; j < 8; ++j) dd[j] = MFMA16(ua, bfr[j], ((f32x4){0.f, 0.f, 0.f, 0.f}));
#pragma unroll
            for (int jj = 0; jj < 4; ++jj)
#pragma unroll
                for (int r = 0; r < 4; ++r) BU[(4 * q + r) * 64 + 16 * jj + lr] = (f32x2){dd[jj][r], dd[4 + jj][r]};
            CBAR();
            f32x2 bu[16];
#pragma unroll
            for (int t = 0; t < 16; ++t) bu[t] = BU[t * 64 + lane];
            if (pass == 0) {
#pragma unroll
                for (int t = 0; t < 16; ++t) { float nr = fmaf(a_re, xr, fmaf(-a_im, xi, bu[t].x)), ni = fmaf(a_re, xi, fmaf(a_im, xr, bu[t].y)); asm volatile("" : "+v"(nr)); asm volatile("" : "+v"(ni)); xr = nr; xi = ni; }
                asm volatile("" : "+v"(xr), "+v"(xi) :: "memory");
            } else {
#pragma unroll
                for (int t = 0; t < 16; ++t) { float nr = fmaf(a_re, xr, fmaf(-a_im, xi, bu[t].x)), ni = fmaf(a_re, xi, fmaf(a_im, xr, bu[t].y)); asm volatile("" : "+v"(nr)); asm volatile("" : "+v"(ni)); xr = nr; xi = ni;
                    const unsigned pk = cvt_pk_bf16(xr, xi);
                    *(LAS unsigned short*)(XB + t * 272 + lane * 2) = (unsigned short)(pk & 0xffffu);
                    *(LAS unsigned short*)(XB + t * 272 + 128 + lane * 2) = (unsigned short)(pk >> 16); }
                CBAR();
                f32x4 y = {0.f, 0.f, 0.f, 0.f};
#pragma unroll
                for (int s = 0; s < 4; ++s) { const bf16x8 xa = as_bf16x8(*(const LAS u32x4*)(XB + lr * 272 + (32 * s + 8 * q) * 2)); y = MFMA16(xa, cfr[s], y); }
#pragma unroll
                for (int r = 0; r < 4; ++r) { const int t = blk * 16 + 4 * q + r;
                    const float uv = __uint_as_float((unsigned)(*(const LAS unsigned short*)(UL + (4 * q + r) * 32 + lr * 2)) << 16);
                    const float yv = gelu_as(y[r] + dsk * uv);
                    yb[(size_t)(b * SEQ + wave * 256 + t) * 1024 + g * 16 + lr] = (bf16_t)(cvt_pk_bf16(yv, 0.f) & 0xffffu); }
                asm volatile("" : "+v"(xr), "+v"(xi) :: "memory");
            }
        }
        if (pass == 0) {
            carry[wave * 64 + lane] = (f32x2){xr, xi};
            __syncthreads();
            float sr = 0.f, si = 0.f;
            for (int w2 = 0; w2 < wave; ++w2) { const f32x2 e = carry[w2 * 64 + lane]; const float nr = a256.x * sr - a256.y * si + e.x, ni = a256.x * si + a256.y * sr + e.y; sr = nr; si = ni; }
            xr = sr; xi = si;
        }
    }
    __syncthreads();
}

__device__ __forceinline__ void prep2_item(const Args& A, LAS unsigned char* wl, int item, int lane) {
    unsigned char* ws = A.ws;
    const bf16_t* proj = (const bf16_t*)(ws + WS_PROJ);
    const int pb = item & 31, h = (item >> 5) & 15, b = item >> 9, P0 = pb * 64, bh = b * 16 + h;
    const int r8 = lane >> 3, c = lane & 7;
    const float* gq = A.in[3]; const float* gk = A.in[4];
    const int fs = c >> 2, fg = c & 3;
#pragma unroll 1
    for (int which = 0; which < 2; ++which) {
        const float* gv = which ? gk : gq; const float cs = which ? 1.f : (LOG2E * 0.125f);
        float gl[8];
#pragma unroll
        for (int e = 0; e < 8; ++e) gl[e] = gv[8 * c + e] * cs;
        bf16_t* F = (bf16_t*)(ws + (which ? WS_KF : WS_QF));
#pragma unroll 2
        for (int i = 0; i < 8; ++i) { const int row = 8 * i + r8, pos = P0 + row;
            const u32x4 raw = *(const u32x4*)(proj + (size_t)(b * SEQ + pos) * DPROJ + which * 1024 + h * 64 + 8 * c);
            float v[8] = {bflo(raw.x), bfhi(raw.x), bflo(raw.y), bfhi(raw.y), bflo(raw.z), bfhi(raw.z), bflo(raw.w), bfhi(raw.w)};
            float ss = 0.f;
#pragma unroll
            for (int e = 0; e < 8; ++e) ss += v[e] * v[e];
            ss += __shfl_xor(ss, 1); ss += __shfl_xor(ss, 2); ss += __shfl_xor(ss, 4);
            const float r = 1.0f / sqrtf(ss * (1.f / 64.f) + EPS);
            u32x4 w; w.x = cvt_pk_bf16(v[0] * r * gl[0], v[1] * r * gl[1]); w.y = cvt_pk_bf16(v[2] * r * gl[2], v[3] * r * gl[3]);
            w.z = cvt_pk_bf16(v[4] * r * gl[4], v[5] * r * gl[5]); w.w = cvt_pk_bf16(v[6] * r * gl[6], v[7] * r * gl[7]);
#pragma unroll
            for (int br = 0; br < 3; ++br) { const int sh = 2 * br, rr = pos & ((1 << sh) - 1), l = pos >> sh;
                *(u32x4*)(F + (size_t)br * 4 * 16 * SEQ * 64 + ((((size_t)(bh << sh) + rr) * (SEQ >> (sh + 4)) + (l >> 4)) * 2 + fs) * 512 + (fg * 16 + (l & 15)) * 8) = w; } }
    }
#pragma unroll
    for (int i = 0; i < 8; ++i) { const int row = 8 * i + r8;
        const u32x4 raw = *(const u32x4*)(proj + (size_t)(b * SEQ + P0 + row) * DPROJ + 2048 + h * 64 + 8 * c);
        *(LAS u32x2*)(wl + row * 136 + c * 16) = (u32x2){raw.x, raw.y}; *(LAS u32x2*)(wl + row * 136 + c * 16 + 8) = (u32x2){raw.z, raw.w}; }
    CBAR();
    unsigned v[64];
#pragma unroll
    for (int p = 0; p < 64; ++p) v[p] = *(const LAS unsigned short*)(wl + p * 136 + lane * 2);
    CBAR();
    bf16_t* vt = (bf16_t*)(ws + WS_VT);
    const int nt = lane >> 4, dl = lane & 15;
#pragma unroll
    for (int G = 0; G < 2; ++G) { bf16_t* tp = vt + ((((size_t)bh * 64 + (P0 >> 5) + G) * 4 + nt) * 64 + dl) * 8;
#pragma unroll
        for (int kg = 0; kg < 4; ++kg) { const int a0 = 32 * G + 4 * kg, b0 = 32 * G + 16 + 4 * kg;
            u32x4 w; w.x = v[a0] | (v[a0 + 1] << 16); w.y = v[a0 + 2] | (v[a0 + 3] << 16); w.z = v[b0] | (v[b0 + 1] << 16); w.w = v[b0 + 2] | (v[b0 + 3] << 16);
            *(u32x4*)(tp + kg * 128) = w; } }
    { bf16_t* vt4 = vt + (size_t)4 * 16 * 64 * SEQ; const int l0 = P0 >> 2, tile = (l0 >> 4) & 1, grp = l0 >> 5;
#pragma unroll
        for (int r = 0; r < 4; ++r) { bf16_t* tp = vt4 + (((((size_t)bh * 4 + r) * 16 + grp) * 4 + nt) * 64 + dl) * 8;
#pragma unroll
            for (int kg = 0; kg < 4; ++kg) { const int p0 = 4 * (4 * kg) + r;
                u32x2 w; w.x = v[p0] | (v[p0 + 4] << 16); w.y = v[p0 + 8] | (v[p0 + 12] << 16);
                *(u32x2*)(tp + kg * 128 + 4 * tile) = w; } } }
    { bf16_t* vt16 = vt + (size_t)2 * 4 * 16 * 64 * SEQ; const int l0 = P0 >> 4, w32 = l0 & 31, tile = (w32 >> 4) & 1, kg = (w32 & 15) >> 2, grp = l0 >> 5;
#pragma unroll
        for (int r = 0; r < 16; ++r) { u32x2 w; w.x = v[r] | (v[16 + r] << 16); w.y = v[32 + r] | (v[48 + r] << 16);
            *(u32x2*)(vt16 + (((((size_t)bh * 16 + r) * 4 + grp) * 4 + nt) * 64 + kg * 16 + dl) * 8 + 4 * tile) = w; } }
}

struct AttnItem { int sh, r, lfirst, ks, tbo; size_t qk_off, v_off; };
__device__ __forceinline__ AttnItem attn_item(int it, int p0, int bh) {
    AttnItem I; const int br = it >> 4, j = it & 15; I.sh = 2 * br; I.tbo = br * 192;
    I.r = j & ((1 << I.sh) - 1); I.lfirst = (p0 >> I.sh) + 16 * (j >> I.sh);
    const size_t rc = (size_t)br * 4 * 16 * SEQ * 64 + ((size_t)(bh << I.sh) + I.r) * (size_t)(SEQ >> I.sh) * 64;
    I.qk_off = rc; I.v_off = rc;
    int ks = (I.lfirst - 128) & ~31; I.ks = ks < 0 ? 0 : ks;
    return I;
}
__device__ __forceinline__ void attn_unit(const Args& A, LAS unsigned char* lds, int unit, int tid, int wave, int lane, int pflags) {
    unsigned char* ws = A.ws;
    const int blk = 7 - (unit >> 6), bh = unit & 63, b = bh >> 4, h = bh & 15, p0 = blk * 256;
    constexpr int OST = 68;
    LAS float* Oacc = (LAS float*)lds; LAS float* lacc = (LAS float*)(lds + 256 * OST * 4); LAS float* tb = (LAS float*)(lds + 256 * OST * 4 + 1024);
    { const float* bt = (const float*)(ws + WS_BTAB) + h * 3 * 192; for (int i = tid; i < 3 * 192; i += 512) tb[i] = bt[i]; }
    __syncthreads();
    const bf16_t* QF = (const bf16_t*)(ws + WS_QF); const bf16_t* KF = (const bf16_t*)(ws + WS_KF); const bf16_t* VF = (const bf16_t*)(ws + WS_VT);
    const int qi = lane & 15, g = lane >> 4;
#define ATT_LOAD(IT, LK, B) do { const AttnItem _I = attn_item(IT, p0, bh); const bf16_t* _kp = KF + _I.qk_off + (size_t)((LK) >> 4) * 1024 + lane * 8; \
        B[0] = *(const u32x4*)(_kp); B[1] = *(const u32x4*)(_kp + 512); B[2] = *(const u32x4*)(_kp + 1024); B[3] = *(const u32x4*)(_kp + 1536); \
        const bf16_t* _vp = VF + _I.v_off + (size_t)((LK) >> 5) * 2048 + lane * 8; \
        B[4] = *(const u32x4*)(_vp); B[5] = *(const u32x4*)(_vp + 512); B[6] = *(const u32x4*)(_vp + 1024); B[7] = *(const u32x4*)(_vp + 1536); \
        const bf16_t* _qp = QF + _I.qk_off + (size_t)(_I.lfirst >> 4) * 1024 + lane * 8; B[8] = *(const u32x4*)(_qp); B[9] = *(const u32x4*)(_qp + 512); } while (0)
#define ATT_ADV(IT, LK, NIT, NLK) do { const AttnItem _J = attn_item(IT, p0, bh); if ((LK) + 32 <= _J.lfirst) { (NIT) = (IT); (NLK) = (LK) + 32; } else { (NIT) = (IT) + 8; (NLK) = 0; if ((NIT) < 48) { const AttnItem _N = attn_item(NIT, p0, bh); (NLK) = _N.ks; } } } while (0)
#define ATT_STEP(CIT, CLK, BC, NIT, NLK, NNIT, NNLK, BNN) { \
        NNIT = 64; NNLK = 0; \
        if ((NIT) < 48) { ATT_ADV(NIT, NLK, NNIT, NNLK); if ((NNIT) < 48) ATT_LOAD(NNIT, NNLK, BNN); } \
        const AttnItem cI = attn_item(CIT, p0, bh); \
        f32x4 sa = {0.f, 0.f, 0.f, 0.f}, sb = {0.f, 0.f, 0.f, 0.f}; \
        sa = MFMA16(as_bf16x8(BC[0]), as_bf16x8(BC[8]), sa); sb = MFMA16(as_bf16x8(BC[2]), as_bf16x8(BC[8]), sb); \
        sa = MFMA16(as_bf16x8(BC[1]), as_bf16x8(BC[9]), sa); sb = MFMA16(as_bf16x8(BC[3]), as_bf16x8(BC[9]), sb); \
        const LAS float* tbb = tb + cI.tbo; \
        const int ba = cI.lfirst + qi - (CLK) - 4 * g + 31; \
        float pa[4], pb[4]; \
        _Pragma("unroll") for (int e = 0; e < 4; ++e) { pa[e] = __builtin_amdgcn_exp2f(sa[e] + tbb[ba - e]); pb[e] = __builtin_amdgcn_exp2f(sb[e] + tbb[ba - 16 - e]); } \
        lsum += (pa[0] + pa[1]) + (pa[2] + pa[3]) + (pb[0] + pb[1]) + (pb[2] + pb[3]); \
        u32x4 pw; pw.x = cvt_pk_bf16(pa[0], pa[1]); pw.y = cvt_pk_bf16(pa[2], pa[3]); pw.z = cvt_pk_bf16(pb[0], pb[1]); pw.w = cvt_pk_bf16(pb[2], pb[3]); \
        const bf16x8 pf = as_bf16x8(pw); \
        _Pragma("unroll") for (int nt = 0; nt < 4; ++nt) o[nt] = MFMA16(pf, as_bf16x8(BC[4 + nt]), o[nt]); \
        if ((CLK) + 32 > cI.lfirst) {     \
            lsum += __shfl_xor(lsum, 16); lsum += __shfl_xor(lsum, 32); \
            const bool first = (CIT) < 16; \
            if (g == 0) { LAS float* lp = lacc + ((((cI.lfirst + qi) << cI.sh) + cI.r) - p0); *lp = first ? lsum : *lp + lsum; } \
            _Pragma("unroll") for (int reg = 0; reg < 4; ++reg) { LAS float* op = Oacc + (((((cI.lfirst + 4 * g + reg) << cI.sh) + cI.r) - p0)) * OST + qi; \
                _Pragma("unroll") for (int nt = 0; nt < 4; ++nt) op[16 * nt] = first ? o[nt][reg] : op[16 * nt] + o[nt][reg]; } \
            _Pragma("unroll") for (int nt = 0; nt < 4; ++nt) o[nt] = (f32x4){0.f, 0.f, 0.f, 0.f}; \
            lsum = 0.f; \
            if (((CIT) >> 3) & 1) __syncthreads();     \
        } \
        if ((NIT) >= 48) break; }
    if (!(pflags & 16)) {
    int itA = wave, lkA, itB, lkB, itC = 64, lkC = 0;
    { const AttnItem I0 = attn_item(wave, p0, bh); lkA = I0.ks; }
    ATT_ADV(itA, lkA, itB, lkB);
    u32x4 bA[10], bB[10], bC[10];
    ATT_LOAD(itA, lkA, bA); if (itB < 48) ATT_LOAD(itB, lkB, bB);
    f32x4 o[4];
#pragma unroll
    for (int nt = 0; nt < 4; ++nt) o[nt] = (f32x4){0.f, 0.f, 0.f, 0.f};
    float lsum = 0.f;
    for (;;) {
        ATT_STEP(itA, lkA, bA, itB, lkB, itC, lkC, bC)
        ATT_STEP(itB, lkB, bB, itC, lkC, itA, lkA, bA)
        ATT_STEP(itC, lkC, bC, itA, lkA, itB, lkB, bB)
    }
    }
#undef ATT_LOAD
#undef ATT_ADV
#undef ATT_STEP
    if (!(pflags & (16 | 32 | 64))) { const int ql = tid >> 1, half = tid & 1; const float inv = 1.0f / lacc[ql];
        bf16_t* dst = (bf16_t*)(ws + WS_MIXED) + (size_t)(b * SEQ + p0 + ql) * 2048 + h * 64 + 32 * half;
        float ss = 0.f;
#pragma unroll
        for (int c4 = 0; c4 < 4; ++c4) { float v[8];
#pragma unroll
            for (int e = 0; e < 8; ++e) { v[e] = Oacc[ql * OST + 32 * half + 8 * c4 + e] * inv; ss += v[e] * v[e]; }
            u32x4 w; w.x = cvt_pk_bf16(v[0], v[1]); w.y = cvt_pk_bf16(v[2], v[3]); w.z = cvt_pk_bf16(v[4], v[5]); w.w = cvt_pk_bf16(v[6], v[7]);
            *(u32x4*)(dst + 8 * c4) = w; }
        ss += __shfl_xor(ss, 1);
        if (half == 0) unsafeAtomicAdd((float*)(ws + WS_CTL + CTL_RSS_ATTN) + b * SEQ + p0 + ql, ss); }
    __syncthreads();
}

__device__ __forceinline__ unsigned fkey(float f) { const unsigned u = __float_as_uint(f); return (u & 0x80000000u) ? ~u : (u | 0x80000000u); }
#define DPP_U(x, ctrl) ((unsigned)__builtin_amdgcn_update_dpp((int)(x), (int)(x), ctrl, 0xf, 0xf, false))
__device__ __forceinline__ unsigned row16_umax(unsigned v) { unsigned t;
    t = DPP_U(v, 0xB1); v = t > v ? t : v; t = DPP_U(v, 0x4E); v = t > v ? t : v; t = DPP_U(v, 0x141); v = t > v ? t : v; t = DPP_U(v, 0x140); v = t > v ? t : v; return v; }
__device__ __forceinline__ float row16_fmax(float v) { float t;
    t = __uint_as_float(DPP_U(__float_as_uint(v), 0xB1)); v = fmaxf(v, t); t = __uint_as_float(DPP_U(__float_as_uint(v), 0x4E)); v = fmaxf(v, t);
    t = __uint_as_float(DPP_U(__float_as_uint(v), 0x141)); v = fmaxf(v, t); t = __uint_as_float(DPP_U(__float_as_uint(v), 0x140)); v = fmaxf(v, t); return v; }
__device__ __forceinline__ float row16_fsum(float v) {
    v += __uint_as_float(DPP_U(__float_as_uint(v), 0xB1)); v += __uint_as_float(DPP_U(__float_as_uint(v), 0x4E));
    v += __uint_as_float(DPP_U(__float_as_uint(v), 0x141)); v += __uint_as_float(DPP_U(__float_as_uint(v), 0x140)); return v; }
__device__ __forceinline__ unsigned wave_umax(unsigned v) { v = row16_umax(v);
    const unsigned a = (unsigned)__builtin_amdgcn_readlane((int)v, 0), b = (unsigned)__builtin_amdgcn_readlane((int)v, 16), c = (unsigned)__builtin_amdgcn_readlane((int)v, 32), d = (unsigned)__builtin_amdgcn_readlane((int)v, 48);
    const unsigned ab = a > b ? a : b, cd = c > d ? c : d; return ab > cd ? ab : cd; }
template <int R> __device__ __forceinline__ void select16(const unsigned (&key)[R], unsigned long long (&m)[R]) {
    unsigned mx = key[0];
#pragma unroll
    for (int r = 1; r < R; ++r) mx = key[r] > mx ? key[r] : mx;
    mx = wave_umax(mx);
    unsigned lo = mx > (3u << 23) ? mx - (3u << 23) : 0u, hi = mx + 1u;
    int cnt = 0;
#pragma unroll
    for (int r = 0; r < R; ++r) cnt += __popcll(__ballot(key[r] >= lo));
    if (cnt < 16) { lo = 0u; cnt = R * 64; }
    while (cnt != 16 && hi - lo > 1u) { const unsigned mid = lo + ((hi - lo) >> 1); int c = 0;
#pragma unroll
        for (int r = 0; r < R; ++r) c += __popcll(__ballot(key[r] >= mid));
        if (c >= 16) { lo = mid; cnt = c; } else hi = mid; }
    const unsigned T = lo;
    if (cnt == 16) {
#pragma unroll
        for (int r = 0; r < R; ++r) m[r] = __ballot(key[r] >= T);
    } else {
        int need = 16;
#pragma unroll
        for (int r = 0; r < R; ++r) { m[r] = __ballot(key[r] > T); need -= __popcll(m[r]); }
#pragma unroll
        for (int r = 0; r < R; ++r) { unsigned long long eq = __ballot(key[r] == T);
            while (__popcll(eq) > need) eq &= ~(1ull << (63 - __builtin_clzll(eq)));
            need -= __popcll(eq); m[r] |= eq; }
    }
}
__device__ __forceinline__ void peer_topk(const float (&sv4)[4], LAS float* sc, LAS int* exo, LAS float* gto, int lane) {
    LAS float* v1 = sc; LAS int* i1 = (LAS int*)(sc + 16); LAS float* v2 = sc + 32; LAS int* i2 = (LAS int*)(sc + 48); LAS float* sv = sc + 64; LAS int* si = (LAS int*)(sc + 80);
    const unsigned long long lt = (1ull << lane) - 1ull;
#pragma unroll
    for (int half = 0; half < 2; ++half) {
        const float a0 = sv4[2 * half], a1 = sv4[2 * half + 1];
        const unsigned key[2] = {fkey(a0), fkey(a1)}; unsigned long long m[2];
        select16<2>(key, m);
        LAS float* vv = half ? v2 : v1; LAS int* ii = half ? i2 : i1;
        if ((m[0] >> lane) & 1ull) { const int pos = __popcll(m[0] & lt); vv[pos] = a0; ii[pos] = lane; }
        if ((m[1] >> lane) & 1ull) { const int pos = __popcll(m[0]) + __popcll(m[1] & lt); vv[pos] = a1; ii[pos] = 64 + lane; }
    }
    CBAR(); LDS_WAIT();
    const int a = lane >> 2, bb = (lane & 3) * 4;
    const float va = v1[a]; float cv[4]; unsigned key[4]; unsigned long long m[4];
#pragma unroll
    for (int e = 0; e < 4; ++e) { cv[e] = va + v2[bb + e]; key[e] = fkey(cv[e]); }
    select16<4>(key, m);
    int base = 0;
#pragma unroll
    for (int e = 0; e < 4; ++e) { if ((m[e] >> lane) & 1ull) { const int pos = base + __popcll(m[e] & lt); sv[pos] = cv[e]; si[pos] = a * 16 + bb + e; } base += __popcll(m[e]); }
    CBAR(); LDS_WAIT();
    if (lane < 16) {
        const float val = sv[lane]; const int fi = si[lane];
        const float mx = row16_fmax(val);
        const float ex = __expf(val - mx); const float sum = row16_fsum(ex);
        exo[lane] = i1[fi >> 4] * 128 + (i2[fi & 15] - 0);
        gto[lane] = ex / sum;
    }
    CBAR(); LDS_WAIT();
}

template <int I> __device__ __forceinline__ float ubyte_f32(unsigned w) { float f;
    if (I == 0) asm("v_cvt_f32_ubyte0 %0, %1" : "=v"(f) : "v"(w)); else if (I == 1) asm("v_cvt_f32_ubyte1 %0, %1" : "=v"(f) : "v"(w));
    else if (I == 2) asm("v_cvt_f32_ubyte2 %0, %1" : "=v"(f) : "v"(w)); else asm("v_cvt_f32_ubyte3 %0, %1" : "=v"(f) : "v"(w));
    return f; }
__device__ __forceinline__ void peer_wave(const Args& A, LAS unsigned char* lds, int wave, int lane, int pflags) {
    unsigned char* ws = A.ws;
    const float* scores = (const float*)(ws + WS_PROJ);
    const unsigned char* uv = ws + WS_UB; const bf16_t* x1b = (const bf16_t*)(ws + WS_HB);
    const float* su = (const float*)(ws + WS_SU); const float* sv = (const float*)(ws + WS_SV);
    const float* rssx = (const float*)(ws + WS_CTL + CTL_RSS_X1);
    LAS int* exl = (LAS int*)(lds + wave * 4096);
    LAS float* gtl = (LAS float*)(lds + wave * 4096 + 2048);
    LAS float* sc = (LAS float*)(lds + 32768 + wave * 512);
    LAS float* cul = (LAS float*)(lds + 40960 + wave * 1024);
    const int t0 = (blockIdx.x * 8 + wave) * 4;
    if (t0 >= NTOK) return;
#define LOAD_SCORES_L(dst, t, h, ln) do { const float* _sp = scores + (size_t)(t) * 2048 + (h) * 256 + (ln); dst[0] = _sp[0]; dst[1] = _sp[64]; dst[2] = _sp[128]; dst[3] = _sp[192]; } while (0)
#define LOAD_SCORES(dst, t, h) LOAD_SCORES_L(dst, t, h, lane)
    { float nx[4]; LOAD_SCORES(nx, t0, 0);
#pragma unroll 1
        for (int h = 0; h < 8; ++h) { const float cs[4] = {nx[0], nx[1], nx[2], nx[3]};
            if (h < 7) LOAD_SCORES(nx, t0, h + 1);
            peer_topk(cs, sc, exl + h * 16, gtl + h * 16, lane); } }
    CBAR(); LDS_WAIT();
    if (pflags & 256) return;
    int ex0 = exl[lane], ex1 = exl[64 + lane];
    float rss = rssx[t0], su0 = su[ex0], su1 = su[ex1], sv0 = sv[ex0], sv1 = sv[ex1];
    float sn[4] = {0.f, 0.f, 0.f, 0.f};
    LOAD_SCORES(sn, t0 + 1, 0);
    u32x4 bu[8], bv[8];
    LAS u32x4* vls = (LAS u32x4*)(lds + 49152 + wave * 8192);
#define ISSUE_E(slot, e0r, e1r, k) do { const int _e = __builtin_amdgcn_readlane((k) < 64 ? (e0r) : (e1r), (k) & 63); \
        const unsigned char* _p = uv + (size_t)_e * 2048 + 16 * lane; bu[slot] = *(const u32x4*)_p; bv[slot] = *(const u32x4*)(_p + 1024); } while (0)
#pragma unroll
    for (int i = 0; i < 8; ++i) ISSUE_E(i, ex0, ex1, i);
    float acc[32];
#pragma unroll 1
    for (int tok = 0; tok < 4; ++tok) {
        const int t = t0 + tok;
        int lz = lane; asm volatile("" : "+v"(lz));
        unsigned xq[8]; float sx; int xsum;
        { u32x4 xr4[4];
#pragma unroll
            for (int v4 = 0; v4 < 4; ++v4) xr4[v4] = *(const u32x4*)(x1b + (size_t)t * 2048 + 16 * lz + 1024 * (v4 >> 1) + 8 * (v4 & 1));
            float m = 0.f;
#pragma unroll
            for (int v4 = 0; v4 < 4; ++v4) { const unsigned rw[4] = {xr4[v4].x, xr4[v4].y, xr4[v4].z, xr4[v4].w};
#pragma unroll
                for (int e = 0; e < 4; ++e) m = fmaxf(m, fmaxf(fabsf(bflo(rw[e])), fabsf(bfhi(rw[e])))); }
            m = fmaxf(wave_max(m), 1e-30f);
            const float inv = 127.f / m; sx = m * (1.f / 127.f);
            int ls = 0;
#pragma unroll
            for (int v4 = 0; v4 < 4; ++v4) { const unsigned rw[4] = {xr4[v4].x, xr4[v4].y, xr4[v4].z, xr4[v4].w};
#pragma unroll
                for (int h2 = 0; h2 < 2; ++h2) { const int a = (int)rintf(bflo(rw[2 * h2]) * inv), b = (int)rintf(bfhi(rw[2 * h2]) * inv), c = (int)rintf(bflo(rw[2 * h2 + 1]) * inv), e = (int)rintf(bfhi(rw[2 * h2 + 1]) * inv);
                    ls += (a + b) + (c + e);
                    xq[2 * v4 + h2] = (unsigned)(a & 255) | ((unsigned)(b & 255) << 8) | ((unsigned)(c & 255) << 16) | ((unsigned)(e & 255) << 24); } }
#pragma unroll
            for (int o = 1; o < 64; o <<= 1) ls += __shfl_xor(ls, o);
            xsum = ls;
            asm volatile("" ::: "memory");
#pragma unroll
            for (int v4 = 0; v4 < 4; ++v4) { const unsigned rw[4] = {xr4[v4].x, xr4[v4].y, xr4[v4].z, xr4[v4].w};
#pragma unroll
                for (int e = 0; e < 4; ++e) { acc[8 * v4 + 2 * e] = bflo(rw[e]); acc[8 * v4 + 2 * e + 1] = bfhi(rw[e]); } } }
        const float ascale = sx / sqrtf(rss * (1.f / 2048.f) + EPS);
        cul[lz] = ascale * su0; cul[64 + lz] = ascale * su1;
        cul[128 + lz] = 2.f * gtl[tok * 128 + lz] * sv0; cul[192 + lz] = 2.f * gtl[tok * 128 + 64 + lz] * sv1;
        CBAR(); LDS_WAIT();
        float wsum = 0.f;
        int nex0 = ex0, nex1 = ex1; float nrss = 1.f, nsu0 = 0.f, nsu1 = 0.f, nsv0 = 0.f, nsv1 = 0.f;
#pragma unroll 1
        for (int k0 = 0; k0 < 128; k0 += 8) {
            if (tok < 3 && k0 == 120) {
                nex0 = exl[(tok + 1) * 128 + lz]; nex1 = exl[(tok + 1) * 128 + 64 + lz];
                nrss = rssx[t + 1]; nsu0 = su[nex0]; nsu1 = su[nex1]; nsv0 = sv[nex0]; nsv1 = sv[nex1];
                if (tok < 2) LOAD_SCORES_L(sn, t + 2, 0, lz); }
            int p[8];
#pragma unroll
            for (int i = 0; i < 8; ++i) { int ac = 0;
                const unsigned w4[4] = {bu[i].x, bu[i].y, bu[i].z, bu[i].w};
#pragma unroll
                for (int e = 0; e < 4; ++e) { ac = __builtin_amdgcn_sdot4((int)(w4[e] & 0x0F0F0F0Fu), (int)xq[e], ac, false); ac = __builtin_amdgcn_sdot4((int)((w4[e] >> 4) & 0x0F0F0F0Fu), (int)xq[4 + e], ac, false); }
                p[i] = ac; vls[i * 64 + lane] = bv[i]; }
            { const bool nxt = (k0 + 8) >= 128;
              const int kb = (k0 + 8) & 127; const int sel = nxt ? (kb < 64 ? nex0 : nex1) : (kb < 64 ? ex0 : ex1);
#pragma unroll
              for (int i = 0; i < 8; ++i) { const int _e = __builtin_amdgcn_readlane(sel, (kb & 63) + i);
                  const unsigned char* _p = uv + (size_t)_e * 2048 + 16 * lane; bu[i] = *(const u32x4*)_p; bv[i] = *(const u32x4*)(_p + 1024); } }
            float wcur;
            { const bool b0 = lane & 1, b1 = lane & 2, b2 = lane & 4;
            int q4[4], q2[2], q1;
#pragma unroll
            for (int i = 0; i < 4; ++i) { const int keep = b0 ? p[i + 4] : p[i], send = b0 ? p[i] : p[i + 4]; q4[i] = keep + __shfl_xor(send, 1); }
#pragma unroll
            for (int i = 0; i < 2; ++i) { const int keep = b1 ? q4[i + 2] : q4[i], send = b1 ? q4[i] : q4[i + 2]; q2[i] = keep + __shfl_xor(send, 2); }
            { const int keep = b2 ? q2[1] : q2[0], send = b2 ? q2[0] : q2[1]; q1 = keep + __shfl_xor(send, 4); }
            q1 += __shfl_xor(q1, 8); q1 += __shfl_xor(q1, 16); q1 += __shfl_xor(q1, 32);
            const int k = (k0 + 4 * (lane & 1) + 2 * ((lane >> 1) & 1) + ((lane >> 2) & 1)) & 127;
            const float a = (float)(2 * q1 - 15 * xsum) * cul[k];
            wcur = cul[128 + k] * gelu_as(a); }
            CBAR();
#pragma unroll 1
            for (int i = 0; i < 8; ++i) { const int rl = ((i & 1) << 2) | (i & 2) | ((i >> 2) & 1);
                const float w = __builtin_bit_cast(float, __builtin_amdgcn_readlane(__builtin_bit_cast(int, wcur), rl));
                wsum += w;
                const u32x4 vv = vls[i * 64 + lane];
                const unsigned w4[4] = {vv.x, vv.y, vv.z, vv.w};
                const float w16 = w * 0.0625f;
#pragma unroll
                for (int e = 0; e < 4; ++e) { const unsigned lo = w4[e] & 0x0F0F0F0Fu, hi = w4[e] & 0xF0F0F0F0u;
                    acc[4 * e + 0] += w * ubyte_f32<0>(lo); acc[4 * e + 1] += w * ubyte_f32<1>(lo); acc[4 * e + 2] += w * ubyte_f32<2>(lo); acc[4 * e + 3] += w * ubyte_f32<3>(lo);
                    acc[16 + 4 * e + 0] += w16 * ubyte_f32<0>(hi); acc[16 + 4 * e + 1] += w16 * ubyte_f32<1>(hi); acc[16 + 4 * e + 2] += w16 * ubyte_f32<2>(hi); acc[16 + 4 * e + 3] += w16 * ubyte_f32<3>(hi); } }
            CBAR();
            if (tok < 3 && !(k0 & 8)) { const int hh = k0 >> 4;
                const float cs[4] = {sn[0], sn[1], sn[2], sn[3]};
                if (hh < 7) LOAD_SCORES_L(sn, t + 1, hh + 1, lz);
                peer_topk(cs, sc, exl + (tok + 1) * 128 + hh * 16, gtl + (tok + 1) * 128 + hh * 16, lane); }
        }
        const float corr = -7.5f * wsum;
        float* op = A.out + (size_t)t * 2048 + 16 * lz;
        if (!(pflags & 128)) {
#pragma unroll
        for (int j = 0; j < 2; ++j)
#pragma unroll
            for (int c4 = 0; c4 < 4; ++c4) { const int a0 = 16 * j + 4 * c4;
                *(f32x4*)(op + 1024 * j + 4 * c4) = (f32x4){acc[a0] + corr, acc[a0 + 1] + corr, acc[a0 + 2] + corr, acc[a0 + 3] + corr}; }
        } else if (corr == 12345.678f) op[0] = acc[0];
        ex0 = nex0; ex1 = nex1; rss = nrss; su0 = nsu0; su1 = nsu1; sv0 = nsv0; sv1 = nsv1;
    }
#undef ISSUE_E
#undef LOAD_SCORES
#undef LOAD_SCORES_L
}

__global__ void __launch_bounds__(512, 2) mk_fwd(Args args) {
    extern __shared__ __attribute__((aligned(16))) unsigned char lds_raw[];
    LAS unsigned char* lds = (LAS unsigned char*)lds_raw;
    const int tid = threadIdx.x, lane = tid & 63, wave = __builtin_amdgcn_readfirstlane(tid >> 6);
    volatile LAS unsigned* MISC = (volatile LAS unsigned*)(lds + MISC_OFF);
    if (tid < 64) MISC[tid] = 0u;
    __syncthreads();
    unsigned char* ws = args.ws;
    const int lo = args.ph_lo, hi = args.ph_hi & 0xff, pflags = args.ph_hi >> 8;
    XcdBarrier bar; bar.bar = (unsigned*)(ws + WS_CTL); bar.x = 0; bar.st = nullptr;
    if (hi - lo > 1) bar = xcd_barrier_post((unsigned*)(ws + WS_CTL), MISC + 8);
#ifndef PH_MASK
#define PH_MASK 0x7f
#endif
#define IN(k) (((PH_MASK >> (k)) & 1) && lo <= (k) && (k) < hi)
#define SEAM(k) do { if (IN(k) && IN((k) + 1)) xcd_barrier(bar); } while (0)

    if (IN(0)) { p0_prologue(args, lds, wave, lane); }
    SEAM(0);
    if (IN(1)) {
        pg8::Gemm g{(const bf16_t*)(ws + WS_HB), (const bf16_t*)(ws + WS_WINT), NTOK, DPROJ, DM}; pg8::StaticOrder S; S.init(NTOK, DPROJ, gridDim.x, (int)blockIdx.x);
        pg8::EpiProj E{(bf16_t*)(ws + WS_PROJ), DPROJ};
        pg8::gemm_phase<pg8::EpiProj, pg8::StaticOrder, false>(lds, g, S, E, nullptr);
    }
    SEAM(1);
    if (IN(2)) {
        if (!(pflags & 4)) for (int u = blockIdx.x; u < 256; u += gridDim.x) ssm_unit(args, lds, u >> 6, u & 63, wave, lane);
        if (!(pflags & 8)) for (int it = blockIdx.x * 8 + wave; it < 2048; it += gridDim.x * 8) prep2_item(args, lds + wave * SSM_WL, it, lane);
    }
    SEAM(2);
    if (IN(3)) {
        if (!(pflags & 2)) {
            pg8::Gemm g{(const bf16_t*)(ws + WS_YB), (const bf16_t*)(ws + WS_GLUT), NTOK, 1024, 1024}; pg8::StaticOrder S; S.init(NTOK, 1024, gridDim.x, (int)blockIdx.x);
            pg8::EpiGlu E{(const bf16_t*)(ws + WS_YB), (bf16_t*)(ws + WS_MIXED) + 1024, args.in[15], (float*)(ws + WS_CTL + CTL_RSS_SSM)};
            pg8::gemm_phase<pg8::EpiGlu, pg8::StaticOrder, false>(lds, g, S, E, nullptr);
        }
        __syncthreads();
        if (!(pflags & 1)) for (;;) {
            if (tid == 0) MISC[0] = atomicAdd((unsigned*)(ws + WS_CTL + CTL_QCTR), 1u);
            __syncthreads();
            const unsigned u = MISC[0];
            __syncthreads();
            if (u >= 512u) break;
            attn_unit(args, lds, (int)u, tid, wave, lane, pflags);
        }
    }
    SEAM(3);
    if (IN(4)) {
        pg8::Gemm g{(const bf16_t*)(ws + WS_MIXED), (const bf16_t*)(ws + WS_WOUTT), NTOK, DM, DM}; pg8::StaticOrder S; S.init(NTOK, DM, gridDim.x, (int)blockIdx.x);
        LAS float* tab = (LAS float*)(lds + 131072);
        { pg8::Unit u0; if (S.next(0, u0) && tid < 256) { const int row = u0.pm * 256 + tid;
            const float ra = 1.0f / sqrtf(((const float*)(ws + WS_CTL + CTL_RSS_ATTN))[row] * (1.f / 1024.f) + EPS), rs = 1.0f / sqrtf(((const float*)(ws + WS_CTL + CTL_RSS_SSM))[row] * (1.f / 1024.f) + EPS);
            tab[tid] = ra / rs; tab[256 + tid] = rs; } }
        __syncthreads();
        pg8::EpiWout E{args.in[0], args.out, (bf16_t*)(ws + WS_HB), (float*)(ws + WS_CTL + CTL_RSS_X1), tab};
        pg8::gemm_phase<pg8::EpiWout, pg8::StaticOrder, false>(lds, g, S, E, nullptr);
    }
    SEAM(4);
    if (IN(5)) {
        pg8::Gemm g{(const bf16_t*)(ws + WS_HB), (const bf16_t*)(ws + WS_WPT), NTOK, DM, DM}; pg8::StaticOrder S; S.init(NTOK, DM, gridDim.x, (int)blockIdx.x);
        pg8::EpiScores E{(float*)(ws + WS_PROJ), (const float*)(ws + WS_CTL + CTL_RSS_X1)};
        pg8::gemm_phase<pg8::EpiScores, pg8::StaticOrder, false>(lds, g, S, E, nullptr);
    }
    SEAM(5);
    if (IN(6)) { peer_wave(args, lds, wave, lane, pflags); }
#undef IN
#undef SEAM
}

#ifndef MK_DEBUG
#ifndef MK_PER_PHASE
#define MK_PER_PHASE 0
#endif
extern "C" void kernel_launch(void* const* d_in, const int* in_sizes, int n_in, void* d_out, int out_size, void* d_ws, size_t ws_size, hipStream_t stream) {
    static int grid = 0;
    if (grid == 0) {
        if (n_in != 25 || out_size != NTOK * DM || ws_size < WS_END) { fprintf(stderr, "kernel_launch: unexpected shapes / workspace (%d inputs, out %d, ws %zu < %zu)\n", n_in, out_size, ws_size, (size_t)WS_END); grid = -1; return; }
        int dev = 0, cus = 0, per_cu = 0;
        if (hipGetDevice(&dev) != hipSuccess || hipDeviceGetAttribute(&cus, hipDeviceAttributeMultiprocessorCount, dev) != hipSuccess) { grid = -1; return; }
        if (hipFuncSetAttribute((const void*)mk_fwd, hipFuncAttributeMaxDynamicSharedMemorySize, LDS_BYTES) != hipSuccess) { fprintf(stderr, "kernel_launch: hipFuncSetAttribute failed\n"); grid = -1; return; }
        if (hipOccupancyMaxActiveBlocksPerMultiprocessor(&per_cu, (const void*)mk_fwd, 512, LDS_BYTES) != hipSuccess || per_cu < 1) { fprintf(stderr, "kernel_launch: occupancy query reports %d\n", per_cu); }
        (void)hipGetLastError();
        grid = cus;
    }
    if (grid < 0) return;
    (void)hipMemsetAsync((char*)d_ws + WS_CTL, 0, CTL_BYTES, stream);
    Args a{};
    for (int i = 0; i < 25; ++i) a.in[i] = (const float*)d_in[i];
    a.out = (float*)d_out; a.ws = (unsigned char*)d_ws;
#if MK_PER_PHASE
#ifndef MK_DUP
#define MK_DUP -1
#endif
    for (int p = 0; p < 7; ++p) { a.ph_lo = p; a.ph_hi = p + 1; hipLaunchKernelGGL(mk_fwd, dim3(grid), dim3(512), LDS_BYTES, stream, a);
        if (p == MK_DUP) {
            (void)hipMemsetAsync((char*)d_ws + WS_CTL + CTL_QCTR, 0, 256, stream);
#ifndef MK_DUP_FLAGS
#define MK_DUP_FLAGS 0
#endif
            if (p == 3 && !((MK_DUP_FLAGS) & (1 | 16 | 32 | 64))) (void)hipMemsetAsync((char*)d_ws + WS_CTL + CTL_RSS_ATTN, 0, 32768, stream);
            if (p == 3 && !((MK_DUP_FLAGS) & 2)) (void)hipMemsetAsync((char*)d_ws + WS_CTL + CTL_RSS_SSM, 0, 32768, stream);
            if (p == 4) (void)hipMemsetAsync((char*)d_ws + WS_CTL + CTL_RSS_X1, 0, 32768, stream);
            a.ph_hi |= (MK_DUP_FLAGS) << 8;
            hipLaunchKernelGGL(mk_fwd, dim3(grid), dim3(512), LDS_BYTES, stream, a); } }
#else
    a.ph_lo = 0; a.ph_hi = 7;
    hipLaunchKernelGGL(mk_fwd, dim3(grid), dim3(512), LDS_BYTES, stream, a);
#endif
}
#endif
```

```cpp
#include <hip/hip_runtime.h>
#include <stdint.h>
#include <stdio.h>

typedef unsigned short bf16_t;
typedef float f32x2 __attribute__((ext_vector_type(2)));
typedef unsigned u32x2 __attribute__((ext_vector_type(2)));
using bf16x2v = __attribute__((ext_vector_type(2))) __bf16;

constexpr int NTOK = 8192, SEQ = 2048, DM = 2048, DPROJ = 4096;
constexpr float EPS = 1e-6f;
constexpr float LOG2E = 1.4426950408889634f;

constexpr size_t MB = 1024 * 1024;
constexpr size_t WS_CTL = 0;
constexpr size_t CTL_BYTES = 128 * 1024;
constexpr size_t CTL_QCTR = 16384;
constexpr size_t CTL_RSS_ATTN = 32768, CTL_RSS_SSM = 65536, CTL_RSS_X1 = 98304;
constexpr size_t WS_HB = 256 * 1024;
constexpr size_t WS_WINT = WS_HB + 32 * MB;
constexpr size_t WS_GLUT = WS_WINT + 16 * MB;
constexpr size_t WS_WOUTT = WS_GLUT + 2 * MB;
constexpr size_t WS_WPT = WS_WOUTT + 8 * MB;
constexpr size_t WS_UB = WS_WPT + 8 * MB;
constexpr size_t WS_VB = WS_UB + 32 * MB;
constexpr size_t WS_SU = WS_VB + 32 * MB;
constexpr size_t WS_SV = WS_SU + 65536;
constexpr size_t WS_PROJ = WS_SV + 65536;
constexpr size_t WS_QF = WS_PROJ + 64 * MB;
constexpr size_t WS_KF = WS_QF + 48 * MB;
constexpr size_t WS_VT = WS_KF + 48 * MB;
constexpr size_t WS_QN = WS_QF, WS_KN = WS_KF;
constexpr size_t WS_YB = WS_VT + 48 * MB + 4096;
constexpr size_t WS_MIXED = WS_YB + 16 * MB;
constexpr size_t WS_SSMP = WS_MIXED + 32 * MB;
constexpr size_t SSMP_ABAR = 0, SSMP_A256 = 32768, SSMP_BFRAG = 65536, SSMP_CFRAG = 65536 + 524288;
constexpr size_t WS_BTAB = WS_SSMP + 1 * MB;
constexpr size_t WS_END = WS_BTAB + 64 * 1024;

constexpr int LDS_BYTES = 147456;
constexpr int MISC_OFF = 147456 - 256;
#define XB_TMO      128
#define XB_XCNT(j)  (256  + 64 * (j))
#define XB_XSUB(j)  (1280 + 64 * (j))
#define XB_XGEN(j)  (2304 + 64 * (j))
#define XB_TOP      3328
#define XB_TOPGEN   3392
#define XCD_BAR_WORDS 3456
#define XB_SPIN_CAP (1u << 18)
#define LAS __attribute__((address_space(3)))

__device__ __forceinline__ unsigned xb_ld(unsigned* p)              { return __hip_atomic_load(p, __ATOMIC_RELAXED, __HIP_MEMORY_SCOPE_AGENT); }
__device__ __forceinline__ unsigned xb_add(unsigned* p, unsigned v) { return __hip_atomic_fetch_add(p, v, __ATOMIC_RELAXED, __HIP_MEMORY_SCOPE_AGENT); }
__device__ __forceinline__ unsigned xb_xcc_id() { return (unsigned)__builtin_amdgcn_s_getreg((3 << 11) | 20) & 0xFu; }
#define XB_SPIN(cond, bar) do { unsigned _sp = 0; while (cond) { __builtin_amdgcn_s_sleep(1); \
    if ((++_sp & 255u) == 0u) { if (xb_ld(&(bar)[XB_TMO])) break; if (_sp > XB_SPIN_CAP) { atomicAdd(&(bar)[XB_TMO], 1u); break; } } } } while (0)

struct XcdBarrier {
    unsigned* bar; unsigned x;
    volatile LAS unsigned* st;
};

__device__ __forceinline__ XcdBarrier xcd_barrier_post(unsigned* bar, volatile LAS unsigned* st) {
    XcdBarrier b; b.bar = bar; b.x = xb_xcc_id(); b.st = st;
    if (threadIdx.x == 0) (void)xb_add(&bar[XB_XCNT(b.x)], 1u);
    return b;
}
__device__ __forceinline__ void xcd_barrier_complete(unsigned* bar, unsigned x, unsigned& nloc, unsigned& nx) {
    const unsigned G = gridDim.x * gridDim.y * gridDim.z;
    unsigned sum, cnt, mine, sp = 0u;
    for (;;) {
        sum = 0u; cnt = 0u; mine = 0u;
#pragma unroll
        for (unsigned j = 0; j < 16; ++j) { const unsigned c = xb_ld(&bar[XB_XCNT(j)]); sum += c; cnt += (c > 0u) ? 1u : 0u; mine = (j == x) ? c : mine; }
        if (sum == G) break;
        __builtin_amdgcn_s_sleep(1);
        if ((++sp & 255u) == 0u) { if (xb_ld(&bar[XB_TMO])) break; if (sp > XB_SPIN_CAP) { atomicAdd(&bar[XB_TMO], 1u); break; } }
    }
    nloc = mine > 0u ? mine : 1u; nx = cnt > 0u ? cnt : 1u;
}

__device__ __forceinline__ void xcd_barrier(const XcdBarrier& b) {
    asm volatile("s_waitcnt vmcnt(0)" ::: "memory");
    __syncthreads();
    if (threadIdx.x == 0) {
        unsigned* bar = b.bar;
        __builtin_amdgcn_s_waitcnt(0);
        unsigned nloc = b.st[0], nx = b.st[1];
        if (nloc == 0u) { xcd_barrier_complete(bar, b.x, nloc, nx); b.st[0] = nloc; b.st[1] = nx; }
        const unsigned old = xb_add(&bar[XB_XSUB(b.x)], 1u);
        const unsigned gen = old / nloc;
        if (old + 1u == (gen + 1u) * nloc) {
            __builtin_amdgcn_fence(__ATOMIC_RELEASE, "agent");
            asm volatile("s_waitcnt vmcnt(0)" ::: "memory");
            const unsigned og = xb_add(&bar[XB_TOP], 1u);
            const unsigned tg = og / nx;
            if (og + 1u == (tg + 1u) * nx) xb_add(&bar[XB_TOPGEN], 1u);
            else XB_SPIN(xb_ld(&bar[XB_TOPGEN]) == tg, bar);
            __builtin_amdgcn_fence(__ATOMIC_ACQUIRE, "agent");
            xb_add(&bar[XB_XGEN(b.x)], 1u);
            asm volatile("s_waitcnt vmcnt(0)" ::: "memory");
        } else {
            XB_SPIN(xb_ld(&bar[XB_XGEN(b.x)]) == gen, bar);
            __builtin_amdgcn_fence(__ATOMIC_ACQUIRE, "agent");
            asm volatile("s_waitcnt vmcnt(0)" ::: "memory");
        }
    }
    __syncthreads();
}
namespace pg8 {
#define PG8_LAS __attribute__((address_space(3)))
typedef unsigned short bf16_t;
typedef short bf16x8 __attribute__((ext_vector_type(8)));
typedef float f32x4 __attribute__((ext_vector_type(4)));
typedef unsigned u32x4 __attribute__((ext_vector_type(4)));
constexpr int BM = 256, BK = 64, HALF = 128, HTB = HALF * BK * 2  , STAGE_BYTES = 8 * HTB, NXCD = 8, WGM = 8;

__host__ __device__ __forceinline__ int lds_byte(int r, int c) { const int st = (r >> 4) * 2 + (c >> 5), rr = r & 15, cc = c & 31, ob = rr * 64 + cc * 2; return st * 1024 + (ob ^ (((ob >> 9) & 1) << 5)); }
__host__ __device__ __forceinline__ void stage_rc(int b, int& R, int& C) { const int st = b / 1024, sb = b % 1024, swz = sb ^ (((sb >> 9) & 1) << 5); R = (st >> 1) * 16 + swz / 64; C = (st & 1) * 32 + (swz % 64) / 2; }
__host__ __device__ __forceinline__ int perm32(int rho) { const int n = rho >> 4, i = rho & 15; return 8 * (i >> 2) + 4 * n + (i & 3); }

struct Unit { int pm, pn; };
struct Gemm { const bf16_t* A; const bf16_t* Bt; int M, N, K; };

struct StaticOrder {
    int nM, nN, nwg, G, c;
    __host__ __device__ void init(int M, int N, int G_, int c_) { nM = M / BM; nN = N / BM; nwg = nM * nN; G = G_; c = c_; }
    __host__ __device__ bool next(int i, Unit& u) const {
        const long L = (long)i * G + c; if (L >= nwg) return false;
        int wgid = (int)L; { const int q = nwg / NXCD, r = nwg % NXCD, xcd = wgid % NXCD, off = wgid / NXCD; wgid = (xcd < r ? xcd * (q + 1) : r * (q + 1) + (xcd - r) * q) + off; }
        const int nig = WGM * nN, gid = wgid / nig, fm = gid * WGM, gsz = (nM - fm) < WGM ? (nM - fm) : WGM;
        u.pm = fm + ((wgid % nig) % gsz); u.pn = (wgid % nig) / gsz; return true;
    }
    __device__ __forceinline__ void a_ready(const Unit&) const {}
    __device__ __forceinline__ void done(const Unit&) const {}
};
typedef float cvt_f32x2 __attribute__((ext_vector_type(2)));
typedef __bf16 cvt_bf16x2 __attribute__((ext_vector_type(2)));
__device__ __forceinline__ unsigned cvt_pk_bf16(float lo, float hi) { return __builtin_bit_cast(unsigned, __builtin_convertvector((cvt_f32x2){lo, hi}, cvt_bf16x2)); }
__device__ __forceinline__ float bflo(unsigned u) { return __uint_as_float(u << 16); }
__device__ __forceinline__ float bfhi(unsigned u) { return __uint_as_float(u & 0xffff0000u); }

struct EpiProj {
    static constexpr bool PERM = true, AFTER_DRAIN = false, HAS_MID = false;
    bf16_t* O; int ldc;
    __device__ __forceinline__ void mid(f32x4 (&)[2][2][4][2], const Unit&, int, int, int, int) const {}
    __device__ __forceinline__ void operator()(const f32x4 (&acc)[2][2][4][2], const Unit& u, int wr, int wc, int fr, int fq) const {
        const int row0 = u.pm * BM + wr * 64 + fr, col0 = u.pn * BM + wc * 32 + 8 * fq;
#pragma unroll
        for (int ai = 0; ai < 2; ++ai)
#pragma unroll
            for (int m = 0; m < 4; ++m) { bf16_t* rowp = O + (size_t)(row0 + ai * HALF + m * 16) * ldc + col0;
#pragma unroll
                for (int bj = 0; bj < 2; ++bj) { const f32x4 v0 = acc[ai][bj][m][0], v1 = acc[ai][bj][m][1];
                    u32x4 w; w.x = cvt_pk_bf16(v0[0], v0[1]); w.y = cvt_pk_bf16(v0[2], v0[3]); w.z = cvt_pk_bf16(v1[0], v1[1]); w.w = cvt_pk_bf16(v1[2], v1[3]);
                    *(u32x4*)(rowp + bj * HALF) = w; } }
    }
};

struct EpiGlu {
    static constexpr bool PERM = true, AFTER_DRAIN = false, HAS_MID = false;
    const bf16_t* Y; bf16_t* O; const float* bias; float* rss;
    __device__ __forceinline__ void mid(f32x4 (&)[2][2][4][2], const Unit&, int, int, int, int) const {}
    __device__ __forceinline__ void operator()(const f32x4 (&acc)[2][2][4][2], const Unit& u, int wr, int wc, int fr, int fq) const {
        const int row0 = u.pm * BM + wr * 64 + fr, col0 = u.pn * BM + wc * 32 + 8 * fq;
        f32x4 bv[2][2];
#pragma unroll
        for (int bj = 0; bj < 2; ++bj)
#pragma unroll
            for (int n = 0; n < 2; ++n) bv[bj][n] = *(const f32x4*)(bias + col0 + bj * HALF + 4 * n);
        u32x4 yq[2][2];
#pragma unroll
        for (int bj = 0; bj < 2; ++bj) yq[0][bj] = *(const u32x4*)(Y + (size_t)row0 * 1024 + col0 + bj * HALF);
#pragma unroll
        for (int idx = 0; idx < 8; ++idx) { const int ai = idx >> 2, m = idx & 3, row = row0 + ai * HALF + m * 16; float ss = 0.f;
            if (idx < 7) { const int nrow = row0 + ((idx + 1) >> 2) * HALF + ((idx + 1) & 3) * 16;
#pragma unroll
                for (int bj = 0; bj < 2; ++bj) yq[(idx + 1) & 1][bj] = *(const u32x4*)(Y + (size_t)nrow * 1024 + col0 + bj * HALF); }
#pragma unroll
            for (int bj = 0; bj < 2; ++bj) {
                const u32x4 yv = yq[idx & 1][bj];
                const f32x4 g0 = acc[ai][bj][m][0] + bv[bj][0], g1 = acc[ai][bj][m][1] + bv[bj][1];
                float y[8] = {bflo(yv.x), bfhi(yv.x), bflo(yv.y), bfhi(yv.y), bflo(yv.z), bfhi(yv.z), bflo(yv.w), bfhi(yv.w)};
                float o[8];
#pragma unroll
                for (int e = 0; e < 4; ++e) { o[e] = y[e] * __builtin_amdgcn_rcpf(1.f + __expf(-g0[e])); o[4 + e] = y[4 + e] * __builtin_amdgcn_rcpf(1.f + __expf(-g1[e])); }
#pragma unroll
                for (int e = 0; e < 8; ++e) ss += o[e] * o[e];
                u32x4 w; w.x = cvt_pk_bf16(o[0], o[1]); w.y = cvt_pk_bf16(o[2], o[3]); w.z = cvt_pk_bf16(o[4], o[5]); w.w = cvt_pk_bf16(o[6], o[7]);
                *(u32x4*)(O + (size_t)row * 2048 + col0 + bj * HALF) = w; }
            ss += __shfl_xor(ss, 16); ss += __shfl_xor(ss, 32);
            if (fq == 0) unsafeAtomicAdd(rss + row, ss); }
    }
};

struct EpiWout {
    static constexpr bool PERM = true, AFTER_DRAIN = false, HAS_MID = true;
    const float* X; float* OUT; bf16_t* XB; float* rss_x; const PG8_LAS float* tab;
    __device__ __forceinline__ void mid(f32x4 (&acc)[2][2][4][2], const Unit& u, int wr, int wc, int fr, int fq) const {
        const PG8_LAS float* tp = tab + wr * 64 + fr;
#pragma unroll
        for (int ai = 0; ai < 2; ++ai)
#pragma unroll
            for (int m = 0; m < 4; ++m) { const float ratio = tp[ai * HALF + m * 16];
#pragma unroll
                for (int bj = 0; bj < 2; ++bj)
#pragma unroll
                    for (int n = 0; n < 2; ++n) acc[ai][bj][m][n] *= ratio; }
    }
    __device__ __forceinline__ void operator()(const f32x4 (&acc)[2][2][4][2], const Unit& u, int wr, int wc, int fr, int fq) const {
        const int row0 = u.pm * BM + wr * 64 + fr, col0 = u.pn * BM + wc * 32 + 8 * fq;
        const PG8_LAS float* tp = tab + 256 + wr * 64 + fr;
        f32x4 xq[2][2][2];
#pragma unroll
        for (int bj = 0; bj < 2; ++bj) { const size_t o = (size_t)row0 * 2048 + col0 + bj * HALF; xq[0][bj][0] = *(const f32x4*)(X + o); xq[0][bj][1] = *(const f32x4*)(X + o + 4); }
#pragma unroll
        for (int idx = 0; idx < 8; ++idx) { const int ai = idx >> 2, m = idx & 3, row = row0 + ai * HALF + m * 16; float ss = 0.f;
            if (idx < 7) { const int nrow = row0 + ((idx + 1) >> 2) * HALF + ((idx + 1) & 3) * 16;
#pragma unroll
                for (int bj = 0; bj < 2; ++bj) { const size_t o = (size_t)nrow * 2048 + col0 + bj * HALF; xq[(idx + 1) & 1][bj][0] = *(const f32x4*)(X + o); xq[(idx + 1) & 1][bj][1] = *(const f32x4*)(X + o + 4); } }
            const float rs = tp[ai * HALF + m * 16];
#pragma unroll
            for (int bj = 0; bj < 2; ++bj) { const size_t o = (size_t)row * 2048 + col0 + bj * HALF;
                const f32x4 v0 = xq[idx & 1][bj][0] + rs * acc[ai][bj][m][0], v1 = xq[idx & 1][bj][1] + rs * acc[ai][bj][m][1];
                u32x4 w; w.x = cvt_pk_bf16(v0[0], v0[1]); w.y = cvt_pk_bf16(v0[2], v0[3]); w.z = cvt_pk_bf16(v1[0], v1[1]); w.w = cvt_pk_bf16(v1[2], v1[3]);
                *(u32x4*)(XB + o) = w;
#pragma unroll
                for (int e = 0; e < 4; ++e) ss += v0[e] * v0[e] + v1[e] * v1[e]; }
            ss += __shfl_xor(ss, 16); ss += __shfl_xor(ss, 32);
            if (fq == 0) unsafeAtomicAdd(rss_x + row, ss); }
    }
};

struct EpiScores {
    static constexpr bool PERM = false, AFTER_DRAIN = false, HAS_MID = false;
    float* C; const float* rss_x;
    __device__ __forceinline__ void mid(f32x4 (&)[2][2][4][2], const Unit&, int, int, int, int) const {}
    __device__ __forceinline__ void operator()(const f32x4 (&acc)[2][2][4][2], const Unit& u, int wr, int wc, int fr, int fq) const {
        const int row0 = u.pm * BM + wr * 64 + fr, col0 = u.pn * BM + wc * 32 + 4 * fq;
        float r2v[8];
#pragma unroll
        for (int idx = 0; idx < 8; ++idx) r2v[idx] = rss_x[row0 + (idx >> 2) * HALF + (idx & 3) * 16];
#pragma unroll
        for (int ai = 0; ai < 2; ++ai)
#pragma unroll
            for (int m = 0; m < 4; ++m) { const int row = row0 + ai * HALF + m * 16;
                const float r2 = __builtin_amdgcn_rsqf(r2v[ai * 4 + m] * (1.f / 2048.f) + 1e-6f);
                float* rowp = C + (size_t)row * 2048 + col0;
#pragma unroll
                for (int bj = 0; bj < 2; ++bj)
#pragma unroll
                    for (int n = 0; n < 2; ++n) *(f32x4*)(rowp + bj * HALF + n * 16) = acc[ai][bj][m][n] * r2; }
    }
};

template <class Epi, class Sched, bool STAMP = false>
__device__ __forceinline__ void gemm_phase(PG8_LAS unsigned char* lds, const Gemm g, const Sched& S, const Epi& E, unsigned long long* stamps) {
    const int tid = threadIdx.x, wid = __builtin_amdgcn_readfirstlane(tid >> 6), lane = tid & 63, wr = wid >> 2, wc = wid & 3, fr = lane & 15, fq = lane >> 4;
    const int K = g.K, nt = K / BK;
    int ts_lo = 0, ts_hi = 0, nts = 0; const unsigned long long rt_entry = STAMP ? (unsigned long long)wall_clock64() : 0ull;
#define PG8_STAMP() do { if (STAMP && wid == 0 && nts < 64) { const unsigned long long _c = (unsigned long long)clock64(); \
        ts_lo = (lane == nts) ? (int)(unsigned)_c : ts_lo; ts_hi = (lane == nts) ? (int)(unsigned)(_c >> 32) : ts_hi; ++nts; } } while (0)
    PG8_STAMP();
    unsigned voffA[2], voffB[2];
#pragma unroll
    for (int i = 0; i < 2; ++i) { int R, C; stage_rc(tid * 16 + i * 8192, R, C); const int Rb = Epi::PERM ? ((R & ~31) + perm32(R & 31)) : R;
        voffA[i] = (unsigned)(R * K + C) * 2u; voffB[i] = (unsigned)(Rb * K + C) * 2u; }
    const size_t kstep = (size_t)(BK * 2);
    const size_t hstep = (size_t)HALF * K * 2;
    const size_t tstep = 2 * hstep;
    const unsigned ldsw = (unsigned)wid * 1024u;
    const int aoff = lds_byte(wr * 64 + fr, fq * 8), boff = lds_byte(wc * 32 + fr, fq * 8);
#define PG8_SA(b, h) (((b) * 2 + (h)) * HTB)
#define PG8_SB(b, h) ((4 + (b) * 2 + (h)) * HTB)
#define PG8_STAGE(bufoff, gbase, voff) do { _Pragma("unroll") for (int _i = 0; _i < 2; ++_i) \
        __builtin_amdgcn_global_load_lds((const unsigned*)((const char*)(gbase) + (voff)[_i]), (PG8_LAS unsigned*)(lds + (bufoff) + ldsw + _i * 8192), 16, 0, 0); } while (0)
#define PG8_LDA(dst, b, h) do { _Pragma("unroll") for (int m = 0; m < 4; ++m) _Pragma("unroll") for (int k = 0; k < 2; ++k) dst[m][k] = *(const PG8_LAS bf16x8*)(lds + PG8_SA(b, h) + aoff + m * 2048 + k * 1024); } while (0)
#define PG8_LDB(dst, b, h) do { _Pragma("unroll") for (int n = 0; n < 2; ++n) _Pragma("unroll") for (int k = 0; k < 2; ++k) dst[n][k] = *(const PG8_LAS bf16x8*)(lds + PG8_SB(b, h) + boff + n * 2048 + k * 1024); } while (0)
#define PG8_MMA(ai, bj, At, Bt) do { __builtin_amdgcn_s_setprio(1); _Pragma("unroll") for (int m = 0; m < 4; ++m) _Pragma("unroll") for (int n = 0; n < 2; ++n) _Pragma("unroll") for (int k = 0; k < 2; ++k) \
        acc[ai][bj][m][n] = __builtin_amdgcn_mfma_f32_16x16x32_bf16(Bt[n][k], At[m][k], acc[ai][bj][m][n], 0, 0, 0); __builtin_amdgcn_s_setprio(0); } while (0)
#define PG8_WAIT_V(n) asm volatile("s_waitcnt vmcnt(" #n ")" ::: "memory")
#define PG8_WAIT_L(n) asm volatile("s_waitcnt lgkmcnt(" #n ")" ::: "memory")
#define PG8_BAR __builtin_amdgcn_s_barrier()
#define PG8_SCHED __builtin_amdgcn_sched_barrier(0)
    Unit cur, nxt; int ui = 0;
    if (!S.next(0, cur)) return;
    f32x4 acc[2][2][4][2];
#pragma unroll
    for (int a = 0; a < 2; ++a)
#pragma unroll
        for (int b = 0; b < 2; ++b)
#pragma unroll
            for (int m = 0; m < 4; ++m)
#pragma unroll
                for (int n = 0; n < 2; ++n) acc[a][b][m][n] = (f32x4){0.f, 0.f, 0.f, 0.f};
    bf16x8 At[4][2], B0[2][2], B1[2][2];
    const char* cA = (const char*)g.A + (size_t)cur.pm * tstep; const char* cB = (const char*)g.Bt + (size_t)cur.pn * tstep;
    S.a_ready(cur);
    PG8_STAGE(PG8_SB(0, 0), cB, voffB); PG8_STAGE(PG8_SA(0, 0), cA, voffA); PG8_STAGE(PG8_SB(0, 1), cB + hstep, voffB); PG8_STAGE(PG8_SA(0, 1), cA + hstep, voffA);
    if (wr == 1) PG8_BAR;
    PG8_WAIT_V(4); PG8_BAR;
    PG8_STAGE(PG8_SB(1, 0), cB + kstep, voffB); PG8_STAGE(PG8_SA(1, 0), cA + kstep, voffA); PG8_STAGE(PG8_SB(1, 1), cB + hstep + kstep, voffB);
    PG8_WAIT_V(6); PG8_BAR;
    PG8_STAMP();
    for (;;) {
        const bool has_next = S.next(ui + 1, nxt);
        const char* nA = has_next ? (const char*)g.A + (size_t)nxt.pm * tstep : cA; const char* nB = has_next ? (const char*)g.Bt + (size_t)nxt.pn * tstep : cB;
        for (int t = 0; t < nt; t += 2) {
            const bool last = (t == nt - 2);
            const char* a1 = cA + (size_t)(t + 1) * kstep;
            const char* a2 = last ? nA : cA + (size_t)(t + 2) * kstep; const char* b2 = last ? nB : cB + (size_t)(t + 2) * kstep;
            const char* a3 = a2 + kstep; const char* b3 = b2 + kstep;
            if (last && has_next) S.a_ready(nxt);
            if constexpr (Epi::HAS_MID) { if (t == (nt >> 1)) { E.mid(acc, cur, wr, wc, fr, fq); asm volatile("s_waitcnt lgkmcnt(0)" ::: "memory"); } }
            PG8_LDB(B0, 0, 0); PG8_SCHED; PG8_LDA(At, 0, 0); PG8_STAGE(PG8_SA(1, 1), a1 + hstep, voffA);
            PG8_WAIT_L(8); PG8_BAR; PG8_WAIT_L(0); PG8_MMA(0, 0, At, B0); PG8_BAR; PG8_SCHED;
            PG8_LDB(B1, 0, 1); PG8_STAGE(PG8_SB(0, 0), b2, voffB);
            PG8_BAR; PG8_WAIT_L(0); PG8_MMA(0, 1, At, B1); PG8_BAR;
            PG8_LDA(At, 0, 1); PG8_STAGE(PG8_SA(0, 0), a2, voffA);
            PG8_BAR; PG8_WAIT_L(0); PG8_MMA(1, 0, At, B0); PG8_BAR; PG8_SCHED;
            PG8_STAGE(PG8_SB(0, 1), b2 + hstep, voffB);
            PG8_WAIT_V(6); PG8_BAR; PG8_MMA(1, 1, At, B1); PG8_BAR;
            PG8_LDB(B0, 1, 0); PG8_SCHED; PG8_LDA(At, 1, 0); PG8_STAGE(PG8_SA(0, 1), a2 + hstep, voffA);
            PG8_WAIT_L(8); PG8_BAR; PG8_WAIT_L(0); PG8_MMA(0, 0, At, B0); PG8_BAR; PG8_SCHED;
            PG8_LDB(B1, 1, 1); PG8_STAGE(PG8_SB(1, 0), b3, voffB);
            PG8_BAR; PG8_WAIT_L(0); PG8_MMA(0, 1, At, B1); PG8_BAR;
            PG8_LDA(At, 1, 1); PG8_STAGE(PG8_SA(1, 0), a3, voffA);
            PG8_BAR; PG8_WAIT_L(0); PG8_MMA(1, 0, At, B0); PG8_BAR; PG8_SCHED;
            PG8_STAGE(PG8_SB(1, 1), b3 + hstep, voffB);
            PG8_WAIT_V(6); PG8_BAR; PG8_MMA(1, 1, At, B1); PG8_BAR;
        }
        PG8_STAMP();
        if constexpr (!Epi::AFTER_DRAIN) { E(acc, cur, wr, wc, fr, fq); S.done(cur); }
        PG8_STAMP();
        if (!has_next) break;
#pragma unroll
        for (int a = 0; a < 2; ++a)
#pragma unroll
            for (int b = 0; b < 2; ++b)
#pragma unroll
                for (int m = 0; m < 4; ++m)
#pragma unroll
                    for (int n = 0; n < 2; ++n) acc[a][b][m][n] = (f32x4){0.f, 0.f, 0.f, 0.f};
        cur = nxt; cA = nA; cB = nB; ++ui;
    }
    PG8_WAIT_V(0);
    if (wr == 0) PG8_BAR;
    PG8_BAR;
    if constexpr (Epi::AFTER_DRAIN) { E.fused(acc, cur, wr, wc, fr, fq, lds, wid, lane); S.done(cur); }
    PG8_STAMP();
    if (STAMP && wid == 0) { stamps[lane] = lane < nts ? (((unsigned long long)(unsigned)ts_hi << 32) | (unsigned)ts_lo) : 0ull;
        if (lane == 62) stamps[62] = rt_entry; if (lane == 63) stamps[63] = (unsigned long long)wall_clock64(); }
#undef PG8_STAMP
#undef PG8_SA
#undef PG8_SB
#undef PG8_STAGE
#undef PG8_LDA
#undef PG8_LDB
#undef PG8_MMA
#undef PG8_WAIT_V
#undef PG8_WAIT_L
#undef PG8_BAR
#undef PG8_SCHED
}
}

typedef short bf16x8 __attribute__((ext_vector_type(8)));
typedef float f32x4 __attribute__((ext_vector_type(4)));
typedef unsigned u32x4 __attribute__((ext_vector_type(4)));
using pg8::cvt_pk_bf16; using pg8::bflo; using pg8::bfhi;

#define LDS_WAIT() asm volatile("s_waitcnt lgkmcnt(0)" ::: "memory")
#define CBAR() asm volatile("" ::: "memory")
#define MFMA16(a, b, c) __builtin_amdgcn_mfma_f32_16x16x32_bf16((a), (b), (c), 0, 0, 0)

struct Args { const float* in[25]; float* out; unsigned char* ws; int ph_lo, ph_hi; };

__device__ __forceinline__ float wave_sum(float v) {
#pragma unroll
    for (int o = 1; o < 64; o <<= 1) v += __shfl_xor(v, o);
    return v;
}
__device__ __forceinline__ float wave_max(float v) {
#pragma unroll
    for (int o = 1; o < 64; o <<= 1) v = fmaxf(v, __shfl_xor(v, o));
    return v;
}
__device__ __forceinline__ float gelu_erf(float x) { return 0.5f * x * (1.0f + erff(x * 0.70710678118654752f)); }
__device__ __forceinline__ float gelu_as(float v) {
    const float av = fabsf(v), t = __builtin_amdgcn_rcpf(fmaf(av, 0.2316418882f, 1.0f));
    float q = fmaf(t, 0.5307027145f, -0.7265760135f); q = fmaf(q, t, 0.7107068705f); q = fmaf(q, t, -0.142248368f); q = fmaf(q, t, 0.127414796f); q *= t;
    const float e = __builtin_amdgcn_exp2f(v * v * -0.72134752044f), m = v * (q * e);
    return v < 0.f ? m : v - m;
}
__device__ __forceinline__ bf16x8 as_bf16x8(u32x4 v) { return __builtin_bit_cast(bf16x8, v); }

__device__ __forceinline__ void p0_transpose_item(const float* W, int K, int N, bf16_t* WT, const float* sc_a, const float* sc_b, LAS float* scr, int item, int lane) {
    const int nblk = N / 32, kb = item / nblk, nb = item % nblk, k0 = 64 * kb, n0 = 32 * nb;
#pragma unroll 8
    for (int i = 0; i < 32; ++i) { const int kk = 2 * i + (lane >> 5); const int k = k0 + kk;
        const float s = sc_a ? (k < 1024 ? sc_a[k] : sc_b[k - 1024]) : 1.f;
        scr[kk * 33 + (lane & 31)] = W[(size_t)k * N + n0 + (lane & 31)] * s; }
    LDS_WAIT();
    const int c = lane & 7;
#pragma unroll
    for (int j = 0; j < 4; ++j) { const int n = (lane >> 3) + 8 * j; const LAS float* s = scr + (8 * c) * 33 + n;
        u32x4 o; o.x = cvt_pk_bf16(s[0 * 33], s[1 * 33]); o.y = cvt_pk_bf16(s[2 * 33], s[3 * 33]); o.z = cvt_pk_bf16(s[4 * 33], s[5 * 33]); o.w = cvt_pk_bf16(s[6 * 33], s[7 * 33]);
        *(u32x4*)(WT + (size_t)(n0 + n) * K + k0 + 8 * c) = o; }
    LDS_WAIT();
}
template <int MODE> __device__ __forceinline__ void p0_row(const float* xrow, const float* g, bf16_t* orow, int lane) {
    const f32x4* xr = (const f32x4*)xrow + lane; const f32x4* gr = (const f32x4*)g + lane;
    f32x4 v[8]; float s = 0.f;
#pragma unroll
    for (int j = 0; j < 8; ++j) { v[j] = xr[64 * j]; s += (v[j].x * v[j].x + v[j].y * v[j].y) + (v[j].z * v[j].z + v[j].w * v[j].w); }
    float r = 1.f;
    if (MODE == 0) r = 1.0f / sqrtf(wave_sum(s) * (1.f / 2048.f) + EPS);
    u32x2* o8 = (u32x2*)orow + lane;
#pragma unroll
    for (int j = 0; j < 8; ++j) { f32x4 w = v[j] * r; if (MODE != 2) w = w * gr[64 * j];
        u32x2 o; o.x = cvt_pk_bf16(w.x, w.y); o.y = cvt_pk_bf16(w.z, w.w); o8[64 * j] = o; }
}
template <bool SCALE_G, bool OFFS> __device__ __forceinline__ void p0_row_q8(const float* xrow, const float* g, unsigned char* orow, float* sc, int lane) {
    const f32x4* xr = (const f32x4*)xrow + lane; const f32x4* gr = (const f32x4*)g + lane;
    f32x4 v[8]; float m = 0.f;
#pragma unroll
    for (int j = 0; j < 8; ++j) { v[j] = xr[64 * j]; if (SCALE_G) v[j] = v[j] * gr[64 * j];
        m = fmaxf(fmaxf(m, fmaxf(fabsf(v[j].x), fabsf(v[j].y))), fmaxf(fabsf(v[j].z), fabsf(v[j].w))); }
    m = fmaxf(wave_max(m), 1e-30f);
    const float inv = 127.f / m;
    if (lane == 0) *sc = m * (1.f / 127.f);
    unsigned* o4 = (unsigned*)orow + lane;
#pragma unroll
    for (int j = 0; j < 8; ++j) { const int a = (int)rintf(v[j].x * inv) + (OFFS ? 128 : 0), b = (int)rintf(v[j].y * inv) + (OFFS ? 128 : 0), c = (int)rintf(v[j].z * inv) + (OFFS ? 128 : 0), d = (int)rintf(v[j].w * inv) + (OFFS ? 128 : 0);
        o4[64 * j] = (unsigned)(a & 255) | ((unsigned)(b & 255) << 8) | ((unsigned)(c & 255) << 16) | ((unsigned)(d & 255) << 24); }
}
template <int KIND> __device__ __forceinline__ void p0_rows(const float* src, const float* g, void* dst, float* sc, int first, int stride, int nrows, int lane) {
    const f32x4* gr = (const f32x4*)g + lane;
    f32x4 cur[8], nxt[8], nx2[8];
    int r = first;
    if (r >= nrows) return;
    { const f32x4* xr = (const f32x4*)(src + (size_t)r * 2048) + lane;
#pragma unroll
        for (int j = 0; j < 8; ++j) cur[j] = xr[64 * j]; }
    if (r + stride < nrows) { const f32x4* xr = (const f32x4*)(src + (size_t)(r + stride) * 2048) + lane;
#pragma unroll
        for (int j = 0; j < 8; ++j) nxt[j] = xr[64 * j]; }
    for (; r < nrows; r += stride) {
        const int rn = r + 2 * stride;
        if (rn < nrows) { const f32x4* xr = (const f32x4*)(src + (size_t)rn * 2048) + lane;
#pragma unroll
            for (int j = 0; j < 8; ++j) nx2[j] = xr[64 * j]; }
        if (KIND == 0) {
            float s = 0.f;
#pragma unroll
            for (int j = 0; j < 8; ++j) s += (cur[j].x * cur[j].x + cur[j].y * cur[j].y) + (cur[j].z * cur[j].z + cur[j].w * cur[j].w);
            const float rr = 1.0f / sqrtf(wave_sum(s) * (1.f / 2048.f) + EPS);
            u32x2* o8 = (u32x2*)((bf16_t*)dst + (size_t)r * 2048) + lane;
#pragma unroll
            for (int j = 0; j < 8; ++j) { const f32x4 w = cur[j] * rr * gr[64 * j]; u32x2 o; o.x = cvt_pk_bf16(w.x, w.y); o.y = cvt_pk_bf16(w.z, w.w); o8[64 * j] = o; }
        } else if (KIND >= 3) {
            float ssq = 0.f;
#pragma unroll
            for (int j = 0; j < 8; ++j) { if (KIND == 3) cur[j] = cur[j] * gr[64 * j]; ssq += (cur[j].x * cur[j].x + cur[j].y * cur[j].y) + (cur[j].z * cur[j].z + cur[j].w * cur[j].w); }
            const float rms = sqrtf(fmaxf(wave_sum(ssq) * (1.f / 2048.f), 1e-30f));
            const float sq = 0.1676f * rms, inv = 0.5f / sq;
            if (lane == 0) sc[r] = sq;
            unsigned* o4 = (unsigned*)((unsigned char*)dst + (size_t)r * 2048) + lane;
#pragma unroll
            for (int j = 0; j < 4; ++j) { unsigned w = 0u;
#pragma unroll
                for (int e = 0; e < 4; ++e) { const float lo = cur[j][e], hi = cur[j + 4][e];
                    int nl = (int)rintf(fmaf(lo, inv, 7.5f)), nh = (int)rintf(fmaf(hi, inv, 7.5f));
                    nl = nl < 0 ? 0 : (nl > 15 ? 15 : nl); nh = nh < 0 ? 0 : (nh > 15 ? 15 : nh);
                    w |= ((unsigned)nl << (8 * e)) | ((unsigned)nh << (8 * e + 4)); }
                o4[64 * j] = w; }
        } else {
            float m = 0.f;
#pragma unroll
            for (int j = 0; j < 8; ++j) { if (KIND == 1) cur[j] = cur[j] * gr[64 * j];
                m = fmaxf(fmaxf(m, fmaxf(fabsf(cur[j].x), fabsf(cur[j].y))), fmaxf(fabsf(cur[j].z), fabsf(cur[j].w))); }
            m = fmaxf(wave_max(m), 1e-30f);
            const float inv = 127.f / m; const int off = KIND == 2 ? 128 : 0;
            if (lane == 0) sc[r] = m * (1.f / 127.f);
            unsigned* o4 = (unsigned*)((unsigned char*)dst + (size_t)r * 2048) + lane;
#pragma unroll
            for (int j = 0; j < 8; ++j) { const int a = (int)rintf(cur[j].x * inv) + off, b = (int)rintf(cur[j].y * inv) + off, c = (int)rintf(cur[j].z * inv) + off, d = (int)rintf(cur[j].w * inv) + off;
                o4[64 * j] = (unsigned)(a & 255) | ((unsigned)(b & 255) << 8) | ((unsigned)(c & 255) << 16) | ((unsigned)(d & 255) << 24); }
        }
#pragma unroll
        for (int j = 0; j < 8; ++j) { cur[j] = nxt[j]; nxt[j] = nx2[j]; }
    }
}
__device__ __forceinline__ void p0_wp_item(const float* wq, const float* keys1, const float* keys2, const float* gffn, bf16_t* WPT, int item, int lane) {
    const int hj = item >> 7, ib = item & 127, h = hj >> 1, j = hj & 1, i0 = 16 * ib, col0 = h * 256 + j * 128;
    const int lr = lane & 15, g = lane >> 4;
    const float* keys = (j ? keys2 : keys1) + (size_t)h * 128 * 128;
    const float gi = gffn[i0 + lr];
    bf16x8 af[4];
#pragma unroll
    for (int s = 0; s < 4; ++s) { const float* p = wq + (size_t)(i0 + lr) * 2048 + col0 + 32 * s + 8 * g;
        const f32x4 a = *(const f32x4*)p * gi, b = *(const f32x4*)(p + 4) * gi;
        u32x4 w; w.x = cvt_pk_bf16(a.x, a.y); w.y = cvt_pk_bf16(a.z, a.w); w.z = cvt_pk_bf16(b.x, b.y); w.w = cvt_pk_bf16(b.z, b.w); af[s] = as_bf16x8(w); }
    f32x4 kn[8];
#pragma unroll
    for (int s = 0; s < 4; ++s) { const float* p = keys + (size_t)lr * 128 + 32 * s + 8 * g; kn[2 * s] = *(const f32x4*)p; kn[2 * s + 1] = *(const f32x4*)(p + 4); }
    for (int kt = 0; kt < 8; ++kt) {
        f32x4 kc[8];
#pragma unroll
        for (int i = 0; i < 8; ++i) kc[i] = kn[i];
        if (kt < 7) {
#pragma unroll
            for (int s = 0; s < 4; ++s) { const float* p = keys + (size_t)(16 * (kt + 1) + lr) * 128 + 32 * s + 8 * g; kn[2 * s] = *(const f32x4*)p; kn[2 * s + 1] = *(const f32x4*)(p + 4); } }
        f32x4 d = {0.f, 0.f, 0.f, 0.f};
#pragma unroll
        for (int s = 0; s < 4; ++s) { const f32x4 a = kc[2 * s], b = kc[2 * s + 1];
            u32x4 w; w.x = cvt_pk_bf16(a.x, a.y); w.y = cvt_pk_bf16(a.z, a.w); w.z = cvt_pk_bf16(b.x, b.y); w.w = cvt_pk_bf16(b.z, b.w);
            d = MFMA16(af[s], as_bf16x8(w), d); }
        u32x2 o; o.x = cvt_pk_bf16(d[0], d[1]); o.y = cvt_pk_bf16(d[2], d[3]);
        *(u32x2*)(WPT + (size_t)(hj * 128 + 16 * kt + lr) * 2048 + i0 + 4 * g) = o;
    }
}
__device__ __forceinline__ int t5_bucket(int n) {
    if (n < 16) return n;
    const int large = 16 + (int)(logf((float)n / 16.f) / 4.852030263919617f * 16.f);
    return large < 31 ? large : 31;
}
__device__ __forceinline__ void p0_ssm_item(const Args& A, unsigned char* sp, int g, int lane) {
    const float* lam_re = A.in[6]; const float* lam_im = A.in[7]; const float* log_dt = A.in[8];
    const float* b_re = A.in[9]; const float* b_im = A.in[10]; const float* c_re = A.in[11]; const float* c_im = A.in[12];
    const int n = lane;
    const float dt = expf(log_dt[g]);
    const float lr = lam_re[g * 64 + n], li = lam_im[g * 64 + n];
    const float mag = expf(lr * dt);
    const float a_re = mag * cosf(li * dt), a_im = mag * sinf(li * dt);
    const float den = lr * lr + li * li;
    const float f_re = ((a_re - 1.f) * lr + a_im * li) / den, f_im = (a_im * lr - (a_re - 1.f) * li) / den;
    ((f32x2*)(sp + SSMP_ABAR))[g * 64 + n] = (f32x2){a_re, a_im};
    float pr = a_re, pi = a_im;
#pragma unroll
    for (int i = 0; i < 8; ++i) { const float nr = pr * pr - pi * pi, ni = 2.f * pr * pi; pr = nr; pi = ni; }
    ((f32x2*)(sp + SSMP_A256))[g * 64 + n] = (f32x2){pr, pi};
    float bbr[16], bbi[16];
#pragma unroll
    for (int q = 0; q < 4; ++q) { const f32x4 br = *(const f32x4*)(b_re + (size_t)(g * 64 + n) * 16 + 4 * q), bi = *(const f32x4*)(b_im + (size_t)(g * 64 + n) * 16 + 4 * q);
#pragma unroll
        for (int e = 0; e < 4; ++e) { bbr[4 * q + e] = f_re * br[e] - f_im * bi[e]; bbi[4 * q + e] = f_re * bi[e] + f_im * br[e]; } }
    bf16_t* bf = (bf16_t*)(sp + SSMP_BFRAG);
    const int jre = n >> 4, n16 = n & 15;
#pragma unroll
    for (int kg = 0; kg < 4; ++kg) {
        u32x4 wr = {0u, 0u, 0u, 0u}, wi = {0u, 0u, 0u, 0u};
        if (kg < 2) { const int c0 = (kg & 1) * 8;
            wr.x = cvt_pk_bf16(bbr[c0 + 0], bbr[c0 + 1]); wr.y = cvt_pk_bf16(bbr[c0 + 2], bbr[c0 + 3]); wr.z = cvt_pk_bf16(bbr[c0 + 4], bbr[c0 + 5]); wr.w = cvt_pk_bf16(bbr[c0 + 6], bbr[c0 + 7]);
            wi.x = cvt_pk_bf16(bbi[c0 + 0], bbi[c0 + 1]); wi.y = cvt_pk_bf16(bbi[c0 + 2], bbi[c0 + 3]); wi.z = cvt_pk_bf16(bbi[c0 + 4], bbi[c0 + 5]); wi.w = cvt_pk_bf16(bbi[c0 + 6], bbi[c0 + 7]); }
        *(u32x4*)(bf + ((size_t)(g * 8 + jre) * 64 + kg * 16 + n16) * 8) = wr;
        *(u32x4*)(bf + ((size_t)(g * 8 + 4 + jre) * 64 + kg * 16 + n16) * 8) = wi;
    }
    bf16_t* cf = (bf16_t*)(sp + SSMP_CFRAG);
    const int ch = lane & 15, kg = lane >> 4;
#pragma unroll
    for (int s = 0; s < 4; ++s) { const int k0 = 32 * s + 8 * kg;
        const float* src = (k0 < 64) ? (c_re + (size_t)(g * 16 + ch) * 64 + k0) : (c_im + (size_t)(g * 16 + ch) * 64 + (k0 - 64));
        const float sg = (k0 < 64) ? 1.f : -1.f;
        const f32x4 a = *(const f32x4*)src * sg, b = *(const f32x4*)(src + 4) * sg;
        u32x4 w; w.x = cvt_pk_bf16(a.x, a.y); w.y = cvt_pk_bf16(a.z, a.w); w.z = cvt_pk_bf16(b.x, b.y); w.w = cvt_pk_bf16(b.z, b.w);
        *(u32x4*)(cf + ((size_t)(g * 4 + s) * 64 + lane) * 8) = w; }
}
__device__ __forceinline__ void p0_btab_item(const Args& A, float* btab, int item, int lane) {
    const float* gq = A.in[3]; const float* gk = A.in[4]; const float* rel_bias = A.in[5];
    const int h = item / 3, br = item % 3, d = br == 0 ? 1 : (br == 1 ? 4 : 16);
    const float G = wave_max(fabsf(gq[lane] * gk[lane]));
    const float mb = wave_max(lane < 32 ? rel_bias[lane * 16 + h] : -1e30f);
    const float smax = 8.4f * G + mb;
    for (int idx = lane; idx < 192; idx += 64) { const int rel = idx - 31;
        float v = -1e30f;
        if (rel >= 0 && rel <= 128) v = LOG2E * (rel_bias[t5_bucket(rel * d) * 16 + h] - smax);
        btab[(h * 3 + br) * 192 + idx] = v; }
}

__device__ __forceinline__ void p0_prologue(const Args& A, LAS unsigned char* lds, int wave, int lane, int pflags) {
    unsigned char* ws = A.ws;
    LAS float* scr = (LAS float*)(lds + wave * 16384);
    const int gw = blockIdx.x * 8 + wave, NGW = gridDim.x * 8;
    constexpr int I_WIN = (2048 / 64) * (4096 / 32), I_GLU = (1024 / 64) * (1024 / 32), I_WOUT = (2048 / 64) * (2048 / 32), I_WP = 2048;
    constexpr int I_SSM = 64, I_BT = 48;
    constexpr int NITEMS = I_WIN + I_GLU + I_WOUT + I_WP + I_SSM + I_BT;
    const bool rows_first = wave & 1;
    if (rows_first && !(pflags & 2048)) {
        p0_rows<0>(A.in[0], A.in[1], ws + WS_HB, nullptr, gw, NGW, 8192, lane);
        p0_rows<3>(A.in[23], A.in[19], ws + WS_UB, (float*)(ws + WS_SU), gw, NGW, 16384, lane);
        p0_rows<4>(A.in[24], A.in[19], ws + WS_UB + 1024, (float*)(ws + WS_SV), gw, NGW, 16384, lane); }
    if (!(pflags & 4096)) for (int it = gw; it < NITEMS; it += NGW) {
        int r = it;
        if (r < I_SSM) { p0_ssm_item(A, ws + WS_SSMP, r, lane); continue; } r -= I_SSM;
        if (r < I_BT) { p0_btab_item(A, (float*)(ws + WS_BTAB), r, lane); continue; } r -= I_BT;
        if (r < I_WP) { p0_wp_item(A.in[20], A.in[21], A.in[22], A.in[19], (bf16_t*)(ws + WS_WPT), r, lane); continue; } r -= I_WP;
        if (r < I_WIN) { p0_transpose_item(A.in[2], 2048, 4096, (bf16_t*)(ws + WS_WINT), nullptr, nullptr, scr, r, lane); continue; } r -= I_WIN;
        if (r < I_GLU) { p0_transpose_item(A.in[14], 1024, 1024, (bf16_t*)(ws + WS_GLUT), nullptr, nullptr, scr, r, lane); continue; } r -= I_GLU;
        p0_transpose_item(A.in[18], 2048, 2048, (bf16_t*)(ws + WS_WOUTT), A.in[16], A.in[17], scr, r, lane);
    }
    if (!rows_first && !(pflags & 2048)) {
        p0_rows<0>(A.in[0], A.in[1], ws + WS_HB, nullptr, gw, NGW, 8192, lane);
        p0_rows<3>(A.in[23], A.in[19], ws + WS_UB, (float*)(ws + WS_SU), gw, NGW, 16384, lane);
        p0_rows<4>(A.in[24], A.in[19], ws + WS_UB + 1024, (float*)(ws + WS_SV), gw, NGW, 16384, lane); }
}

constexpr int SSM_WL = 8192 + 16 * 272 + 512;
__device__ __forceinline__ void ssm_unit(const Args& A, LAS unsigned char* lds, int b, int g, int wave, int lane) {
    unsigned char* ws = A.ws; unsigned char* sp = ws + WS_SSMP;
    const bf16_t* proj = (const bf16_t*)(ws + WS_PROJ); bf16_t* yb = (bf16_t*)(ws + WS_YB);
    LAS unsigned char* wl = lds + wave * SSM_WL;
    LAS f32x2* BU = (LAS f32x2*)wl; LAS unsigned char* XB = wl + 8192; LAS unsigned char* UL = wl + 8192 + 16 * 272;
    LAS f32x2* carry = (LAS f32x2*)(lds + 8 * SSM_WL);
    const int lr = lane & 15, q = lane >> 4;
    bf16x8 bfr[8], cfr[4];
#pragma unroll
    for (int j = 0; j < 8; ++j) bfr[j] = as_bf16x8(*(const u32x4*)((const bf16_t*)(sp + SSMP_BFRAG) + ((size_t)(g * 8 + j) * 64 + lane) * 8));
#pragma unroll
    for (int s = 0; s < 4; ++s) cfr[s] = as_bf16x8(*(const u32x4*)((const bf16_t*)(sp + SSMP_CFRAG) + ((size_t)(g * 4 + s) * 64 + lane) * 8));
    const f32x2 ab = ((const f32x2*)(sp + SSMP_ABAR))[g * 64 + lane], a256 = ((const f32x2*)(sp + SSMP_A256))[g * 64 + lane];
    const float a_re = ab.x, a_im = ab.y;
    const float dsk = A.in[13][g * 16 + lr];
    const bf16_t* up = proj + (size_t)(b * SEQ + wave * 256) * DPROJ + 3072 + g * 16;
    float xr = 0.f, xi = 0.f;
    for (int pass = 0; pass < 2; ++pass) {
        u32x4 unext = {0u, 0u, 0u, 0u};
        if (q < 2) unext = *(const u32x4*)(up + (size_t)lr * DPROJ + 8 * q);
        for (int blk = 0; blk < 16; ++blk) {
            const u32x4 uraw = unext;
            if (q < 2 && blk < 15) unext = *(const u32x4*)(up + (size_t)((blk + 1) * 16 + lr) * DPROJ + 8 * q);
            const bf16x8 ua = as_bf16x8(uraw);
            if (pass == 1 && q < 2) *(LAS u32x4*)(UL + lr * 32 + q * 16) = uraw;
            f32x4 dd[8];
#pragma unroll
            for (int j = 0; j < 8; ++j) dd[j] = MFMA16(ua, bfr[j], ((f32x4){0.f, 0.f, 0.f, 0.f}));
#pragma unroll
            for (int jj = 0; jj < 4; ++jj)
#pragma unroll
                for (int r = 0; r < 4; ++r) BU[(4 * q + r) * 64 + 16 * jj + lr] = (f32x2){dd[jj][r], dd[4 + jj][r]};
            CBAR();
            f32x2 bu[16];
#pragma unroll
            for (int t = 0; t < 16; ++t) bu[t] = BU[t * 64 + lane];
            if (pass == 0) {
#pragma unroll
                for (int t = 0; t < 16; ++t) { float nr = fmaf(a_re, xr, fmaf(-a_im, xi, bu[t].x)), ni = fmaf(a_re, xi, fmaf(a_im, xr, bu[t].y)); asm volatile("" : "+v"(nr)); asm volatile("" : "+v"(ni)); xr = nr; xi = ni; }
                asm volatile("" : "+v"(xr), "+v"(xi) :: "memory");
            } else {
#pragma unroll
                for (int t = 0; t < 16; ++t) { float nr = fmaf(a_re, xr, fmaf(-a_im, xi, bu[t].x)), ni = fmaf(a_re, xi, fmaf(a_im, xr, bu[t].y)); asm volatile("" : "+v"(nr)); asm volatile("" : "+v"(ni)); xr = nr; xi = ni;
                    const unsigned pk = cvt_pk_bf16(xr, xi);
                    *(LAS unsigned short*)(XB + t * 272 + lane * 2) = (unsigned short)(pk & 0xffffu);
                    *(LAS unsigned short*)(XB + t * 272 + 128 + lane * 2) = (unsigned short)(pk >> 16); }
                CBAR();
                f32x4 y = {0.f, 0.f, 0.f, 0.f};
#pragma unroll
                for (int s = 0; s < 4; ++s) { const bf16x8 xa = as_bf16x8(*(const LAS u32x4*)(XB + lr * 272 + (32 * s + 8 * q) * 2)); y = MFMA16(xa, cfr[s], y); }
#pragma unroll
                for (int r = 0; r < 4; ++r) { const int t = blk * 16 + 4 * q + r;
                    const float uv = __uint_as_float((unsigned)(*(const LAS unsigned short*)(UL + (4 * q + r) * 32 + lr * 2)) << 16);
                    const float yv = gelu_as(y[r] + dsk * uv);
                    yb[(size_t)(b * SEQ + wave * 256 + t) * 1024 + g * 16 + lr] = (bf16_t)(cvt_pk_bf16(yv, 0.f) & 0xffffu); }
                asm volatile("" : "+v"(xr), "+v"(xi) :: "memory");
            }
        }
        if (pass == 0) {
            carry[wave * 64 + lane] = (f32x2){xr, xi};
            __syncthreads();
            float sr = 0.f, si = 0.f;
            for (int w2 = 0; w2 < wave; ++w2) { const f32x2 e = carry[w2 * 64 + lane]; const float nr = a256.x * sr - a256.y * si + e.x, ni = a256.x * si + a256.y * sr + e.y; sr = nr; si = ni; }
            xr = sr; xi = si;
        }
    }
    __syncthreads();
}

__device__ __forceinline__ void prep2_item(const Args& A, LAS unsigned char* wl, int item, int lane) {
    unsigned char* ws = A.ws;
    const bf16_t* proj = (const bf16_t*)(ws + WS_PROJ);
    const int pb = item & 31, h = (item >> 5) & 15, b = item >> 9, P0 = pb * 64, bh = b * 16 + h;
    const int r8 = lane >> 3, c = lane & 7;
    const float* gq = A.in[3]; const float* gk = A.in[4];
    const int fs = c >> 2, fg = c & 3;
#pragma unroll 1
    for (int which = 0; which < 2; ++which) {
        const float* gv = which ? gk : gq; const float cs = which ? 1.f : (LOG2E * 0.125f);
        float gl[8];
#pragma unroll
        for (int e = 0; e < 8; ++e) gl[e] = gv[8 * c + e] * cs;
        bf16_t* F = (bf16_t*)(ws + (which ? WS_KF : WS_QF));
        u32x4 raws[8];
#pragma unroll
        for (int i = 0; i < 8; ++i) raws[i] = *(const u32x4*)(proj + (size_t)(b * SEQ + P0 + 8 * i + r8) * DPROJ + which * 1024 + h * 64 + 8 * c);
#pragma unroll
        for (int i = 0; i < 8; ++i) { const int row = 8 * i + r8, pos = P0 + row;
            const u32x4 raw = raws[i];
            float v[8] = {bflo(raw.x), bfhi(raw.x), bflo(raw.y), bfhi(raw.y), bflo(raw.z), bfhi(raw.z), bflo(raw.w), bfhi(raw.w)};
            float ss = 0.f;
#pragma unroll
            for (int e = 0; e < 8; ++e) ss += v[e] * v[e];
            ss += __shfl_xor(ss, 1); ss += __shfl_xor(ss, 2); ss += __shfl_xor(ss, 4);
            const float r = 1.0f / sqrtf(ss * (1.f / 64.f) + EPS);
            u32x4 w; w.x = cvt_pk_bf16(v[0] * r * gl[0], v[1] * r * gl[1]); w.y = cvt_pk_bf16(v[2] * r * gl[2], v[3] * r * gl[3]);
            w.z = cvt_pk_bf16(v[4] * r * gl[4], v[5] * r * gl[5]); w.w = cvt_pk_bf16(v[6] * r * gl[6], v[7] * r * gl[7]);
#pragma unroll
            for (int br = 0; br < 3; ++br) { const int sh = 2 * br, rr = pos & ((1 << sh) - 1), l = pos >> sh;
                *(u32x4*)(F + (size_t)br * 4 * 16 * SEQ * 64 + ((((size_t)(bh << sh) + rr) * (SEQ >> (sh + 4)) + (l >> 4)) * 2 + fs) * 512 + (fg * 16 + (l & 15)) * 8) = w; } }
    }
#pragma unroll
    for (int i = 0; i < 8; ++i) { const int row = 8 * i + r8;
        const u32x4 raw = *(const u32x4*)(proj + (size_t)(b * SEQ + P0 + row) * DPROJ + 2048 + h * 64 + 8 * c);
        *(LAS u32x2*)(wl + row * 136 + c * 16) = (u32x2){raw.x, raw.y}; *(LAS u32x2*)(wl + row * 136 + c * 16 + 8) = (u32x2){raw.z, raw.w}; }
    CBAR();
    unsigned v[64];
#pragma unroll
    for (int p = 0; p < 64; ++p) v[p] = *(const LAS unsigned short*)(wl + p * 136 + lane * 2);
    CBAR();
    bf16_t* vt = (bf16_t*)(ws + WS_VT);
    const int nt = lane >> 4, dl = lane & 15;
#pragma unroll
    for (int G = 0; G < 2; ++G) { bf16_t* tp = vt + ((((size_t)bh * 64 + (P0 >> 5) + G) * 4 + nt) * 64 + dl) * 8;
#pragma unroll
        for (int kg = 0; kg < 4; ++kg) { const int a0 = 32 * G + 4 * kg, b0 = 32 * G + 16 + 4 * kg;
            u32x4 w; w.x = v[a0] | (v[a0 + 1] << 16); w.y = v[a0 + 2] | (v[a0 + 3] << 16); w.z = v[b0] | (v[b0 + 1] << 16); w.w = v[b0 + 2] | (v[b0 + 3] << 16);
            *(u32x4*)(tp + kg * 128) = w; } }
    { bf16_t* vt4 = vt + (size_t)4 * 16 * 64 * SEQ; const int l0 = P0 >> 2, tile = (l0 >> 4) & 1, grp = l0 >> 5;
#pragma unroll
        for (int r = 0; r < 4; ++r) { bf16_t* tp = vt4 + (((((size_t)bh * 4 + r) * 16 + grp) * 4 + nt) * 64 + dl) * 8;
#pragma unroll
            for (int kg = 0; kg < 4; ++kg) { const int p0 = 4 * (4 * kg) + r;
                u32x2 w; w.x = v[p0] | (v[p0 + 4] << 16); w.y = v[p0 + 8] | (v[p0 + 12] << 16);
                *(u32x2*)(tp + kg * 128 + 4 * tile) = w; } } }
    { bf16_t* vt16 = vt + (size_t)2 * 4 * 16 * 64 * SEQ; const int l0 = P0 >> 4, w32 = l0 & 31, tile = (w32 >> 4) & 1, kg = (w32 & 15) >> 2, grp = l0 >> 5;
#pragma unroll
        for (int r = 0; r < 16; ++r) { u32x2 w; w.x = v[r] | (v[16 + r] << 16); w.y = v[32 + r] | (v[48 + r] << 16);
            *(u32x2*)(vt16 + (((((size_t)bh * 16 + r) * 4 + grp) * 4 + nt) * 64 + kg * 16 + dl) * 8 + 4 * tile) = w; } }
}

struct AttnItem { int sh, r, lfirst, ks, tbo; size_t qk_off, v_off; };
__device__ __forceinline__ AttnItem attn_item(int it, int p0, int bh) {
    AttnItem I; const int br = it >> 4, j = it & 15; I.sh = 2 * br; I.tbo = br * 192;
    I.r = j & ((1 << I.sh) - 1); I.lfirst = (p0 >> I.sh) + 16 * (j >> I.sh);
    const size_t rc = (size_t)br * 4 * 16 * SEQ * 64 + ((size_t)(bh << I.sh) + I.r) * (size_t)(SEQ >> I.sh) * 64;
    I.qk_off = rc; I.v_off = rc;
    int ks = (I.lfirst - 128) & ~31; I.ks = ks < 0 ? 0 : ks;
    return I;
}
__device__ __forceinline__ void attn_unit(const Args& A, LAS unsigned char* lds, int unit, int tid, int wave, int lane, int pflags) {
    unsigned char* ws = A.ws;
    const int blk = 7 - (unit >> 6), bh = unit & 63, b = bh >> 4, h = bh & 15, p0 = blk * 256;
    constexpr int OST = 68;
    LAS float* Oacc = (LAS float*)lds; LAS float* lacc = (LAS float*)(lds + 256 * OST * 4); LAS float* tb = (LAS float*)(lds + 256 * OST * 4 + 1024);
    { const float* bt = (const float*)(ws + WS_BTAB) + h * 3 * 192; for (int i = tid; i < 3 * 192; i += 512) tb[i] = bt[i]; }
    __syncthreads();
    const bf16_t* QF = (const bf16_t*)(ws + WS_QF); const bf16_t* KF = (const bf16_t*)(ws + WS_KF); const bf16_t* VF = (const bf16_t*)(ws + WS_VT);
    const int qi = lane & 15, g = lane >> 4;
#define ATT_LOAD(IT, LK, B) do { const AttnItem _I = attn_item(IT, p0, bh); const bf16_t* _kp = KF + _I.qk_off + (size_t)((LK) >> 4) * 1024 + lane * 8; \
        B[0] = *(const u32x4*)(_kp); B[1] = *(const u32x4*)(_kp + 512); B[2] = *(const u32x4*)(_kp + 1024); B[3] = *(const u32x4*)(_kp + 1536); \
        const bf16_t* _vp = VF + _I.v_off + (size_t)((LK) >> 5) * 2048 + lane * 8; \
        B[4] = *(const u32x4*)(_vp); B[5] = *(const u32x4*)(_vp + 512); B[6] = *(const u32x4*)(_vp + 1024); B[7] = *(const u32x4*)(_vp + 1536); \
        const bf16_t* _qp = QF + _I.qk_off + (size_t)(_I.lfirst >> 4) * 1024 + lane * 8; B[8] = *(const u32x4*)(_qp); B[9] = *(const u32x4*)(_qp + 512); } while (0)
#define ATT_ADV(IT, LK, NIT, NLK) do { const AttnItem _J = attn_item(IT, p0, bh); if ((LK) + 32 <= _J.lfirst) { (NIT) = (IT); (NLK) = (LK) + 32; } else { (NIT) = (IT) + 8; (NLK) = 0; if ((NIT) < 48) { const AttnItem _N = attn_item(NIT, p0, bh); (NLK) = _N.ks; } } } while (0)
#define ATT_STEP(CIT, CLK, BC, NIT, NLK, NNIT, NNLK, BNN) { \
        NNIT = 64; NNLK = 0; \
        if ((NIT) < 48) { ATT_ADV(NIT, NLK, NNIT, NNLK); if ((NNIT) < 48) ATT_LOAD(NNIT, NNLK, BNN); } \
        const AttnItem cI = attn_item(CIT, p0, bh); \
        f32x4 sa = {0.f, 0.f, 0.f, 0.f}, sb = {0.f, 0.f, 0.f, 0.f}; \
        sa = MFMA16(as_bf16x8(BC[0]), as_bf16x8(BC[8]), sa); sb = MFMA16(as_bf16x8(BC[2]), as_bf16x8(BC[8]), sb); \
        sa = MFMA16(as_bf16x8(BC[1]), as_bf16x8(BC[9]), sa); sb = MFMA16(as_bf16x8(BC[3]), as_bf16x8(BC[9]), sb); \
        const LAS float* tbb = tb + cI.tbo; \
        const int ba = cI.lfirst + qi - (CLK) - 4 * g + 31; \
        float pa[4], pb[4]; \
        _Pragma("unroll") for (int e = 0; e < 4; ++e) { pa[e] = __builtin_amdgcn_exp2f(sa[e] + tbb[ba - e]); pb[e] = __builtin_amdgcn_exp2f(sb[e] + tbb[ba - 16 - e]); } \
        lsum += (pa[0] + pa[1]) + (pa[2] + pa[3]) + (pb[0] + pb[1]) + (pb[2] + pb[3]); \
        u32x4 pw; pw.x = cvt_pk_bf16(pa[0], pa[1]); pw.y = cvt_pk_bf16(pa[2], pa[3]); pw.z = cvt_pk_bf16(pb[0], pb[1]); pw.w = cvt_pk_bf16(pb[2], pb[3]); \
        const bf16x8 pf = as_bf16x8(pw); \
        _Pragma("unroll") for (int nt = 0; nt < 4; ++nt) o[nt] = MFMA16(pf, as_bf16x8(BC[4 + nt]), o[nt]); \
        if ((CLK) + 32 > cI.lfirst) {     \
            lsum += __shfl_xor(lsum, 16); lsum += __shfl_xor(lsum, 32); \
            const bool first = (CIT) < 16; \
            if (g == 0) { LAS float* lp = lacc + ((((cI.lfirst + qi) << cI.sh) + cI.r) - p0); *lp = first ? lsum : *lp + lsum; } \
            _Pragma("unroll") for (int reg = 0; reg < 4; ++reg) { LAS float* op = Oacc + (((((cI.lfirst + 4 * g + reg) << cI.sh) + cI.r) - p0)) * OST + qi; \
                _Pragma("unroll") for (int nt = 0; nt < 4; ++nt) op[16 * nt] = first ? o[nt][reg] : op[16 * nt] + o[nt][reg]; } \
            _Pragma("unroll") for (int nt = 0; nt < 4; ++nt) o[nt] = (f32x4){0.f, 0.f, 0.f, 0.f}; \
            lsum = 0.f; \
            if (((CIT) >> 3) & 1) __syncthreads();     \
        } \
        if ((NIT) >= 48) break; }
    if (!(pflags & 16)) {
    int itA = wave, lkA, itB, lkB, itC = 64, lkC = 0;
    { const AttnItem I0 = attn_item(wave, p0, bh); lkA = I0.ks; }
    ATT_ADV(itA, lkA, itB, lkB);
    u32x4 bA[10], bB[10], bC[10];
    ATT_LOAD(itA, lkA, bA); if (itB < 48) ATT_LOAD(itB, lkB, bB);
    f32x4 o[4];
#pragma unroll
    for (int nt = 0; nt < 4; ++nt) o[nt] = (f32x4){0.f, 0.f, 0.f, 0.f};
    float lsum = 0.f;
    for (;;) {
        ATT_STEP(itA, lkA, bA, itB, lkB, itC, lkC, bC)
        ATT_STEP(itB, lkB, bB, itC, lkC, itA, lkA, bA)
        ATT_STEP(itC, lkC, bC, itA, lkA, itB, lkB, bB)
    }
    }
#undef ATT_LOAD
#undef ATT_ADV
#undef ATT_STEP
    if (!(pflags & (16 | 32 | 64))) { const int ql = tid >> 1, half = tid & 1; const float inv = 1.0f / lacc[ql];
        bf16_t* dst = (bf16_t*)(ws + WS_MIXED) + (size_t)(b * SEQ + p0 + ql) * 2048 + h * 64 + 32 * half;
        float ss = 0.f;
#pragma unroll
        for (int c4 = 0; c4 < 4; ++c4) { float v[8];
#pragma unroll
            for (int e = 0; e < 8; ++e) { v[e] = Oacc[ql * OST + 32 * half + 8 * c4 + e] * inv; ss += v[e] * v[e]; }
            u32x4 w; w.x = cvt_pk_bf16(v[0], v[1]); w.y = cvt_pk_bf16(v[2], v[3]); w.z = cvt_pk_bf16(v[4], v[5]); w.w = cvt_pk_bf16(v[6], v[7]);
            *(u32x4*)(dst + 8 * c4) = w; }
        ss += __shfl_xor(ss, 1);
        if (half == 0) unsafeAtomicAdd((float*)(ws + WS_CTL + CTL_RSS_ATTN) + b * SEQ + p0 + ql, ss); }
    __syncthreads();
}

__device__ __forceinline__ unsigned fkey(float f) { const unsigned u = __float_as_uint(f); return (u & 0x80000000u) ? ~u : (u | 0x80000000u); }
#define DPP_U(x, ctrl) ((unsigned)__builtin_amdgcn_update_dpp((int)(x), (int)(x), ctrl, 0xf, 0xf, false))
__device__ __forceinline__ unsigned row16_umax(unsigned v) { unsigned t;
    t = DPP_U(v, 0xB1); v = t > v ? t : v; t = DPP_U(v, 0x4E); v = t > v ? t : v; t = DPP_U(v, 0x141); v = t > v ? t : v; t = DPP_U(v, 0x140); v = t > v ? t : v; return v; }
__device__ __forceinline__ float row16_fmax(float v) { float t;
    t = __uint_as_float(DPP_U(__float_as_uint(v), 0xB1)); v = fmaxf(v, t); t = __uint_as_float(DPP_U(__float_as_uint(v), 0x4E)); v = fmaxf(v, t);
    t = __uint_as_float(DPP_U(__float_as_uint(v), 0x141)); v = fmaxf(v, t); t = __uint_as_float(DPP_U(__float_as_uint(v), 0x140)); v = fmaxf(v, t); return v; }
__device__ __forceinline__ float row16_fsum(float v) {
    v += __uint_as_float(DPP_U(__float_as_uint(v), 0xB1)); v += __uint_as_float(DPP_U(__float_as_uint(v), 0x4E));
    v += __uint_as_float(DPP_U(__float_as_uint(v), 0x141)); v += __uint_as_float(DPP_U(__float_as_uint(v), 0x140)); return v; }
__device__ __forceinline__ unsigned wave_umax(unsigned v) { v = row16_umax(v);
    const unsigned a = (unsigned)__builtin_amdgcn_readlane((int)v, 0), b = (unsigned)__builtin_amdgcn_readlane((int)v, 16), c = (unsigned)__builtin_amdgcn_readlane((int)v, 32), d = (unsigned)__builtin_amdgcn_readlane((int)v, 48);
    const unsigned ab = a > b ? a : b, cd = c > d ? c : d; return ab > cd ? ab : cd; }
template <int R> __device__ __forceinline__ void select16(const unsigned (&key)[R], unsigned long long (&m)[R]) {
    unsigned mx = key[0];
#pragma unroll
    for (int r = 1; r < R; ++r) mx = key[r] > mx ? key[r] : mx;
    mx = wave_umax(mx);
    unsigned lo = mx > (3u << 23) ? mx - (3u << 23) : 0u, hi = mx + 1u;
    int cnt = 0;
#pragma unroll
    for (int r = 0; r < R; ++r) cnt += __popcll(__ballot(key[r] >= lo));
    if (cnt < 16) { lo = 0u; cnt = R * 64; }
    while (cnt != 16 && hi - lo > 1u) { const unsigned mid = lo + ((hi - lo) >> 1); int c = 0;
#pragma unroll
        for (int r = 0; r < R; ++r) c += __popcll(__ballot(key[r] >= mid));
        if (c >= 16) { lo = mid; cnt = c; } else hi = mid; }
    const unsigned T = lo;
    if (cnt == 16) {
#pragma unroll
        for (int r = 0; r < R; ++r) m[r] = __ballot(key[r] >= T);
    } else {
        int need = 16;
#pragma unroll
        for (int r = 0; r < R; ++r) { m[r] = __ballot(key[r] > T); need -= __popcll(m[r]); }
#pragma unroll
        for (int r = 0; r < R; ++r) { unsigned long long eq = __ballot(key[r] == T);
            while (__popcll(eq) > need) eq &= ~(1ull << (63 - __builtin_clzll(eq)));
            need -= __popcll(eq); m[r] |= eq; }
    }
}
__device__ __forceinline__ void peer_topk(const float (&sv4)[4], LAS float* sc, LAS int* exo, LAS float* gto, int lane) {
    LAS float* v1 = sc; LAS int* i1 = (LAS int*)(sc + 16); LAS float* v2 = sc + 32; LAS int* i2 = (LAS int*)(sc + 48); LAS float* sv = sc + 64; LAS int* si = (LAS int*)(sc + 80);
    const unsigned long long lt = (1ull << lane) - 1ull;
#pragma unroll
    for (int half = 0; half < 2; ++half) {
        const float a0 = sv4[2 * half], a1 = sv4[2 * half + 1];
        const unsigned key[2] = {fkey(a0), fkey(a1)}; unsigned long long m[2];
        select16<2>(key, m);
        LAS float* vv = half ? v2 : v1; LAS int* ii = half ? i2 : i1;
        if ((m[0] >> lane) & 1ull) { const int pos = __popcll(m[0] & lt); vv[pos] = a0; ii[pos] = lane; }
        if ((m[1] >> lane) & 1ull) { const int pos = __popcll(m[0]) + __popcll(m[1] & lt); vv[pos] = a1; ii[pos] = 64 + lane; }
    }
    CBAR(); LDS_WAIT();
    const int a = lane >> 2, bb = (lane & 3) * 4;
    const float va = v1[a]; float cv[4]; unsigned key[4]; unsigned long long m[4];
#pragma unroll
    for (int e = 0; e < 4; ++e) { cv[e] = va + v2[bb + e]; key[e] = fkey(cv[e]); }
    select16<4>(key, m);
    int base = 0;
#pragma unroll
    for (int e = 0; e < 4; ++e) { if ((m[e] >> lane) & 1ull) { const int pos = base + __popcll(m[e] & lt); sv[pos] = cv[e]; si[pos] = a * 16 + bb + e; } base += __popcll(m[e]); }
    CBAR(); LDS_WAIT();
    if (lane < 16) {
        const float val = sv[lane]; const int fi = si[lane];
        const float mx = row16_fmax(val);
        const float ex = __expf(val - mx); const float sum = row16_fsum(ex);
        exo[lane] = i1[fi >> 4] * 128 + (i2[fi & 15] - 0);
        gto[lane] = ex / sum;
    }
    CBAR(); LDS_WAIT();
}

template <int I> __device__ __forceinline__ float ubyte_f32(unsigned w) { float f;
    if (I == 0) asm("v_cvt_f32_ubyte0 %0, %1" : "=v"(f) : "v"(w)); else if (I == 1) asm("v_cvt_f32_ubyte1 %0, %1" : "=v"(f) : "v"(w));
    else if (I == 2) asm("v_cvt_f32_ubyte2 %0, %1" : "=v"(f) : "v"(w)); else asm("v_cvt_f32_ubyte3 %0, %1" : "=v"(f) : "v"(w));
    return f; }
__device__ __forceinline__ void peer_wave(const Args& A, LAS unsigned char* lds, int wave, int lane, int pflags) {
    unsigned char* ws = A.ws;
    const float* scores = (const float*)(ws + WS_PROJ);
    const unsigned char* uv = ws + WS_UB; const bf16_t* x1b = (const bf16_t*)(ws + WS_HB);
    const float* su = (const float*)(ws + WS_SU); const float* sv = (const float*)(ws + WS_SV);
    const float* rssx = (const float*)(ws + WS_CTL + CTL_RSS_X1);
    LAS int* exl = (LAS int*)(lds + wave * 4096);
    LAS float* gtl = (LAS float*)(lds + wave * 4096 + 2048);
    LAS float* sc = (LAS float*)(lds + 32768 + wave * 512);
    LAS float* cul = (LAS float*)(lds + 40960 + wave * 1024);
    const int t0 = (blockIdx.x * 8 + wave) * 4;
    if (t0 >= NTOK) return;
#define LOAD_SCORES_L(dst, t, h, ln) do { const float* _sp = scores + (size_t)(t) * 2048 + (h) * 256 + (ln); dst[0] = _sp[0]; dst[1] = _sp[64]; dst[2] = _sp[128]; dst[3] = _sp[192]; } while (0)
#define LOAD_SCORES(dst, t, h) LOAD_SCORES_L(dst, t, h, lane)
    { float nx[4]; LOAD_SCORES(nx, t0, 0);
#pragma unroll 1
        for (int h = 0; h < 8; ++h) { const float cs[4] = {nx[0], nx[1], nx[2], nx[3]};
            if (h < 7) LOAD_SCORES(nx, t0, h + 1);
            peer_topk(cs, sc, exl + h * 16, gtl + h * 16, lane); } }
    CBAR(); LDS_WAIT();
    if (pflags & 256) return;
    int ex0 = exl[lane], ex1 = exl[64 + lane];
    float rss = rssx[t0], su0 = su[ex0], su1 = su[ex1], sv0 = sv[ex0], sv1 = sv[ex1];
    float sn[4] = {0.f, 0.f, 0.f, 0.f};
    LOAD_SCORES(sn, t0 + 1, 0);
    u32x4 bu[8], bv[8];
    LAS u32x4* vls = (LAS u32x4*)(lds + 49152 + wave * 8192);
#define ISSUE_E(slot, e0r, e1r, k) do { const int _e = __builtin_amdgcn_readlane((k) < 64 ? (e0r) : (e1r), (k) & 63); \
        const unsigned char* _p = uv + (size_t)_e * 2048 + 16 * lane; bu[slot] = *(const u32x4*)_p; bv[slot] = *(const u32x4*)(_p + 1024); } while (0)
#pragma unroll
    for (int i = 0; i < 8; ++i) ISSUE_E(i, ex0, ex1, i);
    float acc[32];
#pragma unroll 1
    for (int tok = 0; tok < 4; ++tok) {
        const int t = t0 + tok;
        int lz = lane; asm volatile("" : "+v"(lz));
        unsigned xq[8]; float sx; int xsum;
        { u32x4 xr4[4];
#pragma unroll
            for (int v4 = 0; v4 < 4; ++v4) xr4[v4] = *(const u32x4*)(x1b + (size_t)t * 2048 + 16 * lz + 1024 * (v4 >> 1) + 8 * (v4 & 1));
            float m = 0.f;
#pragma unroll
            for (int v4 = 0; v4 < 4; ++v4) { const unsigned rw[4] = {xr4[v4].x, xr4[v4].y, xr4[v4].z, xr4[v4].w};
#pragma unroll
                for (int e = 0; e < 4; ++e) m = fmaxf(m, fmaxf(fabsf(bflo(rw[e])), fabsf(bfhi(rw[e])))); }
            m = fmaxf(wave_max(m), 1e-30f);
            const float inv = 127.f / m; sx = m * (1.f / 127.f);
            int ls = 0;
#pragma unroll
            for (int v4 = 0; v4 < 4; ++v4) { const unsigned rw[4] = {xr4[v4].x, xr4[v4].y, xr4[v4].z, xr4[v4].w};
#pragma unroll
                for (int h2 = 0; h2 < 2; ++h2) { const int a = (int)rintf(bflo(rw[2 * h2]) * inv), b = (int)rintf(bfhi(rw[2 * h2]) * inv), c = (int)rintf(bflo(rw[2 * h2 + 1]) * inv), e = (int)rintf(bfhi(rw[2 * h2 + 1]) * inv);
                    ls += (a + b) + (c + e);
                    xq[2 * v4 + h2] = (unsigned)(a & 255) | ((unsigned)(b & 255) << 8) | ((unsigned)(c & 255) << 16) | ((unsigned)(e & 255) << 24); } }
#pragma unroll
            for (int o = 1; o < 64; o <<= 1) ls += __shfl_xor(ls, o);
            xsum = ls;
            asm volatile("" ::: "memory");
#pragma unroll
            for (int v4 = 0; v4 < 4; ++v4) { const unsigned rw[4] = {xr4[v4].x, xr4[v4].y, xr4[v4].z, xr4[v4].w};
#pragma unroll
                for (int e = 0; e < 4; ++e) { acc[8 * v4 + 2 * e] = bflo(rw[e]); acc[8 * v4 + 2 * e + 1] = bfhi(rw[e]); } } }
        const float ascale = sx / sqrtf(rss * (1.f / 2048.f) + EPS);
        cul[lz] = ascale * su0; cul[64 + lz] = ascale * su1;
        cul[128 + lz] = 2.f * gtl[tok * 128 + lz] * sv0; cul[192 + lz] = 2.f * gtl[tok * 128 + 64 + lz] * sv1;
        CBAR(); LDS_WAIT();
        float wsum = 0.f;
        int nex0 = ex0, nex1 = ex1; float nrss = 1.f, nsu0 = 0.f, nsu1 = 0.f, nsv0 = 0.f, nsv1 = 0.f;
#pragma unroll 1
        for (int k0 = 0; k0 < 128; k0 += 8) {
            if (tok < 3 && k0 == 120) {
                nex0 = exl[(tok + 1) * 128 + lz]; nex1 = exl[(tok + 1) * 128 + 64 + lz];
                nrss = rssx[t + 1]; nsu0 = su[nex0]; nsu1 = su[nex1]; nsv0 = sv[nex0]; nsv1 = sv[nex1];
                if (tok < 2) LOAD_SCORES_L(sn, t + 2, 0, lz); }
            int p[8];
#pragma unroll
            for (int i = 0; i < 8; ++i) { int ac = 0;
                const unsigned w4[4] = {bu[i].x, bu[i].y, bu[i].z, bu[i].w};
#pragma unroll
                for (int e = 0; e < 4; ++e) { ac = __builtin_amdgcn_sdot4((int)(w4[e] & 0x0F0F0F0Fu), (int)xq[e], ac, false); ac = __builtin_amdgcn_sdot4((int)((w4[e] >> 4) & 0x0F0F0F0Fu), (int)xq[4 + e], ac, false); }
                p[i] = ac; vls[i * 64 + lane] = bv[i]; }
            { const bool nxt = (k0 + 8) >= 128;
              const int kb = (k0 + 8) & 127; const int sel = nxt ? (kb < 64 ? nex0 : nex1) : (kb < 64 ? ex0 : ex1);
#pragma unroll
              for (int i = 0; i < 8; ++i) { const int _e = __builtin_amdgcn_readlane(sel, (kb & 63) + i);
                  const unsigned char* _p = uv + (size_t)_e * 2048 + 16 * lane; bu[i] = *(const u32x4*)_p; bv[i] = *(const u32x4*)(_p + 1024); } }
            float wcur;
            { const bool b0 = lane & 1, b1 = lane & 2, b2 = lane & 4;
            int q4[4], q2[2], q1;
#pragma unroll
            for (int i = 0; i < 4; ++i) { const int keep = b0 ? p[i + 4] : p[i], send = b0 ? p[i] : p[i + 4]; q4[i] = keep + __shfl_xor(send, 1); }
#pragma unroll
            for (int i = 0; i < 2; ++i) { const int keep = b1 ? q4[i + 2] : q4[i], send = b1 ? q4[i] : q4[i + 2]; q2[i] = keep + __shfl_xor(send, 2); }
            { const int keep = b2 ? q2[1] : q2[0], send = b2 ? q2[0] : q2[1]; q1 = keep + __shfl_xor(send, 4); }
            q1 += __shfl_xor(q1, 8); q1 += __shfl_xor(q1, 16); q1 += __shfl_xor(q1, 32);
            const int k = (k0 + 4 * (lane & 1) + 2 * ((lane >> 1) & 1) + ((lane >> 2) & 1)) & 127;
            const float a = (float)(2 * q1 - 15 * xsum) * cul[k];
            wcur = cul[128 + k] * gelu_as(a); }
            CBAR();
#pragma unroll 1
            for (int i = 0; i < 8; ++i) { const int rl = ((i & 1) << 2) | (i & 2) | ((i >> 2) & 1);
                const float w = __builtin_bit_cast(float, __builtin_amdgcn_readlane(__builtin_bit_cast(int, wcur), rl));
                wsum += w;
                const u32x4 vv = vls[i * 64 + lane];
                const unsigned w4[4] = {vv.x, vv.y, vv.z, vv.w};
                const float w16 = w * 0.0625f;
#pragma unroll
                for (int e = 0; e < 4; ++e) { const unsigned lo = w4[e] & 0x0F0F0F0Fu, hi = w4[e] & 0xF0F0F0F0u;
                    acc[4 * e + 0] += w * ubyte_f32<0>(lo); acc[4 * e + 1] += w * ubyte_f32<1>(lo); acc[4 * e + 2] += w * ubyte_f32<2>(lo); acc[4 * e + 3] += w * ubyte_f32<3>(lo);
                    acc[16 + 4 * e + 0] += w16 * ubyte_f32<0>(hi); acc[16 + 4 * e + 1] += w16 * ubyte_f32<1>(hi); acc[16 + 4 * e + 2] += w16 * ubyte_f32<2>(hi); acc[16 + 4 * e + 3] += w16 * ubyte_f32<3>(hi); } }
            CBAR();
            if (tok < 3 && !(k0 & 8)) { const int hh = k0 >> 4;
                const float cs[4] = {sn[0], sn[1], sn[2], sn[3]};
                if (hh < 7) LOAD_SCORES_L(sn, t + 1, hh + 1, lz);
                peer_topk(cs, sc, exl + (tok + 1) * 128 + hh * 16, gtl + (tok + 1) * 128 + hh * 16, lane); }
        }
        const float corr = -7.5f * wsum;
        float* op = A.out + (size_t)t * 2048 + 16 * lz;
        if (!(pflags & 128)) {
#pragma unroll
        for (int j = 0; j < 2; ++j)
#pragma unroll
            for (int c4 = 0; c4 < 4; ++c4) { const int a0 = 16 * j + 4 * c4;
                *(f32x4*)(op + 1024 * j + 4 * c4) = (f32x4){acc[a0] + corr, acc[a0 + 1] + corr, acc[a0 + 2] + corr, acc[a0 + 3] + corr}; }
        } else if (corr == 12345.678f) op[0] = acc[0];
        ex0 = nex0; ex1 = nex1; rss = nrss; su0 = nsu0; su1 = nsu1; sv0 = nsv0; sv1 = nsv1;
    }
#undef ISSUE_E
#undef LOAD_SCORES
#undef LOAD_SCORES_L
}

__global__ void __launch_bounds__(512, 2) mk_fwd(Args args) {
    extern __shared__ __attribute__((aligned(16))) unsigned char lds_raw[];
    LAS unsigned char* lds = (LAS unsigned char*)lds_raw;
    const int tid = threadIdx.x, lane = tid & 63, wave = __builtin_amdgcn_readfirstlane(tid >> 6);
    volatile LAS unsigned* MISC = (volatile LAS unsigned*)(lds + MISC_OFF);
    if (tid < 64) MISC[tid] = 0u;
    __syncthreads();
    unsigned char* ws = args.ws;
    const int lo = args.ph_lo, hi = args.ph_hi & 0xff, pflags = args.ph_hi >> 8;
    XcdBarrier bar; bar.bar = (unsigned*)(ws + WS_CTL); bar.x = 0; bar.st = nullptr;
    if (hi - lo > 1) bar = xcd_barrier_post((unsigned*)(ws + WS_CTL), MISC + 8);
#ifndef PH_MASK
#define PH_MASK 0x7f
#endif
#define IN(k) (((PH_MASK >> (k)) & 1) && lo <= (k) && (k) < hi)
#define SEAM(k) do { if (IN(k) && IN((k) + 1)) xcd_barrier(bar); } while (0)

    if (IN(0)) { p0_prologue(args, lds, wave, lane, pflags); }
    SEAM(0);
    if (IN(1)) {
        pg8::Gemm g{(const bf16_t*)(ws + WS_HB), (const bf16_t*)(ws + WS_WINT), NTOK, DPROJ, DM}; pg8::StaticOrder S; S.init(NTOK, DPROJ, gridDim.x, (int)blockIdx.x);
        pg8::EpiProj E{(bf16_t*)(ws + WS_PROJ), DPROJ};
        pg8::gemm_phase<pg8::EpiProj, pg8::StaticOrder, false>(lds, g, S, E, nullptr);
    }
    SEAM(1);
    if (IN(2)) {
        if (!(pflags & 4)) for (int u = blockIdx.x; u < 256; u += gridDim.x) ssm_unit(args, lds, u >> 6, u & 63, wave, lane);
        if (!(pflags & 8)) for (int it = blockIdx.x * 8 + wave; it < 2048; it += gridDim.x * 8) prep2_item(args, lds + wave * SSM_WL, it, lane);
    }
    SEAM(2);
    if (IN(3)) {
        if (!(pflags & 2)) {
            pg8::Gemm g{(const bf16_t*)(ws + WS_YB), (const bf16_t*)(ws + WS_GLUT), NTOK, 1024, 1024}; pg8::StaticOrder S; S.init(NTOK, 1024, gridDim.x, (int)blockIdx.x);
            pg8::EpiGlu E{(const bf16_t*)(ws + WS_YB), (bf16_t*)(ws + WS_MIXED) + 1024, args.in[15], (float*)(ws + WS_CTL + CTL_RSS_SSM)};
            pg8::gemm_phase<pg8::EpiGlu, pg8::StaticOrder, false>(lds, g, S, E, nullptr);
        }
        __syncthreads();
        if (!(pflags & 1)) for (;;) {
            if (tid == 0) MISC[0] = atomicAdd((unsigned*)(ws + WS_CTL + CTL_QCTR), 1u);
            __syncthreads();
            const unsigned u = MISC[0];
            __syncthreads();
            if (u >= 512u) break;
            attn_unit(args, lds, (int)u, tid, wave, lane, pflags);
        }
    }
    SEAM(3);
    if (IN(4)) {
        pg8::Gemm g{(const bf16_t*)(ws + WS_MIXED), (const bf16_t*)(ws + WS_WOUTT), NTOK, DM, DM}; pg8::StaticOrder S; S.init(NTOK, DM, gridDim.x, (int)blockIdx.x);
        LAS float* tab = (LAS float*)(lds + 131072);
        { pg8::Unit u0; if (S.next(0, u0) && tid < 256) { const int row = u0.pm * 256 + tid;
            const float ra = 1.0f / sqrtf(((const float*)(ws + WS_CTL + CTL_RSS_ATTN))[row] * (1.f / 1024.f) + EPS), rs = 1.0f / sqrtf(((const float*)(ws + WS_CTL + CTL_RSS_SSM))[row] * (1.f / 1024.f) + EPS);
            tab[tid] = ra / rs; tab[256 + tid] = rs; } }
        __syncthreads();
        pg8::EpiWout E{args.in[0], args.out, (bf16_t*)(ws + WS_HB), (float*)(ws + WS_CTL + CTL_RSS_X1), tab};
        pg8::gemm_phase<pg8::EpiWout, pg8::StaticOrder, false>(lds, g, S, E, nullptr);
    }
    SEAM(4);
    if (IN(5)) {
        pg8::Gemm g{(const bf16_t*)(ws + WS_HB), (const bf16_t*)(ws + WS_WPT), NTOK, DM, DM}; pg8::StaticOrder S; S.init(NTOK, DM, gridDim.x, (int)blockIdx.x);
        pg8::EpiScores E{(float*)(ws + WS_PROJ), (const float*)(ws + WS_CTL + CTL_RSS_X1)};
        pg8::gemm_phase<pg8::EpiScores, pg8::StaticOrder, false>(lds, g, S, E, nullptr);
    }
    SEAM(5);
    if (IN(6)) { peer_wave(args, lds, wave, lane, pflags); }
#undef IN
#undef SEAM
}

#ifndef MK_DEBUG
#ifndef MK_PER_PHASE
#define MK_PER_PHASE 0
#endif
extern "C" void kernel_launch(void* const* d_in, const int* in_sizes, int n_in, void* d_out, int out_size, void* d_ws, size_t ws_size, hipStream_t stream) {
    static int grid = 0;
    if (grid == 0) {
        if (n_in != 25 || out_size != NTOK * DM || ws_size < WS_END) { fprintf(stderr, "kernel_launch: unexpected shapes / workspace (%d inputs, out %d, ws %zu < %zu)\n", n_in, out_size, ws_size, (size_t)WS_END); grid = -1; return; }
        int dev = 0, cus = 0, per_cu = 0;
        if (hipGetDevice(&dev) != hipSuccess || hipDeviceGetAttribute(&cus, hipDeviceAttributeMultiprocessorCount, dev) != hipSuccess) { grid = -1; return; }
        if (hipFuncSetAttribute((const void*)mk_fwd, hipFuncAttributeMaxDynamicSharedMemorySize, LDS_BYTES) != hipSuccess) { fprintf(stderr, "kernel_launch: hipFuncSetAttribute failed\n"); grid = -1; return; }
        if (hipOccupancyMaxActiveBlocksPerMultiprocessor(&per_cu, (const void*)mk_fwd, 512, LDS_BYTES) != hipSuccess || per_cu < 1) { fprintf(stderr, "kernel_launch: occupancy query reports %d\n", per_cu); }
        (void)hipGetLastError();
        grid = cus;
    }
    if (grid < 0) return;
    (void)hipMemsetAsync((char*)d_ws + WS_CTL, 0, CTL_BYTES, stream);
    Args a{};
    for (int i = 0; i < 25; ++i) a.in[i] = (const float*)d_in[i];
    a.out = (float*)d_out; a.ws = (unsigned char*)d_ws;
#if MK_PER_PHASE
#ifndef MK_DUP
#define MK_DUP -1
#endif
    for (int p = 0; p < 7; ++p) { a.ph_lo = p; a.ph_hi = p + 1; hipLaunchKernelGGL(mk_fwd, dim3(grid), dim3(512), LDS_BYTES, stream, a);
        if (p == MK_DUP) {
            (void)hipMemsetAsync((char*)d_ws + WS_CTL + CTL_QCTR, 0, 256, stream);
#ifndef MK_DUP_FLAGS
#define MK_DUP_FLAGS 0
#endif
            if (p == 3 && !((MK_DUP_FLAGS) & (1 | 16 | 32 | 64))) (void)hipMemsetAsync((char*)d_ws + WS_CTL + CTL_RSS_ATTN, 0, 32768, stream);
            if (p == 3 && !((MK_DUP_FLAGS) & 2)) (void)hipMemsetAsync((char*)d_ws + WS_CTL + CTL_RSS_SSM, 0, 32768, stream);
            if (p == 4) (void)hipMemsetAsync((char*)d_ws + WS_CTL + CTL_RSS_X1, 0, 32768, stream);
            a.ph_hi |= (MK_DUP_FLAGS) << 8;
            hipLaunchKernelGGL(mk_fwd, dim3(grid), dim3(512), LDS_BYTES, stream, a); } }
#else
    a.ph_lo = 0; a.ph_hi = 7;
    hipLaunchKernelGGL(mk_fwd, dim3(grid), dim3(512), LDS_BYTES, stream, a);
#endif
}
#endif
```

```cpp
#include <hip/hip_runtime.h>
#include <stdint.h>
#include <stdio.h>

typedef unsigned short bf16_t;
typedef float f32x2 __attribute__((ext_vector_type(2)));
typedef unsigned u32x2 __attribute__((ext_vector_type(2)));
using bf16x2v = __attribute__((ext_vector_type(2))) __bf16;

constexpr int NTOK = 8192, SEQ = 2048, DM = 2048, DPROJ = 4096;
constexpr float EPS = 1e-6f;
constexpr float LOG2E = 1.4426950408889634f;

constexpr size_t MB = 1024 * 1024;
constexpr size_t WS_CTL = 0;
constexpr size_t CTL_BYTES = 128 * 1024;
constexpr size_t CTL_QCTR = 16384;
constexpr size_t CTL_QCTR2 = 16384 + 256;
constexpr size_t CTL_RSS_ATTN = 32768, CTL_RSS_SSM = 65536, CTL_RSS_X1 = 98304;
constexpr size_t WS_HB = 256 * 1024;
constexpr size_t WS_WINT = WS_HB + 32 * MB;
constexpr size_t WS_GLUT = WS_WINT + 16 * MB;
constexpr size_t WS_WOUTT = WS_GLUT + 2 * MB;
constexpr size_t WS_WPT = WS_WOUTT + 8 * MB;
constexpr size_t WS_UB = WS_WPT + 8 * MB;
constexpr size_t WS_VB = WS_UB + 32 * MB;
constexpr size_t WS_SU = WS_VB + 32 * MB;
constexpr size_t WS_SV = WS_SU + 65536;
constexpr size_t WS_PROJ = WS_SV + 65536;
constexpr size_t WS_QF = WS_PROJ + 64 * MB;
constexpr size_t WS_KF = WS_QF + 48 * MB;
constexpr size_t WS_VT = WS_KF + 48 * MB;
constexpr size_t WS_QN = WS_QF, WS_KN = WS_KF;
constexpr size_t WS_YB = WS_VT + 48 * MB + 4096;
constexpr size_t WS_MIXED = WS_YB + 16 * MB;
constexpr size_t WS_SSMP = WS_MIXED + 32 * MB;
constexpr size_t SSMP_ABAR = 0, SSMP_A256 = 32768, SSMP_BFRAG = 65536, SSMP_CFRAG = 65536 + 524288;
constexpr size_t SSMP_BBT = 1 * MB;
constexpr size_t SSMP_VAND = 2 * MB;
constexpr size_t WS_BTAB = WS_SSMP + 8 * MB;
constexpr size_t WS_END = WS_BTAB + 64 * 1024;

constexpr int LDS_BYTES = 147456;
constexpr int MISC_OFF = 147456 - 256;
#define XB_TMO      128
#define XB_XCNT(j)  (256  + 64 * (j))
#define XB_XSUB(j)  (1280 + 64 * (j))
#define XB_XGEN(j)  (2304 + 64 * (j))
#define XB_TOP      3328
#define XB_TOPGEN   3392
#define XCD_BAR_WORDS 3456
#define XB_SPIN_CAP (1u << 18)
#define LAS __attribute__((address_space(3)))

__device__ __forceinline__ unsigned xb_ld(unsigned* p)              { return __hip_atomic_load(p, __ATOMIC_RELAXED, __HIP_MEMORY_SCOPE_AGENT); }
__device__ __forceinline__ unsigned xb_add(unsigned* p, unsigned v) { return __hip_atomic_fetch_add(p, v, __ATOMIC_RELAXED, __HIP_MEMORY_SCOPE_AGENT); }
__device__ __forceinline__ unsigned xb_xcc_id() { return (unsigned)__builtin_amdgcn_s_getreg((3 << 11) | 20) & 0xFu; }
#define XB_SPIN(cond, bar) do { unsigned _sp = 0; while (cond) { __builtin_amdgcn_s_sleep(1); \
    if ((++_sp & 255u) == 0u) { if (xb_ld(&(bar)[XB_TMO])) break; if (_sp > XB_SPIN_CAP) { atomicAdd(&(bar)[XB_TMO], 1u); break; } } } } while (0)

struct XcdBarrier {
    unsigned* bar; unsigned x;
    volatile LAS unsigned* st;
};

__device__ __forceinline__ XcdBarrier xcd_barrier_post(unsigned* bar, volatile LAS unsigned* st) {
    XcdBarrier b; b.bar = bar; b.x = xb_xcc_id(); b.st = st;
    if (threadIdx.x == 0) (void)xb_add(&bar[XB_XCNT(b.x)], 1u);
    return b;
}
__device__ __forceinline__ void xcd_barrier_complete(unsigned* bar, unsigned x, unsigned& nloc, unsigned& nx) {
    const unsigned G = gridDim.x * gridDim.y * gridDim.z;
    unsigned sum, cnt, mine, sp = 0u;
    for (;;) {
        sum = 0u; cnt = 0u; mine = 0u;
#pragma unroll
        for (unsigned j = 0; j < 16; ++j) { const unsigned c = xb_ld(&bar[XB_XCNT(j)]); sum += c; cnt += (c > 0u) ? 1u : 0u; mine = (j == x) ? c : mine; }
        if (sum == G) break;
        __builtin_amdgcn_s_sleep(1);
        if ((++sp & 255u) == 0u) { if (xb_ld(&bar[XB_TMO])) break; if (sp > XB_SPIN_CAP) { atomicAdd(&bar[XB_TMO], 1u); break; } }
    }
    nloc = mine > 0u ? mine : 1u; nx = cnt > 0u ? cnt : 1u;
}

__device__ __forceinline__ void xcd_barrier(const XcdBarrier& b) {
    asm volatile("s_waitcnt vmcnt(0)" ::: "memory");
    __syncthreads();
    if (threadIdx.x == 0) {
        unsigned* bar = b.bar;
        __builtin_amdgcn_s_waitcnt(0);
        unsigned nloc = b.st[0], nx = b.st[1];
        if (nloc == 0u) { xcd_barrier_complete(bar, b.x, nloc, nx); b.st[0] = nloc; b.st[1] = nx; }
        const unsigned old = xb_add(&bar[XB_XSUB(b.x)], 1u);
        const unsigned gen = old / nloc;
        if (old + 1u == (gen + 1u) * nloc) {
            __builtin_amdgcn_fence(__ATOMIC_RELEASE, "agent");
            asm volatile("s_waitcnt vmcnt(0)" ::: "memory");
            const unsigned og = xb_add(&bar[XB_TOP], 1u);
            const unsigned tg = og / nx;
            if (og + 1u == (tg + 1u) * nx) xb_add(&bar[XB_TOPGEN], 1u);
            else XB_SPIN(xb_ld(&bar[XB_TOPGEN]) == tg, bar);
            __builtin_amdgcn_fence(__ATOMIC_ACQUIRE, "agent");
            xb_add(&bar[XB_XGEN(b.x)], 1u);
            asm volatile("s_waitcnt vmcnt(0)" ::: "memory");
        } else {
            XB_SPIN(xb_ld(&bar[XB_XGEN(b.x)]) == gen, bar);
            __builtin_amdgcn_fence(__ATOMIC_ACQUIRE, "agent");
            asm volatile("s_waitcnt vmcnt(0)" ::: "memory");
        }
    }
    __syncthreads();
}
namespace pg8 {
#define PG8_LAS __attribute__((address_space(3)))
typedef unsigned short bf16_t;
typedef short bf16x8 __attribute__((ext_vector_type(8)));
typedef float f32x4 __attribute__((ext_vector_type(4)));
typedef unsigned u32x4 __attribute__((ext_vector_type(4)));
constexpr int BM = 256, BK = 64, HALF = 128, HTB = HALF * BK * 2  , STAGE_BYTES = 8 * HTB, NXCD = 8, WGM = 8;

__host__ __device__ __forceinline__ int lds_byte(int r, int c) { const int st = (r >> 4) * 2 + (c >> 5), rr = r & 15, cc = c & 31, ob = rr * 64 + cc * 2; return st * 1024 + (ob ^ (((ob >> 9) & 1) << 5)); }
__host__ __device__ __forceinline__ void stage_rc(int b, int& R, int& C) { const int st = b / 1024, sb = b % 1024, swz = sb ^ (((sb >> 9) & 1) << 5); R = (st >> 1) * 16 + swz / 64; C = (st & 1) * 32 + (swz % 64) / 2; }
__host__ __device__ __forceinline__ int perm32(int rho) { const int n = rho >> 4, i = rho & 15; return 8 * (i >> 2) + 4 * n + (i & 3); }

struct Unit { int pm, pn; };
struct Gemm { const bf16_t* A; const bf16_t* Bt; int M, N, K; };

struct StaticOrder {
    int nM, nN, nwg, G, c;
    __host__ __device__ void init(int M, int N, int G_, int c_) { nM = M / BM; nN = N / BM; nwg = nM * nN; G = G_; c = c_; }
    __host__ __device__ bool next(int i, Unit& u) const {
        const long L = (long)i * G + c; if (L >= nwg) return false;
        int wgid = (int)L; { const int q = nwg / NXCD, r = nwg % NXCD, xcd = wgid % NXCD, off = wgid / NXCD; wgid = (xcd < r ? xcd * (q + 1) : r * (q + 1) + (xcd - r) * q) + off; }
        const int nig = WGM * nN, gid = wgid / nig, fm = gid * WGM, gsz = (nM - fm) < WGM ? (nM - fm) : WGM;
        u.pm = fm + ((wgid % nig) % gsz); u.pn = (wgid % nig) / gsz; return true;
    }
    __device__ __forceinline__ void a_ready(const Unit&) const {}
    __device__ __forceinline__ void done(const Unit&) const {}
};
typedef float cvt_f32x2 __attribute__((ext_vector_type(2)));
typedef __bf16 cvt_bf16x2 __attribute__((ext_vector_type(2)));
__device__ __forceinline__ unsigned cvt_pk_bf16(float lo, float hi) { return __builtin_bit_cast(unsigned, __builtin_convertvector((cvt_f32x2){lo, hi}, cvt_bf16x2)); }
__device__ __forceinline__ float bflo(unsigned u) { return __uint_as_float(u << 16); }
__device__ __forceinline__ float bfhi(unsigned u) { return __uint_as_float(u & 0xffff0000u); }

struct EpiProj {
    static constexpr bool PERM = true, AFTER_DRAIN = false, HAS_MID = false;
    bf16_t* O; int ldc;
    __device__ __forceinline__ void mid(f32x4 (&)[2][2][4][2], const Unit&, int, int, int, int) const {}
    __device__ __forceinline__ void operator()(const f32x4 (&acc)[2][2][4][2], const Unit& u, int wr, int wc, int fr, int fq) const {
        const int row0 = u.pm * BM + wr * 64 + fr, col0 = u.pn * BM + wc * 32 + 8 * fq;
#pragma unroll
        for (int ai = 0; ai < 2; ++ai)
#pragma unroll
            for (int m = 0; m < 4; ++m) { bf16_t* rowp = O + (size_t)(row0 + ai * HALF + m * 16) * ldc + col0;
#pragma unroll
                for (int bj = 0; bj < 2; ++bj) { const f32x4 v0 = acc[ai][bj][m][0], v1 = acc[ai][bj][m][1];
                    u32x4 w; w.x = cvt_pk_bf16(v0[0], v0[1]); w.y = cvt_pk_bf16(v0[2], v0[3]); w.z = cvt_pk_bf16(v1[0], v1[1]); w.w = cvt_pk_bf16(v1[2], v1[3]);
                    *(u32x4*)(rowp + bj * HALF) = w; } }
    }
};

struct EpiGlu {
    static constexpr bool PERM = true, AFTER_DRAIN = false, HAS_MID = false;
    const bf16_t* Y; bf16_t* O; const float* bias; float* rss;
    __device__ __forceinline__ void mid(f32x4 (&)[2][2][4][2], const Unit&, int, int, int, int) const {}
    __device__ __forceinline__ void operator()(const f32x4 (&acc)[2][2][4][2], const Unit& u, int wr, int wc, int fr, int fq) const {
        const int row0 = u.pm * BM + wr * 64 + fr, col0 = u.pn * BM + wc * 32 + 8 * fq;
        f32x4 bv[2][2];
#pragma unroll
        for (int bj = 0; bj < 2; ++bj)
#pragma unroll
            for (int n = 0; n < 2; ++n) bv[bj][n] = *(const f32x4*)(bias + col0 + bj * HALF + 4 * n);
        u32x4 yq[2][2];
#pragma unroll
        for (int bj = 0; bj < 2; ++bj) yq[0][bj] = *(const u32x4*)(Y + (size_t)row0 * 1024 + col0 + bj * HALF);
#pragma unroll
        for (int idx = 0; idx < 8; ++idx) { const int ai = idx >> 2, m = idx & 3, row = row0 + ai * HALF + m * 16; float ss = 0.f;
            if (idx < 7) { const int nrow = row0 + ((idx + 1) >> 2) * HALF + ((idx + 1) & 3) * 16;
#pragma unroll
                for (int bj = 0; bj < 2; ++bj) yq[(idx + 1) & 1][bj] = *(const u32x4*)(Y + (size_t)nrow * 1024 + col0 + bj * HALF); }
#pragma unroll
            for (int bj = 0; bj < 2; ++bj) {
                const u32x4 yv = yq[idx & 1][bj];
                const f32x4 g0 = acc[ai][bj][m][0] + bv[bj][0], g1 = acc[ai][bj][m][1] + bv[bj][1];
                float y[8] = {bflo(yv.x), bfhi(yv.x), bflo(yv.y), bfhi(yv.y), bflo(yv.z), bfhi(yv.z), bflo(yv.w), bfhi(yv.w)};
                float o[8];
#pragma unroll
                for (int e = 0; e < 4; ++e) { o[e] = y[e] * __builtin_amdgcn_rcpf(1.f + __expf(-g0[e])); o[4 + e] = y[4 + e] * __builtin_amdgcn_rcpf(1.f + __expf(-g1[e])); }
#pragma unroll
                for (int e = 0; e < 8; ++e) ss += o[e] * o[e];
                u32x4 w; w.x = cvt_pk_bf16(o[0], o[1]); w.y = cvt_pk_bf16(o[2], o[3]); w.z = cvt_pk_bf16(o[4], o[5]); w.w = cvt_pk_bf16(o[6], o[7]);
                *(u32x4*)(O + (size_t)row * 2048 + col0 + bj * HALF) = w; }
            ss += __shfl_xor(ss, 16); ss += __shfl_xor(ss, 32);
            if (fq == 0) unsafeAtomicAdd(rss + row, ss); }
    }
};

struct EpiWout {
    static constexpr bool PERM = true, AFTER_DRAIN = false, HAS_MID = true;
    const float* X; float* OUT; bf16_t* XB; float* rss_x; const PG8_LAS float* tab;
    __device__ __forceinline__ void mid(f32x4 (&acc)[2][2][4][2], const Unit& u, int wr, int wc, int fr, int fq) const {
        const PG8_LAS float* tp = tab + wr * 64 + fr;
#pragma unroll
        for (int ai = 0; ai < 2; ++ai)
#pragma unroll
            for (int m = 0; m < 4; ++m) { const float ratio = tp[ai * HALF + m * 16];
#pragma unroll
                for (int bj = 0; bj < 2; ++bj)
#pragma unroll
                    for (int n = 0; n < 2; ++n) acc[ai][bj][m][n] *= ratio; }
    }
    __device__ __forceinline__ void operator()(const f32x4 (&acc)[2][2][4][2], const Unit& u, int wr, int wc, int fr, int fq) const {
        const int row0 = u.pm * BM + wr * 64 + fr, col0 = u.pn * BM + wc * 32 + 8 * fq;
        const PG8_LAS float* tp = tab + 256 + wr * 64 + fr;
        f32x4 xq[2][2][2];
#pragma unroll
        for (int bj = 0; bj < 2; ++bj) { const size_t o = (size_t)row0 * 2048 + col0 + bj * HALF; xq[0][bj][0] = *(const f32x4*)(X + o); xq[0][bj][1] = *(const f32x4*)(X + o + 4); }
#pragma unroll
        for (int idx = 0; idx < 8; ++idx) { const int ai = idx >> 2, m = idx & 3, row = row0 + ai * HALF + m * 16; float ss = 0.f;
            if (idx < 7) { const int nrow = row0 + ((idx + 1) >> 2) * HALF + ((idx + 1) & 3) * 16;
#pragma unroll
                for (int bj = 0; bj < 2; ++bj) { const size_t o = (size_t)nrow * 2048 + col0 + bj * HALF; xq[(idx + 1) & 1][bj][0] = *(const f32x4*)(X + o); xq[(idx + 1) & 1][bj][1] = *(const f32x4*)(X + o + 4); } }
            const float rs = tp[ai * HALF + m * 16];
#pragma unroll
            for (int bj = 0; bj < 2; ++bj) { const size_t o = (size_t)row * 2048 + col0 + bj * HALF;
                const f32x4 v0 = xq[idx & 1][bj][0] + rs * acc[ai][bj][m][0], v1 = xq[idx & 1][bj][1] + rs * acc[ai][bj][m][1];
                u32x4 w; w.x = cvt_pk_bf16(v0[0], v0[1]); w.y = cvt_pk_bf16(v0[2], v0[3]); w.z = cvt_pk_bf16(v1[0], v1[1]); w.w = cvt_pk_bf16(v1[2], v1[3]);
                *(u32x4*)(XB + o) = w;
#pragma unroll
                for (int e = 0; e < 4; ++e) ss += v0[e] * v0[e] + v1[e] * v1[e]; }
            ss += __shfl_xor(ss, 16); ss += __shfl_xor(ss, 32);
            if (fq == 0) unsafeAtomicAdd(rss_x + row, ss); }
    }
};

struct EpiScores {
    static constexpr bool PERM = false, AFTER_DRAIN = false, HAS_MID = false;
    float* C; const float* rss_x;
    __device__ __forceinline__ void mid(f32x4 (&)[2][2][4][2], const Unit&, int, int, int, int) const {}
    __device__ __forceinline__ void operator()(const f32x4 (&acc)[2][2][4][2], const Unit& u, int wr, int wc, int fr, int fq) const {
        const int row0 = u.pm * BM + wr * 64 + fr, col0 = u.pn * BM + wc * 32 + 4 * fq;
        float r2v[8];
#pragma unroll
        for (int idx = 0; idx < 8; ++idx) r2v[idx] = rss_x[row0 + (idx >> 2) * HALF + (idx & 3) * 16];
#pragma unroll
        for (int ai = 0; ai < 2; ++ai)
#pragma unroll
            for (int m = 0; m < 4; ++m) { const int row = row0 + ai * HALF + m * 16;
                const float r2 = __builtin_amdgcn_rsqf(r2v[ai * 4 + m] * (1.f / 2048.f) + 1e-6f);
                float* rowp = C + (size_t)row * 2048 + col0;
#pragma unroll
                for (int bj = 0; bj < 2; ++bj)
#pragma unroll
                    for (int n = 0; n < 2; ++n) *(f32x4*)(rowp + bj * HALF + n * 16) = acc[ai][bj][m][n] * r2; }
    }
};

template <class Epi, class Sched, bool STAMP = false>
__device__ __forceinline__ void gemm_phase(PG8_LAS unsigned char* lds, const Gemm g, const Sched& S, const Epi& E, unsigned long long* stamps) {
    const int tid = threadIdx.x, wid = __builtin_amdgcn_readfirstlane(tid >> 6), lane = tid & 63, wr = wid >> 2, wc = wid & 3, fr = lane & 15, fq = lane >> 4;
    const int K = g.K, nt = K / BK;
    int ts_lo = 0, ts_hi = 0, nts = 0; const unsigned long long rt_entry = STAMP ? (unsigned long long)wall_clock64() : 0ull;
#define PG8_STAMP() do { if (STAMP && wid == 0 && nts < 64) { const unsigned long long _c = (unsigned long long)clock64(); \
        ts_lo = (lane == nts) ? (int)(unsigned)_c : ts_lo; ts_hi = (lane == nts) ? (int)(unsigned)(_c >> 32) : ts_hi; ++nts; } } while (0)
    PG8_STAMP();
    unsigned voffA[2], voffB[2];
#pragma unroll
    for (int i = 0; i < 2; ++i) { int R, C; stage_rc(tid * 16 + i * 8192, R, C); const int Rb = Epi::PERM ? ((R & ~31) + perm32(R & 31)) : R;
        voffA[i] = (unsigned)(R * K + C) * 2u; voffB[i] = (unsigned)(Rb * K + C) * 2u; }
    const size_t kstep = (size_t)(BK * 2);
    const size_t hstep = (size_t)HALF * K * 2;
    const size_t tstep = 2 * hstep;
    const unsigned ldsw = (unsigned)wid * 1024u;
    const int aoff = lds_byte(wr * 64 + fr, fq * 8), boff = lds_byte(wc * 32 + fr, fq * 8);
#define PG8_SA(b, h) (((b) * 2 + (h)) * HTB)
#define PG8_SB(b, h) ((4 + (b) * 2 + (h)) * HTB)
#define PG8_STAGE(bufoff, gbase, voff) do { _Pragma("unroll") for (int _i = 0; _i < 2; ++_i) \
        __builtin_amdgcn_global_load_lds((const unsigned*)((const char*)(gbase) + (voff)[_i]), (PG8_LAS unsigned*)(lds + (bufoff) + ldsw + _i * 8192), 16, 0, 0); } while (0)
#define PG8_LDA(dst, b, h) do { _Pragma("unroll") for (int m = 0; m < 4; ++m) _Pragma("unroll") for (int k = 0; k < 2; ++k) dst[m][k] = *(const PG8_LAS bf16x8*)(lds + PG8_SA(b, h) + aoff + m * 2048 + k * 1024); } while (0)
#define PG8_LDB(dst, b, h) do { _Pragma("unroll") for (int n = 0; n < 2; ++n) _Pragma("unroll") for (int k = 0; k < 2; ++k) dst[n][k] = *(const PG8_LAS bf16x8*)(lds + PG8_SB(b, h) + boff + n * 2048 + k * 1024); } while (0)
#define PG8_MMA(ai, bj, At, Bt) do { __builtin_amdgcn_s_setprio(1); _Pragma("unroll") for (int m = 0; m < 4; ++m) _Pragma("unroll") for (int n = 0; n < 2; ++n) _Pragma("unroll") for (int k = 0; k < 2; ++k) \
        acc[ai][bj][m][n] = __builtin_amdgcn_mfma_f32_16x16x32_bf16(Bt[n][k], At[m][k], acc[ai][bj][m][n], 0, 0, 0); __builtin_amdgcn_s_setprio(0); } while (0)
#define PG8_WAIT_V(n) asm volatile("s_waitcnt vmcnt(" #n ")" ::: "memory")
#define PG8_WAIT_L(n) asm volatile("s_waitcnt lgkmcnt(" #n ")" ::: "memory")
#define PG8_BAR __builtin_amdgcn_s_barrier()
#define PG8_SCHED __builtin_amdgcn_sched_barrier(0)
    Unit cur, nxt; int ui = 0;
    if (!S.next(0, cur)) return;
    f32x4 acc[2][2][4][2];
#pragma unroll
    for (int a = 0; a < 2; ++a)
#pragma unroll
        for (int b = 0; b < 2; ++b)
#pragma unroll
            for (int m = 0; m < 4; ++m)
#pragma unroll
                for (int n = 0; n < 2; ++n) acc[a][b][m][n] = (f32x4){0.f, 0.f, 0.f, 0.f};
    bf16x8 At[4][2], B0[2][2], B1[2][2];
    const char* cA = (const char*)g.A + (size_t)cur.pm * tstep; const char* cB = (const char*)g.Bt + (size_t)cur.pn * tstep;
    S.a_ready(cur);
    PG8_STAGE(PG8_SB(0, 0), cB, voffB); PG8_STAGE(PG8_SA(0, 0), cA, voffA); PG8_STAGE(PG8_SB(0, 1), cB + hstep, voffB); PG8_STAGE(PG8_SA(0, 1), cA + hstep, voffA);
    if (wr == 1) PG8_BAR;
    PG8_WAIT_V(4); PG8_BAR;
    PG8_STAGE(PG8_SB(1, 0), cB + kstep, voffB); PG8_STAGE(PG8_SA(1, 0), cA + kstep, voffA); PG8_STAGE(PG8_SB(1, 1), cB + hstep + kstep, voffB);
    PG8_WAIT_V(6); PG8_BAR;
    PG8_STAMP();
    for (;;) {
        const bool has_next = S.next(ui + 1, nxt);
        const char* nA = has_next ? (const char*)g.A + (size_t)nxt.pm * tstep : cA; const char* nB = has_next ? (const char*)g.Bt + (size_t)nxt.pn * tstep : cB;
        for (int t = 0; t < nt; t += 2) {
            const bool last = (t == nt - 2);
            const char* a1 = cA + (size_t)(t + 1) * kstep;
            const char* a2 = last ? nA : cA + (size_t)(t + 2) * kstep; const char* b2 = last ? nB : cB + (size_t)(t + 2) * kstep;
            const char* a3 = a2 + kstep; const char* b3 = b2 + kstep;
            if (last && has_next) S.a_ready(nxt);
            if constexpr (Epi::HAS_MID) { if (t == (nt >> 1)) { E.mid(acc, cur, wr, wc, fr, fq); asm volatile("s_waitcnt lgkmcnt(0)" ::: "memory"); } }
            PG8_LDB(B0, 0, 0); PG8_SCHED; PG8_LDA(At, 0, 0); PG8_STAGE(PG8_SA(1, 1), a1 + hstep, voffA);
            PG8_WAIT_L(8); PG8_BAR; PG8_WAIT_L(0); PG8_MMA(0, 0, At, B0); PG8_BAR; PG8_SCHED;
            PG8_LDB(B1, 0, 1); PG8_STAGE(PG8_SB(0, 0), b2, voffB);
            PG8_BAR; PG8_WAIT_L(0); PG8_MMA(0, 1, At, B1); PG8_BAR;
            PG8_LDA(At, 0, 1); PG8_STAGE(PG8_SA(0, 0), a2, voffA);
            PG8_BAR; PG8_WAIT_L(0); PG8_MMA(1, 0, At, B0); PG8_BAR; PG8_SCHED;
            PG8_STAGE(PG8_SB(0, 1), b2 + hstep, voffB);
            PG8_WAIT_V(6); PG8_BAR; PG8_MMA(1, 1, At, B1); PG8_BAR;
            PG8_LDB(B0, 1, 0); PG8_SCHED; PG8_LDA(At, 1, 0); PG8_STAGE(PG8_SA(0, 1), a2 + hstep, voffA);
            PG8_WAIT_L(8); PG8_BAR; PG8_WAIT_L(0); PG8_MMA(0, 0, At, B0); PG8_BAR; PG8_SCHED;
            PG8_LDB(B1, 1, 1); PG8_STAGE(PG8_SB(1, 0), b3, voffB);
            PG8_BAR; PG8_WAIT_L(0); PG8_MMA(0, 1, At, B1); PG8_BAR;
            PG8_LDA(At, 1, 1); PG8_STAGE(PG8_SA(1, 0), a3, voffA);
            PG8_BAR; PG8_WAIT_L(0); PG8_MMA(1, 0, At, B0); PG8_BAR; PG8_SCHED;
            PG8_STAGE(PG8_SB(1, 1), b3 + hstep, voffB);
            PG8_WAIT_V(6); PG8_BAR; PG8_MMA(1, 1, At, B1); PG8_BAR;
        }
        PG8_STAMP();
        if constexpr (!Epi::AFTER_DRAIN) { E(acc, cur, wr, wc, fr, fq); S.done(cur); }
        PG8_STAMP();
        if (!has_next) break;
#pragma unroll
        for (int a = 0; a < 2; ++a)
#pragma unroll
            for (int b = 0; b < 2; ++b)
#pragma unroll
                for (int m = 0; m < 4; ++m)
#pragma unroll
                    for (int n = 0; n < 2; ++n) acc[a][b][m][n] = (f32x4){0.f, 0.f, 0.f, 0.f};
        cur = nxt; cA = nA; cB = nB; ++ui;
    }
    PG8_WAIT_V(0);
    if (wr == 0) PG8_BAR;
    PG8_BAR;
    if constexpr (Epi::AFTER_DRAIN) { E.fused(acc, cur, wr, wc, fr, fq, lds, wid, lane); S.done(cur); }
    PG8_STAMP();
    if (STAMP && wid == 0) { stamps[lane] = lane < nts ? (((unsigned long long)(unsigned)ts_hi << 32) | (unsigned)ts_lo) : 0ull;
        if (lane == 62) stamps[62] = rt_entry; if (lane == 63) stamps[63] = (unsigned long long)wall_clock64(); }
#undef PG8_STAMP
#undef PG8_SA
#undef PG8_SB
#undef PG8_STAGE
#undef PG8_LDA
#undef PG8_LDB
#undef PG8_MMA
#undef PG8_WAIT_V
#undef PG8_WAIT_L
#undef PG8_BAR
#undef PG8_SCHED
}
}

typedef short bf16x8 __attribute__((ext_vector_type(8)));
typedef float f32x4 __attribute__((ext_vector_type(4)));
typedef unsigned u32x4 __attribute__((ext_vector_type(4)));
using pg8::cvt_pk_bf16; using pg8::bflo; using pg8::bfhi;

#define LDS_WAIT() asm volatile("s_waitcnt lgkmcnt(0)" ::: "memory")
#define CBAR() asm volatile("" ::: "memory")
#define MFMA16(a, b, c) __builtin_amdgcn_mfma_f32_16x16x32_bf16((a), (b), (c), 0, 0, 0)

struct Args { const float* in[25]; float* out; unsigned char* ws; int ph_lo, ph_hi; };

__device__ __forceinline__ float wave_sum(float v) {
#pragma unroll
    for (int o = 1; o < 64; o <<= 1) v += __shfl_xor(v, o);
    return v;
}
__device__ __forceinline__ float wave_max(float v) {
#pragma unroll
    for (int o = 1; o < 64; o <<= 1) v = fmaxf(v, __shfl_xor(v, o));
    return v;
}
#define DPP_U(x, ctrl) ((unsigned)__builtin_amdgcn_update_dpp((int)(x), (int)(x), ctrl, 0xf, 0xf, false))
__device__ __forceinline__ unsigned row16_umax(unsigned v) { unsigned t;
    t = DPP_U(v, 0xB1); v = t > v ? t : v; t = DPP_U(v, 0x4E); v = t > v ? t : v; t = DPP_U(v, 0x141); v = t > v ? t : v; t = DPP_U(v, 0x140); v = t > v ? t : v; return v; }
__device__ __forceinline__ float row16_fmax(float v) { float t;
    t = __uint_as_float(DPP_U(__float_as_uint(v), 0xB1)); v = fmaxf(v, t); t = __uint_as_float(DPP_U(__float_as_uint(v), 0x4E)); v = fmaxf(v, t);
    t = __uint_as_float(DPP_U(__float_as_uint(v), 0x141)); v = fmaxf(v, t); t = __uint_as_float(DPP_U(__float_as_uint(v), 0x140)); v = fmaxf(v, t); return v; }
__device__ __forceinline__ float row16_fsum(float v) {
    v += __uint_as_float(DPP_U(__float_as_uint(v), 0xB1)); v += __uint_as_float(DPP_U(__float_as_uint(v), 0x4E));
    v += __uint_as_float(DPP_U(__float_as_uint(v), 0x141)); v += __uint_as_float(DPP_U(__float_as_uint(v), 0x140)); return v; }
__device__ __forceinline__ unsigned wave_umax(unsigned v) { v = row16_umax(v);
    const unsigned a = (unsigned)__builtin_amdgcn_readlane((int)v, 0), b = (unsigned)__builtin_amdgcn_readlane((int)v, 16), c = (unsigned)__builtin_amdgcn_readlane((int)v, 32), d = (unsigned)__builtin_amdgcn_readlane((int)v, 48);
    const unsigned ab = a > b ? a : b, cd = c > d ? c : d; return ab > cd ? ab : cd; }
__device__ __forceinline__ float gelu_erf(float x) { return 0.5f * x * (1.0f + erff(x * 0.70710678118654752f)); }
__device__ __forceinline__ float gelu_as(float v) {
    const float av = fabsf(v), t = __builtin_amdgcn_rcpf(fmaf(av, 0.2316418882f, 1.0f));
    float q = fmaf(t, 0.5307027145f, -0.7265760135f); q = fmaf(q, t, 0.7107068705f); q = fmaf(q, t, -0.142248368f); q = fmaf(q, t, 0.127414796f); q *= t;
    const float e = __builtin_amdgcn_exp2f(v * v * -0.72134752044f), m = v * (q * e);
    return v < 0.f ? m : v - m;
}
__device__ __forceinline__ bf16x8 as_bf16x8(u32x4 v) { return __builtin_bit_cast(bf16x8, v); }

__device__ __forceinline__ void p0_transpose_item(const float* W, int K, int N, bf16_t* WT, const float* sc_a, const float* sc_b, LAS float* scr, int item, int lane) {
    const int nblk = N / 32, kb = item / nblk, nb = item % nblk, k0 = 64 * kb, n0 = 32 * nb;
#pragma unroll 8
    for (int i = 0; i < 32; ++i) { const int kk = 2 * i + (lane >> 5); const int k = k0 + kk;
        const float s = sc_a ? (k < 1024 ? sc_a[k] : sc_b[k - 1024]) : 1.f;
        scr[kk * 33 + (lane & 31)] = W[(size_t)k * N + n0 + (lane & 31)] * s; }
    LDS_WAIT();
    const int c = lane & 7;
#pragma unroll
    for (int j = 0; j < 4; ++j) { const int n = (lane >> 3) + 8 * j; const LAS float* s = scr + (8 * c) * 33 + n;
        u32x4 o; o.x = cvt_pk_bf16(s[0 * 33], s[1 * 33]); o.y = cvt_pk_bf16(s[2 * 33], s[3 * 33]); o.z = cvt_pk_bf16(s[4 * 33], s[5 * 33]); o.w = cvt_pk_bf16(s[6 * 33], s[7 * 33]);
        *(u32x4*)(WT + (size_t)(n0 + n) * K + k0 + 8 * c) = o; }
    LDS_WAIT();
}
template <int MODE> __device__ __forceinline__ void p0_row(const float* xrow, const float* g, bf16_t* orow, int lane) {
    const f32x4* xr = (const f32x4*)xrow + lane; const f32x4* gr = (const f32x4*)g + lane;
    f32x4 v[8]; float s = 0.f;
#pragma unroll
    for (int j = 0; j < 8; ++j) { v[j] = xr[64 * j]; s += (v[j].x * v[j].x + v[j].y * v[j].y) + (v[j].z * v[j].z + v[j].w * v[j].w); }
    float r = 1.f;
    if (MODE == 0) r = 1.0f / sqrtf(wave_sum(s) * (1.f / 2048.f) + EPS);
    u32x2* o8 = (u32x2*)orow + lane;
#pragma unroll
    for (int j = 0; j < 8; ++j) { f32x4 w = v[j] * r; if (MODE != 2) w = w * gr[64 * j];
        u32x2 o; o.x = cvt_pk_bf16(w.x, w.y); o.y = cvt_pk_bf16(w.z, w.w); o8[64 * j] = o; }
}
template <bool SCALE_G, bool OFFS> __device__ __forceinline__ void p0_row_q8(const float* xrow, const float* g, unsigned char* orow, float* sc, int lane) {
    const f32x4* xr = (const f32x4*)xrow + lane; const f32x4* gr = (const f32x4*)g + lane;
    f32x4 v[8]; float m = 0.f;
#pragma unroll
    for (int j = 0; j < 8; ++j) { v[j] = xr[64 * j]; if (SCALE_G) v[j] = v[j] * gr[64 * j];
        m = fmaxf(fmaxf(m, fmaxf(fabsf(v[j].x), fabsf(v[j].y))), fmaxf(fabsf(v[j].z), fabsf(v[j].w))); }
    m = fmaxf(wave_max(m), 1e-30f);
    const float inv = 127.f / m;
    if (lane == 0) *sc = m * (1.f / 127.f);
    unsigned* o4 = (unsigned*)orow + lane;
#pragma unroll
    for (int j = 0; j < 8; ++j) { const int a = (int)rintf(v[j].x * inv) + (OFFS ? 128 : 0), b = (int)rintf(v[j].y * inv) + (OFFS ? 128 : 0), c = (int)rintf(v[j].z * inv) + (OFFS ? 128 : 0), d = (int)rintf(v[j].w * inv) + (OFFS ? 128 : 0);
        o4[64 * j] = (unsigned)(a & 255) | ((unsigned)(b & 255) << 8) | ((unsigned)(c & 255) << 16) | ((unsigned)(d & 255) << 24); }
}
template <int KIND> __device__ __forceinline__ void p0_rows(const float* src, const float* g, void* dst, float* sc, int first, int stride, int nrows, int lane) {
    const f32x4* gr = (const f32x4*)g + lane;
    f32x4 cur[8], nxt[8], nx2[8];
    int r = first;
    if (r >= nrows) return;
    { const f32x4* xr = (const f32x4*)(src + (size_t)r * 2048) + lane;
#pragma unroll
        for (int j = 0; j < 8; ++j) cur[j] = xr[64 * j]; }
    if (r + stride < nrows) { const f32x4* xr = (const f32x4*)(src + (size_t)(r + stride) * 2048) + lane;
#pragma unroll
        for (int j = 0; j < 8; ++j) nxt[j] = xr[64 * j]; }
    for (; r < nrows; r += stride) {
        const int rn = r + 2 * stride;
        if (rn < nrows) { const f32x4* xr = (const f32x4*)(src + (size_t)rn * 2048) + lane;
#pragma unroll
            for (int j = 0; j < 8; ++j) nx2[j] = xr[64 * j]; }
        if (KIND == 0) {
            float s = 0.f;
#pragma unroll
            for (int j = 0; j < 8; ++j) s += (cur[j].x * cur[j].x + cur[j].y * cur[j].y) + (cur[j].z * cur[j].z + cur[j].w * cur[j].w);
            const float rr = 1.0f / sqrtf(wave_sum(s) * (1.f / 2048.f) + EPS);
            u32x2* o8 = (u32x2*)((bf16_t*)dst + (size_t)r * 2048) + lane;
#pragma unroll
            for (int j = 0; j < 8; ++j) { const f32x4 w = cur[j] * rr * gr[64 * j]; u32x2 o; o.x = cvt_pk_bf16(w.x, w.y); o.y = cvt_pk_bf16(w.z, w.w); o8[64 * j] = o; }
        } else if (KIND >= 3) {
            float ssq = 0.f;
#pragma unroll
            for (int j = 0; j < 8; ++j) { if (KIND == 3) cur[j] = cur[j] * gr[64 * j]; ssq += (cur[j].x * cur[j].x + cur[j].y * cur[j].y) + (cur[j].z * cur[j].z + cur[j].w * cur[j].w); }
            const float rms = sqrtf(fmaxf(wave_sum(ssq) * (1.f / 2048.f), 1e-30f));
            const float sq = 0.1676f * rms, inv = 0.5f / sq;
            if (lane == 0) sc[r] = sq;
            unsigned* o4 = (unsigned*)((unsigned char*)dst + (size_t)r * 2048) + lane;
#pragma unroll
            for (int j = 0; j < 4; ++j) { unsigned w = 0u;
#pragma unroll
                for (int e = 0; e < 4; ++e) { const float lo = cur[j][e], hi = cur[j + 4][e];
                    int nl = (int)rintf(fmaf(lo, inv, 7.5f)), nh = (int)rintf(fmaf(hi, inv, 7.5f));
                    nl = nl < 0 ? 0 : (nl > 15 ? 15 : nl); nh = nh < 0 ? 0 : (nh > 15 ? 15 : nh);
                    w |= ((unsigned)nl << (8 * e)) | ((unsigned)nh << (8 * e + 4)); }
                o4[64 * j] = w; }
        } else {
            float m = 0.f;
#pragma unroll
            for (int j = 0; j < 8; ++j) { if (KIND == 1) cur[j] = cur[j] * gr[64 * j];
                m = fmaxf(fmaxf(m, fmaxf(fabsf(cur[j].x), fabsf(cur[j].y))), fmaxf(fabsf(cur[j].z), fabsf(cur[j].w))); }
            m = fmaxf(wave_max(m), 1e-30f);
            const float inv = 127.f / m; const int off = KIND == 2 ? 128 : 0;
            if (lane == 0) sc[r] = m * (1.f / 127.f);
            unsigned* o4 = (unsigned*)((unsigned char*)dst + (size_t)r * 2048) + lane;
#pragma unroll
            for (int j = 0; j < 8; ++j) { const int a = (int)rintf(cur[j].x * inv) + off, b = (int)rintf(cur[j].y * inv) + off, c = (int)rintf(cur[j].z * inv) + off, d = (int)rintf(cur[j].w * inv) + off;
                o4[64 * j] = (unsigned)(a & 255) | ((unsigned)(b & 255) << 8) | ((unsigned)(c & 255) << 16) | ((unsigned)(d & 255) << 24); }
        }
#pragma unroll
        for (int j = 0; j < 8; ++j) { cur[j] = nxt[j]; nxt[j] = nx2[j]; }
    }
}
__device__ __forceinline__ void p0_wp_item(const float* wq, const float* keys1, const float* keys2, const float* gffn, bf16_t* WPT, int item, int lane) {
    const int hj = item >> 7, ib = item & 127, h = hj >> 1, j = hj & 1, i0 = 16 * ib, col0 = h * 256 + j * 128;
    const int lr = lane & 15, g = lane >> 4;
    const float* keys = (j ? keys2 : keys1) + (size_t)h * 128 * 128;
    const float gi = gffn[i0 + lr];
    bf16x8 af[4];
#pragma unroll
    for (int s = 0; s < 4; ++s) { const float* p = wq + (size_t)(i0 + lr) * 2048 + col0 + 32 * s + 8 * g;
        const f32x4 a = *(const f32x4*)p * gi, b = *(const f32x4*)(p + 4) * gi;
        u32x4 w; w.x = cvt_pk_bf16(a.x, a.y); w.y = cvt_pk_bf16(a.z, a.w); w.z = cvt_pk_bf16(b.x, b.y); w.w = cvt_pk_bf16(b.z, b.w); af[s] = as_bf16x8(w); }
    f32x4 kn[8];
#pragma unroll
    for (int s = 0; s < 4; ++s) { const float* p = keys + (size_t)lr * 128 + 32 * s + 8 * g; kn[2 * s] = *(const f32x4*)p; kn[2 * s + 1] = *(const f32x4*)(p + 4); }
    for (int kt = 0; kt < 8; ++kt) {
        f32x4 kc[8];
#pragma unroll
        for (int i = 0; i < 8; ++i) kc[i] = kn[i];
        if (kt < 7) {
#pragma unroll
            for (int s = 0; s < 4; ++s) { const float* p = keys + (size_t)(16 * (kt + 1) + lr) * 128 + 32 * s + 8 * g; kn[2 * s] = *(const f32x4*)p; kn[2 * s + 1] = *(const f32x4*)(p + 4); } }
        f32x4 d = {0.f, 0.f, 0.f, 0.f};
#pragma unroll
        for (int s = 0; s < 4; ++s) { const f32x4 a = kc[2 * s], b = kc[2 * s + 1];
            u32x4 w; w.x = cvt_pk_bf16(a.x, a.y); w.y = cvt_pk_bf16(a.z, a.w); w.z = cvt_pk_bf16(b.x, b.y); w.w = cvt_pk_bf16(b.z, b.w);
            d = MFMA16(af[s], as_bf16x8(w), d); }
        u32x2 o; o.x = cvt_pk_bf16(d[0], d[1]); o.y = cvt_pk_bf16(d[2], d[3]);
        *(u32x2*)(WPT + (size_t)(hj * 128 + 16 * kt + lr) * 2048 + i0 + 4 * g) = o;
    }
}
__device__ __forceinline__ int t5_bucket(int n) {
    if (n < 16) return n;
    const int large = 16 + (int)(logf((float)n / 16.f) / 4.852030263919617f * 16.f);
    return large < 31 ? large : 31;
}
__device__ __forceinline__ void p0_ssm_item(const Args& A, unsigned char* sp, int g, int lane) {
    const float* lam_re = A.in[6]; const float* lam_im = A.in[7]; const float* log_dt = A.in[8];
    const float* b_re = A.in[9]; const float* b_im = A.in[10]; const float* c_re = A.in[11]; const float* c_im = A.in[12];
    const int n = lane;
    const float dt = expf(log_dt[g]);
    const float lr = lam_re[g * 64 + n], li = lam_im[g * 64 + n];
    const float mag = expf(lr * dt);
    const float a_re = mag * cosf(li * dt), a_im = mag * sinf(li * dt);
    const float den = lr * lr + li * li;
    const float f_re = ((a_re - 1.f) * lr + a_im * li) / den, f_im = (a_im * lr - (a_re - 1.f) * li) / den;
    ((f32x2*)(sp + SSMP_ABAR))[g * 64 + n] = (f32x2){a_re, a_im};
    float pr = a_re, pi = a_im;
#pragma unroll
    for (int i = 0; i < 8; ++i) { const float nr = pr * pr - pi * pi, ni = 2.f * pr * pi; pr = nr; pi = ni; }
    ((f32x2*)(sp + SSMP_A256))[g * 64 + n] = (f32x2){pr, pi};
    float bbr[16], bbi[16];
#pragma unroll
    for (int q = 0; q < 4; ++q) { const f32x4 br = *(const f32x4*)(b_re + (size_t)(g * 64 + n) * 16 + 4 * q), bi = *(const f32x4*)(b_im + (size_t)(g * 64 + n) * 16 + 4 * q);
#pragma unroll
        for (int e = 0; e < 4; ++e) { bbr[4 * q + e] = f_re * br[e] - f_im * bi[e]; bbi[4 * q + e] = f_re * bi[e] + f_im * br[e]; } }
    {
        float* bbt = (float*)(sp + SSMP_BBT); const int mt = n >> 4, q4 = (n >> 2) & 3, rg = n & 3;
#pragma unroll
        for (int c = 0; c < 16; ++c) { const size_t o = ((((size_t)g * 4 + mt) * 4 + q4) * 16 + c) * 4 + rg; bbt[o] = bbr[c]; bbt[o + 65536] = bbi[c]; } }
    bf16_t* bf = (bf16_t*)(sp + SSMP_BFRAG);
    const int jre = n >> 4, n16 = n & 15;
#pragma unroll
    for (int kg = 0; kg < 4; ++kg) {
        u32x4 wr = {0u, 0u, 0u, 0u}, wi = {0u, 0u, 0u, 0u};
        if (kg < 2) { const int c0 = (kg & 1) * 8;
            wr.x = cvt_pk_bf16(bbr[c0 + 0], bbr[c0 + 1]); wr.y = cvt_pk_bf16(bbr[c0 + 2], bbr[c0 + 3]); wr.z = cvt_pk_bf16(bbr[c0 + 4], bbr[c0 + 5]); wr.w = cvt_pk_bf16(bbr[c0 + 6], bbr[c0 + 7]);
            wi.x = cvt_pk_bf16(bbi[c0 + 0], bbi[c0 + 1]); wi.y = cvt_pk_bf16(bbi[c0 + 2], bbi[c0 + 3]); wi.z = cvt_pk_bf16(bbi[c0 + 4], bbi[c0 + 5]); wi.w = cvt_pk_bf16(bbi[c0 + 6], bbi[c0 + 7]); }
        *(u32x4*)(bf + ((size_t)(g * 8 + jre) * 64 + kg * 16 + n16) * 8) = wr;
        *(u32x4*)(bf + ((size_t)(g * 8 + 4 + jre) * 64 + kg * 16 + n16) * 8) = wi;
    }
    bf16_t* cf = (bf16_t*)(sp + SSMP_CFRAG);
    const int ch = lane & 15, kg = lane >> 4;
#pragma unroll
    for (int s = 0; s < 4; ++s) { const int k0 = 32 * s + 8 * kg;
        const float* src = (k0 < 64) ? (c_re + (size_t)(g * 16 + ch) * 64 + k0) : (c_im + (size_t)(g * 16 + ch) * 64 + (k0 - 64));
        const float sg = (k0 < 64) ? 1.f : -1.f;
        const f32x4 a = *(const f32x4*)src * sg, b = *(const f32x4*)(src + 4) * sg;
        u32x4 w; w.x = cvt_pk_bf16(a.x, a.y); w.y = cvt_pk_bf16(a.z, a.w); w.z = cvt_pk_bf16(b.x, b.y); w.w = cvt_pk_bf16(b.z, b.w);
        *(u32x4*)(cf + ((size_t)(g * 4 + s) * 64 + lane) * 8) = w; }
}
__device__ __forceinline__ void p0_vand_item(const Args& A, unsigned char* sp, int item, int lane) {
    const int g = item >> 3, mt = item & 7, np = 16 * mt + (lane & 15), n = np & 63, kg = lane >> 4;
    const float dt = expf(A.in[8][g]), lr = A.in[6][g * 64 + n], li = A.in[7][g * 64 + n];
    bf16_t* vf = (bf16_t*)(sp + SSMP_VAND) + (size_t)(g * 8 + mt) * 8 * 64 * 8;
    const float m1 = expf(lr * dt), a_re = m1 * cosf(li * dt), a_im = m1 * sinf(li * dt);
    for (int ks = 0; ks < 8; ++ks) { float v[8];
        const float pw = (float)(255 - (32 * ks + 8 * kg + 7)); const float mag = expf(lr * dt * pw), ang = li * dt * pw;
        float cr = mag * cosf(ang), ci = mag * sinf(ang);
#pragma unroll
        for (int j = 7; j >= 0; --j) { v[j] = np < 64 ? cr : ci; const float nr = cr * a_re - ci * a_im, ni = cr * a_im + ci * a_re; cr = nr; ci = ni; }
        u32x4 w; w.x = cvt_pk_bf16(v[0], v[1]); w.y = cvt_pk_bf16(v[2], v[3]); w.z = cvt_pk_bf16(v[4], v[5]); w.w = cvt_pk_bf16(v[6], v[7]);
        *(u32x4*)(vf + ((size_t)ks * 64 + lane) * 8) = w; }
}
__device__ __forceinline__ void p0_btab_item(const Args& A, float* btab, int item, int lane) {
    const float* gq = A.in[3]; const float* gk = A.in[4]; const float* rel_bias = A.in[5];
    const int h = item / 3, br = item % 3, d = br == 0 ? 1 : (br == 1 ? 4 : 16);
    const float G = wave_max(fabsf(gq[lane] * gk[lane]));
    const float mb = wave_max(lane < 32 ? rel_bias[lane * 16 + h] : -1e30f);
    const float smax = 8.4f * G + mb;
    for (int idx = lane; idx < 192; idx += 64) { const int rel = idx - 31;
        float v = -1e30f;
        if (rel >= 0 && rel <= 128) v = LOG2E * (rel_bias[t5_bucket(rel * d) * 16 + h] - smax);
        btab[(h * 3 + br) * 192 + idx] = v; }
}

__device__ __forceinline__ void p0_prologue(const Args& A, LAS unsigned char* lds, int wave, int lane, int pflags) {
    unsigned char* ws = A.ws;
    LAS float* scr = (LAS float*)(lds + wave * 16384);
    const int gw = blockIdx.x * 8 + wave, NGW = gridDim.x * 8;
    constexpr int I_WIN = (2048 / 64) * (4096 / 32), I_GLU = (1024 / 64) * (1024 / 32), I_WOUT = (2048 / 64) * (2048 / 32), I_WP = 2048;
    constexpr int I_SSM = 64, I_BT = 48, I_VAND = 512;
    constexpr int NITEMS = I_WIN + I_GLU + I_WOUT + I_WP + I_SSM + I_BT + I_VAND;
    const bool rows_first = wave & 1;
    if (rows_first && !(pflags & 2048)) p0_rows<0>(A.in[0], A.in[1], ws + WS_HB, nullptr, gw, NGW, 8192, lane);
    if (!(pflags & 4096)) for (int it = gw; it < NITEMS; it += NGW) {
        int r = it;
        if (r < I_SSM) { p0_ssm_item(A, ws + WS_SSMP, r, lane); continue; } r -= I_SSM;
        if (r < I_BT) { p0_btab_item(A, (float*)(ws + WS_BTAB), r, lane); continue; } r -= I_BT;
        if (r < I_VAND) { p0_vand_item(A, ws + WS_SSMP, r, lane); continue; } r -= I_VAND;
        if (r < I_WP) { p0_wp_item(A.in[20], A.in[21], A.in[22], A.in[19], (bf16_t*)(ws + WS_WPT), r, lane); continue; } r -= I_WP;
        if (r < I_WIN) { p0_transpose_item(A.in[2], 2048, 4096, (bf16_t*)(ws + WS_WINT), nullptr, nullptr, scr, r, lane); continue; } r -= I_WIN;
        if (r < I_GLU) { p0_transpose_item(A.in[14], 1024, 1024, (bf16_t*)(ws + WS_GLUT), nullptr, nullptr, scr, r, lane); continue; } r -= I_GLU;
        p0_transpose_item(A.in[18], 2048, 2048, (bf16_t*)(ws + WS_WOUTT), A.in[16], A.in[17], scr, r, lane);
    }
    if (!rows_first && !(pflags & 2048)) p0_rows<0>(A.in[0], A.in[1], ws + WS_HB, nullptr, gw, NGW, 8192, lane);
}
__device__ __forceinline__ void table_chunk(const Args& A, int c, int wave, int lane) {
    unsigned char* ws = A.ws;
    if (c < 512) p0_rows<3>(A.in[23], A.in[19], ws + WS_UB, (float*)(ws + WS_SU), 32 * c + wave, 8, 32 * c + 32, lane);
    else p0_rows<4>(A.in[24], A.in[19], ws + WS_UB + 1024, (float*)(ws + WS_SV), 32 * (c - 512) + wave, 8, 32 * (c - 512) + 32, lane);
}

constexpr int SSM_WL = 8192 + 16 * 272 + 512;
__device__ __forceinline__ void ssm_unit(const Args& A, LAS unsigned char* lds, int b, int g, int wave, int lane) {
    unsigned char* ws = A.ws; unsigned char* sp = ws + WS_SSMP;
    const bf16_t* proj = (const bf16_t*)(ws + WS_PROJ); bf16_t* yb = (bf16_t*)(ws + WS_YB);
    LAS unsigned char* wl = lds + wave * SSM_WL;
    LAS f32x2* BU = (LAS f32x2*)wl; LAS unsigned char* XB = wl + 8192; LAS unsigned char* UL = wl + 8192 + 16 * 272;
    LAS f32x2* carry = (LAS f32x2*)(lds + 8 * SSM_WL);
    const int lr = lane & 15, q = lane >> 4;
    bf16x8 bfr[8], cfr[4];
#pragma unroll
    for (int j = 0; j < 8; ++j) bfr[j] = as_bf16x8(*(const u32x4*)((const bf16_t*)(sp + SSMP_BFRAG) + ((size_t)(g * 8 + j) * 64 + lane) * 8));
#pragma unroll
    for (int s = 0; s < 4; ++s) cfr[s] = as_bf16x8(*(const u32x4*)((const bf16_t*)(sp + SSMP_CFRAG) + ((size_t)(g * 4 + s) * 64 + lane) * 8));
    const f32x2 ab = ((const f32x2*)(sp + SSMP_ABAR))[g * 64 + lane], a256 = ((const f32x2*)(sp + SSMP_A256))[g * 64 + lane];
    const float a_re = ab.x, a_im = ab.y;
    const float dsk = A.in[13][g * 16 + lr];
    const bf16_t* up = proj + (size_t)(b * SEQ + wave * 256) * DPROJ + 3072 + g * 16;
    float xr = 0.f, xi = 0.f;
    {
        LAS unsigned char* UT = wl;
#pragma unroll
        for (int i = 0; i < 8; ++i) { const int tk = 32 * i + (lane >> 1), hf = lane & 1;
            const u32x4 raw = *(const u32x4*)(up + (size_t)tk * DPROJ + 8 * hf);
            const unsigned rw[4] = {raw.x, raw.y, raw.z, raw.w};
#pragma unroll
            for (int e = 0; e < 4; ++e) { *(LAS unsigned short*)(UT + (8 * hf + 2 * e) * 528 + tk * 2) = (unsigned short)(rw[e] & 0xffffu); *(LAS unsigned short*)(UT + (8 * hf + 2 * e + 1) * 528 + tk * 2) = (unsigned short)(rw[e] >> 16); } }
        CBAR();
        const bf16_t* vf = (const bf16_t*)(sp + SSMP_VAND) + (size_t)g * 8 * 8 * 64 * 8 + lane * 8;
        f32x4 pd[8];
#pragma unroll
        for (int mt = 0; mt < 8; ++mt) pd[mt] = (f32x4){0.f, 0.f, 0.f, 0.f};
#pragma unroll 2
        for (int ks = 0; ks < 8; ++ks) { const bf16x8 ub = as_bf16x8(*(const LAS u32x4*)(UT + lr * 528 + (32 * ks + 8 * q) * 2));
#pragma unroll
            for (int mt = 0; mt < 8; ++mt) pd[mt] = MFMA16(as_bf16x8(*(const u32x4*)(vf + (size_t)(mt * 8 + ks) * 512)), ub, pd[mt]); }
        const float* bbt = (const float*)(sp + SSMP_BBT) + (((size_t)g * 4) * 4 + q) * 64 + lr * 4;
#pragma unroll
        for (int mt = 0; mt < 4; ++mt) { const f32x4 br = *(const f32x4*)(bbt + (size_t)mt * 256), bi = *(const f32x4*)(bbt + (size_t)mt * 256 + 65536);
#pragma unroll
            for (int r = 0; r < 4; ++r) { const float er = row16_fsum(br[r] * pd[mt][r] - bi[r] * pd[mt + 4][r]), ei = row16_fsum(br[r] * pd[mt + 4][r] + bi[r] * pd[mt][r]);
                if (lr == 0) carry[wave * 64 + 16 * mt + 4 * q + r] = (f32x2){er, ei}; } }
        CBAR();
    }
    __syncthreads();
    { float sr = 0.f, si = 0.f;
        for (int w2 = 0; w2 < wave; ++w2) { const f32x2 e = carry[w2 * 64 + lane]; const float nr = a256.x * sr - a256.y * si + e.x, ni = a256.x * si + a256.y * sr + e.y; sr = nr; si = ni; }
        xr = sr; xi = si; }
    for (int pass = 1; pass < 2; ++pass) {
        u32x4 unext = {0u, 0u, 0u, 0u};
        if (q < 2) unext = *(const u32x4*)(up + (size_t)lr * DPROJ + 8 * q);
        for (int blk = 0; blk < 16; ++blk) {
            const u32x4 uraw = unext;
            if (q < 2 && blk < 15) unext = *(const u32x4*)(up + (size_t)((blk + 1) * 16 + lr) * DPROJ + 8 * q);
            const bf16x8 ua = as_bf16x8(uraw);
            if (pass == 1 && q < 2) *(LAS u32x4*)(UL + lr * 32 + q * 16) = uraw;
            f32x4 dd[8];
#pragma unroll
            for (int j = 0; j < 8; ++j) dd[j] = MFMA16(ua, bfr[j], ((f32x4){0.f, 0.f, 0.f, 0.f}));
#pragma unroll
            for (int jj = 0; jj < 4; ++jj)
#pragma unroll
                for (int r = 0; r < 4; ++r) BU[(4 * q + r) * 64 + 16 * jj + lr] = (f32x2){dd[jj][r], dd[4 + jj][r]};
            CBAR();
            f32x2 bu[16];
#pragma unroll
            for (int t = 0; t < 16; ++t) bu[t] = BU[t * 64 + lane];
            if (pass == 0) {
#pragma unroll
                for (int t = 0; t < 16; ++t) { float nr = fmaf(a_re, xr, fmaf(-a_im, xi, bu[t].x)), ni = fmaf(a_re, xi, fmaf(a_im, xr, bu[t].y)); asm volatile("" : "+v"(nr)); asm volatile("" : "+v"(ni)); xr = nr; xi = ni; }
                asm volatile("" : "+v"(xr), "+v"(xi) :: "memory");
            } else {
#pragma unroll
                for (int t = 0; t < 16; ++t) { float nr = fmaf(a_re, xr, fmaf(-a_im, xi, bu[t].x)), ni = fmaf(a_re, xi, fmaf(a_im, xr, bu[t].y)); asm volatile("" : "+v"(nr)); asm volatile("" : "+v"(ni)); xr = nr; xi = ni;
                    const unsigned pk = cvt_pk_bf16(xr, xi);
                    *(LAS unsigned short*)(XB + t * 272 + lane * 2) = (unsigned short)(pk & 0xffffu);
                    *(LAS unsigned short*)(XB + t * 272 + 128 + lane * 2) = (unsigned short)(pk >> 16); }
                CBAR();
                f32x4 y = {0.f, 0.f, 0.f, 0.f};
#pragma unroll
                for (int s = 0; s < 4; ++s) { const bf16x8 xa = as_bf16x8(*(const LAS u32x4*)(XB + lr * 272 + (32 * s + 8 * q) * 2)); y = MFMA16(xa, cfr[s], y); }
#pragma unroll
                for (int r = 0; r < 4; ++r) { const int t = blk * 16 + 4 * q + r;
                    const float uv = __uint_as_float((unsigned)(*(const LAS unsigned short*)(UL + (4 * q + r) * 32 + lr * 2)) << 16);
                    const float yv = gelu_as(y[r] + dsk * uv);
                    yb[(size_t)(b * SEQ + wave * 256 + t) * 1024 + g * 16 + lr] = (bf16_t)(cvt_pk_bf16(yv, 0.f) & 0xffffu); }
                asm volatile("" : "+v"(xr), "+v"(xi) :: "memory");
            }
        }
    }
    __syncthreads();
}

__device__ __forceinline__ void prep2_item(const Args& A, LAS unsigned char* wl, int item, int lane) {
    unsigned char* ws = A.ws;
    const bf16_t* proj = (const bf16_t*)(ws + WS_PROJ);
    const int pb = item & 31, h = (item >> 5) & 15, b = item >> 9, P0 = pb * 64, bh = b * 16 + h;
    const int r8 = lane >> 3, c = lane & 7;
    const float* gq = A.in[3]; const float* gk = A.in[4];
    const int fs = c >> 2, fg = c & 3;
#pragma unroll 1
    for (int which = 0; which < 2; ++which) {
        const float* gv = which ? gk : gq; const float cs = which ? 1.f : (LOG2E * 0.125f);
        float gl[8];
#pragma unroll
        for (int e = 0; e < 8; ++e) gl[e] = gv[8 * c + e] * cs;
        bf16_t* F = (bf16_t*)(ws + (which ? WS_KF : WS_QF));
        u32x4 raws[8];
#pragma unroll
        for (int i = 0; i < 8; ++i) raws[i] = *(const u32x4*)(proj + (size_t)(b * SEQ + P0 + 8 * i + r8) * DPROJ + which * 1024 + h * 64 + 8 * c);
#pragma unroll
        for (int i = 0; i < 8; ++i) { const int row = 8 * i + r8, pos = P0 + row;
            const u32x4 raw = raws[i];
            float v[8] = {bflo(raw.x), bfhi(raw.x), bflo(raw.y), bfhi(raw.y), bflo(raw.z), bfhi(raw.z), bflo(raw.w), bfhi(raw.w)};
            float ss = 0.f;
#pragma unroll
            for (int e = 0; e < 8; ++e) ss += v[e] * v[e];
            ss += __shfl_xor(ss, 1); ss += __shfl_xor(ss, 2); ss += __shfl_xor(ss, 4);
            const float r = 1.0f / sqrtf(ss * (1.f / 64.f) + EPS);
            u32x4 w; w.x = cvt_pk_bf16(v[0] * r * gl[0], v[1] * r * gl[1]); w.y = cvt_pk_bf16(v[2] * r * gl[2], v[3] * r * gl[3]);
            w.z = cvt_pk_bf16(v[4] * r * gl[4], v[5] * r * gl[5]); w.w = cvt_pk_bf16(v[6] * r * gl[6], v[7] * r * gl[7]);
#pragma unroll
            for (int br = 0; br < 3; ++br) { const int sh = 2 * br, rr = pos & ((1 << sh) - 1), l = pos >> sh;
                *(u32x4*)(F + (size_t)br * 4 * 16 * SEQ * 64 + ((((size_t)(bh << sh) + rr) * (SEQ >> (sh + 4)) + (l >> 4)) * 2 + fs) * 512 + (fg * 16 + (l & 15)) * 8) = w; } }
    }
#pragma unroll
    for (int i = 0; i < 8; ++i) { const int row = 8 * i + r8;
        const u32x4 raw = *(const u32x4*)(proj + (size_t)(b * SEQ + P0 + row) * DPROJ + 2048 + h * 64 + 8 * c);
        *(LAS u32x2*)(wl + row * 136 + c * 16) = (u32x2){raw.x, raw.y}; *(LAS u32x2*)(wl + row * 136 + c * 16 + 8) = (u32x2){raw.z, raw.w}; }
    CBAR();
    unsigned v[64];
#pragma unroll
    for (int p = 0; p < 64; ++p) v[p] = *(const LAS unsigned short*)(wl + p * 136 + lane * 2);
    CBAR();
    bf16_t* vt = (bf16_t*)(ws + WS_VT);
    const int nt = lane >> 4, dl = lane & 15;
#pragma unroll
    for (int G = 0; G < 2; ++G) { bf16_t* tp = vt + ((((size_t)bh * 64 + (P0 >> 5) + G) * 4 + nt) * 64 + dl) * 8;
#pragma unroll
        for (int kg = 0; kg < 4; ++kg) { const int a0 = 32 * G + 4 * kg, b0 = 32 * G + 16 + 4 * kg;
            u32x4 w; w.x = v[a0] | (v[a0 + 1] << 16); w.y = v[a0 + 2] | (v[a0 + 3] << 16); w.z = v[b0] | (v[b0 + 1] << 16); w.w = v[b0 + 2] | (v[b0 + 3] << 16);
            *(u32x4*)(tp + kg * 128) = w; } }
    { bf16_t* vt4 = vt + (size_t)4 * 16 * 64 * SEQ; const int l0 = P0 >> 2, tile = (l0 >> 4) & 1, grp = l0 >> 5;
#pragma unroll
        for (int r = 0; r < 4; ++r) { bf16_t* tp = vt4 + (((((size_t)bh * 4 + r) * 16 + grp) * 4 + nt) * 64 + dl) * 8;
#pragma unroll
            for (int kg = 0; kg < 4; ++kg) { const int p0 = 4 * (4 * kg) + r;
                u32x2 w; w.x = v[p0] | (v[p0 + 4] << 16); w.y = v[p0 + 8] | (v[p0 + 12] << 16);
                *(u32x2*)(tp + kg * 128 + 4 * tile) = w; } } }
    { bf16_t* vt16 = vt + (size_t)2 * 4 * 16 * 64 * SEQ; const int l0 = P0 >> 4, w32 = l0 & 31, tile = (w32 >> 4) & 1, kg = (w32 & 15) >> 2, grp = l0 >> 5;
#pragma unroll
        for (int r = 0; r < 16; ++r) { u32x2 w; w.x = v[r] | (v[16 + r] << 16); w.y = v[32 + r] | (v[48 + r] << 16);
            *(u32x2*)(vt16 + (((((size_t)bh * 16 + r) * 4 + grp) * 4 + nt) * 64 + kg * 16 + dl) * 8 + 4 * tile) = w; } }
}

struct AttnItem { int sh, r, lfirst, ks, tbo; size_t qk_off, v_off; };
__device__ __forceinline__ AttnItem attn_item(int it, int p0, int bh) {
    AttnItem I; const int br = it >> 4, j = it & 15; I.sh = 2 * br; I.tbo = br * 192;
    I.r = j & ((1 << I.sh) - 1); I.lfirst = (p0 >> I.sh) + 16 * (j >> I.sh);
    const size_t rc = (size_t)br * 4 * 16 * SEQ * 64 + ((size_t)(bh << I.sh) + I.r) * (size_t)(SEQ >> I.sh) * 64;
    I.qk_off = rc; I.v_off = rc;
    int ks = (I.lfirst - 128) & ~31; I.ks = ks < 0 ? 0 : ks;
    return I;
}
__device__ __forceinline__ void attn_unit(const Args& A, LAS unsigned char* lds, int unit, int tid, int wave, int lane, int pflags) {
    unsigned char* ws = A.ws;
    const int blk = 7 - (unit >> 6), bh = unit & 63, b = bh >> 4, h = bh & 15, p0 = blk * 256;
    constexpr int OST = 68;
    LAS float* Oacc = (LAS float*)lds; LAS float* lacc = (LAS float*)(lds + 256 * OST * 4); LAS float* tb = (LAS float*)(lds + 256 * OST * 4 + 1024);
    { const float* bt = (const float*)(ws + WS_BTAB) + h * 3 * 192; for (int i = tid; i < 3 * 192; i += 512) tb[i] = bt[i]; }
    __syncthreads();
    const bf16_t* QF = (const bf16_t*)(ws + WS_QF); const bf16_t* KF = (const bf16_t*)(ws + WS_KF); const bf16_t* VF = (const bf16_t*)(ws + WS_VT);
    const int qi = lane & 15, g = lane >> 4;
#define ATT_LOAD(IT, LK, B) do { const AttnItem _I = attn_item(IT, p0, bh); const bf16_t* _kp = KF + _I.qk_off + (size_t)((LK) >> 4) * 1024 + lane * 8; \
        B[0] = *(const u32x4*)(_kp); B[1] = *(const u32x4*)(_kp + 512); B[2] = *(const u32x4*)(_kp + 1024); B[3] = *(const u32x4*)(_kp + 1536); \
        const bf16_t* _vp = VF + _I.v_off + (size_t)((LK) >> 5) * 2048 + lane * 8; \
        B[4] = *(const u32x4*)(_vp); B[5] = *(const u32x4*)(_vp + 512); B[6] = *(const u32x4*)(_vp + 1024); B[7] = *(const u32x4*)(_vp + 1536); \
        const bf16_t* _qp = QF + _I.qk_off + (size_t)(_I.lfirst >> 4) * 1024 + lane * 8; B[8] = *(const u32x4*)(_qp); B[9] = *(const u32x4*)(_qp + 512); } while (0)
#define ATT_ADV(IT, LK, NIT, NLK) do { const AttnItem _J = attn_item(IT, p0, bh); if ((LK) + 32 <= _J.lfirst) { (NIT) = (IT); (NLK) = (LK) + 32; } else { (NIT) = (IT) + 8; (NLK) = 0; if ((NIT) < 48) { const AttnItem _N = attn_item(NIT, p0, bh); (NLK) = _N.ks; } } } while (0)
#define ATT_STEP(CIT, CLK, BC, NIT, NLK, NNIT, NNLK, BNN) { \
        NNIT = 64; NNLK = 0; \
        if ((NIT) < 48) { ATT_ADV(NIT, NLK, NNIT, NNLK); if ((NNIT) < 48) ATT_LOAD(NNIT, NNLK, BNN); } \
        const AttnItem cI = attn_item(CIT, p0, bh); \
        f32x4 sa = {0.f, 0.f, 0.f, 0.f}, sb = {0.f, 0.f, 0.f, 0.f}; \
        sa = MFMA16(as_bf16x8(BC[0]), as_bf16x8(BC[8]), sa); sb = MFMA16(as_bf16x8(BC[2]), as_bf16x8(BC[8]), sb); \
        sa = MFMA16(as_bf16x8(BC[1]), as_bf16x8(BC[9]), sa); sb = MFMA16(as_bf16x8(BC[3]), as_bf16x8(BC[9]), sb); \
        const LAS float* tbb = tb + cI.tbo; \
        const int ba = cI.lfirst + qi - (CLK) - 4 * g + 31; \
        float pa[4], pb[4]; \
        _Pragma("unroll") for (int e = 0; e < 4; ++e) { pa[e] = __builtin_amdgcn_exp2f(sa[e] + tbb[ba - e]); pb[e] = __builtin_amdgcn_exp2f(sb[e] + tbb[ba - 16 - e]); } \
        lsum += (pa[0] + pa[1]) + (pa[2] + pa[3]) + (pb[0] + pb[1]) + (pb[2] + pb[3]); \
        u32x4 pw; pw.x = cvt_pk_bf16(pa[0], pa[1]); pw.y = cvt_pk_bf16(pa[2], pa[3]); pw.z = cvt_pk_bf16(pb[0], pb[1]); pw.w = cvt_pk_bf16(pb[2], pb[3]); \
        const bf16x8 pf = as_bf16x8(pw); \
        _Pragma("unroll") for (int nt = 0; nt < 4; ++nt) o[nt] = MFMA16(pf, as_bf16x8(BC[4 + nt]), o[nt]); \
        if ((CLK) + 32 > cI.lfirst) {     \
            lsum += __shfl_xor(lsum, 16); lsum += __shfl_xor(lsum, 32); \
            const bool first = (CIT) < 16; \
            if (g == 0) { LAS float* lp = lacc + ((((cI.lfirst + qi) << cI.sh) + cI.r) - p0); *lp = first ? lsum : *lp + lsum; } \
            _Pragma("unroll") for (int reg = 0; reg < 4; ++reg) { LAS float* op = Oacc + (((((cI.lfirst + 4 * g + reg) << cI.sh) + cI.r) - p0)) * OST + qi; \
                _Pragma("unroll") for (int nt = 0; nt < 4; ++nt) op[16 * nt] = first ? o[nt][reg] : op[16 * nt] + o[nt][reg]; } \
            _Pragma("unroll") for (int nt = 0; nt < 4; ++nt) o[nt] = (f32x4){0.f, 0.f, 0.f, 0.f}; \
            lsum = 0.f; \
            if (((CIT) >> 3) & 1) __syncthreads();     \
        } \
        if ((NIT) >= 48) break; }
    if (!(pflags & 16)) {
    int itA = wave, lkA, itB, lkB, itC = 64, lkC = 0;
    { const AttnItem I0 = attn_item(wave, p0, bh); lkA = I0.ks; }
    ATT_ADV(itA, lkA, itB, lkB);
    u32x4 bA[10], bB[10], bC[10];
    ATT_LOAD(itA, lkA, bA); if (itB < 48) ATT_LOAD(itB, lkB, bB);
    f32x4 o[4];
#pragma unroll
    for (int nt = 0; nt < 4; ++nt) o[nt] = (f32x4){0.f, 0.f, 0.f, 0.f};
    float lsum = 0.f;
    for (;;) {
        ATT_STEP(itA, lkA, bA, itB, lkB, itC, lkC, bC)
        ATT_STEP(itB, lkB, bB, itC, lkC, itA, lkA, bA)
        ATT_STEP(itC, lkC, bC, itA, lkA, itB, lkB, bB)
    }
    }
#undef ATT_LOAD
#undef ATT_ADV
#undef ATT_STEP
    if (!(pflags & (16 | 32 | 64))) { const int ql = tid >> 1, half = tid & 1; const float inv = 1.0f / lacc[ql];
        bf16_t* dst = (bf16_t*)(ws + WS_MIXED) + (size_t)(b * SEQ + p0 + ql) * 2048 + h * 64 + 32 * half;
        float ss = 0.f;
#pragma unroll
        for (int c4 = 0; c4 < 4; ++c4) { float v[8];
#pragma unroll
            for (int e = 0; e < 8; ++e) { v[e] = Oacc[ql * OST + 32 * half + 8 * c4 + e] * inv; ss += v[e] * v[e]; }
            u32x4 w; w.x = cvt_pk_bf16(v[0], v[1]); w.y = cvt_pk_bf16(v[2], v[3]); w.z = cvt_pk_bf16(v[4], v[5]); w.w = cvt_pk_bf16(v[6], v[7]);
            *(u32x4*)(dst + 8 * c4) = w; }
        ss += __shfl_xor(ss, 1);
        if (half == 0) unsafeAtomicAdd((float*)(ws + WS_CTL + CTL_RSS_ATTN) + b * SEQ + p0 + ql, ss); }
    __syncthreads();
}

__device__ __forceinline__ unsigned fkey(float f) { const unsigned u = __float_as_uint(f); return (u & 0x80000000u) ? ~u : (u | 0x80000000u); }
template <int R> __device__ __forceinline__ void select16(const unsigned (&key)[R], unsigned long long (&m)[R]) {
    unsigned mx = key[0];
#pragma unroll
    for (int r = 1; r < R; ++r) mx = key[r] > mx ? key[r] : mx;
    mx = wave_umax(mx);
    unsigned lo = mx > (3u << 23) ? mx - (3u << 23) : 0u, hi = mx + 1u;
    int cnt = 0;
#pragma unroll
    for (int r = 0; r < R; ++r) cnt += __popcll(__ballot(key[r] >= lo));
    if (cnt < 16) { lo = 0u; cnt = R * 64; }
    while (cnt != 16 && hi - lo > 1u) { const unsigned mid = lo + ((hi - lo) >> 1); int c = 0;
#pragma unroll
        for (int r = 0; r < R; ++r) c += __popcll(__ballot(key[r] >= mid));
        if (c >= 16) { lo = mid; cnt = c; } else hi = mid; }
    const unsigned T = lo;
    if (cnt == 16) {
#pragma unroll
        for (int r = 0; r < R; ++r) m[r] = __ballot(key[r] >= T);
    } else {
        int need = 16;
#pragma unroll
        for (int r = 0; r < R; ++r) { m[r] = __ballot(key[r] > T); need -= __popcll(m[r]); }
#pragma unroll
        for (int r = 0; r < R; ++r) { unsigned long long eq = __ballot(key[r] == T);
            while (__popcll(eq) > need) eq &= ~(1ull << (63 - __builtin_clzll(eq)));
            need -= __popcll(eq); m[r] |= eq; }
    }
}
__device__ __forceinline__ void peer_topk(const float (&sv4)[4], LAS float* sc, LAS int* exo, LAS float* gto, int lane) {
    LAS float* v1 = sc; LAS int* i1 = (LAS int*)(sc + 16); LAS float* v2 = sc + 32; LAS int* i2 = (LAS int*)(sc + 48); LAS float* sv = sc + 64; LAS int* si = (LAS int*)(sc + 80);
    const unsigned long long lt = (1ull << lane) - 1ull;
#pragma unroll
    for (int half = 0; half < 2; ++half) {
        const float a0 = sv4[2 * half], a1 = sv4[2 * half + 1];
        const unsigned key[2] = {fkey(a0), fkey(a1)}; unsigned long long m[2];
        select16<2>(key, m);
        LAS float* vv = half ? v2 : v1; LAS int* ii = half ? i2 : i1;
        if ((m[0] >> lane) & 1ull) { const int pos = __popcll(m[0] & lt); vv[pos] = a0; ii[pos] = lane; }
        if ((m[1] >> lane) & 1ull) { const int pos = __popcll(m[0]) + __popcll(m[1] & lt); vv[pos] = a1; ii[pos] = 64 + lane; }
    }
    CBAR(); LDS_WAIT();
    const int a = lane >> 2, bb = (lane & 3) * 4;
    const float va = v1[a]; float cv[4]; unsigned key[4]; unsigned long long m[4];
#pragma unroll
    for (int e = 0; e < 4; ++e) { cv[e] = va + v2[bb + e]; key[e] = fkey(cv[e]); }
    select16<4>(key, m);
    int base = 0;
#pragma unroll
    for (int e = 0; e < 4; ++e) { if ((m[e] >> lane) & 1ull) { const int pos = base + __popcll(m[e] & lt); sv[pos] = cv[e]; si[pos] = a * 16 + bb + e; } base += __popcll(m[e]); }
    CBAR(); LDS_WAIT();
    if (lane < 16) {
        const float val = sv[lane]; const int fi = si[lane];
        const float mx = row16_fmax(val);
        const float ex = __expf(val - mx); const float sum = row16_fsum(ex);
        exo[lane] = i1[fi >> 4] * 128 + (i2[fi & 15] - 0);
        gto[lane] = ex / sum;
    }
    CBAR(); LDS_WAIT();
}

template <int I> __device__ __forceinline__ float ubyte_f32(unsigned w) { float f;
    if (I == 0) asm("v_cvt_f32_ubyte0 %0, %1" : "=v"(f) : "v"(w)); else if (I == 1) asm("v_cvt_f32_ubyte1 %0, %1" : "=v"(f) : "v"(w));
    else if (I == 2) asm("v_cvt_f32_ubyte2 %0, %1" : "=v"(f) : "v"(w)); else asm("v_cvt_f32_ubyte3 %0, %1" : "=v"(f) : "v"(w));
    return f; }
__device__ __forceinline__ void peer_wave(const Args& A, LAS unsigned char* lds, int wave, int lane, int pflags) {
    unsigned char* ws = A.ws;
    const float* scores = (const float*)(ws + WS_PROJ);
    const unsigned char* uv = ws + WS_UB; const bf16_t* x1b = (const bf16_t*)(ws + WS_HB);
    const float* su = (const float*)(ws + WS_SU); const float* sv = (const float*)(ws + WS_SV);
    const float* rssx = (const float*)(ws + WS_CTL + CTL_RSS_X1);
    LAS int* exl = (LAS int*)(lds + wave * 4096);
    LAS float* gtl = (LAS float*)(lds + wave * 4096 + 2048);
    LAS float* sc = (LAS float*)(lds + 32768 + wave * 512);
    LAS float* cul = (LAS float*)(lds + 40960 + wave * 1024);
    const int t0 = (blockIdx.x * 8 + wave) * 4;
    if (t0 >= NTOK) return;
#define LOAD_SCORES_L(dst, t, h, ln) do { const float* _sp = scores + (size_t)(t) * 2048 + (h) * 256 + (ln); dst[0] = _sp[0]; dst[1] = _sp[64]; dst[2] = _sp[128]; dst[3] = _sp[192]; } while (0)
#define LOAD_SCORES(dst, t, h) LOAD_SCORES_L(dst, t, h, lane)
    { float nx[4]; LOAD_SCORES(nx, t0, 0);
#pragma unroll 1
        for (int h = 0; h < 8; ++h) { const float cs[4] = {nx[0], nx[1], nx[2], nx[3]};
            if (h < 7) LOAD_SCORES(nx, t0, h + 1);
            peer_topk(cs, sc, exl + h * 16, gtl + h * 16, lane); } }
    CBAR(); LDS_WAIT();
    if (pflags & 256) return;
    int ex0 = exl[lane], ex1 = exl[64 + lane];
    float rss = rssx[t0], su0 = su[ex0], su1 = su[ex1], sv0 = sv[ex0], sv1 = sv[ex1];
    float sn[4] = {0.f, 0.f, 0.f, 0.f};
    LOAD_SCORES(sn, t0 + 1, 0);
    u32x4 bu[8], bv[8];
    LAS u32x4* vls = (LAS u32x4*)(lds + 49152 + wave * 8192);
#define ISSUE_E(slot, e0r, e1r, k) do { const int _e = __builtin_amdgcn_readlane((k) < 64 ? (e0r) : (e1r), (k) & 63); \
        const unsigned char* _p = uv + (size_t)_e * 2048 + 16 * lane; bu[slot] = *(const u32x4*)_p; bv[slot] = *(const u32x4*)(_p + 1024); } while (0)
#pragma unroll
    for (int i = 0; i < 8; ++i) ISSUE_E(i, ex0, ex1, i);
    float acc[32];
    u32x4 xr4[4];
#pragma unroll
    for (int v4 = 0; v4 < 4; ++v4) xr4[v4] = *(const u32x4*)(x1b + (size_t)t0 * 2048 + 16 * lane + 1024 * (v4 >> 1) + 8 * (v4 & 1));
#pragma unroll 1
    for (int tok = 0; tok < 4; ++tok) {
        const int t = t0 + tok;
        int lz = lane; asm volatile("" : "+v"(lz));
        unsigned xq[8]; float sx; int xsum;
        {
            float m = 0.f;
#pragma unroll
            for (int v4 = 0; v4 < 4; ++v4) { const unsigned rw[4] = {xr4[v4].x, xr4[v4].y, xr4[v4].z, xr4[v4].w};
#pragma unroll
                for (int e = 0; e < 4; ++e) m = fmaxf(m, fmaxf(fabsf(bflo(rw[e])), fabsf(bfhi(rw[e])))); }
            m = fmaxf(wave_max(m), 1e-30f);
            const float inv = 127.f / m; sx = m * (1.f / 127.f);
            int ls = 0;
#pragma unroll
            for (int v4 = 0; v4 < 4; ++v4) { const unsigned rw[4] = {xr4[v4].x, xr4[v4].y, xr4[v4].z, xr4[v4].w};
#pragma unroll
                for (int h2 = 0; h2 < 2; ++h2) { const int a = (int)rintf(bflo(rw[2 * h2]) * inv), b = (int)rintf(bfhi(rw[2 * h2]) * inv), c = (int)rintf(bflo(rw[2 * h2 + 1]) * inv), e = (int)rintf(bfhi(rw[2 * h2 + 1]) * inv);
                    ls += (a + b) + (c + e);
                    xq[2 * v4 + h2] = (unsigned)(a & 255) | ((unsigned)(b & 255) << 8) | ((unsigned)(c & 255) << 16) | ((unsigned)(e & 255) << 24); } }
#pragma unroll
            for (int o = 1; o < 64; o <<= 1) ls += __shfl_xor(ls, o);
            xsum = ls;
            asm volatile("" ::: "memory");
#pragma unroll
            for (int v4 = 0; v4 < 4; ++v4) { const unsigned rw[4] = {xr4[v4].x, xr4[v4].y, xr4[v4].z, xr4[v4].w};
#pragma unroll
                for (int e = 0; e < 4; ++e) { acc[8 * v4 + 2 * e] = bflo(rw[e]); acc[8 * v4 + 2 * e + 1] = bfhi(rw[e]); } } }
        const float ascale = sx / sqrtf(rss * (1.f / 2048.f) + EPS);
        cul[lz] = ascale * su0; cul[64 + lz] = ascale * su1;
        cul[128 + lz] = 2.f * gtl[tok * 128 + lz] * sv0; cul[192 + lz] = 2.f * gtl[tok * 128 + 64 + lz] * sv1;
        CBAR(); LDS_WAIT();
        float wsum = 0.f;
        int nex0 = ex0, nex1 = ex1; float nrss = 1.f, nsu0 = 0.f, nsu1 = 0.f, nsv0 = 0.f, nsv1 = 0.f;
#pragma unroll 1
        for (int k0 = 0; k0 < 128; k0 += 8) {
            if (tok < 3 && k0 == 120) {
                nex0 = exl[(tok + 1) * 128 + lz]; nex1 = exl[(tok + 1) * 128 + 64 + lz];
                nrss = rssx[t + 1]; nsu0 = su[nex0]; nsu1 = su[nex1]; nsv0 = sv[nex0]; nsv1 = sv[nex1];
#pragma unroll
                for (int v4 = 0; v4 < 4; ++v4) xr4[v4] = *(const u32x4*)(x1b + (size_t)(t + 1) * 2048 + 16 * lz + 1024 * (v4 >> 1) + 8 * (v4 & 1));
                if (tok < 2) LOAD_SCORES_L(sn, t + 2, 0, lz); }
            int p[8];
#pragma unroll
            for (int i = 0; i < 8; ++i) { int ac = 0;
                const unsigned w4[4] = {bu[i].x, bu[i].y, bu[i].z, bu[i].w};
#pragma unroll
                for (int e = 0; e < 4; ++e) { ac = __builtin_amdgcn_sdot4((int)(w4[e] & 0x0F0F0F0Fu), (int)xq[e], ac, false); ac = __builtin_amdgcn_sdot4((int)((w4[e] >> 4) & 0x0F0F0F0Fu), (int)xq[4 + e], ac, false); }
                p[i] = ac; vls[i * 64 + lane] = bv[i]; }
            { const bool nxt = (k0 + 8) >= 128;
              const int kb = (k0 + 8) & 127; const int sel = nxt ? (kb < 64 ? nex0 : nex1) : (kb < 64 ? ex0 : ex1);
#pragma unroll
              for (int i = 0; i < 8; ++i) { const int _e = __builtin_amdgcn_readlane(sel, (kb & 63) + i);
                  const unsigned char* _p = uv + (size_t)_e * 2048 + 16 * lane; bu[i] = *(const u32x4*)_p; bv[i] = *(const u32x4*)(_p + 1024); } }
            float wcur;
            { const bool b0 = lane & 1, b1 = lane & 2, b2 = lane & 4;
            int q4[4], q2[2], q1;
#pragma unroll
            for (int i = 0; i < 4; ++i) { const int keep = b0 ? p[i + 4] : p[i], send = b0 ? p[i] : p[i + 4]; q4[i] = keep + __shfl_xor(send, 1); }
#pragma unroll
            for (int i = 0; i < 2; ++i) { const int keep = b1 ? q4[i + 2] : q4[i], send = b1 ? q4[i] : q4[i + 2]; q2[i] = keep + __shfl_xor(send, 2); }
            { const int keep = b2 ? q2[1] : q2[0], send = b2 ? q2[0] : q2[1]; q1 = keep + __shfl_xor(send, 4); }
            q1 += __shfl_xor(q1, 8); q1 += __shfl_xor(q1, 16); q1 += __shfl_xor(q1, 32);
            const int k = (k0 + 4 * (lane & 1) + 2 * ((lane >> 1) & 1) + ((lane >> 2) & 1)) & 127;
            const float a = (float)(2 * q1 - 15 * xsum) * cul[k];
            wcur = cul[128 + k] * gelu_as(a); }
            CBAR();
#pragma unroll 1
            for (int i = 0; i < 8; ++i) { const int rl = ((i & 1) << 2) | (i & 2) | ((i >> 2) & 1);
                const float w = __builtin_bit_cast(float, __builtin_amdgcn_readlane(__builtin_bit_cast(int, wcur), rl));
                wsum += w;
                const u32x4 vv = vls[i * 64 + lane];
                const unsigned w4[4] = {vv.x, vv.y, vv.z, vv.w};
                const float w16 = w * 0.0625f;
#pragma unroll
                for (int e = 0; e < 4; ++e) { const unsigned lo = w4[e] & 0x0F0F0F0Fu, hi = w4[e] & 0xF0F0F0F0u;
                    acc[4 * e + 0] += w * ubyte_f32<0>(lo); acc[4 * e + 1] += w * ubyte_f32<1>(lo); acc[4 * e + 2] += w * ubyte_f32<2>(lo); acc[4 * e + 3] += w * ubyte_f32<3>(lo);
                    acc[16 + 4 * e + 0] += w16 * ubyte_f32<0>(hi); acc[16 + 4 * e + 1] += w16 * ubyte_f32<1>(hi); acc[16 + 4 * e + 2] += w16 * ubyte_f32<2>(hi); acc[16 + 4 * e + 3] += w16 * ubyte_f32<3>(hi); } }
            CBAR();
            if (tok < 3 && !(k0 & 8)) { const int hh = k0 >> 4;
                const float cs[4] = {sn[0], sn[1], sn[2], sn[3]};
                if (hh < 7) LOAD_SCORES_L(sn, t + 1, hh + 1, lz);
                peer_topk(cs, sc, exl + (tok + 1) * 128 + hh * 16, gtl + (tok + 1) * 128 + hh * 16, lane); }
        }
        const float corr = -7.5f * wsum;
        float* op = A.out + (size_t)t * 2048 + 16 * lz;
        if (!(pflags & 128)) {
#pragma unroll
        for (int j = 0; j < 2; ++j)
#pragma unroll
            for (int c4 = 0; c4 < 4; ++c4) { const int a0 = 16 * j + 4 * c4;
                *(f32x4*)(op + 1024 * j + 4 * c4) = (f32x4){acc[a0] + corr, acc[a0 + 1] + corr, acc[a0 + 2] + corr, acc[a0 + 3] + corr}; }
        } else if (corr == 12345.678f) op[0] = acc[0];
        ex0 = nex0; ex1 = nex1; rss = nrss; su0 = nsu0; su1 = nsu1; sv0 = nsv0; sv1 = nsv1;
    }
#undef ISSUE_E
#undef LOAD_SCORES
#undef LOAD_SCORES_L
}

__global__ void __launch_bounds__(512, 2) mk_fwd(Args args) {
    extern __shared__ __attribute__((aligned(16))) unsigned char lds_raw[];
    LAS unsigned char* lds = (LAS unsigned char*)lds_raw;
    const int tid = threadIdx.x, lane = tid & 63, wave = __builtin_amdgcn_readfirstlane(tid >> 6);
    volatile LAS unsigned* MISC = (volatile LAS unsigned*)(lds + MISC_OFF);
    if (tid < 64) MISC[tid] = 0u;
    __syncthreads();
    unsigned char* ws = args.ws;
    const int lo = args.ph_lo, hi = args.ph_hi & 0xff, pflags = args.ph_hi >> 8;
    XcdBarrier bar; bar.bar = (unsigned*)(ws + WS_CTL); bar.x = 0; bar.st = nullptr;
    if (hi - lo > 1) bar = xcd_barrier_post((unsigned*)(ws + WS_CTL), MISC + 8);
#ifndef PH_MASK
#define PH_MASK 0x7f
#endif
#define IN(k) (((PH_MASK >> (k)) & 1) && lo <= (k) && (k) < hi)
#define SEAM(k) do { if (IN(k) && IN((k) + 1)) xcd_barrier(bar); } while (0)

    if (IN(0)) { p0_prologue(args, lds, wave, lane, pflags); }
    SEAM(0);
    if (IN(1)) {
        pg8::Gemm g{(const bf16_t*)(ws + WS_HB), (const bf16_t*)(ws + WS_WINT), NTOK, DPROJ, DM}; pg8::StaticOrder S; S.init(NTOK, DPROJ, gridDim.x, (int)blockIdx.x);
        pg8::EpiProj E{(bf16_t*)(ws + WS_PROJ), DPROJ};
        pg8::gemm_phase<pg8::EpiProj, pg8::StaticOrder, false>(lds, g, S, E, nullptr);
    }
    SEAM(1);
    if (IN(2)) {
        const bool prep_first = blockIdx.x & 1;
        if (prep_first && !(pflags & 8)) { for (int it = blockIdx.x * 8 + wave; it < 2048; it += gridDim.x * 8) prep2_item(args, lds + wave * SSM_WL, it, lane); __syncthreads(); }
        if (!(pflags & 4)) for (int u = blockIdx.x; u < 256; u += gridDim.x) ssm_unit(args, lds, u >> 6, u & 63, wave, lane);
        if (!prep_first && !(pflags & 8)) for (int it = blockIdx.x * 8 + wave; it < 2048; it += gridDim.x * 8) prep2_item(args, lds + wave * SSM_WL, it, lane);
    }
    SEAM(2);
    if (IN(3)) {
        if (!(pflags & 2)) {
            pg8::Gemm g{(const bf16_t*)(ws + WS_YB), (const bf16_t*)(ws + WS_GLUT), NTOK, 1024, 1024}; pg8::StaticOrder S; S.init(NTOK, 1024, gridDim.x, (int)blockIdx.x);
            pg8::EpiGlu E{(const bf16_t*)(ws + WS_YB), (bf16_t*)(ws + WS_MIXED) + 1024, args.in[15], (float*)(ws + WS_CTL + CTL_RSS_SSM)};
            pg8::gemm_phase<pg8::EpiGlu, pg8::StaticOrder, false>(lds, g, S, E, nullptr);
        }
        __syncthreads();
        if (!(pflags & 1)) for (;;) {
            if (tid == 0) MISC[0] = atomicAdd((unsigned*)(ws + WS_CTL + CTL_QCTR), 1u);
            __syncthreads();
            const unsigned u = MISC[0];
            __syncthreads();
            if (u < 512u) attn_unit(args, lds, (int)u, tid, wave, lane, pflags);
            unsigned c = 0u;
            for (int rep = 0; rep < 2; ++rep) {
                if (tid == 0) MISC[1] = atomicAdd((unsigned*)(ws + WS_CTL + CTL_QCTR2), 1u);
                __syncthreads();
                c = MISC[1];
                __syncthreads();
                if (c < 1024u) table_chunk(args, (int)c, wave, lane); else break;
            }
            if (u >= 512u && c >= 1024u) break;
        }
    }
    SEAM(3);
    if (IN(4)) {
        pg8::Gemm g{(const bf16_t*)(ws + WS_MIXED), (const bf16_t*)(ws + WS_WOUTT), NTOK, DM, DM}; pg8::StaticOrder S; S.init(NTOK, DM, gridDim.x, (int)blockIdx.x);
        LAS float* tab = (LAS float*)(lds + 131072);
        { pg8::Unit u0; if (S.next(0, u0) && tid < 256) { const int row = u0.pm * 256 + tid;
            const float ra = 1.0f / sqrtf(((const float*)(ws + WS_CTL + CTL_RSS_ATTN))[row] * (1.f / 1024.f) + EPS), rs = 1.0f / sqrtf(((const float*)(ws + WS_CTL + CTL_RSS_SSM))[row] * (1.f / 1024.f) + EPS);
            tab[tid] = ra / rs; tab[256 + tid] = rs; } }
        __syncthreads();
        pg8::EpiWout E{args.in[0], args.out, (bf16_t*)(ws + WS_HB), (float*)(ws + WS_CTL + CTL_RSS_X1), tab};
        pg8::gemm_phase<pg8::EpiWout, pg8::StaticOrder, false>(lds, g, S, E, nullptr);
    }
    SEAM(4);
    if (IN(5)) {
        pg8::Gemm g{(const bf16_t*)(ws + WS_HB), (const bf16_t*)(ws + WS_WPT), NTOK, DM, DM}; pg8::StaticOrder S; S.init(NTOK, DM, gridDim.x, (int)blockIdx.x);
        pg8::EpiScores E{(float*)(ws + WS_PROJ), (const float*)(ws + WS_CTL + CTL_RSS_X1)};
        pg8::gemm_phase<pg8::EpiScores, pg8::StaticOrder, false>(lds, g, S, E, nullptr);
    }
    SEAM(5);
    if (IN(6)) { peer_wave(args, lds, wave, lane, pflags); }
#undef IN
#undef SEAM
}

#ifndef MK_DEBUG
#ifndef MK_PER_PHASE
#define MK_PER_PHASE 0
#endif
extern "C" void kernel_launch(void* const* d_in, const int* in_sizes, int n_in, void* d_out, int out_size, void* d_ws, size_t ws_size, hipStream_t stream) {
    static int grid = 0;
    if (grid == 0) {
        if (n_in != 25 || out_size != NTOK * DM || ws_size < WS_END) { fprintf(stderr, "kernel_launch: unexpected shapes / workspace (%d inputs, out %d, ws %zu < %zu)\n", n_in, out_size, ws_size, (size_t)WS_END); grid = -1; return; }
        int dev = 0, cus = 0, per_cu = 0;
        if (hipGetDevice(&dev) != hipSuccess || hipDeviceGetAttribute(&cus, hipDeviceAttributeMultiprocessorCount, dev) != hipSuccess) { grid = -1; return; }
        if (hipFuncSetAttribute((const void*)mk_fwd, hipFuncAttributeMaxDynamicSharedMemorySize, LDS_BYTES) != hipSuccess) { fprintf(stderr, "kernel_launch: hipFuncSetAttribute failed\n"); grid = -1; return; }
        if (hipOccupancyMaxActiveBlocksPerMultiprocessor(&per_cu, (const void*)mk_fwd, 512, LDS_BYTES) != hipSuccess || per_cu < 1) { fprintf(stderr, "kernel_launch: occupancy query reports %d\n", per_cu); }
        (void)hipGetLastError();
        grid = cus;
    }
    if (grid < 0) return;
    (void)hipMemsetAsync((char*)d_ws + WS_CTL, 0, CTL_BYTES, stream);
    Args a{};
    for (int i = 0; i < 25; ++i) a.in[i] = (const float*)d_in[i];
    a.out = (float*)d_out; a.ws = (unsigned char*)d_ws;
#if MK_PER_PHASE
#ifndef MK_DUP
#define MK_DUP -1
#endif
    for (int p = 0; p < 7; ++p) { a.ph_lo = p; a.ph_hi = p + 1; hipLaunchKernelGGL(mk_fwd, dim3(grid), dim3(512), LDS_BYTES, stream, a);
        if (p == MK_DUP) {
            (void)hipMemsetAsync((char*)d_ws + WS_CTL + CTL_QCTR, 0, 512, stream);
#ifndef MK_DUP_FLAGS
#define MK_DUP_FLAGS 0
#endif
            if (p == 3 && !((MK_DUP_FLAGS) & (1 | 16 | 32 | 64))) (void)hipMemsetAsync((char*)d_ws + WS_CTL + CTL_RSS_ATTN, 0, 32768, stream);
            if (p == 3 && !((MK_DUP_FLAGS) & 2)) (void)hipMemsetAsync((char*)d_ws + WS_CTL + CTL_RSS_SSM, 0, 32768, stream);
            if (p == 4) (void)hipMemsetAsync((char*)d_ws + WS_CTL + CTL_RSS_X1, 0, 32768, stream);
            a.ph_hi |= (MK_DUP_FLAGS) << 8;
            hipLaunchKernelGGL(mk_fwd, dim3(grid), dim3(512), LDS_BYTES, stream, a); } }
#else
    a.ph_lo = 0; a.ph_hi = 7;
    hipLaunchKernelGGL(mk_fwd, dim3(grid), dim3(512), LDS_BYTES, stream, a);
#endif
}
#endif
```

```cpp
#include <hip/hip_runtime.h>
#include <stdint.h>
#include <stdio.h>

typedef unsigned short bf16_t;
typedef float f32x2 __attribute__((ext_vector_type(2)));
typedef unsigned u32x2 __attribute__((ext_vector_type(2)));
using bf16x2v = __attribute__((ext_vector_type(2))) __bf16;

constexpr int NTOK = 8192, SEQ = 2048, DM = 2048, DPROJ = 4096;
constexpr float EPS = 1e-6f;
constexpr float LOG2E = 1.4426950408889634f;

constexpr size_t MB = 1024 * 1024;
constexpr size_t WS_CTL = 0;
constexpr size_t CTL_BYTES = 128 * 1024;
constexpr size_t CTL_QCTR = 16384;
constexpr size_t CTL_QCTR2 = 16384 + 256;
constexpr size_t CTL_RSS_ATTN = 32768, CTL_RSS_SSM = 65536, CTL_RSS_X1 = 98304;
constexpr size_t WS_HB = 256 * 1024;
constexpr size_t WS_WINT = WS_HB + 32 * MB;
constexpr size_t WS_GLUT = WS_WINT + 16 * MB;
constexpr size_t WS_WOUTT = WS_GLUT + 2 * MB;
constexpr size_t WS_WPT = WS_WOUTT + 8 * MB;
constexpr size_t WS_UB = WS_WPT + 8 * MB;
constexpr size_t WS_VB = WS_UB + 32 * MB;
constexpr size_t WS_SU = WS_VB + 32 * MB;
constexpr size_t WS_SV = WS_SU + 65536;
constexpr size_t WS_PROJ = WS_SV + 65536;
constexpr size_t WS_QF = WS_PROJ + 64 * MB;
constexpr size_t WS_KF = WS_QF + 48 * MB;
constexpr size_t WS_VT = WS_KF + 48 * MB;
constexpr size_t WS_QN = WS_QF, WS_KN = WS_KF;
constexpr size_t WS_YB = WS_VT + 48 * MB + 4096;
constexpr size_t WS_MIXED = WS_YB + 16 * MB;
constexpr size_t WS_SSMP = WS_MIXED + 32 * MB;
constexpr size_t SSMP_ABAR = 0, SSMP_A256 = 32768, SSMP_BFRAG = 65536, SSMP_CFRAG = 65536 + 524288;
constexpr size_t SSMP_BBT = 1 * MB;
constexpr size_t SSMP_VAND = 2 * MB;
constexpr size_t WS_BTAB = WS_SSMP + 8 * MB;
constexpr size_t WS_END = WS_BTAB + 64 * 1024;

constexpr int LDS_BYTES = 147456;
constexpr int MISC_OFF = 147456 - 256;
#define XB_TMO      128
#define XB_XCNT(j)  (256  + 64 * (j))
#define XB_XSUB(j)  (1280 + 64 * (j))
#define XB_XGEN(j)  (2304 + 64 * (j))
#define XB_TOP      3328
#define XB_TOPGEN   3392
#define XCD_BAR_WORDS 3456
#define XB_SPIN_CAP (1u << 18)
#define LAS __attribute__((address_space(3)))

__device__ __forceinline__ unsigned xb_ld(unsigned* p)              { return __hip_atomic_load(p, __ATOMIC_RELAXED, __HIP_MEMORY_SCOPE_AGENT); }
__device__ __forceinline__ unsigned xb_add(unsigned* p, unsigned v) { return __hip_atomic_fetch_add(p, v, __ATOMIC_RELAXED, __HIP_MEMORY_SCOPE_AGENT); }
__device__ __forceinline__ unsigned xb_xcc_id() { return (unsigned)__builtin_amdgcn_s_getreg((3 << 11) | 20) & 0xFu; }
#define XB_SPIN(cond, bar) do { unsigned _sp = 0; while (cond) { __builtin_amdgcn_s_sleep(1); \
    if ((++_sp & 255u) == 0u) { if (xb_ld(&(bar)[XB_TMO])) break; if (_sp > XB_SPIN_CAP) { atomicAdd(&(bar)[XB_TMO], 1u); break; } } } } while (0)

struct XcdBarrier {
    unsigned* bar; unsigned x;
    volatile LAS unsigned* st;
};

__device__ __forceinline__ XcdBarrier xcd_barrier_post(unsigned* bar, volatile LAS unsigned* st) {
    XcdBarrier b; b.bar = bar; b.x = xb_xcc_id(); b.st = st;
    if (threadIdx.x == 0) (void)xb_add(&bar[XB_XCNT(b.x)], 1u);
    return b;
}
__device__ __forceinline__ void xcd_barrier_complete(unsigned* bar, unsigned x, unsigned& nloc, unsigned& nx) {
    const unsigned G = gridDim.x * gridDim.y * gridDim.z;
    unsigned sum, cnt, mine, sp = 0u;
    for (;;) {
        sum = 0u; cnt = 0u; mine = 0u;
#pragma unroll
        for (unsigned j = 0; j < 16; ++j) { const unsigned c = xb_ld(&bar[XB_XCNT(j)]); sum += c; cnt += (c > 0u) ? 1u : 0u; mine = (j == x) ? c : mine; }
        if (sum == G) break;
        __builtin_amdgcn_s_sleep(1);
        if ((++sp & 255u) == 0u) { if (xb_ld(&bar[XB_TMO])) break; if (sp > XB_SPIN_CAP) { atomicAdd(&bar[XB_TMO], 1u); break; } }
    }
    nloc = mine > 0u ? mine : 1u; nx = cnt > 0u ? cnt : 1u;
}

__device__ __forceinline__ void xcd_barrier(const XcdBarrier& b) {
    asm volatile("s_waitcnt vmcnt(0)" ::: "memory");
    __syncthreads();
    if (threadIdx.x == 0) {
        unsigned* bar = b.bar;
        __builtin_amdgcn_s_waitcnt(0);
        unsigned nloc = b.st[0], nx = b.st[1];
        if (nloc == 0u) { xcd_barrier_complete(bar, b.x, nloc, nx); b.st[0] = nloc; b.st[1] = nx; }
        const unsigned old = xb_add(&bar[XB_XSUB(b.x)], 1u);
        const unsigned gen = old / nloc;
        if (old + 1u == (gen + 1u) * nloc) {
            __builtin_amdgcn_fence(__ATOMIC_RELEASE, "agent");
            asm volatile("s_waitcnt vmcnt(0)" ::: "memory");
            const unsigned og = xb_add(&bar[XB_TOP], 1u);
            const unsigned tg = og / nx;
            if (og + 1u == (tg + 1u) * nx) xb_add(&bar[XB_TOPGEN], 1u);
            else XB_SPIN(xb_ld(&bar[XB_TOPGEN]) == tg, bar);
            __builtin_amdgcn_fence(__ATOMIC_ACQUIRE, "agent");
            xb_add(&bar[XB_XGEN(b.x)], 1u);
            asm volatile("s_waitcnt vmcnt(0)" ::: "memory");
        } else {
            XB_SPIN(xb_ld(&bar[XB_XGEN(b.x)]) == gen, bar);
            __builtin_amdgcn_fence(__ATOMIC_ACQUIRE, "agent");
            asm volatile("s_waitcnt vmcnt(0)" ::: "memory");
        }
    }
    __syncthreads();
}
namespace pg8 {
#define PG8_LAS __attribute__((address_space(3)))
typedef unsigned short bf16_t;
typedef short bf16x8 __attribute__((ext_vector_type(8)));
typedef float f32x4 __attribute__((ext_vector_type(4)));
typedef unsigned u32x4 __attribute__((ext_vector_type(4)));
constexpr int BM = 256, BK = 64, HALF = 128, HTB = HALF * BK * 2  , STAGE_BYTES = 8 * HTB, NXCD = 8, WGM = 8;

__host__ __device__ __forceinline__ int lds_byte(int r, int c) { const int st = (r >> 4) * 2 + (c >> 5), rr = r & 15, cc = c & 31, ob = rr * 64 + cc * 2; return st * 1024 + (ob ^ (((ob >> 9) & 1) << 5)); }
__host__ __device__ __forceinline__ void stage_rc(int b, int& R, int& C) { const int st = b / 1024, sb = b % 1024, swz = sb ^ (((sb >> 9) & 1) << 5); R = (st >> 1) * 16 + swz / 64; C = (st & 1) * 32 + (swz % 64) / 2; }
__host__ __device__ __forceinline__ int perm32(int rho) { const int n = rho >> 4, i = rho & 15; return 8 * (i >> 2) + 4 * n + (i & 3); }

struct Unit { int pm, pn; };
struct Gemm { const bf16_t* A; const bf16_t* Bt; int M, N, K; };

struct StaticOrder {
    int nM, nN, nwg, G, c;
    __host__ __device__ void init(int M, int N, int G_, int c_) { nM = M / BM; nN = N / BM; nwg = nM * nN; G = G_; c = c_; }
    __host__ __device__ bool next(int i, Unit& u) const {
        const long L = (long)i * G + c; if (L >= nwg) return false;
        int wgid = (int)L; { const int q = nwg / NXCD, r = nwg % NXCD, xcd = wgid % NXCD, off = wgid / NXCD; wgid = (xcd < r ? xcd * (q + 1) : r * (q + 1) + (xcd - r) * q) + off; }
        const int nig = WGM * nN, gid = wgid / nig, fm = gid * WGM, gsz = (nM - fm) < WGM ? (nM - fm) : WGM;
        u.pm = fm + ((wgid % nig) % gsz); u.pn = (wgid % nig) / gsz; return true;
    }
    __device__ __forceinline__ void a_ready(const Unit&) const {}
    __device__ __forceinline__ void done(const Unit&) const {}
};
typedef float cvt_f32x2 __attribute__((ext_vector_type(2)));
typedef __bf16 cvt_bf16x2 __attribute__((ext_vector_type(2)));
__device__ __forceinline__ unsigned cvt_pk_bf16(float lo, float hi) { return __builtin_bit_cast(unsigned, __builtin_convertvector((cvt_f32x2){lo, hi}, cvt_bf16x2)); }
__device__ __forceinline__ float bflo(unsigned u) { return __uint_as_float(u << 16); }
__device__ __forceinline__ float bfhi(unsigned u) { return __uint_as_float(u & 0xffff0000u); }

struct EpiProj {
    static constexpr bool PERM = true, AFTER_DRAIN = false, HAS_MID = false;
    bf16_t* O; int ldc;
    __device__ __forceinline__ void mid(f32x4 (&)[2][2][4][2], const Unit&, int, int, int, int) const {}
    __device__ __forceinline__ void operator()(const f32x4 (&acc)[2][2][4][2], const Unit& u, int wr, int wc, int fr, int fq) const {
        const int row0 = u.pm * BM + wr * 64 + fr, col0 = u.pn * BM + wc * 32 + 8 * fq;
#pragma unroll
        for (int ai = 0; ai < 2; ++ai)
#pragma unroll
            for (int m = 0; m < 4; ++m) { bf16_t* rowp = O + (size_t)(row0 + ai * HALF + m * 16) * ldc + col0;
#pragma unroll
                for (int bj = 0; bj < 2; ++bj) { const f32x4 v0 = acc[ai][bj][m][0], v1 = acc[ai][bj][m][1];
                    u32x4 w; w.x = cvt_pk_bf16(v0[0], v0[1]); w.y = cvt_pk_bf16(v0[2], v0[3]); w.z = cvt_pk_bf16(v1[0], v1[1]); w.w = cvt_pk_bf16(v1[2], v1[3]);
                    *(u32x4*)(rowp + bj * HALF) = w; } }
    }
};

struct EpiGlu {
    static constexpr bool PERM = true, AFTER_DRAIN = false, HAS_MID = false;
    const bf16_t* Y; bf16_t* O; const float* bias; float* rss;
    __device__ __forceinline__ void mid(f32x4 (&)[2][2][4][2], const Unit&, int, int, int, int) const {}
    __device__ __forceinline__ void operator()(const f32x4 (&acc)[2][2][4][2], const Unit& u, int wr, int wc, int fr, int fq) const {
        const int row0 = u.pm * BM + wr * 64 + fr, col0 = u.pn * BM + wc * 32 + 8 * fq;
        f32x4 bv[2][2];
#pragma unroll
        for (int bj = 0; bj < 2; ++bj)
#pragma unroll
            for (int n = 0; n < 2; ++n) bv[bj][n] = *(const f32x4*)(bias + col0 + bj * HALF + 4 * n);
        u32x4 yq[2][2];
#pragma unroll
        for (int bj = 0; bj < 2; ++bj) yq[0][bj] = *(const u32x4*)(Y + (size_t)row0 * 1024 + col0 + bj * HALF);
#pragma unroll
        for (int idx = 0; idx < 8; ++idx) { const int ai = idx >> 2, m = idx & 3, row = row0 + ai * HALF + m * 16; float ss = 0.f;
            if (idx < 7) { const int nrow = row0 + ((idx + 1) >> 2) * HALF + ((idx + 1) & 3) * 16;
#pragma unroll
                for (int bj = 0; bj < 2; ++bj) yq[(idx + 1) & 1][bj] = *(const u32x4*)(Y + (size_t)nrow * 1024 + col0 + bj * HALF); }
#pragma unroll
            for (int bj = 0; bj < 2; ++bj) {
                const u32x4 yv = yq[idx & 1][bj];
                const f32x4 g0 = acc[ai][bj][m][0] + bv[bj][0], g1 = acc[ai][bj][m][1] + bv[bj][1];
                float y[8] = {bflo(yv.x), bfhi(yv.x), bflo(yv.y), bfhi(yv.y), bflo(yv.z), bfhi(yv.z), bflo(yv.w), bfhi(yv.w)};
                float o[8];
#pragma unroll
                for (int e = 0; e < 4; ++e) { o[e] = y[e] * __builtin_amdgcn_rcpf(1.f + __expf(-g0[e])); o[4 + e] = y[4 + e] * __builtin_amdgcn_rcpf(1.f + __expf(-g1[e])); }
#pragma unroll
                for (int e = 0; e < 8; ++e) ss += o[e] * o[e];
                u32x4 w; w.x = cvt_pk_bf16(o[0], o[1]); w.y = cvt_pk_bf16(o[2], o[3]); w.z = cvt_pk_bf16(o[4], o[5]); w.w = cvt_pk_bf16(o[6], o[7]);
                *(u32x4*)(O + (size_t)row * 2048 + col0 + bj * HALF) = w; }
            ss += __shfl_xor(ss, 16); ss += __shfl_xor(ss, 32);
            if (fq == 0) unsafeAtomicAdd(rss + row, ss); }
    }
};

struct EpiWout {
    static constexpr bool PERM = true, AFTER_DRAIN = false, HAS_MID = true;
    const float* X; float* OUT; bf16_t* XB; float* rss_x; const PG8_LAS float* tab;
    __device__ __forceinline__ void mid(f32x4 (&acc)[2][2][4][2], const Unit& u, int wr, int wc, int fr, int fq) const {
        const PG8_LAS float* tp = tab + wr * 64 + fr;
#pragma unroll
        for (int ai = 0; ai < 2; ++ai)
#pragma unroll
            for (int m = 0; m < 4; ++m) { const float ratio = tp[ai * HALF + m * 16];
#pragma unroll
                for (int bj = 0; bj < 2; ++bj)
#pragma unroll
                    for (int n = 0; n < 2; ++n) acc[ai][bj][m][n] *= ratio; }
    }
    __device__ __forceinline__ void operator()(const f32x4 (&acc)[2][2][4][2], const Unit& u, int wr, int wc, int fr, int fq) const {
        const int row0 = u.pm * BM + wr * 64 + fr, col0 = u.pn * BM + wc * 32 + 8 * fq;
        const PG8_LAS float* tp = tab + 256 + wr * 64 + fr;
        f32x4 xq[2][2][2];
#pragma unroll
        for (int bj = 0; bj < 2; ++bj) { const size_t o = (size_t)row0 * 2048 + col0 + bj * HALF; xq[0][bj][0] = *(const f32x4*)(X + o); xq[0][bj][1] = *(const f32x4*)(X + o + 4); }
#pragma unroll
        for (int idx = 0; idx < 8; ++idx) { const int ai = idx >> 2, m = idx & 3, row = row0 + ai * HALF + m * 16; float ss = 0.f;
            if (idx < 7) { const int nrow = row0 + ((idx + 1) >> 2) * HALF + ((idx + 1) & 3) * 16;
#pragma unroll
                for (int bj = 0; bj < 2; ++bj) { const size_t o = (size_t)nrow * 2048 + col0 + bj * HALF; xq[(idx + 1) & 1][bj][0] = *(const f32x4*)(X + o); xq[(idx + 1) & 1][bj][1] = *(const f32x4*)(X + o + 4); } }
            const float rs = tp[ai * HALF + m * 16];
#pragma unroll
            for (int bj = 0; bj < 2; ++bj) { const size_t o = (size_t)row * 2048 + col0 + bj * HALF;
                const f32x4 v0 = xq[idx & 1][bj][0] + rs * acc[ai][bj][m][0], v1 = xq[idx & 1][bj][1] + rs * acc[ai][bj][m][1];
                u32x4 w; w.x = cvt_pk_bf16(v0[0], v0[1]); w.y = cvt_pk_bf16(v0[2], v0[3]); w.z = cvt_pk_bf16(v1[0], v1[1]); w.w = cvt_pk_bf16(v1[2], v1[3]);
                *(u32x4*)(XB + o) = w;
#pragma unroll
                for (int e = 0; e < 4; ++e) ss += v0[e] * v0[e] + v1[e] * v1[e]; }
            ss += __shfl_xor(ss, 16); ss += __shfl_xor(ss, 32);
            if (fq == 0) unsafeAtomicAdd(rss_x + row, ss); }
    }
};

struct EpiScores {
    static constexpr bool PERM = false, AFTER_DRAIN = false, HAS_MID = false;
    float* C; const float* rss_x;
    __device__ __forceinline__ void mid(f32x4 (&)[2][2][4][2], const Unit&, int, int, int, int) const {}
    __device__ __forceinline__ void operator()(const f32x4 (&acc)[2][2][4][2], const Unit& u, int wr, int wc, int fr, int fq) const {
        const int row0 = u.pm * BM + wr * 64 + fr, col0 = u.pn * BM + wc * 32 + 4 * fq;
        float r2v[8];
#pragma unroll
        for (int idx = 0; idx < 8; ++idx) r2v[idx] = rss_x[row0 + (idx >> 2) * HALF + (idx & 3) * 16];
#pragma unroll
        for (int ai = 0; ai < 2; ++ai)
#pragma unroll
            for (int m = 0; m < 4; ++m) { const int row = row0 + ai * HALF + m * 16;
                const float r2 = __builtin_amdgcn_rsqf(r2v[ai * 4 + m] * (1.f / 2048.f) + 1e-6f);
                float* rowp = C + (size_t)row * 2048 + col0;
#pragma unroll
                for (int bj = 0; bj < 2; ++bj)
#pragma unroll
                    for (int n = 0; n < 2; ++n) *(f32x4*)(rowp + bj * HALF + n * 16) = acc[ai][bj][m][n] * r2; }
    }
};

template <class Epi, class Sched, bool STAMP = false>
__device__ __forceinline__ void gemm_phase(PG8_LAS unsigned char* lds, const Gemm g, const Sched& S, const Epi& E, unsigned long long* stamps) {
    const int tid = threadIdx.x, wid = __builtin_amdgcn_readfirstlane(tid >> 6), lane = tid & 63, wr = wid >> 2, wc = wid & 3, fr = lane & 15, fq = lane >> 4;
    const int K = g.K, nt = K / BK;
    int ts_lo = 0, ts_hi = 0, nts = 0; const unsigned long long rt_entry = STAMP ? (unsigned long long)wall_clock64() : 0ull;
#define PG8_STAMP() do { if (STAMP && wid == 0 && nts < 64) { const unsigned long long _c = (unsigned long long)clock64(); \
        ts_lo = (lane == nts) ? (int)(unsigned)_c : ts_lo; ts_hi = (lane == nts) ? (int)(unsigned)(_c >> 32) : ts_hi; ++nts; } } while (0)
    PG8_STAMP();
    unsigned voffA[2], voffB[2];
#pragma unroll
    for (int i = 0; i < 2; ++i) { int R, C; stage_rc(tid * 16 + i * 8192, R, C); const int Rb = Epi::PERM ? ((R & ~31) + perm32(R & 31)) : R;
        voffA[i] = (unsigned)(R * K + C) * 2u; voffB[i] = (unsigned)(Rb * K + C) * 2u; }
    const size_t kstep = (size_t)(BK * 2);
    const size_t hstep = (size_t)HALF * K * 2;
    const size_t tstep = 2 * hstep;
    const unsigned ldsw = (unsigned)wid * 1024u;
    const int aoff = lds_byte(wr * 64 + fr, fq * 8), boff = lds_byte(wc * 32 + fr, fq * 8);
#define PG8_SA(b, h) (((b) * 2 + (h)) * HTB)
#define PG8_SB(b, h) ((4 + (b) * 2 + (h)) * HTB)
#define PG8_STAGE(bufoff, gbase, voff) do { _Pragma("unroll") for (int _i = 0; _i < 2; ++_i) \
        __builtin_amdgcn_global_load_lds((const unsigned*)((const char*)(gbase) + (voff)[_i]), (PG8_LAS unsigned*)(lds + (bufoff) + ldsw + _i * 8192), 16, 0, 0); } while (0)
#define PG8_LDA(dst, b, h) do { _Pragma("unroll") for (int m = 0; m < 4; ++m) _Pragma("unroll") for (int k = 0; k < 2; ++k) dst[m][k] = *(const PG8_LAS bf16x8*)(lds + PG8_SA(b, h) + aoff + m * 2048 + k * 1024); } while (0)
#define PG8_LDB(dst, b, h) do { _Pragma("unroll") for (int n = 0; n < 2; ++n) _Pragma("unroll") for (int k = 0; k < 2; ++k) dst[n][k] = *(const PG8_LAS bf16x8*)(lds + PG8_SB(b, h) + boff + n * 2048 + k * 1024); } while (0)
#define PG8_MMA(ai, bj, At, Bt) do { __builtin_amdgcn_s_setprio(1); _Pragma("unroll") for (int m = 0; m < 4; ++m) _Pragma("unroll") for (int n = 0; n < 2; ++n) _Pragma("unroll") for (int k = 0; k < 2; ++k) \
        acc[ai][bj][m][n] = __builtin_amdgcn_mfma_f32_16x16x32_bf16(Bt[n][k], At[m][k], acc[ai][bj][m][n], 0, 0, 0); __builtin_amdgcn_s_setprio(0); } while (0)
#define PG8_WAIT_V(n) asm volatile("s_waitcnt vmcnt(" #n ")" ::: "memory")
#define PG8_WAIT_L(n) asm volatile("s_waitcnt lgkmcnt(" #n ")" ::: "memory")
#define PG8_BAR __builtin_amdgcn_s_barrier()
#define PG8_SCHED __builtin_amdgcn_sched_barrier(0)
    Unit cur, nxt; int ui = 0;
    if (!S.next(0, cur)) return;
    f32x4 acc[2][2][4][2];
#pragma unroll
    for (int a = 0; a < 2; ++a)
#pragma unroll
        for (int b = 0; b < 2; ++b)
#pragma unroll
            for (int m = 0; m < 4; ++m)
#pragma unroll
                for (int n = 0; n < 2; ++n) acc[a][b][m][n] = (f32x4){0.f, 0.f, 0.f, 0.f};
    bf16x8 At[4][2], B0[2][2], B1[2][2];
    const char* cA = (const char*)g.A + (size_t)cur.pm * tstep; const char* cB = (const char*)g.Bt + (size_t)cur.pn * tstep;
    S.a_ready(cur);
    PG8_STAGE(PG8_SB(0, 0), cB, voffB); PG8_STAGE(PG8_SA(0, 0), cA, voffA); PG8_STAGE(PG8_SB(0, 1), cB + hstep, voffB); PG8_STAGE(PG8_SA(0, 1), cA + hstep, voffA);
    if (wr == 1) PG8_BAR;
    PG8_WAIT_V(4); PG8_BAR;
    PG8_STAGE(PG8_SB(1, 0), cB + kstep, voffB); PG8_STAGE(PG8_SA(1, 0), cA + kstep, voffA); PG8_STAGE(PG8_SB(1, 1), cB + hstep + kstep, voffB);
    PG8_WAIT_V(6); PG8_BAR;
    PG8_STAMP();
    for (;;) {
        const bool has_next = S.next(ui + 1, nxt);
        const char* nA = has_next ? (const char*)g.A + (size_t)nxt.pm * tstep : cA; const char* nB = has_next ? (const char*)g.Bt + (size_t)nxt.pn * tstep : cB;
        for (int t = 0; t < nt; t += 2) {
            const bool last = (t == nt - 2);
            const char* a1 = cA + (size_t)(t + 1) * kstep;
            const char* a2 = last ? nA : cA + (size_t)(t + 2) * kstep; const char* b2 = last ? nB : cB + (size_t)(t + 2) * kstep;
            const char* a3 = a2 + kstep; const char* b3 = b2 + kstep;
            if (last && has_next) S.a_ready(nxt);
            if constexpr (Epi::HAS_MID) { if (t == (nt >> 1)) { E.mid(acc, cur, wr, wc, fr, fq); asm volatile("s_waitcnt lgkmcnt(0)" ::: "memory"); } }
            PG8_LDB(B0, 0, 0); PG8_SCHED; PG8_LDA(At, 0, 0); PG8_STAGE(PG8_SA(1, 1), a1 + hstep, voffA);
            PG8_WAIT_L(8); PG8_BAR; PG8_WAIT_L(0); PG8_MMA(0, 0, At, B0); PG8_BAR; PG8_SCHED;
            PG8_LDB(B1, 0, 1); PG8_STAGE(PG8_SB(0, 0), b2, voffB);
            PG8_BAR; PG8_WAIT_L(0); PG8_MMA(0, 1, At, B1); PG8_BAR;
            PG8_LDA(At, 0, 1); PG8_STAGE(PG8_SA(0, 0), a2, voffA);
            PG8_BAR; PG8_WAIT_L(0); PG8_MMA(1, 0, At, B0); PG8_BAR; PG8_SCHED;
            PG8_STAGE(PG8_SB(0, 1), b2 + hstep, voffB);
            PG8_WAIT_V(6); PG8_BAR; PG8_MMA(1, 1, At, B1); PG8_BAR;
            PG8_LDB(B0, 1, 0); PG8_SCHED; PG8_LDA(At, 1, 0); PG8_STAGE(PG8_SA(0, 1), a2 + hstep, voffA);
            PG8_WAIT_L(8); PG8_BAR; PG8_WAIT_L(0); PG8_MMA(0, 0, At, B0); PG8_BAR; PG8_SCHED;
            PG8_LDB(B1, 1, 1); PG8_STAGE(PG8_SB(1, 0), b3, voffB);
            PG8_BAR; PG8_WAIT_L(0); PG8_MMA(0, 1, At, B1); PG8_BAR;
            PG8_LDA(At, 1, 1); PG8_STAGE(PG8_SA(1, 0), a3, voffA);
            PG8_BAR; PG8_WAIT_L(0); PG8_MMA(1, 0, At, B0); PG8_BAR; PG8_SCHED;
            PG8_STAGE(PG8_SB(1, 1), b3 + hstep, voffB);
            PG8_WAIT_V(6); PG8_BAR; PG8_MMA(1, 1, At, B1); PG8_BAR;
        }
        PG8_STAMP();
        if constexpr (!Epi::AFTER_DRAIN) { E(acc, cur, wr, wc, fr, fq); S.done(cur); }
        PG8_STAMP();
        if (!has_next) break;
#pragma unroll
        for (int a = 0; a < 2; ++a)
#pragma unroll
            for (int b = 0; b < 2; ++b)
#pragma unroll
                for (int m = 0; m < 4; ++m)
#pragma unroll
                    for (int n = 0; n < 2; ++n) acc[a][b][m][n] = (f32x4){0.f, 0.f, 0.f, 0.f};
        cur = nxt; cA = nA; cB = nB; ++ui;
    }
    PG8_WAIT_V(0);
    if (wr == 0) PG8_BAR;
    PG8_BAR;
    if constexpr (Epi::AFTER_DRAIN) { E.fused(acc, cur, wr, wc, fr, fq, lds, wid, lane); S.done(cur); }
    PG8_STAMP();
    if (STAMP && wid == 0) { stamps[lane] = lane < nts ? (((unsigned long long)(unsigned)ts_hi << 32) | (unsigned)ts_lo) : 0ull;
        if (lane == 62) stamps[62] = rt_entry; if (lane == 63) stamps[63] = (unsigned long long)wall_clock64(); }
#undef PG8_STAMP
#undef PG8_SA
#undef PG8_SB
#undef PG8_STAGE
#undef PG8_LDA
#undef PG8_LDB
#undef PG8_MMA
#undef PG8_WAIT_V
#undef PG8_WAIT_L
#undef PG8_BAR
#undef PG8_SCHED
}
}

typedef short bf16x8 __attribute__((ext_vector_type(8)));
typedef float f32x4 __attribute__((ext_vector_type(4)));
typedef unsigned u32x4 __attribute__((ext_vector_type(4)));
using pg8::cvt_pk_bf16; using pg8::bflo; using pg8::bfhi;

#define LDS_WAIT() asm volatile("s_waitcnt lgkmcnt(0)" ::: "memory")
#define CBAR() asm volatile("" ::: "memory")
#define MFMA16(a, b, c) __builtin_amdgcn_mfma_f32_16x16x32_bf16((a), (b), (c), 0, 0, 0)

struct Args { const float* in[25]; float* out; unsigned char* ws; int ph_lo, ph_hi; };

__device__ __forceinline__ float wave_sum(float v) {
#pragma unroll
    for (int o = 1; o < 64; o <<= 1) v += __shfl_xor(v, o);
    return v;
}
__device__ __forceinline__ float wave_max(float v) {
#pragma unroll
    for (int o = 1; o < 64; o <<= 1) v = fmaxf(v, __shfl_xor(v, o));
    return v;
}
#define DPP_U(x, ctrl) ((unsigned)__builtin_amdgcn_update_dpp((int)(x), (int)(x), ctrl, 0xf, 0xf, false))
__device__ __forceinline__ unsigned row16_umax(unsigned v) { unsigned t;
    t = DPP_U(v, 0xB1); v = t > v ? t : v; t = DPP_U(v, 0x4E); v = t > v ? t : v; t = DPP_U(v, 0x141); v = t > v ? t : v; t = DPP_U(v, 0x140); v = t > v ? t : v; return v; }
__device__ __forceinline__ float row16_fmax(float v) { float t;
    t = __uint_as_float(DPP_U(__float_as_uint(v), 0xB1)); v = fmaxf(v, t); t = __uint_as_float(DPP_U(__float_as_uint(v), 0x4E)); v = fmaxf(v, t);
    t = __uint_as_float(DPP_U(__float_as_uint(v), 0x141)); v = fmaxf(v, t); t = __uint_as_float(DPP_U(__float_as_uint(v), 0x140)); v = fmaxf(v, t); return v; }
__device__ __forceinline__ float row16_fsum(float v) {
    v += __uint_as_float(DPP_U(__float_as_uint(v), 0xB1)); v += __uint_as_float(DPP_U(__float_as_uint(v), 0x4E));
    v += __uint_as_float(DPP_U(__float_as_uint(v), 0x141)); v += __uint_as_float(DPP_U(__float_as_uint(v), 0x140)); return v; }
__device__ __forceinline__ unsigned wave_umax(unsigned v) { v = row16_umax(v);
    const unsigned a = (unsigned)__builtin_amdgcn_readlane((int)v, 0), b = (unsigned)__builtin_amdgcn_readlane((int)v, 16), c = (unsigned)__builtin_amdgcn_readlane((int)v, 32), d = (unsigned)__builtin_amdgcn_readlane((int)v, 48);
    const unsigned ab = a > b ? a : b, cd = c > d ? c : d; return ab > cd ? ab : cd; }
__device__ __forceinline__ float gelu_erf(float x) { return 0.5f * x * (1.0f + erff(x * 0.70710678118654752f)); }
__device__ __forceinline__ float gelu_as(float v) {
    const float av = fabsf(v), t = __builtin_amdgcn_rcpf(fmaf(av, 0.2316418882f, 1.0f));
    float q = fmaf(t, 0.5307027145f, -0.7265760135f); q = fmaf(q, t, 0.7107068705f); q = fmaf(q, t, -0.142248368f); q = fmaf(q, t, 0.127414796f); q *= t;
    const float e = __builtin_amdgcn_exp2f(v * v * -0.72134752044f), m = v * (q * e);
    return v < 0.f ? m : v - m;
}
__device__ __forceinline__ bf16x8 as_bf16x8(u32x4 v) { return __builtin_bit_cast(bf16x8, v); }

__device__ __forceinline__ void p0_transpose_item(const float* W, int K, int N, bf16_t* WT, const float* sc_a, const float* sc_b, LAS float* scr, int item, int lane) {
    const int nblk = N / 32, kb = item / nblk, nb = item % nblk, k0 = 64 * kb, n0 = 32 * nb;
#pragma unroll 8
    for (int i = 0; i < 32; ++i) { const int kk = 2 * i + (lane >> 5); const int k = k0 + kk;
        const float s = sc_a ? (k < 1024 ? sc_a[k] : sc_b[k - 1024]) : 1.f;
        scr[kk * 33 + (lane & 31)] = W[(size_t)k * N + n0 + (lane & 31)] * s; }
    LDS_WAIT();
    const int c = lane & 7;
#pragma unroll
    for (int j = 0; j < 4; ++j) { const int n = (lane >> 3) + 8 * j; const LAS float* s = scr + (8 * c) * 33 + n;
        u32x4 o; o.x = cvt_pk_bf16(s[0 * 33], s[1 * 33]); o.y = cvt_pk_bf16(s[2 * 33], s[3 * 33]); o.z = cvt_pk_bf16(s[4 * 33], s[5 * 33]); o.w = cvt_pk_bf16(s[6 * 33], s[7 * 33]);
        *(u32x4*)(WT + (size_t)(n0 + n) * K + k0 + 8 * c) = o; }
    LDS_WAIT();
}
template <int MODE> __device__ __forceinline__ void p0_row(const float* xrow, const float* g, bf16_t* orow, int lane) {
    const f32x4* xr = (const f32x4*)xrow + lane; const f32x4* gr = (const f32x4*)g + lane;
    f32x4 v[8]; float s = 0.f;
#pragma unroll
    for (int j = 0; j < 8; ++j) { v[j] = xr[64 * j]; s += (v[j].x * v[j].x + v[j].y * v[j].y) + (v[j].z * v[j].z + v[j].w * v[j].w); }
    float r = 1.f;
    if (MODE == 0) r = 1.0f / sqrtf(wave_sum(s) * (1.f / 2048.f) + EPS);
    u32x2* o8 = (u32x2*)orow + lane;
#pragma unroll
    for (int j = 0; j < 8; ++j) { f32x4 w = v[j] * r; if (MODE != 2) w = w * gr[64 * j];
        u32x2 o; o.x = cvt_pk_bf16(w.x, w.y); o.y = cvt_pk_bf16(w.z, w.w); o8[64 * j] = o; }
}
template <bool SCALE_G, bool OFFS> __device__ __forceinline__ void p0_row_q8(const float* xrow, const float* g, unsigned char* orow, float* sc, int lane) {
    const f32x4* xr = (const f32x4*)xrow + lane; const f32x4* gr = (const f32x4*)g + lane;
    f32x4 v[8]; float m = 0.f;
#pragma unroll
    for (int j = 0; j < 8; ++j) { v[j] = xr[64 * j]; if (SCALE_G) v[j] = v[j] * gr[64 * j];
        m = fmaxf(fmaxf(m, fmaxf(fabsf(v[j].x), fabsf(v[j].y))), fmaxf(fabsf(v[j].z), fabsf(v[j].w))); }
    m = fmaxf(wave_max(m), 1e-30f);
    const float inv = 127.f / m;
    if (lane == 0) *sc = m * (1.f / 127.f);
    unsigned* o4 = (unsigned*)orow + lane;
#pragma unroll
    for (int j = 0; j < 8; ++j) { const int a = (int)rintf(v[j].x * inv) + (OFFS ? 128 : 0), b = (int)rintf(v[j].y * inv) + (OFFS ? 128 : 0), c = (int)rintf(v[j].z * inv) + (OFFS ? 128 : 0), d = (int)rintf(v[j].w * inv) + (OFFS ? 128 : 0);
        o4[64 * j] = (unsigned)(a & 255) | ((unsigned)(b & 255) << 8) | ((unsigned)(c & 255) << 16) | ((unsigned)(d & 255) << 24); }
}
template <int KIND> __device__ __forceinline__ void p0_rows(const float* src, const float* g, void* dst, float* sc, int first, int stride, int nrows, int lane) {
    const f32x4* gr = (const f32x4*)g + lane;
    f32x4 cur[8], nxt[8], nx2[8];
    int r = first;
    if (r >= nrows) return;
    { const f32x4* xr = (const f32x4*)(src + (size_t)r * 2048) + lane;
#pragma unroll
        for (int j = 0; j < 8; ++j) cur[j] = xr[64 * j]; }
    if (r + stride < nrows) { const f32x4* xr = (const f32x4*)(src + (size_t)(r + stride) * 2048) + lane;
#pragma unroll
        for (int j = 0; j < 8; ++j) nxt[j] = xr[64 * j]; }
    for (; r < nrows; r += stride) {
        const int rn = r + 2 * stride;
        if (rn < nrows) { const f32x4* xr = (const f32x4*)(src + (size_t)rn * 2048) + lane;
#pragma unroll
            for (int j = 0; j < 8; ++j) nx2[j] = xr[64 * j]; }
        if (KIND == 0) {
            float s = 0.f;
#pragma unroll
            for (int j = 0; j < 8; ++j) s += (cur[j].x * cur[j].x + cur[j].y * cur[j].y) + (cur[j].z * cur[j].z + cur[j].w * cur[j].w);
            const float rr = 1.0f / sqrtf(wave_sum(s) * (1.f / 2048.f) + EPS);
            u32x2* o8 = (u32x2*)((bf16_t*)dst + (size_t)r * 2048) + lane;
#pragma unroll
            for (int j = 0; j < 8; ++j) { const f32x4 w = cur[j] * rr * gr[64 * j]; u32x2 o; o.x = cvt_pk_bf16(w.x, w.y); o.y = cvt_pk_bf16(w.z, w.w); o8[64 * j] = o; }
        } else if (KIND >= 3) {
            float ssq = 0.f;
#pragma unroll
            for (int j = 0; j < 8; ++j) { if (KIND == 3) cur[j] = cur[j] * gr[64 * j]; ssq += (cur[j].x * cur[j].x + cur[j].y * cur[j].y) + (cur[j].z * cur[j].z + cur[j].w * cur[j].w); }
            const float rms = sqrtf(fmaxf(wave_sum(ssq) * (1.f / 2048.f), 1e-30f));
            const float sq = 0.1676f * rms, inv = 0.5f / sq;
            if (lane == 0) sc[r] = sq;
            unsigned* o4 = (unsigned*)((unsigned char*)dst + (size_t)r * 2048) + lane;
#pragma unroll
            for (int j = 0; j < 4; ++j) { unsigned w = 0u;
#pragma unroll
                for (int e = 0; e < 4; ++e) { const float lo = cur[j][e], hi = cur[j + 4][e];
                    int nl = (int)rintf(fmaf(lo, inv, 7.5f)), nh = (int)rintf(fmaf(hi, inv, 7.5f));
                    nl = nl < 0 ? 0 : (nl > 15 ? 15 : nl); nh = nh < 0 ? 0 : (nh > 15 ? 15 : nh);
                    w |= ((unsigned)nl << (8 * e)) | ((unsigned)nh << (8 * e + 4)); }
                o4[64 * j] = w; }
        } else {
            float m = 0.f;
#pragma unroll
            for (int j = 0; j < 8; ++j) { if (KIND == 1) cur[j] = cur[j] * gr[64 * j];
                m = fmaxf(fmaxf(m, fmaxf(fabsf(cur[j].x), fabsf(cur[j].y))), fmaxf(fabsf(cur[j].z), fabsf(cur[j].w))); }
            m = fmaxf(wave_max(m), 1e-30f);
            const float inv = 127.f / m; const int off = KIND == 2 ? 128 : 0;
            if (lane == 0) sc[r] = m * (1.f / 127.f);
            unsigned* o4 = (unsigned*)((unsigned char*)dst + (size_t)r * 2048) + lane;
#pragma unroll
            for (int j = 0; j < 8; ++j) { const int a = (int)rintf(cur[j].x * inv) + off, b = (int)rintf(cur[j].y * inv) + off, c = (int)rintf(cur[j].z * inv) + off, d = (int)rintf(cur[j].w * inv) + off;
                o4[64 * j] = (unsigned)(a & 255) | ((unsigned)(b & 255) << 8) | ((unsigned)(c & 255) << 16) | ((unsigned)(d & 255) << 24); }
        }
#pragma unroll
        for (int j = 0; j < 8; ++j) { cur[j] = nxt[j]; nxt[j] = nx2[j]; }
    }
}
__device__ __forceinline__ void p0_wp_item(const float* wq, const float* keys1, const float* keys2, const float* gffn, bf16_t* WPT, int item, int lane) {
    const int hj = item >> 7, ib = item & 127, h = hj >> 1, j = hj & 1, i0 = 16 * ib, col0 = h * 256 + j * 128;
    const int lr = lane & 15, g = lane >> 4;
    const float* keys = (j ? keys2 : keys1) + (size_t)h * 128 * 128;
    const float gi = gffn[i0 + lr];
    bf16x8 af[4];
#pragma unroll
    for (int s = 0; s < 4; ++s) { const float* p = wq + (size_t)(i0 + lr) * 2048 + col0 + 32 * s + 8 * g;
        const f32x4 a = *(const f32x4*)p * gi, b = *(const f32x4*)(p + 4) * gi;
        u32x4 w; w.x = cvt_pk_bf16(a.x, a.y); w.y = cvt_pk_bf16(a.z, a.w); w.z = cvt_pk_bf16(b.x, b.y); w.w = cvt_pk_bf16(b.z, b.w); af[s] = as_bf16x8(w); }
    f32x4 kn[8];
#pragma unroll
    for (int s = 0; s < 4; ++s) { const float* p = keys + (size_t)lr * 128 + 32 * s + 8 * g; kn[2 * s] = *(const f32x4*)p; kn[2 * s + 1] = *(const f32x4*)(p + 4); }
    for (int kt = 0; kt < 8; ++kt) {
        f32x4 kc[8];
#pragma unroll
        for (int i = 0; i < 8; ++i) kc[i] = kn[i];
        if (kt < 7) {
#pragma unroll
            for (int s = 0; s < 4; ++s) { const float* p = keys + (size_t)(16 * (kt + 1) + lr) * 128 + 32 * s + 8 * g; kn[2 * s] = *(const f32x4*)p; kn[2 * s + 1] = *(const f32x4*)(p + 4); } }
        f32x4 d = {0.f, 0.f, 0.f, 0.f};
#pragma unroll
        for (int s = 0; s < 4; ++s) { const f32x4 a = kc[2 * s], b = kc[2 * s + 1];
            u32x4 w; w.x = cvt_pk_bf16(a.x, a.y); w.y = cvt_pk_bf16(a.z, a.w); w.z = cvt_pk_bf16(b.x, b.y); w.w = cvt_pk_bf16(b.z, b.w);
            d = MFMA16(af[s], as_bf16x8(w), d); }
        u32x2 o; o.x = cvt_pk_bf16(d[0], d[1]); o.y = cvt_pk_bf16(d[2], d[3]);
        *(u32x2*)(WPT + (size_t)(hj * 128 + 16 * kt + lr) * 2048 + i0 + 4 * g) = o;
    }
}
__device__ __forceinline__ int t5_bucket(int n) {
    if (n < 16) return n;
    const int large = 16 + (int)(logf((float)n / 16.f) / 4.852030263919617f * 16.f);
    return large < 31 ? large : 31;
}
__device__ __forceinline__ void p0_ssm_item(const Args& A, unsigned char* sp, int g, int lane) {
    const float* lam_re = A.in[6]; const float* lam_im = A.in[7]; const float* log_dt = A.in[8];
    const float* b_re = A.in[9]; const float* b_im = A.in[10]; const float* c_re = A.in[11]; const float* c_im = A.in[12];
    const int n = lane;
    const float dt = expf(log_dt[g]);
    const float lr = lam_re[g * 64 + n], li = lam_im[g * 64 + n];
    const float mag = expf(lr * dt);
    const float a_re = mag * cosf(li * dt), a_im = mag * sinf(li * dt);
    const float den = lr * lr + li * li;
    const float f_re = ((a_re - 1.f) * lr + a_im * li) / den, f_im = (a_im * lr - (a_re - 1.f) * li) / den;
    ((f32x2*)(sp + SSMP_ABAR))[g * 64 + n] = (f32x2){a_re, a_im};
    float pr = a_re, pi = a_im;
#pragma unroll
    for (int i = 0; i < 8; ++i) { const float nr = pr * pr - pi * pi, ni = 2.f * pr * pi; pr = nr; pi = ni; }
    ((f32x2*)(sp + SSMP_A256))[g * 64 + n] = (f32x2){pr, pi};
    float bbr[16], bbi[16];
#pragma unroll
    for (int q = 0; q < 4; ++q) { const f32x4 br = *(const f32x4*)(b_re + (size_t)(g * 64 + n) * 16 + 4 * q), bi = *(const f32x4*)(b_im + (size_t)(g * 64 + n) * 16 + 4 * q);
#pragma unroll
        for (int e = 0; e < 4; ++e) { bbr[4 * q + e] = f_re * br[e] - f_im * bi[e]; bbi[4 * q + e] = f_re * bi[e] + f_im * br[e]; } }
    {
        float* bbt = (float*)(sp + SSMP_BBT); const int mt = n >> 4, q4 = (n >> 2) & 3, rg = n & 3;
#pragma unroll
        for (int c = 0; c < 16; ++c) { const size_t o = ((((size_t)g * 4 + mt) * 4 + q4) * 16 + c) * 4 + rg; bbt[o] = bbr[c]; bbt[o + 65536] = bbi[c]; } }
    bf16_t* bf = (bf16_t*)(sp + SSMP_BFRAG);
    const int jre = n >> 4, n16 = n & 15;
#pragma unroll
    for (int kg = 0; kg < 4; ++kg) {
        u32x4 wr = {0u, 0u, 0u, 0u}, wi = {0u, 0u, 0u, 0u};
        if (kg < 2) { const int c0 = (kg & 1) * 8;
            wr.x = cvt_pk_bf16(bbr[c0 + 0], bbr[c0 + 1]); wr.y = cvt_pk_bf16(bbr[c0 + 2], bbr[c0 + 3]); wr.z = cvt_pk_bf16(bbr[c0 + 4], bbr[c0 + 5]); wr.w = cvt_pk_bf16(bbr[c0 + 6], bbr[c0 + 7]);
            wi.x = cvt_pk_bf16(bbi[c0 + 0], bbi[c0 + 1]); wi.y = cvt_pk_bf16(bbi[c0 + 2], bbi[c0 + 3]); wi.z = cvt_pk_bf16(bbi[c0 + 4], bbi[c0 + 5]); wi.w = cvt_pk_bf16(bbi[c0 + 6], bbi[c0 + 7]); }
        *(u32x4*)(bf + ((size_t)(g * 8 + jre) * 64 + kg * 16 + n16) * 8) = wr;
        *(u32x4*)(bf + ((size_t)(g * 8 + 4 + jre) * 64 + kg * 16 + n16) * 8) = wi;
    }
    bf16_t* cf = (bf16_t*)(sp + SSMP_CFRAG);
    const int ch = lane & 15, kg = lane >> 4;
#pragma unroll
    for (int s = 0; s < 4; ++s) { const int k0 = 32 * s + 8 * kg;
        const float* src = (k0 < 64) ? (c_re + (size_t)(g * 16 + ch) * 64 + k0) : (c_im + (size_t)(g * 16 + ch) * 64 + (k0 - 64));
        const float sg = (k0 < 64) ? 1.f : -1.f;
        const f32x4 a = *(const f32x4*)src * sg, b = *(const f32x4*)(src + 4) * sg;
        u32x4 w; w.x = cvt_pk_bf16(a.x, a.y); w.y = cvt_pk_bf16(a.z, a.w); w.z = cvt_pk_bf16(b.x, b.y); w.w = cvt_pk_bf16(b.z, b.w);
        *(u32x4*)(cf + ((size_t)(g * 4 + s) * 64 + lane) * 8) = w; }
}
__device__ __forceinline__ void p0_vand_item(const Args& A, unsigned char* sp, int item, int lane) {
    const int g = item >> 3, mt = item & 7, np = 16 * mt + (lane & 15), n = np & 63, kg = lane >> 4;
    const float dt = expf(A.in[8][g]), lr = A.in[6][g * 64 + n], li = A.in[7][g * 64 + n];
    bf16_t* vf = (bf16_t*)(sp + SSMP_VAND) + (size_t)(g * 8 + mt) * 8 * 64 * 8;
    const float m1 = expf(lr * dt), a_re = m1 * cosf(li * dt), a_im = m1 * sinf(li * dt);
    for (int ks = 0; ks < 8; ++ks) { float v[8];
        const float pw = (float)(255 - (32 * ks + 8 * kg + 7)); const float mag = expf(lr * dt * pw), ang = li * dt * pw;
        float cr = mag * cosf(ang), ci = mag * sinf(ang);
#pragma unroll
        for (int j = 7; j >= 0; --j) { v[j] = np < 64 ? cr : ci; const float nr = cr * a_re - ci * a_im, ni = cr * a_im + ci * a_re; cr = nr; ci = ni; }
        u32x4 w; w.x = cvt_pk_bf16(v[0], v[1]); w.y = cvt_pk_bf16(v[2], v[3]); w.z = cvt_pk_bf16(v[4], v[5]); w.w = cvt_pk_bf16(v[6], v[7]);
        *(u32x4*)(vf + ((size_t)ks * 64 + lane) * 8) = w; }
}
__device__ __forceinline__ void p0_btab_item(const Args& A, float* btab, int item, int lane) {
    const float* gq = A.in[3]; const float* gk = A.in[4]; const float* rel_bias = A.in[5];
    const int h = item / 3, br = item % 3, d = br == 0 ? 1 : (br == 1 ? 4 : 16);
    const float G = wave_max(fabsf(gq[lane] * gk[lane]));
    const float mb = wave_max(lane < 32 ? rel_bias[lane * 16 + h] : -1e30f);
    const float smax = 8.4f * G + mb;
    for (int idx = lane; idx < 192; idx += 64) { const int rel = idx - 31;
        float v = -1e30f;
        if (rel >= 0 && rel <= 128) v = LOG2E * (rel_bias[t5_bucket(rel * d) * 16 + h] - smax);
        btab[(h * 3 + br) * 192 + idx] = v; }
}

__device__ __forceinline__ void p0_prologue(const Args& A, LAS unsigned char* lds, int wave, int lane, int pflags) {
    unsigned char* ws = A.ws;
    LAS float* scr = (LAS float*)(lds + wave * 16384);
    const int gw = blockIdx.x * 8 + wave, NGW = gridDim.x * 8;
    constexpr int I_WIN = (2048 / 64) * (4096 / 32), I_GLU = (1024 / 64) * (1024 / 32), I_WOUT = (2048 / 64) * (2048 / 32), I_WP = 2048;
    constexpr int I_SSM = 64, I_BT = 48, I_VAND = 512;
    constexpr int NITEMS = I_WIN + I_GLU + I_WOUT + I_WP + I_SSM + I_BT + I_VAND;
    const bool rows_first = wave & 1;
    if (rows_first && !(pflags & 2048)) p0_rows<0>(A.in[0], A.in[1], ws + WS_HB, nullptr, gw, NGW, 8192, lane);
    if (!(pflags & 4096)) for (int it = gw; it < NITEMS; it += NGW) {
        int r = it;
        if (r < I_SSM) { p0_ssm_item(A, ws + WS_SSMP, r, lane); continue; } r -= I_SSM;
        if (r < I_BT) { p0_btab_item(A, (float*)(ws + WS_BTAB), r, lane); continue; } r -= I_BT;
        if (r < I_VAND) { p0_vand_item(A, ws + WS_SSMP, r, lane); continue; } r -= I_VAND;
        if (r < I_WP) { p0_wp_item(A.in[20], A.in[21], A.in[22], A.in[19], (bf16_t*)(ws + WS_WPT), r, lane); continue; } r -= I_WP;
        if (r < I_WIN) { p0_transpose_item(A.in[2], 2048, 4096, (bf16_t*)(ws + WS_WINT), nullptr, nullptr, scr, r, lane); continue; } r -= I_WIN;
        if (r < I_GLU) { p0_transpose_item(A.in[14], 1024, 1024, (bf16_t*)(ws + WS_GLUT), nullptr, nullptr, scr, r, lane); continue; } r -= I_GLU;
        p0_transpose_item(A.in[18], 2048, 2048, (bf16_t*)(ws + WS_WOUTT), A.in[16], A.in[17], scr, r, lane);
    }
    if (!rows_first && !(pflags & 2048)) p0_rows<0>(A.in[0], A.in[1], ws + WS_HB, nullptr, gw, NGW, 8192, lane);
}
__device__ __forceinline__ void table_chunk(const Args& A, int c, int wave, int lane) {
    unsigned char* ws = A.ws;
    if (c < 512) p0_rows<3>(A.in[23], A.in[19], ws + WS_UB, (float*)(ws + WS_SU), 32 * c + wave, 8, 32 * c + 32, lane);
    else p0_rows<4>(A.in[24], A.in[19], ws + WS_UB + 1024, (float*)(ws + WS_SV), 32 * (c - 512) + wave, 8, 32 * (c - 512) + 32, lane);
}

constexpr int SSM_WL = 8192 + 16 * 272 + 512;
__device__ __forceinline__ void ssm_unit(const Args& A, LAS unsigned char* lds, int b, int g, int wave, int lane) {
    unsigned char* ws = A.ws; unsigned char* sp = ws + WS_SSMP;
    const bf16_t* proj = (const bf16_t*)(ws + WS_PROJ); bf16_t* yb = (bf16_t*)(ws + WS_YB);
    LAS unsigned char* wl = lds + wave * SSM_WL;
    LAS f32x2* BU = (LAS f32x2*)wl; LAS unsigned char* XB = wl + 8192; LAS unsigned char* UL = wl + 8192 + 16 * 272;
    LAS f32x2* carry = (LAS f32x2*)(lds + 8 * SSM_WL);
    const int lr = lane & 15, q = lane >> 4;
    bf16x8 bfr[8], cfr[4];
#pragma unroll
    for (int j = 0; j < 8; ++j) bfr[j] = as_bf16x8(*(const u32x4*)((const bf16_t*)(sp + SSMP_BFRAG) + ((size_t)(g * 8 + j) * 64 + lane) * 8));
#pragma unroll
    for (int s = 0; s < 4; ++s) cfr[s] = as_bf16x8(*(const u32x4*)((const bf16_t*)(sp + SSMP_CFRAG) + ((size_t)(g * 4 + s) * 64 + lane) * 8));
    const f32x2 ab = ((const f32x2*)(sp + SSMP_ABAR))[g * 64 + lane], a256 = ((const f32x2*)(sp + SSMP_A256))[g * 64 + lane];
    const float a_re = ab.x, a_im = ab.y;
    const float dsk = A.in[13][g * 16 + lr];
    const bf16_t* up = proj + (size_t)(b * SEQ + wave * 256) * DPROJ + 3072 + g * 16;
    float xr = 0.f, xi = 0.f;
    {
        LAS unsigned char* UT = wl;
#pragma unroll
        for (int i = 0; i < 8; ++i) { const int tk = 32 * i + (lane >> 1), hf = lane & 1;
            const u32x4 raw = *(const u32x4*)(up + (size_t)tk * DPROJ + 8 * hf);
            const unsigned rw[4] = {raw.x, raw.y, raw.z, raw.w};
#pragma unroll
            for (int e = 0; e < 4; ++e) { *(LAS unsigned short*)(UT + (8 * hf + 2 * e) * 528 + tk * 2) = (unsigned short)(rw[e] & 0xffffu); *(LAS unsigned short*)(UT + (8 * hf + 2 * e + 1) * 528 + tk * 2) = (unsigned short)(rw[e] >> 16); } }
        CBAR();
        const bf16_t* vf = (const bf16_t*)(sp + SSMP_VAND) + (size_t)g * 8 * 8 * 64 * 8 + lane * 8;
        f32x4 pd[8];
#pragma unroll
        for (int mt = 0; mt < 8; ++mt) pd[mt] = (f32x4){0.f, 0.f, 0.f, 0.f};
#pragma unroll 2
        for (int ks = 0; ks < 8; ++ks) { const bf16x8 ub = as_bf16x8(*(const LAS u32x4*)(UT + lr * 528 + (32 * ks + 8 * q) * 2));
#pragma unroll
            for (int mt = 0; mt < 8; ++mt) pd[mt] = MFMA16(as_bf16x8(*(const u32x4*)(vf + (size_t)(mt * 8 + ks) * 512)), ub, pd[mt]); }
        const float* bbt = (const float*)(sp + SSMP_BBT) + (((size_t)g * 4) * 4 + q) * 64 + lr * 4;
#pragma unroll
        for (int mt = 0; mt < 4; ++mt) { const f32x4 br = *(const f32x4*)(bbt + (size_t)mt * 256), bi = *(const f32x4*)(bbt + (size_t)mt * 256 + 65536);
#pragma unroll
            for (int r = 0; r < 4; ++r) { const float er = row16_fsum(br[r] * pd[mt][r] - bi[r] * pd[mt + 4][r]), ei = row16_fsum(br[r] * pd[mt + 4][r] + bi[r] * pd[mt][r]);
                if (lr == 0) carry[wave * 64 + 16 * mt + 4 * q + r] = (f32x2){er, ei}; } }
        CBAR();
    }
    __syncthreads();
    { float sr = 0.f, si = 0.f;
        for (int w2 = 0; w2 < wave; ++w2) { const f32x2 e = carry[w2 * 64 + lane]; const float nr = a256.x * sr - a256.y * si + e.x, ni = a256.x * si + a256.y * sr + e.y; sr = nr; si = ni; }
        xr = sr; xi = si; }
    for (int pass = 1; pass < 2; ++pass) {
        u32x4 unext = {0u, 0u, 0u, 0u};
        if (q < 2) unext = *(const u32x4*)(up + (size_t)lr * DPROJ + 8 * q);
        for (int blk = 0; blk < 16; ++blk) {
            const u32x4 uraw = unext;
            if (q < 2 && blk < 15) unext = *(const u32x4*)(up + (size_t)((blk + 1) * 16 + lr) * DPROJ + 8 * q);
            const bf16x8 ua = as_bf16x8(uraw);
            if (pass == 1 && q < 2) *(LAS u32x4*)(UL + lr * 32 + q * 16) = uraw;
            f32x4 dd[8];
#pragma unroll
            for (int j = 0; j < 8; ++j) dd[j] = MFMA16(ua, bfr[j], ((f32x4){0.f, 0.f, 0.f, 0.f}));
#pragma unroll
            for (int jj = 0; jj < 4; ++jj)
#pragma unroll
                for (int r = 0; r < 4; ++r) BU[(4 * q + r) * 64 + 16 * jj + lr] = (f32x2){dd[jj][r], dd[4 + jj][r]};
            CBAR();
            f32x2 bu[16];
#pragma unroll
            for (int t = 0; t < 16; ++t) bu[t] = BU[t * 64 + lane];
            if (pass == 0) {
#pragma unroll
                for (int t = 0; t < 16; ++t) { float nr = fmaf(a_re, xr, fmaf(-a_im, xi, bu[t].x)), ni = fmaf(a_re, xi, fmaf(a_im, xr, bu[t].y)); asm volatile("" : "+v"(nr)); asm volatile("" : "+v"(ni)); xr = nr; xi = ni; }
                asm volatile("" : "+v"(xr), "+v"(xi) :: "memory");
            } else {
#pragma unroll
                for (int t = 0; t < 16; ++t) { float nr = fmaf(a_re, xr, fmaf(-a_im, xi, bu[t].x)), ni = fmaf(a_re, xi, fmaf(a_im, xr, bu[t].y)); asm volatile("" : "+v"(nr)); asm volatile("" : "+v"(ni)); xr = nr; xi = ni;
                    const unsigned pk = cvt_pk_bf16(xr, xi);
                    *(LAS unsigned short*)(XB + t * 272 + lane * 2) = (unsigned short)(pk & 0xffffu);
                    *(LAS unsigned short*)(XB + t * 272 + 128 + lane * 2) = (unsigned short)(pk >> 16); }
                CBAR();
                f32x4 y = {0.f, 0.f, 0.f, 0.f};
#pragma unroll
                for (int s = 0; s < 4; ++s) { const bf16x8 xa = as_bf16x8(*(const LAS u32x4*)(XB + lr * 272 + (32 * s + 8 * q) * 2)); y = MFMA16(xa, cfr[s], y); }
#pragma unroll
                for (int r = 0; r < 4; ++r) { const int t = blk * 16 + 4 * q + r;
                    const float uv = __uint_as_float((unsigned)(*(const LAS unsigned short*)(UL + (4 * q + r) * 32 + lr * 2)) << 16);
                    const float yv = gelu_as(y[r] + dsk * uv);
                    yb[(size_t)(b * SEQ + wave * 256 + t) * 1024 + g * 16 + lr] = (bf16_t)(cvt_pk_bf16(yv, 0.f) & 0xffffu); }
                asm volatile("" : "+v"(xr), "+v"(xi) :: "memory");
            }
        }
    }
    __syncthreads();
}

__device__ __forceinline__ void prep2_item(const Args& A, LAS unsigned char* wl, int item, int lane) {
    unsigned char* ws = A.ws;
    const bf16_t* proj = (const bf16_t*)(ws + WS_PROJ);
    const int pb = item & 31, h = (item >> 5) & 15, b = item >> 9, P0 = pb * 64, bh = b * 16 + h;
    const int r8 = lane >> 3, c = lane & 7;
    const float* gq = A.in[3]; const float* gk = A.in[4];
    const int fs = c >> 2, fg = c & 3;
#pragma unroll 1
    for (int which = 0; which < 2; ++which) {
        const float* gv = which ? gk : gq; const float cs = which ? 1.f : (LOG2E * 0.125f);
        float gl[8];
#pragma unroll
        for (int e = 0; e < 8; ++e) gl[e] = gv[8 * c + e] * cs;
        bf16_t* F = (bf16_t*)(ws + (which ? WS_KF : WS_QF));
        u32x4 raws[8];
#pragma unroll
        for (int i = 0; i < 8; ++i) raws[i] = *(const u32x4*)(proj + (size_t)(b * SEQ + P0 + 8 * i + r8) * DPROJ + which * 1024 + h * 64 + 8 * c);
#pragma unroll
        for (int i = 0; i < 8; ++i) { const int row = 8 * i + r8, pos = P0 + row;
            const u32x4 raw = raws[i];
            float v[8] = {bflo(raw.x), bfhi(raw.x), bflo(raw.y), bfhi(raw.y), bflo(raw.z), bfhi(raw.z), bflo(raw.w), bfhi(raw.w)};
            float ss = 0.f;
#pragma unroll
            for (int e = 0; e < 8; ++e) ss += v[e] * v[e];
            ss += __shfl_xor(ss, 1); ss += __shfl_xor(ss, 2); ss += __shfl_xor(ss, 4);
            const float r = 1.0f / sqrtf(ss * (1.f / 64.f) + EPS);
            u32x4 w; w.x = cvt_pk_bf16(v[0] * r * gl[0], v[1] * r * gl[1]); w.y = cvt_pk_bf16(v[2] * r * gl[2], v[3] * r * gl[3]);
            w.z = cvt_pk_bf16(v[4] * r * gl[4], v[5] * r * gl[5]); w.w = cvt_pk_bf16(v[6] * r * gl[6], v[7] * r * gl[7]);
#pragma unroll
            for (int br = 0; br < 3; ++br) { const int sh = 2 * br, rr = pos & ((1 << sh) - 1), l = pos >> sh;
                *(u32x4*)(F + (size_t)br * 4 * 16 * SEQ * 64 + ((((size_t)(bh << sh) + rr) * (SEQ >> (sh + 4)) + (l >> 4)) * 2 + fs) * 512 + (fg * 16 + (l & 15)) * 8) = w; } }
    }
#pragma unroll
    for (int i = 0; i < 8; ++i) { const int row = 8 * i + r8;
        const u32x4 raw = *(const u32x4*)(proj + (size_t)(b * SEQ + P0 + row) * DPROJ + 2048 + h * 64 + 8 * c);
        *(LAS u32x2*)(wl + row * 136 + c * 16) = (u32x2){raw.x, raw.y}; *(LAS u32x2*)(wl + row * 136 + c * 16 + 8) = (u32x2){raw.z, raw.w}; }
    CBAR();
    unsigned v[64];
#pragma unroll
    for (int p = 0; p < 64; ++p) v[p] = *(const LAS unsigned short*)(wl + p * 136 + lane * 2);
    CBAR();
    bf16_t* vt = (bf16_t*)(ws + WS_VT);
    const int nt = lane >> 4, dl = lane & 15;
#pragma unroll
    for (int G = 0; G < 2; ++G) { bf16_t* tp = vt + ((((size_t)bh * 64 + (P0 >> 5) + G) * 4 + nt) * 64 + dl) * 8;
#pragma unroll
        for (int kg = 0; kg < 4; ++kg) { const int a0 = 32 * G + 4 * kg, b0 = 32 * G + 16 + 4 * kg;
            u32x4 w; w.x = v[a0] | (v[a0 + 1] << 16); w.y = v[a0 + 2] | (v[a0 + 3] << 16); w.z = v[b0] | (v[b0 + 1] << 16); w.w = v[b0 + 2] | (v[b0 + 3] << 16);
            *(u32x4*)(tp + kg * 128) = w; } }
    { bf16_t* vt4 = vt + (size_t)4 * 16 * 64 * SEQ; const int l0 = P0 >> 2, tile = (l0 >> 4) & 1, grp = l0 >> 5;
#pragma unroll
        for (int r = 0; r < 4; ++r) { bf16_t* tp = vt4 + (((((size_t)bh * 4 + r) * 16 + grp) * 4 + nt) * 64 + dl) * 8;
#pragma unroll
            for (int kg = 0; kg < 4; ++kg) { const int p0 = 4 * (4 * kg) + r;
                u32x2 w; w.x = v[p0] | (v[p0 + 4] << 16); w.y = v[p0 + 8] | (v[p0 + 12] << 16);
                *(u32x2*)(tp + kg * 128 + 4 * tile) = w; } } }
    { bf16_t* vt16 = vt + (size_t)2 * 4 * 16 * 64 * SEQ; const int l0 = P0 >> 4, w32 = l0 & 31, tile = (w32 >> 4) & 1, kg = (w32 & 15) >> 2, grp = l0 >> 5;
#pragma unroll
        for (int r = 0; r < 16; ++r) { u32x2 w; w.x = v[r] | (v[16 + r] << 16); w.y = v[32 + r] | (v[48 + r] << 16);
            *(u32x2*)(vt16 + (((((size_t)bh * 16 + r) * 4 + grp) * 4 + nt) * 64 + kg * 16 + dl) * 8 + 4 * tile) = w; } }
}

struct AttnItem { int sh, r, lfirst, ks, tbo; size_t qk_off, v_off; };
__device__ __forceinline__ AttnItem attn_item(int it, int p0, int bh) {
    AttnItem I; const int br = it >> 4, j = it & 15; I.sh = 2 * br; I.tbo = br * 192;
    I.r = j & ((1 << I.sh) - 1); I.lfirst = (p0 >> I.sh) + 16 * (j >> I.sh);
    const size_t rc = (size_t)br * 4 * 16 * SEQ * 64 + ((size_t)(bh << I.sh) + I.r) * (size_t)(SEQ >> I.sh) * 64;
    I.qk_off = rc; I.v_off = rc;
    int ks = (I.lfirst - 128) & ~31; I.ks = ks < 0 ? 0 : ks;
    return I;
}
__device__ __forceinline__ void attn_unit(const Args& A, LAS unsigned char* lds, int unit, int tid, int wave, int lane, int pflags) {
    unsigned char* ws = A.ws;
    const int blk = 7 - (unit >> 6), bh = unit & 63, b = bh >> 4, h = bh & 15, p0 = blk * 256;
    constexpr int OST = 68;
    LAS float* Oacc = (LAS float*)lds; LAS float* lacc = (LAS float*)(lds + 256 * OST * 4); LAS float* tb = (LAS float*)(lds + 256 * OST * 4 + 1024);
    { const float* bt = (const float*)(ws + WS_BTAB) + h * 3 * 192; for (int i = tid; i < 3 * 192; i += 512) tb[i] = bt[i]; }
    __syncthreads();
    const bf16_t* QF = (const bf16_t*)(ws + WS_QF); const bf16_t* KF = (const bf16_t*)(ws + WS_KF); const bf16_t* VF = (const bf16_t*)(ws + WS_VT);
    const int qi = lane & 15, g = lane >> 4;
#define ATT_LOAD(IT, LK, B) do { const AttnItem _I = attn_item(IT, p0, bh); const bf16_t* _kp = KF + _I.qk_off + (size_t)((LK) >> 4) * 1024 + lane * 8; \
        B[0] = *(const u32x4*)(_kp); B[1] = *(const u32x4*)(_kp + 512); B[2] = *(const u32x4*)(_kp + 1024); B[3] = *(const u32x4*)(_kp + 1536); \
        const bf16_t* _vp = VF + _I.v_off + (size_t)((LK) >> 5) * 2048 + lane * 8; \
        B[4] = *(const u32x4*)(_vp); B[5] = *(const u32x4*)(_vp + 512); B[6] = *(const u32x4*)(_vp + 1024); B[7] = *(const u32x4*)(_vp + 1536); \
        const bf16_t* _qp = QF + _I.qk_off + (size_t)(_I.lfirst >> 4) * 1024 + lane * 8; B[8] = *(const u32x4*)(_qp); B[9] = *(const u32x4*)(_qp + 512); } while (0)
#define ATT_ADV(IT, LK, NIT, NLK) do { const AttnItem _J = attn_item(IT, p0, bh); if ((LK) + 32 <= _J.lfirst) { (NIT) = (IT); (NLK) = (LK) + 32; } else { (NIT) = (IT) + 8; (NLK) = 0; if ((NIT) < 48) { const AttnItem _N = attn_item(NIT, p0, bh); (NLK) = _N.ks; } } } while (0)
#define ATT_STEP(CIT, CLK, BC, NIT, NLK, NNIT, NNLK, BNN) { \
        NNIT = 64; NNLK = 0; \
        if ((NIT) < 48) { ATT_ADV(NIT, NLK, NNIT, NNLK); if ((NNIT) < 48) ATT_LOAD(NNIT, NNLK, BNN); } \
        const AttnItem cI = attn_item(CIT, p0, bh); \
        f32x4 sa = {0.f, 0.f, 0.f, 0.f}, sb = {0.f, 0.f, 0.f, 0.f}; \
        sa = MFMA16(as_bf16x8(BC[0]), as_bf16x8(BC[8]), sa); sb = MFMA16(as_bf16x8(BC[2]), as_bf16x8(BC[8]), sb); \
        sa = MFMA16(as_bf16x8(BC[1]), as_bf16x8(BC[9]), sa); sb = MFMA16(as_bf16x8(BC[3]), as_bf16x8(BC[9]), sb); \
        const LAS float* tbb = tb + cI.tbo; \
        const int ba = cI.lfirst + qi - (CLK) - 4 * g + 31; \
        float pa[4], pb[4]; \
        _Pragma("unroll") for (int e = 0; e < 4; ++e) { pa[e] = __builtin_amdgcn_exp2f(sa[e] + tbb[ba - e]); pb[e] = __builtin_amdgcn_exp2f(sb[e] + tbb[ba - 16 - e]); } \
        lsum += (pa[0] + pa[1]) + (pa[2] + pa[3]) + (pb[0] + pb[1]) + (pb[2] + pb[3]); \
        u32x4 pw; pw.x = cvt_pk_bf16(pa[0], pa[1]); pw.y = cvt_pk_bf16(pa[2], pa[3]); pw.z = cvt_pk_bf16(pb[0], pb[1]); pw.w = cvt_pk_bf16(pb[2], pb[3]); \
        const bf16x8 pf = as_bf16x8(pw); \
        _Pragma("unroll") for (int nt = 0; nt < 4; ++nt) o[nt] = MFMA16(pf, as_bf16x8(BC[4 + nt]), o[nt]); \
        if ((CLK) + 32 > cI.lfirst) {     \
            lsum += __shfl_xor(lsum, 16); lsum += __shfl_xor(lsum, 32); \
            const bool first = (CIT) < 16; \
            if (g == 0) { LAS float* lp = lacc + ((((cI.lfirst + qi) << cI.sh) + cI.r) - p0); *lp = first ? lsum : *lp + lsum; } \
            _Pragma("unroll") for (int reg = 0; reg < 4; ++reg) { LAS float* op = Oacc + (((((cI.lfirst + 4 * g + reg) << cI.sh) + cI.r) - p0)) * OST + qi; \
                _Pragma("unroll") for (int nt = 0; nt < 4; ++nt) op[16 * nt] = first ? o[nt][reg] : op[16 * nt] + o[nt][reg]; } \
            _Pragma("unroll") for (int nt = 0; nt < 4; ++nt) o[nt] = (f32x4){0.f, 0.f, 0.f, 0.f}; \
            lsum = 0.f; \
            if (((CIT) >> 3) & 1) __syncthreads();     \
        } \
        if ((NIT) >= 48) break; }
    if (!(pflags & 16)) {
    int itA = wave, lkA, itB, lkB, itC = 64, lkC = 0;
    { const AttnItem I0 = attn_item(wave, p0, bh); lkA = I0.ks; }
    ATT_ADV(itA, lkA, itB, lkB);
    u32x4 bA[10], bB[10], bC[10];
    ATT_LOAD(itA, lkA, bA); if (itB < 48) ATT_LOAD(itB, lkB, bB);
    f32x4 o[4];
#pragma unroll
    for (int nt = 0; nt < 4; ++nt) o[nt] = (f32x4){0.f, 0.f, 0.f, 0.f};
    float lsum = 0.f;
    for (;;) {
        ATT_STEP(itA, lkA, bA, itB, lkB, itC, lkC, bC)
        ATT_STEP(itB, lkB, bB, itC, lkC, itA, lkA, bA)
        ATT_STEP(itC, lkC, bC, itA, lkA, itB, lkB, bB)
    }
    }
#undef ATT_LOAD
#undef ATT_ADV
#undef ATT_STEP
    if (!(pflags & (16 | 32 | 64))) { const int ql = tid >> 1, half = tid & 1; const float inv = 1.0f / lacc[ql];
        bf16_t* dst = (bf16_t*)(ws + WS_MIXED) + (size_t)(b * SEQ + p0 + ql) * 2048 + h * 64 + 32 * half;
        float ss = 0.f;
#pragma unroll
        for (int c4 = 0; c4 < 4; ++c4) { float v[8];
#pragma unroll
            for (int e = 0; e < 8; ++e) { v[e] = Oacc[ql * OST + 32 * half + 8 * c4 + e] * inv; ss += v[e] * v[e]; }
            u32x4 w; w.x = cvt_pk_bf16(v[0], v[1]); w.y = cvt_pk_bf16(v[2], v[3]); w.z = cvt_pk_bf16(v[4], v[5]); w.w = cvt_pk_bf16(v[6], v[7]);
            *(u32x4*)(dst + 8 * c4) = w; }
        ss += __shfl_xor(ss, 1);
        if (half == 0) unsafeAtomicAdd((float*)(ws + WS_CTL + CTL_RSS_ATTN) + b * SEQ + p0 + ql, ss); }
    __syncthreads();
}

__device__ __forceinline__ unsigned fkey(float f) { const unsigned u = __float_as_uint(f); return (u & 0x80000000u) ? ~u : (u | 0x80000000u); }
template <int R> __device__ __forceinline__ void select16(const unsigned (&key)[R], unsigned long long (&m)[R]) {
    unsigned mx = key[0];
#pragma unroll
    for (int r = 1; r < R; ++r) mx = key[r] > mx ? key[r] : mx;
    mx = wave_umax(mx);
    unsigned lo = mx > (3u << 23) ? mx - (3u << 23) : 0u, hi = mx + 1u;
    int cnt = 0;
#pragma unroll
    for (int r = 0; r < R; ++r) cnt += __popcll(__ballot(key[r] >= lo));
    if (cnt < 16) { lo = 0u; cnt = R * 64; }
    while (cnt != 16 && hi - lo > 1u) { const unsigned mid = lo + ((hi - lo) >> 1); int c = 0;
#pragma unroll
        for (int r = 0; r < R; ++r) c += __popcll(__ballot(key[r] >= mid));
        if (c >= 16) { lo = mid; cnt = c; } else hi = mid; }
    const unsigned T = lo;
    if (cnt == 16) {
#pragma unroll
        for (int r = 0; r < R; ++r) m[r] = __ballot(key[r] >= T);
    } else {
        int need = 16;
#pragma unroll
        for (int r = 0; r < R; ++r) { m[r] = __ballot(key[r] > T); need -= __popcll(m[r]); }
#pragma unroll
        for (int r = 0; r < R; ++r) { unsigned long long eq = __ballot(key[r] == T);
            while (__popcll(eq) > need) eq &= ~(1ull << (63 - __builtin_clzll(eq)));
            need -= __popcll(eq); m[r] |= eq; }
    }
}
__device__ __forceinline__ void peer_topk(const float (&sv4)[4], LAS float* sc, LAS int* exo, LAS float* gto, int lane) {
    LAS float* v1 = sc; LAS int* i1 = (LAS int*)(sc + 16); LAS float* v2 = sc + 32; LAS int* i2 = (LAS int*)(sc + 48); LAS float* sv = sc + 64; LAS int* si = (LAS int*)(sc + 80);
    const unsigned long long lt = (1ull << lane) - 1ull;
#pragma unroll
    for (int half = 0; half < 2; ++half) {
        const float a0 = sv4[2 * half], a1 = sv4[2 * half + 1];
        const unsigned key[2] = {fkey(a0), fkey(a1)}; unsigned long long m[2];
        select16<2>(key, m);
        LAS float* vv = half ? v2 : v1; LAS int* ii = half ? i2 : i1;
        if ((m[0] >> lane) & 1ull) { const int pos = __popcll(m[0] & lt); vv[pos] = a0; ii[pos] = lane; }
        if ((m[1] >> lane) & 1ull) { const int pos = __popcll(m[0]) + __popcll(m[1] & lt); vv[pos] = a1; ii[pos] = 64 + lane; }
    }
    CBAR(); LDS_WAIT();
    const int a = lane >> 2, bb = (lane & 3) * 4;
    const float va = v1[a]; float cv[4]; unsigned key[4]; unsigned long long m[4];
#pragma unroll
    for (int e = 0; e < 4; ++e) { cv[e] = va + v2[bb + e]; key[e] = fkey(cv[e]); }
    select16<4>(key, m);
    int base = 0;
#pragma unroll
    for (int e = 0; e < 4; ++e) { if ((m[e] >> lane) & 1ull) { const int pos = base + __popcll(m[e] & lt); sv[pos] = cv[e]; si[pos] = a * 16 + bb + e; } base += __popcll(m[e]); }
    CBAR(); LDS_WAIT();
    if (lane < 16) {
        const float val = sv[lane]; const int fi = si[lane];
        const float mx = row16_fmax(val);
        const float ex = __expf(val - mx); const float sum = row16_fsum(ex);
        exo[lane] = i1[fi >> 4] * 128 + (i2[fi & 15] - 0);
        gto[lane] = ex / sum;
    }
    CBAR(); LDS_WAIT();
}

template <int I> __device__ __forceinline__ float ubyte_f32(unsigned w) { float f;
    if (I == 0) asm("v_cvt_f32_ubyte0 %0, %1" : "=v"(f) : "v"(w)); else if (I == 1) asm("v_cvt_f32_ubyte1 %0, %1" : "=v"(f) : "v"(w));
    else if (I == 2) asm("v_cvt_f32_ubyte2 %0, %1" : "=v"(f) : "v"(w)); else asm("v_cvt_f32_ubyte3 %0, %1" : "=v"(f) : "v"(w));
    return f; }
__device__ __forceinline__ void peer_wave(const Args& A, LAS unsigned char* lds, int wave, int lane, int pflags) {
    unsigned char* ws = A.ws;
    const float* scores = (const float*)(ws + WS_PROJ);
    const unsigned char* uv = ws + WS_UB; const bf16_t* x1b = (const bf16_t*)(ws + WS_HB);
    const float* su = (const float*)(ws + WS_SU); const float* sv = (const float*)(ws + WS_SV);
    const float* rssx = (const float*)(ws + WS_CTL + CTL_RSS_X1);
    LAS int* exl = (LAS int*)(lds + wave * 4096);
    LAS float* gtl = (LAS float*)(lds + wave * 4096 + 2048);
    LAS float* sc = (LAS float*)(lds + 32768 + wave * 512);
    LAS float* cul = (LAS float*)(lds + 40960 + wave * 1024);
    const int t0 = (blockIdx.x * 8 + wave) * 4;
    if (t0 >= NTOK) return;
#define LOAD_SCORES_L(dst, t, h, ln) do { const float* _sp = scores + (size_t)(t) * 2048 + (h) * 256 + (ln); dst[0] = _sp[0]; dst[1] = _sp[64]; dst[2] = _sp[128]; dst[3] = _sp[192]; } while (0)
#define LOAD_SCORES(dst, t, h) LOAD_SCORES_L(dst, t, h, lane)
    { float nx[4]; LOAD_SCORES(nx, t0, 0);
#pragma unroll 1
        for (int h = 0; h < 8; ++h) { const float cs[4] = {nx[0], nx[1], nx[2], nx[3]};
            if (h < 7) LOAD_SCORES(nx, t0, h + 1);
            peer_topk(cs, sc, exl + h * 16, gtl + h * 16, lane); } }
    CBAR(); LDS_WAIT();
    if (pflags & 256) return;
    int ex0 = exl[lane], ex1 = exl[64 + lane];
    float rss = rssx[t0], su0 = su[ex0], su1 = su[ex1], sv0 = sv[ex0], sv1 = sv[ex1];
    float sn[4] = {0.f, 0.f, 0.f, 0.f};
    LOAD_SCORES(sn, t0 + 1, 0);
    u32x4 bu[8], bv[8];
    LAS u32x4* vls = (LAS u32x4*)(lds + 49152 + wave * 8192);
#define ISSUE_E(slot, e0r, e1r, k) do { const int _e = __builtin_amdgcn_readlane((k) < 64 ? (e0r) : (e1r), (k) & 63); \
        const unsigned char* _p = uv + (size_t)_e * 2048 + 16 * lane; bu[slot] = *(const u32x4*)_p; bv[slot] = *(const u32x4*)(_p + 1024); } while (0)
#pragma unroll
    for (int i = 0; i < 8; ++i) ISSUE_E(i, ex0, ex1, i);
    float acc[32];
    u32x4 xr4[4];
#pragma unroll
    for (int v4 = 0; v4 < 4; ++v4) xr4[v4] = *(const u32x4*)(x1b + (size_t)t0 * 2048 + 16 * lane + 1024 * (v4 >> 1) + 8 * (v4 & 1));
#pragma unroll 1
    for (int tok = 0; tok < 4; ++tok) {
        const int t = t0 + tok;
        int lz = lane; asm volatile("" : "+v"(lz));
        unsigned xq[8]; float sx; int xsum;
        {
            float m = 0.f;
#pragma unroll
            for (int v4 = 0; v4 < 4; ++v4) { const unsigned rw[4] = {xr4[v4].x, xr4[v4].y, xr4[v4].z, xr4[v4].w};
#pragma unroll
                for (int e = 0; e < 4; ++e) m = fmaxf(m, fmaxf(fabsf(bflo(rw[e])), fabsf(bfhi(rw[e])))); }
            m = fmaxf(wave_max(m), 1e-30f);
            const float inv = 127.f / m; sx = m * (1.f / 127.f);
            int ls = 0;
#pragma unroll
            for (int v4 = 0; v4 < 4; ++v4) { const unsigned rw[4] = {xr4[v4].x, xr4[v4].y, xr4[v4].z, xr4[v4].w};
#pragma unroll
                for (int h2 = 0; h2 < 2; ++h2) { const int a = (int)rintf(bflo(rw[2 * h2]) * inv), b = (int)rintf(bfhi(rw[2 * h2]) * inv), c = (int)rintf(bflo(rw[2 * h2 + 1]) * inv), e = (int)rintf(bfhi(rw[2 * h2 + 1]) * inv);
                    ls += (a + b) + (c + e);
                    xq[2 * v4 + h2] = (unsigned)(a & 255) | ((unsigned)(b & 255) << 8) | ((unsigned)(c & 255) << 16) | ((unsigned)(e & 255) << 24); } }
#pragma unroll
            for (int o = 1; o < 64; o <<= 1) ls += __shfl_xor(ls, o);
            xsum = ls;
            asm volatile("" ::: "memory");
#pragma unroll
            for (int v4 = 0; v4 < 4; ++v4) { const unsigned rw[4] = {xr4[v4].x, xr4[v4].y, xr4[v4].z, xr4[v4].w};
#pragma unroll
                for (int e = 0; e < 4; ++e) { acc[8 * v4 + 2 * e] = bflo(rw[e]); acc[8 * v4 + 2 * e + 1] = bfhi(rw[e]); } } }
        const float ascale = sx / sqrtf(rss * (1.f / 2048.f) + EPS);
        cul[lz] = ascale * su0; cul[64 + lz] = ascale * su1;
        cul[128 + lz] = 2.f * gtl[tok * 128 + lz] * sv0; cul[192 + lz] = 2.f * gtl[tok * 128 + 64 + lz] * sv1;
        CBAR(); LDS_WAIT();
        float wsum = 0.f;
        int nex0 = ex0, nex1 = ex1; float nrss = 1.f, nsu0 = 0.f, nsu1 = 0.f, nsv0 = 0.f, nsv1 = 0.f;
#pragma unroll 1
        for (int k0 = 0; k0 < 128; k0 += 8) {
            if (tok < 3 && k0 == 120) {
                nex0 = exl[(tok + 1) * 128 + lz]; nex1 = exl[(tok + 1) * 128 + 64 + lz];
                nrss = rssx[t + 1]; nsu0 = su[nex0]; nsu1 = su[nex1]; nsv0 = sv[nex0]; nsv1 = sv[nex1];
#pragma unroll
                for (int v4 = 0; v4 < 4; ++v4) xr4[v4] = *(const u32x4*)(x1b + (size_t)(t + 1) * 2048 + 16 * lz + 1024 * (v4 >> 1) + 8 * (v4 & 1));
                if (tok < 2) LOAD_SCORES_L(sn, t + 2, 0, lz); }
            int p[8];
#pragma unroll
            for (int i = 0; i < 8; ++i) { int ac = 0;
                const unsigned w4[4] = {bu[i].x, bu[i].y, bu[i].z, bu[i].w};
#pragma unroll
                for (int e = 0; e < 4; ++e) { ac = __builtin_amdgcn_sdot4((int)(w4[e] & 0x0F0F0F0Fu), (int)xq[e], ac, false); ac = __builtin_amdgcn_sdot4((int)((w4[e] >> 4) & 0x0F0F0F0Fu), (int)xq[4 + e], ac, false); }
                p[i] = ac; vls[i * 64 + lane] = bv[i]; }
            { const bool nxt = (k0 + 8) >= 128;
              const int kb = (k0 + 8) & 127; const int sel = nxt ? (kb < 64 ? nex0 : nex1) : (kb < 64 ? ex0 : ex1);
#pragma unroll
              for (int i = 0; i < 8; ++i) { const int _e = __builtin_amdgcn_readlane(sel, (kb & 63) + i);
                  const unsigned char* _p = uv + (size_t)_e * 2048 + 16 * lane; bu[i] = *(const u32x4*)_p; bv[i] = *(const u32x4*)(_p + 1024); } }
            float wcur;
            { const bool b0 = lane & 1, b1 = lane & 2, b2 = lane & 4;
            int q4[4], q2[2], q1;
#pragma unroll
            for (int i = 0; i < 4; ++i) { const int keep = b0 ? p[i + 4] : p[i], send = b0 ? p[i] : p[i + 4]; q4[i] = keep + __shfl_xor(send, 1); }
#pragma unroll
            for (int i = 0; i < 2; ++i) { const int keep = b1 ? q4[i + 2] : q4[i], send = b1 ? q4[i] : q4[i + 2]; q2[i] = keep + __shfl_xor(send, 2); }
            { const int keep = b2 ? q2[1] : q2[0], send = b2 ? q2[0] : q2[1]; q1 = keep + __shfl_xor(send, 4); }
            q1 += __shfl_xor(q1, 8); q1 += __shfl_xor(q1, 16); q1 += __shfl_xor(q1, 32);
            const int k = (k0 + 4 * (lane & 1) + 2 * ((lane >> 1) & 1) + ((lane >> 2) & 1)) & 127;
            const float a = (float)(2 * q1 - 15 * xsum) * cul[k];
            wcur = cul[128 + k] * gelu_as(a); }
            CBAR();
#pragma unroll 1
            for (int i = 0; i < 8; ++i) { const int rl = ((i & 1) << 2) | (i & 2) | ((i >> 2) & 1);
                const float w = __builtin_bit_cast(float, __builtin_amdgcn_readlane(__builtin_bit_cast(int, wcur), rl));
                wsum += w;
                const u32x4 vv = vls[i * 64 + lane];
                const unsigned w4[4] = {vv.x, vv.y, vv.z, vv.w};
                const float w16 = w * 0.0625f;
#pragma unroll
                for (int e = 0; e < 4; ++e) { const unsigned lo = w4[e] & 0x0F0F0F0Fu, hi = w4[e] & 0xF0F0F0F0u;
                    acc[4 * e + 0] += w * ubyte_f32<0>(lo); acc[4 * e + 1] += w * ubyte_f32<1>(lo); acc[4 * e + 2] += w * ubyte_f32<2>(lo); acc[4 * e + 3] += w * ubyte_f32<3>(lo);
                    acc[16 + 4 * e + 0] += w16 * ubyte_f32<0>(hi); acc[16 + 4 * e + 1] += w16 * ubyte_f32<1>(hi); acc[16 + 4 * e + 2] += w16 * ubyte_f32<2>(hi); acc[16 + 4 * e + 3] += w16 * ubyte_f32<3>(hi); } }
            CBAR();
            if (tok < 3 && !(k0 & 8)) { const int hh = k0 >> 4;
                const float cs[4] = {sn[0], sn[1], sn[2], sn[3]};
                if (hh < 7) LOAD_SCORES_L(sn, t + 1, hh + 1, lz);
                peer_topk(cs, sc, exl + (tok + 1) * 128 + hh * 16, gtl + (tok + 1) * 128 + hh * 16, lane); }
        }
        const float corr = -7.5f * wsum;
        float* op = A.out + (size_t)t * 2048 + 16 * lz;
        if (!(pflags & 128)) {
#pragma unroll
        for (int j = 0; j < 2; ++j)
#pragma unroll
            for (int c4 = 0; c4 < 4; ++c4) { const int a0 = 16 * j + 4 * c4;
                *(f32x4*)(op + 1024 * j + 4 * c4) = (f32x4){acc[a0] + corr, acc[a0 + 1] + corr, acc[a0 + 2] + corr, acc[a0 + 3] + corr}; }
        } else if (corr == 12345.678f) op[0] = acc[0];
        ex0 = nex0; ex1 = nex1; rss = nrss; su0 = nsu0; su1 = nsu1; sv0 = nsv0; sv1 = nsv1;
    }
#undef ISSUE_E
#undef LOAD_SCORES
#undef LOAD_SCORES_L
}

__global__ void __launch_bounds__(512, 2) mk_fwd(Args args) {
    extern __shared__ __attribute__((aligned(16))) unsigned char lds_raw[];
    LAS unsigned char* lds = (LAS unsigned char*)lds_raw;
    const int tid = threadIdx.x, lane = tid & 63, wave = __builtin_amdgcn_readfirstlane(tid >> 6);
    volatile LAS unsigned* MISC = (volatile LAS unsigned*)(lds + MISC_OFF);
    if (tid < 64) MISC[tid] = 0u;
    __syncthreads();
    unsigned char* ws = args.ws;
    const int lo = args.ph_lo, hi = args.ph_hi & 0xff;
#ifdef MK_PROBE
    const int pflags = args.ph_hi >> 8;
#else
    constexpr int pflags = 0;
#endif
    XcdBarrier bar; bar.bar = (unsigned*)(ws + WS_CTL); bar.x = 0; bar.st = nullptr;
    if (hi - lo > 1) bar = xcd_barrier_post((unsigned*)(ws + WS_CTL), MISC + 8);
#ifndef PH_MASK
#define PH_MASK 0x7f
#endif
#define IN(k) (((PH_MASK >> (k)) & 1) && lo <= (k) && (k) < hi)
#define SEAM(k) do { if (IN(k) && IN((k) + 1)) xcd_barrier(bar); } while (0)

    if (IN(0)) { p0_prologue(args, lds, wave, lane, pflags); }
    SEAM(0);
    if (IN(1)) {
        pg8::Gemm g{(const bf16_t*)(ws + WS_HB), (const bf16_t*)(ws + WS_WINT), NTOK, DPROJ, DM}; pg8::StaticOrder S; S.init(NTOK, DPROJ, gridDim.x, (int)blockIdx.x);
        pg8::EpiProj E{(bf16_t*)(ws + WS_PROJ), DPROJ};
        pg8::gemm_phase<pg8::EpiProj, pg8::StaticOrder, false>(lds, g, S, E, nullptr);
    }
    SEAM(1);
    if (IN(2)) {
        const bool prep_first = blockIdx.x & 1;
        if (prep_first && !(pflags & 8)) { for (int it = blockIdx.x * 8 + wave; it < 2048; it += gridDim.x * 8) prep2_item(args, lds + wave * SSM_WL, it, lane); __syncthreads(); }
        if (!(pflags & 4)) for (int u = blockIdx.x; u < 256; u += gridDim.x) ssm_unit(args, lds, u >> 6, u & 63, wave, lane);
        if (!prep_first && !(pflags & 8)) for (int it = blockIdx.x * 8 + wave; it < 2048; it += gridDim.x * 8) prep2_item(args, lds + wave * SSM_WL, it, lane);
    }
    SEAM(2);
    if (IN(3)) {
        if (!(pflags & 2)) {
            pg8::Gemm g{(const bf16_t*)(ws + WS_YB), (const bf16_t*)(ws + WS_GLUT), NTOK, 1024, 1024}; pg8::StaticOrder S; S.init(NTOK, 1024, gridDim.x, (int)blockIdx.x);
            pg8::EpiGlu E{(const bf16_t*)(ws + WS_YB), (bf16_t*)(ws + WS_MIXED) + 1024, args.in[15], (float*)(ws + WS_CTL + CTL_RSS_SSM)};
            pg8::gemm_phase<pg8::EpiGlu, pg8::StaticOrder, false>(lds, g, S, E, nullptr);
        }
        __syncthreads();
        if (!(pflags & 1)) for (;;) {
            if (tid == 0) MISC[0] = atomicAdd((unsigned*)(ws + WS_CTL + CTL_QCTR), 1u);
            __syncthreads();
            const unsigned u = MISC[0];
            __syncthreads();
            if (u < 512u) attn_unit(args, lds, (int)u, tid, wave, lane, pflags);
            unsigned c = 0u;
            for (int rep = 0; rep < 2; ++rep) {
                if (tid == 0) MISC[1] = atomicAdd((unsigned*)(ws + WS_CTL + CTL_QCTR2), 1u);
                __syncthreads();
                c = MISC[1];
                __syncthreads();
                if (c < 1024u) table_chunk(args, (int)c, wave, lane); else break;
            }
            if (u >= 512u && c >= 1024u) break;
        }
    }
    SEAM(3);
    if (IN(4)) {
        pg8::Gemm g{(const bf16_t*)(ws + WS_MIXED), (const bf16_t*)(ws + WS_WOUTT), NTOK, DM, DM}; pg8::StaticOrder S; S.init(NTOK, DM, gridDim.x, (int)blockIdx.x);
        LAS float* tab = (LAS float*)(lds + 131072);
        { pg8::Unit u0; if (S.next(0, u0) && tid < 256) { const int row = u0.pm * 256 + tid;
            const float ra = 1.0f / sqrtf(((const float*)(ws + WS_CTL + CTL_RSS_ATTN))[row] * (1.f / 1024.f) + EPS), rs = 1.0f / sqrtf(((const float*)(ws + WS_CTL + CTL_RSS_SSM))[row] * (1.f / 1024.f) + EPS);
            tab[tid] = ra / rs; tab[256 + tid] = rs; } }
        __syncthreads();
        pg8::EpiWout E{args.in[0], args.out, (bf16_t*)(ws + WS_HB), (float*)(ws + WS_CTL + CTL_RSS_X1), tab};
        pg8::gemm_phase<pg8::EpiWout, pg8::StaticOrder, false>(lds, g, S, E, nullptr);
    }
    SEAM(4);
    if (IN(5)) {
        pg8::Gemm g{(const bf16_t*)(ws + WS_HB), (const bf16_t*)(ws + WS_WPT), NTOK, DM, DM}; pg8::StaticOrder S; S.init(NTOK, DM, gridDim.x, (int)blockIdx.x);
        pg8::EpiScores E{(float*)(ws + WS_PROJ), (const float*)(ws + WS_CTL + CTL_RSS_X1)};
        pg8::gemm_phase<pg8::EpiScores, pg8::StaticOrder, false>(lds, g, S, E, nullptr);
    }
    SEAM(5);
    if (IN(6)) { peer_wave(args, lds, wave, lane, pflags); }
#undef IN
#undef SEAM
}

#ifndef MK_DEBUG
#ifndef MK_PER_PHASE
#define MK_PER_PHASE 0
#endif
extern "C" void kernel_launch(void* const* d_in, const int* in_sizes, int n_in, void* d_out, int out_size, void* d_ws, size_t ws_size, hipStream_t stream) {
    static int grid = 0;
    if (grid == 0) {
        if (n_in != 25 || out_size != NTOK * DM || ws_size < WS_END) { fprintf(stderr, "kernel_launch: unexpected shapes / workspace (%d inputs, out %d, ws %zu < %zu)\n", n_in, out_size, ws_size, (size_t)WS_END); grid = -1; return; }
        int dev = 0, cus = 0, per_cu = 0;
        if (hipGetDevice(&dev) != hipSuccess || hipDeviceGetAttribute(&cus, hipDeviceAttributeMultiprocessorCount, dev) != hipSuccess) { grid = -1; return; }
        if (hipFuncSetAttribute((const void*)mk_fwd, hipFuncAttributeMaxDynamicSharedMemorySize, LDS_BYTES) != hipSuccess) { fprintf(stderr, "kernel_launch: hipFuncSetAttribute failed\n"); grid = -1; return; }
        if (hipOccupancyMaxActiveBlocksPerMultiprocessor(&per_cu, (const void*)mk_fwd, 512, LDS_BYTES) != hipSuccess || per_cu < 1) { fprintf(stderr, "kernel_launch: occupancy query reports %d\n", per_cu); }
        (void)hipGetLastError();
        if (cus < 256) { fprintf(stderr, "kernel_launch: built for a 256-CU device (found %d CUs): a 256-workgroup grid would not be resident; nothing launched\n", cus); grid = -1; return; }
        grid = 256;
    }
    if (grid < 0) return;
    (void)hipMemsetAsync((char*)d_ws + WS_CTL, 0, CTL_BYTES, stream);
    Args a{};
    for (int i = 0; i < 25; ++i) a.in[i] = (const float*)d_in[i];
    a.out = (float*)d_out; a.ws = (unsigned char*)d_ws;
#if MK_PER_PHASE
#ifndef MK_DUP
#define MK_DUP -1
#endif
    for (int p = 0; p < 7; ++p) { a.ph_lo = p; a.ph_hi = p + 1; hipLaunchKernelGGL(mk_fwd, dim3(grid), dim3(512), LDS_BYTES, stream, a);
        if (p == MK_DUP) {
            (void)hipMemsetAsync((char*)d_ws + WS_CTL + CTL_QCTR, 0, 512, stream);
#ifndef MK_DUP_FLAGS
#define MK_DUP_FLAGS 0
#endif
            if (p == 3 && !((MK_DUP_FLAGS) & (1 | 16 | 32 | 64))) (void)hipMemsetAsync((char*)d_ws + WS_CTL + CTL_RSS_ATTN, 0, 32768, stream);
            if (p == 3 && !((MK_DUP_FLAGS) & 2)) (void)hipMemsetAsync((char*)d_ws + WS_CTL + CTL_RSS_SSM, 0, 32768, stream);
            if (p == 4) (void)hipMemsetAsync((char*)d_ws + WS_CTL + CTL_RSS_X1, 0, 32768, stream);
            a.ph_hi |= (MK_DUP_FLAGS) << 8;
            hipLaunchKernelGGL(mk_fwd, dim3(grid), dim3(512), LDS_BYTES, stream, a); } }
#else
    a.ph_lo = 0; a.ph_hi = 7;
    hipLaunchKernelGGL(mk_fwd, dim3(grid), dim3(512), LDS_BYTES, stream, a);
#endif
}
#endif
```

```cpp
#include <hip/hip_runtime.h>
#include <stdint.h>
#include <stdio.h>

typedef unsigned short bf16_t;
typedef float f32x2 __attribute__((ext_vector_type(2)));
typedef unsigned u32x2 __attribute__((ext_vector_type(2)));
using bf16x2v = __attribute__((ext_vector_type(2))) __bf16;

constexpr int NTOK = 8192, SEQ = 2048, DM = 2048, DPROJ = 4096;
constexpr float EPS = 1e-6f;
constexpr float LOG2E = 1.4426950408889634f;

constexpr size_t MB = 1024 * 1024;
constexpr size_t WS_CTL = 0;
constexpr size_t CTL_BYTES = 128 * 1024;
constexpr size_t CTL_QCTR = 16384;
constexpr size_t CTL_QCTR2 = 16384 + 256;
constexpr size_t CTL_RSS_ATTN = 32768, CTL_RSS_SSM = 65536, CTL_RSS_X1 = 98304;
constexpr size_t WS_HB = 256 * 1024;
constexpr size_t WS_WINT = WS_HB + 32 * MB;
constexpr size_t WS_GLUT = WS_WINT + 16 * MB;
constexpr size_t WS_WOUTT = WS_GLUT + 2 * MB;
constexpr size_t WS_WPT = WS_WOUTT + 8 * MB;
constexpr size_t WS_UB = WS_WPT + 8 * MB;
constexpr size_t WS_VB = WS_UB + 32 * MB;
constexpr size_t WS_SN = WS_VB;
constexpr size_t WS_SU = WS_VB + 32 * MB;
constexpr size_t WS_SV = WS_SU + 65536;
constexpr size_t WS_PROJ = WS_SV + 65536;
constexpr size_t WS_QF = WS_PROJ + 64 * MB;
constexpr size_t WS_KF = WS_QF + 48 * MB;
constexpr size_t WS_VT = WS_KF + 48 * MB;
constexpr size_t WS_QN = WS_QF, WS_KN = WS_KF;
constexpr size_t WS_YB = WS_VT + 48 * MB + 4096;
constexpr size_t WS_MIXED = WS_YB + 16 * MB;
constexpr size_t WS_SSMP = WS_MIXED + 32 * MB;
constexpr size_t SSMP_ABAR = 0, SSMP_A256 = 32768, SSMP_BFRAG = 65536, SSMP_CFRAG = 65536 + 524288;
constexpr size_t SSMP_BBT = 1 * MB;
constexpr size_t SSMP_VAND = 2 * MB;
constexpr size_t WS_BTAB = WS_SSMP + 8 * MB;
constexpr size_t WS_END = WS_BTAB + 64 * 1024;

constexpr int LDS_BYTES = 147456;
constexpr int MISC_OFF = 147456 - 256;
#define XB_TMO      128
#define XB_XCNT(j)  (256  + 64 * (j))
#define XB_XSUB(j)  (1280 + 64 * (j))
#define XB_XGEN(j)  (2304 + 64 * (j))
#define XB_TOP      3328
#define XB_TOPGEN   3392
#define XCD_BAR_WORDS 3456
#define XB_SPIN_CAP (1u << 18)
#define LAS __attribute__((address_space(3)))

__device__ __forceinline__ unsigned xb_ld(unsigned* p)              { return __hip_atomic_load(p, __ATOMIC_RELAXED, __HIP_MEMORY_SCOPE_AGENT); }
__device__ __forceinline__ unsigned xb_add(unsigned* p, unsigned v) { return __hip_atomic_fetch_add(p, v, __ATOMIC_RELAXED, __HIP_MEMORY_SCOPE_AGENT); }
__device__ __forceinline__ unsigned xb_xcc_id() { return (unsigned)__builtin_amdgcn_s_getreg((3 << 11) | 20) & 0xFu; }
#define XB_SPIN(cond, bar) do { unsigned _sp = 0; while (cond) { __builtin_amdgcn_s_sleep(1); \
    if ((++_sp & 255u) == 0u) { if (xb_ld(&(bar)[XB_TMO])) break; if (_sp > XB_SPIN_CAP) { atomicAdd(&(bar)[XB_TMO], 1u); break; } } } } while (0)

struct XcdBarrier {
    unsigned* bar; unsigned x;
    volatile LAS unsigned* st;
};

__device__ __forceinline__ XcdBarrier xcd_barrier_post(unsigned* bar, volatile LAS unsigned* st) {
    XcdBarrier b; b.bar = bar; b.x = xb_xcc_id(); b.st = st;
    if (threadIdx.x == 0) (void)xb_add(&bar[XB_XCNT(b.x)], 1u);
    return b;
}
__device__ __forceinline__ void xcd_barrier_complete(unsigned* bar, unsigned x, unsigned& nloc, unsigned& nx) {
    const unsigned G = gridDim.x * gridDim.y * gridDim.z;
    unsigned sum, cnt, mine, sp = 0u;
    for (;;) {
        sum = 0u; cnt = 0u; mine = 0u;
#pragma unroll
        for (unsigned j = 0; j < 16; ++j) { const unsigned c = xb_ld(&bar[XB_XCNT(j)]); sum += c; cnt += (c > 0u) ? 1u : 0u; mine = (j == x) ? c : mine; }
        if (sum == G) break;
        __builtin_amdgcn_s_sleep(1);
        if ((++sp & 255u) == 0u) { if (xb_ld(&bar[XB_TMO])) break; if (sp > XB_SPIN_CAP) { atomicAdd(&bar[XB_TMO], 1u); break; } }
    }
    nloc = mine > 0u ? mine : 1u; nx = cnt > 0u ? cnt : 1u;
}

__device__ __forceinline__ void xcd_barrier(const XcdBarrier& b) {
    asm volatile("s_waitcnt vmcnt(0)" ::: "memory");
    __syncthreads();
    if (threadIdx.x == 0) {
        unsigned* bar = b.bar;
        __builtin_amdgcn_s_waitcnt(0);
        unsigned nloc = b.st[0], nx = b.st[1];
        if (nloc == 0u) { xcd_barrier_complete(bar, b.x, nloc, nx); b.st[0] = nloc; b.st[1] = nx; }
        const unsigned old = xb_add(&bar[XB_XSUB(b.x)], 1u);
        const unsigned gen = old / nloc;
        if (old + 1u == (gen + 1u) * nloc) {
            __builtin_amdgcn_fence(__ATOMIC_RELEASE, "agent");
            asm volatile("s_waitcnt vmcnt(0)" ::: "memory");
            const unsigned og = xb_add(&bar[XB_TOP], 1u);
            const unsigned tg = og / nx;
            if (og + 1u == (tg + 1u) * nx) xb_add(&bar[XB_TOPGEN], 1u);
            else XB_SPIN(xb_ld(&bar[XB_TOPGEN]) == tg, bar);
            __builtin_amdgcn_fence(__ATOMIC_ACQUIRE, "agent");
            xb_add(&bar[XB_XGEN(b.x)], 1u);
            asm volatile("s_waitcnt vmcnt(0)" ::: "memory");
        } else {
            XB_SPIN(xb_ld(&bar[XB_XGEN(b.x)]) == gen, bar);
            __builtin_amdgcn_fence(__ATOMIC_ACQUIRE, "agent");
            asm volatile("s_waitcnt vmcnt(0)" ::: "memory");
        }
    }
    __syncthreads();
}
namespace pg8 {
#define PG8_LAS __attribute__((address_space(3)))
typedef unsigned short bf16_t;
typedef short bf16x8 __attribute__((ext_vector_type(8)));
typedef float f32x4 __attribute__((ext_vector_type(4)));
typedef unsigned u32x4 __attribute__((ext_vector_type(4)));
constexpr int BM = 256, BK = 64, HALF = 128, HTB = HALF * BK * 2  , STAGE_BYTES = 8 * HTB, NXCD = 8, WGM = 8;

__host__ __device__ __forceinline__ int lds_byte(int r, int c) { const int st = (r >> 4) * 2 + (c >> 5), rr = r & 15, cc = c & 31, ob = rr * 64 + cc * 2; return st * 1024 + (ob ^ (((ob >> 9) & 1) << 5)); }
__host__ __device__ __forceinline__ void stage_rc(int b, int& R, int& C) { const int st = b / 1024, sb = b % 1024, swz = sb ^ (((sb >> 9) & 1) << 5); R = (st >> 1) * 16 + swz / 64; C = (st & 1) * 32 + (swz % 64) / 2; }
__host__ __device__ __forceinline__ int perm32(int rho) { const int n = rho >> 4, i = rho & 15; return 8 * (i >> 2) + 4 * n + (i & 3); }

struct Unit { int pm, pn; };
struct Gemm { const bf16_t* A; const bf16_t* Bt; int M, N, K; };

struct StaticOrder {
    int nM, nN, nwg, G, c;
    __host__ __device__ void init(int M, int N, int G_, int c_) { nM = M / BM; nN = N / BM; nwg = nM * nN; G = G_; c = c_; }
    __host__ __device__ bool next(int i, Unit& u) const {
        const long L = (long)i * G + c; if (L >= nwg) return false;
        int wgid = (int)L; { const int q = nwg / NXCD, r = nwg % NXCD, xcd = wgid % NXCD, off = wgid / NXCD; wgid = (xcd < r ? xcd * (q + 1) : r * (q + 1) + (xcd - r) * q) + off; }
        const int nig = WGM * nN, gid = wgid / nig, fm = gid * WGM, gsz = (nM - fm) < WGM ? (nM - fm) : WGM;
        u.pm = fm + ((wgid % nig) % gsz); u.pn = (wgid % nig) / gsz; return true;
    }
    __device__ __forceinline__ void a_ready(const Unit&) const {}
    __device__ __forceinline__ void done(const Unit&) const {}
};
typedef float cvt_f32x2 __attribute__((ext_vector_type(2)));
typedef __bf16 cvt_bf16x2 __attribute__((ext_vector_type(2)));
__device__ __forceinline__ unsigned cvt_pk_bf16(float lo, float hi) { return __builtin_bit_cast(unsigned, __builtin_convertvector((cvt_f32x2){lo, hi}, cvt_bf16x2)); }
__device__ __forceinline__ float bflo(unsigned u) { return __uint_as_float(u << 16); }
__device__ __forceinline__ float bfhi(unsigned u) { return __uint_as_float(u & 0xffff0000u); }

struct EpiProj {
    static constexpr bool PERM = true, AFTER_DRAIN = false, HAS_MID = false;
    bf16_t* O; int ldc;
    __device__ __forceinline__ void mid(f32x4 (&)[2][2][4][2], const Unit&, int, int, int, int) const {}
    __device__ __forceinline__ void operator()(const f32x4 (&acc)[2][2][4][2], const Unit& u, int wr, int wc, int fr, int fq) const {
        const int row0 = u.pm * BM + wr * 64 + fr, col0 = u.pn * BM + wc * 32 + 8 * fq;
#pragma unroll
        for (int ai = 0; ai < 2; ++ai)
#pragma unroll
            for (int m = 0; m < 4; ++m) { bf16_t* rowp = O + (size_t)(row0 + ai * HALF + m * 16) * ldc + col0;
#pragma unroll
                for (int bj = 0; bj < 2; ++bj) { const f32x4 v0 = acc[ai][bj][m][0], v1 = acc[ai][bj][m][1];
                    u32x4 w; w.x = cvt_pk_bf16(v0[0], v0[1]); w.y = cvt_pk_bf16(v0[2], v0[3]); w.z = cvt_pk_bf16(v1[0], v1[1]); w.w = cvt_pk_bf16(v1[2], v1[3]);
                    *(u32x4*)(rowp + bj * HALF) = w; } }
    }
};

struct EpiGlu {
    static constexpr bool PERM = true, AFTER_DRAIN = false, HAS_MID = false;
    const bf16_t* Y; bf16_t* O; const float* bias; float* rss;
    __device__ __forceinline__ void mid(f32x4 (&)[2][2][4][2], const Unit&, int, int, int, int) const {}
    __device__ __forceinline__ void operator()(const f32x4 (&acc)[2][2][4][2], const Unit& u, int wr, int wc, int fr, int fq) const {
        const int row0 = u.pm * BM + wr * 64 + fr, col0 = u.pn * BM + wc * 32 + 8 * fq;
        f32x4 bv[2][2];
#pragma unroll
        for (int bj = 0; bj < 2; ++bj)
#pragma unroll
            for (int n = 0; n < 2; ++n) bv[bj][n] = *(const f32x4*)(bias + col0 + bj * HALF + 4 * n);
        u32x4 yq[2][2];
#pragma unroll
        for (int bj = 0; bj < 2; ++bj) yq[0][bj] = *(const u32x4*)(Y + (size_t)row0 * 1024 + col0 + bj * HALF);
#pragma unroll
        for (int idx = 0; idx < 8; ++idx) { const int ai = idx >> 2, m = idx & 3, row = row0 + ai * HALF + m * 16; float ss = 0.f;
            if (idx < 7) { const int nrow = row0 + ((idx + 1) >> 2) * HALF + ((idx + 1) & 3) * 16;
#pragma unroll
                for (int bj = 0; bj < 2; ++bj) yq[(idx + 1) & 1][bj] = *(const u32x4*)(Y + (size_t)nrow * 1024 + col0 + bj * HALF); }
#pragma unroll
            for (int bj = 0; bj < 2; ++bj) {
                const u32x4 yv = yq[idx & 1][bj];
                const f32x4 g0 = acc[ai][bj][m][0] + bv[bj][0], g1 = acc[ai][bj][m][1] + bv[bj][1];
                float y[8] = {bflo(yv.x), bfhi(yv.x), bflo(yv.y), bfhi(yv.y), bflo(yv.z), bfhi(yv.z), bflo(yv.w), bfhi(yv.w)};
                float o[8];
#pragma unroll
                for (int e = 0; e < 4; ++e) { o[e] = y[e] * __builtin_amdgcn_rcpf(1.f + __expf(-g0[e])); o[4 + e] = y[4 + e] * __builtin_amdgcn_rcpf(1.f + __expf(-g1[e])); }
#pragma unroll
                for (int e = 0; e < 8; ++e) ss += o[e] * o[e];
                u32x4 w; w.x = cvt_pk_bf16(o[0], o[1]); w.y = cvt_pk_bf16(o[2], o[3]); w.z = cvt_pk_bf16(o[4], o[5]); w.w = cvt_pk_bf16(o[6], o[7]);
                *(u32x4*)(O + (size_t)row * 2048 + col0 + bj * HALF) = w; }
            ss += __shfl_xor(ss, 16); ss += __shfl_xor(ss, 32);
            if (fq == 0) unsafeAtomicAdd(rss + row, ss); }
    }
};

struct EpiWout {
    static constexpr bool PERM = true, AFTER_DRAIN = false, HAS_MID = true;
    const float* X; float* OUT; bf16_t* XB; float* rss_x; const PG8_LAS float* tab;
    __device__ __forceinline__ void mid(f32x4 (&acc)[2][2][4][2], const Unit& u, int wr, int wc, int fr, int fq) const {
        const PG8_LAS float* tp = tab + wr * 64 + fr;
#pragma unroll
        for (int ai = 0; ai < 2; ++ai)
#pragma unroll
            for (int m = 0; m < 4; ++m) { const float ratio = tp[ai * HALF + m * 16];
#pragma unroll
                for (int bj = 0; bj < 2; ++bj)
#pragma unroll
                    for (int n = 0; n < 2; ++n) acc[ai][bj][m][n] *= ratio; }
    }
    __device__ __forceinline__ void operator()(const f32x4 (&acc)[2][2][4][2], const Unit& u, int wr, int wc, int fr, int fq) const {
        const int row0 = u.pm * BM + wr * 64 + fr, col0 = u.pn * BM + wc * 32 + 8 * fq;
        const PG8_LAS float* tp = tab + 256 + wr * 64 + fr;
        f32x4 xq[2][2][2];
#pragma unroll
        for (int bj = 0; bj < 2; ++bj) { const size_t o = (size_t)row0 * 2048 + col0 + bj * HALF; xq[0][bj][0] = *(const f32x4*)(X + o); xq[0][bj][1] = *(const f32x4*)(X + o + 4); }
#pragma unroll
        for (int idx = 0; idx < 8; ++idx) { const int ai = idx >> 2, m = idx & 3, row = row0 + ai * HALF + m * 16; float ss = 0.f;
            if (idx < 7) { const int nrow = row0 + ((idx + 1) >> 2) * HALF + ((idx + 1) & 3) * 16;
#pragma unroll
                for (int bj = 0; bj < 2; ++bj) { const size_t o = (size_t)nrow * 2048 + col0 + bj * HALF; xq[(idx + 1) & 1][bj][0] = *(const f32x4*)(X + o); xq[(idx + 1) & 1][bj][1] = *(const f32x4*)(X + o + 4); } }
            const float rs = tp[ai * HALF + m * 16];
#pragma unroll
            for (int bj = 0; bj < 2; ++bj) { const size_t o = (size_t)row * 2048 + col0 + bj * HALF;
                const f32x4 v0 = xq[idx & 1][bj][0] + rs * acc[ai][bj][m][0], v1 = xq[idx & 1][bj][1] + rs * acc[ai][bj][m][1];
                u32x4 w; w.x = cvt_pk_bf16(v0[0], v0[1]); w.y = cvt_pk_bf16(v0[2], v0[3]); w.z = cvt_pk_bf16(v1[0], v1[1]); w.w = cvt_pk_bf16(v1[2], v1[3]);
                *(u32x4*)(XB + o) = w;
#pragma unroll
                for (int e = 0; e < 4; ++e) ss += v0[e] * v0[e] + v1[e] * v1[e]; }
            ss += __shfl_xor(ss, 16); ss += __shfl_xor(ss, 32);
            if (fq == 0) unsafeAtomicAdd(rss_x + row, ss); }
    }
};

struct EpiScores {
    static constexpr bool PERM = false, AFTER_DRAIN = false, HAS_MID = false;
    float* C; const float* rss_x;
    __device__ __forceinline__ void mid(f32x4 (&)[2][2][4][2], const Unit&, int, int, int, int) const {}
    __device__ __forceinline__ void operator()(const f32x4 (&acc)[2][2][4][2], const Unit& u, int wr, int wc, int fr, int fq) const {
        const int row0 = u.pm * BM + wr * 64 + fr, col0 = u.pn * BM + wc * 32 + 4 * fq;
        float r2v[8];
#pragma unroll
        for (int idx = 0; idx < 8; ++idx) r2v[idx] = rss_x[row0 + (idx >> 2) * HALF + (idx & 3) * 16];
#pragma unroll
        for (int ai = 0; ai < 2; ++ai)
#pragma unroll
            for (int m = 0; m < 4; ++m) { const int row = row0 + ai * HALF + m * 16;
                const float r2 = __builtin_amdgcn_rsqf(r2v[ai * 4 + m] * (1.f / 2048.f) + 1e-6f);
                float* rowp = C + (size_t)row * 2048 + col0;
#pragma unroll
                for (int bj = 0; bj < 2; ++bj)
#pragma unroll
                    for (int n = 0; n < 2; ++n) *(f32x4*)(rowp + bj * HALF + n * 16) = acc[ai][bj][m][n] * r2; }
    }
};

template <class Epi, class Sched, bool STAMP = false>
__device__ __forceinline__ void gemm_phase(PG8_LAS unsigned char* lds, const Gemm g, const Sched& S, const Epi& E, unsigned long long* stamps) {
    const int tid = threadIdx.x, wid = __builtin_amdgcn_readfirstlane(tid >> 6), lane = tid & 63, wr = wid >> 2, wc = wid & 3, fr = lane & 15, fq = lane >> 4;
    const int K = g.K, nt = K / BK;
    int ts_lo = 0, ts_hi = 0, nts = 0; const unsigned long long rt_entry = STAMP ? (unsigned long long)wall_clock64() : 0ull;
#define PG8_STAMP() do { if (STAMP && wid == 0 && nts < 64) { const unsigned long long _c = (unsigned long long)clock64(); \
        ts_lo = (lane == nts) ? (int)(unsigned)_c : ts_lo; ts_hi = (lane == nts) ? (int)(unsigned)(_c >> 32) : ts_hi; ++nts; } } while (0)
    PG8_STAMP();
    unsigned voffA[2], voffB[2];
#pragma unroll
    for (int i = 0; i < 2; ++i) { int R, C; stage_rc(tid * 16 + i * 8192, R, C); const int Rb = Epi::PERM ? ((R & ~31) + perm32(R & 31)) : R;
        voffA[i] = (unsigned)(R * K + C) * 2u; voffB[i] = (unsigned)(Rb * K + C) * 2u; }
    const size_t kstep = (size_t)(BK * 2);
    const size_t hstep = (size_t)HALF * K * 2;
    const size_t tstep = 2 * hstep;
    const unsigned ldsw = (unsigned)wid * 1024u;
    const int aoff = lds_byte(wr * 64 + fr, fq * 8), boff = lds_byte(wc * 32 + fr, fq * 8);
#define PG8_SA(b, h) (((b) * 2 + (h)) * HTB)
#define PG8_SB(b, h) ((4 + (b) * 2 + (h)) * HTB)
#define PG8_STAGE(bufoff, gbase, voff) do { _Pragma("unroll") for (int _i = 0; _i < 2; ++_i) \
        __builtin_amdgcn_global_load_lds((const unsigned*)((const char*)(gbase) + (voff)[_i]), (PG8_LAS unsigned*)(lds + (bufoff) + ldsw + _i * 8192), 16, 0, 0); } while (0)
#define PG8_LDA(dst, b, h) do { _Pragma("unroll") for (int m = 0; m < 4; ++m) _Pragma("unroll") for (int k = 0; k < 2; ++k) dst[m][k] = *(const PG8_LAS bf16x8*)(lds + PG8_SA(b, h) + aoff + m * 2048 + k * 1024); } while (0)
#define PG8_LDB(dst, b, h) do { _Pragma("unroll") for (int n = 0; n < 2; ++n) _Pragma("unroll") for (int k = 0; k < 2; ++k) dst[n][k] = *(const PG8_LAS bf16x8*)(lds + PG8_SB(b, h) + boff + n * 2048 + k * 1024); } while (0)
#define PG8_MMA(ai, bj, At, Bt) do { __builtin_amdgcn_s_setprio(1); _Pragma("unroll") for (int m = 0; m < 4; ++m) _Pragma("unroll") for (int n = 0; n < 2; ++n) _Pragma("unroll") for (int k = 0; k < 2; ++k) \
        acc[ai][bj][m][n] = __builtin_amdgcn_mfma_f32_16x16x32_bf16(Bt[n][k], At[m][k], acc[ai][bj][m][n], 0, 0, 0); __builtin_amdgcn_s_setprio(0); } while (0)
#define PG8_WAIT_V(n) asm volatile("s_waitcnt vmcnt(" #n ")" ::: "memory")
#define PG8_WAIT_L(n) asm volatile("s_waitcnt lgkmcnt(" #n ")" ::: "memory")
#define PG8_BAR __builtin_amdgcn_s_barrier()
#define PG8_SCHED __builtin_amdgcn_sched_barrier(0)
    Unit cur, nxt; int ui = 0;
    if (!S.next(0, cur)) return;
    f32x4 acc[2][2][4][2];
#pragma unroll
    for (int a = 0; a < 2; ++a)
#pragma unroll
        for (int b = 0; b < 2; ++b)
#pragma unroll
            for (int m = 0; m < 4; ++m)
#pragma unroll
                for (int n = 0; n < 2; ++n) acc[a][b][m][n] = (f32x4){0.f, 0.f, 0.f, 0.f};
    bf16x8 At[4][2], B0[2][2], B1[2][2];
    const char* cA = (const char*)g.A + (size_t)cur.pm * tstep; const char* cB = (const char*)g.Bt + (size_t)cur.pn * tstep;
    S.a_ready(cur);
    PG8_STAGE(PG8_SB(0, 0), cB, voffB); PG8_STAGE(PG8_SA(0, 0), cA, voffA); PG8_STAGE(PG8_SB(0, 1), cB + hstep, voffB); PG8_STAGE(PG8_SA(0, 1), cA + hstep, voffA);
    if (wr == 1) PG8_BAR;
    PG8_WAIT_V(4); PG8_BAR;
    PG8_STAGE(PG8_SB(1, 0), cB + kstep, voffB); PG8_STAGE(PG8_SA(1, 0), cA + kstep, voffA); PG8_STAGE(PG8_SB(1, 1), cB + hstep + kstep, voffB);
    PG8_WAIT_V(6); PG8_BAR;
    PG8_STAMP();
    for (;;) {
        const bool has_next = S.next(ui + 1, nxt);
        const char* nA = has_next ? (const char*)g.A + (size_t)nxt.pm * tstep : cA; const char* nB = has_next ? (const char*)g.Bt + (size_t)nxt.pn * tstep : cB;
        for (int t = 0; t < nt; t += 2) {
            const bool last = (t == nt - 2);
            const char* a1 = cA + (size_t)(t + 1) * kstep;
            const char* a2 = last ? nA : cA + (size_t)(t + 2) * kstep; const char* b2 = last ? nB : cB + (size_t)(t + 2) * kstep;
            const char* a3 = a2 + kstep; const char* b3 = b2 + kstep;
            if (last && has_next) S.a_ready(nxt);
            if constexpr (Epi::HAS_MID) { if (t == (nt >> 1)) { E.mid(acc, cur, wr, wc, fr, fq); asm volatile("s_waitcnt lgkmcnt(0)" ::: "memory"); } }
            PG8_LDB(B0, 0, 0); PG8_SCHED; PG8_LDA(At, 0, 0); PG8_STAGE(PG8_SA(1, 1), a1 + hstep, voffA);
            PG8_WAIT_L(8); PG8_BAR; PG8_WAIT_L(0); PG8_MMA(0, 0, At, B0); PG8_BAR; PG8_SCHED;
            PG8_LDB(B1, 0, 1); PG8_STAGE(PG8_SB(0, 0), b2, voffB);
            PG8_BAR; PG8_WAIT_L(0); PG8_MMA(0, 1, At, B1); PG8_BAR;
            PG8_LDA(At, 0, 1); PG8_STAGE(PG8_SA(0, 0), a2, voffA);
            PG8_BAR; PG8_WAIT_L(0); PG8_MMA(1, 0, At, B0); PG8_BAR; PG8_SCHED;
            PG8_STAGE(PG8_SB(0, 1), b2 + hstep, voffB);
            PG8_WAIT_V(6); PG8_BAR; PG8_MMA(1, 1, At, B1); PG8_BAR;
            PG8_LDB(B0, 1, 0); PG8_SCHED; PG8_LDA(At, 1, 0); PG8_STAGE(PG8_SA(0, 1), a2 + hstep, voffA);
            PG8_WAIT_L(8); PG8_BAR; PG8_WAIT_L(0); PG8_MMA(0, 0, At, B0); PG8_BAR; PG8_SCHED;
            PG8_LDB(B1, 1, 1); PG8_STAGE(PG8_SB(1, 0), b3, voffB);
            PG8_BAR; PG8_WAIT_L(0); PG8_MMA(0, 1, At, B1); PG8_BAR;
            PG8_LDA(At, 1, 1); PG8_STAGE(PG8_SA(1, 0), a3, voffA);
            PG8_BAR; PG8_WAIT_L(0); PG8_MMA(1, 0, At, B0); PG8_BAR; PG8_SCHED;
            PG8_STAGE(PG8_SB(1, 1), b3 + hstep, voffB);
            PG8_WAIT_V(6); PG8_BAR; PG8_MMA(1, 1, At, B1); PG8_BAR;
        }
        PG8_STAMP();
        if constexpr (!Epi::AFTER_DRAIN) { E(acc, cur, wr, wc, fr, fq); S.done(cur); }
        PG8_STAMP();
        if (!has_next) break;
#pragma unroll
        for (int a = 0; a < 2; ++a)
#pragma unroll
            for (int b = 0; b < 2; ++b)
#pragma unroll
                for (int m = 0; m < 4; ++m)
#pragma unroll
                    for (int n = 0; n < 2; ++n) acc[a][b][m][n] = (f32x4){0.f, 0.f, 0.f, 0.f};
        cur = nxt; cA = nA; cB = nB; ++ui;
    }
    PG8_WAIT_V(0);
    if (wr == 0) PG8_BAR;
    PG8_BAR;
    if constexpr (Epi::AFTER_DRAIN) { E.fused(acc, cur, wr, wc, fr, fq, lds, wid, lane); S.done(cur); }
    PG8_STAMP();
    if (STAMP && wid == 0) { stamps[lane] = lane < nts ? (((unsigned long long)(unsigned)ts_hi << 32) | (unsigned)ts_lo) : 0ull;
        if (lane == 62) stamps[62] = rt_entry; if (lane == 63) stamps[63] = (unsigned long long)wall_clock64(); }
#undef PG8_STAMP
#undef PG8_SA
#undef PG8_SB
#undef PG8_STAGE
#undef PG8_LDA
#undef PG8_LDB
#undef PG8_MMA
#undef PG8_WAIT_V
#undef PG8_WAIT_L
#undef PG8_BAR
#undef PG8_SCHED
}
}

typedef short bf16x8 __attribute__((ext_vector_type(8)));
typedef float f32x4 __attribute__((ext_vector_type(4)));
typedef unsigned u32x4 __attribute__((ext_vector_type(4)));
using pg8::cvt_pk_bf16; using pg8::bflo; using pg8::bfhi;

#define LDS_WAIT() asm volatile("s_waitcnt lgkmcnt(0)" ::: "memory")
#define CBAR() asm volatile("" ::: "memory")
#define MFMA16(a, b, c) __builtin_amdgcn_mfma_f32_16x16x32_bf16((a), (b), (c), 0, 0, 0)

struct Args { const float* in[25]; float* out; unsigned char* ws; int ph_lo, ph_hi; };

__device__ __forceinline__ float wave_sum(float v) {
#pragma unroll
    for (int o = 1; o < 64; o <<= 1) v += __shfl_xor(v, o);
    return v;
}
__device__ __forceinline__ float wave_max(float v) {
#pragma unroll
    for (int o = 1; o < 64; o <<= 1) v = fmaxf(v, __shfl_xor(v, o));
    return v;
}
#define DPP_U(x, ctrl) ((unsigned)__builtin_amdgcn_update_dpp((int)(x), (int)(x), ctrl, 0xf, 0xf, false))
__device__ __forceinline__ unsigned row16_umax(unsigned v) { unsigned t;
    t = DPP_U(v, 0xB1); v = t > v ? t : v; t = DPP_U(v, 0x4E); v = t > v ? t : v; t = DPP_U(v, 0x141); v = t > v ? t : v; t = DPP_U(v, 0x140); v = t > v ? t : v; return v; }
__device__ __forceinline__ float row16_fmax(float v) { float t;
    t = __uint_as_float(DPP_U(__float_as_uint(v), 0xB1)); v = fmaxf(v, t); t = __uint_as_float(DPP_U(__float_as_uint(v), 0x4E)); v = fmaxf(v, t);
    t = __uint_as_float(DPP_U(__float_as_uint(v), 0x141)); v = fmaxf(v, t); t = __uint_as_float(DPP_U(__float_as_uint(v), 0x140)); v = fmaxf(v, t); return v; }
__device__ __forceinline__ float row16_fsum(float v) {
    v += __uint_as_float(DPP_U(__float_as_uint(v), 0xB1)); v += __uint_as_float(DPP_U(__float_as_uint(v), 0x4E));
    v += __uint_as_float(DPP_U(__float_as_uint(v), 0x141)); v += __uint_as_float(DPP_U(__float_as_uint(v), 0x140)); return v; }
__device__ __forceinline__ unsigned wave_umax(unsigned v) { v = row16_umax(v);
    const unsigned a = (unsigned)__builtin_amdgcn_readlane((int)v, 0), b = (unsigned)__builtin_amdgcn_readlane((int)v, 16), c = (unsigned)__builtin_amdgcn_readlane((int)v, 32), d = (unsigned)__builtin_amdgcn_readlane((int)v, 48);
    const unsigned ab = a > b ? a : b, cd = c > d ? c : d; return ab > cd ? ab : cd; }
__device__ __forceinline__ float gelu_erf(float x) { return 0.5f * x * (1.0f + erff(x * 0.70710678118654752f)); }
__device__ __forceinline__ float gelu_as(float v) {
    const float av = fabsf(v), t = __builtin_amdgcn_rcpf(fmaf(av, 0.2316418882f, 1.0f));
    float q = fmaf(t, 0.5307027145f, -0.7265760135f); q = fmaf(q, t, 0.7107068705f); q = fmaf(q, t, -0.142248368f); q = fmaf(q, t, 0.127414796f); q *= t;
    const float e = __builtin_amdgcn_exp2f(v * v * -0.72134752044f), m = v * (q * e);
    return v < 0.f ? m : v - m;
}
__device__ __forceinline__ bf16x8 as_bf16x8(u32x4 v) { return __builtin_bit_cast(bf16x8, v); }

__device__ __forceinline__ void p0_transpose_item(const float* W, int K, int N, bf16_t* WT, const float* sc_a, const float* sc_b, LAS float* scr, int item, int lane) {
    const int nblk = N / 32, kb = item / nblk, nb = item % nblk, k0 = 64 * kb, n0 = 32 * nb;
#pragma unroll 8
    for (int i = 0; i < 32; ++i) { const int kk = 2 * i + (lane >> 5); const int k = k0 + kk;
        const float s = sc_a ? (k < 1024 ? sc_a[k] : sc_b[k - 1024]) : 1.f;
        scr[kk * 33 + (lane & 31)] = W[(size_t)k * N + n0 + (lane & 31)] * s; }
    LDS_WAIT();
    const int c = lane & 7;
#pragma unroll
    for (int j = 0; j < 4; ++j) { const int n = (lane >> 3) + 8 * j; const LAS float* s = scr + (8 * c) * 33 + n;
        u32x4 o; o.x = cvt_pk_bf16(s[0 * 33], s[1 * 33]); o.y = cvt_pk_bf16(s[2 * 33], s[3 * 33]); o.z = cvt_pk_bf16(s[4 * 33], s[5 * 33]); o.w = cvt_pk_bf16(s[6 * 33], s[7 * 33]);
        *(u32x4*)(WT + (size_t)(n0 + n) * K + k0 + 8 * c) = o; }
    LDS_WAIT();
}
template <int MODE> __device__ __forceinline__ void p0_row(const float* xrow, const float* g, bf16_t* orow, int lane) {
    const f32x4* xr = (const f32x4*)xrow + lane; const f32x4* gr = (const f32x4*)g + lane;
    f32x4 v[8]; float s = 0.f;
#pragma unroll
    for (int j = 0; j < 8; ++j) { v[j] = xr[64 * j]; s += (v[j].x * v[j].x + v[j].y * v[j].y) + (v[j].z * v[j].z + v[j].w * v[j].w); }
    float r = 1.f;
    if (MODE == 0) r = 1.0f / sqrtf(wave_sum(s) * (1.f / 2048.f) + EPS);
    u32x2* o8 = (u32x2*)orow + lane;
#pragma unroll
    for (int j = 0; j < 8; ++j) { f32x4 w = v[j] * r; if (MODE != 2) w = w * gr[64 * j];
        u32x2 o; o.x = cvt_pk_bf16(w.x, w.y); o.y = cvt_pk_bf16(w.z, w.w); o8[64 * j] = o; }
}
template <bool SCALE_G, bool OFFS> __device__ __forceinline__ void p0_row_q8(const float* xrow, const float* g, unsigned char* orow, float* sc, int lane) {
    const f32x4* xr = (const f32x4*)xrow + lane; const f32x4* gr = (const f32x4*)g + lane;
    f32x4 v[8]; float m = 0.f;
#pragma unroll
    for (int j = 0; j < 8; ++j) { v[j] = xr[64 * j]; if (SCALE_G) v[j] = v[j] * gr[64 * j];
        m = fmaxf(fmaxf(m, fmaxf(fabsf(v[j].x), fabsf(v[j].y))), fmaxf(fabsf(v[j].z), fabsf(v[j].w))); }
    m = fmaxf(wave_max(m), 1e-30f);
    const float inv = 127.f / m;
    if (lane == 0) *sc = m * (1.f / 127.f);
    unsigned* o4 = (unsigned*)orow + lane;
#pragma unroll
    for (int j = 0; j < 8; ++j) { const int a = (int)rintf(v[j].x * inv) + (OFFS ? 128 : 0), b = (int)rintf(v[j].y * inv) + (OFFS ? 128 : 0), c = (int)rintf(v[j].z * inv) + (OFFS ? 128 : 0), d = (int)rintf(v[j].w * inv) + (OFFS ? 128 : 0);
        o4[64 * j] = (unsigned)(a & 255) | ((unsigned)(b & 255) << 8) | ((unsigned)(c & 255) << 16) | ((unsigned)(d & 255) << 24); }
}
template <int KIND> __device__ __forceinline__ void p0_rows(const float* src, const float* g, void* dst, float* sc, int first, int stride, int nrows, int lane) {
    const f32x4* gr = (const f32x4*)g + lane;
    f32x4 cur[8], nxt[8], nx2[8];
    int r = first;
    if (r >= nrows) return;
    const int lo4 = KIND == 4 ? 256 * ((lane >> 1) & 1) + 4 * (lane >> 2) + 2 * (lane & 1) : lane;
#define P0_ROW_LOAD(dstv, rr) { const f32x4* xr = (const f32x4*)(src + (size_t)(rr) * 2048) + lo4; \
        _Pragma("unroll") for (int j = 0; j < 8; ++j) dstv[j] = KIND == 4 ? xr[64 * (j >> 1) + (j & 1)] : xr[64 * j]; }
    P0_ROW_LOAD(cur, r)
    if (r + stride < nrows) P0_ROW_LOAD(nxt, r + stride)
    for (; r < nrows; r += stride) {
        const int rn = r + 2 * stride;
        if (rn < nrows) P0_ROW_LOAD(nx2, rn)
        if (KIND == 0) {
            float s = 0.f;
#pragma unroll
            for (int j = 0; j < 8; ++j) s += (cur[j].x * cur[j].x + cur[j].y * cur[j].y) + (cur[j].z * cur[j].z + cur[j].w * cur[j].w);
            const float rr = 1.0f / sqrtf(wave_sum(s) * (1.f / 2048.f) + EPS);
            u32x2* o8 = (u32x2*)((bf16_t*)dst + (size_t)r * 2048) + lane;
#pragma unroll
            for (int j = 0; j < 8; ++j) { const f32x4 w = cur[j] * rr * gr[64 * j]; u32x2 o; o.x = cvt_pk_bf16(w.x, w.y); o.y = cvt_pk_bf16(w.z, w.w); o8[64 * j] = o; }
        } else if (KIND >= 3) {
            float ssq = 0.f;
#pragma unroll
            for (int j = 0; j < 8; ++j) { if (KIND == 3) cur[j] = cur[j] * gr[64 * j]; ssq += (cur[j].x * cur[j].x + cur[j].y * cur[j].y) + (cur[j].z * cur[j].z + cur[j].w * cur[j].w); }
            const float rms = sqrtf(fmaxf(wave_sum(ssq) * (1.f / 2048.f), 1e-30f));
            const float sq = (KIND == 4 ? 0.49f : 0.1676f) * rms, inv = (KIND == 4 ? 1.0f : 0.5f) / sq;
            if (lane == 0) sc[r] = sq;
            unsigned* o4 = (unsigned*)((unsigned char*)dst + (size_t)r * 2048) + lane;
            if (KIND == 4) {
#pragma unroll
                for (int j = 0; j < 4; ++j) { unsigned w = 0u;
                    w = __builtin_amdgcn_cvt_scalef32_pk_fp4_f32(w, cur[2 * j][0] * inv, cur[2 * j][1] * inv, 1.0f, 0);
                    w = __builtin_amdgcn_cvt_scalef32_pk_fp4_f32(w, cur[2 * j][2] * inv, cur[2 * j][3] * inv, 1.0f, 1);
                    w = __builtin_amdgcn_cvt_scalef32_pk_fp4_f32(w, cur[2 * j + 1][0] * inv, cur[2 * j + 1][1] * inv, 1.0f, 2);
                    w = __builtin_amdgcn_cvt_scalef32_pk_fp4_f32(w, cur[2 * j + 1][2] * inv, cur[2 * j + 1][3] * inv, 1.0f, 3);
                    o4[64 * j] = w; }
            } else
            { int csum = 0;
#pragma unroll
            for (int j = 0; j < 4; ++j) { unsigned w = 0u;
#pragma unroll
                for (int e = 0; e < 4; ++e) { const float lo = cur[j][e], hi = cur[j + 4][e];
                    int nl = (int)rintf(fmaf(lo, inv, 7.5f)), nh = (int)rintf(fmaf(hi, inv, 7.5f));
                    nl = nl < 0 ? 0 : (nl > 15 ? 15 : nl); nh = nh < 0 ? 0 : (nh > 15 ? 15 : nh);
                    csum += nl + nh;
                    w |= ((unsigned)nl << (8 * e)) | ((unsigned)nh << (8 * e + 4)); }
                o4[64 * j] = w; }
#pragma unroll
            for (int o = 1; o < 64; o <<= 1) csum += __shfl_xor(csum, o);
            if (lane == 0) ((int*)((unsigned char*)sc + ((ptrdiff_t)WS_SN - (ptrdiff_t)WS_SU)))[r] = 256 * csum; }
        } else {
            float m = 0.f;
#pragma unroll
            for (int j = 0; j < 8; ++j) { if (KIND == 1) cur[j] = cur[j] * gr[64 * j];
                m = fmaxf(fmaxf(m, fmaxf(fabsf(cur[j].x), fabsf(cur[j].y))), fmaxf(fabsf(cur[j].z), fabsf(cur[j].w))); }
            m = fmaxf(wave_max(m), 1e-30f);
            const float inv = 127.f / m; const int off = KIND == 2 ? 128 : 0;
            if (lane == 0) sc[r] = m * (1.f / 127.f);
            unsigned* o4 = (unsigned*)((unsigned char*)dst + (size_t)r * 2048) + lane;
#pragma unroll
            for (int j = 0; j < 8; ++j) { const int a = (int)rintf(cur[j].x * inv) + off, b = (int)rintf(cur[j].y * inv) + off, c = (int)rintf(cur[j].z * inv) + off, d = (int)rintf(cur[j].w * inv) + off;
                o4[64 * j] = (unsigned)(a & 255) | ((unsigned)(b & 255) << 8) | ((unsigned)(c & 255) << 16) | ((unsigned)(d & 255) << 24); }
        }
#pragma unroll
        for (int j = 0; j < 8; ++j) { cur[j] = nxt[j]; nxt[j] = nx2[j]; }
    }
#undef P0_ROW_LOAD
}
__device__ __forceinline__ void p0_wp_item(const float* wq, const float* keys1, const float* keys2, const float* gffn, bf16_t* WPT, int item, int lane) {
    const int hj = item >> 7, ib = item & 127, h = hj >> 1, j = hj & 1, i0 = 16 * ib, col0 = h * 256 + j * 128;
    const int lr = lane & 15, g = lane >> 4;
    const float* keys = (j ? keys2 : keys1) + (size_t)h * 128 * 128;
    const float gi = gffn[i0 + lr];
    bf16x8 af[4];
#pragma unroll
    for (int s = 0; s < 4; ++s) { const float* p = wq + (size_t)(i0 + lr) * 2048 + col0 + 32 * s + 8 * g;
        const f32x4 a = *(const f32x4*)p * gi, b = *(const f32x4*)(p + 4) * gi;
        u32x4 w; w.x = cvt_pk_bf16(a.x, a.y); w.y = cvt_pk_bf16(a.z, a.w); w.z = cvt_pk_bf16(b.x, b.y); w.w = cvt_pk_bf16(b.z, b.w); af[s] = as_bf16x8(w); }
    f32x4 kn[8];
#pragma unroll
    for (int s = 0; s < 4; ++s) { const float* p = keys + (size_t)lr * 128 + 32 * s + 8 * g; kn[2 * s] = *(const f32x4*)p; kn[2 * s + 1] = *(const f32x4*)(p + 4); }
    for (int kt = 0; kt < 8; ++kt) {
        f32x4 kc[8];
#pragma unroll
        for (int i = 0; i < 8; ++i) kc[i] = kn[i];
        if (kt < 7) {
#pragma unroll
            for (int s = 0; s < 4; ++s) { const float* p = keys + (size_t)(16 * (kt + 1) + lr) * 128 + 32 * s + 8 * g; kn[2 * s] = *(const f32x4*)p; kn[2 * s + 1] = *(const f32x4*)(p + 4); } }
        f32x4 d = {0.f, 0.f, 0.f, 0.f};
#pragma unroll
        for (int s = 0; s < 4; ++s) { const f32x4 a = kc[2 * s], b = kc[2 * s + 1];
            u32x4 w; w.x = cvt_pk_bf16(a.x, a.y); w.y = cvt_pk_bf16(a.z, a.w); w.z = cvt_pk_bf16(b.x, b.y); w.w = cvt_pk_bf16(b.z, b.w);
            d = MFMA16(af[s], as_bf16x8(w), d); }
        u32x2 o; o.x = cvt_pk_bf16(d[0], d[1]); o.y = cvt_pk_bf16(d[2], d[3]);
        *(u32x2*)(WPT + (size_t)(hj * 128 + 16 * kt + lr) * 2048 + i0 + 4 * g) = o;
    }
}
__device__ __forceinline__ int t5_bucket(int n) {
    if (n < 16) return n;
    const int large = 16 + (int)(logf((float)n / 16.f) / 4.852030263919617f * 16.f);
    return large < 31 ? large : 31;
}
__device__ __forceinline__ void p0_ssm_item(const Args& A, unsigned char* sp, int g, int lane) {
    const float* lam_re = A.in[6]; const float* lam_im = A.in[7]; const float* log_dt = A.in[8];
    const float* b_re = A.in[9]; const float* b_im = A.in[10]; const float* c_re = A.in[11]; const float* c_im = A.in[12];
    const int n = lane;
    const float dt = expf(log_dt[g]);
    const float lr = lam_re[g * 64 + n], li = lam_im[g * 64 + n];
    const float mag = expf(lr * dt);
    const float a_re = mag * cosf(li * dt), a_im = mag * sinf(li * dt);
    const float den = lr * lr + li * li;
    const float f_re = ((a_re - 1.f) * lr + a_im * li) / den, f_im = (a_im * lr - (a_re - 1.f) * li) / den;
    ((f32x2*)(sp + SSMP_ABAR))[g * 64 + n] = (f32x2){a_re, a_im};
    float pr = a_re, pi = a_im;
#pragma unroll
    for (int i = 0; i < 8; ++i) { const float nr = pr * pr - pi * pi, ni = 2.f * pr * pi; pr = nr; pi = ni; }
    ((f32x2*)(sp + SSMP_A256))[g * 64 + n] = (f32x2){pr, pi};
    float bbr[16], bbi[16];
#pragma unroll
    for (int q = 0; q < 4; ++q) { const f32x4 br = *(const f32x4*)(b_re + (size_t)(g * 64 + n) * 16 + 4 * q), bi = *(const f32x4*)(b_im + (size_t)(g * 64 + n) * 16 + 4 * q);
#pragma unroll
        for (int e = 0; e < 4; ++e) { bbr[4 * q + e] = f_re * br[e] - f_im * bi[e]; bbi[4 * q + e] = f_re * bi[e] + f_im * br[e]; } }
    {
        float* bbt = (float*)(sp + SSMP_BBT); const int mt = n >> 4, q4 = (n >> 2) & 3, rg = n & 3;
#pragma unroll
        for (int c = 0; c < 16; ++c) { const size_t o = ((((size_t)g * 4 + mt) * 4 + q4) * 16 + c) * 4 + rg; bbt[o] = bbr[c]; bbt[o + 65536] = bbi[c]; } }
    bf16_t* bf = (bf16_t*)(sp + SSMP_BFRAG);
    const int jre = n >> 4, n16 = n & 15;
#pragma unroll
    for (int kg = 0; kg < 4; ++kg) {
        u32x4 wr = {0u, 0u, 0u, 0u}, wi = {0u, 0u, 0u, 0u};
        if (kg < 2) { const int c0 = (kg & 1) * 8;
            wr.x = cvt_pk_bf16(bbr[c0 + 0], bbr[c0 + 1]); wr.y = cvt_pk_bf16(bbr[c0 + 2], bbr[c0 + 3]); wr.z = cvt_pk_bf16(bbr[c0 + 4], bbr[c0 + 5]); wr.w = cvt_pk_bf16(bbr[c0 + 6], bbr[c0 + 7]);
            wi.x = cvt_pk_bf16(bbi[c0 + 0], bbi[c0 + 1]); wi.y = cvt_pk_bf16(bbi[c0 + 2], bbi[c0 + 3]); wi.z = cvt_pk_bf16(bbi[c0 + 4], bbi[c0 + 5]); wi.w = cvt_pk_bf16(bbi[c0 + 6], bbi[c0 + 7]); }
        *(u32x4*)(bf + ((size_t)(g * 8 + jre) * 64 + kg * 16 + n16) * 8) = wr;
        *(u32x4*)(bf + ((size_t)(g * 8 + 4 + jre) * 64 + kg * 16 + n16) * 8) = wi;
    }
    bf16_t* cf = (bf16_t*)(sp + SSMP_CFRAG);
    const int ch = lane & 15, kg = lane >> 4;
#pragma unroll
    for (int s = 0; s < 4; ++s) { const int k0 = 32 * s + 8 * kg;
        const float* src = (k0 < 64) ? (c_re + (size_t)(g * 16 + ch) * 64 + k0) : (c_im + (size_t)(g * 16 + ch) * 64 + (k0 - 64));
        const float sg = (k0 < 64) ? 1.f : -1.f;
        const f32x4 a = *(const f32x4*)src * sg, b = *(const f32x4*)(src + 4) * sg;
        u32x4 w; w.x = cvt_pk_bf16(a.x, a.y); w.y = cvt_pk_bf16(a.z, a.w); w.z = cvt_pk_bf16(b.x, b.y); w.w = cvt_pk_bf16(b.z, b.w);
        *(u32x4*)(cf + ((size_t)(g * 4 + s) * 64 + lane) * 8) = w; }
}
__device__ __forceinline__ void p0_vand_item(const Args& A, unsigned char* sp, int item, int lane) {
    const int g = item >> 3, mt = item & 7, np = 16 * mt + (lane & 15), n = np & 63, kg = lane >> 4;
    const float dt = expf(A.in[8][g]), lr = A.in[6][g * 64 + n], li = A.in[7][g * 64 + n];
    bf16_t* vf = (bf16_t*)(sp + SSMP_VAND) + (size_t)(g * 8 + mt) * 8 * 64 * 8;
    const float m1 = expf(lr * dt), a_re = m1 * cosf(li * dt), a_im = m1 * sinf(li * dt);
    for (int ks = 0; ks < 8; ++ks) { float v[8];
        const float pw = (float)(255 - (32 * ks + 8 * kg + 7)); const float mag = expf(lr * dt * pw), ang = li * dt * pw;
        float cr = mag * cosf(ang), ci = mag * sinf(ang);
#pragma unroll
        for (int j = 7; j >= 0; --j) { v[j] = np < 64 ? cr : ci; const float nr = cr * a_re - ci * a_im, ni = cr * a_im + ci * a_re; cr = nr; ci = ni; }
        u32x4 w; w.x = cvt_pk_bf16(v[0], v[1]); w.y = cvt_pk_bf16(v[2], v[3]); w.z = cvt_pk_bf16(v[4], v[5]); w.w = cvt_pk_bf16(v[6], v[7]);
        *(u32x4*)(vf + ((size_t)ks * 64 + lane) * 8) = w; }
}
__device__ __forceinline__ void p0_btab_item(const Args& A, float* btab, int item, int lane) {
    const float* gq = A.in[3]; const float* gk = A.in[4]; const float* rel_bias = A.in[5];
    const int h = item / 3, br = item % 3, d = br == 0 ? 1 : (br == 1 ? 4 : 16);
    const float G = wave_max(fabsf(gq[lane] * gk[lane]));
    const float mb = wave_max(lane < 32 ? rel_bias[lane * 16 + h] : -1e30f);
    const float smax = 8.4f * G + mb;
    for (int idx = lane; idx < 192; idx += 64) { const int rel = idx - 31;
        float v = -1e30f;
        if (rel >= 0 && rel <= 128) v = LOG2E * (rel_bias[t5_bucket(rel * d) * 16 + h] - smax);
        btab[(h * 3 + br) * 192 + idx] = v; }
}

__device__ __forceinline__ void p0_prologue(const Args& A, LAS unsigned char* lds, int wave, int lane, int pflags) {
    unsigned char* ws = A.ws;
    LAS float* scr = (LAS float*)(lds + wave * 16384);
    const int gw = blockIdx.x * 8 + wave, NGW = gridDim.x * 8;
    constexpr int I_WIN = (2048 / 64) * (4096 / 32), I_GLU = (1024 / 64) * (1024 / 32), I_WOUT = (2048 / 64) * (2048 / 32), I_WP = 2048;
    constexpr int I_SSM = 64, I_BT = 48, I_VAND = 512;
    constexpr int NITEMS = I_WIN + I_GLU + I_WOUT + I_WP + I_SSM + I_BT + I_VAND;
    const bool rows_first = wave & 1;
    if (rows_first && !(pflags & 2048)) p0_rows<0>(A.in[0], A.in[1], ws + WS_HB, nullptr, gw, NGW, 8192, lane);
    if (!(pflags & 4096)) for (int it = gw; it < NITEMS; it += NGW) {
        int r = it;
        if (r < I_SSM) { p0_ssm_item(A, ws + WS_SSMP, r, lane); continue; } r -= I_SSM;
        if (r < I_BT) { p0_btab_item(A, (float*)(ws + WS_BTAB), r, lane); continue; } r -= I_BT;
        if (r < I_VAND) { p0_vand_item(A, ws + WS_SSMP, r, lane); continue; } r -= I_VAND;
        if (r < I_WP) { p0_wp_item(A.in[20], A.in[21], A.in[22], A.in[19], (bf16_t*)(ws + WS_WPT), r, lane); continue; } r -= I_WP;
        if (r < I_WIN) { p0_transpose_item(A.in[2], 2048, 4096, (bf16_t*)(ws + WS_WINT), nullptr, nullptr, scr, r, lane); continue; } r -= I_WIN;
        if (r < I_GLU) { p0_transpose_item(A.in[14], 1024, 1024, (bf16_t*)(ws + WS_GLUT), nullptr, nullptr, scr, r, lane); continue; } r -= I_GLU;
        p0_transpose_item(A.in[18], 2048, 2048, (bf16_t*)(ws + WS_WOUTT), A.in[16], A.in[17], scr, r, lane);
    }
    if (!rows_first && !(pflags & 2048)) p0_rows<0>(A.in[0], A.in[1], ws + WS_HB, nullptr, gw, NGW, 8192, lane);
}
__device__ __forceinline__ void table_chunk(const Args& A, int c, int wave, int lane) {
    unsigned char* ws = A.ws;
    if (c < 512) p0_rows<3>(A.in[23], A.in[19], ws + WS_UB, (float*)(ws + WS_SU), 32 * c + wave, 8, 32 * c + 32, lane);
    else p0_rows<4>(A.in[24], A.in[19], ws + WS_UB + 1024, (float*)(ws + WS_SV), 32 * (c - 512) + wave, 8, 32 * (c - 512) + 32, lane);
}

constexpr int SSM_WL = 8192 + 16 * 272 + 512;
__device__ __forceinline__ void ssm_unit(const Args& A, LAS unsigned char* lds, int b, int g, int wave, int lane) {
    unsigned char* ws = A.ws; unsigned char* sp = ws + WS_SSMP;
    const bf16_t* proj = (const bf16_t*)(ws + WS_PROJ); bf16_t* yb = (bf16_t*)(ws + WS_YB);
    LAS unsigned char* wl = lds + wave * SSM_WL;
    LAS f32x2* BU = (LAS f32x2*)wl; LAS unsigned char* XB = wl + 8192; LAS unsigned char* UL = wl + 8192 + 16 * 272;
    LAS f32x2* carry = (LAS f32x2*)(lds + 8 * SSM_WL);
    const int lr = lane & 15, q = lane >> 4;
    bf16x8 bfr[8], cfr[4];
#pragma unroll
    for (int j = 0; j < 8; ++j) bfr[j] = as_bf16x8(*(const u32x4*)((const bf16_t*)(sp + SSMP_BFRAG) + ((size_t)(g * 8 + j) * 64 + lane) * 8));
#pragma unroll
    for (int s = 0; s < 4; ++s) cfr[s] = as_bf16x8(*(const u32x4*)((const bf16_t*)(sp + SSMP_CFRAG) + ((size_t)(g * 4 + s) * 64 + lane) * 8));
    const f32x2 ab = ((const f32x2*)(sp + SSMP_ABAR))[g * 64 + lane], a256 = ((const f32x2*)(sp + SSMP_A256))[g * 64 + lane];
    const float a_re = ab.x, a_im = ab.y;
    const float dsk = A.in[13][g * 16 + lr];
    const bf16_t* up = proj + (size_t)(b * SEQ + wave * 256) * DPROJ + 3072 + g * 16;
    float xr = 0.f, xi = 0.f;
    {
        LAS unsigned char* UT = wl;
#pragma unroll
        for (int i = 0; i < 8; ++i) { const int tk = 32 * i + (lane >> 1), hf = lane & 1;
            const u32x4 raw = *(const u32x4*)(up + (size_t)tk * DPROJ + 8 * hf);
            const unsigned rw[4] = {raw.x, raw.y, raw.z, raw.w};
#pragma unroll
            for (int e = 0; e < 4; ++e) { *(LAS unsigned short*)(UT + (8 * hf + 2 * e) * 528 + tk * 2) = (unsigned short)(rw[e] & 0xffffu); *(LAS unsigned short*)(UT + (8 * hf + 2 * e + 1) * 528 + tk * 2) = (unsigned short)(rw[e] >> 16); } }
        CBAR();
        const bf16_t* vf = (const bf16_t*)(sp + SSMP_VAND) + (size_t)g * 8 * 8 * 64 * 8 + lane * 8;
        f32x4 pd[8];
#pragma unroll
        for (int mt = 0; mt < 8; ++mt) pd[mt] = (f32x4){0.f, 0.f, 0.f, 0.f};
#pragma unroll 2
        for (int ks = 0; ks < 8; ++ks) { const bf16x8 ub = as_bf16x8(*(const LAS u32x4*)(UT + lr * 528 + (32 * ks + 8 * q) * 2));
#pragma unroll
            for (int mt = 0; mt < 8; ++mt) pd[mt] = MFMA16(as_bf16x8(*(const u32x4*)(vf + (size_t)(mt * 8 + ks) * 512)), ub, pd[mt]); }
        const float* bbt = (const float*)(sp + SSMP_BBT) + (((size_t)g * 4) * 4 + q) * 64 + lr * 4;
#pragma unroll
        for (int mt = 0; mt < 4; ++mt) { const f32x4 br = *(const f32x4*)(bbt + (size_t)mt * 256), bi = *(const f32x4*)(bbt + (size_t)mt * 256 + 65536);
#pragma unroll
            for (int r = 0; r < 4; ++r) { const float er = row16_fsum(br[r] * pd[mt][r] - bi[r] * pd[mt + 4][r]), ei = row16_fsum(br[r] * pd[mt + 4][r] + bi[r] * pd[mt][r]);
                if (lr == 0) carry[wave * 64 + 16 * mt + 4 * q + r] = (f32x2){er, ei}; } }
        CBAR();
    }
    __syncthreads();
    { float sr = 0.f, si = 0.f;
        for (int w2 = 0; w2 < wave; ++w2) { const f32x2 e = carry[w2 * 64 + lane]; const float nr = a256.x * sr - a256.y * si + e.x, ni = a256.x * si + a256.y * sr + e.y; sr = nr; si = ni; }
        xr = sr; xi = si; }
    for (int pass = 1; pass < 2; ++pass) {
        u32x4 unext = {0u, 0u, 0u, 0u};
        if (q < 2) unext = *(const u32x4*)(up + (size_t)lr * DPROJ + 8 * q);
        for (int blk = 0; blk < 16; ++blk) {
            const u32x4 uraw = unext;
            if (q < 2 && blk < 15) unext = *(const u32x4*)(up + (size_t)((blk + 1) * 16 + lr) * DPROJ + 8 * q);
            const bf16x8 ua = as_bf16x8(uraw);
            if (pass == 1 && q < 2) *(LAS u32x4*)(UL + lr * 32 + q * 16) = uraw;
            f32x4 dd[8];
#pragma unroll
            for (int j = 0; j < 8; ++j) dd[j] = MFMA16(ua, bfr[j], ((f32x4){0.f, 0.f, 0.f, 0.f}));
#pragma unroll
            for (int jj = 0; jj < 4; ++jj)
#pragma unroll
                for (int r = 0; r < 4; ++r) BU[(4 * q + r) * 64 + 16 * jj + lr] = (f32x2){dd[jj][r], dd[4 + jj][r]};
            CBAR();
            f32x2 bu[16];
#pragma unroll
            for (int t = 0; t < 16; ++t) bu[t] = BU[t * 64 + lane];
            if (pass == 0) {
#pragma unroll
                for (int t = 0; t < 16; ++t) { float nr = fmaf(a_re, xr, fmaf(-a_im, xi, bu[t].x)), ni = fmaf(a_re, xi, fmaf(a_im, xr, bu[t].y)); asm volatile("" : "+v"(nr)); asm volatile("" : "+v"(ni)); xr = nr; xi = ni; }
                asm volatile("" : "+v"(xr), "+v"(xi) :: "memory");
            } else {
#pragma unroll
                for (int t = 0; t < 16; ++t) { float nr = fmaf(a_re, xr, fmaf(-a_im, xi, bu[t].x)), ni = fmaf(a_re, xi, fmaf(a_im, xr, bu[t].y)); asm volatile("" : "+v"(nr)); asm volatile("" : "+v"(ni)); xr = nr; xi = ni;
                    const unsigned pk = cvt_pk_bf16(xr, xi);
                    *(LAS unsigned short*)(XB + t * 272 + lane * 2) = (unsigned short)(pk & 0xffffu);
                    *(LAS unsigned short*)(XB + t * 272 + 128 + lane * 2) = (unsigned short)(pk >> 16); }
                CBAR();
                f32x4 y = {0.f, 0.f, 0.f, 0.f};
#pragma unroll
                for (int s = 0; s < 4; ++s) { const bf16x8 xa = as_bf16x8(*(const LAS u32x4*)(XB + lr * 272 + (32 * s + 8 * q) * 2)); y = MFMA16(xa, cfr[s], y); }
#pragma unroll
                for (int r = 0; r < 4; ++r) { const int t = blk * 16 + 4 * q + r;
                    const float uv = __uint_as_float((unsigned)(*(const LAS unsigned short*)(UL + (4 * q + r) * 32 + lr * 2)) << 16);
                    const float yv = gelu_as(y[r] + dsk * uv);
                    yb[(size_t)(b * SEQ + wave * 256 + t) * 1024 + g * 16 + lr] = (bf16_t)(cvt_pk_bf16(yv, 0.f) & 0xffffu); }
                asm volatile("" : "+v"(xr), "+v"(xi) :: "memory");
            }
        }
    }
    __syncthreads();
}

__device__ __forceinline__ void prep2_item(const Args& A, LAS unsigned char* wl, int item, int lane) {
    unsigned char* ws = A.ws;
    const bf16_t* proj = (const bf16_t*)(ws + WS_PROJ);
    const int pb = item & 31, h = (item >> 5) & 15, b = item >> 9, P0 = pb * 64, bh = b * 16 + h;
    const int r8 = lane >> 3, c = lane & 7;
    const float* gq = A.in[3]; const float* gk = A.in[4];
    const int fs = c >> 2, fg = c & 3;
#pragma unroll 1
    for (int which = 0; which < 2; ++which) {
        const float* gv = which ? gk : gq; const float cs = which ? 1.f : (LOG2E * 0.125f);
        float gl[8];
#pragma unroll
        for (int e = 0; e < 8; ++e) gl[e] = gv[8 * c + e] * cs;
        bf16_t* F = (bf16_t*)(ws + (which ? WS_KF : WS_QF));
        u32x4 raws[8];
#pragma unroll
        for (int i = 0; i < 8; ++i) raws[i] = *(const u32x4*)(proj + (size_t)(b * SEQ + P0 + 8 * i + r8) * DPROJ + which * 1024 + h * 64 + 8 * c);
#pragma unroll
        for (int i = 0; i < 8; ++i) { const int row = 8 * i + r8, pos = P0 + row;
            const u32x4 raw = raws[i];
            float v[8] = {bflo(raw.x), bfhi(raw.x), bflo(raw.y), bfhi(raw.y), bflo(raw.z), bfhi(raw.z), bflo(raw.w), bfhi(raw.w)};
            float ss = 0.f;
#pragma unroll
            for (int e = 0; e < 8; ++e) ss += v[e] * v[e];
            ss += __shfl_xor(ss, 1); ss += __shfl_xor(ss, 2); ss += __shfl_xor(ss, 4);
            const float r = 1.0f / sqrtf(ss * (1.f / 64.f) + EPS);
            u32x4 w; w.x = cvt_pk_bf16(v[0] * r * gl[0], v[1] * r * gl[1]); w.y = cvt_pk_bf16(v[2] * r * gl[2], v[3] * r * gl[3]);
            w.z = cvt_pk_bf16(v[4] * r * gl[4], v[5] * r * gl[5]); w.w = cvt_pk_bf16(v[6] * r * gl[6], v[7] * r * gl[7]);
#pragma unroll
            for (int br = 0; br < 3; ++br) { const int sh = 2 * br, rr = pos & ((1 << sh) - 1), l = pos >> sh;
                *(u32x4*)(F + (size_t)br * 4 * 16 * SEQ * 64 + ((((size_t)(bh << sh) + rr) * (SEQ >> (sh + 4)) + (l >> 4)) * 2 + fs) * 512 + (fg * 16 + (l & 15)) * 8) = w; } }
    }
#pragma unroll
    for (int i = 0; i < 8; ++i) { const int row = 8 * i + r8;
        const u32x4 raw = *(const u32x4*)(proj + (size_t)(b * SEQ + P0 + row) * DPROJ + 2048 + h * 64 + 8 * c);
        *(LAS u32x2*)(wl + row * 136 + c * 16) = (u32x2){raw.x, raw.y}; *(LAS u32x2*)(wl + row * 136 + c * 16 + 8) = (u32x2){raw.z, raw.w}; }
    CBAR();
    unsigned v[64];
#pragma unroll
    for (int p = 0; p < 64; ++p) v[p] = *(const LAS unsigned short*)(wl + p * 136 + lane * 2);
    CBAR();
    bf16_t* vt = (bf16_t*)(ws + WS_VT);
    const int nt = lane >> 4, dl = lane & 15;
#pragma unroll
    for (int G = 0; G < 2; ++G) { bf16_t* tp = vt + ((((size_t)bh * 64 + (P0 >> 5) + G) * 4 + nt) * 64 + dl) * 8;
#pragma unroll
        for (int kg = 0; kg < 4; ++kg) { const int a0 = 32 * G + 4 * kg, b0 = 32 * G + 16 + 4 * kg;
            u32x4 w; w.x = v[a0] | (v[a0 + 1] << 16); w.y = v[a0 + 2] | (v[a0 + 3] << 16); w.z = v[b0] | (v[b0 + 1] << 16); w.w = v[b0 + 2] | (v[b0 + 3] << 16);
            *(u32x4*)(tp + kg * 128) = w; } }
    { bf16_t* vt4 = vt + (size_t)4 * 16 * 64 * SEQ; const int l0 = P0 >> 2, tile = (l0 >> 4) & 1, grp = l0 >> 5;
#pragma unroll
        for (int r = 0; r < 4; ++r) { bf16_t* tp = vt4 + (((((size_t)bh * 4 + r) * 16 + grp) * 4 + nt) * 64 + dl) * 8;
#pragma unroll
            for (int kg = 0; kg < 4; ++kg) { const int p0 = 4 * (4 * kg) + r;
                u32x2 w; w.x = v[p0] | (v[p0 + 4] << 16); w.y = v[p0 + 8] | (v[p0 + 12] << 16);
                *(u32x2*)(tp + kg * 128 + 4 * tile) = w; } } }
    { bf16_t* vt16 = vt + (size_t)2 * 4 * 16 * 64 * SEQ; const int l0 = P0 >> 4, w32 = l0 & 31, tile = (w32 >> 4) & 1, kg = (w32 & 15) >> 2, grp = l0 >> 5;
#pragma unroll
        for (int r = 0; r < 16; ++r) { u32x2 w; w.x = v[r] | (v[16 + r] << 16); w.y = v[32 + r] | (v[48 + r] << 16);
            *(u32x2*)(vt16 + (((((size_t)bh * 16 + r) * 4 + grp) * 4 + nt) * 64 + kg * 16 + dl) * 8 + 4 * tile) = w; } }
}

struct AttnItem { int sh, r, lfirst, ks, tbo, two; size_t qk_off, v_off; };
__device__ __forceinline__ AttnItem attn_item(int it, int p0, int bh) {
    AttnItem I; const int br = it < 8 ? 0 : (it < 16 ? 1 : 2); I.sh = 2 * br; I.tbo = br * 192; I.two = br < 2;
    if (br == 0) { I.r = 0; I.lfirst = p0 + 32 * it; }
    else if (br == 1) { I.r = (it - 8) & 3; I.lfirst = (p0 >> 2) + 32 * ((it - 8) >> 2); }
    else { I.r = it - 16; I.lfirst = p0 >> 4; }
    const size_t rc = (size_t)br * 4 * 16 * SEQ * 64 + ((size_t)(bh << I.sh) + I.r) * (size_t)(SEQ >> I.sh) * 64;
    I.qk_off = rc; I.v_off = rc;
    int ks = (I.lfirst - 128) & ~31; I.ks = ks < 0 ? 0 : ks;
    return I;
}
__device__ __forceinline__ void attn_unit(const Args& A, LAS unsigned char* lds, int unit, int tid, int wave, int lane, int pflags) {
    unsigned char* ws = A.ws;
    const int blk = 7 - (unit >> 6), bh = unit & 63, b = bh >> 4, h = bh & 15, p0 = blk * 256;
    constexpr int OST = 68;
    LAS float* Oacc = (LAS float*)lds; LAS float* lacc = (LAS float*)(lds + 256 * OST * 4); LAS float* tb = (LAS float*)(lds + 256 * OST * 4 + 1024);
    { const float* bt = (const float*)(ws + WS_BTAB) + h * 3 * 192; for (int i = tid; i < 3 * 192; i += 512) tb[i] = bt[i]; }
    __syncthreads();
    const bf16_t* QF = (const bf16_t*)(ws + WS_QF); const bf16_t* KF = (const bf16_t*)(ws + WS_KF); const bf16_t* VF = (const bf16_t*)(ws + WS_VT);
    const int qi = lane & 15, g = lane >> 4;
#define ATT_LOAD(IT, LK, B) do { const AttnItem _I = attn_item(IT, p0, bh); const bf16_t* _kp = KF + _I.qk_off + (size_t)((LK) >> 4) * 1024 + lane * 8; \
        B[0] = *(const u32x4*)(_kp); B[1] = *(const u32x4*)(_kp + 512); B[2] = *(const u32x4*)(_kp + 1024); B[3] = *(const u32x4*)(_kp + 1536); \
        const bf16_t* _vp = VF + _I.v_off + (size_t)((LK) >> 5) * 2048 + lane * 8; \
        B[4] = *(const u32x4*)(_vp); B[5] = *(const u32x4*)(_vp + 512); B[6] = *(const u32x4*)(_vp + 1024); B[7] = *(const u32x4*)(_vp + 1536); \
        const bf16_t* _qp = QF + _I.qk_off + (size_t)(_I.lfirst >> 4) * 1024 + lane * 8; B[8] = *(const u32x4*)(_qp); B[9] = *(const u32x4*)(_qp + 512); \
        if (_I.two) { B[10] = *(const u32x4*)(_qp + 1024); B[11] = *(const u32x4*)(_qp + 1536); } } while (0)
#define ATT_ADV(IT, LK, NIT, NLK) do { const AttnItem _J = attn_item(IT, p0, bh); if ((LK) + 32 <= _J.lfirst) { (NIT) = (IT); (NLK) = (LK) + 32; } else { (NIT) = (IT) + 8; (NLK) = 0; if ((NIT) < 32) { const AttnItem _N = attn_item(NIT, p0, bh); (NLK) = _N.ks; } } } while (0)
#define ATT_STEP(CIT, CLK, BC, NIT, NLK, NNIT, NNLK, BNN) { \
        NNIT = 64; NNLK = 0; \
        if ((NIT) < 32) { ATT_ADV(NIT, NLK, NNIT, NNLK); if ((NNIT) < 32) ATT_LOAD(NNIT, NNLK, BNN); } \
        const AttnItem cI = attn_item(CIT, p0, bh); \
        const LAS float* tbb = tb + cI.tbo; \
        const int ba = cI.lfirst + qi - (CLK) - 4 * g + 31; \
        { f32x4 sa = {0.f, 0.f, 0.f, 0.f}, sb = {0.f, 0.f, 0.f, 0.f}; \
          sa = MFMA16(as_bf16x8(BC[0]), as_bf16x8(BC[8]), sa); sb = MFMA16(as_bf16x8(BC[2]), as_bf16x8(BC[8]), sb); \
          sa = MFMA16(as_bf16x8(BC[1]), as_bf16x8(BC[9]), sa); sb = MFMA16(as_bf16x8(BC[3]), as_bf16x8(BC[9]), sb); \
          float pa[4], pb[4]; \
          _Pragma("unroll") for (int e = 0; e < 4; ++e) { pa[e] = __builtin_amdgcn_exp2f(sa[e] + tbb[ba - e]); pb[e] = __builtin_amdgcn_exp2f(sb[e] + tbb[ba - 16 - e]); } \
          lsum += (pa[0] + pa[1]) + (pa[2] + pa[3]) + (pb[0] + pb[1]) + (pb[2] + pb[3]); \
          u32x4 pw; pw.x = cvt_pk_bf16(pa[0], pa[1]); pw.y = cvt_pk_bf16(pa[2], pa[3]); pw.z = cvt_pk_bf16(pb[0], pb[1]); pw.w = cvt_pk_bf16(pb[2], pb[3]); \
          const bf16x8 pf = as_bf16x8(pw); \
          _Pragma("unroll") for (int nt = 0; nt < 4; ++nt) o[nt] = MFMA16(pf, as_bf16x8(BC[4 + nt]), o[nt]); } \
        if (cI.two) { f32x4 sa = {0.f, 0.f, 0.f, 0.f}, sb = {0.f, 0.f, 0.f, 0.f};     \
          sa = MFMA16(as_bf16x8(BC[0]), as_bf16x8(BC[10]), sa); sb = MFMA16(as_bf16x8(BC[2]), as_bf16x8(BC[10]), sb); \
          sa = MFMA16(as_bf16x8(BC[1]), as_bf16x8(BC[11]), sa); sb = MFMA16(as_bf16x8(BC[3]), as_bf16x8(BC[11]), sb); \
          float pa[4], pb[4]; \
          _Pragma("unroll") for (int e = 0; e < 4; ++e) { pa[e] = __builtin_amdgcn_exp2f(sa[e] + tbb[ba + 16 - e]); pb[e] = __builtin_amdgcn_exp2f(sb[e] + tbb[ba - e]); } \
          lsum2 += (pa[0] + pa[1]) + (pa[2] + pa[3]) + (pb[0] + pb[1]) + (pb[2] + pb[3]); \
          u32x4 pw; pw.x = cvt_pk_bf16(pa[0], pa[1]); pw.y = cvt_pk_bf16(pa[2], pa[3]); pw.z = cvt_pk_bf16(pb[0], pb[1]); pw.w = cvt_pk_bf16(pb[2], pb[3]); \
          const bf16x8 pf = as_bf16x8(pw); \
          _Pragma("unroll") for (int nt = 0; nt < 4; ++nt) o2[nt] = MFMA16(pf, as_bf16x8(BC[4 + nt]), o2[nt]); } \
        if ((CLK) + 32 > cI.lfirst) {     \
            const bool first = (CIT) < 8; \
            lsum += __shfl_xor(lsum, 16); lsum += __shfl_xor(lsum, 32); \
            if (g == 0) { LAS float* lp = lacc + ((((cI.lfirst + qi) << cI.sh) + cI.r) - p0); *lp = first ? lsum : *lp + lsum; } \
            _Pragma("unroll") for (int reg = 0; reg < 4; ++reg) { LAS float* op = Oacc + (((((cI.lfirst + 4 * g + reg) << cI.sh) + cI.r) - p0)) * OST + qi; \
                _Pragma("unroll") for (int nt = 0; nt < 4; ++nt) op[16 * nt] = first ? o[nt][reg] : op[16 * nt] + o[nt][reg]; } \
            _Pragma("unroll") for (int nt = 0; nt < 4; ++nt) o[nt] = (f32x4){0.f, 0.f, 0.f, 0.f}; \
            lsum = 0.f; \
            if (cI.two) { \
                lsum2 += __shfl_xor(lsum2, 16); lsum2 += __shfl_xor(lsum2, 32); \
                if (g == 0) { LAS float* lp = lacc + ((((cI.lfirst + 16 + qi) << cI.sh) + cI.r) - p0); *lp = first ? lsum2 : *lp + lsum2; } \
                _Pragma("unroll") for (int reg = 0; reg < 4; ++reg) { LAS float* op = Oacc + (((((cI.lfirst + 16 + 4 * g + reg) << cI.sh) + cI.r) - p0)) * OST + qi; \
                    _Pragma("unroll") for (int nt = 0; nt < 4; ++nt) op[16 * nt] = first ? o2[nt][reg] : op[16 * nt] + o2[nt][reg]; } \
                _Pragma("unroll") for (int nt = 0; nt < 4; ++nt) o2[nt] = (f32x4){0.f, 0.f, 0.f, 0.f}; \
                lsum2 = 0.f; } \
            if ((CIT) < 16 || (CIT) >= 24) __syncthreads();     \
        } \
        if ((NIT) >= 32) break; }
    if (!(pflags & 16)) {
    int itA = wave, lkA, itB, lkB, itC = 64, lkC = 0;
    { const AttnItem I0 = attn_item(wave, p0, bh); lkA = I0.ks; }
    ATT_ADV(itA, lkA, itB, lkB);
    u32x4 bA[12], bB[12], bC[12];
    ATT_LOAD(itA, lkA, bA); if (itB < 32) ATT_LOAD(itB, lkB, bB);
    f32x4 o[4], o2[4];
#pragma unroll
    for (int nt = 0; nt < 4; ++nt) { o[nt] = (f32x4){0.f, 0.f, 0.f, 0.f}; o2[nt] = (f32x4){0.f, 0.f, 0.f, 0.f}; }
    float lsum = 0.f, lsum2 = 0.f;
    for (;;) {
        ATT_STEP(itA, lkA, bA, itB, lkB, itC, lkC, bC)
        ATT_STEP(itB, lkB, bB, itC, lkC, itA, lkA, bA)
        ATT_STEP(itC, lkC, bC, itA, lkA, itB, lkB, bB)
    }
    }
#undef ATT_LOAD
#undef ATT_ADV
#undef ATT_STEP
    if (!(pflags & (16 | 32 | 64))) { const int ql = tid >> 1, half = tid & 1; const float inv = 1.0f / lacc[ql];
        bf16_t* dst = (bf16_t*)(ws + WS_MIXED) + (size_t)(b * SEQ + p0 + ql) * 2048 + h * 64 + 32 * half;
        float ss = 0.f;
#pragma unroll
        for (int c4 = 0; c4 < 4; ++c4) { float v[8];
#pragma unroll
            for (int e = 0; e < 8; ++e) { v[e] = Oacc[ql * OST + 32 * half + 8 * c4 + e] * inv; ss += v[e] * v[e]; }
            u32x4 w; w.x = cvt_pk_bf16(v[0], v[1]); w.y = cvt_pk_bf16(v[2], v[3]); w.z = cvt_pk_bf16(v[4], v[5]); w.w = cvt_pk_bf16(v[6], v[7]);
            *(u32x4*)(dst + 8 * c4) = w; }
        ss += __shfl_xor(ss, 1);
        if (half == 0) unsafeAtomicAdd((float*)(ws + WS_CTL + CTL_RSS_ATTN) + b * SEQ + p0 + ql, ss); }
    __syncthreads();
}

__device__ __forceinline__ unsigned fkey(float f) { const unsigned u = __float_as_uint(f); return (u & 0x80000000u) ? ~u : (u | 0x80000000u); }
template <int R> __device__ __forceinline__ void select16(const unsigned (&key)[R], unsigned long long (&m)[R]) {
    unsigned mx = key[0];
#pragma unroll
    for (int r = 1; r < R; ++r) mx = key[r] > mx ? key[r] : mx;
    mx = wave_umax(mx);
    unsigned lo = mx > (3u << 23) ? mx - (3u << 23) : 0u, hi = mx + 1u;
    int cnt = 0;
#pragma unroll
    for (int r = 0; r < R; ++r) cnt += __popcll(__ballot(key[r] >= lo));
    if (cnt < 16) { lo = 0u; cnt = R * 64; }
    while (cnt != 16 && hi - lo > 1u) { const unsigned mid = lo + ((hi - lo) >> 1); int c = 0;
#pragma unroll
        for (int r = 0; r < R; ++r) c += __popcll(__ballot(key[r] >= mid));
        if (c >= 16) { lo = mid; cnt = c; } else hi = mid; }
    const unsigned T = lo;
    if (cnt == 16) {
#pragma unroll
        for (int r = 0; r < R; ++r) m[r] = __ballot(key[r] >= T);
    } else {
        int need = 16;
#pragma unroll
        for (int r = 0; r < R; ++r) { m[r] = __ballot(key[r] > T); need -= __popcll(m[r]); }
#pragma unroll
        for (int r = 0; r < R; ++r) { unsigned long long eq = __ballot(key[r] == T);
            while (__popcll(eq) > need) eq &= ~(1ull << (63 - __builtin_clzll(eq)));
            need -= __popcll(eq); m[r] |= eq; }
    }
}
__device__ __forceinline__ void peer_topk(const float (&sv4)[4], LAS float* sc, LAS int* exo, LAS float* gto, int lane) {
    LAS float* v1 = sc; LAS int* i1 = (LAS int*)(sc + 16); LAS float* v2 = sc + 32; LAS int* i2 = (LAS int*)(sc + 48); LAS float* sv = sc + 64; LAS int* si = (LAS int*)(sc + 80);
    const unsigned long long lt = (1ull << lane) - 1ull;
#pragma unroll
    for (int half = 0; half < 2; ++half) {
        const float a0 = sv4[2 * half], a1 = sv4[2 * half + 1];
        const unsigned key[2] = {fkey(a0), fkey(a1)}; unsigned long long m[2];
        select16<2>(key, m);
        LAS float* vv = half ? v2 : v1; LAS int* ii = half ? i2 : i1;
        if ((m[0] >> lane) & 1ull) { const int pos = __popcll(m[0] & lt); vv[pos] = a0; ii[pos] = lane; }
        if ((m[1] >> lane) & 1ull) { const int pos = __popcll(m[0]) + __popcll(m[1] & lt); vv[pos] = a1; ii[pos] = 64 + lane; }
    }
    CBAR(); LDS_WAIT();
    const int a = lane >> 2, bb = (lane & 3) * 4;
    const float va = v1[a]; float cv[4]; unsigned key[4]; unsigned long long m[4];
#pragma unroll
    for (int e = 0; e < 4; ++e) { cv[e] = va + v2[bb + e]; key[e] = fkey(cv[e]); }
    select16<4>(key, m);
    int base = 0;
#pragma unroll
    for (int e = 0; e < 4; ++e) { if ((m[e] >> lane) & 1ull) { const int pos = base + __popcll(m[e] & lt); sv[pos] = cv[e]; si[pos] = a * 16 + bb + e; } base += __popcll(m[e]); }
    CBAR(); LDS_WAIT();
    if (lane < 16) {
        const float val = sv[lane]; const int fi = si[lane];
        const float mx = row16_fmax(val);
        const float ex = __expf(val - mx); const float sum = row16_fsum(ex);
        exo[lane] = i1[fi >> 4] * 128 + (i2[fi & 15] - 0);
        gto[lane] = ex / sum;
    }
    CBAR(); LDS_WAIT();
}

#ifndef FP8_CODE_SCALE
#define FP8_CODE_SCALE 512.f
#endif
template <int I> __device__ __forceinline__ float ubyte_f32(unsigned w) { float f;
    if (I == 0) asm("v_cvt_f32_ubyte0 %0, %1" : "=v"(f) : "v"(w)); else if (I == 1) asm("v_cvt_f32_ubyte1 %0, %1" : "=v"(f) : "v"(w));
    else if (I == 2) asm("v_cvt_f32_ubyte2 %0, %1" : "=v"(f) : "v"(w)); else asm("v_cvt_f32_ubyte3 %0, %1" : "=v"(f) : "v"(w));
    return f; }
__device__ __forceinline__ void peer_wave(const Args& A, LAS unsigned char* lds, int wave, int lane, int pflags) {
    unsigned char* ws = A.ws;
    const float* scores = (const float*)(ws + WS_PROJ);
    const unsigned char* uv = ws + WS_UB; const bf16_t* x1b = (const bf16_t*)(ws + WS_HB);
    const float* su = (const float*)(ws + WS_SU); const float* sv = (const float*)(ws + WS_SV);
    const float* rssx = (const float*)(ws + WS_CTL + CTL_RSS_X1);
    LAS int* exl = (LAS int*)(lds + wave * 4096);
    LAS float* gtl = (LAS float*)(lds + wave * 4096 + 2048);
    LAS float* sc = (LAS float*)(lds + 32768 + wave * 512);
    LAS int* culi = (LAS int*)(lds + 36864 + wave * 512);
    LAS float* cul = (LAS float*)(lds + 40960 + wave * 1024);
    const int t0 = (blockIdx.x * 8 + wave) * 4;
    if (t0 >= NTOK) return;
#define LOAD_SCORES_L(dst, t, h, ln) do { const float* _sp = scores + (size_t)(t) * 2048 + (h) * 256 + (ln); dst[0] = _sp[0]; dst[1] = _sp[64]; dst[2] = _sp[128]; dst[3] = _sp[192]; } while (0)
#define LOAD_SCORES(dst, t, h) LOAD_SCORES_L(dst, t, h, lane)
    { float nx[4]; LOAD_SCORES(nx, t0, 0);
#pragma unroll 1
        for (int h = 0; h < 8; ++h) { const float cs[4] = {nx[0], nx[1], nx[2], nx[3]};
            if (h < 7) LOAD_SCORES(nx, t0, h + 1);
            peer_topk(cs, sc, exl + h * 16, gtl + h * 16, lane); } }
    CBAR(); LDS_WAIT();
    if (pflags & 256) return;
    int ex0 = exl[lane], ex1 = exl[64 + lane];
    const int* snt = (const int*)(ws + WS_SN);
    float rss = rssx[t0], su0 = su[ex0], su1 = su[ex1], sv0 = sv[ex0], sv1 = sv[ex1]; int sn0 = snt[ex0], sn1 = snt[ex1];
    float sn[4] = {0.f, 0.f, 0.f, 0.f};
    LOAD_SCORES(sn, t0 + 1, 0);
    u32x4 bu[8], bv[8];
    LAS u32x4* vls = (LAS u32x4*)(lds + 49152 + wave * 8192);
#define ISSUE_E(slot, e0r, e1r, k) do { const int _e = __builtin_amdgcn_readlane((k) < 64 ? (e0r) : (e1r), (k) & 63); \
        const unsigned char* _p = uv + (size_t)_e * 2048 + 16 * lane; bu[slot] = *(const u32x4*)_p; bv[slot] = *(const u32x4*)(_p + 1024); } while (0)
#pragma unroll
    for (int i = 0; i < 8; ++i) ISSUE_E(i, ex0, ex1, i);
    float acc[32];
    u32x4 xr4[4];
#pragma unroll
    for (int v4 = 0; v4 < 4; ++v4) xr4[v4] = *(const u32x4*)(x1b + (size_t)t0 * 2048 + 16 * lane + 1024 * (v4 >> 1) + 8 * (v4 & 1));
#pragma unroll 1
    for (int tok = 0; tok < 4; ++tok) {
        const int t = t0 + tok;
        int lz = lane; asm volatile("" : "+v"(lz));
        unsigned xq[8], xh[4], xl[4]; float sx; int xsum;
        {
            float m = 0.f;
#pragma unroll
            for (int v4 = 0; v4 < 4; ++v4) { const unsigned rw[4] = {xr4[v4].x, xr4[v4].y, xr4[v4].z, xr4[v4].w};
#pragma unroll
                for (int e = 0; e < 4; ++e) m = fmaxf(m, fmaxf(fabsf(bflo(rw[e])), fabsf(bfhi(rw[e])))); }
            m = fmaxf(wave_max(m), 1e-30f);
            const float inv = 127.f / m; sx = m * (1.f / 127.f);
            int ls = 0;
#pragma unroll
            for (int v4 = 0; v4 < 4; ++v4) { const unsigned rw[4] = {xr4[v4].x, xr4[v4].y, xr4[v4].z, xr4[v4].w};
#pragma unroll
                for (int h2 = 0; h2 < 2; ++h2) { const int a = (int)rintf(bflo(rw[2 * h2]) * inv), b = (int)rintf(bfhi(rw[2 * h2]) * inv), c = (int)rintf(bflo(rw[2 * h2 + 1]) * inv), e = (int)rintf(bfhi(rw[2 * h2 + 1]) * inv);
                    ls += (a + b) + (c + e);
                    xq[2 * v4 + h2] = (unsigned)(a & 255) | ((unsigned)(b & 255) << 8) | ((unsigned)(c & 255) << 16) | ((unsigned)(e & 255) << 24); } }
#pragma unroll
            for (int o = 1; o < 64; o <<= 1) ls += __shfl_xor(ls, o);
            xsum = ls;
#pragma unroll
            for (int e = 0; e < 4; ++e) { const unsigned pa = xq[e] ^ 0x80808080u, pb = xq[4 + e] ^ 0x80808080u;
                xh[e] = ((pa >> 4) & 0x0F0F0F0Fu) | (pb & 0xF0F0F0F0u); xl[e] = (pa & 0x0F0F0F0Fu) | ((pb << 4) & 0xF0F0F0F0u); }
            asm volatile("" ::: "memory");
#pragma unroll
            for (int v4 = 0; v4 < 4; ++v4) { const unsigned rw[4] = {xr4[v4].x, xr4[v4].y, xr4[v4].z, xr4[v4].w};
#pragma unroll
                for (int e = 0; e < 4; ++e) { acc[8 * v4 + 2 * e] = bflo(rw[e]); acc[8 * v4 + 2 * e + 1] = bfhi(rw[e]); } } }
        const float ascale = sx / sqrtf(rss * (1.f / 2048.f) + EPS);
        cul[lz] = ascale * su0; cul[64 + lz] = ascale * su1; culi[lz] = sn0; culi[64 + lz] = sn1;
        cul[128 + lz] = gtl[tok * 128 + lz] * sv0; cul[192 + lz] = gtl[tok * 128 + 64 + lz] * sv1;
        CBAR(); LDS_WAIT();
        int nex0 = ex0, nex1 = ex1, nsn0 = 0, nsn1 = 0; float nrss = 1.f, nsu0 = 0.f, nsu1 = 0.f, nsv0 = 0.f, nsv1 = 0.f;
#pragma unroll 1
        for (int k0 = 0; k0 < 128; k0 += 8) {
            if (tok < 3 && k0 == 120) {
                nex0 = exl[(tok + 1) * 128 + lz]; nex1 = exl[(tok + 1) * 128 + 64 + lz];
                nrss = rssx[t + 1]; nsu0 = su[nex0]; nsu1 = su[nex1]; nsv0 = sv[nex0]; nsv1 = sv[nex1]; nsn0 = snt[nex0]; nsn1 = snt[nex1];
#pragma unroll
                for (int v4 = 0; v4 < 4; ++v4) xr4[v4] = *(const u32x4*)(x1b + (size_t)(t + 1) * 2048 + 16 * lz + 1024 * (v4 >> 1) + 8 * (v4 & 1));
                if (tok < 2) LOAD_SCORES_L(sn, t + 2, 0, lz); }
            int p[8];
#pragma unroll
            for (int i = 0; i < 8; ++i) { unsigned ah = 0u, al = 0u;
                const unsigned w4[4] = {bu[i].x, bu[i].y, bu[i].z, bu[i].w};
#pragma unroll
                for (int e = 0; e < 4; ++e) { ah = __builtin_amdgcn_udot8(w4[e], xh[e], ah, false); al = __builtin_amdgcn_udot8(w4[e], xl[e], al, false); }
                p[i] = (int)(16u * ah + al); vls[i * 64 + lane] = bv[i]; }
            { const bool nxt = (k0 + 8) >= 128;
              const int kb = (k0 + 8) & 127; const int sel = nxt ? (kb < 64 ? nex0 : nex1) : (kb < 64 ? ex0 : ex1);
#pragma unroll
              for (int i = 0; i < 8; ++i) { const int _e = __builtin_amdgcn_readlane(sel, (kb & 63) + i);
                  const unsigned char* _p = uv + (size_t)_e * 2048 + 16 * lane; bu[i] = *(const u32x4*)_p; bv[i] = *(const u32x4*)(_p + 1024); } }
            float wcur;
            { const bool b0 = lane & 1, b1 = lane & 2, b2 = lane & 4;
            int q4[4], q2[2], q1;
#pragma unroll
            for (int i = 0; i < 4; ++i) { const int keep = b0 ? p[i + 4] : p[i], send = b0 ? p[i] : p[i + 4]; q4[i] = keep + __shfl_xor(send, 1); }
#pragma unroll
            for (int i = 0; i < 2; ++i) { const int keep = b1 ? q4[i + 2] : q4[i], send = b1 ? q4[i] : q4[i + 2]; q2[i] = keep + __shfl_xor(send, 2); }
            { const int keep = b2 ? q2[1] : q2[0], send = b2 ? q2[0] : q2[1]; q1 = keep + __shfl_xor(send, 4); }
            q1 += __shfl_xor(q1, 8); q1 += __shfl_xor(q1, 16); q1 += __shfl_xor(q1, 32);
            const int k = (k0 + 4 * (lane & 1) + 2 * ((lane >> 1) & 1) + ((lane >> 2) & 1)) & 127;
            const float a = (float)(2 * q1 - culi[k] - 15 * xsum) * cul[k];
            wcur = cul[128 + k] * gelu_as(a); }
            CBAR();
#pragma unroll 1
            for (int i = 0; i < 8; ++i) { const int rl = ((i & 1) << 2) | (i & 2) | ((i >> 2) & 1);
                const float w = __builtin_bit_cast(float, __builtin_amdgcn_readlane(__builtin_bit_cast(int, wcur), rl));
                const u32x4 vv = vls[i * 64 + lane];
                const unsigned w4[4] = {vv.x, vv.y, vv.z, vv.w};
#pragma unroll
                for (int e = 0; e < 4; ++e) {
#define P6_VACC(bb) { const f32x2 pq = __builtin_amdgcn_cvt_scalef32_pk_f32_fp4(w4[e], 1.0f, bb); acc[8 * e + 2 * bb] += w * pq.x; acc[8 * e + 2 * bb + 1] += w * pq.y; }
                    P6_VACC(0) P6_VACC(1) P6_VACC(2) P6_VACC(3)
#undef P6_VACC
                } }
            CBAR();
            if (tok < 3 && !(k0 & 8)) { const int hh = k0 >> 4;
                const float cs[4] = {sn[0], sn[1], sn[2], sn[3]};
                if (hh < 7) LOAD_SCORES_L(sn, t + 1, hh + 1, lz);
                peer_topk(cs, sc, exl + (tok + 1) * 128 + hh * 16, gtl + (tok + 1) * 128 + hh * 16, lane); }
        }
        float* op = A.out + (size_t)t * 2048 + 16 * lz;
        if (!(pflags & 128)) {
#pragma unroll
        for (int j = 0; j < 2; ++j)
#pragma unroll
            for (int c4 = 0; c4 < 4; ++c4) { const int a0 = 16 * j + 4 * c4;
                *(f32x4*)(op + 1024 * j + 4 * c4) = (f32x4){acc[a0], acc[a0 + 1], acc[a0 + 2], acc[a0 + 3]}; }
        } else if (acc[1] == 12345.678f) op[0] = acc[0];
        ex0 = nex0; ex1 = nex1; rss = nrss; su0 = nsu0; su1 = nsu1; sv0 = nsv0; sv1 = nsv1; sn0 = nsn0; sn1 = nsn1;
    }
#undef ISSUE_E
#undef LOAD_SCORES
#undef LOAD_SCORES_L
}

__global__ void __launch_bounds__(512, 2) mk_fwd(Args args) {
    extern __shared__ __attribute__((aligned(16))) unsigned char lds_raw[];
    LAS unsigned char* lds = (LAS unsigned char*)lds_raw;
    const int tid = threadIdx.x, lane = tid & 63, wave = __builtin_amdgcn_readfirstlane(tid >> 6);
    volatile LAS unsigned* MISC = (volatile LAS unsigned*)(lds + MISC_OFF);
    if (tid < 64) MISC[tid] = 0u;
    __syncthreads();
    unsigned char* ws = args.ws;
    const int lo = args.ph_lo, hi = args.ph_hi & 0xff;
#ifdef MK_PROBE
    const int pflags = args.ph_hi >> 8;
#else
    constexpr int pflags = 0;
#endif
    XcdBarrier bar; bar.bar = (unsigned*)(ws + WS_CTL); bar.x = 0; bar.st = nullptr;
    if (hi - lo > 1) bar = xcd_barrier_post((unsigned*)(ws + WS_CTL), MISC + 8);
#ifndef PH_MASK
#define PH_MASK 0x7f
#endif
#define IN(k) (((PH_MASK >> (k)) & 1) && lo <= (k) && (k) < hi)
#define SEAM(k) do { if (IN(k) && IN((k) + 1)) xcd_barrier(bar); } while (0)

    if (IN(0)) { p0_prologue(args, lds, wave, lane, pflags); }
    SEAM(0);
    if (IN(1)) {
        pg8::Gemm g{(const bf16_t*)(ws + WS_HB), (const bf16_t*)(ws + WS_WINT), NTOK, DPROJ, DM}; pg8::StaticOrder S; S.init(NTOK, DPROJ, gridDim.x, (int)blockIdx.x);
        pg8::EpiProj E{(bf16_t*)(ws + WS_PROJ), DPROJ};
        pg8::gemm_phase<pg8::EpiProj, pg8::StaticOrder, false>(lds, g, S, E, nullptr);
    }
    SEAM(1);
    if (IN(2)) {
        const bool prep_first = blockIdx.x & 1;
        if (prep_first && !(pflags & 8)) { for (int it = blockIdx.x * 8 + wave; it < 2048; it += gridDim.x * 8) prep2_item(args, lds + wave * SSM_WL, it, lane); __syncthreads(); }
        if (!(pflags & 4)) for (int u = blockIdx.x; u < 256; u += gridDim.x) ssm_unit(args, lds, u >> 6, u & 63, wave, lane);
        if (!prep_first && !(pflags & 8)) for (int it = blockIdx.x * 8 + wave; it < 2048; it += gridDim.x * 8) prep2_item(args, lds + wave * SSM_WL, it, lane);
    }
    SEAM(2);
    if (IN(3)) {
        if (!(pflags & 2)) {
            pg8::Gemm g{(const bf16_t*)(ws + WS_YB), (const bf16_t*)(ws + WS_GLUT), NTOK, 1024, 1024}; pg8::StaticOrder S; S.init(NTOK, 1024, gridDim.x, (int)blockIdx.x);
            pg8::EpiGlu E{(const bf16_t*)(ws + WS_YB), (bf16_t*)(ws + WS_MIXED) + 1024, args.in[15], (float*)(ws + WS_CTL + CTL_RSS_SSM)};
            pg8::gemm_phase<pg8::EpiGlu, pg8::StaticOrder, false>(lds, g, S, E, nullptr);
        }
        __syncthreads();
        if (!(pflags & 1)) for (;;) {
            if (tid == 0) MISC[0] = atomicAdd((unsigned*)(ws + WS_CTL + CTL_QCTR), 1u);
            __syncthreads();
            const unsigned u = MISC[0];
            __syncthreads();
            if (u < 512u) attn_unit(args, lds, (int)u, tid, wave, lane, pflags);
            unsigned c = 0u;
            for (int rep = 0; rep < 2; ++rep) {
                if (tid == 0) MISC[1] = atomicAdd((unsigned*)(ws + WS_CTL + CTL_QCTR2), 1u);
                __syncthreads();
                c = MISC[1];
                __syncthreads();
                if (c < 1024u) { if (!(pflags & 128)) table_chunk(args, (int)c, wave, lane); } else break;
            }
            if (u >= 512u && c >= 1024u) break;
        }
    }
    SEAM(3);
    if (IN(4)) {
        pg8::Gemm g{(const bf16_t*)(ws + WS_MIXED), (const bf16_t*)(ws + WS_WOUTT), NTOK, DM, DM}; pg8::StaticOrder S; S.init(NTOK, DM, gridDim.x, (int)blockIdx.x);
        LAS float* tab = (LAS float*)(lds + 131072);
        { pg8::Unit u0; if (S.next(0, u0) && tid < 256) { const int row = u0.pm * 256 + tid;
            const float ra = 1.0f / sqrtf(((const float*)(ws + WS_CTL + CTL_RSS_ATTN))[row] * (1.f / 1024.f) + EPS), rs = 1.0f / sqrtf(((const float*)(ws + WS_CTL + CTL_RSS_SSM))[row] * (1.f / 1024.f) + EPS);
            tab[tid] = ra / rs; tab[256 + tid] = rs; } }
        __syncthreads();
        pg8::EpiWout E{args.in[0], args.out, (bf16_t*)(ws + WS_HB), (float*)(ws + WS_CTL + CTL_RSS_X1), tab};
        pg8::gemm_phase<pg8::EpiWout, pg8::StaticOrder, false>(lds, g, S, E, nullptr);
    }
    SEAM(4);
    if (IN(5)) {
        pg8::Gemm g{(const bf16_t*)(ws + WS_HB), (const bf16_t*)(ws + WS_WPT), NTOK, DM, DM}; pg8::StaticOrder S; S.init(NTOK, DM, gridDim.x, (int)blockIdx.x);
        pg8::EpiScores E{(float*)(ws + WS_PROJ), (const float*)(ws + WS_CTL + CTL_RSS_X1)};
        pg8::gemm_phase<pg8::EpiScores, pg8::StaticOrder, false>(lds, g, S, E, nullptr);
    }
    SEAM(5);
    if (IN(6)) { peer_wave(args, lds, wave, lane, pflags); }
#undef IN
#undef SEAM
}

#ifndef MK_DEBUG
#ifndef MK_PER_PHASE
#define MK_PER_PHASE 0
#endif
extern "C" void kernel_launch(void* const* d_in, const int* in_sizes, int n_in, void* d_out, int out_size, void* d_ws, size_t ws_size, hipStream_t stream) {
    static int grid = 0;
    if (grid == 0) {
        if (n_in != 25 || out_size != NTOK * DM || ws_size < WS_END) { fprintf(stderr, "kernel_launch: unexpected shapes / workspace (%d inputs, out %d, ws %zu < %zu)\n", n_in, out_size, ws_size, (size_t)WS_END); grid = -1; return; }
        int dev = 0, cus = 0, per_cu = 0;
        if (hipGetDevice(&dev) != hipSuccess || hipDeviceGetAttribute(&cus, hipDeviceAttributeMultiprocessorCount, dev) != hipSuccess) { grid = -1; return; }
        if (hipFuncSetAttribute((const void*)mk_fwd, hipFuncAttributeMaxDynamicSharedMemorySize, LDS_BYTES) != hipSuccess) { fprintf(stderr, "kernel_launch: hipFuncSetAttribute failed\n"); grid = -1; return; }
        if (hipOccupancyMaxActiveBlocksPerMultiprocessor(&per_cu, (const void*)mk_fwd, 512, LDS_BYTES) != hipSuccess || per_cu < 1) { fprintf(stderr, "kernel_launch: occupancy query reports %d\n", per_cu); }
        (void)hipGetLastError();
        if (cus < 256) { fprintf(stderr, "kernel_launch: built for a 256-CU device (found %d CUs): a 256-workgroup grid would not be resident; nothing launched\n", cus); grid = -1; return; }
        grid = 256;
    }
    if (grid < 0) return;
    (void)hipMemsetAsync((char*)d_ws + WS_CTL, 0, CTL_BYTES, stream);
    Args a{};
    for (int i = 0; i < 25; ++i) a.in[i] = (const float*)d_in[i];
    a.out = (float*)d_out; a.ws = (unsigned char*)d_ws;
#if MK_PER_PHASE
#ifndef MK_DUP
#define MK_DUP -1
#endif
    for (int p = 0; p < 7; ++p) { a.ph_lo = p; a.ph_hi = p + 1; hipLaunchKernelGGL(mk_fwd, dim3(grid), dim3(512), LDS_BYTES, stream, a);
        if (p == MK_DUP) {
            (void)hipMemsetAsync((char*)d_ws + WS_CTL + CTL_QCTR, 0, 512, stream);
#ifndef MK_DUP_FLAGS
#define MK_DUP_FLAGS 0
#endif
            if (p == 3 && !((MK_DUP_FLAGS) & (1 | 16 | 32 | 64))) (void)hipMemsetAsync((char*)d_ws + WS_CTL + CTL_RSS_ATTN, 0, 32768, stream);
            if (p == 3 && !((MK_DUP_FLAGS) & 2)) (void)hipMemsetAsync((char*)d_ws + WS_CTL + CTL_RSS_SSM, 0, 32768, stream);
            if (p == 4) (void)hipMemsetAsync((char*)d_ws + WS_CTL + CTL_RSS_X1, 0, 32768, stream);
            a.ph_hi |= (MK_DUP_FLAGS) << 8;
            hipLaunchKernelGGL(mk_fwd, dim3(grid), dim3(512), LDS_BYTES, stream, a); } }
#else
    a.ph_lo = 0; a.ph_hi = 7;
    hipLaunchKernelGGL(mk_fwd, dim3(grid), dim3(512), LDS_BYTES, stream, a);
#endif
}
#endif
```

```cpp
#include <hip/hip_runtime.h>
#include <stdint.h>
#include <stdio.h>

typedef unsigned short bf16_t;
typedef float f32x2 __attribute__((ext_vector_type(2)));
typedef unsigned u32x2 __attribute__((ext_vector_type(2)));
using bf16x2v = __attribute__((ext_vector_type(2))) __bf16;

constexpr int NTOK = 8192, SEQ = 2048, DM = 2048, DPROJ = 4096;
constexpr float EPS = 1e-6f;
constexpr float LOG2E = 1.4426950408889634f;

constexpr size_t MB = 1024 * 1024;
constexpr size_t WS_CTL = 0;
constexpr size_t CTL_BYTES = 256 * 1024;
constexpr size_t CTL_QCTR = 16384;
constexpr size_t CTL_QCTR2 = 16384 + 256;
constexpr size_t CTL_RSS_ATTN = 65536, CTL_RSS_SSM = 131072, CTL_RSS_X1 = 196608;
constexpr size_t WS_HB = 256 * 1024;
constexpr size_t WS_WINT = WS_HB + 32 * MB;
constexpr size_t WS_GLUT = WS_WINT + 16 * MB;
constexpr size_t WS_WOUTT = WS_GLUT + 2 * MB;
constexpr size_t WS_WPT = WS_WOUTT + 8 * MB;
constexpr size_t WS_UB = WS_WPT + 8 * MB;
constexpr size_t WS_VB = WS_UB + 32 * MB;
constexpr size_t WS_SN = WS_VB + 24 * MB;
constexpr size_t WS_SU = WS_VB + 32 * MB;
constexpr size_t WS_SV = WS_SU + 65536;
constexpr size_t WS_PROJ = WS_SV + 65536;
constexpr size_t WS_QF = WS_PROJ + 64 * MB;
constexpr size_t WS_KF = WS_QF + 48 * MB;
constexpr size_t WS_VT = WS_KF + 48 * MB;
constexpr size_t WS_QN = WS_QF, WS_KN = WS_KF;
constexpr size_t WS_EW = WS_QF;
constexpr size_t VS_SLICE = 16384 * 128;
constexpr size_t WS_YB = WS_VT + 48 * MB + 4096;
constexpr size_t WS_MIXED = WS_YB + 16 * MB;
constexpr size_t WS_SSMP = WS_MIXED + 32 * MB;
constexpr size_t SSMP_ABAR = 0, SSMP_A256 = 32768, SSMP_BFRAG = 65536, SSMP_CFRAG = 65536 + 524288;
constexpr size_t SSMP_BBT = 1 * MB;
constexpr size_t SSMP_VAND = 2 * MB;
constexpr size_t WS_BTAB = WS_SSMP + 8 * MB;
constexpr size_t WS_END = WS_BTAB + 64 * 1024;

constexpr int LDS_BYTES = 147456;
constexpr int MISC_OFF = 147456 - 256;
#define XB_TMO      128
#define XB_XCNT(j)  (256  + 64 * (j))
#define XB_XSUB(j)  (1280 + 64 * (j))
#define XB_XGEN(j)  (2304 + 64 * (j))
#define XB_TOP      3328
#define XB_TOPGEN   3392
#define XCD_BAR_WORDS 3456
#define XB_SPIN_CAP (1u << 18)
#define LAS __attribute__((address_space(3)))

__device__ __forceinline__ unsigned xb_ld(unsigned* p)              { return __hip_atomic_load(p, __ATOMIC_RELAXED, __HIP_MEMORY_SCOPE_AGENT); }
__device__ __forceinline__ unsigned xb_add(unsigned* p, unsigned v) { return __hip_atomic_fetch_add(p, v, __ATOMIC_RELAXED, __HIP_MEMORY_SCOPE_AGENT); }
__device__ __forceinline__ unsigned xb_xcc_id() { return (unsigned)__builtin_amdgcn_s_getreg((3 << 11) | 20) & 0xFu; }
#define XB_SPIN(cond, bar) do { unsigned _sp = 0; while (cond) { __builtin_amdgcn_s_sleep(1); \
    if ((++_sp & 255u) == 0u) { if (xb_ld(&(bar)[XB_TMO])) break; if (_sp > XB_SPIN_CAP) { atomicAdd(&(bar)[XB_TMO], 1u); break; } } } } while (0)

struct XcdBarrier {
    unsigned* bar; unsigned x;
    volatile LAS unsigned* st;
};

__device__ __forceinline__ XcdBarrier xcd_barrier_post(unsigned* bar, volatile LAS unsigned* st) {
    XcdBarrier b; b.bar = bar; b.x = xb_xcc_id(); b.st = st;
    if (threadIdx.x == 0) (void)xb_add(&bar[XB_XCNT(b.x)], 1u);
    return b;
}
__device__ __forceinline__ void xcd_barrier_complete(unsigned* bar, unsigned x, unsigned& nloc, unsigned& nx) {
    const unsigned G = gridDim.x * gridDim.y * gridDim.z;
    unsigned sum, cnt, mine, sp = 0u;
    for (;;) {
        sum = 0u; cnt = 0u; mine = 0u;
#pragma unroll
        for (unsigned j = 0; j < 16; ++j) { const unsigned c = xb_ld(&bar[XB_XCNT(j)]); sum += c; cnt += (c > 0u) ? 1u : 0u; mine = (j == x) ? c : mine; }
        if (sum == G) break;
        __builtin_amdgcn_s_sleep(1);
        if ((++sp & 255u) == 0u) { if (xb_ld(&bar[XB_TMO])) break; if (sp > XB_SPIN_CAP) { atomicAdd(&bar[XB_TMO], 1u); break; } }
    }
    nloc = mine > 0u ? mine : 1u; nx = cnt > 0u ? cnt : 1u;
}

__device__ __forceinline__ void xcd_barrier(const XcdBarrier& b) {
    asm volatile("s_waitcnt vmcnt(0)" ::: "memory");
    __syncthreads();
    if (threadIdx.x == 0) {
        unsigned* bar = b.bar;
        __builtin_amdgcn_s_waitcnt(0);
        unsigned nloc = b.st[0], nx = b.st[1];
        if (nloc == 0u) { xcd_barrier_complete(bar, b.x, nloc, nx); b.st[0] = nloc; b.st[1] = nx; }
        const unsigned old = xb_add(&bar[XB_XSUB(b.x)], 1u);
        const unsigned gen = old / nloc;
        if (old + 1u == (gen + 1u) * nloc) {
            __builtin_amdgcn_fence(__ATOMIC_RELEASE, "agent");
            asm volatile("s_waitcnt vmcnt(0)" ::: "memory");
            const unsigned og = xb_add(&bar[XB_TOP], 1u);
            const unsigned tg = og / nx;
            if (og + 1u == (tg + 1u) * nx) xb_add(&bar[XB_TOPGEN], 1u);
            else XB_SPIN(xb_ld(&bar[XB_TOPGEN]) == tg, bar);
            __builtin_amdgcn_fence(__ATOMIC_ACQUIRE, "agent");
            xb_add(&bar[XB_XGEN(b.x)], 1u);
            asm volatile("s_waitcnt vmcnt(0)" ::: "memory");
        } else {
            XB_SPIN(xb_ld(&bar[XB_XGEN(b.x)]) == gen, bar);
            __builtin_amdgcn_fence(__ATOMIC_ACQUIRE, "agent");
            asm volatile("s_waitcnt vmcnt(0)" ::: "memory");
        }
    }
    __syncthreads();
}
namespace pg8 {
#define PG8_LAS __attribute__((address_space(3)))
typedef unsigned short bf16_t;
typedef short bf16x8 __attribute__((ext_vector_type(8)));
typedef float f32x4 __attribute__((ext_vector_type(4)));
typedef unsigned u32x4 __attribute__((ext_vector_type(4)));
constexpr int BM = 256, BK = 64, HALF = 128, HTB = HALF * BK * 2  , STAGE_BYTES = 8 * HTB, NXCD = 8, WGM = 8;

__host__ __device__ __forceinline__ int lds_byte(int r, int c) { const int st = (r >> 4) * 2 + (c >> 5), rr = r & 15, cc = c & 31, ob = rr * 64 + cc * 2; return st * 1024 + (ob ^ (((ob >> 9) & 1) << 5)); }
__host__ __device__ __forceinline__ void stage_rc(int b, int& R, int& C) { const int st = b / 1024, sb = b % 1024, swz = sb ^ (((sb >> 9) & 1) << 5); R = (st >> 1) * 16 + swz / 64; C = (st & 1) * 32 + (swz % 64) / 2; }
__host__ __device__ __forceinline__ int perm32(int rho) { const int n = rho >> 4, i = rho & 15; return 8 * (i >> 2) + 4 * n + (i & 3); }

struct Unit { int pm, pn; };
struct Gemm { const bf16_t* A; const bf16_t* Bt; int M, N, K; };

struct StaticOrder {
    int nM, nN, nwg, G, c;
    __host__ __device__ __forceinline__ void init(int M, int N, int G_, int c_) { nM = M / BM; nN = N / BM; nwg = nM * nN; G = G_; c = c_; }
    __host__ __device__ __forceinline__ bool next(int i, Unit& u) const {
        const long L = (long)i * G + c; if (L >= nwg) return false;
        int wgid = (int)L; { const int q = nwg / NXCD, r = nwg % NXCD, xcd = wgid % NXCD, off = wgid / NXCD; wgid = (xcd < r ? xcd * (q + 1) : r * (q + 1) + (xcd - r) * q) + off; }
        const int nig = WGM * nN, gid = wgid / nig, fm = gid * WGM, gsz = (nM - fm) < WGM ? (nM - fm) : WGM;
        u.pm = fm + ((wgid % nig) % gsz); u.pn = (wgid % nig) / gsz; return true;
    }
    __device__ __forceinline__ void a_ready(const Unit&) const {}
    __device__ __forceinline__ void done(const Unit&) const {}
};
typedef float cvt_f32x2 __attribute__((ext_vector_type(2)));
typedef __bf16 cvt_bf16x2 __attribute__((ext_vector_type(2)));
__device__ __forceinline__ unsigned cvt_pk_bf16(float lo, float hi) { return __builtin_bit_cast(unsigned, __builtin_convertvector((cvt_f32x2){lo, hi}, cvt_bf16x2)); }
typedef unsigned long long rss_t;
__device__ __forceinline__ void rss_add(rss_t* p, float ss) { atomicAdd(p, (rss_t)(ss * 16777216.f)); }
__device__ __forceinline__ float rss_get(const rss_t* p) { return (float)(*p) * (1.f / 16777216.f); }
__device__ __forceinline__ float bflo(unsigned u) { return __uint_as_float(u << 16); }
__device__ __forceinline__ float bfhi(unsigned u) { return __uint_as_float(u & 0xffff0000u); }

struct EpiProj {
    static constexpr bool PERM = true, AFTER_DRAIN = false, HAS_MID = false;
    bf16_t* O; int ldc;
    __device__ __forceinline__ void mid(f32x4 (&)[2][2][4][2], const Unit&, int, int, int, int) const {}
    __device__ __forceinline__ void operator()(const f32x4 (&acc)[2][2][4][2], const Unit& u, int wr, int wc, int fr, int fq) const {
        const int row0 = u.pm * BM + wr * 64 + fr, col0 = u.pn * BM + wc * 32 + 8 * fq;
#pragma unroll
        for (int ai = 0; ai < 2; ++ai)
#pragma unroll
            for (int m = 0; m < 4; ++m) { bf16_t* rowp = O + (size_t)(row0 + ai * HALF + m * 16) * ldc + col0;
#pragma unroll
                for (int bj = 0; bj < 2; ++bj) { const f32x4 v0 = acc[ai][bj][m][0], v1 = acc[ai][bj][m][1];
                    u32x4 w; w.x = cvt_pk_bf16(v0[0], v0[1]); w.y = cvt_pk_bf16(v0[2], v0[3]); w.z = cvt_pk_bf16(v1[0], v1[1]); w.w = cvt_pk_bf16(v1[2], v1[3]);
                    *(u32x4*)(rowp + bj * HALF) = w; } }
    }
};

struct EpiGlu {
    static constexpr bool PERM = true, AFTER_DRAIN = false, HAS_MID = false;
    const bf16_t* Y; bf16_t* O; const float* bias; rss_t* rss;
    __device__ __forceinline__ void mid(f32x4 (&)[2][2][4][2], const Unit&, int, int, int, int) const {}
    __device__ __forceinline__ void operator()(const f32x4 (&acc)[2][2][4][2], const Unit& u, int wr, int wc, int fr, int fq) const {
        const int row0 = u.pm * BM + wr * 64 + fr, col0 = u.pn * BM + wc * 32 + 8 * fq;
        f32x4 bv[2][2];
#pragma unroll
        for (int bj = 0; bj < 2; ++bj)
#pragma unroll
            for (int n = 0; n < 2; ++n) bv[bj][n] = *(const f32x4*)(bias + col0 + bj * HALF + 4 * n);
        u32x4 yq[2][2];
#pragma unroll
        for (int bj = 0; bj < 2; ++bj) yq[0][bj] = *(const u32x4*)(Y + (size_t)row0 * 1024 + col0 + bj * HALF);
#pragma unroll
        for (int idx = 0; idx < 8; ++idx) { const int ai = idx >> 2, m = idx & 3, row = row0 + ai * HALF + m * 16; float ss = 0.f;
            if (idx < 7) { const int nrow = row0 + ((idx + 1) >> 2) * HALF + ((idx + 1) & 3) * 16;
#pragma unroll
                for (int bj = 0; bj < 2; ++bj) yq[(idx + 1) & 1][bj] = *(const u32x4*)(Y + (size_t)nrow * 1024 + col0 + bj * HALF); }
#pragma unroll
            for (int bj = 0; bj < 2; ++bj) {
                const u32x4 yv = yq[idx & 1][bj];
                const f32x4 g0 = acc[ai][bj][m][0] + bv[bj][0], g1 = acc[ai][bj][m][1] + bv[bj][1];
                float y[8] = {bflo(yv.x), bfhi(yv.x), bflo(yv.y), bfhi(yv.y), bflo(yv.z), bfhi(yv.z), bflo(yv.w), bfhi(yv.w)};
                float o[8];
#pragma unroll
                for (int e = 0; e < 4; ++e) { o[e] = y[e] * __builtin_amdgcn_rcpf(1.f + __expf(-g0[e])); o[4 + e] = y[4 + e] * __builtin_amdgcn_rcpf(1.f + __expf(-g1[e])); }
#pragma unroll
                for (int e = 0; e < 8; ++e) ss += o[e] * o[e];
                u32x4 w; w.x = cvt_pk_bf16(o[0], o[1]); w.y = cvt_pk_bf16(o[2], o[3]); w.z = cvt_pk_bf16(o[4], o[5]); w.w = cvt_pk_bf16(o[6], o[7]);
                *(u32x4*)(O + (size_t)row * 2048 + col0 + bj * HALF) = w; }
            ss += __shfl_xor(ss, 16); ss += __shfl_xor(ss, 32);
            if (fq == 0) rss_add(rss + row, ss); }
    }
};

struct EpiWout {
    static constexpr bool PERM = true, AFTER_DRAIN = false, HAS_MID = true;
    const float* X; float* OUT; bf16_t* XB; rss_t* rss_x; const PG8_LAS float* tab;
    __device__ __forceinline__ void mid(f32x4 (&acc)[2][2][4][2], const Unit& u, int wr, int wc, int fr, int fq) const {
        const PG8_LAS float* tp = tab + wr * 64 + fr;
#pragma unroll
        for (int ai = 0; ai < 2; ++ai)
#pragma unroll
            for (int m = 0; m < 4; ++m) { const float ratio = tp[ai * HALF + m * 16];
#pragma unroll
                for (int bj = 0; bj < 2; ++bj)
#pragma unroll
                    for (int n = 0; n < 2; ++n) acc[ai][bj][m][n] *= ratio; }
    }
    __device__ __forceinline__ void operator()(const f32x4 (&acc)[2][2][4][2], const Unit& u, int wr, int wc, int fr, int fq) const {
        const int row0 = u.pm * BM + wr * 64 + fr, col0 = u.pn * BM + wc * 32 + 8 * fq;
        const PG8_LAS float* tp = tab + 256 + wr * 64 + fr;
        f32x4 xq[2][2][2];
#pragma unroll
        for (int bj = 0; bj < 2; ++bj) { const size_t o = (size_t)row0 * 2048 + col0 + bj * HALF; xq[0][bj][0] = __builtin_nontemporal_load((const f32x4*)(X + o)); xq[0][bj][1] = __builtin_nontemporal_load((const f32x4*)(X + o + 4)); }
#pragma unroll
        for (int idx = 0; idx < 8; ++idx) { const int ai = idx >> 2, m = idx & 3, row = row0 + ai * HALF + m * 16; float ss = 0.f;
            if (idx < 7) { const int nrow = row0 + ((idx + 1) >> 2) * HALF + ((idx + 1) & 3) * 16;
#pragma unroll
                for (int bj = 0; bj < 2; ++bj) { const size_t o = (size_t)nrow * 2048 + col0 + bj * HALF; xq[(idx + 1) & 1][bj][0] = __builtin_nontemporal_load((const f32x4*)(X + o)); xq[(idx + 1) & 1][bj][1] = __builtin_nontemporal_load((const f32x4*)(X + o + 4)); } }
            const float rs = tp[ai * HALF + m * 16];
#pragma unroll
            for (int bj = 0; bj < 2; ++bj) { const size_t o = (size_t)row * 2048 + col0 + bj * HALF;
                const f32x4 v0 = xq[idx & 1][bj][0] + rs * acc[ai][bj][m][0], v1 = xq[idx & 1][bj][1] + rs * acc[ai][bj][m][1];
                u32x4 w; w.x = cvt_pk_bf16(v0[0], v0[1]); w.y = cvt_pk_bf16(v0[2], v0[3]); w.z = cvt_pk_bf16(v1[0], v1[1]); w.w = cvt_pk_bf16(v1[2], v1[3]);
                *(u32x4*)(XB + o) = w;
#pragma unroll
                for (int e = 0; e < 4; ++e) ss += v0[e] * v0[e] + v1[e] * v1[e]; }
            ss += __shfl_xor(ss, 16); ss += __shfl_xor(ss, 32);
            if (fq == 0) rss_add(rss_x + row, ss); }
    }
};

struct EpiScores {
    static constexpr bool PERM = false, AFTER_DRAIN = false, HAS_MID = false;
    float* C; const rss_t* rss_x;
    __device__ __forceinline__ void mid(f32x4 (&)[2][2][4][2], const Unit&, int, int, int, int) const {}
    __device__ __forceinline__ void operator()(const f32x4 (&acc)[2][2][4][2], const Unit& u, int wr, int wc, int fr, int fq) const {
        const int row0 = u.pm * BM + wr * 64 + fr, col0 = u.pn * BM + wc * 32 + 4 * fq;
        float r2v[8];
#pragma unroll
        for (int idx = 0; idx < 8; ++idx) r2v[idx] = rss_get(rss_x + row0 + (idx >> 2) * HALF + (idx & 3) * 16);
#pragma unroll
        for (int ai = 0; ai < 2; ++ai)
#pragma unroll
            for (int m = 0; m < 4; ++m) { const int row = row0 + ai * HALF + m * 16;
                const float r2 = __builtin_amdgcn_rsqf(r2v[ai * 4 + m] * (1.f / 2048.f) + 1e-6f);
                float* rowp = C + (size_t)row * 2048 + col0;
#pragma unroll
                for (int bj = 0; bj < 2; ++bj)
#pragma unroll
                    for (int n = 0; n < 2; ++n) *(f32x4*)(rowp + bj * HALF + n * 16) = acc[ai][bj][m][n] * r2; }
    }
};

template <class Epi, class Sched, bool STAMP = false>
__device__ __forceinline__ void gemm_phase(PG8_LAS unsigned char* lds, const Gemm g, const Sched& S, const Epi& E, unsigned long long* stamps) {
    const int tid = threadIdx.x, wid = __builtin_amdgcn_readfirstlane(tid >> 6), lane = tid & 63, wr = wid >> 2, wc = wid & 3, fr = lane & 15, fq = lane >> 4;
    const int K = g.K, nt = K / BK;
    int ts_lo = 0, ts_hi = 0, nts = 0; const unsigned long long rt_entry = STAMP ? (unsigned long long)wall_clock64() : 0ull;
#define PG8_STAMP() do { if (STAMP && wid == 0 && nts < 64) { const unsigned long long _c = (unsigned long long)clock64(); \
        ts_lo = (lane == nts) ? (int)(unsigned)_c : ts_lo; ts_hi = (lane == nts) ? (int)(unsigned)(_c >> 32) : ts_hi; ++nts; } } while (0)
    PG8_STAMP();
    unsigned voffA[2], voffB[2];
#pragma unroll
    for (int i = 0; i < 2; ++i) { int R, C; stage_rc(tid * 16 + i * 8192, R, C); const int Rb = Epi::PERM ? ((R & ~31) + perm32(R & 31)) : R;
        voffA[i] = (unsigned)(R * K + C) * 2u; voffB[i] = (unsigned)(Rb * K + C) * 2u; }
    const size_t kstep = (size_t)(BK * 2);
    const size_t hstep = (size_t)HALF * K * 2;
    const size_t tstep = 2 * hstep;
    const unsigned ldsw = (unsigned)wid * 1024u;
    const int aoff = lds_byte(wr * 64 + fr, fq * 8), boff = lds_byte(wc * 32 + fr, fq * 8);
#define PG8_SA(b, h) (((b) * 2 + (h)) * HTB)
#define PG8_SB(b, h) ((4 + (b) * 2 + (h)) * HTB)
#define PG8_STAGE(bufoff, gbase, voff) do { _Pragma("unroll") for (int _i = 0; _i < 2; ++_i) \
        __builtin_amdgcn_global_load_lds((const unsigned*)((const char*)(gbase) + (voff)[_i]), (PG8_LAS unsigned*)(lds + (bufoff) + ldsw + _i * 8192), 16, 0, 0); } while (0)
#define PG8_LDA(dst, b, h) do { _Pragma("unroll") for (int m = 0; m < 4; ++m) _Pragma("unroll") for (int k = 0; k < 2; ++k) dst[m][k] = *(const PG8_LAS bf16x8*)(lds + PG8_SA(b, h) + aoff + m * 2048 + k * 1024); } while (0)
#define PG8_LDB(dst, b, h) do { _Pragma("unroll") for (int n = 0; n < 2; ++n) _Pragma("unroll") for (int k = 0; k < 2; ++k) dst[n][k] = *(const PG8_LAS bf16x8*)(lds + PG8_SB(b, h) + boff + n * 2048 + k * 1024); } while (0)
#define PG8_MMA(ai, bj, At, Bt) do { __builtin_amdgcn_s_setprio(1); _Pragma("unroll") for (int m = 0; m < 4; ++m) _Pragma("unroll") for (int n = 0; n < 2; ++n) _Pragma("unroll") for (int k = 0; k < 2; ++k) \
        acc[ai][bj][m][n] = __builtin_amdgcn_mfma_f32_16x16x32_bf16(Bt[n][k], At[m][k], acc[ai][bj][m][n], 0, 0, 0); __builtin_amdgcn_s_setprio(0); } while (0)
#define PG8_WAIT_V(n) asm volatile("s_waitcnt vmcnt(" #n ")" ::: "memory")
#define PG8_WAIT_L(n) asm volatile("s_waitcnt lgkmcnt(" #n ")" ::: "memory")
#define PG8_BAR __builtin_amdgcn_s_barrier()
#define PG8_SCHED __builtin_amdgcn_sched_barrier(0)
    Unit cur, nxt; int ui = 0;
    if (!S.next(0, cur)) return;
    f32x4 acc[2][2][4][2];
#pragma unroll
    for (int a = 0; a < 2; ++a)
#pragma unroll
        for (int b = 0; b < 2; ++b)
#pragma unroll
            for (int m = 0; m < 4; ++m)
#pragma unroll
                for (int n = 0; n < 2; ++n) acc[a][b][m][n] = (f32x4){0.f, 0.f, 0.f, 0.f};
    bf16x8 At[4][2], B0[2][2], B1[2][2];
    const char* cA = (const char*)g.A + (size_t)cur.pm * tstep; const char* cB = (const char*)g.Bt + (size_t)cur.pn * tstep;
    S.a_ready(cur);
    PG8_STAGE(PG8_SB(0, 0), cB, voffB); PG8_STAGE(PG8_SA(0, 0), cA, voffA); PG8_STAGE(PG8_SB(0, 1), cB + hstep, voffB); PG8_STAGE(PG8_SA(0, 1), cA + hstep, voffA);
    if (wr == 1) PG8_BAR;
    PG8_WAIT_V(4); PG8_BAR;
    PG8_STAGE(PG8_SB(1, 0), cB + kstep, voffB); PG8_STAGE(PG8_SA(1, 0), cA + kstep, voffA); PG8_STAGE(PG8_SB(1, 1), cB + hstep + kstep, voffB);
    PG8_WAIT_V(6); PG8_BAR;
    PG8_STAMP();
    for (;;) {
        const bool has_next = S.next(ui + 1, nxt);
        const char* nA = has_next ? (const char*)g.A + (size_t)nxt.pm * tstep : cA; const char* nB = has_next ? (const char*)g.Bt + (size_t)nxt.pn * tstep : cB;
        for (int t = 0; t < nt; t += 2) {
            const bool last = (t == nt - 2);
            const char* a1 = cA + (size_t)(t + 1) * kstep;
            const char* a2 = last ? nA : cA + (size_t)(t + 2) * kstep; const char* b2 = last ? nB : cB + (size_t)(t + 2) * kstep;
            const char* a3 = a2 + kstep; const char* b3 = b2 + kstep;
            if (last && has_next) S.a_ready(nxt);
            if constexpr (Epi::HAS_MID) { if (t == (nt >> 1)) { E.mid(acc, cur, wr, wc, fr, fq); asm volatile("s_waitcnt lgkmcnt(0)" ::: "memory"); } }
            PG8_LDB(B0, 0, 0); PG8_SCHED; PG8_LDA(At, 0, 0); PG8_STAGE(PG8_SA(1, 1), a1 + hstep, voffA);
            PG8_WAIT_L(8); PG8_BAR; PG8_WAIT_L(0); PG8_MMA(0, 0, At, B0); PG8_BAR; PG8_SCHED;
            PG8_LDB(B1, 0, 1); PG8_STAGE(PG8_SB(0, 0), b2, voffB);
            PG8_BAR; PG8_WAIT_L(0); PG8_MMA(0, 1, At, B1); PG8_BAR;
            PG8_LDA(At, 0, 1); PG8_STAGE(PG8_SA(0, 0), a2, voffA);
            PG8_BAR; PG8_WAIT_L(0); PG8_MMA(1, 0, At, B0); PG8_BAR; PG8_SCHED;
            PG8_STAGE(PG8_SB(0, 1), b2 + hstep, voffB);
            PG8_WAIT_V(6); PG8_BAR; PG8_MMA(1, 1, At, B1); PG8_BAR;
            PG8_LDB(B0, 1, 0); PG8_SCHED; PG8_LDA(At, 1, 0); PG8_STAGE(PG8_SA(0, 1), a2 + hstep, voffA);
            PG8_WAIT_L(8); PG8_BAR; PG8_WAIT_L(0); PG8_MMA(0, 0, At, B0); PG8_BAR; PG8_SCHED;
            PG8_LDB(B1, 1, 1); PG8_STAGE(PG8_SB(1, 0), b3, voffB);
            PG8_BAR; PG8_WAIT_L(0); PG8_MMA(0, 1, At, B1); PG8_BAR;
            PG8_LDA(At, 1, 1); PG8_STAGE(PG8_SA(1, 0), a3, voffA);
            PG8_BAR; PG8_WAIT_L(0); PG8_MMA(1, 0, At, B0); PG8_BAR; PG8_SCHED;
            PG8_STAGE(PG8_SB(1, 1), b3 + hstep, voffB);
            PG8_WAIT_V(6); PG8_BAR; PG8_MMA(1, 1, At, B1); PG8_BAR;
        }
        PG8_STAMP();
        if constexpr (!Epi::AFTER_DRAIN) { E(acc, cur, wr, wc, fr, fq); S.done(cur); }
        PG8_STAMP();
        if (!has_next) break;
#pragma unroll
        for (int a = 0; a < 2; ++a)
#pragma unroll
            for (int b = 0; b < 2; ++b)
#pragma unroll
                for (int m = 0; m < 4; ++m)
#pragma unroll
                    for (int n = 0; n < 2; ++n) acc[a][b][m][n] = (f32x4){0.f, 0.f, 0.f, 0.f};
        cur = nxt; cA = nA; cB = nB; ++ui;
    }
    PG8_WAIT_V(0);
    if (wr == 0) PG8_BAR;
    PG8_BAR;
    if constexpr (Epi::AFTER_DRAIN) { E.fused(acc, cur, wr, wc, fr, fq, lds, wid, lane); S.done(cur); }
    PG8_STAMP();
    if (STAMP && wid == 0) { stamps[lane] = lane < nts ? (((unsigned long long)(unsigned)ts_hi << 32) | (unsigned)ts_lo) : 0ull;
        if (lane == 62) stamps[62] = rt_entry; if (lane == 63) stamps[63] = (unsigned long long)wall_clock64(); }
#undef PG8_STAMP
#undef PG8_SA
#undef PG8_SB
#undef PG8_STAGE
#undef PG8_LDA
#undef PG8_LDB
#undef PG8_MMA
#undef PG8_WAIT_V
#undef PG8_WAIT_L
#undef PG8_BAR
#undef PG8_SCHED
}
}

typedef short bf16x8 __attribute__((ext_vector_type(8)));
typedef float f32x4 __attribute__((ext_vector_type(4)));
typedef unsigned u32x4 __attribute__((ext_vector_type(4)));
using pg8::cvt_pk_bf16; using pg8::bflo; using pg8::bfhi;

#define LDS_WAIT() asm volatile("s_waitcnt lgkmcnt(0)" ::: "memory")
#define CBAR() asm volatile("" ::: "memory")
#define MFMA16(a, b, c) __builtin_amdgcn_mfma_f32_16x16x32_bf16((a), (b), (c), 0, 0, 0)

struct Args { const float* in[25]; float* out; unsigned char* ws; int ph_lo, ph_hi; };

__device__ __forceinline__ float wave_sum(float v) {
#pragma unroll
    for (int o = 1; o < 64; o <<= 1) v += __shfl_xor(v, o);
    return v;
}
__device__ __forceinline__ float wave_max(float v) {
#pragma unroll
    for (int o = 1; o < 64; o <<= 1) v = fmaxf(v, __shfl_xor(v, o));
    return v;
}
#define DPP_U(x, ctrl) ((unsigned)__builtin_amdgcn_mov_dpp((int)(x), ctrl, 0xf, 0xf, true))
__device__ __forceinline__ unsigned row16_umax(unsigned v) { unsigned t;
    t = DPP_U(v, 0xB1); v = t > v ? t : v; t = DPP_U(v, 0x4E); v = t > v ? t : v; t = DPP_U(v, 0x141); v = t > v ? t : v; t = DPP_U(v, 0x140); v = t > v ? t : v; return v; }
__device__ __forceinline__ float row16_fmax(float v) { float t;
    t = __uint_as_float(DPP_U(__float_as_uint(v), 0xB1)); v = fmaxf(v, t); t = __uint_as_float(DPP_U(__float_as_uint(v), 0x4E)); v = fmaxf(v, t);
    t = __uint_as_float(DPP_U(__float_as_uint(v), 0x141)); v = fmaxf(v, t); t = __uint_as_float(DPP_U(__float_as_uint(v), 0x140)); v = fmaxf(v, t); return v; }
__device__ __forceinline__ float row16_fsum(float v) {
    v += __uint_as_float(DPP_U(__float_as_uint(v), 0xB1)); v += __uint_as_float(DPP_U(__float_as_uint(v), 0x4E));
    v += __uint_as_float(DPP_U(__float_as_uint(v), 0x141)); v += __uint_as_float(DPP_U(__float_as_uint(v), 0x140)); return v; }
__device__ __forceinline__ unsigned wave_umax(unsigned v) { v = row16_umax(v);
    const unsigned a = (unsigned)__builtin_amdgcn_readlane((int)v, 0), b = (unsigned)__builtin_amdgcn_readlane((int)v, 16), c = (unsigned)__builtin_amdgcn_readlane((int)v, 32), d = (unsigned)__builtin_amdgcn_readlane((int)v, 48);
    const unsigned ab = a > b ? a : b, cd = c > d ? c : d; return ab > cd ? ab : cd; }
__device__ __forceinline__ float gelu_erf(float x) { return 0.5f * x * (1.0f + erff(x * 0.70710678118654752f)); }
__device__ __forceinline__ float gelu_as(float v) {
    const float av = fabsf(v), t = __builtin_amdgcn_rcpf(fmaf(av, 0.2316418882f, 1.0f));
    float q = fmaf(t, 0.5307027145f, -0.7265760135f); q = fmaf(q, t, 0.7107068705f); q = fmaf(q, t, -0.142248368f); q = fmaf(q, t, 0.127414796f); q *= t;
    const float e = __builtin_amdgcn_exp2f(v * v * -0.72134752044f), m = v * (q * e);
    return v < 0.f ? m : v - m;
}
__device__ __forceinline__ bf16x8 as_bf16x8(u32x4 v) { return __builtin_bit_cast(bf16x8, v); }

__device__ __forceinline__ void p0_transpose_item(const float* W, int K, int N, bf16_t* WT, const float* sc_a, const float* sc_b, LAS float* scr, int item, int lane) {
    const int nblk = N / 32, kb = item / nblk, nb = item % nblk, k0 = 64 * kb, n0 = 32 * nb;
    f32x4 ld[8]; float sv8[8];
    const int rr = lane >> 3, n4 = (lane & 7) * 4;
#pragma unroll
    for (int i = 0; i < 8; ++i) { const int k = k0 + 8 * i + rr; ld[i] = __builtin_nontemporal_load((const f32x4*)(W + (size_t)k * N + n0 + n4)); sv8[i] = sc_a ? (k < 1024 ? sc_a[k] : sc_b[k - 1024]) : 1.f; }
#pragma unroll
    for (int i = 0; i < 8; ++i) { LAS float* d = scr + (8 * i + rr) * 33 + n4; const f32x4 v = ld[i] * sv8[i]; d[0] = v.x; d[1] = v.y; d[2] = v.z; d[3] = v.w; }
    LDS_WAIT();
    const int c = lane & 7;
#pragma unroll
    for (int j = 0; j < 4; ++j) { const int n = (lane >> 3) + 8 * j; const LAS float* s = scr + (8 * c) * 33 + n;
        u32x4 o; o.x = cvt_pk_bf16(s[0 * 33], s[1 * 33]); o.y = cvt_pk_bf16(s[2 * 33], s[3 * 33]); o.z = cvt_pk_bf16(s[4 * 33], s[5 * 33]); o.w = cvt_pk_bf16(s[6 * 33], s[7 * 33]);
        *(u32x4*)(WT + (size_t)(n0 + n) * K + k0 + 8 * c) = o; }
    LDS_WAIT();
}
template <int MODE> __device__ __forceinline__ void p0_row(const float* xrow, const float* g, bf16_t* orow, int lane) {
    const f32x4* xr = (const f32x4*)xrow + lane; const f32x4* gr = (const f32x4*)g + lane;
    f32x4 v[8]; float s = 0.f;
#pragma unroll
    for (int j = 0; j < 8; ++j) { v[j] = xr[64 * j]; s += (v[j].x * v[j].x + v[j].y * v[j].y) + (v[j].z * v[j].z + v[j].w * v[j].w); }
    float r = 1.f;
    if (MODE == 0) r = 1.0f / sqrtf(wave_sum(s) * (1.f / 2048.f) + EPS);
    u32x2* o8 = (u32x2*)orow + lane;
#pragma unroll
    for (int j = 0; j < 8; ++j) { f32x4 w = v[j] * r; if (MODE != 2) w = w * gr[64 * j];
        u32x2 o; o.x = cvt_pk_bf16(w.x, w.y); o.y = cvt_pk_bf16(w.z, w.w); o8[64 * j] = o; }
}
template <bool SCALE_G, bool OFFS> __device__ __forceinline__ void p0_row_q8(const float* xrow, const float* g, unsigned char* orow, float* sc, int lane) {
    const f32x4* xr = (const f32x4*)xrow + lane; const f32x4* gr = (const f32x4*)g + lane;
    f32x4 v[8]; float m = 0.f;
#pragma unroll
    for (int j = 0; j < 8; ++j) { v[j] = xr[64 * j]; if (SCALE_G) v[j] = v[j] * gr[64 * j];
        m = fmaxf(fmaxf(m, fmaxf(fabsf(v[j].x), fabsf(v[j].y))), fmaxf(fabsf(v[j].z), fabsf(v[j].w))); }
    m = fmaxf(wave_max(m), 1e-30f);
    const float inv = 127.f / m;
    if (lane == 0) *sc = m * (1.f / 127.f);
    unsigned* o4 = (unsigned*)orow + lane;
#pragma unroll
    for (int j = 0; j < 8; ++j) { const int a = (int)rintf(v[j].x * inv) + (OFFS ? 128 : 0), b = (int)rintf(v[j].y * inv) + (OFFS ? 128 : 0), c = (int)rintf(v[j].z * inv) + (OFFS ? 128 : 0), d = (int)rintf(v[j].w * inv) + (OFFS ? 128 : 0);
        o4[64 * j] = (unsigned)(a & 255) | ((unsigned)(b & 255) << 8) | ((unsigned)(c & 255) << 16) | ((unsigned)(d & 255) << 24); }
}
template <int KIND> __device__ __forceinline__ void p0_rows(const float* src, const float* g, void* dst, float* sc, int first, int stride, int nrows, int lane) {
    const f32x4* gr = (const f32x4*)g + lane;
    f32x4 cur[8], nxt[8], nx2[8];
    int r = first;
    if (r >= nrows) return;
    const int lo4 = KIND == 4 ? 2 * lane : lane;
#define P0_ROW_LOAD(dstv, rr) { const f32x4* xr = (const f32x4*)(src + (size_t)(rr) * 2048) + lo4; \
        _Pragma("unroll") for (int j = 0; j < 8; ++j) dstv[j] = __builtin_nontemporal_load(KIND == 4 ? &xr[128 * (j >> 1) + (j & 1)] : &xr[64 * j]); }
    P0_ROW_LOAD(cur, r)
    if (r + stride < nrows) P0_ROW_LOAD(nxt, r + stride)
    for (; r < nrows; r += stride) {
        const int rn = r + 2 * stride;
        if (rn < nrows) P0_ROW_LOAD(nx2, rn)
        if (KIND == 0) {
            float s = 0.f;
#pragma unroll
            for (int j = 0; j < 8; ++j) s += (cur[j].x * cur[j].x + cur[j].y * cur[j].y) + (cur[j].z * cur[j].z + cur[j].w * cur[j].w);
            const float rr = 1.0f / sqrtf(wave_sum(s) * (1.f / 2048.f) + EPS);
            u32x2* o8 = (u32x2*)((bf16_t*)dst + (size_t)r * 2048) + lane;
#pragma unroll
            for (int j = 0; j < 8; ++j) { const f32x4 w = cur[j] * rr * gr[64 * j]; u32x2 o; o.x = cvt_pk_bf16(w.x, w.y); o.y = cvt_pk_bf16(w.z, w.w); o8[64 * j] = o; }
        } else if (KIND >= 3) {
            float ssq = 0.f;
#pragma unroll
            for (int j = 0; j < 8; ++j) { if (KIND == 3) cur[j] = cur[j] * gr[64 * j]; ssq += (cur[j].x * cur[j].x + cur[j].y * cur[j].y) + (cur[j].z * cur[j].z + cur[j].w * cur[j].w); }
            const float rms = sqrtf(fmaxf(wave_sum(ssq) * (1.f / 2048.f), 1e-30f));
            const float sq = (KIND == 4 ? 0.49f : 0.1676f) * rms, inv = (KIND == 4 ? 1.0f : 0.5f) / sq;
            if (lane == 0) sc[r] = sq;
            unsigned* o4 = (unsigned*)((unsigned char*)dst + (size_t)r * 1024) + lane;
            int csum = 0;
            if (KIND == 4) {
#pragma unroll
                for (int j = 0; j < 4; ++j) { unsigned w = 0u;
                    w = __builtin_amdgcn_cvt_scalef32_pk_fp4_f32(w, cur[2 * j][0] * inv, cur[2 * j][1] * inv, 1.0f, 0);
                    w = __builtin_amdgcn_cvt_scalef32_pk_fp4_f32(w, cur[2 * j][2] * inv, cur[2 * j][3] * inv, 1.0f, 1);
                    w = __builtin_amdgcn_cvt_scalef32_pk_fp4_f32(w, cur[2 * j + 1][0] * inv, cur[2 * j + 1][1] * inv, 1.0f, 2);
                    w = __builtin_amdgcn_cvt_scalef32_pk_fp4_f32(w, cur[2 * j + 1][2] * inv, cur[2 * j + 1][3] * inv, 1.0f, 3);
                    __builtin_nontemporal_store(w, (unsigned*)((unsigned char*)dst + (size_t)(2 * j + (lane >> 5)) * VS_SLICE + (size_t)r * 128 + 4 * (lane & 31))); }
            } else {
#pragma unroll
            for (int j = 0; j < 4; ++j) { unsigned w = 0u;
#pragma unroll
                for (int e = 0; e < 4; ++e) { const float lo = cur[j][e], hi = cur[j + 4][e];
                    int nl = (int)rintf(fmaf(lo, inv, 7.5f)), nh = (int)rintf(fmaf(hi, inv, 7.5f));
                    nl = nl < 0 ? 0 : (nl > 15 ? 15 : nl); nh = nh < 0 ? 0 : (nh > 15 ? 15 : nh);
                    csum += nl + nh;
                    w |= ((unsigned)nl << (8 * e)) | ((unsigned)nh << (8 * e + 4)); }
                __builtin_nontemporal_store(w, o4 + 64 * j); }
            if (KIND == 3) {
#pragma unroll
                for (int o = 1; o < 64; o <<= 1) csum += __shfl_xor(csum, o);
                if (lane == 0) ((int*)((unsigned char*)sc + ((ptrdiff_t)WS_SN - (ptrdiff_t)WS_SU)))[r] = 256 * csum; }
            }
        } else {
            float m = 0.f;
#pragma unroll
            for (int j = 0; j < 8; ++j) { if (KIND == 1) cur[j] = cur[j] * gr[64 * j];
                m = fmaxf(fmaxf(m, fmaxf(fabsf(cur[j].x), fabsf(cur[j].y))), fmaxf(fabsf(cur[j].z), fabsf(cur[j].w))); }
            m = fmaxf(wave_max(m), 1e-30f);
            const float inv = 127.f / m; const int off = KIND == 2 ? 128 : 0;
            if (lane == 0) sc[r] = m * (1.f / 127.f);
            unsigned* o4 = (unsigned*)((unsigned char*)dst + (size_t)r * 2048) + lane;
#pragma unroll
            for (int j = 0; j < 8; ++j) { const int a = (int)rintf(cur[j].x * inv) + off, b = (int)rintf(cur[j].y * inv) + off, c = (int)rintf(cur[j].z * inv) + off, d = (int)rintf(cur[j].w * inv) + off;
                o4[64 * j] = (unsigned)(a & 255) | ((unsigned)(b & 255) << 8) | ((unsigned)(c & 255) << 16) | ((unsigned)(d & 255) << 24); }
        }
#pragma unroll
        for (int j = 0; j < 8; ++j) { cur[j] = nxt[j]; nxt[j] = nx2[j]; }
    }
#undef P0_ROW_LOAD
}
__device__ __forceinline__ void p0_wp_item(const float* wq, const float* keys1, const float* keys2, const float* gffn, bf16_t* WPT, int item, int lane) {
    const int hj = item >> 7, ib = item & 127, h = hj >> 1, j = hj & 1, i0 = 16 * ib, col0 = h * 256 + j * 128;
    const int lr = lane & 15, g = lane >> 4;
    const float* keys = (j ? keys2 : keys1) + (size_t)h * 128 * 128;
    const float gi = gffn[i0 + lr];
    bf16x8 af[4];
#pragma unroll
    for (int s = 0; s < 4; ++s) { const float* p = wq + (size_t)(i0 + lr) * 2048 + col0 + 32 * s + 8 * g;
        const f32x4 a = __builtin_nontemporal_load((const f32x4*)p) * gi, b = __builtin_nontemporal_load((const f32x4*)(p + 4)) * gi;
        u32x4 w; w.x = cvt_pk_bf16(a.x, a.y); w.y = cvt_pk_bf16(a.z, a.w); w.z = cvt_pk_bf16(b.x, b.y); w.w = cvt_pk_bf16(b.z, b.w); af[s] = as_bf16x8(w); }
    f32x4 kn[8], kn2[8];
#pragma unroll
    for (int s = 0; s < 4; ++s) { const float* p = keys + (size_t)lr * 128 + 32 * s + 8 * g; kn[2 * s] = *(const f32x4*)p; kn[2 * s + 1] = *(const f32x4*)(p + 4); }
#pragma unroll
    for (int s = 0; s < 4; ++s) { const float* p = keys + (size_t)(16 + lr) * 128 + 32 * s + 8 * g; kn2[2 * s] = *(const f32x4*)p; kn2[2 * s + 1] = *(const f32x4*)(p + 4); }
    for (int kt = 0; kt < 8; ++kt) {
        f32x4 kc[8];
#pragma unroll
        for (int i = 0; i < 8; ++i) { kc[i] = kn[i]; kn[i] = kn2[i]; }
        if (kt < 6) {
#pragma unroll
            for (int s = 0; s < 4; ++s) { const float* p = keys + (size_t)(16 * (kt + 2) + lr) * 128 + 32 * s + 8 * g; kn2[2 * s] = *(const f32x4*)p; kn2[2 * s + 1] = *(const f32x4*)(p + 4); } }
        f32x4 d = {0.f, 0.f, 0.f, 0.f};
#pragma unroll
        for (int s = 0; s < 4; ++s) { const f32x4 a = kc[2 * s], b = kc[2 * s + 1];
            u32x4 w; w.x = cvt_pk_bf16(a.x, a.y); w.y = cvt_pk_bf16(a.z, a.w); w.z = cvt_pk_bf16(b.x, b.y); w.w = cvt_pk_bf16(b.z, b.w);
            d = MFMA16(af[s], as_bf16x8(w), d); }
        u32x2 o; o.x = cvt_pk_bf16(d[0], d[1]); o.y = cvt_pk_bf16(d[2], d[3]);
        *(u32x2*)(WPT + (size_t)(hj * 128 + 16 * kt + lr) * 2048 + i0 + 4 * g) = o;
    }
}
__device__ __forceinline__ int t5_bucket(int n) {
    if (n < 16) return n;
    const int large = 16 + (int)(logf((float)n / 16.f) / 4.852030263919617f * 16.f);
    return large < 31 ? large : 31;
}
__device__ __forceinline__ void p0_ssm_item(const Args& A, unsigned char* sp, int g, int lane) {
    const float* lam_re = A.in[6]; const float* lam_im = A.in[7]; const float* log_dt = A.in[8];
    const float* b_re = A.in[9]; const float* b_im = A.in[10]; const float* c_re = A.in[11]; const float* c_im = A.in[12];
    const int n = lane;
    const float dt = expf(log_dt[g]);
    const float lr = lam_re[g * 64 + n], li = lam_im[g * 64 + n];
    const float mag = expf(lr * dt);
    const float a_re = mag * cosf(li * dt), a_im = mag * sinf(li * dt);
    const float den = lr * lr + li * li;
    const float f_re = ((a_re - 1.f) * lr + a_im * li) / den, f_im = (a_im * lr - (a_re - 1.f) * li) / den;
    ((f32x2*)(sp + SSMP_ABAR))[g * 64 + n] = (f32x2){a_re, a_im};
    float pr = a_re, pi = a_im;
#pragma unroll
    for (int i = 0; i < 8; ++i) { const float nr = pr * pr - pi * pi, ni = 2.f * pr * pi; pr = nr; pi = ni; }
    ((f32x2*)(sp + SSMP_A256))[g * 64 + n] = (f32x2){pr, pi};
    float bbr[16], bbi[16];
#pragma unroll
    for (int q = 0; q < 4; ++q) { const f32x4 br = *(const f32x4*)(b_re + (size_t)(g * 64 + n) * 16 + 4 * q), bi = *(const f32x4*)(b_im + (size_t)(g * 64 + n) * 16 + 4 * q);
#pragma unroll
        for (int e = 0; e < 4; ++e) { bbr[4 * q + e] = f_re * br[e] - f_im * bi[e]; bbi[4 * q + e] = f_re * bi[e] + f_im * br[e]; } }
    {
        float* bbt = (float*)(sp + SSMP_BBT); const int mt = n >> 4, q4 = (n >> 2) & 3, rg = n & 3;
#pragma unroll
        for (int c = 0; c < 16; ++c) { const size_t o = ((((size_t)g * 4 + mt) * 4 + q4) * 16 + c) * 4 + rg; bbt[o] = bbr[c]; bbt[o + 65536] = bbi[c]; } }
    bf16_t* bf = (bf16_t*)(sp + SSMP_BFRAG);
    const int jre = n >> 4, n16 = n & 15;
#pragma unroll
    for (int kg = 0; kg < 4; ++kg) {
        u32x4 wr = {0u, 0u, 0u, 0u}, wi = {0u, 0u, 0u, 0u};
        if (kg < 2) { const int c0 = (kg & 1) * 8;
            wr.x = cvt_pk_bf16(bbr[c0 + 0], bbr[c0 + 1]); wr.y = cvt_pk_bf16(bbr[c0 + 2], bbr[c0 + 3]); wr.z = cvt_pk_bf16(bbr[c0 + 4], bbr[c0 + 5]); wr.w = cvt_pk_bf16(bbr[c0 + 6], bbr[c0 + 7]);
            wi.x = cvt_pk_bf16(bbi[c0 + 0], bbi[c0 + 1]); wi.y = cvt_pk_bf16(bbi[c0 + 2], bbi[c0 + 3]); wi.z = cvt_pk_bf16(bbi[c0 + 4], bbi[c0 + 5]); wi.w = cvt_pk_bf16(bbi[c0 + 6], bbi[c0 + 7]); }
        *(u32x4*)(bf + ((size_t)(g * 8 + jre) * 64 + kg * 16 + n16) * 8) = wr;
        *(u32x4*)(bf + ((size_t)(g * 8 + 4 + jre) * 64 + kg * 16 + n16) * 8) = wi;
    }
    bf16_t* cf = (bf16_t*)(sp + SSMP_CFRAG);
    const int ch = lane & 15, kg = lane >> 4;
#pragma unroll
    for (int s = 0; s < 4; ++s) { const int k0 = 32 * s + 8 * kg;
        const float* src = (k0 < 64) ? (c_re + (size_t)(g * 16 + ch) * 64 + k0) : (c_im + (size_t)(g * 16 + ch) * 64 + (k0 - 64));
        const float sg = (k0 < 64) ? 1.f : -1.f;
        const f32x4 a = *(const f32x4*)src * sg, b = *(const f32x4*)(src + 4) * sg;
        u32x4 w; w.x = cvt_pk_bf16(a.x, a.y); w.y = cvt_pk_bf16(a.z, a.w); w.z = cvt_pk_bf16(b.x, b.y); w.w = cvt_pk_bf16(b.z, b.w);
        *(u32x4*)(cf + ((size_t)(g * 4 + s) * 64 + lane) * 8) = w; }
}
__device__ __forceinline__ void p0_vand_item(const Args& A, unsigned char* sp, int item, int lane) {
    const int g = item >> 3, mt = item & 7, np = 16 * mt + (lane & 15), n = np & 63, kg = lane >> 4;
    const float dt = expf(A.in[8][g]), lr = A.in[6][g * 64 + n], li = A.in[7][g * 64 + n];
    bf16_t* vf = (bf16_t*)(sp + SSMP_VAND) + (size_t)(g * 8 + mt) * 8 * 64 * 8;
    const float m1 = expf(lr * dt), a_re = m1 * cosf(li * dt), a_im = m1 * sinf(li * dt);
    for (int ks = 0; ks < 8; ++ks) { float v[8];
        const float pw = (float)(255 - (32 * ks + 8 * kg + 7)); const float mag = expf(lr * dt * pw), ang = li * dt * pw;
        float cr = mag * cosf(ang), ci = mag * sinf(ang);
#pragma unroll
        for (int j = 7; j >= 0; --j) { v[j] = np < 64 ? cr : ci; const float nr = cr * a_re - ci * a_im, ni = cr * a_im + ci * a_re; cr = nr; ci = ni; }
        u32x4 w; w.x = cvt_pk_bf16(v[0], v[1]); w.y = cvt_pk_bf16(v[2], v[3]); w.z = cvt_pk_bf16(v[4], v[5]); w.w = cvt_pk_bf16(v[6], v[7]);
        *(u32x4*)(vf + ((size_t)ks * 64 + lane) * 8) = w; }
}
__device__ __forceinline__ void p0_btab_item(const Args& A, float* btab, int item, int lane) {
    const float* gq = A.in[3]; const float* gk = A.in[4]; const float* rel_bias = A.in[5];
    const int h = item / 3, br = item % 3, d = br == 0 ? 1 : (br == 1 ? 4 : 16);
    const float G = wave_max(fabsf(gq[lane] * gk[lane]));
    const float mb = wave_max(lane < 32 ? rel_bias[lane * 16 + h] : -1e30f);
    const float smax = 8.4f * G + mb;
    for (int idx = lane; idx < 192; idx += 64) { const int rel = idx - 31;
        float v = -1e30f;
        if (rel >= 0 && rel <= 128) v = LOG2E * (rel_bias[t5_bucket(rel * d) * 16 + h] - smax);
        btab[(h * 3 + br) * 192 + idx] = v; }
}

__device__ __forceinline__ void p0_prologue(const Args& A, LAS unsigned char* lds, int wave, int lane, int pflags) {
    unsigned char* ws = A.ws;
    LAS float* scr = (LAS float*)(lds + wave * 16384);
    const int gw = blockIdx.x * 8 + wave, NGW = gridDim.x * 8;
    constexpr int I_WIN = (2048 / 64) * (4096 / 32), I_GLU = (1024 / 64) * (1024 / 32), I_WOUT = (2048 / 64) * (2048 / 32), I_WP = 2048;
    constexpr int I_SSM = 64, I_BT = 48, I_VAND = 512;
    constexpr int NITEMS = I_WIN + I_GLU + I_WOUT + I_WP + I_SSM + I_BT + I_VAND;
    const bool rows_first = wave & 1;
    if (rows_first && !(pflags & 2048)) p0_rows<0>(A.in[0], A.in[1], ws + WS_HB, nullptr, gw, NGW, 8192, lane);
    if (!(pflags & 4096)) for (int it = gw; it < NITEMS; it += NGW) {
        int r = it;
        if (r < I_SSM) { p0_ssm_item(A, ws + WS_SSMP, r, lane); continue; } r -= I_SSM;
        if (r < I_BT) { p0_btab_item(A, (float*)(ws + WS_BTAB), r, lane); continue; } r -= I_BT;
        if (r < I_VAND) { p0_vand_item(A, ws + WS_SSMP, r, lane); continue; } r -= I_VAND;
        if (r < I_WP) { p0_wp_item(A.in[20], A.in[21], A.in[22], A.in[19], (bf16_t*)(ws + WS_WPT), r, lane); continue; } r -= I_WP;
        if (r < I_WIN) { p0_transpose_item(A.in[2], 2048, 4096, (bf16_t*)(ws + WS_WINT), nullptr, nullptr, scr, r, lane); continue; } r -= I_WIN;
        if (r < I_GLU) { p0_transpose_item(A.in[14], 1024, 1024, (bf16_t*)(ws + WS_GLUT), nullptr, nullptr, scr, r, lane); continue; } r -= I_GLU;
        p0_transpose_item(A.in[18], 2048, 2048, (bf16_t*)(ws + WS_WOUTT), A.in[16], A.in[17], scr, r, lane);
    }
    if (!rows_first && !(pflags & 2048)) p0_rows<0>(A.in[0], A.in[1], ws + WS_HB, nullptr, gw, NGW, 8192, lane);
}
__device__ __forceinline__ void table_chunk(const Args& A, int c, int wave, int lane) {
    unsigned char* ws = A.ws;
    if (c < 512) p0_rows<3>(A.in[23], A.in[19], ws + WS_UB, (float*)(ws + WS_SU), 32 * c + wave, 8, 32 * c + 32, lane);
    else p0_rows<4>(A.in[24], A.in[19], ws + WS_VB, (float*)(ws + WS_SV), 32 * (c - 512) + wave, 8, 32 * (c - 512) + 32, lane);
}

constexpr int SSM_WL = 8192 + 16 * 272 + 512;
__device__ __forceinline__ void ssm_unit(const Args& A, LAS unsigned char* lds, int b, int g, int wave, int lane) {
    unsigned char* ws = A.ws; unsigned char* sp = ws + WS_SSMP;
    const bf16_t* proj = (const bf16_t*)(ws + WS_PROJ); bf16_t* yb = (bf16_t*)(ws + WS_YB);
    LAS unsigned char* wl = lds + wave * SSM_WL;
    LAS f32x2* BU = (LAS f32x2*)wl; LAS unsigned char* XB = wl + 8192; LAS unsigned char* UL = wl + 8192 + 16 * 272;
    LAS f32x2* carry = (LAS f32x2*)(lds + 8 * SSM_WL);
    const int lr = lane & 15, q = lane >> 4;
    bf16x8 bfr[8], cfr[4];
#pragma unroll
    for (int j = 0; j < 8; ++j) bfr[j] = as_bf16x8(*(const u32x4*)((const bf16_t*)(sp + SSMP_BFRAG) + ((size_t)(g * 8 + j) * 64 + lane) * 8));
#pragma unroll
    for (int s = 0; s < 4; ++s) cfr[s] = as_bf16x8(*(const u32x4*)((const bf16_t*)(sp + SSMP_CFRAG) + ((size_t)(g * 4 + s) * 64 + lane) * 8));
    const f32x2 ab = ((const f32x2*)(sp + SSMP_ABAR))[g * 64 + lane], a256 = ((const f32x2*)(sp + SSMP_A256))[g * 64 + lane];
    const float a_re = ab.x, a_im = ab.y;
    const float dsk = A.in[13][g * 16 + lr];
    const bf16_t* up = proj + (size_t)(b * SEQ + wave * 256) * DPROJ + 3072 + g * 16;
    float xr = 0.f, xi = 0.f;
    {
        LAS unsigned char* UT = wl;
#pragma unroll
        for (int i = 0; i < 8; ++i) { const int tk = 32 * i + (lane >> 1), hf = lane & 1;
            const u32x4 raw = *(const u32x4*)(up + (size_t)tk * DPROJ + 8 * hf);
            const unsigned rw[4] = {raw.x, raw.y, raw.z, raw.w};
#pragma unroll
            for (int e = 0; e < 4; ++e) { *(LAS unsigned short*)(UT + (8 * hf + 2 * e) * 528 + tk * 2) = (unsigned short)(rw[e] & 0xffffu); *(LAS unsigned short*)(UT + (8 * hf + 2 * e + 1) * 528 + tk * 2) = (unsigned short)(rw[e] >> 16); } }
        CBAR();
        const bf16_t* vf = (const bf16_t*)(sp + SSMP_VAND) + (size_t)g * 8 * 8 * 64 * 8 + lane * 8;
        f32x4 pd[8];
#pragma unroll
        for (int mt = 0; mt < 8; ++mt) pd[mt] = (f32x4){0.f, 0.f, 0.f, 0.f};
#pragma unroll 2
        for (int ks = 0; ks < 8; ++ks) { const bf16x8 ub = as_bf16x8(*(const LAS u32x4*)(UT + lr * 528 + (32 * ks + 8 * q) * 2));
#pragma unroll
            for (int mt = 0; mt < 8; ++mt) pd[mt] = MFMA16(as_bf16x8(*(const u32x4*)(vf + (size_t)(mt * 8 + ks) * 512)), ub, pd[mt]); }
        const float* bbt = (const float*)(sp + SSMP_BBT) + (((size_t)g * 4) * 4 + q) * 64 + lr * 4;
#pragma unroll
        for (int mt = 0; mt < 4; ++mt) { const f32x4 br = *(const f32x4*)(bbt + (size_t)mt * 256), bi = *(const f32x4*)(bbt + (size_t)mt * 256 + 65536);
#pragma unroll
            for (int r = 0; r < 4; ++r) { const float er = row16_fsum(br[r] * pd[mt][r] - bi[r] * pd[mt + 4][r]), ei = row16_fsum(br[r] * pd[mt + 4][r] + bi[r] * pd[mt][r]);
                if (lr == 0) carry[wave * 64 + 16 * mt + 4 * q + r] = (f32x2){er, ei}; } }
        CBAR();
    }
    __syncthreads();
    { float sr = 0.f, si = 0.f;
        for (int w2 = 0; w2 < wave; ++w2) { const f32x2 e = carry[w2 * 64 + lane]; const float nr = a256.x * sr - a256.y * si + e.x, ni = a256.x * si + a256.y * sr + e.y; sr = nr; si = ni; }
        xr = sr; xi = si; }
    for (int pass = 1; pass < 2; ++pass) {
        u32x4 unext = {0u, 0u, 0u, 0u};
        if (q < 2) unext = *(const u32x4*)(up + (size_t)lr * DPROJ + 8 * q);
        for (int blk = 0; blk < 16; ++blk) {
            const u32x4 uraw = unext;
            if (q < 2 && blk < 15) unext = *(const u32x4*)(up + (size_t)((blk + 1) * 16 + lr) * DPROJ + 8 * q);
            const bf16x8 ua = as_bf16x8(uraw);
            if (pass == 1 && q < 2) *(LAS u32x4*)(UL + lr * 32 + q * 16) = uraw;
            f32x4 dd[8];
#pragma unroll
            for (int j = 0; j < 8; ++j) dd[j] = MFMA16(ua, bfr[j], ((f32x4){0.f, 0.f, 0.f, 0.f}));
#pragma unroll
            for (int jj = 0; jj < 4; ++jj)
#pragma unroll
                for (int r = 0; r < 4; ++r) BU[(4 * q + r) * 64 + 16 * jj + lr] = (f32x2){dd[jj][r], dd[4 + jj][r]};
            CBAR();
            f32x2 bu[16];
#pragma unroll
            for (int t = 0; t < 16; ++t) bu[t] = BU[t * 64 + lane];
            if (pass == 0) {
#pragma unroll
                for (int t = 0; t < 16; ++t) { float nr = fmaf(a_re, xr, fmaf(-a_im, xi, bu[t].x)), ni = fmaf(a_re, xi, fmaf(a_im, xr, bu[t].y)); asm volatile("" : "+v"(nr)); asm volatile("" : "+v"(ni)); xr = nr; xi = ni; }
                asm volatile("" : "+v"(xr), "+v"(xi) :: "memory");
            } else {
#pragma unroll
                for (int t = 0; t < 16; ++t) { float nr = fmaf(a_re, xr, fmaf(-a_im, xi, bu[t].x)), ni = fmaf(a_re, xi, fmaf(a_im, xr, bu[t].y)); asm volatile("" : "+v"(nr)); asm volatile("" : "+v"(ni)); xr = nr; xi = ni;
                    const unsigned pk = cvt_pk_bf16(xr, xi);
                    *(LAS unsigned short*)(XB + t * 272 + lane * 2) = (unsigned short)(pk & 0xffffu);
                    *(LAS unsigned short*)(XB + t * 272 + 128 + lane * 2) = (unsigned short)(pk >> 16); }
                CBAR();
                f32x4 y = {0.f, 0.f, 0.f, 0.f};
#pragma unroll
                for (int s = 0; s < 4; ++s) { const bf16x8 xa = as_bf16x8(*(const LAS u32x4*)(XB + lr * 272 + (32 * s + 8 * q) * 2)); y = MFMA16(xa, cfr[s], y); }
#pragma unroll
                for (int r = 0; r < 4; ++r) { const int t = blk * 16 + 4 * q + r;
                    const float uv = __uint_as_float((unsigned)(*(const LAS unsigned short*)(UL + (4 * q + r) * 32 + lr * 2)) << 16);
                    const float yv = gelu_as(y[r] + dsk * uv);
                    yb[(size_t)(b * SEQ + wave * 256 + t) * 1024 + g * 16 + lr] = (bf16_t)(cvt_pk_bf16(yv, 0.f) & 0xffffu); }
                asm volatile("" : "+v"(xr), "+v"(xi) :: "memory");
            }
        }
    }
    __syncthreads();
}

__device__ __forceinline__ void prep2_item(const Args& A, LAS unsigned char* wl, int item, int lane) {
    unsigned char* ws = A.ws;
    const bf16_t* proj = (const bf16_t*)(ws + WS_PROJ);
    const int pb = item & 31, h = (item >> 5) & 15, b = item >> 9, P0 = pb * 64, bh = b * 16 + h;
    const int r8 = lane >> 3, c = lane & 7;
    const float* gq = A.in[3]; const float* gk = A.in[4];
    if (item == 0) ((float*)(ws + WS_CTL + 32768))[lane] = gq[lane] * (LOG2E * 0.125f);
    const int fs = c >> 2, fg = c & 3;
#pragma unroll 1
    for (int which = 1; which < 2; ++which) {
        const float* gv = which ? gk : gq; const float cs = which ? 1.f : (LOG2E * 0.125f);
        float gl[8];
#pragma unroll
        for (int e = 0; e < 8; ++e) gl[e] = gv[8 * c + e] * cs;
        bf16_t* F = (bf16_t*)(ws + (which ? WS_KF : WS_QF));
        u32x4 raws[8];
#pragma unroll
        for (int i = 0; i < 8; ++i) raws[i] = __builtin_nontemporal_load((const u32x4*)(proj + (size_t)(b * SEQ + P0 + 8 * i + r8) * DPROJ + which * 1024 + h * 64 + 8 * c));
#pragma unroll
        for (int i = 0; i < 8; ++i) { const int row = 8 * i + r8, pos = P0 + row;
            const u32x4 raw = raws[i];
            float v[8] = {bflo(raw.x), bfhi(raw.x), bflo(raw.y), bfhi(raw.y), bflo(raw.z), bfhi(raw.z), bflo(raw.w), bfhi(raw.w)};
            float ss = 0.f;
#pragma unroll
            for (int e = 0; e < 8; ++e) ss += v[e] * v[e];
            ss += __shfl_xor(ss, 1); ss += __shfl_xor(ss, 2); ss += __shfl_xor(ss, 4);
            const float r = 1.0f / sqrtf(ss * (1.f / 64.f) + EPS);
            u32x4 w; w.x = cvt_pk_bf16(v[0] * r * gl[0], v[1] * r * gl[1]); w.y = cvt_pk_bf16(v[2] * r * gl[2], v[3] * r * gl[3]);
            w.z = cvt_pk_bf16(v[4] * r * gl[4], v[5] * r * gl[5]); w.w = cvt_pk_bf16(v[6] * r * gl[6], v[7] * r * gl[7]);
            if (which < 2) { *(u32x4*)(F + ((size_t)bh * SEQ + pos) * 64 + 8 * c) = w; continue; }
            *(u32x4*)(F + ((((size_t)bh) * (SEQ >> 4) + (pos >> 4)) * 2 + fs) * 512 + (fg * 16 + (pos & 15)) * 8) = w;
            *(LAS u32x4*)(wl + (row * 8 + c) * 16) = w; }
        if (which < 2) continue;
        CBAR();
#pragma unroll
        for (int br = 1; br < 3; ++br) { const int sh = 2 * br, lb = 6 - sh;
#pragma unroll
            for (int m = 0; m < 8; ++m) { const int q = lane + 64 * m, lidx = q & ((1 << lb) - 1), rest = q >> lb, qfg = rest & 3, qfs = (rest >> 2) & 1, rr = rest >> 3;
                const u32x4 w = *(const LAS u32x4*)(wl + ((((lidx << sh) + rr) * 8) + qfs * 4 + qfg) * 16);
                const int l = (P0 >> sh) + lidx;
                *(u32x4*)(F + (size_t)br * 4 * 16 * SEQ * 64 + ((((size_t)(bh << sh) + rr) * (SEQ >> (sh + 4)) + (l >> 4)) * 2 + qfs) * 512 + (qfg * 16 + (l & 15)) * 8) = w; } }
        CBAR();
    }
#pragma unroll
    for (int i = 0; i < 8; ++i) { const int row = 8 * i + r8;
        const u32x4 raw = __builtin_nontemporal_load((const u32x4*)(proj + (size_t)(b * SEQ + P0 + row) * DPROJ + 2048 + h * 64 + 8 * c));
        *(LAS u32x2*)(wl + row * 136 + c * 16) = (u32x2){raw.x, raw.y}; *(LAS u32x2*)(wl + row * 136 + c * 16 + 8) = (u32x2){raw.z, raw.w}; }
    CBAR();
    unsigned v[64];
#pragma unroll
    for (int p = 0; p < 64; ++p) v[p] = *(const LAS unsigned short*)(wl + p * 136 + lane * 2);
    CBAR();
    bf16_t* vt = (bf16_t*)(ws + WS_VT);
    const int nt = lane >> 4, dl = lane & 15;
#pragma unroll
    for (int G = 0; G < 2; ++G) { bf16_t* tp = vt + ((((size_t)bh * 64 + (P0 >> 5) + G) * 4 + nt) * 64 + dl) * 8;
#pragma unroll
        for (int kg = 0; kg < 4; ++kg) { const int a0 = 32 * G + 4 * kg, b0 = 32 * G + 16 + 4 * kg;
            u32x4 w; w.x = v[a0] | (v[a0 + 1] << 16); w.y = v[a0 + 2] | (v[a0 + 3] << 16); w.z = v[b0] | (v[b0 + 1] << 16); w.w = v[b0 + 2] | (v[b0 + 3] << 16);
            *(u32x4*)(tp + kg * 128) = w; } }
    { bf16_t* vt4 = vt + (size_t)4 * 16 * 64 * SEQ; const int l0 = P0 >> 2, tile = (l0 >> 4) & 1, grp = l0 >> 5;
#pragma unroll
        for (int r = 0; r < 4; ++r) { bf16_t* tp = vt4 + (((((size_t)bh * 4 + r) * 16 + grp) * 4 + nt) * 64 + dl) * 8;
#pragma unroll
            for (int kg = 0; kg < 4; ++kg) { const int p0 = 4 * (4 * kg) + r;
                u32x2 w; w.x = v[p0] | (v[p0 + 4] << 16); w.y = v[p0 + 8] | (v[p0 + 12] << 16);
                *(u32x2*)(tp + kg * 128 + 4 * tile) = w; } } }
    { bf16_t* vt16 = vt + (size_t)2 * 4 * 16 * 64 * SEQ; const int l0 = P0 >> 4, w32 = l0 & 31, tile = (w32 >> 4) & 1, kg = (w32 & 15) >> 2, grp = l0 >> 5;
#pragma unroll
        for (int r = 0; r < 16; ++r) { u32x2 w; w.x = v[r] | (v[16 + r] << 16); w.y = v[32 + r] | (v[48 + r] << 16);
            *(u32x2*)(vt16 + (((((size_t)bh * 16 + r) * 4 + grp) * 4 + nt) * 64 + kg * 16 + dl) * 8 + 4 * tile) = w; } }
}

struct AttnItem { int sh, r, lfirst, ks, tbo, two; size_t qk_off, v_off; };
__device__ __forceinline__ AttnItem attn_item(int it, int p0, int bh) {
    AttnItem I; const int br = it < 8 ? 0 : (it < 16 ? 1 : 2); I.sh = 2 * br; I.tbo = br * 192; I.two = br < 2;
    if (br == 0) { I.r = 0; I.lfirst = p0 + 32 * it; }
    else if (br == 1) { I.r = (it - 8) & 3; I.lfirst = (p0 >> 2) + 32 * ((it - 8) >> 2); }
    else { I.r = it - 16; I.lfirst = p0 >> 4; }
    const size_t rc = (size_t)br * 4 * 16 * SEQ * 64 + ((size_t)(bh << I.sh) + I.r) * (size_t)(SEQ >> I.sh) * 64;
    I.qk_off = rc; I.v_off = rc;
    int ks = (I.lfirst - 128) & ~31; I.ks = ks < 0 ? 0 : ks;
    return I;
}
__device__ __forceinline__ void attn_unit(const Args& A, LAS unsigned char* lds, int unit, int tid, int wave, int lane_, int pflags) {
    int lane = lane_; asm volatile("" : "+v"(lane));
    unsigned char* ws = A.ws;
    const int blk = 7 - (unit >> 6), bh = unit & 63, b = bh >> 4, h = bh & 15, p0 = blk * 256;
    constexpr int OST = 68;
    LAS float* Oacc = (LAS float*)lds; LAS float* lacc = (LAS float*)(lds + 256 * OST * 4); LAS float* tb = (LAS float*)(lds + 256 * OST * 4 + 1024);
    constexpr int QRS = 128; LAS unsigned char* Qs = lds + 256 * OST * 4 + 1024 + 3 * 192 * 4;
    { const float* bt = (const float*)(ws + WS_BTAB) + h * 3 * 192; for (int i = tid; i < 3 * 192; i += 512) tb[i] = bt[i]; }
    __syncthreads();
    const bf16_t* QF = (const bf16_t*)(ws + WS_PROJ); const bf16_t* KF = (const bf16_t*)(ws + WS_KF); const bf16_t* VF = (const bf16_t*)(ws + WS_VT);
    const int qi = lane & 15, g = lane >> 4;
#define ATT_LOAD(IT, LK, B) do { const AttnItem _I = attn_item(IT, p0, bh); const bf16_t* _kp = KF + ((size_t)bh * SEQ + ((((LK) + qi) << _I.sh) + _I.r)) * 64 + 8 * g; const int _kt = 1024 << _I.sh; \
        B[0] = *(const u32x4*)(_kp); B[1] = *(const u32x4*)(_kp + 32); B[2] = *(const u32x4*)(_kp + _kt); B[3] = *(const u32x4*)(_kp + _kt + 32); \
        const bf16_t* _vp = VF + _I.v_off + (size_t)((LK) >> 5) * 2048 + lane * 8; \
        B[4] = *(const u32x4*)(_vp); B[5] = *(const u32x4*)(_vp + 512); B[6] = *(const u32x4*)(_vp + 1024); B[7] = *(const u32x4*)(_vp + 1536); \
        } while (0)
#define ATT_SMM(BC, QS, TWO) sa1 = MFMA16(as_bf16x8(BC[0]), as_bf16x8(QS[0]), sa1); sb1 = MFMA16(as_bf16x8(BC[2]), as_bf16x8(QS[0]), sb1); \
        sa1 = MFMA16(as_bf16x8(BC[1]), as_bf16x8(QS[1]), sa1); sb1 = MFMA16(as_bf16x8(BC[3]), as_bf16x8(QS[1]), sb1); \
        if (TWO) { sa2 = MFMA16(as_bf16x8(BC[0]), as_bf16x8(QS[2]), sa2); sb2 = MFMA16(as_bf16x8(BC[2]), as_bf16x8(QS[2]), sb2); \
                   sa2 = MFMA16(as_bf16x8(BC[1]), as_bf16x8(QS[3]), sa2); sb2 = MFMA16(as_bf16x8(BC[3]), as_bf16x8(QS[3]), sb2); }
#define ATT_LOADQ(QS, QP, TWO, TS) QS[0] = *(const LAS u32x4*)(QP); QS[1] = *(const LAS u32x4*)((QP) + 64); if (TWO) { QS[2] = *(const LAS u32x4*)((QP) + (TS)); QS[3] = *(const LAS u32x4*)((QP) + (TS) + 64); }
#define ATT_ADV(IT, LK, NIT, NLK) do { const AttnItem _J = attn_item(IT, p0, bh); if ((LK) + 32 <= _J.lfirst) { (NIT) = (IT); (NLK) = (LK) + 32; } else { (NIT) = (IT) + 8; (NLK) = 0; if ((NIT) < 32) { const AttnItem _N = attn_item(NIT, p0, bh); (NLK) = _N.ks; } } } while (0)
#define ATT_STEP(CIT, CLK, BC, NIT, NLK, NNIT, NNLK, BNN) { \
        NNIT = 64; NNLK = 0; \
        if ((NIT) < 32) { ATT_ADV(NIT, NLK, NNIT, NNLK); if ((NNIT) < 32) ATT_LOAD(NNIT, NNLK, BNN); } \
        const AttnItem cI = attn_item(CIT, p0, bh); \
        f32x4 sa1 = {0.f, 0.f, 0.f, 0.f}, sb1 = sa1, sa2 = sa1, sb2 = sa1; \
        u32x4 qv[4];     \
        { const LAS unsigned char* _qp = Qs + (((((cI.lfirst + qi) << cI.sh) + cI.r) - p0)) * QRS + g * 16; const int _ts = (16 * QRS) << cI.sh; ATT_LOADQ(qv, _qp, cI.two, _ts) } \
        ATT_SMM(BC, qv, cI.two) \
        const LAS float* tbb = tb + cI.tbo; \
        const int ba = cI.lfirst + qi - (CLK) - 4 * g + 31; \
        { const f32x4 sa = sa1, sb = sb1; \
          float pa[4], pb[4]; \
          _Pragma("unroll") for (int e = 0; e < 4; ++e) { pa[e] = __builtin_amdgcn_exp2f(sa[e] + tbb[ba - e]); pb[e] = __builtin_amdgcn_exp2f(sb[e] + tbb[ba - 16 - e]); } \
          lsum += (pa[0] + pa[1]) + (pa[2] + pa[3]) + (pb[0] + pb[1]) + (pb[2] + pb[3]); \
          u32x4 pw; pw.x = cvt_pk_bf16(pa[0], pa[1]); pw.y = cvt_pk_bf16(pa[2], pa[3]); pw.z = cvt_pk_bf16(pb[0], pb[1]); pw.w = cvt_pk_bf16(pb[2], pb[3]); \
          const bf16x8 pf = as_bf16x8(pw); \
          _Pragma("unroll") for (int nt = 0; nt < 4; ++nt) o[nt] = MFMA16(pf, as_bf16x8(BC[4 + nt]), o[nt]); } \
        if (cI.two) { const f32x4 sa = sa2, sb = sb2;     \
          float pa[4], pb[4]; \
          _Pragma("unroll") for (int e = 0; e < 4; ++e) { pa[e] = __builtin_amdgcn_exp2f(sa[e] + tbb[ba + 16 - e]); pb[e] = __builtin_amdgcn_exp2f(sb[e] + tbb[ba - e]); } \
          lsum2 += (pa[0] + pa[1]) + (pa[2] + pa[3]) + (pb[0] + pb[1]) + (pb[2] + pb[3]); \
          u32x4 pw; pw.x = cvt_pk_bf16(pa[0], pa[1]); pw.y = cvt_pk_bf16(pa[2], pa[3]); pw.z = cvt_pk_bf16(pb[0], pb[1]); pw.w = cvt_pk_bf16(pb[2], pb[3]); \
          const bf16x8 pf = as_bf16x8(pw); \
          _Pragma("unroll") for (int nt = 0; nt < 4; ++nt) o2[nt] = MFMA16(pf, as_bf16x8(BC[4 + nt]), o2[nt]); } \
        if ((CLK) + 32 > cI.lfirst) {     \
            const bool first = (CIT) < 8; \
            lsum += __shfl_xor(lsum, 16); lsum += __shfl_xor(lsum, 32); \
            if (g == 0) { LAS float* lp = lacc + ((((cI.lfirst + qi) << cI.sh) + cI.r) - p0); *lp = first ? lsum : *lp + lsum; } \
            _Pragma("unroll") for (int reg = 0; reg < 4; ++reg) { LAS float* op = Oacc + (((((cI.lfirst + 4 * g + reg) << cI.sh) + cI.r) - p0)) * OST + qi; \
                _Pragma("unroll") for (int nt = 0; nt < 4; ++nt) op[16 * nt] = first ? o[nt][reg] : op[16 * nt] + o[nt][reg]; } \
            _Pragma("unroll") for (int nt = 0; nt < 4; ++nt) o[nt] = (f32x4){0.f, 0.f, 0.f, 0.f}; \
            lsum = 0.f; \
            if (cI.two) { \
                lsum2 += __shfl_xor(lsum2, 16); lsum2 += __shfl_xor(lsum2, 32); \
                if (g == 0) { LAS float* lp = lacc + ((((cI.lfirst + 16 + qi) << cI.sh) + cI.r) - p0); *lp = first ? lsum2 : *lp + lsum2; } \
                _Pragma("unroll") for (int reg = 0; reg < 4; ++reg) { LAS float* op = Oacc + (((((cI.lfirst + 16 + 4 * g + reg) << cI.sh) + cI.r) - p0)) * OST + qi; \
                    _Pragma("unroll") for (int nt = 0; nt < 4; ++nt) op[16 * nt] = first ? o2[nt][reg] : op[16 * nt] + o2[nt][reg]; } \
                _Pragma("unroll") for (int nt = 0; nt < 4; ++nt) o2[nt] = (f32x4){0.f, 0.f, 0.f, 0.f}; \
                lsum2 = 0.f; } \
            if ((CIT) < 16 || (CIT) >= 24) __syncthreads();     \
        } \
        if ((NIT) >= 32) break; }
    if (!(pflags & 16)) {
    int itA = wave, lkA, itB, lkB, itC = 64, lkC = 0;
    { const AttnItem I0 = attn_item(wave, p0, bh); lkA = I0.ks; }
    ATT_ADV(itA, lkA, itB, lkB);
    u32x4 bA[8], bB[8], bC[8];
    ATT_LOAD(itA, lkA, bA); if (itB < 32) ATT_LOAD(itB, lkB, bB);
    u32x4 qraw[4];
    const int lq = lane;
#pragma unroll
    for (int i = 0; i < 4; ++i) qraw[i] = __builtin_nontemporal_load((const u32x4*)((const bf16_t*)(ws + WS_PROJ) + (size_t)(b * SEQ + p0 + wave * 32 + 8 * i + (lq >> 3)) * DPROJ + h * 64 + 8 * (lq & 7)));
    {
        const int c = lq & 7; const float* gq = (const float*)(ws + WS_CTL + 32768); float gl[8];
#pragma unroll
        for (int e = 0; e < 8; ++e) gl[e] = gq[8 * c + e];
#pragma unroll
        for (int i = 0; i < 4; ++i) { const u32x4 raw = qraw[i];
            float v[8] = {bflo(raw.x), bfhi(raw.x), bflo(raw.y), bfhi(raw.y), bflo(raw.z), bfhi(raw.z), bflo(raw.w), bfhi(raw.w)};
            float ss = 0.f;
#pragma unroll
            for (int e = 0; e < 8; ++e) ss += v[e] * v[e];
            ss += __shfl_xor(ss, 1); ss += __shfl_xor(ss, 2); ss += __shfl_xor(ss, 4);
            const float r = 1.0f / sqrtf(ss * (1.f / 64.f) + EPS);
            u32x4 w; w.x = cvt_pk_bf16(v[0] * r * gl[0], v[1] * r * gl[1]); w.y = cvt_pk_bf16(v[2] * r * gl[2], v[3] * r * gl[3]);
            w.z = cvt_pk_bf16(v[4] * r * gl[4], v[5] * r * gl[5]); w.w = cvt_pk_bf16(v[6] * r * gl[6], v[7] * r * gl[7]);
            *(LAS u32x4*)(Qs + (wave * 32 + 8 * i + (lq >> 3)) * QRS + c * 16) = w; } }
    __syncthreads();
    f32x4 o[4], o2[4];
#pragma unroll
    for (int nt = 0; nt < 4; ++nt) { o[nt] = (f32x4){0.f, 0.f, 0.f, 0.f}; o2[nt] = (f32x4){0.f, 0.f, 0.f, 0.f}; }
    float lsum = 0.f, lsum2 = 0.f;
    for (;;) {
        ATT_STEP(itA, lkA, bA, itB, lkB, itC, lkC, bC)
        ATT_STEP(itB, lkB, bB, itC, lkC, itA, lkA, bA)
        ATT_STEP(itC, lkC, bC, itA, lkA, itB, lkB, bB)
    }
    }
#undef ATT_LOAD
#undef ATT_LOADQ
#undef ATT_SMM
#undef ATT_ADV
#undef ATT_STEP
    if (!(pflags & (16 | 32 | 64))) { const int ql = tid >> 1, half = tid & 1; const float inv = 1.0f / lacc[ql];
        bf16_t* dst = (bf16_t*)(ws + WS_MIXED) + (size_t)(b * SEQ + p0 + ql) * 2048 + h * 64 + 32 * half;
        float ss = 0.f;
#pragma unroll
        for (int c4 = 0; c4 < 4; ++c4) { float v[8];
#pragma unroll
            for (int e = 0; e < 8; ++e) { v[e] = Oacc[ql * OST + 32 * half + 8 * c4 + e] * inv; ss += v[e] * v[e]; }
            u32x4 w; w.x = cvt_pk_bf16(v[0], v[1]); w.y = cvt_pk_bf16(v[2], v[3]); w.z = cvt_pk_bf16(v[4], v[5]); w.w = cvt_pk_bf16(v[6], v[7]);
            *(u32x4*)(dst + 8 * c4) = w; }
        ss += __shfl_xor(ss, 1);
        if (half == 0) pg8::rss_add((pg8::rss_t*)(ws + WS_CTL + CTL_RSS_ATTN) + b * SEQ + p0 + ql, ss); }
    __syncthreads();
}

__device__ __forceinline__ unsigned fkey(float f) { const int u = (int)__float_as_uint(f); return (unsigned)(u ^ ((u >> 31) | (int)0x80000000u)); }
template <int R> __device__ __forceinline__ void select16(const unsigned (&key)[R], unsigned long long (&m)[R]) {
    unsigned mx = key[0];
#pragma unroll
    for (int r = 1; r < R; ++r) mx = key[r] > mx ? key[r] : mx;
    mx = wave_umax(mx);
    unsigned lo = mx > (3u << 23) ? mx - (3u << 23) : 0u, hi = mx + 1u;
    int cnt = 0;
#pragma unroll
    for (int r = 0; r < R; ++r) cnt += __popcll(__ballot(key[r] >= lo));
    if (cnt < 16) { lo = 0u; cnt = R * 64; }
    bool exact = cnt == 16;
    unsigned width = hi - lo;
    if (!exact && width > 1u) for (;;) { const unsigned w = width >> 1, mid = lo + w; int c = 0;
#pragma unroll
        for (int r = 0; r < R; ++r) c += __popcll(__ballot(key[r] >= mid));
        if (c == 16) { lo = mid; exact = true; break; }
        const bool ge = c > 16;
        lo = ge ? mid : lo; width = ge ? width - w : w;
        if (width <= 1u) break; }
    const unsigned T = lo;
    if (exact) {
#pragma unroll
        for (int r = 0; r < R; ++r) m[r] = __ballot(key[r] >= T);
    } else {
        int need = 16;
#pragma unroll
        for (int r = 0; r < R; ++r) { m[r] = __ballot(key[r] > T); need -= __popcll(m[r]); }
#pragma unroll
        for (int r = 0; r < R; ++r) { unsigned long long eq = __ballot(key[r] == T);
            while (__popcll(eq) > need) eq &= ~(1ull << (63 - __builtin_clzll(eq)));
            need -= __popcll(eq); m[r] |= eq; }
    }
}
__device__ __forceinline__ int below(unsigned long long m) { return (int)__builtin_amdgcn_mbcnt_hi((unsigned)(m >> 32), __builtin_amdgcn_mbcnt_lo((unsigned)m, 0u)); }
__device__ __forceinline__ void peer_topk(const float (&sv4)[4], LAS float* sc, LAS int* exo, LAS float* gto, int lane) {
    LAS float* v1 = sc; LAS int* i1 = (LAS int*)(sc + 16); LAS float* v2 = sc + 32; LAS int* i2 = (LAS int*)(sc + 48); LAS float* sv = sc + 64; LAS int* si = (LAS int*)(sc + 80);
    const unsigned long long lt = (1ull << lane) - 1ull;
#pragma unroll
    for (int half = 0; half < 2; ++half) {
        const float a0 = sv4[2 * half], a1 = sv4[2 * half + 1];
        const unsigned key[2] = {fkey(a0), fkey(a1)}; unsigned long long m[2];
        select16<2>(key, m);
        LAS float* vv = half ? v2 : v1; LAS int* ii = half ? i2 : i1;
        if ((m[0] >> lane) & 1ull) { const int pos = below(m[0]); vv[pos] = a0; ii[pos] = lane; }
        if ((m[1] >> lane) & 1ull) { const int pos = __popcll(m[0]) + below(m[1]); vv[pos] = a1; ii[pos] = 64 + lane; }
    }
    CBAR(); LDS_WAIT();
    const int a = lane >> 2, bb = (lane & 3) * 4;
    const float va = v1[a]; float cv[4]; unsigned key[4]; unsigned long long m[4];
#pragma unroll
    for (int e = 0; e < 4; ++e) { cv[e] = va + v2[bb + e]; key[e] = fkey(cv[e]); }
    select16<4>(key, m);
    int base = 0;
#pragma unroll
    for (int e = 0; e < 4; ++e) { if ((m[e] >> lane) & 1ull) { const int pos = base + below(m[e]); sv[pos] = cv[e]; si[pos] = a * 16 + bb + e; } base += __popcll(m[e]); }
    CBAR(); LDS_WAIT();
    if (lane < 16) {
        const float val = sv[lane]; const int fi = si[lane];
        const float mx = row16_fmax(val);
        const float ex = __expf(val - mx); const float sum = row16_fsum(ex);
        exo[lane] = i1[fi >> 4] * 128 + (i2[fi & 15] - 0);
        gto[lane] = ex * __builtin_amdgcn_rcpf(sum);
    }
    CBAR(); LDS_WAIT();
}

#ifndef FP8_CODE_SCALE
#define FP8_CODE_SCALE 512.f
#endif
template <int I> __device__ __forceinline__ float ubyte_f32(unsigned w) { float f;
    if (I == 0) asm("v_cvt_f32_ubyte0 %0, %1" : "=v"(f) : "v"(w)); else if (I == 1) asm("v_cvt_f32_ubyte1 %0, %1" : "=v"(f) : "v"(w));
    else if (I == 2) asm("v_cvt_f32_ubyte2 %0, %1" : "=v"(f) : "v"(w)); else asm("v_cvt_f32_ubyte3 %0, %1" : "=v"(f) : "v"(w));
    return f; }
__device__ __forceinline__ void peer_stage_a(const Args& A, LAS unsigned char* lds, int wave, int lane, int pflags) {
    unsigned char* ws = A.ws;
    const float* scores = (const float*)(ws + WS_PROJ);
    const unsigned char* ut = ws + WS_UB; const bf16_t* x1b = (const bf16_t*)(ws + WS_HB);
    const float* su = (const float*)(ws + WS_SU); const float* sv = (const float*)(ws + WS_SV);
    const pg8::rss_t* rssx = (const pg8::rss_t*)(ws + WS_CTL + CTL_RSS_X1);
    int* Eg = (int*)(ws + WS_EW); float* Wg = (float*)(ws + WS_EW + 4 * MB);
    LAS int* exl = (LAS int*)(lds + wave * 4096);
    LAS float* gtl = (LAS float*)(lds + wave * 4096 + 2048);
    LAS float* sc = (LAS float*)(lds + 32768 + wave * 512);
    LAS float* cul = (LAS float*)(lds + 40960 + wave * 1024);
    LAS int* culi = (LAS int*)(lds + 36864 + wave * 512);
    const int* snt = (const int*)(ws + WS_SN);
    const int t0 = (blockIdx.x * 8 + wave) * 4;
    if (t0 >= NTOK) return;
#define LOAD_SCORES_L(dst, t, h, ln) do { const float* _sp = scores + (size_t)(t) * 2048 + (h) * 256 + (ln); dst[0] = __builtin_nontemporal_load(_sp); dst[1] = __builtin_nontemporal_load(_sp + 64); dst[2] = __builtin_nontemporal_load(_sp + 128); dst[3] = __builtin_nontemporal_load(_sp + 192); } while (0)
#define LOAD_SCORES(dst, t, h) LOAD_SCORES_L(dst, t, h, lane)
    { float nx[4]; LOAD_SCORES(nx, t0, 0); peer_topk(nx, sc, exl, gtl, lane); }
    CBAR(); LDS_WAIT();
    if (pflags & 256) return;
    const int li = lane & 15;
    int ecur = exl[li];
    float csu = su[ecur], csv = sv[ecur]; int csn = snt[ecur];
    float rss = pg8::rss_get(rssx + t0);
    float sn[4] = {0.f, 0.f, 0.f, 0.f};
    LOAD_SCORES(sn, t0, 1);
    u32x4 bu[16];
#pragma unroll
    for (int i = 0; i < 16; ++i) { const int _e = __builtin_amdgcn_readlane(ecur, i); bu[i] = *(const u32x4*)(ut + ((unsigned)_e * 1024u + 16u * (unsigned)lane)); }
    u32x4 xr4[4];
#pragma unroll
    for (int v4 = 0; v4 < 4; ++v4) xr4[v4] = *(const u32x4*)(x1b + (size_t)t0 * 2048 + 16 * lane + 1024 * (v4 >> 1) + 8 * (v4 & 1));
#pragma unroll 1
    for (int tok = 0; tok < 4; ++tok) {
        const int t = t0 + tok;
        int lz = lane; asm volatile("" : "+v"(lz));
        unsigned xq[8], xh[4], xl[4]; float sx; int xsum;
        {
            float m = 0.f;
#pragma unroll
            for (int v4 = 0; v4 < 4; ++v4) { const unsigned rw[4] = {xr4[v4].x, xr4[v4].y, xr4[v4].z, xr4[v4].w};
#pragma unroll
                for (int e = 0; e < 4; ++e) m = fmaxf(m, fmaxf(fabsf(bflo(rw[e])), fabsf(bfhi(rw[e])))); }
            m = fmaxf(wave_max(m), 1e-30f);
            const float inv = 127.f / m; sx = m * (1.f / 127.f);
            int ls = 0;
#pragma unroll
            for (int v4 = 0; v4 < 4; ++v4) { const unsigned rw[4] = {xr4[v4].x, xr4[v4].y, xr4[v4].z, xr4[v4].w};
#pragma unroll
                for (int h2 = 0; h2 < 2; ++h2) { const int a = (int)rintf(bflo(rw[2 * h2]) * inv), b = (int)rintf(bfhi(rw[2 * h2]) * inv), c = (int)rintf(bflo(rw[2 * h2 + 1]) * inv), e = (int)rintf(bfhi(rw[2 * h2 + 1]) * inv);
                    ls += (a + b) + (c + e);
                    xq[2 * v4 + h2] = (unsigned)(a & 255) | ((unsigned)(b & 255) << 8) | ((unsigned)(c & 255) << 16) | ((unsigned)(e & 255) << 24); } }
#pragma unroll
            for (int o = 1; o < 64; o <<= 1) ls += __shfl_xor(ls, o);
            xsum = ls;
#pragma unroll
            for (int e = 0; e < 4; ++e) { const unsigned pa = xq[e] ^ 0x80808080u, pb = xq[4 + e] ^ 0x80808080u;
                xh[e] = ((pa >> 4) & 0x0F0F0F0Fu) | (pb & 0xF0F0F0F0u); xl[e] = (pa & 0x0F0F0F0Fu) | ((pb << 4) & 0xF0F0F0F0u); } }
        const float ascale = sx / sqrtf(rss * (1.f / 2048.f) + EPS);
        float nrss = 1.f;
#pragma unroll 1
        for (int k0 = 0; k0 < 128; k0 += 16) {
            const int lq = lz & 15;
            cul[k0 + lq] = ascale * csu; culi[k0 + lq] = csn; cul[128 + k0 + lq] = gtl[k0 + lq] * csv;
            if (lz < 16) Eg[(size_t)t * 128 + k0 + lz] = ecur;
            const bool last = k0 == 112;
            const int hn = ((k0 >> 4) + 1) & 7, tn = last ? t + 1 : t;
            const bool valid = tn < t0 + 4;
            int enext = ecur; float nsu = 0.f, nsv = 0.f; int nsn = 0;
            if (valid) {
                const float cs[4] = {sn[0], sn[1], sn[2], sn[3]};
                { const int h2 = (hn + 1) & 7, t2 = hn == 7 ? tn + 1 : tn; if (t2 < t0 + 4) LOAD_SCORES_L(sn, t2, h2, lz); }
                peer_topk(cs, sc, exl + hn * 16, gtl + hn * 16, lane);
                enext = exl[hn * 16 + lq];
                nsu = su[enext]; nsv = sv[enext]; nsn = snt[enext];
                if (last) {
                    nrss = pg8::rss_get(rssx + t + 1);
#pragma unroll
                    for (int v4 = 0; v4 < 4; ++v4) xr4[v4] = *(const u32x4*)(x1b + (size_t)(t + 1) * 2048 + 16 * lz + 1024 * (v4 >> 1) + 8 * (v4 & 1)); } }
            int p[16];
#pragma unroll
            for (int i = 0; i < 16; ++i) { unsigned ah = 0u, al = 0u;
                const unsigned w4[4] = {bu[i].x, bu[i].y, bu[i].z, bu[i].w};
#pragma unroll
                for (int e = 0; e < 4; ++e) { ah = __builtin_amdgcn_udot8(w4[e], xh[e], ah, false); al = __builtin_amdgcn_udot8(w4[e], xl[e], al, false); }
                p[i] = (int)(16u * ah + al); }
#pragma unroll
            for (int i = 0; i < 16; ++i) { const int _e = __builtin_amdgcn_readlane(enext, i); bu[i] = *(const u32x4*)(ut + ((unsigned)_e * 1024u + 16u * (unsigned)lane)); }
            { const bool b0 = lane & 1, b1 = lane & 2, b2 = lane & 4, b3 = lane & 8;
            int q8[8], q4[4], q2[2], q1;
#pragma unroll
            for (int i = 0; i < 8; ++i) { const int keep = b0 ? p[i + 8] : p[i], send = b0 ? p[i] : p[i + 8]; q8[i] = keep + __builtin_amdgcn_mov_dpp(send, 0xB1, 0xF, 0xF, true); }
#pragma unroll
            for (int i = 0; i < 4; ++i) { const int keep = b1 ? q8[i + 4] : q8[i], send = b1 ? q8[i] : q8[i + 4]; q4[i] = keep + __builtin_amdgcn_mov_dpp(send, 0x4E, 0xF, 0xF, true); }
#pragma unroll
            for (int i = 0; i < 2; ++i) { const int keep = b2 ? q4[i + 2] : q4[i], send = b2 ? q4[i] : q4[i + 2]; q2[i] = keep + __shfl_xor(send, 4); }
            { const int keep = b3 ? q2[1] : q2[0], send = b3 ? q2[0] : q2[1]; q1 = keep + __builtin_amdgcn_mov_dpp(send, 0x128, 0xF, 0xF, true); }
            q1 += __shfl_xor(q1, 16); q1 += __shfl_xor(q1, 32);
            const int k = k0 + 8 * (lane & 1) + 4 * ((lane >> 1) & 1) + 2 * ((lane >> 2) & 1) + ((lane >> 3) & 1);
            const float a = (float)(2 * q1 - culi[k] - 15 * xsum) * cul[k];
            const float wcur = cul[128 + k] * gelu_as(a);
            if (lane < 16) Wg[(size_t)t * 128 + k] = wcur; }
            CBAR();
            ecur = enext; csu = nsu; csv = nsv; csn = nsn;
        }
        rss = nrss;
    }
#undef LOAD_SCORES
#undef LOAD_SCORES_L
}

typedef int i32x4v __attribute__((ext_vector_type(4)));
__device__ __forceinline__ void peer_stage_b(const Args& A, LAS unsigned char* lds, int x, int idx, int wave, int lane_, int pflags) {
    unsigned char* ws = A.ws;
    int lane = lane_; asm volatile("" : "+v"(lane));
    const int s = lane >> 3, c = lane & 7;
    const unsigned char* vs = ws + WS_VB + (size_t)x * VS_SLICE; const unsigned c16 = 16u * (unsigned)c;
    const int* Eg = (const int*)(ws + WS_EW); const float* Wg = (const float*)(ws + WS_EW + 4 * MB);
    const bf16_t* x1b = (const bf16_t*)(ws + WS_HB);
    LAS int* el = (LAS int*)(lds + wave * 10240);
    LAS float* wl = (LAS float*)(lds + wave * 10240 + 1024);
    LAS f32x4* red = (LAS f32x4*)(lds + wave * 10240 + 2048);
    const int tb = idx * 256 + wave * 32;
    const int lp = (lane & 7) * 16 + (lane >> 3);
    int e0 = Eg[(size_t)tb * 128 + lane], e1 = Eg[(size_t)tb * 128 + 64 + lane]; float w0 = Wg[(size_t)tb * 128 + lane], w1 = Wg[(size_t)tb * 128 + 64 + lane];
    el[lp] = e0; el[lp + 8] = e1; wl[lp] = w0; wl[lp + 8] = w1;
    e0 = Eg[(size_t)(tb + 1) * 128 + lane]; e1 = Eg[(size_t)(tb + 1) * 128 + 64 + lane]; w0 = Wg[(size_t)(tb + 1) * 128 + lane]; w1 = Wg[(size_t)(tb + 1) * 128 + 64 + lane];
    u32x4 ring[16];
#ifdef MK_PROBE
    const int emask = (pflags & 1024) ? 255 : 16383;
#define EMASK(e) ((e) & emask)
#else
#define EMASK(e) (e)
#endif
#pragma unroll
    for (int i = 0; i < 16; ++i) ring[i] = *(const u32x4*)(vs + ((unsigned)EMASK(el[16 * s + i]) * 128u + c16));
#pragma unroll 1
    for (int tok = 0; tok < 32; ++tok) {
        const int t = tb + tok, cur = (tok & 1) * 128, nx = 128 - cur;
        int lz = lane; asm volatile("" : "+v"(lz));
        { const int lpz = (lz & 7) * 16 + (lz >> 3); el[nx + lpz] = e0; el[nx + lpz + 8] = e1; wl[nx + lpz] = w0; wl[nx + lpz + 8] = w1; }
        f32x4 wv[4]; i32x4v ev[4];
#pragma unroll
        for (int q = 0; q < 4; ++q) { wv[q] = ((const LAS f32x4*)(wl + cur))[4 * (lz >> 3) + q]; ev[q] = ((const LAS i32x4v*)(el + nx))[4 * (lz >> 3) + q]; }
        { const size_t o = (size_t)(tok < 30 ? t + 2 : t) * 128 + lz; e0 = Eg[o]; e1 = Eg[o + 64]; w0 = Wg[o]; w1 = Wg[o + 64]; }
        const u32x2 xr = __builtin_nontemporal_load((const u32x2*)(x1b + (size_t)t * 2048 + 256 * x + 4 * (8 * (lz & 7) + (lz >> 3))));
        float acc[32];
#pragma unroll
        for (int i = 0; i < 32; ++i) acc[i] = 0.f;
#pragma unroll
        for (int i = 0; i < 16; ++i) {
            const float w = wv[i >> 2][i & 3]; const int en = EMASK(ev[i >> 2][i & 3]);
            asm volatile("" : "+v"(ring[i]) : "v"(acc[31]));
            const unsigned w4[4] = {ring[i].x, ring[i].y, ring[i].z, ring[i].w};
#pragma unroll
            for (int e = 0; e < 4; ++e) {
#define P6_VACC(bb) { const f32x2 pq = __builtin_amdgcn_cvt_scalef32_pk_f32_fp4(w4[e], 1.0f, bb); acc[8 * e + 2 * bb] += w * pq.x; acc[8 * e + 2 * bb + 1] += w * pq.y; }
                P6_VACC(0) P6_VACC(1) P6_VACC(2) P6_VACC(3)
#undef P6_VACC
            }
            ring[i] = *(const u32x4*)(vs + ((unsigned)en * 128u + c16));
            asm volatile("" ::: "memory"); }
#pragma unroll
        for (int q = 0; q < 8; ++q) red[q * 64 + lane] = (f32x4){acc[4 * q], acc[4 * q + 1], acc[4 * q + 2], acc[4 * q + 3]};
        f32x4 r = red[s * 64 + c];
#pragma unroll
        for (int s2 = 1; s2 < 8; ++s2) r += red[s * 64 + c + 8 * s2];
        r[0] += bflo(xr.x); r[1] += bfhi(xr.x); r[2] += bflo(xr.y); r[3] += bfhi(xr.y);
        __builtin_nontemporal_store(r, (f32x4*)(A.out + (size_t)t * 2048 + 256 * x + 32 * c + 4 * s));
    }
#undef EMASK
}

__global__ void __launch_bounds__(512, 2) mk_fwd(Args args) {
    extern __shared__ __attribute__((aligned(16))) unsigned char lds_raw[];
    LAS unsigned char* lds = (LAS unsigned char*)lds_raw;
    const int tid = threadIdx.x, lane = tid & 63, wave = __builtin_amdgcn_readfirstlane(tid >> 6);
    volatile LAS unsigned* MISC = (volatile LAS unsigned*)(lds + MISC_OFF);
    if (tid < 64) MISC[tid] = 0u;
    __syncthreads();
    unsigned char* ws = args.ws;
    const int lo = args.ph_lo, hi = args.ph_hi & 0xff;
#ifdef MK_PROBE
    const int pflags = args.ph_hi >> 8;
#else
    constexpr int pflags = 0;
#endif
    XcdBarrier bar; bar.bar = (unsigned*)(ws + WS_CTL); bar.x = 0; bar.st = nullptr;
    if (hi - lo > 1) bar = xcd_barrier_post((unsigned*)(ws + WS_CTL), MISC + 8);
#ifndef PH_MASK
#define PH_MASK 0xff
#endif
#define IN(k) (((PH_MASK >> (k)) & 1) && lo <= (k) && (k) < hi)
#define SEAM(k) do { if (IN(k) && IN((k) + 1)) xcd_barrier(bar); } while (0)

    if (IN(0)) { p0_prologue(args, lds, wave, lane, pflags); }
    SEAM(0);
    if (IN(1)) {
        pg8::Gemm g{(const bf16_t*)(ws + WS_HB), (const bf16_t*)(ws + WS_WINT), NTOK, DPROJ, DM}; pg8::StaticOrder S; S.init(NTOK, DPROJ, gridDim.x, (int)blockIdx.x);
        pg8::EpiProj E{(bf16_t*)(ws + WS_PROJ), DPROJ};
        pg8::gemm_phase<pg8::EpiProj, pg8::StaticOrder, false>(lds, g, S, E, nullptr);
    }
    SEAM(1);
    if (IN(2)) {
        const bool prep_first = blockIdx.x & 1;
        if (prep_first && !(pflags & 8)) { for (int it = blockIdx.x * 8 + wave; it < 2048; it += gridDim.x * 8) prep2_item(args, lds + wave * SSM_WL, it, lane); __syncthreads(); }
        if (!(pflags & 4)) for (int u = blockIdx.x; u < 256; u += gridDim.x) ssm_unit(args, lds, u >> 6, 8 * (u & 7) + ((u >> 3) & 7), wave, lane);
        if (!prep_first && !(pflags & 8)) for (int it = blockIdx.x * 8 + wave; it < 2048; it += gridDim.x * 8) prep2_item(args, lds + wave * SSM_WL, it, lane);
    }
    SEAM(2);
    if (IN(3)) {
        if (!(pflags & 2)) {
            pg8::Gemm g{(const bf16_t*)(ws + WS_YB), (const bf16_t*)(ws + WS_GLUT), NTOK, 1024, 1024}; pg8::StaticOrder S; S.init(NTOK, 1024, gridDim.x, (int)blockIdx.x);
            pg8::EpiGlu E{(const bf16_t*)(ws + WS_YB), (bf16_t*)(ws + WS_MIXED) + 1024, args.in[15], (pg8::rss_t*)(ws + WS_CTL + CTL_RSS_SSM)};
            pg8::gemm_phase<pg8::EpiGlu, pg8::StaticOrder, false>(lds, g, S, E, nullptr);
        }
        __syncthreads();
        if (!(pflags & 1)) for (;;) {
            if (tid == 0) MISC[0] = atomicAdd((unsigned*)(ws + WS_CTL + CTL_QCTR), 1u);
            __syncthreads();
            const unsigned u = MISC[0];
            __syncthreads();
            if (u >= 512u) break;
            attn_unit(args, lds, (int)u, tid, wave, lane, pflags);
            if (!(pflags & 128)) { table_chunk(args, (int)(2u * u), wave, lane); table_chunk(args, (int)(2u * u + 1u), wave, lane); }
        }
    }
    SEAM(3);
    if (IN(4)) {
        pg8::Gemm g{(const bf16_t*)(ws + WS_MIXED), (const bf16_t*)(ws + WS_WOUTT), NTOK, DM, DM}; pg8::StaticOrder S; S.init(NTOK, DM, gridDim.x, (int)blockIdx.x);
        LAS float* tab = (LAS float*)(lds + 131072);
        { pg8::Unit u0; if (S.next(0, u0) && tid < 256) { const int row = u0.pm * 256 + tid;
            const float ra = 1.0f / sqrtf(pg8::rss_get((const pg8::rss_t*)(ws + WS_CTL + CTL_RSS_ATTN) + row) * (1.f / 1024.f) + EPS), rs = 1.0f / sqrtf(pg8::rss_get((const pg8::rss_t*)(ws + WS_CTL + CTL_RSS_SSM) + row) * (1.f / 1024.f) + EPS);
            tab[tid] = ra / rs; tab[256 + tid] = rs; } }
        __syncthreads();
        pg8::EpiWout E{args.in[0], args.out, (bf16_t*)(ws + WS_HB), (pg8::rss_t*)(ws + WS_CTL + CTL_RSS_X1), tab};
        pg8::gemm_phase<pg8::EpiWout, pg8::StaticOrder, false>(lds, g, S, E, nullptr);
    }
    SEAM(4);
    if (IN(5)) {
        pg8::Gemm g{(const bf16_t*)(ws + WS_HB), (const bf16_t*)(ws + WS_WPT), NTOK, DM, DM}; pg8::StaticOrder S; S.init(NTOK, DM, gridDim.x, (int)blockIdx.x);
        pg8::EpiScores E{(float*)(ws + WS_PROJ), (const pg8::rss_t*)(ws + WS_CTL + CTL_RSS_X1)};
        pg8::gemm_phase<pg8::EpiScores, pg8::StaticOrder, false>(lds, g, S, E, nullptr);
    }
    SEAM(5);
    if (IN(6)) { peer_stage_a(args, lds, wave, lane, pflags); }
    const int myx = (int)(xb_xcc_id() & 7u);
    unsigned* qb = (unsigned*)(ws + WS_CTL + CTL_QCTR + 320);
    unsigned tk7 = 0u;
    if (IN(7) && tid == 0) tk7 = atomicAdd(qb + 4 * myx, 1u);
    SEAM(6);
    if (IN(7)) {
        if (tid == 0) MISC[0] = tk7;
        __syncthreads();
        unsigned it = MISC[0];
        __syncthreads();
        for (;;) {
            if (it >= 32u) break;
            peer_stage_b(args, lds, myx, (int)it, wave, lane, pflags);
            if (tid == 0) MISC[0] = (__hip_atomic_load(qb + 4 * myx, __ATOMIC_RELAXED, __HIP_MEMORY_SCOPE_AGENT) < 32u) ? atomicAdd(qb + 4 * myx, 1u) : 32u;
            __syncthreads();
            it = MISC[0];
            __syncthreads();
        }
        if (tid < 8) MISC[16 + tid] = __hip_atomic_load(qb + 4 * tid, __ATOMIC_RELAXED, __HIP_MEMORY_SCOPE_AGENT);
        __syncthreads();
        for (int d = 1; d < 8; ++d) { const int x = (myx + d) & 7;
            if (MISC[16 + x] < 32u) for (;;) {
                if (tid == 0) MISC[0] = atomicAdd(qb + 4 * x, 1u);
                __syncthreads();
                const unsigned it2 = MISC[0];
                __syncthreads();
                if (it2 >= 32u) break;
                peer_stage_b(args, lds, x, (int)it2, wave, lane, pflags);
            } }
    }
#undef IN
#undef SEAM
}

#ifndef MK_DEBUG
#ifndef MK_PER_PHASE
#define MK_PER_PHASE 0
#endif
extern "C" void kernel_launch(void* const* d_in, const int* in_sizes, int n_in, void* d_out, int out_size, void* d_ws, size_t ws_size, hipStream_t stream) {
    static int grid = 0;
    if (grid == 0) {
        if (n_in != 25 || out_size != NTOK * DM || ws_size < WS_END) { fprintf(stderr, "kernel_launch: unexpected shapes / workspace (%d inputs, out %d, ws %zu < %zu)\n", n_in, out_size, ws_size, (size_t)WS_END); grid = -1; return; }
        int dev = 0, cus = 0, per_cu = 0;
        if (hipGetDevice(&dev) != hipSuccess || hipDeviceGetAttribute(&cus, hipDeviceAttributeMultiprocessorCount, dev) != hipSuccess) { grid = -1; return; }
        if (hipFuncSetAttribute((const void*)mk_fwd, hipFuncAttributeMaxDynamicSharedMemorySize, LDS_BYTES) != hipSuccess) { fprintf(stderr, "kernel_launch: hipFuncSetAttribute failed\n"); grid = -1; return; }
        if (hipOccupancyMaxActiveBlocksPerMultiprocessor(&per_cu, (const void*)mk_fwd, 512, LDS_BYTES) != hipSuccess || per_cu < 1) { fprintf(stderr, "kernel_launch: occupancy query reports %d\n", per_cu); }
        (void)hipGetLastError();
        if (cus < 256) { fprintf(stderr, "kernel_launch: built for a 256-CU device (found %d CUs): a 256-workgroup grid would not be resident; nothing launched\n", cus); grid = -1; return; }
        grid = 256;
    }
    if (grid < 0) return;
    (void)hipMemsetAsync((char*)d_ws + WS_CTL, 0, CTL_BYTES, stream);
    Args a{};
    for (int i = 0; i < 25; ++i) a.in[i] = (const float*)d_in[i];
    a.out = (float*)d_out; a.ws = (unsigned char*)d_ws;
#if MK_PER_PHASE
#ifndef MK_DUP
#define MK_DUP -1
#endif
    for (int p = 0; p < 8; ++p) { a.ph_lo = p; a.ph_hi = p + 1;
#ifdef MK_DUP_FIRST
        if (p == MK_DUP) { a.ph_hi |= (MK_DUP_FLAGS) << 8; hipLaunchKernelGGL(mk_fwd, dim3(grid), dim3(512), LDS_BYTES, stream, a); a.ph_hi = p + 1; (void)hipMemsetAsync((char*)d_ws + WS_CTL + CTL_QCTR, 0, 512, stream); }
#endif
        hipLaunchKernelGGL(mk_fwd, dim3(grid), dim3(512), LDS_BYTES, stream, a);
#ifndef MK_DUP_FIRST
        if (p == MK_DUP) {
            (void)hipMemsetAsync((char*)d_ws + WS_CTL + CTL_QCTR, 0, 512, stream);
#ifndef MK_DUP_FLAGS
#define MK_DUP_FLAGS 0
#endif
            if (p == 3 && !((MK_DUP_FLAGS) & (1 | 16 | 32 | 64))) (void)hipMemsetAsync((char*)d_ws + WS_CTL + CTL_RSS_ATTN, 0, 65536, stream);
            if (p == 3 && !((MK_DUP_FLAGS) & 2)) (void)hipMemsetAsync((char*)d_ws + WS_CTL + CTL_RSS_SSM, 0, 65536, stream);
            if (p == 4) (void)hipMemsetAsync((char*)d_ws + WS_CTL + CTL_RSS_X1, 0, 65536, stream);
            a.ph_hi |= (MK_DUP_FLAGS) << 8;
            hipLaunchKernelGGL(mk_fwd, dim3(grid), dim3(512), LDS_BYTES, stream, a); }
#endif
    }
#else
    a.ph_lo = 0; a.ph_hi = 8;
    hipLaunchKernelGGL(mk_fwd, dim3(grid), dim3(512), LDS_BYTES, stream, a);
#endif
}
#endif
```
